# Optimizing an MI355X kernel written in HIP

```python
import math
import jax
import jax.numpy as jnp
from jax import lax
import numpy as np

D_MODEL = 1024
BATCH = 16
SEQ = 2048
DEPTH = 2

GRID_W = 64
CTX_LEN = 256
N_EVEN = (DEPTH + 1) // 2
N_ODD = DEPTH // 2
NORM_EPS = 1e-6

S5_WIDTH = D_MODEL // 2
S5_GROUP = 16
S5_GROUPS = S5_WIDTH // S5_GROUP
S5_STATE = 64
S5_DT_MIN = 1e-3
S5_DT_MAX = 1e-1

MLA_HEADS = 8
MLA_NOPE = 64
MLA_ROPE = 32
MLA_QK = MLA_NOPE + MLA_ROPE
MLA_V = 64
MLA_Q_RANK = D_MODEL // 4
MLA_KV_RANK = D_MODEL // 8
ROPE_BASE = 10000.0
Q_BLOCK = 128
EVEN_IN = S5_WIDTH + MLA_Q_RANK + MLA_KV_RANK + MLA_ROPE
EVEN_OUT = S5_WIDTH + MLA_HEADS * MLA_V

GLA_HEADS = 4
GLA_KEY = D_MODEL // 2
GLA_VAL = D_MODEL
GLA_DK = GLA_KEY // GLA_HEADS
GLA_DV = GLA_VAL // GLA_HEADS
GLA_GATE_RANK = 16
GLA_TAU = 16.0
GLA_CHUNK = 64
ODD_IN = 2 * GLA_KEY + 2 * GLA_VAL + 2 * GLA_GATE_RANK

FFN_DENSE = 2816
N_EXPERTS = 8
TOP_K = 2
FFN_EXPERT = 3584

kernel_name = 'hybrid_s5_mla_gla_moe_diffusion_block'


def rms_norm(x, g):
    xf = x.astype(jnp.float32)
    y = xf * lax.rsqrt(jnp.mean(xf * xf, axis=-1, keepdims=True) + NORM_EPS)
    return (y * g.astype(jnp.float32)).astype(x.dtype)


def modulate(x, shift, scale):
    return x * (1.0 + scale) + shift


def swiglu(x, w_gate, w_up, w_down):
    return (jax.nn.silu(x @ w_gate) * (x @ w_up)) @ w_down


def axial_rope_tables(n_rows, dtype):
    half = MLA_ROPE // 2
    inv = 1.0 / (ROPE_BASE ** (jnp.arange(0, half, 2, dtype=jnp.float32) / half))
    rows = jnp.repeat(jnp.arange(n_rows, dtype=jnp.float32), GRID_W)
    cols = jnp.tile(jnp.arange(GRID_W, dtype=jnp.float32), n_rows)
    ang_r = rows[:, None] * inv
    ang_c = cols[:, None] * inv
    return (jnp.cos(ang_r).astype(dtype), jnp.sin(ang_r).astype(dtype),
            jnp.cos(ang_c).astype(dtype), jnp.sin(ang_c).astype(dtype))


def _rotate_half(v, cos, sin):
    n = v.shape[-1] // 2
    v1, v2 = v[..., :n], v[..., n:]
    return jnp.concatenate([v1 * cos - v2 * sin, v2 * cos + v1 * sin], axis=-1)


def axial_rope(x, tab):
    cos_r, sin_r, cos_c, sin_c = tab
    half = MLA_ROPE // 2
    return jnp.concatenate([_rotate_half(x[..., :half], cos_r[:, None], sin_r[:, None]),
                            _rotate_half(x[..., half:], cos_c[:, None], sin_c[:, None])], axis=-1)


def block_attention(q, k, v):
    b, t, h, dq = q.shape
    nb = t // Q_BLOCK
    scale = dq ** -0.5
    qb = jnp.moveaxis(q.reshape(b, nb, Q_BLOCK, h, dq), 1, 0)

    def one(qblk):
        s = jnp.einsum('bqhd,bkhd->bhqk', qblk, k).astype(jnp.float32) * scale
        p = jax.nn.softmax(s, axis=-1).astype(v.dtype)
        return jnp.einsum('bhqk,bkhd->bqhd', p, v)

    o = lax.map(one, qb)
    return jnp.moveaxis(o, 0, 1).reshape(b, t, h * v.shape[-1])


def mla_queries(cq, q_norm, w_uq, tab):
    b, t = cq.shape[:2]
    q = (rms_norm(cq, q_norm) @ w_uq).reshape(b, t, MLA_HEADS, MLA_QK)
    if tab is None:
        return q
    return jnp.concatenate([q[..., :MLA_NOPE], axial_rope(q[..., MLA_NOPE:], tab)], axis=-1)


def mla_keys_values(ckv, k_rope, kv_norm, w_ukv, tab):
    b, t = ckv.shape[:2]
    kv = (rms_norm(ckv, kv_norm) @ w_ukv).reshape(b, t, MLA_HEADS, MLA_NOPE + MLA_V)
    kr = k_rope[:, :, None, :]
    if tab is not None:
        kr = axial_rope(kr, tab)
    k = jnp.concatenate([kv[..., :MLA_NOPE], jnp.broadcast_to(kr, (b, t, MLA_HEADS, MLA_ROPE))], axis=-1)
    return k, kv[..., MLA_NOPE:]


def s5_discretize(lam_re, lam_im, log_dt, b_re, b_im):
    dt = jnp.exp(log_dt)[:, None]
    mag = jnp.exp(lam_re * dt)
    abar_re = mag * jnp.cos(lam_im * dt)
    abar_im = mag * jnp.sin(lam_im * dt)
    den = lam_re * lam_re + lam_im * lam_im
    nr = abar_re - 1.0
    coef_re = (nr * lam_re + abar_im * lam_im) / den
    coef_im = (abar_im * lam_re - nr * lam_im) / den
    bbar_re = coef_re[..., None] * b_re - coef_im[..., None] * b_im
    bbar_im = coef_re[..., None] * b_im + coef_im[..., None] * b_re
    return abar_re, abar_im, bbar_re, bbar_im


def _complex_combine(e1, e2):
    a1r, a1i, b1r, b1i = e1
    a2r, a2i, b2r, b2i = e2
    return (a1r * a2r - a1i * a2i, a1r * a2i + a1i * a2r,
            a2r * b1r - a2i * b1i + b2r, a2r * b1i + a2i * b1r + b2i)


def s5_scan(u, abar_re, abar_im, bbar_re, bbar_im, s0_re, s0_im, reverse):
    if reverse:
        u = jnp.flip(u, axis=1)
    bu_re = jnp.einsum('btgh,gph->btgp', u, bbar_re)
    bu_im = jnp.einsum('btgh,gph->btgp', u, bbar_im)
    a_re = jnp.broadcast_to(abar_re, bu_re.shape)
    a_im = jnp.broadcast_to(abar_im, bu_im.shape)
    pw_re, pw_im, s_re, s_im = lax.associative_scan(_complex_combine, (a_re, a_im, bu_re, bu_im), axis=1)
    s_re, s_im = (s_re + pw_re * s0_re[:, None] - pw_im * s0_im[:, None],
                  s_im + pw_re * s0_im[:, None] + pw_im * s0_re[:, None])
    fin_re, fin_im = s_re[:, -1], s_im[:, -1]
    if reverse:
        s_re, s_im = jnp.flip(s_re, axis=1), jnp.flip(s_im, axis=1)
    return s_re, s_im, fin_re, fin_im


def s5_readout(s_re, s_im, c_re, c_im):
    y = jnp.einsum('btgp,ghp->btgh', s_re, c_re) - jnp.einsum('btgp,ghp->btgh', s_im, c_im)
    return y.reshape(y.shape[0], y.shape[1], S5_WIDTH)


def s5_mixer(u_lat, u_ctx, lam_re, lam_im, log_dt, b_re, b_im, c_re, c_im, d_skip, w_glu, b_glu, need_ctx):
    bsz = u_lat.shape[0]
    ul = u_lat.reshape(bsz, u_lat.shape[1], S5_GROUPS, S5_GROUP)
    uc = u_ctx.reshape(bsz, u_ctx.shape[1], S5_GROUPS, S5_GROUP)
    zero = jnp.zeros((bsz, S5_GROUPS, S5_STATE), u_lat.dtype)
    y_lat = u_lat * d_skip
    y_ctx = u_ctx * d_skip if need_ctx else None
    for direction in range(2):
        rev = direction == 1
        abar_re, abar_im, bbar_re, bbar_im = s5_discretize(lam_re[direction], lam_im[direction], log_dt[direction], b_re[direction], b_im[direction])
        sc_re, sc_im, fin_re, fin_im = s5_scan(uc, abar_re, abar_im, bbar_re, bbar_im, zero, zero, rev)
        sl_re, sl_im, _, _ = s5_scan(ul, abar_re, abar_im, bbar_re, bbar_im, fin_re, fin_im, rev)
        y_lat = y_lat + s5_readout(sl_re, sl_im, c_re[direction], c_im[direction])
        if need_ctx:
            y_ctx = y_ctx + s5_readout(sc_re, sc_im, c_re[direction], c_im[direction])

    def glu(y):
        a = jax.nn.gelu(y)
        return a * jax.nn.sigmoid(a @ w_glu + b_glu)

    return glu(y_lat), (glu(y_ctx) if need_ctx else None)


def even_mixer(x_lat, x_ctx, w_in, lam_re, lam_im, log_dt, b_re, b_im, c_re, c_im, d_skip, w_glu, b_glu,
               q_norm, w_uq, kv_norm, w_ukv, w_out, tab, need_ctx):
    z_l = x_lat @ w_in
    z_c = x_ctx @ w_in
    i0 = S5_WIDTH
    i1 = i0 + MLA_Q_RANK
    i2 = i1 + MLA_KV_RANK
    s5_l, s5_c = s5_mixer(z_l[..., :i0], z_c[..., :i0], lam_re, lam_im, log_dt, b_re, b_im, c_re, c_im,
                          d_skip, w_glu, b_glu, need_ctx)
    k_l, v_l = mla_keys_values(z_l[..., i1:i2], z_l[..., i2:], kv_norm, w_ukv, tab)
    k_c, v_c = mla_keys_values(z_c[..., i1:i2], z_c[..., i2:], kv_norm, w_ukv, None)
    q_l = mla_queries(z_l[..., i0:i1], q_norm, w_uq, tab)
    a_l = block_attention(q_l, jnp.concatenate([k_c, k_l], axis=1), jnp.concatenate([v_c, v_l], axis=1))
    out_l = jnp.concatenate([s5_l, a_l], axis=-1) @ w_out
    out_c = None
    if need_ctx:
        q_c = mla_queries(z_c[..., i0:i1], q_norm, w_uq, None)
        a_c = block_attention(q_c, k_c, v_c)
        out_c = jnp.concatenate([s5_c, a_c], axis=-1) @ w_out
    return out_l, out_c


def gla_chunk_scan(q, k, v, log_a, s0):
    b, t, h, _ = q.shape
    dv = v.shape[-1]
    n = t // GLA_CHUNK

    def chunks(a):
        return jnp.moveaxis(a.reshape(b, n, GLA_CHUNK, h, a.shape[-1]), 1, 0)

    order = jnp.tril(jnp.ones((GLA_CHUNK, GLA_CHUNK), dtype=bool))[None, :, :, None, None]

    def step(state, inp):
        qc, kc, vc, ac = inp
        qc = qc.astype(jnp.float32)
        kc = kc.astype(jnp.float32)
        vc = vc.astype(jnp.float32)
        cum = jnp.cumsum(ac.astype(jnp.float32), axis=1)
        last = cum[:, -1]
        o_inter = jnp.einsum('blhk,bhkv->blhv', qc * jnp.exp(cum), state)
        decay = jnp.exp(jnp.where(order, cum[:, :, None] - cum[:, None], -jnp.inf))
        scores = jnp.einsum('blhk,bmhk,blmhk->bhlm', qc, kc, decay)
        o_intra = jnp.einsum('bhlm,bmhv->blhv', scores, vc)
        new_state = jnp.exp(last)[..., None] * state + jnp.einsum('bmhk,bmhv->bhkv', kc * jnp.exp(last[:, None] - cum), vc)
        return new_state, o_inter + o_intra

    s_fin, o = lax.scan(step, s0.astype(jnp.float32), (chunks(q), chunks(k), chunks(v), chunks(log_a)))
    o = jnp.moveaxis(o, 0, 1).reshape(b, t, h, dv)
    return o.astype(v.dtype), s_fin


def gla_direction(q_c, k_c, v_c, la_c, q_l, k_l, v_l, la_l, reverse):
    def flip(a):
        return jnp.flip(a, axis=1) if reverse else a
    zero = jnp.zeros((q_c.shape[0], GLA_HEADS, GLA_DK, GLA_DV), jnp.float32)
    o_c, s_c = gla_chunk_scan(flip(q_c), flip(k_c), flip(v_c), flip(la_c), zero)
    o_l, _ = gla_chunk_scan(flip(q_l), flip(k_l), flip(v_l), flip(la_l), s_c)
    return flip(o_l), flip(o_c)


def odd_mixer(x_lat, x_ctx, w_in, w_gate2, b_gate2, head_norm, w_out, need_ctx):
    i1 = GLA_KEY
    i2 = 2 * GLA_KEY
    i3 = i2 + GLA_VAL
    i4 = i3 + GLA_VAL
    i5 = i4 + GLA_GATE_RANK

    def project(x):
        z = x @ w_in
        b, t = z.shape[:2]
        q = z[..., :i1].reshape(b, t, GLA_HEADS, GLA_DK) * (GLA_DK ** -0.5)
        k = z[..., i1:i2].reshape(b, t, GLA_HEADS, GLA_DK)
        v = z[..., i2:i3].reshape(b, t, GLA_HEADS, GLA_DV)
        r = z[..., i3:i4]
        la_f = (jax.nn.log_sigmoid((z[..., i4:i5] @ w_gate2[0] + b_gate2[0]).astype(jnp.float32)) / GLA_TAU).reshape(b, t, GLA_HEADS, GLA_DK)
        la_b = (jax.nn.log_sigmoid((z[..., i5:] @ w_gate2[1] + b_gate2[1]).astype(jnp.float32)) / GLA_TAU).reshape(b, t, GLA_HEADS, GLA_DK)
        return q, k, v, r, la_f, la_b

    q_l, k_l, v_l, r_l, laf_l, lab_l = project(x_lat)
    q_c, k_c, v_c, r_c, laf_c, lab_c = project(x_ctx)
    of_l, of_c = gla_direction(q_c, k_c, v_c, laf_c, q_l, k_l, v_l, laf_l, False)
    ob_l, ob_c = gla_direction(q_c, k_c, v_c, lab_c, q_l, k_l, v_l, lab_l, True)

    def finish(o, r):
        b, t = o.shape[:2]
        o = rms_norm(o, head_norm).reshape(b, t, GLA_VAL) * jax.nn.silu(r)
        return o @ w_out

    out_l = finish(of_l + ob_l, r_l)
    out_c = finish(of_c + ob_c, r_c) if need_ctx else None
    return out_l, out_c


def moe_swiglu(x, router, w_gate, w_up, w_down):
    b, t, d = x.shape
    xf = x.reshape(b * t, d)
    logits = (xf @ router).astype(jnp.float32)
    top_val, top_idx = lax.top_k(logits, TOP_K)
    top_w = jax.nn.softmax(top_val, axis=-1)
    comb = jnp.sum(jax.nn.one_hot(top_idx, N_EXPERTS, dtype=jnp.float32) * top_w[..., None], axis=1).astype(x.dtype)
    y = jnp.zeros_like(xf)
    for e in range(N_EXPERTS):
        y = y + comb[:, e:e + 1] * swiglu(xf, w_gate[e], w_up[e], w_down[e])
    return y.reshape(b, t, d)


def setup_inputs(seed: int = 0) -> dict:
    key = jax.random.key(seed)
    ks = list(jax.random.split(key, 48))

    def nrm(shape, scale):
        return jax.random.normal(ks.pop(), shape, jnp.float32) * scale

    D = D_MODEL
    G, P, H = S5_GROUPS, S5_STATE, S5_GROUP
    n_idx = jnp.arange(P, dtype=jnp.float32)
    return {
        'x': nrm((BATCH, SEQ, D), 1.0),
        'c': nrm((BATCH, D), 1.0),
        'ctx': nrm((BATCH, CTX_LEN, D), 1.0),
        'c_ctx': nrm((D,), 1.0),
        'mod_w': nrm((DEPTH, D, 6 * D), D ** -0.5),
        'mod_b': nrm((DEPTH, 6 * D), 0.02),
        'norm_g': 1.0 + nrm((DEPTH, 4, D), 0.05),
        'ev_w_in': nrm((N_EVEN, D, EVEN_IN), D ** -0.5),
        's5_lam_re': -0.5 + nrm((N_EVEN, 2, G, P), 0.01),
        's5_lam_im': jnp.pi * n_idx + nrm((N_EVEN, 2, G, P), 0.01),
        's5_log_dt': jax.random.uniform(ks.pop(), (N_EVEN, 2, G), jnp.float32, math.log(S5_DT_MIN), math.log(S5_DT_MAX)),
        's5_b_re': nrm((N_EVEN, 2, G, P, H), (2 * H) ** -0.5),
        's5_b_im': nrm((N_EVEN, 2, G, P, H), (2 * H) ** -0.5),
        's5_c_re': nrm((N_EVEN, 2, G, H, P), (2 * P) ** -0.5),
        's5_c_im': nrm((N_EVEN, 2, G, H, P), (2 * P) ** -0.5),
        's5_d': nrm((N_EVEN, S5_WIDTH), 1.0),
        's5_w_glu': nrm((N_EVEN, S5_WIDTH, S5_WIDTH), S5_WIDTH ** -0.5),
        's5_b_glu': nrm((N_EVEN, S5_WIDTH), 0.02),
        'mla_q_norm': 1.0 + nrm((N_EVEN, MLA_Q_RANK), 0.05),
        'mla_w_uq': nrm((N_EVEN, MLA_Q_RANK, MLA_HEADS * MLA_QK), MLA_Q_RANK ** -0.5),
        'mla_kv_norm': 1.0 + nrm((N_EVEN, MLA_KV_RANK), 0.05),
        'mla_w_ukv': nrm((N_EVEN, MLA_KV_RANK, MLA_HEADS * (MLA_NOPE + MLA_V)), MLA_KV_RANK ** -0.5),
        'ev_w_out': nrm((N_EVEN, EVEN_OUT, D), EVEN_OUT ** -0.5),
        'ffn_w_gate': nrm((N_EVEN, D, FFN_DENSE), D ** -0.5),
        'ffn_w_up': nrm((N_EVEN, D, FFN_DENSE), D ** -0.5),
        'ffn_w_down': nrm((N_EVEN, FFN_DENSE, D), FFN_DENSE ** -0.5),
        'od_w_in': nrm((N_ODD, D, ODD_IN), D ** -0.5),
        'gla_w_gate2': nrm((N_ODD, 2, GLA_GATE_RANK, GLA_KEY), GLA_GATE_RANK ** -0.5),
        'gla_b_gate2': nrm((N_ODD, 2, GLA_KEY), 0.1),
        'gla_head_norm': 1.0 + nrm((N_ODD, GLA_DV), 0.05),
        'od_w_out': nrm((N_ODD, GLA_VAL, D), GLA_VAL ** -0.5),
        'moe_router': nrm((N_ODD, D, N_EXPERTS), D ** -0.5),
        'moe_w_gate': nrm((N_ODD, N_EXPERTS, D, FFN_EXPERT), D ** -0.5),
        'moe_w_up': nrm((N_ODD, N_EXPERTS, D, FFN_EXPERT), D ** -0.5),
        'moe_w_down': nrm((N_ODD, N_EXPERTS, FFN_EXPERT, D), FFN_EXPERT ** -0.5),
    }


def reference(x, c, ctx, c_ctx, mod_w, mod_b, norm_g, ev_w_in, s5_lam_re, s5_lam_im, s5_log_dt,
              s5_b_re, s5_b_im, s5_c_re, s5_c_im, s5_d, s5_w_glu, s5_b_glu, mla_q_norm, mla_w_uq,
              mla_kv_norm, mla_w_ukv, ev_w_out, ffn_w_gate, ffn_w_up, ffn_w_down, od_w_in,
              gla_w_gate2, gla_b_gate2, gla_head_norm, od_w_out, moe_router, moe_w_gate, moe_w_up,
              moe_w_down):
    n_rows = x.shape[1] // GRID_W
    tab = axial_rope_tables(n_rows, x.dtype)
    h, hc = x, ctx
    act_c = jax.nn.silu(c)
    act_ctx = jax.nn.silu(c_ctx)
    for i in range(DEPTH):
        need_ctx = i < DEPTH - 1
        j = i // 2
        mod_l = act_c @ mod_w[i] + mod_b[i]
        mod_c = act_ctx @ mod_w[i] + mod_b[i]
        sh1, sc1, g1, sh2, sc2, g2 = jnp.split(mod_l[:, None, :], 6, axis=-1)
        csh1, csc1, cg1, csh2, csc2, cg2 = jnp.split(mod_c, 6, axis=-1)
        xl = modulate(rms_norm(h, norm_g[i, 0]), sh1, sc1)
        xc = modulate(rms_norm(hc, norm_g[i, 0]), csh1, csc1)
        if i % 2 == 0:
            yl, yc = even_mixer(xl, xc, ev_w_in[j], s5_lam_re[j], s5_lam_im[j], s5_log_dt[j], s5_b_re[j],
                                s5_b_im[j], s5_c_re[j], s5_c_im[j], s5_d[j], s5_w_glu[j], s5_b_glu[j],
                                mla_q_norm[j], mla_w_uq[j], mla_kv_norm[j], mla_w_ukv[j], ev_w_out[j],
                                tab, need_ctx)
        else:
            yl, yc = odd_mixer(xl, xc, od_w_in[j], gla_w_gate2[j], gla_b_gate2[j], gla_head_norm[j],
                               od_w_out[j], need_ctx)
        h = h + g1 * rms_norm(yl, norm_g[i, 1])
        if need_ctx:
            hc = hc + cg1 * rms_norm(yc, norm_g[i, 1])
        xl = modulate(rms_norm(h, norm_g[i, 2]), sh2, sc2)
        if i % 2 == 0:
            fl = swiglu(xl, ffn_w_gate[j], ffn_w_up[j], ffn_w_down[j])
        else:
            fl = moe_swiglu(xl, moe_router[j], moe_w_gate[j], moe_w_up[j], moe_w_down[j])
        h = h + g2 * rms_norm(fl, norm_g[i, 3])
        if need_ctx:
            xc = modulate(rms_norm(hc, norm_g[i, 2]), csh2, csc2)
            if i % 2 == 0:
                fc = swiglu(xc, ffn_w_gate[j], ffn_w_up[j], ffn_w_down[j])
            else:
                fc = moe_swiglu(xc, moe_router[j], moe_w_gate[j], moe_w_up[j], moe_w_down[j])
            hc = hc + cg2 * rms_norm(fc, norm_g[i, 3])
    return h
```

```cpp
#include <hip/hip_runtime.h>
#include <cstdio>
#include <cstdint>
#define MK_ONE_LAUNCH 1
namespace pg8 {
#define PG8_LAS __attribute__((address_space(3)))
typedef unsigned short bf16_t;
typedef short bf16x8 __attribute__((ext_vector_type(8)));
typedef float f32x4 __attribute__((ext_vector_type(4)));
typedef unsigned u32x4 __attribute__((ext_vector_type(4)));
constexpr int BM = 256, BK = 64, HALF = 128, HTB = HALF * BK * 2  , STAGE_BYTES = 8 * HTB, NXCD = 8, WGM = 8;

__host__ __device__ __forceinline__ int lds_byte(int r, int c) { const int st = (r >> 4) * 2 + (c >> 5), rr = r & 15, cc = c & 31, ob = rr * 64 + cc * 2; return st * 1024 + (ob ^ (((ob >> 9) & 1) << 5)); }
__host__ __device__ __forceinline__ void stage_rc(int b, int& R, int& C) { const int st = b / 1024, sb = b % 1024, swz = sb ^ (((sb >> 9) & 1) << 5); R = (st >> 1) * 16 + swz / 64; C = (st & 1) * 32 + (swz % 64) / 2; }
__host__ __device__ __forceinline__ int perm32(int rho) { const int n = rho >> 4, i = rho & 15; return 8 * (i >> 2) + 4 * n + (i & 3); }

struct Unit { int pm, pn; };
struct Gemm { const bf16_t* A; const bf16_t* Bt; int M, N, K; };

struct StaticOrder {
    int nM, nN, nwg, G, c;
    __host__ __device__ void init(int M, int N, int G_, int c_) { nM = M / BM; nN = N / BM; nwg = nM * nN; G = G_; c = c_; }
    __host__ __device__ bool next(int i, Unit& u) const {
        const long L = (long)i * G + c; if (L >= nwg) return false;
        int wgid = (int)L; { const int q = nwg / NXCD, r = nwg % NXCD, xcd = wgid % NXCD, off = wgid / NXCD; wgid = (xcd < r ? xcd * (q + 1) : r * (q + 1) + (xcd - r) * q) + off; }
        const int nig = WGM * nN, gid = wgid / nig, fm = gid * WGM, gsz = (nM - fm) < WGM ? (nM - fm) : WGM;
        u.pm = fm + ((wgid % nig) % gsz); u.pn = (wgid % nig) / gsz; return true;
    }
    __device__ __forceinline__ void a_ready(const Unit&) const {}
    __device__ __forceinline__ void done(const Unit&) const {}
};

__device__ __forceinline__ unsigned cvt_pk_bf16(float lo, float hi) { unsigned r; asm volatile("v_cvt_pk_bf16_f32 %0, %1, %2" : "=v"(r) : "v"(lo), "v"(hi)); return r; }
typedef float f32x2 __attribute__((ext_vector_type(2)));
__device__ __forceinline__ u32x4 pack8(const f32x4 v0, const f32x4 v1) { u32x4 w; w.x = cvt_pk_bf16(v0[0], v0[1]); w.y = cvt_pk_bf16(v0[2], v0[3]); w.z = cvt_pk_bf16(v1[0], v1[1]); w.w = cvt_pk_bf16(v1[2], v1[3]); return w; }
__device__ __forceinline__ float bf_lo(unsigned u) { return __uint_as_float(u << 16); }
__device__ __forceinline__ float bf_hi(unsigned u) { return __uint_as_float(u & 0xffff0000u); }
__device__ __forceinline__ float sigmoid_f(float x) { return __builtin_amdgcn_rcpf(1.0f + __builtin_amdgcn_exp2f(-1.4426950408889634f * x)); }

struct EpiPlain {
    static constexpr bool PERM = true, AFTER_DRAIN = false;
    bf16_t* O; int ldc; int pm_off; int nmod;
    __device__ __forceinline__ void operator()(const f32x4 (&acc)[2][2][4][2], const Unit& u, int wr, int wc, int fr, int fq) const {
        const int row0 = (u.pm - pm_off) * BM + wr * 64 + fr; const int ct = nmod ? (u.pn % nmod) : u.pn; const int col0 = ct * BM + wc * 32 + 8 * fq;
#pragma unroll
        for (int ai = 0; ai < 2; ++ai)
#pragma unroll
            for (int m = 0; m < 4; ++m) { bf16_t* rowp = O + (size_t)(row0 + ai * HALF + m * 16) * ldc + col0;
#pragma unroll
                for (int bj = 0; bj < 2; ++bj) *(u32x4*)(rowp + bj * HALF) = pack8(acc[ai][bj][m][0], acc[ai][bj][m][1]); }
    }
};
struct EpiSplit {
    static constexpr bool PERM = true, AFTER_DRAIN = false;
    bf16_t* O0; int ld0; bf16_t* O1; int ld1; int nsplit; int ncols1;
    __device__ __forceinline__ void operator()(const f32x4 (&acc)[2][2][4][2], const Unit& u, int wr, int wc, int fr, int fq) const {
        const int row0 = u.pm * BM + wr * 64 + fr; const bool first = u.pn < nsplit;
        bf16_t* base = first ? O0 : O1; const int ld = first ? ld0 : ld1; const int col0 = (first ? u.pn : u.pn - nsplit) * BM + wc * 32 + 8 * fq; const int lim = first ? 0x7fffffff : ncols1;
#pragma unroll
        for (int ai = 0; ai < 2; ++ai)
#pragma unroll
            for (int m = 0; m < 4; ++m) { bf16_t* rowp = base + (size_t)(row0 + ai * HALF + m * 16) * ld + col0;
#pragma unroll
                for (int bj = 0; bj < 2; ++bj) if (col0 + bj * HALF < lim) *(u32x4*)(rowp + bj * HALF) = pack8(acc[ai][bj][m][0], acc[ai][bj][m][1]); }
    }
};
struct EpiGlu {
    static constexpr bool PERM = true, AFTER_DRAIN = false;
    const bf16_t* Aa; int lda; const float* bias; bf16_t* O; int ldc;
    __device__ __forceinline__ void operator()(const f32x4 (&acc)[2][2][4][2], const Unit& u, int wr, int wc, int fr, int fq) const {
        const int row0 = u.pm * BM + wr * 64 + fr; const int col0 = u.pn * BM + wc * 32 + 8 * fq;
#pragma unroll
        for (int bj = 0; bj < 2; ++bj) { const f32x4 b0 = *(const f32x4*)(bias + col0 + bj * HALF), b1 = *(const f32x4*)(bias + col0 + bj * HALF + 4);
#pragma unroll
            for (int ai = 0; ai < 2; ++ai)
#pragma unroll
                for (int m = 0; m < 4; ++m) { const size_t r = (size_t)(row0 + ai * HALF + m * 16);
                    const u32x4 a8 = *(const u32x4*)(Aa + r * lda + col0 + bj * HALF);
                    f32x4 v0 = acc[ai][bj][m][0] + b0, v1 = acc[ai][bj][m][1] + b1;
                    v0[0] = bf_lo(a8.x) * sigmoid_f(v0[0]); v0[1] = bf_hi(a8.x) * sigmoid_f(v0[1]); v0[2] = bf_lo(a8.y) * sigmoid_f(v0[2]); v0[3] = bf_hi(a8.y) * sigmoid_f(v0[3]);
                    v1[0] = bf_lo(a8.z) * sigmoid_f(v1[0]); v1[1] = bf_hi(a8.z) * sigmoid_f(v1[1]); v1[2] = bf_lo(a8.w) * sigmoid_f(v1[2]); v1[3] = bf_hi(a8.w) * sigmoid_f(v1[3]);
                    *(u32x4*)(O + r * ldc + col0 + bj * HALF) = pack8(v0, v1); } }
    }
};
struct EpiSwiGlu {
    static constexpr bool PERM = true, AFTER_DRAIN = false;
    bf16_t* O; int ldc; int pm_off; int nmod;
    __device__ __forceinline__ void operator()(const f32x4 (&acc)[2][2][4][2], const Unit& u, int wr, int wc, int fr, int fq) const {
        const int row0 = (u.pm - pm_off) * BM + wr * 64 + fr; const int ct = nmod ? (u.pn % nmod) : u.pn; const int col0 = ct * HALF + wc * 32 + 8 * fq;
#pragma unroll
        for (int ai = 0; ai < 2; ++ai)
#pragma unroll
            for (int m = 0; m < 4; ++m) { f32x4 o0, o1;
#pragma unroll
                for (int i = 0; i < 4; ++i) { const float g0 = acc[ai][0][m][0][i], g1 = acc[ai][0][m][1][i]; o0[i] = g0 * sigmoid_f(g0) * acc[ai][1][m][0][i]; o1[i] = g1 * sigmoid_f(g1) * acc[ai][1][m][1][i]; }
                *(u32x4*)(O + (size_t)(row0 + ai * HALF + m * 16) * ldc + col0) = pack8(o0, o1); }
    }
};
struct MoeOrder {
    int t0, nT, nN, G, c; int e1, e2, e3, e4, e5, e6, e7;
    __device__ __forceinline__ bool next(int i, Unit& u) const {
        const int nwg = nT * nN; const long L = (long)i * G + c; if (L >= nwg) return false;
        int wgid = (int)L; { const int q = nwg / NXCD, r = nwg % NXCD, xcd = wgid % NXCD, off = wgid / NXCD; wgid = (xcd < r ? xcd * (q + 1) : r * (q + 1) + (xcd - r) * q) + off; }
        const int nig = WGM * nN, gid = wgid / nig, fm = gid * WGM, gsz = (nT - fm) < WGM ? (nT - fm) : WGM;
        const int pm = t0 + fm + ((wgid % nig) % gsz), pn = (wgid % nig) / gsz;
        const int e = (pm >= e1) + (pm >= e2) + (pm >= e3) + (pm >= e4) + (pm >= e5) + (pm >= e6) + (pm >= e7);
        u.pm = pm; u.pn = e * nN + pn; return true;
    }
    __device__ __forceinline__ void a_ready(const Unit&) const {}
    __device__ __forceinline__ void done(const Unit&) const {}
};
template <class Epi, class Sched, bool ALIGN_EPI = false, bool SP2 = false>
__device__ __forceinline__ void gemm_phase(PG8_LAS unsigned char* lds, const Gemm g, const Sched& S, const Epi& E) {
    const int tid = threadIdx.x, wid = __builtin_amdgcn_readfirstlane(tid >> 6), lane = tid & 63, wr = wid >> 2, wc = wid & 3, fr = lane & 15, fq = lane >> 4;
    const int K = g.K, nt = K / BK;
    unsigned voffA[2], voffB[2];
#pragma unroll
    for (int i = 0; i < 2; ++i) { int R, C; stage_rc(tid * 16 + i * 8192, R, C); const int Rb = Epi::PERM ? ((R & ~31) + perm32(R & 31)) : R;
        voffA[i] = (unsigned)(R * K + C) * 2u; voffB[i] = (unsigned)(Rb * K + C) * 2u; }
    const size_t kstep = (size_t)(BK * 2);
    const size_t hstep = (size_t)HALF * K * 2;
    const size_t tstep = 2 * hstep;
    const unsigned ldsw = (unsigned)wid * 1024u;
    const int aoff = lds_byte(wr * 64 + fr, fq * 8), boff = lds_byte(wc * 32 + fr, fq * 8);
#define PG8_SA(b, h) (((b) * 2 + (h)) * HTB)
#define PG8_SB(b, h) ((4 + (b) * 2 + (h)) * HTB)
#define PG8_STAGE(bufoff, gbase, voff) do { _Pragma("unroll") for (int _i = 0; _i < 2; ++_i) \
        __builtin_amdgcn_global_load_lds((const unsigned*)((const char*)(gbase) + (voff)[_i]), (PG8_LAS unsigned*)(lds + (bufoff) + ldsw + _i * 8192), 16, 0, 0); } while (0)
#define PG8_LDA(dst, b, h) do { _Pragma("unroll") for (int m = 0; m < 4; ++m) _Pragma("unroll") for (int k = 0; k < 2; ++k) dst[m][k] = *(const PG8_LAS bf16x8*)(lds + PG8_SA(b, h) + aoff + m * 2048 + k * 1024); } while (0)
#define PG8_LDB(dst, b, h) do { _Pragma("unroll") for (int n = 0; n < 2; ++n) _Pragma("unroll") for (int k = 0; k < 2; ++k) dst[n][k] = *(const PG8_LAS bf16x8*)(lds + PG8_SB(b, h) + boff + n * 2048 + k * 1024); } while (0)
#define PG8_MMA(ai, bj, At, Bt) do { __builtin_amdgcn_s_setprio(1); _Pragma("unroll") for (int m = 0; m < 4; ++m) _Pragma("unroll") for (int n = 0; n < 2; ++n) _Pragma("unroll") for (int k = 0; k < 2; ++k) \
        acc[ai][bj][m][n] = __builtin_amdgcn_mfma_f32_16x16x32_bf16(Bt[n][k], At[m][k], acc[ai][bj][m][n], 0, 0, 0); __builtin_amdgcn_s_setprio(0); } while (0)
#define PG8_WAIT_V(n) asm volatile("s_waitcnt vmcnt(" #n ")" ::: "memory")
#define PG8_WAIT_L(n) asm volatile("s_waitcnt lgkmcnt(" #n ")" ::: "memory")
#define PG8_BAR __builtin_amdgcn_s_barrier()
#define PG8_SCHED __builtin_amdgcn_sched_barrier(0)
    Unit cur, nxt; int ui = 0;
    if (!S.next(0, cur)) return;
    f32x4 acc[2][2][4][2];
#pragma unroll
    for (int a = 0; a < 2; ++a)
#pragma unroll
        for (int b = 0; b < 2; ++b)
#pragma unroll
            for (int m = 0; m < 4; ++m)
#pragma unroll
                for (int n = 0; n < 2; ++n) acc[a][b][m][n] = (f32x4){0.f, 0.f, 0.f, 0.f};
    bf16x8 At[4][2], B0[2][2], B1[2][2];
    const char* cA = (const char*)g.A + (size_t)cur.pm * tstep; const char* cB = (const char*)g.Bt + (size_t)cur.pn * tstep;
    S.a_ready(cur);
    if constexpr (SP2) {
        PG8_STAGE(PG8_SB(0, 0), cB, voffB); PG8_STAGE(PG8_SB(0, 1), cB + hstep, voffB); PG8_STAGE(PG8_SA(0, 0), cA, voffA); PG8_STAGE(PG8_SA(0, 1), cA + hstep, voffA);
        if (wr == 1) PG8_BAR;
        PG8_WAIT_V(2); PG8_BAR;
        PG8_STAGE(PG8_SB(1, 0), cB + kstep, voffB); PG8_STAGE(PG8_SA(1, 0), cA + kstep, voffA); PG8_STAGE(PG8_SB(1, 1), cB + hstep + kstep, voffB);
        PG8_WAIT_V(6); PG8_BAR;
    } else {
        PG8_STAGE(PG8_SB(0, 0), cB, voffB); PG8_STAGE(PG8_SA(0, 0), cA, voffA); PG8_STAGE(PG8_SB(0, 1), cB + hstep, voffB); PG8_STAGE(PG8_SA(0, 1), cA + hstep, voffA);
        if (wr == 1) PG8_BAR;
        PG8_WAIT_V(4); PG8_BAR;
        PG8_STAGE(PG8_SB(1, 0), cB + kstep, voffB); PG8_STAGE(PG8_SA(1, 0), cA + kstep, voffA); PG8_STAGE(PG8_SB(1, 1), cB + hstep + kstep, voffB);
        PG8_WAIT_V(6); PG8_BAR;
    }
    for (;;) {
        const bool has_next = S.next(ui + 1, nxt);
        const char* nA = has_next ? (const char*)g.A + (size_t)nxt.pm * tstep : cA; const char* nB = has_next ? (const char*)g.Bt + (size_t)nxt.pn * tstep : cB;
        for (int t = 0; t < nt; t += 2) {
            const bool last = (t == nt - 2);
            const char* a1 = cA + (size_t)(t + 1) * kstep;
            const char* a2 = last ? nA : cA + (size_t)(t + 2) * kstep; const char* b2 = last ? nB : cB + (size_t)(t + 2) * kstep;
            const char* a3 = a2 + kstep; const char* b3 = b2 + kstep;
            if (last && has_next) S.a_ready(nxt);
            if constexpr (SP2) {
            PG8_LDB(B0, 0, 0); PG8_LDB(B1, 0, 1); PG8_SCHED; PG8_LDA(At, 0, 0); PG8_STAGE(PG8_SA(1, 1), a1 + hstep, voffA);
            PG8_WAIT_V(8); PG8_WAIT_L(0); PG8_BAR; PG8_MMA(0, 0, At, B0); PG8_MMA(0, 1, At, B1); PG8_BAR; PG8_SCHED;
            PG8_LDA(At, 0, 1); PG8_STAGE(PG8_SB(0, 0), b2, voffB); PG8_STAGE(PG8_SB(0, 1), b2 + hstep, voffB); PG8_STAGE(PG8_SA(0, 0), a2, voffA);
            PG8_WAIT_V(8); PG8_WAIT_L(0); PG8_BAR; PG8_MMA(1, 0, At, B0); PG8_MMA(1, 1, At, B1); PG8_BAR; PG8_SCHED;
            PG8_LDB(B0, 1, 0); PG8_LDB(B1, 1, 1); PG8_SCHED; PG8_LDA(At, 1, 0); PG8_STAGE(PG8_SA(0, 1), a2 + hstep, voffA);
            PG8_WAIT_V(8); PG8_WAIT_L(0); PG8_BAR; PG8_MMA(0, 0, At, B0); PG8_MMA(0, 1, At, B1); PG8_BAR; PG8_SCHED;
            PG8_LDA(At, 1, 1); PG8_STAGE(PG8_SB(1, 0), b3, voffB); PG8_STAGE(PG8_SB(1, 1), b3 + hstep, voffB); PG8_STAGE(PG8_SA(1, 0), a3, voffA);
            PG8_WAIT_V(8); PG8_WAIT_L(0); PG8_BAR; PG8_MMA(1, 0, At, B0); PG8_MMA(1, 1, At, B1); PG8_BAR; PG8_SCHED;
            } else {
            PG8_LDB(B0, 0, 0); PG8_SCHED; PG8_LDA(At, 0, 0); PG8_STAGE(PG8_SA(1, 1), a1 + hstep, voffA);
            PG8_WAIT_L(8); PG8_BAR; PG8_WAIT_L(0); PG8_MMA(0, 0, At, B0); PG8_BAR; PG8_SCHED;
            PG8_LDB(B1, 0, 1); PG8_STAGE(PG8_SB(0, 0), b2, voffB);
            PG8_BAR; PG8_WAIT_L(0); PG8_MMA(0, 1, At, B1); PG8_BAR;
            PG8_LDA(At, 0, 1); PG8_STAGE(PG8_SA(0, 0), a2, voffA);
            PG8_BAR; PG8_WAIT_L(0); PG8_MMA(1, 0, At, B0); PG8_BAR; PG8_SCHED;
            PG8_STAGE(PG8_SB(0, 1), b2 + hstep, voffB);
            PG8_WAIT_V(6); PG8_BAR; PG8_MMA(1, 1, At, B1); PG8_BAR;
            PG8_LDB(B0, 1, 0); PG8_SCHED; PG8_LDA(At, 1, 0); PG8_STAGE(PG8_SA(0, 1), a2 + hstep, voffA);
            PG8_WAIT_L(8); PG8_BAR; PG8_WAIT_L(0); PG8_MMA(0, 0, At, B0); PG8_BAR; PG8_SCHED;
            PG8_LDB(B1, 1, 1); PG8_STAGE(PG8_SB(1, 0), b3, voffB);
            PG8_BAR; PG8_WAIT_L(0); PG8_MMA(0, 1, At, B1); PG8_BAR;
            PG8_LDA(At, 1, 1); PG8_STAGE(PG8_SA(1, 0), a3, voffA);
            PG8_BAR; PG8_WAIT_L(0); PG8_MMA(1, 0, At, B0); PG8_BAR; PG8_SCHED;
            PG8_STAGE(PG8_SB(1, 1), b3 + hstep, voffB);
            PG8_WAIT_V(6); PG8_BAR; PG8_MMA(1, 1, At, B1); PG8_BAR;
            }
        }
        if constexpr (ALIGN_EPI) { if (wr == 0) PG8_BAR; }
        if constexpr (!Epi::AFTER_DRAIN) { E(acc, cur, wr, wc, fr, fq); S.done(cur); }
        if (!has_next) break;
#pragma unroll
        for (int a = 0; a < 2; ++a)
#pragma unroll
            for (int b = 0; b < 2; ++b)
#pragma unroll
                for (int m = 0; m < 4; ++m)
#pragma unroll
                    for (int n = 0; n < 2; ++n) acc[a][b][m][n] = (f32x4){0.f, 0.f, 0.f, 0.f};
        cur = nxt; cA = nA; cB = nB; ++ui;
        if constexpr (ALIGN_EPI) { if (wr == 1) PG8_BAR; }
    }
    PG8_WAIT_V(0);
    if constexpr (!ALIGN_EPI) { if (wr == 0) PG8_BAR; }
    PG8_BAR;
    if constexpr (Epi::AFTER_DRAIN) { E.fused(acc, cur, wr, wc, fr, fq, lds, wid, lane); S.done(cur); }
#undef PG8_SA
#undef PG8_SB
#undef PG8_STAGE
#undef PG8_LDA
#undef PG8_LDB
#undef PG8_MMA
#undef PG8_WAIT_V
#undef PG8_WAIT_L
#undef PG8_BAR
#undef PG8_SCHED
}
}
#define GAS __attribute__((address_space(1)))
#define LAS __attribute__((address_space(3)))
typedef unsigned short bf16;
typedef unsigned v4u __attribute__((ext_vector_type(4)));
typedef float f32x4 __attribute__((ext_vector_type(4)));
typedef short bf16x8 __attribute__((ext_vector_type(8)));
typedef GAS unsigned gu32;
typedef GAS unsigned long long gu64;
#define RLX_AGENT __ATOMIC_RELAXED, __HIP_MEMORY_SCOPE_AGENT
#define LDS_WAIT() asm volatile("s_waitcnt lgkmcnt(0)" ::: "memory")
#define VM_WAIT() asm volatile("s_waitcnt vmcnt(0)" ::: "memory")
__device__ __forceinline__ unsigned long long rt() { return __builtin_amdgcn_s_memrealtime(); }
__device__ __forceinline__ unsigned f2bf(float f) { unsigned u = __builtin_bit_cast(unsigned, f); return (u + 0x7fffu + ((u >> 16) & 1u)) >> 16; }
__device__ __forceinline__ unsigned pk2(float lo, float hi) { return f2bf(lo) | (f2bf(hi) << 16); }
#define XB_TMO      128
#define XB_XCNT(j)  (256  + 64 * (j))
#define XB_XSUB(j)  (1280 + 64 * (j))
#define XB_XGEN(j)  (2304 + 64 * (j))
#define XB_TOP      3328
#define XB_TOPGEN   3392
#define XCD_BAR_WORDS 3456
#define XB_SPIN_CAP (1u << 18)

__device__ __forceinline__ unsigned xb_ld(unsigned* p)              { return __hip_atomic_load(p, __ATOMIC_RELAXED, __HIP_MEMORY_SCOPE_AGENT); }
__device__ __forceinline__ unsigned xb_add(unsigned* p, unsigned v) { return __hip_atomic_fetch_add(p, v, __ATOMIC_RELAXED, __HIP_MEMORY_SCOPE_AGENT); }
__device__ __forceinline__ unsigned xb_xcc_id() { return (unsigned)__builtin_amdgcn_s_getreg((3 << 11) | 20) & 0xFu; }
#define XB_SPIN(cond, bar) do { unsigned _sp = 0; while (cond) { __builtin_amdgcn_s_sleep(1); \
    if ((++_sp & 255u) == 0u) { if (xb_ld(&(bar)[XB_TMO])) break; if (_sp > XB_SPIN_CAP) { atomicAdd(&(bar)[XB_TMO], 1u); break; } } } } while (0)

struct XcdBarrier {
    unsigned* bar; unsigned x;
    volatile LAS unsigned* st;
};

__device__ __forceinline__ XcdBarrier xcd_barrier_post(unsigned* bar, volatile LAS unsigned* st) {
    XcdBarrier b; b.bar = bar; b.x = xb_xcc_id(); b.st = st;
    if (threadIdx.x == 0) (void)xb_add(&bar[XB_XCNT(b.x)], 1u);
    return b;
}
__device__ __forceinline__ void xcd_barrier_complete(unsigned* bar, unsigned x, unsigned& nloc, unsigned& nx) {
    const unsigned G = gridDim.x * gridDim.y * gridDim.z;
    unsigned sum, cnt, mine, sp = 0u;
    for (;;) {
        sum = 0u; cnt = 0u; mine = 0u;
#pragma unroll
        for (unsigned j = 0; j < 16; ++j) { const unsigned c = xb_ld(&bar[XB_XCNT(j)]); sum += c; cnt += (c > 0u) ? 1u : 0u; mine = (j == x) ? c : mine; }
        if (sum == G) break;
        __builtin_amdgcn_s_sleep(1);
        if ((++sp & 255u) == 0u) { if (xb_ld(&bar[XB_TMO])) break; if (sp > XB_SPIN_CAP) { atomicAdd(&bar[XB_TMO], 1u); break; } }
    }
    nloc = mine > 0u ? mine : 1u; nx = cnt > 0u ? cnt : 1u;
}

__device__ __forceinline__ void xcd_barrier(const XcdBarrier& b) {
    asm volatile("s_waitcnt vmcnt(0)" ::: "memory");
    __syncthreads();
    if (threadIdx.x == 0) {
        unsigned* bar = b.bar;
        __builtin_amdgcn_s_waitcnt(0);
        unsigned nloc = b.st[0], nx = b.st[1];
        if (nloc == 0u) { xcd_barrier_complete(bar, b.x, nloc, nx); b.st[0] = nloc; b.st[1] = nx; }
        const unsigned old = xb_add(&bar[XB_XSUB(b.x)], 1u);
        const unsigned gen = old / nloc;
        if (old + 1u == (gen + 1u) * nloc) {
            __builtin_amdgcn_fence(__ATOMIC_RELEASE, "agent");
            asm volatile("s_waitcnt vmcnt(0)" ::: "memory");
            const unsigned og = xb_add(&bar[XB_TOP], 1u);
            const unsigned tg = og / nx;
            if (og + 1u == (tg + 1u) * nx) xb_add(&bar[XB_TOPGEN], 1u);
            else XB_SPIN(xb_ld(&bar[XB_TOPGEN]) == tg, bar);
            __builtin_amdgcn_fence(__ATOMIC_ACQUIRE, "agent");
            xb_add(&bar[XB_XGEN(b.x)], 1u);
            asm volatile("s_waitcnt vmcnt(0)" ::: "memory");
        } else {
            XB_SPIN(xb_ld(&bar[XB_XGEN(b.x)]) == gen, bar);
            __builtin_amdgcn_fence(__ATOMIC_ACQUIRE, "agent");
            asm volatile("s_waitcnt vmcnt(0)" ::: "memory");
        }
    }
    __syncthreads();
}

constexpr int NWAVES = 8;
constexpr int D = 1024, NB = 16, SEQ = 2048, CTXL = 256, TT = SEQ + CTXL;
constexpr int ML = NB * SEQ, MC = NB * CTXL, MA = ML + MC;
constexpr float EPS = 1e-6f;
constexpr int S5W = 512, S5G = 32, S5H = 16, S5P = 64;
constexpr int NH = 8, NOPE = 64, ROPE = 32, QK = 96, VD = 64, QRANK = 256, KVRANK = 128;
constexpr int EV_IN = 928, EV_INP = 1024, NQKV = 1792, KQKV = 384;
constexpr int GH = 4, GDK = 128, GDV = 256, GKEY = 512, GVAL = 1024, GRANK = 16;
constexpr int OD_IN = 3104, OD_INP = 3328, Z1LD = 3072;
constexpr int FFN = 2816, NE = 8, FE = 3584;
constexpr int MOE_SLICE = 64;
constexpr int MOE_MAXT = 264;

constexpr size_t MiB = 1u << 20;
constexpr size_t WS_CTL = 0, CTL_ZERO_BYTES = 1 * MiB;
constexpr size_t WS_MODV = 1 * MiB;
constexpr size_t WS_TOK = 2 * MiB;
constexpr size_t WS_W_IN0 = 4 * MiB, WS_W_QKV = 6 * MiB, WS_W_GLU = 7 * MiB + 512 * 1024, WS_W_OUT0 = 8 * MiB, WS_W_GU = 10 * MiB, WS_W_DN = 21 * MiB,
                 WS_W_IN1 = 27 * MiB, WS_W_OUT1 = 34 * MiB, WS_W_MGU = 36 * MiB, WS_W_MDN = 148 * MiB, WS_HC = 204 * MiB, WS_POOL = 220 * MiB;
constexpr size_t WS_XL = 220 * MiB, WS_Q = 220 * MiB, WS_Z0 = 292 * MiB, WS_YL = 292 * MiB, WS_KV = 364 * MiB, WS_AG = 436 * MiB, WS_AO = 472 * MiB, WS_QA = 544 * MiB, WS_KR = 571 * MiB;
constexpr size_t WS_ACT = 292 * MiB, WS_FL = 490 * MiB;
constexpr size_t WS_Z1 = 292 * MiB, WS_ZG = 508 * MiB, WS_OF = 220 * MiB, WS_OB = 511 * MiB, WS_YL1 = 511 * MiB;
constexpr size_t WS_XLM = 220 * MiB, WS_XG = 284 * MiB, WS_ACTM = 416 * MiB;
constexpr size_t WS_END = 588 * MiB;
static_assert(WS_KR + (size_t)MA * 32 * 2 <= WS_END && WS_FL + (size_t)MA * D * 2 <= WS_END && WS_OB + (size_t)ML * D * 2 <= WS_END && WS_ZG + (size_t)MA * 32 * 2 <= WS_OB, "ws map");
static_assert(WS_Z1 + (size_t)MA * Z1LD * 2 <= WS_ZG && WS_XG + (size_t)MOE_MAXT * 256 * D * 2 <= WS_ACTM && WS_ACTM + (size_t)MOE_SLICE * 256 * FE * 2 <= WS_END, "ws map 2");
static_assert(WS_ACT + (size_t)MA * FFN * 2 <= WS_FL && WS_W_MGU + (size_t)NE * 2 * FE * D * 2 <= WS_W_MDN && WS_W_MDN + (size_t)NE * D * FE * 2 <= WS_HC, "ws map 3");
static_assert(WS_W_GU + (size_t)2 * FFN * D * 2 <= WS_W_DN && WS_W_DN + (size_t)D * FFN * 2 <= WS_W_IN1 && WS_W_IN1 + (size_t)OD_INP * D * 2 <= WS_W_OUT1, "ws map 4");

constexpr int CW_TMO = 0, CW_CODE = 1, CW_CNT = 64, CW_BAR = 4096;

constexpr int RING_OFF = 0, RING_BYTES = 131072;
constexpr int LDSCTL_OFF = RING_BYTES, MISC_OFF = LDSCTL_OFF + 320;
constexpr int LDS_BYTES = 147456;

struct Args { const float* in[35]; float* out; unsigned char* ws; int ph_lo, ph_hi; };
struct Frame { LAS unsigned char* lds; volatile LAS unsigned* MISC; gu32* ctl; int tid, lane, wave, G, gw, ngw; };

__device__ __forceinline__ float wave_sum(float v) {
#pragma unroll
    for (int o = 1; o < 64; o <<= 1) v += __shfl_xor(v, o);
    return v;
}
__device__ __forceinline__ float bf_lo(unsigned u) { return __uint_as_float(u << 16); }
__device__ __forceinline__ float bf_hi(unsigned u) { return __uint_as_float(u & 0xffff0000u); }
__device__ __forceinline__ float bf1(bf16 u) { return __uint_as_float(((unsigned)u) << 16); }
typedef unsigned v2u __attribute__((ext_vector_type(2)));

__device__ __forceinline__ void ld_row_f32(const float* p, int lane, f32x4 (&v)[4]) {
    const GAS f32x4* q = (const GAS f32x4*)p + lane;
#pragma unroll
    for (int j = 0; j < 4; ++j) v[j] = q[64 * j];
}
__device__ __forceinline__ void st_row_f32(float* p, int lane, const f32x4 (&v)[4]) {
    GAS f32x4* q = (GAS f32x4*)p + lane;
#pragma unroll
    for (int j = 0; j < 4; ++j) q[64 * j] = v[j];
}
__device__ __forceinline__ void ld_row_bf16(const bf16* p, int lane, f32x4 (&v)[4]) {
    const GAS v2u* q = (const GAS v2u*)p + lane;
#pragma unroll
    for (int j = 0; j < 4; ++j) { const v2u w = q[64 * j]; v[j] = (f32x4){bf_lo(w.x), bf_hi(w.x), bf_lo(w.y), bf_hi(w.y)}; }
}
__device__ __forceinline__ void st_row_bf16(bf16* p, int lane, const f32x4 (&v)[4]) {
    GAS v2u* q = (GAS v2u*)p + lane;
#pragma unroll
    for (int j = 0; j < 4; ++j) { v2u w; w.x = pk2(v[j].x, v[j].y); w.y = pk2(v[j].z, v[j].w); q[64 * j] = w; }
}
__device__ __forceinline__ float row_rs(const f32x4 (&v)[4]) {
    float s = 0.f;
#pragma unroll
    for (int j = 0; j < 4; ++j) s += (v[j].x * v[j].x + v[j].y * v[j].y) + (v[j].z * v[j].z + v[j].w * v[j].w);
    return rsqrtf(wave_sum(s) * (1.0f / D) + EPS);
}
__device__ __forceinline__ void norm_mod(f32x4 (&v)[4], const float* gam, const float* sh, const float* sc, int lane) {
    const float rs = row_rs(v); f32x4 g[4], a[4], b[4]; ld_row_f32(gam, lane, g); ld_row_f32(sh, lane, a); ld_row_f32(sc, lane, b);
#pragma unroll
    for (int j = 0; j < 4; ++j) v[j] = (v[j] * rs) * g[j] * (1.0f + b[j]) + a[j];
}
__device__ __forceinline__ void gated_add(f32x4 (&h)[4], const f32x4 (&y)[4], const float* gam, const float* gate, int lane) {
    const float rs = row_rs(y); f32x4 g[4], t[4]; ld_row_f32(gam, lane, g); ld_row_f32(gate, lane, t);
#pragma unroll
    for (int j = 0; j < 4; ++j) h[j] = h[j] + t[j] * ((y[j] * rs) * g[j]);
}

__device__ __forceinline__ void cvt_item(const float* W, int K, int N, bf16* WT, int ldk, int kcol0, int row_off, int mode, const float* gain, float scale, int nscale,
                                         LAS float* scr, int item, int lane) {
    const int nblk = N / 32, kb = item / nblk, nb = item % nblk, k0 = 64 * kb, n0 = 32 * nb;
#pragma unroll 8
    for (int i = 0; i < 32; ++i) { const int kk = 2 * i + (lane >> 5); scr[kk * 33 + (lane & 31)] = W[(size_t)(k0 + kk) * N + n0 + (lane & 31)]; }
    LDS_WAIT(); asm volatile("" ::: "memory");
    const int c = lane & 7;
    float gn[8];
#pragma unroll
    for (int q = 0; q < 8; ++q) gn[q] = (gain ? gain[k0 + 8 * c + q] : 1.0f) * ((n0 < nscale) ? scale : 1.0f);
    const int drow0 = (mode == 0) ? n0 : ((n0 >> 7) * 256 + (n0 & 127) + (mode == 2 ? 128 : 0));
#pragma unroll
    for (int j = 0; j < 4; ++j) { const int n = (lane >> 3) + 8 * j; const LAS float* s = scr + (8 * c) * 33 + n;
        v4u o; o.x = pk2(s[0 * 33] * gn[0], s[1 * 33] * gn[1]); o.y = pk2(s[2 * 33] * gn[2], s[3 * 33] * gn[3]); o.z = pk2(s[4 * 33] * gn[4], s[5 * 33] * gn[5]); o.w = pk2(s[6 * 33] * gn[6], s[7 * 33] * gn[7]);
        *(GAS v4u*)(WT + (size_t)(row_off + drow0 + n) * ldk + kcol0 + k0 + 8 * c) = o; }
    LDS_WAIT(); asm volatile("" ::: "memory");
}
__device__ __forceinline__ void p0_prologue(Frame& F, const Args& A) {
    LAS float* scr = (LAS float*)(F.lds + RING_OFF + F.wave * 16384);
    unsigned char* ws = A.ws;
    constexpr int I_IN0 = (D / 64) * (EV_IN / 32), I_UQ = (QRANK / 64) * (768 / 32), I_UKV = (KVRANK / 64) * (1024 / 32), I_GLU = (512 / 64) * (512 / 32), I_OUT = (D / 64) * (D / 32);
    constexpr int I_FG = (D / 64) * (FFN / 32), I_FD = (FFN / 64) * (D / 32), I_IN1 = (D / 64) * (OD_IN / 32), I_MG1 = (D / 64) * (FE / 32), I_MD1 = (FE / 64) * (D / 32);
    constexpr int NITEMS = I_IN0 + I_UQ + I_UKV + I_GLU + I_OUT + 2 * I_FG + I_FD + I_IN1 + I_OUT + NE * (2 * I_MG1 + I_MD1);
    for (int it = F.gw; it < NITEMS; it += F.ngw) {
        int r = it;
        if (r < I_IN0) { cvt_item(A.in[7], D, EV_IN, (bf16*)(ws + WS_W_IN0), D, 0, 0, 0, nullptr, 1.f, 0, scr, r, F.lane); continue; } r -= I_IN0;
        if (r < I_UQ) { cvt_item(A.in[19], QRANK, 768, (bf16*)(ws + WS_W_QKV), KQKV, 0, 0, 0, A.in[18], 1.f, 0, scr, r, F.lane); continue; } r -= I_UQ;
        if (r < I_UKV) { cvt_item(A.in[21], KVRANK, 1024, (bf16*)(ws + WS_W_QKV), KQKV, QRANK, 768, 0, A.in[20], 1.f, 0, scr, r, F.lane); continue; } r -= I_UKV;
        if (r < I_GLU) { cvt_item(A.in[16], 512, 512, (bf16*)(ws + WS_W_GLU), 512, 0, 0, 0, nullptr, 1.f, 0, scr, r, F.lane); continue; } r -= I_GLU;
        if (r < I_OUT) { cvt_item(A.in[22], D, D, (bf16*)(ws + WS_W_OUT0), D, 0, 0, 0, nullptr, 1.f, 0, scr, r, F.lane); continue; } r -= I_OUT;
        if (r < I_FG) { cvt_item(A.in[23], D, FFN, (bf16*)(ws + WS_W_GU), D, 0, 0, 1, nullptr, 1.f, 0, scr, r, F.lane); continue; } r -= I_FG;
        if (r < I_FG) { cvt_item(A.in[24], D, FFN, (bf16*)(ws + WS_W_GU), D, 0, 0, 2, nullptr, 1.f, 0, scr, r, F.lane); continue; } r -= I_FG;
        if (r < I_FD) { cvt_item(A.in[25], FFN, D, (bf16*)(ws + WS_W_DN), FFN, 0, 0, 0, nullptr, 1.f, 0, scr, r, F.lane); continue; } r -= I_FD;
        if (r < I_IN1) { cvt_item(A.in[26], D, OD_IN, (bf16*)(ws + WS_W_IN1), D, 0, 0, 0, nullptr, 0.08838834764831845f, GKEY, scr, r, F.lane); continue; } r -= I_IN1;
        if (r < I_OUT) { cvt_item(A.in[30], D, D, (bf16*)(ws + WS_W_OUT1), D, 0, 0, 0, nullptr, 1.f, 0, scr, r, F.lane); continue; } r -= I_OUT;
        if (r < NE * I_MG1) { const int e = r / I_MG1; cvt_item(A.in[32] + (size_t)e * D * FE, D, FE, (bf16*)(ws + WS_W_MGU) + (size_t)e * 2 * FE * D, D, 0, 0, 1, nullptr, 1.f, 0, scr, r % I_MG1, F.lane); continue; } r -= NE * I_MG1;
        if (r < NE * I_MG1) { const int e = r / I_MG1; cvt_item(A.in[33] + (size_t)e * D * FE, D, FE, (bf16*)(ws + WS_W_MGU) + (size_t)e * 2 * FE * D, D, 0, 0, 2, nullptr, 1.f, 0, scr, r % I_MG1, F.lane); continue; } r -= NE * I_MG1;
        { const int e = r / I_MD1; cvt_item(A.in[34] + (size_t)e * FE * D, FE, D, (bf16*)(ws + WS_W_MDN) + (size_t)e * D * FE, FE, 0, 0, 0, nullptr, 1.f, 0, scr, r % I_MD1, F.lane); }
    }
    __syncthreads();
    LAS float* act = (LAS float*)(F.lds);
    LAS float* red = (LAS float*)(F.lds + 17 * 1024 * 4);
    float* modv = (float*)(ws + WS_MODV);
    bool have_act = false;
    for (int u = blockIdx.x; u < 2 * 96; u += F.G) {
        if (!have_act) {
            for (int i = F.tid; i < 17 * 1024; i += NWAVES * 64) { const float x = (i < 16 * 1024) ? A.in[1][i] : A.in[3][i - 16 * 1024]; act[i] = x / (1.0f + __expf(-x)); }
            have_act = true;
        }
        __syncthreads();
        const int layer = u / 96, c0 = (u % 96) * 64;
        const float* mw = A.in[4] + (size_t)layer * D * 6144 + c0 + F.lane;
        float acc[17];
#pragma unroll
        for (int r = 0; r < 17; ++r) acc[r] = 0.f;
        for (int k = F.wave * 128; k < F.wave * 128 + 128; ++k) { const float w = mw[(size_t)k * 6144];
#pragma unroll
            for (int r = 0; r < 17; ++r) acc[r] += act[r * 1024 + k] * w; }
#pragma unroll
        for (int r = 0; r < 17; ++r) red[(F.wave * 17 + r) * 64 + F.lane] = acc[r];
        __syncthreads();
        for (int i = F.tid; i < 17 * 64; i += NWAVES * 64) { const int r = i >> 6, l = i & 63; float s = A.in[5][layer * 6144 + c0 + l];
#pragma unroll
            for (int w = 0; w < 8; ++w) s += red[(w * 17 + r) * 64 + l];
            modv[(size_t)(layer * 17 + r) * 6144 + c0 + l] = s; }
    }
    __syncthreads();
}

__device__ __forceinline__ void thin_t1(Frame& F, const Args& A) {
    const float* modv = (const float*)(A.ws + WS_MODV); bf16* XL = (bf16*)(A.ws + WS_XL); const float* gam = A.in[6];
    for (int r = F.gw; r < MA; r += F.ngw) {
        const bool lat = r < ML; const float* src = lat ? A.in[0] + (size_t)r * D : A.in[2] + (size_t)(r - ML) * D; const int bs = lat ? r / SEQ : 16;
        const float* mod = modv + (size_t)bs * 6144;
        f32x4 v[4]; ld_row_f32(src, F.lane, v); norm_mod(v, gam, mod, mod + D, F.lane); st_row_bf16(XL + (size_t)r * D, F.lane, v);
    }
}
__device__ __forceinline__ void thin_t2(Frame& F, const Args& A) {
    const float* modv = (const float*)(A.ws + WS_MODV); bf16* XL = (bf16*)(A.ws + WS_XL); const bf16* YL = (const bf16*)(A.ws + WS_YL); float* HC = (float*)(A.ws + WS_HC); const float* gam = A.in[6];
    for (int r = F.gw; r < MA; r += F.ngw) {
        const bool lat = r < ML; const float* src = lat ? A.in[0] + (size_t)r * D : A.in[2] + (size_t)(r - ML) * D; const int bs = lat ? r / SEQ : 16;
        float* dst = lat ? A.out + (size_t)r * D : HC + (size_t)(r - ML) * D;
        const float* mod = modv + (size_t)bs * 6144;
        f32x4 h[4], y[4]; ld_row_f32(src, F.lane, h); ld_row_bf16(YL + (size_t)r * D, F.lane, y);
        gated_add(h, y, gam + 1 * D, mod + 2 * D, F.lane); st_row_f32(dst, F.lane, h);
        norm_mod(h, gam + 2 * D, mod + 3 * D, mod + 4 * D, F.lane); st_row_bf16(XL + (size_t)r * D, F.lane, h);
    }
}
__device__ __forceinline__ void thin_t3(Frame& F, const Args& A) {
    const float* modv = (const float*)(A.ws + WS_MODV); bf16* XL = (bf16*)(A.ws + WS_XL); const bf16* FL = (const bf16*)(A.ws + WS_FL); const float* HC = (const float*)(A.ws + WS_HC); const float* gam = A.in[6];
    for (int r = F.gw; r < MA; r += F.ngw) {
        const bool lat = r < ML; const float* src = lat ? A.out + (size_t)r * D : HC + (size_t)(r - ML) * D; const int bs = lat ? r / SEQ : 16;
        const float* mod0 = modv + (size_t)bs * 6144; const float* mod1 = modv + (size_t)(17 + bs) * 6144;
        f32x4 h[4], y[4]; ld_row_f32(src, F.lane, h); ld_row_bf16(FL + (size_t)r * D, F.lane, y);
        gated_add(h, y, gam + 3 * D, mod0 + 5 * D, F.lane); if (lat) st_row_f32(A.out + (size_t)r * D, F.lane, h);
        norm_mod(h, gam + 4 * D, mod1, mod1 + D, F.lane); st_row_bf16(XL + (size_t)r * D, F.lane, h);
    }
}
__device__ __forceinline__ void thin_t4(Frame& F, const Args& A) {
    const float* modv = (const float*)(A.ws + WS_MODV); bf16* XL = (bf16*)(A.ws + WS_XLM); const bf16* YL = (const bf16*)(A.ws + WS_YL1); const float* gam = A.in[6] + 4 * D;
    const float* router = A.in[31]; unsigned* tok = (unsigned*)(A.ws + WS_TOK);
    for (int r = F.gw; r < ML; r += F.ngw) {
        const int bs = r / SEQ; const float* mod1 = modv + (size_t)(17 + bs) * 6144;
        f32x4 h[4], y[4]; ld_row_f32(A.out + (size_t)r * D, F.lane, h); ld_row_bf16(YL + (size_t)r * D, F.lane, y);
        gated_add(h, y, gam + 1 * D, mod1 + 2 * D, F.lane); st_row_f32(A.out + (size_t)r * D, F.lane, h);
        norm_mod(h, gam + 2 * D, mod1 + 3 * D, mod1 + 4 * D, F.lane); st_row_bf16(XL + (size_t)r * D, F.lane, h);
        float lg[8];
#pragma unroll
        for (int e = 0; e < 8; ++e) lg[e] = 0.f;
#pragma unroll
        for (int j = 0; j < 4; ++j)
#pragma unroll
            for (int i = 0; i < 4; ++i) { const int c = 256 * j + 4 * F.lane + i; const float xv = h[j][i];
                const f32x4 r0 = *(const GAS f32x4*)(router + (size_t)c * 8), r1 = *(const GAS f32x4*)(router + (size_t)c * 8 + 4);
                lg[0] += xv * r0.x; lg[1] += xv * r0.y; lg[2] += xv * r0.z; lg[3] += xv * r0.w; lg[4] += xv * r1.x; lg[5] += xv * r1.y; lg[6] += xv * r1.z; lg[7] += xv * r1.w; }
#pragma unroll
        for (int e = 0; e < 8; ++e) lg[e] = wave_sum(lg[e]);
        int e0 = 0; float v0 = lg[0];
#pragma unroll
        for (int e = 1; e < 8; ++e) if (lg[e] > v0) { v0 = lg[e]; e0 = e; }
        int e1 = -1; float v1 = -3.0e38f;
#pragma unroll
        for (int e = 0; e < 8; ++e) if (e != e0 && lg[e] > v1) { v1 = lg[e]; e1 = e; }
        const float w1 = 1.0f / (1.0f + __expf(v0 - v1)), w0 = 1.0f - w1;
        if (F.lane == 0) {
            const unsigned i0 = __hip_atomic_fetch_add((unsigned*)(F.ctl + CW_CNT + e0), 1u, __ATOMIC_RELAXED, __HIP_MEMORY_SCOPE_AGENT);
            const unsigned i1 = __hip_atomic_fetch_add((unsigned*)(F.ctl + CW_CNT + e1), 1u, __ATOMIC_RELAXED, __HIP_MEMORY_SCOPE_AGENT);
            unsigned* t = tok + (size_t)r * 8; t[0] = (unsigned)e0; t[1] = (unsigned)e1; t[2] = i0; t[3] = i1; t[4] = __float_as_uint(w0); t[5] = __float_as_uint(w1);
        }
    }
}
__device__ __forceinline__ void moe_tile_starts(Frame& F, int (&ts)[9]) {
    ts[0] = 0;
#pragma unroll
    for (int e = 0; e < 8; ++e) { const unsigned c = __hip_atomic_load((unsigned*)(F.ctl + CW_CNT + e), __ATOMIC_RELAXED, __HIP_MEMORY_SCOPE_AGENT); ts[e + 1] = ts[e] + (int)((c + 255u) >> 8); }
#pragma unroll
    for (int e = 0; e < 9; ++e) ts[e] = __builtin_amdgcn_readfirstlane(ts[e]);
}
__device__ __forceinline__ void moe_gather(Frame& F, const Args& A) {
    int ts[9]; moe_tile_starts(F, ts);
    const bf16* XL = (const bf16*)(A.ws + WS_XLM); bf16* XG = (bf16*)(A.ws + WS_XG); unsigned* tok = (unsigned*)(A.ws + WS_TOK);
    for (int r = F.gw; r < ML; r += F.ngw) {
        const unsigned* t = tok + (size_t)r * 8; const int e0 = (int)t[0], e1 = (int)t[1]; const unsigned i0 = t[2], i1 = t[3];
        int s0 = 0, s1 = 0;
#pragma unroll
        for (int e = 0; e < 8; ++e) { s0 = (e0 == e) ? ts[e] : s0; s1 = (e1 == e) ? ts[e] : s1; }
        const unsigned p0 = (unsigned)s0 * 256u + i0, p1 = (unsigned)s1 * 256u + i1;
        if (F.lane == 0) { tok[(size_t)r * 8 + 6] = p0; tok[(size_t)r * 8 + 7] = p1; }
        const GAS v4u* src = (const GAS v4u*)(XL + (size_t)r * D) + F.lane; const v4u a = src[0], b = src[64];
        GAS v4u* d0 = (GAS v4u*)(XG + (size_t)p0 * D) + F.lane; GAS v4u* d1 = (GAS v4u*)(XG + (size_t)p1 * D) + F.lane;
        d0[0] = a; d0[64] = b; d1[0] = a; d1[64] = b;
    }
}
__device__ __forceinline__ void thin_t5(Frame& F, const Args& A) {
    const float* modv = (const float*)(A.ws + WS_MODV); const bf16* Y = (const bf16*)(A.ws + WS_XG); const float* gam = A.in[6] + 7 * D; const unsigned* tok = (const unsigned*)(A.ws + WS_TOK);
    for (int r = F.gw; r < ML; r += F.ngw) {
        const int bs = r / SEQ; const float* mod1 = modv + (size_t)(17 + bs) * 6144;
        const unsigned* t = tok + (size_t)r * 8; const float w0 = __uint_as_float(t[4]), w1 = __uint_as_float(t[5]); const unsigned p0 = t[6], p1 = t[7];
        f32x4 h[4], y0[4], y1[4]; ld_row_f32(A.out + (size_t)r * D, F.lane, h); ld_row_bf16(Y + (size_t)p0 * D, F.lane, y0); ld_row_bf16(Y + (size_t)p1 * D, F.lane, y1);
#pragma unroll
        for (int j = 0; j < 4; ++j) y0[j] = y0[j] * w0 + y1[j] * w1;
        gated_add(h, y0, gam, mod1 + 5 * D, F.lane); st_row_f32(A.out + (size_t)r * D, F.lane, h);
    }
}

__device__ __forceinline__ float rope_inv(int f) { return exp2f(-(float)f * (13.287712379549449f / 8.0f)); }
__device__ __forceinline__ void prep_qa(Frame& F, const Args& A) {
    const bf16* Z0 = (const bf16*)(A.ws + WS_Z0); bf16* QA = (bf16*)(A.ws + WS_QA); bf16* KR = (bf16*)(A.ws + WS_KR);
    for (int r = F.gw; r < MA; r += F.ngw) {
        const bf16* z = Z0 + (size_t)r * EV_INP;
        const v2u cq = *((const GAS v2u*)(z + 512) + F.lane); const unsigned ck = *((const GAS unsigned*)(z + 768) + F.lane);
        const float q0 = bf_lo(cq.x), q1 = bf_hi(cq.x), q2 = bf_lo(cq.y), q3 = bf_hi(cq.y), k0 = bf_lo(ck), k1 = bf_hi(ck);
        const float rq = rsqrtf(wave_sum((q0 * q0 + q1 * q1) + (q2 * q2 + q3 * q3)) * (1.0f / QRANK) + EPS);
        const float rk = rsqrtf(wave_sum(k0 * k0 + k1 * k1) * (1.0f / KVRANK) + EPS);
        v2u oq; oq.x = pk2(q0 * rq, q1 * rq); oq.y = pk2(q2 * rq, q3 * rq);
        *((GAS v2u*)(QA + (size_t)r * KQKV) + F.lane) = oq; *((GAS unsigned*)(QA + (size_t)r * KQKV + QRANK) + F.lane) = pk2(k0 * rk, k1 * rk);
        const int l = F.lane & 31; float v = bf1(z[896 + l]); const float pv = __shfl_xor(v, 8);
        if (r < ML) { const int t = r % SEQ; const float pos = (l < 16) ? (float)(t / 64) : (float)(t % 64); float sn, cs; sincosf(pos * rope_inv(l & 7), &sn, &cs);
            v = (l & 8) ? (v * cs + pv * sn) : (v * cs - pv * sn); }
        if (F.lane < 32) KR[(size_t)r * 32 + l] = (bf16)f2bf(v);
    }
}
__device__ __forceinline__ void rope_q(Frame& F, const Args& A) {
    bf16* Q = (bf16*)(A.ws + WS_Q);
    for (int r = F.gw; r < ML; r += F.ngw) {
        const int t = r % SEQ, hh = F.lane >> 3, sub = F.lane & 7; bf16* p = Q + (size_t)r * 768 + hh * QK + NOPE + sub;
        const float inv = rope_inv(sub); float sr, cr, sc, cc; sincosf((float)(t / 64) * inv, &sr, &cr); sincosf((float)(t % 64) * inv, &sc, &cc);
        const float x0 = bf1(p[0]), x1 = bf1(p[8]), x2 = bf1(p[16]), x3 = bf1(p[24]);
        p[0] = (bf16)f2bf(x0 * cr - x1 * sr); p[8] = (bf16)f2bf(x1 * cr + x0 * sr); p[16] = (bf16)f2bf(x2 * cc - x3 * sc); p[24] = (bf16)f2bf(x3 * cc + x2 * sc);
    }
}
__device__ __forceinline__ int scan_row(int b, int dir, int tau) {
    if (tau < CTXL) return ML + b * CTXL + (dir ? CTXL - 1 - tau : tau);
    const int t = tau - CTXL; return b * SEQ + (dir ? SEQ - 1 - t : t);
}
__device__ __forceinline__ float gelu_tanh(float x) { const float u = 0.7978845608028654f * (x + 0.044715f * x * x * x); const float e = __expf(2.0f * u); const float th = 1.0f - 2.0f / (e + 1.0f); return 0.5f * x * (1.0f + th); }
__device__ __forceinline__ void s5_naive(Frame& F, const Args& A) {
    if (F.wave < 2) {
        const bf16* Z0 = (const bf16*)(A.ws + WS_Z0); float* Y = (float*)(A.ws + WS_AO); bf16* AG = (bf16*)(A.ws + WS_AG);
        LAS float* ybuf = (LAS float*)(F.lds + F.wave * 8192);
        const int p = F.lane;
        for (int u = blockIdx.x + F.G * F.wave; u < NB * S5G; u += 2 * F.G) {
            const int b = u / S5G, g = u % S5G;
            for (int dir = 0; dir < 2; ++dir) {
                const int ig = dir * S5G + g, idx = ig * S5P + p;
                const float lr = A.in[8][idx], li = A.in[9][idx], dt = expf(A.in[10][ig]), mag = expf(lr * dt);
                const float ar = mag * cosf(li * dt), ai = mag * sinf(li * dt), den = lr * lr + li * li, nr = ar - 1.0f;
                const float cr = (nr * lr + ai * li) / den, ci = (ai * lr - nr * li) / den;
                float bre[16], bim[16], cre[16], cim[16];
#pragma unroll
                for (int h = 0; h < 16; ++h) { const float br = A.in[11][(size_t)idx * 16 + h], bi = A.in[12][(size_t)idx * 16 + h]; bre[h] = cr * br - ci * bi; bim[h] = cr * bi + ci * br;
                    cre[h] = A.in[13][(size_t)(ig * 16 + h) * S5P + p]; cim[h] = A.in[14][(size_t)(ig * 16 + h) * S5P + p]; }
                float sr = 0.f, si = 0.f;
                for (int tau0 = 0; tau0 < TT; tau0 += 64) {
                    const int row = scan_row(b, dir, tau0 + F.lane);
                    const GAS v4u* up = (const GAS v4u*)(Z0 + (size_t)row * EV_INP + g * 16); const v4u u0 = up[0], u1 = up[1];
                    unsigned pk[8] = {u0.x, u0.y, u0.z, u0.w, u1.x, u1.y, u1.z, u1.w};
                    for (int j = 0; j < 64; ++j) {
                        float uu[16];
#pragma unroll
                        for (int i = 0; i < 8; ++i) { const unsigned w = (unsigned)__builtin_amdgcn_readlane((int)pk[i], j); uu[2 * i] = bf_lo(w); uu[2 * i + 1] = bf_hi(w); }
                        float bur = 0.f, bui = 0.f;
#pragma unroll
                        for (int h = 0; h < 16; ++h) { bur += bre[h] * uu[h]; bui += bim[h] * uu[h]; }
                        const float nsr = ar * sr - ai * si + bur, nsi = ar * si + ai * sr + bui; sr = nsr; si = nsi;
                        float part[16];
#pragma unroll
                        for (int h = 0; h < 16; ++h) part[h] = cre[h] * sr - cim[h] * si;
                        const bool b5 = (F.lane & 32) != 0, b4 = (F.lane & 16) != 0, b3 = (F.lane & 8) != 0, b2 = (F.lane & 4) != 0;
                        float v8[8], v4[4], v2[2];
#pragma unroll
                        for (int i = 0; i < 8; ++i) { const float keep = b5 ? part[i + 8] : part[i], send = b5 ? part[i] : part[i + 8]; v8[i] = keep + __shfl_xor(send, 32); }
#pragma unroll
                        for (int i = 0; i < 4; ++i) { const float keep = b4 ? v8[i + 4] : v8[i], send = b4 ? v8[i] : v8[i + 4]; v4[i] = keep + __shfl_xor(send, 16); }
#pragma unroll
                        for (int i = 0; i < 2; ++i) { const float keep = b3 ? v4[i + 2] : v4[i], send = b3 ? v4[i] : v4[i + 2]; v2[i] = keep + __shfl_xor(send, 8); }
                        float v1 = (b2 ? v2[1] : v2[0]) + __shfl_xor(b2 ? v2[0] : v2[1], 4);
                        v1 += __shfl_xor(v1, 1); v1 += __shfl_xor(v1, 2);
                        if ((F.lane & 3) == 0) ybuf[j * 16 + (F.lane >> 2)] = v1;
                    }
                    LDS_WAIT(); asm volatile("" ::: "memory");
                    f32x4 yv[4];
#pragma unroll
                    for (int q = 0; q < 4; ++q) yv[q] = *(const LAS f32x4*)(ybuf + F.lane * 16 + 4 * q);
                    LDS_WAIT(); asm volatile("" ::: "memory");
                    float* yrow = Y + (size_t)row * S5W + g * 16;
                    if (dir == 0) {
#pragma unroll
                        for (int q = 0; q < 4; ++q) *(GAS f32x4*)(yrow + 4 * q) = yv[q];
                    } else {
                        float o[16];
#pragma unroll
                        for (int q = 0; q < 4; ++q) { const f32x4 yf = *(const GAS f32x4*)(yrow + 4 * q); const f32x4 dd = *(const GAS f32x4*)(A.in[15] + g * 16 + 4 * q);
#pragma unroll
                            for (int i = 0; i < 4; ++i) { const int h = 4 * q + i; const unsigned w = pk[h >> 1]; const float uv = (h & 1) ? bf_hi(w) : bf_lo(w); o[h] = gelu_tanh(yf[i] + yv[q][i] + uv * dd[i]); } }
                        v4u w0, w1; w0.x = pk2(o[0], o[1]); w0.y = pk2(o[2], o[3]); w0.z = pk2(o[4], o[5]); w0.w = pk2(o[6], o[7]); w1.x = pk2(o[8], o[9]); w1.y = pk2(o[10], o[11]); w1.z = pk2(o[12], o[13]); w1.w = pk2(o[14], o[15]);
                        GAS v4u* ap = (GAS v4u*)(AG + (size_t)row * S5W + g * 16); ap[0] = w0; ap[1] = w1;
                    }
                }
                __threadfence();
            }
        }
    }
}
__device__ __forceinline__ void attn_naive(Frame& F, const Args& A) {
    const bf16* Q = (const bf16*)(A.ws + WS_Q); const bf16* KV = (const bf16*)(A.ws + WS_KV); const bf16* KR = (const bf16*)(A.ws + WS_KR); bf16* AO = (bf16*)(A.ws + WS_AO);
    LAS float* Ks = (LAS float*)(F.lds); LAS float* Vs = (LAS float*)(F.lds + 64 * QK * 4);
    const int half = F.tid & 1, qi = F.tid >> 1;
    for (int unit = blockIdx.x; unit < 1024 + 128; unit += F.G) {
        int b, h, qrow, nkeys;
        if (unit < 1024) { b = unit >> 6; h = (unit >> 3) & 7; qrow = b * SEQ + (unit & 7) * 256 + qi; nkeys = TT; }
        else { const int uu = unit - 1024; b = uu >> 3; h = uu & 7; qrow = ML + b * CTXL + qi; nkeys = CTXL; }
        float q[48];
        { const GAS v4u* qp = (const GAS v4u*)(Q + (size_t)qrow * 768 + h * QK + half * 48); const float sc = 0.10206207261596577f * 1.4426950408889634f;
#pragma unroll
          for (int i = 0; i < 6; ++i) { const v4u w = qp[i]; q[8 * i] = bf_lo(w.x) * sc; q[8 * i + 1] = bf_hi(w.x) * sc; q[8 * i + 2] = bf_lo(w.y) * sc; q[8 * i + 3] = bf_hi(w.y) * sc;
              q[8 * i + 4] = bf_lo(w.z) * sc; q[8 * i + 5] = bf_hi(w.z) * sc; q[8 * i + 6] = bf_lo(w.w) * sc; q[8 * i + 7] = bf_hi(w.w) * sc; } }
        float o[32];
#pragma unroll
        for (int d = 0; d < 32; ++d) o[d] = 0.f;
        float m = -3.0e38f, l = 0.f;
        for (int kt = 0; kt < nkeys; kt += 64) {
            __syncthreads();
            for (int c = F.tid; c < 64 * 40; c += NWAVES * 64) { const int j = c / 40, qq = c % 40; const int kk = kt + j; const int krow = (kk < CTXL) ? (ML + b * CTXL + kk) : (b * SEQ + kk - CTXL);
                const bf16* src; LAS float* dst;
                if (qq < 16) { src = KV + (size_t)krow * 1024 + h * 128 + 4 * qq; dst = Ks + j * QK + 4 * qq; }
                else if (qq < 24) { src = KR + (size_t)krow * 32 + 4 * (qq - 16); dst = Ks + j * QK + NOPE + 4 * (qq - 16); }
                else { src = KV + (size_t)krow * 1024 + h * 128 + 64 + 4 * (qq - 24); dst = Vs + j * VD + 4 * (qq - 24); }
                const v2u w = *(const GAS v2u*)src; *(LAS f32x4*)dst = (f32x4){bf_lo(w.x), bf_hi(w.x), bf_lo(w.y), bf_hi(w.y)}; }
            __syncthreads();
#pragma unroll 1
            for (int g8 = 0; g8 < 8; ++g8) {
                float s[8];
#pragma unroll
                for (int jj = 0; jj < 8; ++jj) { const LAS f32x4* kp = (const LAS f32x4*)(Ks + (g8 * 8 + jj) * QK + half * 48); float a = 0.f;
#pragma unroll
                    for (int d4 = 0; d4 < 12; ++d4) { const f32x4 kv = kp[d4]; a += q[4 * d4] * kv.x + q[4 * d4 + 1] * kv.y + q[4 * d4 + 2] * kv.z + q[4 * d4 + 3] * kv.w; }
                    s[jj] = a + __shfl_xor(a, 1); }
                float mx = s[0];
#pragma unroll
                for (int jj = 1; jj < 8; ++jj) mx = fmaxf(mx, s[jj]);
                const float mn = fmaxf(m, mx), corr = exp2f(m - mn); l *= corr;
#pragma unroll
                for (int d = 0; d < 32; ++d) o[d] *= corr;
#pragma unroll
                for (int jj = 0; jj < 8; ++jj) { const float pp = exp2f(s[jj] - mn); l += pp; const LAS f32x4* vp = (const LAS f32x4*)(Vs + (g8 * 8 + jj) * VD + half * 32);
#pragma unroll
                    for (int d4 = 0; d4 < 8; ++d4) { const f32x4 vv = vp[d4]; o[4 * d4] += pp * vv.x; o[4 * d4 + 1] += pp * vv.y; o[4 * d4 + 2] += pp * vv.z; o[4 * d4 + 3] += pp * vv.w; } }
                m = mn;
            }
        }
        { const float il = 1.0f / l; GAS v4u* op = (GAS v4u*)(AO + (size_t)qrow * D + S5W + h * VD + half * 32);
#pragma unroll
            for (int i = 0; i < 4; ++i) { v4u w; w.x = pk2(o[8 * i] * il, o[8 * i + 1] * il); w.y = pk2(o[8 * i + 2] * il, o[8 * i + 3] * il); w.z = pk2(o[8 * i + 4] * il, o[8 * i + 5] * il); w.w = pk2(o[8 * i + 6] * il, o[8 * i + 7] * il); op[i] = w; } }
    }
    __syncthreads();
}
__device__ __forceinline__ void gla_naive(Frame& F, const Args& A) {
    const bf16* Z1 = (const bf16*)(A.ws + WS_Z1); const bf16* ZG = (const bf16*)(A.ws + WS_ZG);
    LAS float* qs = (LAS float*)(F.lds); LAS float* ks = qs + 2048; LAS float* as = ks + 2048; LAS float* vs = as + 2048; LAS float* w2s = vs + 2048; LAS float* b2s = w2s + 2048; LAS float* ob = b2s + 128;
    const int kq = F.tid >> 7, vl = F.tid & 127, si = F.tid >> 5, sc = (F.tid & 31) * 4;
    for (int unit = blockIdx.x; unit < 256; unit += F.G) {
        const int b = unit >> 4, h = (unit >> 2) & 3, dir = (unit >> 1) & 1, vh = unit & 1;
        bf16* O = (bf16*)(A.ws + (dir ? WS_OB : WS_OF));
        __syncthreads();
        for (int i = F.tid; i < 2048; i += NWAVES * 64) { const int r = i >> 7, k = i & 127; w2s[i] = A.in[27][(size_t)(dir * GRANK + r) * GKEY + h * GDK + k]; }
        if (F.tid < 128) b2s[F.tid] = A.in[28][dir * GKEY + h * GDK + F.tid];
        float S[32];
#pragma unroll
        for (int i = 0; i < 32; ++i) S[i] = 0.f;
        __syncthreads();
        for (int tb = 0; tb < TT / 16; ++tb) {
            const int tau = tb * 16 + si; const int row = scan_row(b, dir, tau);
            { const bf16* zr = Z1 + (size_t)row * Z1LD;
              const v2u q4 = *(const GAS v2u*)(zr + h * GDK + sc), k4 = *(const GAS v2u*)(zr + GKEY + h * GDK + sc), v4 = *(const GAS v2u*)(zr + 2 * GKEY + h * GDV + vh * 128 + sc);
              const GAS v4u* gp = (const GAS v4u*)(ZG + (size_t)row * 32 + dir * GRANK); const v4u g0 = gp[0], g1 = gp[1];
              const float zg[16] = {bf_lo(g0.x), bf_hi(g0.x), bf_lo(g0.y), bf_hi(g0.y), bf_lo(g0.z), bf_hi(g0.z), bf_lo(g0.w), bf_hi(g0.w), bf_lo(g1.x), bf_hi(g1.x), bf_lo(g1.y), bf_hi(g1.y), bf_lo(g1.z), bf_hi(g1.z), bf_lo(g1.w), bf_hi(g1.w)};
              f32x4 av;
#pragma unroll
              for (int i = 0; i < 4; ++i) { float x = b2s[sc + i];
#pragma unroll 4
                  for (int r = 0; r < 16; ++r) x += zg[r] * w2s[r * 128 + sc + i];
                  const float ls = fminf(x, 0.f) - log1pf(__expf(-fabsf(x))); av[i] = __expf(ls * (1.0f / 16.0f)); }
              *(LAS f32x4*)(qs + si * 128 + sc) = (f32x4){bf_lo(q4.x), bf_hi(q4.x), bf_lo(q4.y), bf_hi(q4.y)};
              *(LAS f32x4*)(ks + si * 128 + sc) = (f32x4){bf_lo(k4.x), bf_hi(k4.x), bf_lo(k4.y), bf_hi(k4.y)};
              *(LAS f32x4*)(as + si * 128 + sc) = av;
              *(LAS f32x4*)(vs + si * 128 + sc) = (f32x4){bf_lo(v4.x), bf_hi(v4.x), bf_lo(v4.y), bf_hi(v4.y)}; }
            __syncthreads();
#pragma unroll 1
            for (int i = 0; i < 16; ++i) { const float v = vs[i * 128 + vl]; float acc = 0.f;
                const LAS f32x4* ap = (const LAS f32x4*)(as + i * 128 + 32 * kq); const LAS f32x4* kp = (const LAS f32x4*)(ks + i * 128 + 32 * kq); const LAS f32x4* qp = (const LAS f32x4*)(qs + i * 128 + 32 * kq);
#pragma unroll
                for (int k4 = 0; k4 < 8; ++k4) { const f32x4 a = ap[k4], kk = kp[k4], qq = qp[k4];
#pragma unroll
                    for (int c = 0; c < 4; ++c) { S[4 * k4 + c] = a[c] * S[4 * k4 + c] + kk[c] * v; acc += qq[c] * S[4 * k4 + c]; } }
                ob[(i * 4 + kq) * 128 + vl] = acc; }
            __syncthreads();
            if (tau >= CTXL) { f32x4 o = *(const LAS f32x4*)(ob + (si * 4 + 0) * 128 + sc);
#pragma unroll
                for (int q = 1; q < 4; ++q) o = o + *(const LAS f32x4*)(ob + (si * 4 + q) * 128 + sc);
                v2u w; w.x = pk2(o.x, o.y); w.y = pk2(o.z, o.w); *(GAS v2u*)(O + (size_t)row * D + h * GDV + vh * 128 + sc) = w; }
        }
    }
    __syncthreads();
}
__device__ __forceinline__ void gla_finish(Frame& F, const Args& A) {
    bf16* OF = (bf16*)(A.ws + WS_OF); const bf16* OB = (const bf16*)(A.ws + WS_OB); const bf16* Z1 = (const bf16*)(A.ws + WS_Z1); const float* hn = A.in[29];
    const f32x4 g = *(const GAS f32x4*)(hn + 4 * F.lane);
    for (int r = F.gw; r < ML; r += F.ngw) {
        f32x4 a[4], bb[4], rr[4]; ld_row_bf16(OF + (size_t)r * D, F.lane, a); ld_row_bf16(OB + (size_t)r * D, F.lane, bb);
        { const GAS v2u* q = (const GAS v2u*)(Z1 + (size_t)r * Z1LD + 2 * GKEY + GVAL) + F.lane;
#pragma unroll
          for (int j = 0; j < 4; ++j) { const v2u w = q[64 * j]; rr[j] = (f32x4){bf_lo(w.x), bf_hi(w.x), bf_lo(w.y), bf_hi(w.y)}; } }
#pragma unroll
        for (int j = 0; j < 4; ++j) { const f32x4 o = a[j] + bb[j]; const float rs = rsqrtf(wave_sum((o.x * o.x + o.y * o.y) + (o.z * o.z + o.w * o.w)) * (1.0f / GDV) + EPS);
#pragma unroll
            for (int i = 0; i < 4; ++i) { const float x = rr[j][i]; a[j][i] = o[i] * rs * g[i] * (x / (1.0f + __expf(-x))); } }
        st_row_bf16(OF + (size_t)r * D, F.lane, a);
    }
}

#ifndef MK_ONE_LAUNCH
#define MK_ONE_LAUNCH 1
#endif
constexpr int NPHASE = 29;
constexpr bool SP2 = true, ALIGN = true;

__global__ void __launch_bounds__(NWAVES * 64, 2) fwd_kernel(Args args) {
    extern __shared__ __attribute__((aligned(16))) unsigned char lds[];
    Frame F;
    F.lds = (LAS unsigned char*)lds;
    F.MISC = (volatile LAS unsigned*)(F.lds + MISC_OFF);
    F.tid = threadIdx.x; F.lane = F.tid & 63; F.wave = __builtin_amdgcn_readfirstlane(F.tid >> 6);
    F.G = gridDim.x; F.gw = blockIdx.x * NWAVES + F.wave; F.ngw = F.G * NWAVES;
    unsigned char* ws = args.ws;
    F.ctl = (gu32*)(ws + WS_CTL);
    for (int u = F.tid; u < (LDS_BYTES - LDSCTL_OFF) / 4; u += NWAVES * 64) ((LAS unsigned*)(F.lds + LDSCTL_OFF))[u] = 0u;
    __syncthreads();
    XcdBarrier bar; bar.bar = (unsigned*)(F.ctl + CW_BAR); bar.x = 0; bar.st = nullptr;
    if (MK_ONE_LAUNCH) bar = xcd_barrier_post((unsigned*)(F.ctl + CW_BAR), F.MISC + 8);
    const int lo = args.ph_lo, hi = args.ph_hi;
#define IN(k) (lo <= (k) && (k) < hi)
#define SEAM(k) do { if (MK_ONE_LAUNCH && IN(k) && IN((k) + 1)) xcd_barrier(bar); } while (0)
    const int bid = (int)blockIdx.x;

    if (IN(0)) {
#ifndef NO_P0
 p0_prologue(F, args);
#endif
 } SEAM(0);
    if (IN(1)) { thin_t1(F, args); } SEAM(1);
    if (IN(2)) { pg8::Gemm g{(const bf16*)(ws + WS_XL), (const bf16*)(ws + WS_W_IN0), MA, EV_INP, D}; pg8::StaticOrder S; S.init(MA, EV_INP, F.G, bid);
        pg8::EpiPlain E{(bf16*)(ws + WS_Z0), EV_INP, 0, 0};
        pg8::gemm_phase<pg8::EpiPlain, pg8::StaticOrder, ALIGN, SP2>(F.lds + RING_OFF, g, S, E); } SEAM(2);
    if (IN(3)) { prep_qa(F, args); } SEAM(3);
    if (IN(4)) { pg8::Gemm g{(const bf16*)(ws + WS_QA), (const bf16*)(ws + WS_W_QKV), MA, NQKV, KQKV}; pg8::StaticOrder S; S.init(MA, NQKV, F.G, bid);
        pg8::EpiSplit E{(bf16*)(ws + WS_Q), 768, (bf16*)(ws + WS_KV), 1024, 3, 0x7fffffff};
        pg8::gemm_phase<pg8::EpiSplit, pg8::StaticOrder, ALIGN, SP2>(F.lds + RING_OFF, g, S, E); } SEAM(4);
    if (IN(5)) { rope_q(F, args);
#ifndef NO_S5
 s5_naive(F, args);
#endif
 } SEAM(5);
    if (IN(6)) {
#ifndef NO_ATT
 attn_naive(F, args);
#endif

        pg8::Gemm g{(const bf16*)(ws + WS_AG), (const bf16*)(ws + WS_W_GLU), MA, S5W, S5W}; pg8::StaticOrder S; S.init(MA, S5W, F.G, bid);
        pg8::EpiGlu E{(const bf16*)(ws + WS_AG), S5W, args.in[17], (bf16*)(ws + WS_AO), D};
        pg8::gemm_phase<pg8::EpiGlu, pg8::StaticOrder, ALIGN, SP2>(F.lds + RING_OFF, g, S, E); } SEAM(6);
    if (IN(7)) { pg8::Gemm g{(const bf16*)(ws + WS_AO), (const bf16*)(ws + WS_W_OUT0), MA, D, D}; pg8::StaticOrder S; S.init(MA, D, F.G, bid);
        pg8::EpiPlain E{(bf16*)(ws + WS_YL), D, 0, 0};
        pg8::gemm_phase<pg8::EpiPlain, pg8::StaticOrder, ALIGN, SP2>(F.lds + RING_OFF, g, S, E); } SEAM(7);
    if (IN(8)) { thin_t2(F, args); } SEAM(8);
    if (IN(9)) { pg8::Gemm g{(const bf16*)(ws + WS_XL), (const bf16*)(ws + WS_W_GU), MA, 2 * FFN, D}; pg8::StaticOrder S; S.init(MA, 2 * FFN, F.G, bid);
        pg8::EpiSwiGlu E{(bf16*)(ws + WS_ACT), FFN, 0, 0};
        pg8::gemm_phase<pg8::EpiSwiGlu, pg8::StaticOrder, ALIGN, SP2>(F.lds + RING_OFF, g, S, E); } SEAM(9);
    if (IN(10)) { pg8::Gemm g{(const bf16*)(ws + WS_ACT), (const bf16*)(ws + WS_W_DN), MA, D, FFN}; pg8::StaticOrder S; S.init(MA, D, F.G, bid);
        pg8::EpiPlain E{(bf16*)(ws + WS_FL), D, 0, 0};
        pg8::gemm_phase<pg8::EpiPlain, pg8::StaticOrder, ALIGN, SP2>(F.lds + RING_OFF, g, S, E); } SEAM(10);
    if (IN(11)) { thin_t3(F, args); } SEAM(11);
    if (IN(12)) { pg8::Gemm g{(const bf16*)(ws + WS_XL), (const bf16*)(ws + WS_W_IN1), MA, OD_INP, D}; pg8::StaticOrder S; S.init(MA, OD_INP, F.G, bid);
        pg8::EpiSplit E{(bf16*)(ws + WS_Z1), Z1LD, (bf16*)(ws + WS_ZG), 32, 12, 32};
        pg8::gemm_phase<pg8::EpiSplit, pg8::StaticOrder, ALIGN, SP2>(F.lds + RING_OFF, g, S, E); } SEAM(12);
    if (IN(13)) {
#ifndef NO_GLA
 gla_naive(F, args);
#endif
 } SEAM(13);
    if (IN(14)) { gla_finish(F, args); } SEAM(14);
    if (IN(15)) { pg8::Gemm g{(const bf16*)(ws + WS_OF), (const bf16*)(ws + WS_W_OUT1), ML, D, D}; pg8::StaticOrder S; S.init(ML, D, F.G, bid);
        pg8::EpiPlain E{(bf16*)(ws + WS_YL1), D, 0, 0};
        pg8::gemm_phase<pg8::EpiPlain, pg8::StaticOrder, ALIGN, SP2>(F.lds + RING_OFF, g, S, E); } SEAM(15);
    if (IN(16)) { thin_t4(F, args); } SEAM(16);
    if (IN(17)) { moe_gather(F, args); } SEAM(17);
    if (lo < 28 && hi > 18) {
        int ts[9]; moe_tile_starts(F, ts); const int NT = ts[8];
        for (int s = 0; s < 5; ++s) {
            const int t0 = s * MOE_SLICE; int nT = NT - t0; nT = nT > MOE_SLICE ? MOE_SLICE : nT; nT = nT < 0 ? 0 : nT;
            if (IN(18 + 2 * s)) { pg8::Gemm g{(const bf16*)(ws + WS_XG), (const bf16*)(ws + WS_W_MGU), MOE_MAXT * 256, 2 * FE, D};
                pg8::MoeOrder S{t0, nT, 2 * FE / 256, F.G, bid, ts[1], ts[2], ts[3], ts[4], ts[5], ts[6], ts[7]};
                pg8::EpiSwiGlu E{(bf16*)(ws + WS_ACTM), FE, t0, 2 * FE / 256};
                pg8::gemm_phase<pg8::EpiSwiGlu, pg8::MoeOrder, ALIGN, SP2>(F.lds + RING_OFF, g, S, E); } SEAM(18 + 2 * s);
            if (IN(19 + 2 * s)) { pg8::Gemm g{(const bf16*)(ws + WS_ACTM) - (size_t)t0 * 256 * FE, (const bf16*)(ws + WS_W_MDN), MOE_MAXT * 256, D, FE};
                pg8::MoeOrder S{t0, nT, D / 256, F.G, bid, ts[1], ts[2], ts[3], ts[4], ts[5], ts[6], ts[7]};
                pg8::EpiPlain E{(bf16*)(ws + WS_XG), D, 0, D / 256};
                pg8::gemm_phase<pg8::EpiPlain, pg8::MoeOrder, ALIGN, SP2>(F.lds + RING_OFF, g, S, E); } SEAM(19 + 2 * s);
        }
    }
    if (IN(28)) { thin_t5(F, args); }
#undef IN
#undef SEAM
}

extern "C" void kernel_launch(void* const* d_in, const int* in_sizes, int n_in, void* d_out, int out_size, void* d_ws, size_t ws_size, hipStream_t stream) {
    static int grid = 0;
    if (grid == 0) {
        if (n_in != 35 || out_size != ML * D || ws_size < WS_END) { fprintf(stderr, "kernel_launch: unexpected shapes: n_in %d out %d ws %zu (need %zu)\n", n_in, out_size, ws_size, (size_t)WS_END); grid = -1; return; }
        int dev = 0, cus = 0, per_cu = 0;
        if (hipGetDevice(&dev) != hipSuccess || hipDeviceGetAttribute(&cus, hipDeviceAttributeMultiprocessorCount, dev) != hipSuccess) { grid = -1; return; }
        if (hipFuncSetAttribute((const void*)fwd_kernel, hipFuncAttributeMaxDynamicSharedMemorySize, LDS_BYTES) != hipSuccess) { fprintf(stderr, "kernel_launch: hipFuncSetAttribute failed\n"); grid = -1; return; }
        if (hipOccupancyMaxActiveBlocksPerMultiprocessor(&per_cu, (const void*)fwd_kernel, NWAVES * 64, LDS_BYTES) != hipSuccess || per_cu < 1) { fprintf(stderr, "kernel_launch: occupancy query reports %d blocks per CU\n", per_cu); }
        (void)hipGetLastError();
        grid = cus;
    }
    if (grid < 0) return;
    (void)hipMemsetAsync((char*)d_ws + WS_CTL, 0, CTL_ZERO_BYTES, stream);
    (void)hipMemsetAsync((char*)d_ws + WS_W_IN0, 0, WS_W_GLU - WS_W_IN0, stream);
    (void)hipMemsetAsync((char*)d_ws + WS_W_IN1, 0, (size_t)OD_INP * D * 2, stream);
    Args a{};
    for (int i = 0; i < 35; ++i) a.in[i] = (const float*)d_in[i];
    a.out = (float*)d_out; a.ws = (unsigned char*)d_ws;
#if MK_ONE_LAUNCH
    a.ph_lo = 0; a.ph_hi = NPHASE;
    hipLaunchKernelGGL(fwd_kernel, dim3(grid), dim3(NWAVES * 64), LDS_BYTES, stream, a);
#else
    for (int p = 0; p < NPHASE; ++p) { a.ph_lo = p; a.ph_hi = p + 1; hipLaunchKernelGGL(fwd_kernel, dim3(grid), dim3(NWAVES * 64), LDS_BYTES, stream, a); }
#endif
}
```

```cpp
#include <hip/hip_runtime.h>
#include <cstdio>
#include <cstdint>
#define MK_ONE_LAUNCH 1
namespace pg8 {
#define PG8_LAS __attribute__((address_space(3)))
typedef unsigned short bf16_t;
typedef short bf16x8 __attribute__((ext_vector_type(8)));
typedef float f32x4 __attribute__((ext_vector_type(4)));
typedef unsigned u32x4 __attribute__((ext_vector_type(4)));
constexpr int BM = 256, BK = 64, HALF = 128, HTB = HALF * BK * 2  , STAGE_BYTES = 8 * HTB, NXCD = 8, WGM = 8;

__host__ __device__ __forceinline__ int lds_byte(int r, int c) { const int st = (r >> 4) * 2 + (c >> 5), rr = r & 15, cc = c & 31, ob = rr * 64 + cc * 2; return st * 1024 + (ob ^ (((ob >> 9) & 1) << 5)); }
__host__ __device__ __forceinline__ void stage_rc(int b, int& R, int& C) { const int st = b / 1024, sb = b % 1024, swz = sb ^ (((sb >> 9) & 1) << 5); R = (st >> 1) * 16 + swz / 64; C = (st & 1) * 32 + (swz % 64) / 2; }
__host__ __device__ __forceinline__ int perm32(int rho) { const int n = rho >> 4, i = rho & 15; return 8 * (i >> 2) + 4 * n + (i & 3); }

struct Unit { int pm, pn; };
struct Gemm { const bf16_t* A; const bf16_t* Bt; int M, N, K; const PG8_LAS unsigned short* atab = nullptr; };
constexpr unsigned ACH_GS = 2304u * 256u * 2u;

struct StaticOrder {
    int nM, nN, nwg, G, c;
    __host__ __device__ void init(int M, int N, int G_, int c_) { nM = M / BM; nN = N / BM; nwg = nM * nN; G = G_; c = c_; }
    __host__ __device__ bool next(int i, Unit& u) const {
        const long L = (long)i * G + c; if (L >= nwg) return false;
        int wgid = (int)L; { const int q = nwg / NXCD, r = nwg % NXCD, xcd = wgid % NXCD, off = wgid / NXCD; wgid = (xcd < r ? xcd * (q + 1) : r * (q + 1) + (xcd - r) * q) + off; }
        const int nig = WGM * nN, gid = wgid / nig, fm = gid * WGM, gsz = (nM - fm) < WGM ? (nM - fm) : WGM;
        u.pm = fm + ((wgid % nig) % gsz); u.pn = (wgid % nig) / gsz; return true;
    }
    __device__ __forceinline__ void a_ready(const Unit&) const {}
    __device__ __forceinline__ void done(const Unit&) const {}
};

__device__ __forceinline__ unsigned cvt_pk_bf16(float lo, float hi) { unsigned r; asm volatile("v_cvt_pk_bf16_f32 %0, %1, %2" : "=v"(r) : "v"(lo), "v"(hi)); return r; }
typedef float f32x2 __attribute__((ext_vector_type(2)));
__device__ __forceinline__ u32x4 pack8(const f32x4 v0, const f32x4 v1) { u32x4 w; w.x = cvt_pk_bf16(v0[0], v0[1]); w.y = cvt_pk_bf16(v0[2], v0[3]); w.z = cvt_pk_bf16(v1[0], v1[1]); w.w = cvt_pk_bf16(v1[2], v1[3]); return w; }
__device__ __forceinline__ float bf_lo(unsigned u) { return __uint_as_float(u << 16); }
__device__ __forceinline__ float bf_hi(unsigned u) { return __uint_as_float(u & 0xffff0000u); }
__device__ __forceinline__ unsigned pk4_fp8(float a, float b, float c, float d) {
    a = __builtin_amdgcn_fmed3f(a, -448.f, 448.f); b = __builtin_amdgcn_fmed3f(b, -448.f, 448.f); c = __builtin_amdgcn_fmed3f(c, -448.f, 448.f); d = __builtin_amdgcn_fmed3f(d, -448.f, 448.f);
    int r = __builtin_amdgcn_cvt_pk_fp8_f32(a, b, 0, false); r = __builtin_amdgcn_cvt_pk_fp8_f32(c, d, r, true); return (unsigned)r; }
__device__ __forceinline__ float sigmoid_f(float x) { return __builtin_amdgcn_rcpf(1.0f + __builtin_amdgcn_exp2f(-1.4426950408889634f * x)); }

struct EpiPlain {
    static constexpr bool PERM = true, AFTER_DRAIN = false;
    bf16_t* O; int ldc; int pm_off; int nmod; float sc;
    __device__ __forceinline__ void operator()(const f32x4 (&acc)[2][2][4][2], const Unit& u, int wr, int wc, int fr, int fq) const {
        const int row0 = (u.pm - pm_off) * BM + wr * 64 + fr; const int ct = nmod ? (u.pn % nmod) : u.pn; const int col0 = ct * BM + wc * 32 + 8 * fq;
#pragma unroll
        for (int ai = 0; ai < 2; ++ai)
#pragma unroll
            for (int m = 0; m < 4; ++m) { bf16_t* rowp = O + (size_t)(row0 + ai * HALF + m * 16) * ldc + col0;
#pragma unroll
                for (int bj = 0; bj < 2; ++bj) *(u32x4*)(rowp + bj * HALF) = pack8(acc[ai][bj][m][0] * sc, acc[ai][bj][m][1] * sc); }
    }
};
struct EpiSplit {
    static constexpr bool PERM = true, AFTER_DRAIN = false;
    bf16_t* O0; int ld0; bf16_t* O1; int ld1; int nsplit; int ncols1;
    __device__ __forceinline__ void operator()(const f32x4 (&acc)[2][2][4][2], const Unit& u, int wr, int wc, int fr, int fq) const {
        const int row0 = u.pm * BM + wr * 64 + fr; const bool first = u.pn < nsplit;
        bf16_t* base = first ? O0 : O1; const int ld = first ? ld0 : ld1; const int col0 = (first ? u.pn : u.pn - nsplit) * BM + wc * 32 + 8 * fq; const int lim = first ? 0x7fffffff : ncols1;
#pragma unroll
        for (int ai = 0; ai < 2; ++ai)
#pragma unroll
            for (int m = 0; m < 4; ++m) { bf16_t* rowp = base + (size_t)(row0 + ai * HALF + m * 16) * ld + col0;
#pragma unroll
                for (int bj = 0; bj < 2; ++bj) if (col0 + bj * HALF < lim) *(u32x4*)(rowp + bj * HALF) = pack8(acc[ai][bj][m][0], acc[ai][bj][m][1]); }
    }
};
struct EpiGlu {
    static constexpr bool PERM = true, AFTER_DRAIN = false;
    const bf16_t* Aa; const float* bias; bf16_t* O; int ldc;
    __device__ __forceinline__ void operator()(const f32x4 (&acc)[2][2][4][2], const Unit& u, int wr, int wc, int fr, int fq) const {
        const int row0 = u.pm * BM + wr * 64 + fr; const int col0 = u.pn * BM + wc * 32 + 8 * fq;
        const int crow0 = (u.pm < 128 ? (u.pm >> 3) * 144 + 16 + (u.pm & 7) * 16 : (u.pm - 128) * 144) + wr * 4;
#pragma unroll
        for (int bj = 0; bj < 2; ++bj) { const f32x4 b0 = *(const f32x4*)(bias + col0 + bj * HALF), b1 = *(const f32x4*)(bias + col0 + bj * HALF + 4);
            const int cg = (col0 + bj * HALF) >> 4, ch = (col0 + bj * HALF) & 15;
#pragma unroll
            for (int ai = 0; ai < 2; ++ai)
#pragma unroll
                for (int m = 0; m < 4; ++m) { const size_t r = (size_t)(row0 + ai * HALF + m * 16);
                    const u32x4 a8 = *(const u32x4*)(Aa + (size_t)cg * (2304 * 256) + (size_t)(crow0 + ai * 8 + m) * 256 + fr * 16 + ch);
                    f32x4 v0 = acc[ai][bj][m][0] + b0, v1 = acc[ai][bj][m][1] + b1;
                    v0[0] = bf_lo(a8.x) * sigmoid_f(v0[0]); v0[1] = bf_hi(a8.x) * sigmoid_f(v0[1]); v0[2] = bf_lo(a8.y) * sigmoid_f(v0[2]); v0[3] = bf_hi(a8.y) * sigmoid_f(v0[3]);
                    v1[0] = bf_lo(a8.z) * sigmoid_f(v1[0]); v1[1] = bf_hi(a8.z) * sigmoid_f(v1[1]); v1[2] = bf_lo(a8.w) * sigmoid_f(v1[2]); v1[3] = bf_hi(a8.w) * sigmoid_f(v1[3]);
                    *(u32x4*)(O + r * ldc + col0 + bj * HALF) = pack8(v0, v1); } }
    }
};
struct EpiSwiGlu {
    static constexpr bool PERM = true, AFTER_DRAIN = false;
    bf16_t* O; int ldc; int pm_off; int nmod;
    __device__ __forceinline__ void operator()(const f32x4 (&acc)[2][2][4][2], const Unit& u, int wr, int wc, int fr, int fq) const {
        const int row0 = (u.pm - pm_off) * BM + wr * 64 + fr; const int ct = nmod ? (u.pn % nmod) : u.pn; const int col0 = ct * HALF + wc * 32 + 8 * fq;
#pragma unroll
        for (int ai = 0; ai < 2; ++ai)
#pragma unroll
            for (int m = 0; m < 4; ++m) { f32x4 o0, o1;
#pragma unroll
                for (int i = 0; i < 4; ++i) { const float g0 = acc[ai][0][m][0][i], g1 = acc[ai][0][m][1][i]; o0[i] = g0 * sigmoid_f(g0) * acc[ai][1][m][0][i]; o1[i] = g1 * sigmoid_f(g1) * acc[ai][1][m][1][i]; }
                *(u32x4*)(O + (size_t)(row0 + ai * HALF + m * 16) * ldc + col0) = pack8(o0, o1); }
    }
};
struct EpiIn0 {
    static constexpr bool PERM = true, AFTER_DRAIN = false;
    bf16_t* U; bf16_t* A3; bf16_t* Z0c;
    __device__ __forceinline__ void operator()(const f32x4 (&acc)[2][2][4][2], const Unit& u, int wr, int wc, int fr, int fq) const {
        if (u.pn >= 2) {
            const int row0 = u.pm * BM + wr * 64 + fr, col0 = (u.pn - 2) * BM + wc * 32 + 8 * fq;
#pragma unroll
            for (int ai = 0; ai < 2; ++ai)
#pragma unroll
                for (int m = 0; m < 4; ++m) { bf16_t* rowp = Z0c + (size_t)(row0 + ai * HALF + m * 16) * 512 + col0;
#pragma unroll
                    for (int bj = 0; bj < 2; ++bj) *(u32x4*)(rowp + bj * HALF) = pack8(acc[ai][bj][m][0], acc[ai][bj][m][1]); }
        } else {
            const int b = (u.pm < 128) ? (u.pm >> 3) : (u.pm - 128); const int c0 = (u.pm < 128) ? (16 + (u.pm & 7) * 16) : 0;
            const int g0 = u.pn * 16 + wc * 2 + (fq >> 1);
            const size_t r0 = (size_t)(g0 * 16 + b) * 144 + c0 + wr * 4;
            const int cc = fr * 16 + 8 * (fq & 1);
#pragma unroll
            for (int ai = 0; ai < 2; ++ai)
#pragma unroll
                for (int m = 0; m < 4; ++m)
#pragma unroll
                    for (int bj = 0; bj < 2; ++bj) { const size_t r = r0 + (size_t)bj * (8 * 16 * 144) + ai * 8 + m; const u32x4 w = pack8(acc[ai][bj][m][0], acc[ai][bj][m][1]);
                        *(u32x4*)(U + r * 256 + cc) = w; *(u32x4*)(A3 + r * 512 + cc) = w; }
        }
    }
};
struct EpiF32 {
    static constexpr bool PERM = false, AFTER_DRAIN = false;
    float* C; int ldc;
    __device__ __forceinline__ void operator()(const f32x4 (&acc)[2][2][4][2], const Unit& u, int wr, int wc, int fr, int fq) const {
        const int row0 = u.pm * BM + wr * 64 + fr, col0 = wc * 32 + 4 * fq;
#pragma unroll
        for (int ai = 0; ai < 2; ++ai)
#pragma unroll
            for (int m = 0; m < 4; ++m) { float* rowp = C + (size_t)(row0 + ai * HALF + m * 16) * ldc + col0;
#pragma unroll
                for (int bj = 0; bj < 2; ++bj)
#pragma unroll
                    for (int n = 0; n < 2; ++n) *(f32x4*)(rowp + bj * HALF + n * 16) = acc[ai][bj][m][n]; }
    }
};
__device__ __forceinline__ float gelu_tanh_f(float x) { const float t = 0.7978845608028654f * (x + 0.044715f * x * x * x); const float e = __builtin_amdgcn_exp2f(2.8853900817779268f * t); return x - x * __builtin_amdgcn_rcpf(e + 1.0f); }
struct EpiS5Out {
    static constexpr bool PERM = true, AFTER_DRAIN = false;
    bf16_t* AG;
    __device__ __forceinline__ void operator()(const f32x4 (&acc)[2][2][4][2], const Unit& u, int wr, int wc, int fr, int fq) const {
        const int row0 = u.pm * BM + wr * 64 + fr, col0 = wc * 32 + 8 * fq;
#pragma unroll
        for (int ai = 0; ai < 2; ++ai)
#pragma unroll
            for (int m = 0; m < 4; ++m) { bf16_t* rowp = AG + (size_t)(row0 + ai * HALF + m * 16) * 256 + col0;
#pragma unroll
                for (int bj = 0; bj < 2; ++bj) { f32x4 v0 = acc[ai][bj][m][0], v1 = acc[ai][bj][m][1];
#pragma unroll
                    for (int i = 0; i < 4; ++i) { v0[i] = gelu_tanh_f(v0[i]); v1[i] = gelu_tanh_f(v1[i]); }
                    *(u32x4*)(rowp + bj * HALF) = pack8(v0, v1); } }
    }
};
struct S5Order {
    int G, c;
    __device__ __forceinline__ bool next(int i, Unit& u) const { const int L = i * G + c; if (L >= 32 * 9) return false; u.pm = L; u.pn = L / 9; return true; }
    __device__ __forceinline__ void a_ready(const Unit&) const {}
    __device__ __forceinline__ void done(const Unit&) const {}
};
struct EpiSwiGlu8 {
    static constexpr bool PERM = true, AFTER_DRAIN = false;
    unsigned char* O; int ldc; int nmod; float us, os; int tiled;
    __device__ __forceinline__ void operator()(const f32x4 (&acc)[2][2][4][2], const Unit& u, int wr, int wc, int fr, int fq) const {
        const int row0 = u.pm * BM + wr * 64 + fr; const int ct = nmod ? (u.pn % nmod) : u.pn; const int col0 = ct * HALF + wc * 32 + 8 * fq;
        typedef unsigned u32x2_ __attribute__((ext_vector_type(2)));
#pragma unroll
        for (int ai = 0; ai < 2; ++ai)
#pragma unroll
            for (int m = 0; m < 4; ++m) { f32x4 o0, o1;
#pragma unroll
                for (int i = 0; i < 4; ++i) { const float g0 = acc[ai][0][m][0][i] * us, g1 = acc[ai][0][m][1][i] * us; o0[i] = g0 * sigmoid_f(g0) * (acc[ai][1][m][0][i] * us) * os; o1[i] = g1 * sigmoid_f(g1) * (acc[ai][1][m][1][i] * us) * os; }
                u32x2_ w; w.x = pk4_fp8(o0[0], o0[1], o0[2], o0[3]); w.y = pk4_fp8(o1[0], o1[1], o1[2], o1[3]);
                const int rr = wr * 64 + fr + ai * HALF + m * 16;
                if (tiled) *(u32x2_*)(O + (size_t)u.pm * BM * ldc + (size_t)ct * (BM * 128) + rr * 128 + wc * 32 + 8 * fq) = w;
                else *(u32x2_*)(O + (size_t)(row0 + ai * HALF + m * 16) * ldc + col0) = w; }
    }
};
struct MoeOrder {
    int t0, nT, nN, G, c; int e1, e2, e3, e4, e5, e6, e7; int rev;
    __device__ __forceinline__ bool next(int i, Unit& u) const {
        const int nwg = nT * nN; const long L = (long)i * G + c; if (L >= nwg) return false;
        int wgid = (int)L; { const int q = nwg / NXCD, r = nwg % NXCD, xcd = wgid % NXCD, off = wgid / NXCD, sz = xcd < r ? q + 1 : q; wgid = (xcd < r ? xcd * (q + 1) : r * (q + 1) + (xcd - r) * q) + (rev ? sz - 1 - off : off); }
        const int nig = WGM * nN, gid = wgid / nig, fm = gid * WGM, gsz = (nT - fm) < WGM ? (nT - fm) : WGM;
        const int pm = t0 + fm + ((wgid % nig) % gsz), pn = (wgid % nig) / gsz;
        const int e = (pm >= e1) + (pm >= e2) + (pm >= e3) + (pm >= e4) + (pm >= e5) + (pm >= e6) + (pm >= e7);
        u.pm = pm; u.pn = e * nN + pn; return true;
    }
    __device__ __forceinline__ void a_ready(const Unit&) const {}
    __device__ __forceinline__ void done(const Unit&) const {}
};
template <class Epi, class Sched, bool ALIGN_EPI = false, bool SP2 = false, bool FP8 = false, bool TILED = false, bool ACHUNK = false, bool AGATHER = false>
__device__ __forceinline__ void gemm_phase(PG8_LAS unsigned char* lds, const Gemm g, const Sched& S, const Epi& E) {
    const int tid = threadIdx.x, wid = __builtin_amdgcn_readfirstlane(tid >> 6), lane = tid & 63, wr = wid >> 2, wc = wid & 3, fr = lane & 15, fq = lane >> 4;
    const int K = g.K, nt = K / BK;
    unsigned voffA[2], voffB[2];
#pragma unroll
    for (int i = 0; i < 2; ++i) { int R, C; stage_rc(tid * 16 + i * 8192, R, C); const int Rb = Epi::PERM ? ((R & ~31) + perm32(R & 31)) : R;
        voffA[i] = TILED ? (unsigned)(R * BK + C) * 2u : (unsigned)(R * K + C) * 2u; voffB[i] = TILED ? (unsigned)(Rb * BK + C) * 2u : (unsigned)(Rb * K + C) * 2u;
        if (ACHUNK) voffA[i] = (unsigned)((R >> 4) * 512 + (R & 15) * 32 + (C & 15) * 2) + (unsigned)(C >> 4) * ACH_GS; }
    const size_t kstep = TILED ? (size_t)(BM * BK * 2) : (size_t)(BK * 2);
    const size_t hstep = TILED ? (size_t)(HALF * BK * 2) : (size_t)HALF * K * 2;
    const size_t tstep = (size_t)BM * K * 2;
    const size_t kstepA = ACHUNK ? (size_t)4 * ACH_GS : kstep, hstepA = ACHUNK ? (size_t)4096 : hstep;
#define PG8_ABASE(pm_) (AGATHER ? (const char*)g.A : ACHUNK ? (const char*)g.A + (size_t)((pm_) < 128 ? ((pm_) >> 3) * 144 + 16 + ((pm_) & 7) * 16 : ((pm_) - 128) * 144) * 512 : (const char*)g.A + (size_t)(pm_) * tstep)
    const unsigned ldsw = (unsigned)wid * 1024u;
    const int aoff = lds_byte(wr * 64 + fr, fq * 8), boff = lds_byte(wc * 32 + fr, fq * 8);
#define PG8_SA(b, h) (((b) * 2 + (h)) * HTB)
#define PG8_SB(b, h) ((4 + (b) * 2 + (h)) * HTB)
#define PG8_STAGE(bufoff, gbase, voff) do { _Pragma("unroll") for (int _i = 0; _i < 2; ++_i) \
        __builtin_amdgcn_global_load_lds((const unsigned*)((const char*)(gbase) + (voff)[_i]), (PG8_LAS unsigned*)(lds + (bufoff) + ldsw + _i * 8192), 16, 0, 0); } while (0)
    static_assert(!AGATHER || SP2, "AGATHER is written for the SP2 loop");
    unsigned gvA0[2] = {0u, 0u}, gvA1[2] = {0u, 0u}, gnA0[2] = {0u, 0u}, gnA1[2] = {0u, 0u};
#define PG8_GLOAD(uidx, v0, v1) do { _Pragma("unroll") for (int i_ = 0; i_ < 2; ++i_) { int R_, C_; stage_rc(tid * 16 + i_ * 8192, R_, C_); \
        const unsigned t0_ = g.atab[(uidx) * 256 + R_], t1_ = g.atab[(uidx) * 256 + 128 + R_]; v0[i_] = t0_ * (unsigned)(2 * K) + (unsigned)C_ * 2u; v1[i_] = t1_ * (unsigned)(2 * K) + (unsigned)C_ * 2u; } } while (0)
#define PG8_STAGE_A(bufoff, gbase, half, nx) do { if constexpr (AGATHER) { unsigned vs_[2]; \
        vs_[0] = (nx) ? ((half) ? gnA1[0] : gnA0[0]) : ((half) ? gvA1[0] : gvA0[0]); vs_[1] = (nx) ? ((half) ? gnA1[1] : gnA0[1]) : ((half) ? gvA1[1] : gvA0[1]); PG8_STAGE(bufoff, gbase, vs_); } \
        else PG8_STAGE(bufoff, (gbase) + ((half) ? hstepA : (size_t)0), voffA); } while (0)
#define PG8_LDA(dst, b, h) do { _Pragma("unroll") for (int m = 0; m < 4; ++m) _Pragma("unroll") for (int k = 0; k < 2; ++k) dst[m][k] = *(const PG8_LAS bf16x8*)(lds + PG8_SA(b, h) + aoff + m * 2048 + k * 1024); } while (0)
#define PG8_LDB(dst, b, h) do { _Pragma("unroll") for (int n = 0; n < 2; ++n) _Pragma("unroll") for (int k = 0; k < 2; ++k) dst[n][k] = *(const PG8_LAS bf16x8*)(lds + PG8_SB(b, h) + boff + n * 2048 + k * 1024); } while (0)
#define PG8_MMA(ai, bj, At, Bt) do { __builtin_amdgcn_s_setprio(1); _Pragma("unroll") for (int m = 0; m < 4; ++m) _Pragma("unroll") for (int n = 0; n < 2; ++n) { \
        if constexpr (FP8) { typedef int i32x4_ __attribute__((ext_vector_type(4))); typedef int i32x8_ __attribute__((ext_vector_type(8))); \
            const i32x8_ bo_ = __builtin_shufflevector(__builtin_bit_cast(i32x4_, Bt[n][0]), __builtin_bit_cast(i32x4_, Bt[n][1]), 0, 1, 2, 3, 4, 5, 6, 7); \
            const i32x8_ ao_ = __builtin_shufflevector(__builtin_bit_cast(i32x4_, At[m][0]), __builtin_bit_cast(i32x4_, At[m][1]), 0, 1, 2, 3, 4, 5, 6, 7); \
            asm volatile("v_mfma_scale_f32_16x16x128_f8f6f4 %0, %1, %2, %0, %3, %3 op_sel_hi:[0,0,0]" : "+v"(acc[ai][bj][m][n]) : "v"(bo_), "v"(ao_), "v"(fp8_unit_scale_)); } \
        else { _Pragma("unroll") for (int k = 0; k < 2; ++k) acc[ai][bj][m][n] = __builtin_amdgcn_mfma_f32_16x16x32_bf16(Bt[n][k], At[m][k], acc[ai][bj][m][n], 0, 0, 0); } } \
        __builtin_amdgcn_s_setprio(0); } while (0)
#define PG8_WAIT_V(n) asm volatile("s_waitcnt vmcnt(" #n ")" ::: "memory")
#define PG8_WAIT_L(n) asm volatile("s_waitcnt lgkmcnt(" #n ")" ::: "memory")
#define PG8_BAR __builtin_amdgcn_s_barrier()
#define PG8_SCHED __builtin_amdgcn_sched_barrier(0)
    const int fp8_unit_scale_ = 0x7f7f7f7f; (void)fp8_unit_scale_;
    Unit cur, nxt; int ui = 0;
    if (!S.next(0, cur)) return;
    f32x4 acc[2][2][4][2];
#pragma unroll
    for (int a = 0; a < 2; ++a)
#pragma unroll
        for (int b = 0; b < 2; ++b)
#pragma unroll
            for (int m = 0; m < 4; ++m)
#pragma unroll
                for (int n = 0; n < 2; ++n) acc[a][b][m][n] = (f32x4){0.f, 0.f, 0.f, 0.f};
    bf16x8 At[4][2], B0[2][2], B1[2][2];
    const char* cA = PG8_ABASE(cur.pm); const char* cB = (const char*)g.Bt + (size_t)cur.pn * tstep;
    if constexpr (AGATHER) PG8_GLOAD(0, gvA0, gvA1);
    S.a_ready(cur);
    if constexpr (SP2) {
        PG8_STAGE(PG8_SB(0, 0), cB, voffB); PG8_STAGE(PG8_SB(0, 1), cB + hstep, voffB); PG8_STAGE_A(PG8_SA(0, 0), cA, 0, false); PG8_STAGE_A(PG8_SA(0, 1), cA, 1, false);
        if (wr == 1) PG8_BAR;
        PG8_WAIT_V(2); PG8_BAR;
        PG8_STAGE(PG8_SB(1, 0), cB + kstep, voffB); PG8_STAGE_A(PG8_SA(1, 0), cA + kstepA, 0, false); PG8_STAGE(PG8_SB(1, 1), cB + hstep + kstep, voffB);
        PG8_WAIT_V(6); PG8_BAR;
    } else {
        PG8_STAGE(PG8_SB(0, 0), cB, voffB); PG8_STAGE(PG8_SA(0, 0), cA, voffA); PG8_STAGE(PG8_SB(0, 1), cB + hstep, voffB); PG8_STAGE(PG8_SA(0, 1), cA + hstepA, voffA);
        if (wr == 1) PG8_BAR;
        PG8_WAIT_V(4); PG8_BAR;
        PG8_STAGE(PG8_SB(1, 0), cB + kstep, voffB); PG8_STAGE(PG8_SA(1, 0), cA + kstepA, voffA); PG8_STAGE(PG8_SB(1, 1), cB + hstep + kstep, voffB);
        PG8_WAIT_V(6); PG8_BAR;
    }
    for (;;) {
        const bool has_next = S.next(ui + 1, nxt);
        const char* nA = has_next ? PG8_ABASE(nxt.pm) : cA; const char* nB = has_next ? (const char*)g.Bt + (size_t)nxt.pn * tstep : cB;
        for (int t = 0; t < nt; t += 2) {
            const bool last = (t == nt - 2);
            const char* a1 = cA + (size_t)(t + 1) * kstepA;
            const char* a2 = last ? nA : cA + (size_t)(t + 2) * kstepA; const char* b2 = last ? nB : cB + (size_t)(t + 2) * kstep;
            const char* a3 = a2 + kstepA; const char* b3 = b2 + kstep;
            if (last && has_next) S.a_ready(nxt);
            const bool nx_ = last && has_next;
            if constexpr (AGATHER) { if (nx_) PG8_GLOAD(ui + 1, gnA0, gnA1); }
            if constexpr (SP2) {
            PG8_LDB(B0, 0, 0); PG8_LDB(B1, 0, 1); PG8_SCHED; PG8_LDA(At, 0, 0); PG8_STAGE_A(PG8_SA(1, 1), a1, 1, false);
            PG8_WAIT_V(8); PG8_WAIT_L(0); PG8_BAR; PG8_MMA(0, 0, At, B0); PG8_MMA(0, 1, At, B1); PG8_BAR; PG8_SCHED;
            PG8_LDA(At, 0, 1); PG8_STAGE(PG8_SB(0, 0), b2, voffB); PG8_STAGE(PG8_SB(0, 1), b2 + hstep, voffB); PG8_STAGE_A(PG8_SA(0, 0), a2, 0, nx_);
            PG8_WAIT_V(8); PG8_WAIT_L(0); PG8_BAR; PG8_MMA(1, 0, At, B0); PG8_MMA(1, 1, At, B1); PG8_BAR; PG8_SCHED;
            PG8_LDB(B0, 1, 0); PG8_LDB(B1, 1, 1); PG8_SCHED; PG8_LDA(At, 1, 0); PG8_STAGE_A(PG8_SA(0, 1), a2, 1, nx_);
            PG8_WAIT_V(8); PG8_WAIT_L(0); PG8_BAR; PG8_MMA(0, 0, At, B0); PG8_MMA(0, 1, At, B1); PG8_BAR; PG8_SCHED;
            PG8_LDA(At, 1, 1); PG8_STAGE(PG8_SB(1, 0), b3, voffB); PG8_STAGE(PG8_SB(1, 1), b3 + hstep, voffB); PG8_STAGE_A(PG8_SA(1, 0), a3, 0, nx_);
            PG8_WAIT_V(8); PG8_WAIT_L(0); PG8_BAR; PG8_MMA(1, 0, At, B0); PG8_MMA(1, 1, At, B1); PG8_BAR; PG8_SCHED;
            } else {
            PG8_LDB(B0, 0, 0); PG8_SCHED; PG8_LDA(At, 0, 0); PG8_STAGE(PG8_SA(1, 1), a1 + hstepA, voffA);
            PG8_WAIT_L(8); PG8_BAR; PG8_WAIT_L(0); PG8_MMA(0, 0, At, B0); PG8_BAR; PG8_SCHED;
            PG8_LDB(B1, 0, 1); PG8_STAGE(PG8_SB(0, 0), b2, voffB);
            PG8_BAR; PG8_WAIT_L(0); PG8_MMA(0, 1, At, B1); PG8_BAR;
            PG8_LDA(At, 0, 1); PG8_STAGE(PG8_SA(0, 0), a2, voffA);
            PG8_BAR; PG8_WAIT_L(0); PG8_MMA(1, 0, At, B0); PG8_BAR; PG8_SCHED;
            PG8_STAGE(PG8_SB(0, 1), b2 + hstep, voffB);
            PG8_WAIT_V(6); PG8_BAR; PG8_MMA(1, 1, At, B1); PG8_BAR;
            PG8_LDB(B0, 1, 0); PG8_SCHED; PG8_LDA(At, 1, 0); PG8_STAGE(PG8_SA(0, 1), a2 + hstepA, voffA);
            PG8_WAIT_L(8); PG8_BAR; PG8_WAIT_L(0); PG8_MMA(0, 0, At, B0); PG8_BAR; PG8_SCHED;
            PG8_LDB(B1, 1, 1); PG8_STAGE(PG8_SB(1, 0), b3, voffB);
            PG8_BAR; PG8_WAIT_L(0); PG8_MMA(0, 1, At, B1); PG8_BAR;
            PG8_LDA(At, 1, 1); PG8_STAGE(PG8_SA(1, 0), a3, voffA);
            PG8_BAR; PG8_WAIT_L(0); PG8_MMA(1, 0, At, B0); PG8_BAR; PG8_SCHED;
            PG8_STAGE(PG8_SB(1, 1), b3 + hstep, voffB);
            PG8_WAIT_V(6); PG8_BAR; PG8_MMA(1, 1, At, B1); PG8_BAR;
            }
        }
        if constexpr (ALIGN_EPI) { if (wr == 0) PG8_BAR; }
        if constexpr (FP8) asm volatile("s_nop 15\n\ts_nop 7" ::: "memory");
        if constexpr (!Epi::AFTER_DRAIN) { E(acc, cur, wr, wc, fr, fq); S.done(cur); }
        if (!has_next) break;
#pragma unroll
        for (int a = 0; a < 2; ++a)
#pragma unroll
            for (int b = 0; b < 2; ++b)
#pragma unroll
                for (int m = 0; m < 4; ++m)
#pragma unroll
                    for (int n = 0; n < 2; ++n) acc[a][b][m][n] = (f32x4){0.f, 0.f, 0.f, 0.f};
        cur = nxt; cA = nA; cB = nB; ++ui;
        if constexpr (AGATHER) { gvA0[0] = gnA0[0]; gvA0[1] = gnA0[1]; gvA1[0] = gnA1[0]; gvA1[1] = gnA1[1]; }
        if constexpr (ALIGN_EPI) { if (wr == 1) PG8_BAR; }
    }
    PG8_WAIT_V(0);
    if constexpr (!ALIGN_EPI) { if (wr == 0) PG8_BAR; }
    PG8_BAR;
    if constexpr (Epi::AFTER_DRAIN) { E.fused(acc, cur, wr, wc, fr, fq, lds, wid, lane); S.done(cur); }
#undef PG8_ABASE
#undef PG8_GLOAD
#undef PG8_STAGE_A
#undef PG8_SA
#undef PG8_SB
#undef PG8_STAGE
#undef PG8_LDA
#undef PG8_LDB
#undef PG8_MMA
#undef PG8_WAIT_V
#undef PG8_WAIT_L
#undef PG8_BAR
#undef PG8_SCHED
}
}
#define GAS __attribute__((address_space(1)))
#define LAS __attribute__((address_space(3)))
typedef unsigned short bf16;
typedef unsigned v4u __attribute__((ext_vector_type(4)));
typedef float f32x4 __attribute__((ext_vector_type(4)));
typedef short bf16x8 __attribute__((ext_vector_type(8)));
typedef GAS unsigned gu32;
typedef GAS unsigned long long gu64;
#define RLX_AGENT __ATOMIC_RELAXED, __HIP_MEMORY_SCOPE_AGENT
#define LDS_WAIT() asm volatile("s_waitcnt lgkmcnt(0)" ::: "memory")
#define VM_WAIT() asm volatile("s_waitcnt vmcnt(0)" ::: "memory")
__device__ __forceinline__ unsigned long long rt() { return __builtin_amdgcn_s_memrealtime(); }
__device__ __forceinline__ unsigned f2bf(float f) { unsigned u = __builtin_bit_cast(unsigned, f); return (u + 0x7fffu + ((u >> 16) & 1u)) >> 16; }
__device__ __forceinline__ unsigned pk2(float lo, float hi) { return f2bf(lo) | (f2bf(hi) << 16); }
#define XB_TMO      128
#define XB_XCNT(j)  (256  + 64 * (j))
#define XB_XSUB(j)  (1280 + 64 * (j))
#define XB_XGEN(j)  (2304 + 64 * (j))
#define XB_TOP      3328
#define XB_TOPGEN   3392
#define XCD_BAR_WORDS 3456
#define XB_SPIN_CAP (1u << 18)

__device__ __forceinline__ unsigned xb_ld(unsigned* p)              { return __hip_atomic_load(p, __ATOMIC_RELAXED, __HIP_MEMORY_SCOPE_AGENT); }
__device__ __forceinline__ unsigned xb_add(unsigned* p, unsigned v) { return __hip_atomic_fetch_add(p, v, __ATOMIC_RELAXED, __HIP_MEMORY_SCOPE_AGENT); }
__device__ __forceinline__ unsigned xb_xcc_id() { return (unsigned)__builtin_amdgcn_s_getreg((3 << 11) | 20) & 0xFu; }
#define XB_SPIN(cond, bar) do { unsigned _sp = 0; while (cond) { __builtin_amdgcn_s_sleep(1); \
    if ((++_sp & 255u) == 0u) { if (xb_ld(&(bar)[XB_TMO])) break; if (_sp > XB_SPIN_CAP) { atomicAdd(&(bar)[XB_TMO], 1u); break; } } } } while (0)

struct XcdBarrier {
    unsigned* bar; unsigned x;
    volatile LAS unsigned* st;
};

__device__ __forceinline__ XcdBarrier xcd_barrier_post(unsigned* bar, volatile LAS unsigned* st) {
    XcdBarrier b; b.bar = bar; b.x = xb_xcc_id(); b.st = st;
    if (threadIdx.x == 0) (void)xb_add(&bar[XB_XCNT(b.x)], 1u);
    return b;
}
__device__ __forceinline__ void xcd_barrier_complete(unsigned* bar, unsigned x, unsigned& nloc, unsigned& nx) {
    const unsigned G = gridDim.x * gridDim.y * gridDim.z;
    unsigned sum, cnt, mine, sp = 0u;
    for (;;) {
        sum = 0u; cnt = 0u; mine = 0u;
#pragma unroll
        for (unsigned j = 0; j < 16; ++j) { const unsigned c = xb_ld(&bar[XB_XCNT(j)]); sum += c; cnt += (c > 0u) ? 1u : 0u; mine = (j == x) ? c : mine; }
        if (sum == G) break;
        __builtin_amdgcn_s_sleep(1);
        if ((++sp & 255u) == 0u) { if (xb_ld(&bar[XB_TMO])) break; if (sp > XB_SPIN_CAP) { atomicAdd(&bar[XB_TMO], 1u); break; } }
    }
    nloc = mine > 0u ? mine : 1u; nx = cnt > 0u ? cnt : 1u;
}

__device__ __forceinline__ void xcd_barrier(const XcdBarrier& b) {
    asm volatile("s_waitcnt vmcnt(0)" ::: "memory");
    __syncthreads();
    if (threadIdx.x == 0) {
        unsigned* bar = b.bar;
        __builtin_amdgcn_s_waitcnt(0);
        unsigned nloc = b.st[0], nx = b.st[1];
        if (nloc == 0u) { xcd_barrier_complete(bar, b.x, nloc, nx); b.st[0] = nloc; b.st[1] = nx; }
        const unsigned old = xb_add(&bar[XB_XSUB(b.x)], 1u);
        const unsigned gen = old / nloc;
        if (old + 1u == (gen + 1u) * nloc) {
            __builtin_amdgcn_fence(__ATOMIC_RELEASE, "agent");
            asm volatile("s_waitcnt vmcnt(0)" ::: "memory");
            const unsigned og = xb_add(&bar[XB_TOP], 1u);
            const unsigned tg = og / nx;
            if (og + 1u == (tg + 1u) * nx) xb_add(&bar[XB_TOPGEN], 1u);
            else XB_SPIN(xb_ld(&bar[XB_TOPGEN]) == tg, bar);
            __builtin_amdgcn_fence(__ATOMIC_ACQUIRE, "agent");
            xb_add(&bar[XB_XGEN(b.x)], 1u);
            asm volatile("s_waitcnt vmcnt(0)" ::: "memory");
        } else {
            XB_SPIN(xb_ld(&bar[XB_XGEN(b.x)]) == gen, bar);
            __builtin_amdgcn_fence(__ATOMIC_ACQUIRE, "agent");
            asm volatile("s_waitcnt vmcnt(0)" ::: "memory");
        }
    }
    __syncthreads();
}

namespace att {
typedef short bf16x8 __attribute__((ext_vector_type(8)));
typedef short s16x4 __attribute__((ext_vector_type(4)));
typedef float f32x16 __attribute__((ext_vector_type(16)));
typedef unsigned u32x4 __attribute__((ext_vector_type(4)));
#define ATT_LAS __attribute__((address_space(3)))
constexpr int QBLK = 32, KVBLK = 64, DQ = 96, DV = 64, LDQ = 768, LDKN = 1024, LDKR = 32, LDV = 1024, LDO = 1024;
typedef const __attribute__((address_space(1))) unsigned short* gcp; typedef __attribute__((address_space(1))) unsigned short* gp;
constexpr float SCALE = 0.10206207261596577f, QSC = SCALE * 1.4426950408889634f, THR2 = 8.f * 1.4426950408889634f;
constexpr int SHM_V = KVBLK * DV * 2, SHM_K = KVBLK * 256, NRING = 4, OFF_K = 0, OFF_V = NRING * SHM_K, OFF_WS = NRING * (SHM_V + SHM_K), ATT_LDS = OFF_WS + 8 * 256;
#define KSWZ(row, colB) ((row) * 256 + ((colB) ^ (((row) & 7) << 4)))
#define SBAR() __builtin_amdgcn_sched_barrier(0)
__device__ __forceinline__ int crow(int r, int hi) { return (r & 3) + 8 * (r >> 2) + 4 * hi; }
__device__ __forceinline__ unsigned cvtpk(float lo, float hi) { unsigned r; asm volatile("v_cvt_pk_bf16_f32 %0, %1, %2" : "=v"(r) : "v"(lo), "v"(hi)); return r; }
template <bool FIRST> __device__ __forceinline__ void partialSM(f32x16& p0, f32x16& p1, f32x16& mC, float& alpha) {
  float pmax = p0[0];
#pragma unroll
  for (int r = 1; r < 16; ++r) pmax = fmaxf(pmax, p0[r]);
#pragma unroll
  for (int r = 0; r < 16; ++r) pmax = fmaxf(pmax, p1[r]);
  { auto rr = __builtin_amdgcn_permlane32_swap(__float_as_uint(pmax), __float_as_uint(pmax), false, false);
    pmax = fmaxf(__uint_as_float(rr[0]), __uint_as_float(rr[1])); }
  if (!FIRST && __builtin_expect(__all(pmax <= THR2), 1)) alpha = 1.f;
  else { const float d = FIRST ? pmax : fmaxf(pmax, 0.f); alpha = __builtin_amdgcn_exp2f(-d);
#pragma unroll
    for (int r = 0; r < 16; ++r) { p0[r] -= d; p1[r] -= d; mC[r] -= d; } }
#pragma unroll
  for (int r = 0; r < 16; ++r) p0[r] = __builtin_amdgcn_exp2f(p0[r]);
}
__device__ __forceinline__ void finishSM(f32x16& p0, f32x16& p1, bf16x8& pa0, bf16x8& pa1, bf16x8& pa2, bf16x8& pa3) {
#pragma unroll
  for (int r = 0; r < 16; ++r) p1[r] = __builtin_amdgcn_exp2f(p1[r]);
#define PK4(P, BASE, OUT) do { u32x4 w = {cvtpk(P[BASE + 0], P[BASE + 1]), cvtpk(P[BASE + 2], P[BASE + 3]), cvtpk(P[BASE + 4], P[BASE + 5]), cvtpk(P[BASE + 6], P[BASE + 7])}; OUT = __builtin_bit_cast(bf16x8, w); } while (0)
  PK4(p0, 0, pa0); PK4(p0, 8, pa1); PK4(p1, 0, pa2); PK4(p1, 8, pa3);
#undef PK4
}
__device__ __forceinline__ void qkt(f32x16& p0, f32x16& p1, const f32x16& mC, const ATT_LAS unsigned char* Ks, const bf16x8* qr, int r32, int hi) {
#pragma unroll
  for (int d0 = 0; d0 < DQ / 16; ++d0) { const int cb = (d0 * 16 + hi * 8) * 2;
    const bf16x8 b0 = *(const ATT_LAS bf16x8*)(Ks + KSWZ(r32, cb));
    const bf16x8 b1 = *(const ATT_LAS bf16x8*)(Ks + KSWZ(32 + r32, cb));
    p0 = __builtin_amdgcn_mfma_f32_32x32x16_bf16(b0, qr[d0], d0 ? p0 : mC, 0, 0, 0);
    p1 = __builtin_amdgcn_mfma_f32_32x32x16_bf16(b1, qr[d0], d0 ? p1 : mC, 0, 0, 0); }
}
__device__ __forceinline__ int v_st(int k, int c) { const int kk = k; return ((kk >> 3) * 2 + (c >> 5)) * 512 + ((kk & 7) * 32 + (c & 31)) * 2; }
__device__ __forceinline__ int v_rd_base(int lane) { return ((lane & 3) << 3) | (((lane >> 2) & 3) << 6) | (((lane >> 4) & 1) << 5) | (((lane >> 5) & 1) << 8); }
constexpr int v_rd_off(int d0, int ks, int half) { return d0 * 512 + ks * 2048 + half * 1024; }
struct KPre { bf16x8 a0, b0, a1, b1; };
#define KLDX(KS, D0, A, B) do { A = *(const ATT_LAS bf16x8*)((KS) + KSWZ(r32, ((D0) * 16 + hi * 8) * 2)); B = *(const ATT_LAS bf16x8*)((KS) + KSWZ(32 + r32, ((D0) * 16 + hi * 8) * 2)); } while (0)
#define VLD(D0, KS_, H) __builtin_amdgcn_ds_read_tr16_b64_v4i16((ATT_LAS s16x4*)(vbp + VO + v_rd_off(D0, KS_, H)))
#define PK(L, H) (bf16x8){L[0], L[1], L[2], L[3], H[0], H[1], H[2], H[3]}
#define MFMA(A, B, C) __builtin_amdgcn_mfma_f32_32x32x16_bf16(A, B, C, 0, 0, 0)
template <int VO> __device__ __forceinline__ void region1(f32x16& n0, f32x16& n1, const f32x16& mC, const ATT_LAS unsigned char* Ks, const bf16x8* qr, int r32, int hi, const KPre& kp,
                                                          f32x16& p0, f32x16& p1, bf16x8& pa0, bf16x8& pa1, bf16x8& pa2, bf16x8& pa3, const ATT_LAS unsigned char* vbp, s16x4* vf) {
  bf16x8 kA[DQ / 16], kB[DQ / 16]; unsigned w[16]; kA[0] = kp.a0; kB[0] = kp.b0; kA[1] = kp.a1; kB[1] = kp.b1;
#define KLD(D0) KLDX(Ks, D0, kA[D0], kB[D0])
#define KMM(D0) do { n0 = MFMA(kA[D0], qr[D0], (D0) ? n0 : mC); n1 = MFMA(kB[D0], qr[D0], (D0) ? n1 : mC); } while (0)
#define EXP1(R) p1[R] = __builtin_amdgcn_exp2f(p1[R])
  KLD(2); KMM(0); EXP1(0); EXP1(1); EXP1(2); EXP1(3); EXP1(4); EXP1(5); w[0] = cvtpk(p0[0], p0[1]); w[1] = cvtpk(p0[2], p0[3]); SBAR();
  KLD(3); KMM(1); EXP1(6); EXP1(7); EXP1(8); EXP1(9); EXP1(10); EXP1(11); w[2] = cvtpk(p0[4], p0[5]); w[3] = cvtpk(p0[6], p0[7]); SBAR();
  KLD(4); KMM(2); EXP1(12); EXP1(13); EXP1(14); EXP1(15); w[4] = cvtpk(p0[8], p0[9]); w[5] = cvtpk(p0[10], p0[11]); w[6] = cvtpk(p0[12], p0[13]); w[7] = cvtpk(p0[14], p0[15]); SBAR();
  KLD(5); KMM(3); w[8] = cvtpk(p1[0], p1[1]); w[9] = cvtpk(p1[2], p1[3]); w[10] = cvtpk(p1[4], p1[5]); w[11] = cvtpk(p1[6], p1[7]); SBAR();
#pragma unroll
  for (int ks = 0; ks < 4; ++ks) { vf[2 * ks] = VLD(0, ks, 0); vf[2 * ks + 1] = VLD(0, ks, 1); }
  KMM(4); w[12] = cvtpk(p1[8], p1[9]); w[13] = cvtpk(p1[10], p1[11]); w[14] = cvtpk(p1[12], p1[13]); w[15] = cvtpk(p1[14], p1[15]); SBAR();
  KMM(5);
#undef KLD
#undef KMM
#undef EXP1
  { const u32x4 a = {w[0], w[1], w[2], w[3]}, b = {w[4], w[5], w[6], w[7]}, c = {w[8], w[9], w[10], w[11]}, d = {w[12], w[13], w[14], w[15]};
    pa0 = __builtin_bit_cast(bf16x8, a); pa1 = __builtin_bit_cast(bf16x8, b); pa2 = __builtin_bit_cast(bf16x8, c); pa3 = __builtin_bit_cast(bf16x8, d); }
}
template <int VO> __device__ __forceinline__ void region2(f32x16* o, const s16x4* vf, const ATT_LAS unsigned char* vbp, bf16x8 pa0, bf16x8 pa1, bf16x8 pa2, bf16x8 pa3, bf16x8 ones,
                                                          f32x16& n0, f32x16& n1, f32x16& mC, float& alpha) {
  s16x4 vg[8];
#pragma unroll
  for (int ks = 0; ks < 4; ++ks) { vg[2 * ks] = VLD(1, ks, 0); vg[2 * ks + 1] = VLD(1, ks, 1); }
#define MX3(A, P, R) A = fmaxf(fmaxf(A, P[R]), P[R + 1])
  o[0] = MFMA(pa0, PK(vf[0], vf[1]), o[0]); o[2] = MFMA(pa0, ones, o[2]); SBAR();
  float ma = fmaxf(n0[0], n0[1]), mb = fmaxf(n1[0], n1[1]);
  o[0] = MFMA(pa1, PK(vf[2], vf[3]), o[0]); o[2] = MFMA(pa1, ones, o[2]); MX3(ma, n0, 2); MX3(mb, n1, 2); MX3(ma, n0, 4); MX3(mb, n1, 4); SBAR();
  o[0] = MFMA(pa2, PK(vf[4], vf[5]), o[0]); o[2] = MFMA(pa2, ones, o[2]); MX3(ma, n0, 6); MX3(mb, n1, 6); MX3(ma, n0, 8); MX3(mb, n1, 8); MX3(ma, n0, 10); MX3(mb, n1, 10); SBAR();
  o[0] = MFMA(pa3, PK(vf[6], vf[7]), o[0]); o[2] = MFMA(pa3, ones, o[2]); MX3(ma, n0, 12); MX3(mb, n1, 12); MX3(ma, n0, 14); MX3(mb, n1, 14);
  float pmax = fmaxf(ma, mb);
  { auto rr = __builtin_amdgcn_permlane32_swap(__float_as_uint(pmax), __float_as_uint(pmax), false, false);
    pmax = fmaxf(__uint_as_float(rr[0]), __uint_as_float(rr[1])); }
  if (__builtin_expect(__all(pmax <= THR2), 1)) alpha = 1.f;
  else { const float d = fmaxf(pmax, 0.f); alpha = __builtin_amdgcn_exp2f(-d);
#pragma unroll
    for (int r = 0; r < 16; ++r) { n0[r] -= d; n1[r] -= d; mC[r] -= d; } }
#define EXP4(R) do { float e0 = __builtin_amdgcn_exp2f(n0[R]), e1 = __builtin_amdgcn_exp2f(n0[R + 1]), e2 = __builtin_amdgcn_exp2f(n0[R + 2]), e3 = __builtin_amdgcn_exp2f(n0[R + 3]); \
    asm volatile("" : "+v"(e0), "+v"(e1), "+v"(e2), "+v"(e3)); n0[R] = e0; n0[R + 1] = e1; n0[R + 2] = e2; n0[R + 3] = e3; } while (0)
  SBAR(); o[1] = MFMA(pa0, PK(vg[0], vg[1]), o[1]); EXP4(0); SBAR();
  o[1] = MFMA(pa1, PK(vg[2], vg[3]), o[1]); EXP4(4); SBAR();
  o[1] = MFMA(pa2, PK(vg[4], vg[5]), o[1]); EXP4(8); SBAR();
  o[1] = MFMA(pa3, PK(vg[6], vg[7]), o[1]); EXP4(12);
#undef EXP4
#undef MX3
}
template <int VO> __device__ __forceinline__ void pv_last(f32x16* o, const ATT_LAS unsigned char* vbp, bf16x8 pa0, bf16x8 pa1, bf16x8 pa2, bf16x8 pa3, bf16x8 ones) {
  s16x4 vf[8], vg[8];
#pragma unroll
  for (int ks = 0; ks < 4; ++ks) { vf[2 * ks] = VLD(0, ks, 0); vf[2 * ks + 1] = VLD(0, ks, 1); vg[2 * ks] = VLD(1, ks, 0); vg[2 * ks + 1] = VLD(1, ks, 1); }
  o[0] = MFMA(pa0, PK(vf[0], vf[1]), o[0]); o[1] = MFMA(pa0, PK(vg[0], vg[1]), o[1]); o[2] = MFMA(pa0, ones, o[2]);
  o[0] = MFMA(pa1, PK(vf[2], vf[3]), o[0]); o[1] = MFMA(pa1, PK(vg[2], vg[3]), o[1]); o[2] = MFMA(pa1, ones, o[2]);
  o[0] = MFMA(pa2, PK(vf[4], vf[5]), o[0]); o[1] = MFMA(pa2, PK(vg[4], vg[5]), o[1]); o[2] = MFMA(pa2, ones, o[2]);
  o[0] = MFMA(pa3, PK(vf[6], vf[7]), o[0]); o[1] = MFMA(pa3, PK(vg[6], vg[7]), o[1]); o[2] = MFMA(pa3, ones, o[2]);
}
#undef VLD
#undef PK
#undef MFMA

__device__ __forceinline__ void attn_unit(const unsigned short* Qb_, const unsigned short* Kn_, const unsigned short* Kr_, const unsigned short* Vc_, int ra, int nt_a, int rb, int NT,
                                          unsigned short* Ob_, ATT_LAS unsigned char* lds, int rope_t0) {
  gcp Qb = (gcp)Qb_, Kn = (gcp)Kn_, Kr = (gcp)Kr_, Vc = (gcp)Vc_; gp Ob = (gp)Ob_;
  const int tid = threadIdx.x, wid = tid >> 6, lane = tid & 63, r32 = lane & 31, hi = lane >> 5;
  ATT_LAS unsigned char* V_lds = lds + OFF_V; ATT_LAS unsigned char* K_lds = lds + OFF_K;
  ATT_LAS float* wsp = (ATT_LAS float*)(lds + OFF_WS) + wid * 64; ATT_LAS float* al_l = wsp + 32;
  f32x16 o[3] = {}, mC = {}; bf16x8 qr[DQ / 16]; const u32x4 ones_w = {0x3f803f80u, 0x3f803f80u, 0x3f803f80u, 0x3f803f80u}; const bf16x8 ones = __builtin_bit_cast(bf16x8, ones_w);
  const int sk = tid >> 3, sc = (tid & 7) * 8, rk = (tid & 255) >> 2, rc = (tid & 3) * 8; const bool rw = tid < 256;
  const int vst = v_st(sk, sc), kst0 = KSWZ(sk, sc * 2), kst1 = KSWZ(rk, (64 + rc) * 2);
  struct SR { bf16x8 vs, k0, k1; };
#define TROW(t) ((t) < nt_a ? ra + (t) * KVBLK : rb + ((t) - nt_a) * KVBLK)
#define SLOADX(S, t) do { const long r0_ = TROW(t); S.vs = *(const __attribute__((address_space(1))) bf16x8*)(Vc + (r0_ + sk) * LDV + sc); S.k0 = *(const __attribute__((address_space(1))) bf16x8*)(Kn + (r0_ + sk) * LDKN + sc); \
    S.k1 = *(const __attribute__((address_space(1))) bf16x8*)(Kr + (r0_ + rk) * LDKR + rc); } while (0)
#define SWRITEX(b, S) do { *(ATT_LAS bf16x8*)(V_lds + (b) * SHM_V + vst) = S.vs; *(ATT_LAS bf16x8*)(K_lds + (b) * SHM_K + kst0) = S.k0; \
    if (rw) *(ATT_LAS bf16x8*)(K_lds + (b) * SHM_K + kst1) = S.k1; } while (0)
  SR s0_, s1_, sr_; SLOADX(s0_, 0); SLOADX(s1_, 1); SLOADX(sr_, 2);
  gcp Qw = Qb + (long)(wid * QBLK + r32) * LDQ + hi * 8;
#pragma unroll
  for (int d0 = 0; d0 < DQ / 16; ++d0) qr[d0] = *(const __attribute__((address_space(1))) bf16x8*)(Qw + d0 * 16);
  if (rope_t0 >= 0) {
    int t = rope_t0 + wid * QBLK + r32; asm volatile("" : "+v"(t));
    const float prow = (float)(t >> 6), pcol = (float)(t & 63);
#pragma unroll
    for (int f = 0; f < 2; ++f) { const u32x4 own = __builtin_bit_cast(u32x4, qr[4 + f]); u32x4 oth;
      oth.x = (unsigned)__shfl_xor((int)own.x, 32); oth.y = (unsigned)__shfl_xor((int)own.y, 32); oth.z = (unsigned)__shfl_xor((int)own.z, 32); oth.w = (unsigned)__shfl_xor((int)own.w, 32);
      const float pos = f ? pcol : prow; float o8[8];
#pragma unroll
      for (int j = 0; j < 8; ++j) { const unsigned wo = (j < 2) ? own.x : (j < 4) ? own.y : (j < 6) ? own.z : own.w, wp = (j < 2) ? oth.x : (j < 4) ? oth.y : (j < 6) ? oth.z : oth.w;
        const float a = (j & 1) ? __uint_as_float(wo & 0xffff0000u) : __uint_as_float(wo << 16), bq = (j & 1) ? __uint_as_float(wp & 0xffff0000u) : __uint_as_float(wp << 16);
        const float ang = pos * __builtin_amdgcn_exp2f(-(float)j * (13.287712379549449f / 8.0f)); float sn, cs; __sincosf(ang, &sn, &cs);
        o8[j] = hi ? (a * cs + bq * sn) : (a * cs - bq * sn); }
      u32x4 w = {cvtpk(o8[0], o8[1]), cvtpk(o8[2], o8[3]), cvtpk(o8[4], o8[5]), cvtpk(o8[6], o8[7])}; qr[4 + f] = __builtin_bit_cast(bf16x8, w); } }
#pragma unroll
  for (int d0 = 0; d0 < DQ / 16; ++d0) { const u32x4 w = __builtin_bit_cast(u32x4, qr[d0]); u32x4 q;
#pragma unroll
    for (int i = 0; i < 4; ++i) q[i] = cvtpk(__uint_as_float(w[i] << 16) * QSC, __uint_as_float(w[i] & 0xffff0000u) * QSC);
    qr[d0] = __builtin_bit_cast(bf16x8, q); }
#define SLOAD(t) SLOADX(sr_, t)
#define SWRITE(b) SWRITEX(b, sr_)
#define SWAIT() asm volatile("s_waitcnt vmcnt(0)" ::: "memory")
#define BAR() asm volatile("s_barrier" ::: "memory")
#define RESC(a) do { if (__any((a) < 1.f)) { if (hi == 0) al_l[r32] = (a); asm volatile("s_waitcnt lgkmcnt(0)" ::: "memory"); \
    _Pragma("unroll") for (int d = 0; d < 3; ++d) _Pragma("unroll") for (int r = 0; r < 16; ++r) o[d][r] *= al_l[crow(r, hi)]; } } while (0)
#define KPRE(KB) do { KLDX(K_lds + (KB) * SHM_K, 0, kp.a0, kp.b0); KLDX(K_lds + (KB) * SHM_K, 1, kp.a1, kp.b1); } while (0)
  f32x16 pA0, pA1, pB0, pB1; float alA, alB; bf16x8 pa0, pa1, pa2, pa3; KPre kp; s16x4 vf[8];
  const ATT_LAS unsigned char* vbp = V_lds + v_rd_base(lane);
  SWAIT(); SWRITEX(0, s0_); SWRITEX(1, s1_); SWRITE(2); SLOAD(3); __syncthreads();
  qkt(pA0, pA1, mC, K_lds, qr, r32, hi); partialSM<true>(pA0, pA1, mC, alA);
  KPRE(1); BAR();
#define STEP(PN0, PN1, ALN, PO0, PO1, KB, VB, T, WR, LD, NX) do { \
    SBAR(); if (WR) { SWAIT(); SWRITE(((KB) + 2) & 3); } if (LD) SLOAD((T) + 3); SBAR(); \
    region1<(VB) * SHM_V>(PN0, PN1, mC, K_lds + (KB) * SHM_K, qr, r32, hi, kp, PO0, PO1, pa0, pa1, pa2, pa3, vbp, vf); SBAR(); \
    region2<(VB) * SHM_V>(o, vf, vbp, pa0, pa1, pa2, pa3, ones, PN0, PN1, mC, ALN); SBAR(); \
    if (NX) KPRE(((KB) + 1) & 3); RESC(ALN); BAR(); } while (0)
  int j = 1;
  for (; j + 3 < NT; j += 4) {
    STEP(pB0, pB1, alB, pA0, pA1, 1, 0, j, true, true, true);
    STEP(pA0, pA1, alA, pB0, pB1, 2, 1, j + 1, true, true, true);
    STEP(pB0, pB1, alB, pA0, pA1, 3, 2, j + 2, true, true, true);
    STEP(pA0, pA1, alA, pB0, pB1, 0, 3, j + 3, true, true, true);
  }
  STEP(pB0, pB1, alB, pA0, pA1, 1, 0, j, true, false, true);
  STEP(pA0, pA1, alA, pB0, pB1, 2, 1, j + 1, false, false, true);
  STEP(pB0, pB1, alB, pA0, pA1, 3, 2, j + 2, false, false, false);
  finishSM(pB0, pB1, pa0, pa1, pa2, pa3); SBAR();
  pv_last<3 * SHM_V>(o, vbp, pa0, pa1, pa2, pa3, ones);
  float rli[16];
#pragma unroll
  for (int r = 0; r < 16; ++r) rli[r] = __builtin_amdgcn_rcpf(o[2][r]);
  gp Ow = Ob + (long)(wid * QBLK) * LDO;
#pragma unroll
  for (int r = 0; r < 16; ++r) { const int orow = crow(r, hi);
#pragma unroll
    for (int d0 = 0; d0 < 2; ++d0) Ow[(long)orow * LDO + d0 * 32 + r32] = (unsigned short)(cvtpk(o[d0][r] * rli[r], 0.f) & 0xffffu); }
  asm volatile("s_waitcnt vmcnt(0)" ::: "memory");
  __syncthreads();
#undef TROW
#undef SLOAD
#undef SWRITE
#undef SLOADX
#undef SWRITEX
#undef STEP
#undef BAR
#undef KPRE
#undef SWAIT
#undef RESC
}
#undef KLDX
#undef KSWZ
#undef SBAR
}

namespace gla {
typedef short bf16x8 __attribute__((ext_vector_type(8)));
typedef short s16x4 __attribute__((ext_vector_type(4)));
typedef float f32x16 __attribute__((ext_vector_type(16)));
typedef float f32x4 __attribute__((ext_vector_type(4)));
typedef float f32x2 __attribute__((ext_vector_type(2)));
typedef __bf16 bf16x2_t __attribute__((ext_vector_type(2)));
typedef unsigned u32x4 __attribute__((ext_vector_type(4)));
typedef unsigned u32x2 __attribute__((ext_vector_type(2)));
#define GLA_LAS __attribute__((address_space(3)))
#define GLA_GAS __attribute__((address_space(1)))
constexpr int RS256 = 272, RS128 = 144;
constexpr int OFF_QT = 0, OFF_KT = 64 * RS256, OFF_KH = 2 * 64 * RS256, OFF_V = OFF_KH + 128 * RS128, OFF_P = OFF_V + 32768, OFF_TOT = OFF_P + 64 * RS128, OFF_EL = OFF_TOT + 2048, OFF_ZG = OFF_EL + 512, OFF_W2 = OFF_ZG + 4096, GLA_LDS = OFF_W2 + 8192;
static_assert(GLA_LDS <= 131072 && OFF_V % 16 == 0 && OFF_P % 16 == 0 && OFF_TOT % 16 == 0, "gla lds map");
__device__ __forceinline__ int swz256(int row, int colB) { return row * RS256 + colB; }
__device__ __forceinline__ int swz128(int row, int colB) { return row * RS128 + colB; }
__device__ __forceinline__ int crow(int r, int hi) { return (r & 3) + 8 * (r >> 2) + 4 * hi; }
__device__ __forceinline__ unsigned pk2f(float lo, float hi) { const f32x2 v = {lo, hi}; return __builtin_bit_cast(unsigned, __builtin_convertvector(v, bf16x2_t)); }
__device__ __forceinline__ unsigned short bf1f(float x) { return (unsigned short)(pk2f(x, 0.f) & 0xffffu); }
__device__ __forceinline__ float bfu(unsigned short u) { return __uint_as_float(((unsigned)u) << 16); }
__device__ __forceinline__ int v_st(int k, int c) { const int kk = (k & ~0xC) | ((k & 4) << 1) | ((k & 8) >> 1); return ((kk >> 3) * 8 + (c >> 5)) * 512 + ((kk & 7) * 32 + (c & 31)) * 2; }
__device__ __forceinline__ int v_rd_base(int lane) { return ((lane & 3) << 3) | (((lane >> 2) & 3) << 6) | (((lane >> 4) & 1) << 5) | (((lane >> 5) & 1) << 8); }
template <int OFF> __device__ __forceinline__ s16x4 tr_read(int vb) { s16x4 r; asm volatile("ds_read_b64_tr_b16 %0, %1 offset:%2" : "=&v"(r) : "v"(vb), "i"(OFF) : "memory"); return r; }
#define GLA_MFMA(a, b, c) __builtin_amdgcn_mfma_f32_32x32x16_bf16((a), (b), (c), 0, 0, 0)
__device__ __forceinline__ bf16x8 pack_step(const f32x16& x, int s) {
    u32x4 p; p.x = pk2f(x[8 * s], x[8 * s + 1]); p.y = pk2f(x[8 * s + 2], x[8 * s + 3]); p.z = pk2f(x[8 * s + 4], x[8 * s + 5]); p.w = pk2f(x[8 * s + 6], x[8 * s + 7]); return __builtin_bit_cast(bf16x8, p);
}
__device__ __forceinline__ void gla_prep(const unsigned short* QK_, const unsigned short* ZG_, const float* w2_, const float* b2_, unsigned short* TQ_, unsigned short* TK_, unsigned short* TP_, float* EL_,
                                         int b, int h, int dir, int c_lo, int c_hi, int ML_, int SEQ_, int CTX_, GLA_LAS unsigned char* lds) {
    const GLA_GAS unsigned short* QK = (const GLA_GAS unsigned short*)QK_; const GLA_GAS unsigned short* ZG = (const GLA_GAS unsigned short*)ZG_;
    const GLA_GAS float* w2g = (const GLA_GAS float*)w2_; const GLA_GAS float* b2g = (const GLA_GAS float*)b2_;
    const int tid = threadIdx.x, wid = __builtin_amdgcn_readfirstlane(tid >> 6), lane = tid & 63, r32 = lane & 31, hi = lane >> 5;
    const int seg = tid >> 7, kk = tid & 127;
    GLA_LAS unsigned char* QT = lds + OFF_QT; GLA_LAS unsigned char* KT = lds + OFF_KT;
    GLA_LAS float* TOT = (GLA_LAS float*)(lds + OFF_TOT); GLA_LAS float* ZGS = (GLA_LAS float*)(lds + OFF_ZG); GLA_LAS float* W2S = (GLA_LAS float*)(lds + OFF_W2);
    __syncthreads();
#pragma unroll
    for (int i = 0; i < 4; ++i) { const int idx = tid + 512 * i; W2S[idx] = w2g[(size_t)(dir * 16 + (idx >> 7)) * 512 + h * 128 + (idx & 127)]; }
    const float b2 = b2g[dir * 512 + h * 128 + kk];
    const int nctx = CTX_ / 64;
    unsigned raw[16], zgw;
#define GLA_PLOAD(cs_) do { const long r0_ = ((cs_) < nctx) ? (long)ML_ + (long)b * CTX_ + 64 * (cs_) : (long)b * SEQ_ + 64 * ((cs_) - nctx); \
        zgw = *(const GLA_GAS unsigned*)(ZG + (r0_ + (tid >> 3)) * 2304 + dir * 16 + (tid & 7) * 2); \
        _Pragma("unroll") for (int i_ = 0; i_ < 16; ++i_) { const GLA_GAS unsigned short* zr_ = QK + (r0_ + 16 * seg + i_) * 1024 + h * 128 + kk; raw[i_] = (unsigned)zr_[0] | ((unsigned)zr_[512] << 16); } } while (0)
    for (int cs = c_lo; cs < c_hi; ++cs) {
        GLA_PLOAD(cs);
        const size_t tile = (size_t)((b * 4 + h) * 2 + dir) * 36 + cs;
        GLA_GAS unsigned short* TQ = (GLA_GAS unsigned short*)TQ_ + tile * 8192; GLA_GAS unsigned short* TK = (GLA_GAS unsigned short*)TK_ + tile * 8192; GLA_GAS unsigned short* TP = (GLA_GAS unsigned short*)TP_ + tile * 4096;
        { const int l = tid >> 3, r2 = (tid & 7) * 2; ZGS[l * 16 + r2] = __uint_as_float(zgw << 16); ZGS[l * 16 + r2 + 1] = __uint_as_float(zgw & 0xffff0000u); }
        __syncthreads();
        float cum[16];
#pragma unroll
        for (int i = 0; i < 16; ++i) cum[i] = b2;
#pragma unroll
        for (int q = 0; q < 4; ++q) { const float wa = W2S[(4 * q) * 128 + kk], wb = W2S[(4 * q + 1) * 128 + kk], wc_ = W2S[(4 * q + 2) * 128 + kk], wd = W2S[(4 * q + 3) * 128 + kk];
#pragma unroll
            for (int i = 0; i < 16; ++i) { const f32x4 z = *(const GLA_LAS f32x4*)(ZGS + (16 * seg + i) * 16 + 4 * q); cum[i] += z.x * wa + z.y * wb + z.z * wc_ + z.w * wd; } }
#pragma unroll
        for (int i = 0; i < 16; ++i) { const float x = cum[i]; cum[i] = (fminf(x, 0.f) - __logf(1.0f + __expf(-fabsf(x)))) * (1.0f / 16.0f); }
        if (dir == 0) {
#pragma unroll
            for (int i = 1; i < 16; ++i) cum[i] += cum[i - 1];
            TOT[seg * 128 + kk] = cum[15];
        } else {
#pragma unroll
            for (int i = 14; i >= 0; --i) cum[i] += cum[i + 1];
            TOT[seg * 128 + kk] = cum[0];
        }
        __syncthreads();
        { const float t0 = TOT[kk], t1 = TOT[128 + kk], t2 = TOT[256 + kk], t3 = TOT[384 + kk]; const float last = (t0 + t1) + (t2 + t3);
          float off;
          if (dir == 0) off = (seg > 0 ? t0 : 0.f) + (seg > 1 ? t1 : 0.f) + (seg > 2 ? t2 : 0.f);
          else off = (seg < 3 ? t3 : 0.f) + (seg < 2 ? t2 : 0.f) + (seg < 1 ? t1 : 0.f);
          if (seg == 0) ((GLA_GAS float*)EL_)[tile * 128 + kk] = __expf(last);
          unsigned ktp[8];
#pragma unroll
          for (int i = 0; i < 16; i += 2) {
              const float c0 = cum[i] + off, c1 = cum[i + 1] + off; const int l0 = 16 * seg + i, l1 = l0 + 1;
              const float q0 = __uint_as_float(raw[i] << 16), k0v = __uint_as_float(raw[i] & 0xffff0000u), q1 = __uint_as_float(raw[i + 1] << 16), k1v = __uint_as_float(raw[i + 1] & 0xffff0000u);
              const unsigned short qa = bf1f(q0 * __expf(c0)), qb = bf1f(q1 * __expf(c1)); const float ka = k0v * __expf(-c0), kb = k1v * __expf(-c1); const unsigned kp = pk2f(ka, kb);
              *(GLA_LAS unsigned short*)(QT + swz256(l0, 2 * kk)) = qa; *(GLA_LAS unsigned short*)(QT + swz256(l1, 2 * kk)) = qb;
              *(GLA_LAS unsigned short*)(KT + swz256(l0, 2 * kk)) = (unsigned short)(kp & 0xffffu); *(GLA_LAS unsigned short*)(KT + swz256(l1, 2 * kk)) = (unsigned short)(kp >> 16);
              TQ[l0 * 128 + kk] = qa; TQ[l1 * 128 + kk] = qb; ktp[i >> 1] = kp; }
          u32x4 k0 = {ktp[0], ktp[1], ktp[2], ktp[3]}, k1 = {ktp[4], ktp[5], ktp[6], ktp[7]};
          *(GLA_GAS u32x4*)(TK + kk * 64 + 16 * seg) = k0; *(GLA_GAS u32x4*)(TK + kk * 64 + 16 * seg + 8) = k1; }
        __syncthreads();
        if (wid < 4) { const int mi = wid >> 1, li = wid & 1; f32x16 x = f32x16{};
#pragma unroll
            for (int s2 = 0; s2 < 8; ++s2) { const int cb = (16 * s2 + 8 * hi) * 2;
                const bf16x8 a = *(const GLA_LAS bf16x8*)(KT + swz256(32 * mi + r32, cb)); const bf16x8 bq = *(const GLA_LAS bf16x8*)(QT + swz256(32 * li + r32, cb)); x = GLA_MFMA(a, bq, x); }
            const int l = 32 * li + r32;
#pragma unroll
            for (int g = 0; g < 4; ++g) { float v[4];
#pragma unroll
                for (int j = 0; j < 4; ++j) { const int m = 32 * mi + 8 * g + 4 * hi + j; const bool keep = (dir == 0) ? (m <= l) : (m >= l); v[j] = keep ? x[4 * g + j] : 0.f; }
                u32x2 w; w.x = pk2f(v[0], v[1]); w.y = pk2f(v[2], v[3]); *(GLA_GAS u32x2*)(TP + l * 64 + 32 * mi + 8 * g + 4 * hi) = w; } }
    }
#undef GLA_PLOAD
    __syncthreads();
}
__device__ __forceinline__ void gla_chain(const unsigned short* VR_, const unsigned short* TQ_, const unsigned short* TK_, const unsigned short* TP_, const float* EL_, unsigned short* O_, int b, int h, int dir,
                                          int ML_, int SEQ_, int CTX_, GLA_LAS unsigned char* lds) {
    const GLA_GAS unsigned short* VR = (const GLA_GAS unsigned short*)VR_; GLA_GAS unsigned short* O = (GLA_GAS unsigned short*)O_;
    const int tid = threadIdx.x, wid = __builtin_amdgcn_readfirstlane(tid >> 6), lane = tid & 63, r32 = lane & 31, hi = lane >> 5;
    GLA_LAS unsigned char* QT = lds + OFF_QT; GLA_LAS unsigned char* KH = lds + OFF_KH; GLA_LAS unsigned char* VI = lds + OFF_V; GLA_LAS unsigned char* PI = lds + OFF_P; GLA_LAS float* EL = (GLA_LAS float*)(lds + OFF_EL);
    f32x16 S[4];
#pragma unroll
    for (int t = 0; t < 4; ++t) S[t] = f32x16{};
    const int vb = (int)(unsigned)(uintptr_t)VI + v_rd_base(lane) + wid * 512;
    const int nchunk = (CTX_ + SEQ_) / 64, nctx = CTX_ / 64;
    const size_t tile0 = (size_t)((b * 4 + h) * 2 + dir) * 36;
    u32x4 pq[2], pk[2], pp, pv[4]; float pe = 0.f;
#define GLA_CS(sc_) ((dir == 0) ? (sc_) : (((sc_) < nctx) ? (nctx - 1 - (sc_)) : (nchunk - 1 - ((sc_) - nctx))))
#define GLA_FETCH(sc_) do { const int cs_ = GLA_CS(sc_); const size_t t_ = tile0 + cs_; const long r0_ = (cs_ < nctx) ? (long)ML_ + (long)b * CTX_ + 64 * cs_ : (long)b * SEQ_ + 64 * (cs_ - nctx); \
        const GLA_GAS u32x4* q_ = (const GLA_GAS u32x4*)((const GLA_GAS unsigned short*)TQ_ + t_ * 8192); const GLA_GAS u32x4* k_ = (const GLA_GAS u32x4*)((const GLA_GAS unsigned short*)TK_ + t_ * 8192); \
        pq[0] = q_[tid]; pq[1] = q_[tid + 512]; pk[0] = k_[tid]; pk[1] = k_[tid + 512]; pp = ((const GLA_GAS u32x4*)((const GLA_GAS unsigned short*)TP_ + t_ * 4096))[tid]; \
        if (tid < 128) pe = ((const GLA_GAS float*)EL_)[t_ * 128 + tid]; \
        _Pragma("unroll") for (int i_ = 0; i_ < 4; ++i_) { const int c_ = tid + 512 * i_; pv[i_] = *(const GLA_GAS u32x4*)(VR + (r0_ + (c_ >> 5)) * 2304 + h * 256 + (c_ & 31) * 8); } } while (0)
    GLA_FETCH(0);
    for (int sc = 0; sc < nchunk; ++sc) {
        const int cs = GLA_CS(sc); const bool is_lat = cs >= nctx; const long row0 = is_lat ? (long)b * SEQ_ + 64 * (cs - nctx) : (long)ML_ + (long)b * CTX_ + 64 * cs;
#pragma unroll
        for (int i = 0; i < 2; ++i) { const int c = tid + 512 * i; *(GLA_LAS u32x4*)(QT + (c >> 4) * RS256 + (c & 15) * 16) = pq[i]; *(GLA_LAS u32x4*)(KH + (c >> 3) * RS128 + (c & 7) * 16) = pk[i]; }
        *(GLA_LAS u32x4*)(PI + (tid >> 3) * RS128 + (tid & 7) * 16) = pp;
        if (tid < 128) EL[tid] = pe;
#pragma unroll
        for (int i = 0; i < 4; ++i) { const int c = tid + 512 * i; *(GLA_LAS u32x4*)(VI + v_st(c >> 5, (c & 31) * 8)) = pv[i]; }
        __syncthreads();
        if (sc + 1 < nchunk) GLA_FETCH(sc + 1);
        f32x16 o[2] = {f32x16{}, f32x16{}};
#pragma unroll
        for (int kt = 0; kt < 4; ++kt)
#pragma unroll
            for (int s2 = 0; s2 < 2; ++s2) { const bf16x8 bs = pack_step(S[kt], s2); const int cb0 = (32 * kt + 16 * s2 + 4 * hi) * 2;
#pragma unroll
                for (int rb = 0; rb < 2; ++rb) { const int l = 32 * rb + r32;
                    const s16x4 a0 = *(const GLA_LAS s16x4*)(QT + swz256(l, cb0)), a1 = *(const GLA_LAS s16x4*)(QT + swz256(l, cb0 + 16));
                    const bf16x8 a = {a0[0], a0[1], a0[2], a0[3], a1[0], a1[1], a1[2], a1[3]}; o[rb] = GLA_MFMA(a, bs, o[rb]); } }
        bf16x8 vf[4];
        { const s16x4 l0 = tr_read<0 * 8192>(vb), h0 = tr_read<0 * 8192 + 4096>(vb), l1 = tr_read<1 * 8192>(vb), h1 = tr_read<1 * 8192 + 4096>(vb);
          const s16x4 l2 = tr_read<2 * 8192>(vb), h2 = tr_read<2 * 8192 + 4096>(vb), l3 = tr_read<3 * 8192>(vb), h3 = tr_read<3 * 8192 + 4096>(vb);
          asm volatile("s_waitcnt lgkmcnt(0)" ::: "memory"); __builtin_amdgcn_sched_barrier(0);
          vf[0] = (bf16x8){l0[0], l0[1], l0[2], l0[3], h0[0], h0[1], h0[2], h0[3]}; vf[1] = (bf16x8){l1[0], l1[1], l1[2], l1[3], h1[0], h1[1], h1[2], h1[3]};
          vf[2] = (bf16x8){l2[0], l2[1], l2[2], l2[3], h2[0], h2[1], h2[2], h2[3]}; vf[3] = (bf16x8){l3[0], l3[1], l3[2], l3[3], h3[0], h3[1], h3[2], h3[3]}; }
#pragma unroll
        for (int rb = 0; rb < 2; ++rb)
#pragma unroll
            for (int ks = 0; ks < 4; ++ks) { const bf16x8 a = *(const GLA_LAS bf16x8*)(PI + swz128(32 * rb + r32, (16 * ks + 8 * hi) * 2)); o[rb] = GLA_MFMA(a, vf[ks], o[rb]); }
        if (is_lat) {
#pragma unroll
            for (int rb = 0; rb < 2; ++rb)
#pragma unroll
                for (int r = 0; r < 16; ++r) O[(row0 + 32 * rb + crow(r, hi)) * 1024 + h * 256 + 32 * wid + r32] = bf1f(o[rb][r]); }
#pragma unroll
        for (int kt = 0; kt < 4; ++kt) {
#pragma unroll
            for (int ks = 0; ks < 4; ++ks) { const bf16x8 a = *(const GLA_LAS bf16x8*)(KH + swz128(32 * kt + r32, (16 * ks + 8 * hi) * 2)); S[kt] = GLA_MFMA(a, vf[ks], S[kt]); }
#pragma unroll
            for (int r = 0; r < 16; ++r) S[kt][r] *= EL[32 * kt + crow(r, hi)]; }
        __syncthreads();
    }
#undef GLA_FETCH
#undef GLA_CS
}
__device__ __forceinline__ int v_st4(int k, int c) { const int kk = (k & ~0xC) | ((k & 4) << 1) | ((k & 8) >> 1); return ((kk >> 3) * 4 + (c >> 5)) * 512 + ((kk & 7) * 32 + (c & 31)) * 2; }
constexpr int OFF_XO_A = OFF_KT, OFF_XO_B = OFF_V + 16384;
static_assert(OFF_XO_A + 16384 <= OFF_KH && OFF_XO_B + 16384 <= OFF_P, "gla chain2 lds map");
__device__ __forceinline__ void gla_chain2(const unsigned short* VR_, const unsigned short* TQ_, const unsigned short* TK_, const unsigned short* TP_, const float* EL_, unsigned short* O_, int b, int h, int dir, int vh,
                                           int ML_, int SEQ_, int CTX_, GLA_LAS unsigned char* lds) {
    const GLA_GAS unsigned short* VR = (const GLA_GAS unsigned short*)VR_; GLA_GAS unsigned short* O = (GLA_GAS unsigned short*)O_;
    const int tid = threadIdx.x, wid = __builtin_amdgcn_readfirstlane(tid >> 6), lane = tid & 63, r32 = lane & 31, hi = lane >> 5;
    const int vt = wid & 3, kh = wid >> 2;
    GLA_LAS unsigned char* QT = lds + OFF_QT; GLA_LAS unsigned char* KH = lds + OFF_KH; GLA_LAS unsigned char* VI = lds + OFF_V; GLA_LAS unsigned char* PI = lds + OFF_P; GLA_LAS float* EL = (GLA_LAS float*)(lds + OFF_EL);
    GLA_LAS f32x4* XOs = (GLA_LAS f32x4*)(lds + (wid < 4 ? OFF_XO_A + wid * 4096 : OFF_XO_B + (wid - 4) * 4096));
    GLA_LAS f32x4* XOr = (GLA_LAS f32x4*)(lds + ((wid ^ 4) < 4 ? OFF_XO_A + (wid ^ 4) * 4096 : OFF_XO_B + ((wid ^ 4) - 4) * 4096));
    f32x16 S[2] = {f32x16{}, f32x16{}};
    const int vb = (int)(unsigned)(uintptr_t)VI + v_rd_base(lane) + vt * 512;
    const int nchunk = (CTX_ + SEQ_) / 64, nctx = CTX_ / 64;
    const size_t tile0 = (size_t)((b * 4 + h) * 2 + dir) * 36;
    u32x4 pq[2], pk[2], pp, pv[2]; float pe = 0.f;
#define GLA_CS(sc_) ((dir == 0) ? (sc_) : (((sc_) < nctx) ? (nctx - 1 - (sc_)) : (nchunk - 1 - ((sc_) - nctx))))
#define GLA_FETCH(sc_) do { const int cs_ = GLA_CS(sc_); const size_t t_ = tile0 + cs_; const long r0_ = (cs_ < nctx) ? (long)ML_ + (long)b * CTX_ + 64 * cs_ : (long)b * SEQ_ + 64 * (cs_ - nctx); \
        const GLA_GAS u32x4* q_ = (const GLA_GAS u32x4*)((const GLA_GAS unsigned short*)TQ_ + t_ * 8192); const GLA_GAS u32x4* k_ = (const GLA_GAS u32x4*)((const GLA_GAS unsigned short*)TK_ + t_ * 8192); \
        pq[0] = q_[tid]; pq[1] = q_[tid + 512]; pk[0] = k_[tid]; pk[1] = k_[tid + 512]; pp = ((const GLA_GAS u32x4*)((const GLA_GAS unsigned short*)TP_ + t_ * 4096))[tid]; \
        if (tid < 128) pe = ((const GLA_GAS float*)EL_)[t_ * 128 + tid]; \
        _Pragma("unroll") for (int i_ = 0; i_ < 2; ++i_) { const int c_ = tid + 512 * i_; pv[i_] = *(const GLA_GAS u32x4*)(VR + (r0_ + (c_ >> 4)) * 2304 + h * 256 + vh * 128 + (c_ & 15) * 8); } } while (0)
    GLA_FETCH(0);
    for (int sc = 0; sc < nchunk; ++sc) {
        const int cs = GLA_CS(sc); const bool is_lat = cs >= nctx; const long row0 = is_lat ? (long)b * SEQ_ + 64 * (cs - nctx) : (long)ML_ + (long)b * CTX_ + 64 * cs;
#pragma unroll
        for (int i = 0; i < 2; ++i) { const int c = tid + 512 * i; *(GLA_LAS u32x4*)(QT + (c >> 4) * RS256 + (c & 15) * 16) = pq[i]; *(GLA_LAS u32x4*)(KH + (c >> 3) * RS128 + (c & 7) * 16) = pk[i];
            *(GLA_LAS u32x4*)(VI + v_st4(c >> 4, (c & 15) * 8)) = pv[i]; }
        *(GLA_LAS u32x4*)(PI + (tid >> 3) * RS128 + (tid & 7) * 16) = pp;
        if (tid < 128) EL[tid] = pe;
        __syncthreads();
        if (sc + 1 < nchunk) GLA_FETCH(sc + 1);
        f32x16 op[2] = {f32x16{}, f32x16{}};
#pragma unroll
        for (int j = 0; j < 2; ++j)
#pragma unroll
            for (int s2 = 0; s2 < 2; ++s2) { const bf16x8 bs = pack_step(S[j], s2); const int cb0 = (32 * (2 * kh + j) + 16 * s2 + 4 * hi) * 2;
#pragma unroll
                for (int rb = 0; rb < 2; ++rb) { const int l = 32 * rb + r32;
                    const s16x4 a0 = *(const GLA_LAS s16x4*)(QT + swz256(l, cb0)), a1 = *(const GLA_LAS s16x4*)(QT + swz256(l, cb0 + 16));
                    const bf16x8 a = {a0[0], a0[1], a0[2], a0[3], a1[0], a1[1], a1[2], a1[3]}; op[rb] = GLA_MFMA(a, bs, op[rb]); } }
        { const f32x16& snd = kh ? op[0] : op[1];
#pragma unroll
          for (int g = 0; g < 4; ++g) XOs[g * 64 + lane] = (f32x4){snd[4 * g], snd[4 * g + 1], snd[4 * g + 2], snd[4 * g + 3]}; }
        __syncthreads();
        f32x16 o = kh ? op[1] : op[0];
#pragma unroll
        for (int g = 0; g < 4; ++g) { const f32x4 rv = XOr[g * 64 + lane]; o[4 * g] += rv.x; o[4 * g + 1] += rv.y; o[4 * g + 2] += rv.z; o[4 * g + 3] += rv.w; }
        bf16x8 vf[4];
        { const s16x4 l0 = tr_read<0 * 4096>(vb), h0 = tr_read<0 * 4096 + 2048>(vb), l1 = tr_read<1 * 4096>(vb), h1 = tr_read<1 * 4096 + 2048>(vb);
          const s16x4 l2 = tr_read<2 * 4096>(vb), h2 = tr_read<2 * 4096 + 2048>(vb), l3 = tr_read<3 * 4096>(vb), h3 = tr_read<3 * 4096 + 2048>(vb);
          asm volatile("s_waitcnt lgkmcnt(0)" ::: "memory"); __builtin_amdgcn_sched_barrier(0);
          vf[0] = (bf16x8){l0[0], l0[1], l0[2], l0[3], h0[0], h0[1], h0[2], h0[3]}; vf[1] = (bf16x8){l1[0], l1[1], l1[2], l1[3], h1[0], h1[1], h1[2], h1[3]};
          vf[2] = (bf16x8){l2[0], l2[1], l2[2], l2[3], h2[0], h2[1], h2[2], h2[3]}; vf[3] = (bf16x8){l3[0], l3[1], l3[2], l3[3], h3[0], h3[1], h3[2], h3[3]}; }
#pragma unroll
        for (int ks = 0; ks < 4; ++ks) { const bf16x8 a = *(const GLA_LAS bf16x8*)(PI + swz128(32 * kh + r32, (16 * ks + 8 * hi) * 2)); o = GLA_MFMA(a, vf[ks], o); }
        if (is_lat) {
#pragma unroll
            for (int r = 0; r < 16; ++r) O[(row0 + 32 * kh + crow(r, hi)) * 1024 + h * 256 + vh * 128 + 32 * vt + r32] = bf1f(o[r]); }
#pragma unroll
        for (int j = 0; j < 2; ++j) { const int kt = 2 * kh + j;
#pragma unroll
            for (int ks = 0; ks < 4; ++ks) { const bf16x8 a = *(const GLA_LAS bf16x8*)(KH + swz128(32 * kt + r32, (16 * ks + 8 * hi) * 2)); S[j] = GLA_MFMA(a, vf[ks], S[j]); }
#pragma unroll
            for (int r = 0; r < 16; ++r) S[j][r] *= EL[32 * kt + crow(r, hi)]; }
        __syncthreads();
    }
#undef GLA_FETCH
#undef GLA_CS
}
#undef GLA_MFMA
}

constexpr int NWAVES = 8;
constexpr int D = 1024, NB = 16, SEQ = 2048, CTXL = 256, TT = SEQ + CTXL;
constexpr int ML = NB * SEQ, MC = NB * CTXL, MA = ML + MC;
constexpr float EPS = 1e-6f;
constexpr int S5W = 512, S5G = 32, S5H = 16, S5P = 64;
constexpr int NH = 8, NOPE = 64, ROPE = 32, QK = 96, VD = 64, QRANK = 256, KVRANK = 128;
constexpr int EV_IN = 928, EV_INP = 1024, NQKV = 1792, KQKV = 384;
constexpr int GH = 4, GDK = 128, GDV = 256, GKEY = 512, GVAL = 1024, GRANK = 16;
constexpr int OD_IN = 3104, OD_INP = 3328;
constexpr int FFN = 2816, NE = 8, FE = 3584;
constexpr int MOE_MAXT = 264;

constexpr size_t MiB = 1u << 20;
constexpr size_t WS_CTL = 0, CTL_ZERO_BYTES = 1 * MiB;
constexpr size_t WS_MODV = 1 * MiB;
constexpr size_t WS_TOK = 2 * MiB;
constexpr size_t WS_INV = 3 * MiB;
constexpr size_t WS_W_IN1 = 4 * MiB, WS_W_OUT1 = 11 * MiB, WS_W_MGU = 13 * MiB  , WS_W_MDN = 69 * MiB  ;
constexpr size_t WS_W_IN0 = 97 * MiB, WS_W_QKV = 99 * MiB, WS_W_GLU = 100 * MiB + 512 * 1024, WS_W_OUT0 = 101 * MiB, WS_W_GU = 103 * MiB, WS_W_DN = 114 * MiB, WS_HC = 120 * MiB;
constexpr size_t PB = 136 * MiB;
constexpr size_t WS_XL = PB + 0 * MiB, WS_Q = PB + 0 * MiB, WS_A3 = PB + 72 * MiB, WS_YL = PB + 72 * MiB, WS_KV = PB + 144 * MiB, WS_Z0C = PB + 144 * MiB, WS_U = PB + 180 * MiB, WS_DS = PB + 216 * MiB, WS_AO = PB + 216 * MiB,
                 WS_QA = PB + 288 * MiB, WS_AG = PB + 288 * MiB, WS_KR = PB + 324 * MiB, WS_B1 = PB + 328 * MiB, WS_B3 = PB + 332 * MiB;
constexpr size_t WS_ACT = PB + 72 * MiB, WS_FL = PB + 270 * MiB;
constexpr size_t WS_TP = 97 * MiB, WS_EL = 133 * MiB, WS_OF = PB, WS_VR = 208 * MiB, WS_QK = 370 * MiB, WS_OB = 370 * MiB, WS_YL1 = 370 * MiB, WS_TQ = 442 * MiB, WS_TK = 514 * MiB;
constexpr int VRLD = 2304;
constexpr int GLA_TILES = NB * GH * 2 * 36;
constexpr int MOE_W_ITEMS = NE * (2 * (D / 64) * (FE / 32) + (FE / 64) * (D / 32));
constexpr int MW0 = 0, MW1 = (MOE_W_ITEMS * 20) / 100, MW2 = (MOE_W_ITEMS * 40) / 100, MW3 = (MOE_W_ITEMS * 54) / 100, MW4 = (MOE_W_ITEMS * 82) / 100, MW5 = MOE_W_ITEMS;
constexpr size_t WS_XLM = PB + 0 * MiB, WS_Y = PB + 0 * MiB, WS_XG = PB + 132 * MiB, WS_ACTM = PB + 198 * MiB;
constexpr size_t WS_END = 588 * MiB;
static_assert(WS_KR + (size_t)MA * 32 * 2 <= WS_B1 && WS_KV + (size_t)MA * 1024 * 2 <= WS_DS && WS_AG + (size_t)MA * 512 * 2 <= WS_KR && WS_AO + (size_t)MA * D * 2 <= WS_AG && WS_A3 + (size_t)MA * 1024 * 2 <= WS_KV &&
              WS_Z0C + (size_t)MA * 512 * 2 <= WS_U && WS_U + (size_t)MA * 512 * 2 <= WS_DS && WS_DS + (size_t)MA * 512 * 4 <= WS_QA && WS_QA + (size_t)MA * KQKV * 2 <= WS_KR && WS_B1 + (size_t)32 * 256 * 256 * 2 <= WS_B3 && WS_B3 + (size_t)32 * 256 * 512 * 2 <= WS_END, "ws map");
static_assert(WS_FL + (size_t)MA * D * 2 <= WS_END && WS_ACT + (size_t)MA * FFN * 2 <= WS_FL, "ws map 2");
static_assert(WS_TP + (size_t)GLA_TILES * 8192 <= WS_EL && WS_EL + (size_t)GLA_TILES * 512 <= PB && WS_XL + (size_t)MA * D * 2 <= WS_VR && WS_VR + (size_t)MA * VRLD * 2 <= WS_QK && WS_QK + (size_t)MA * 1024 * 2 <= WS_TQ &&
              WS_TQ + (size_t)GLA_TILES * 16384 <= WS_TK && WS_TK + (size_t)GLA_TILES * 16384 <= WS_END && WS_OF + (size_t)ML * D * 2 <= WS_VR && WS_OB + (size_t)ML * D * 2 <= WS_TQ, "ws map layer 1");
static_assert(WS_Y + (size_t)MOE_MAXT * 256 * D * 2 <= WS_XG && WS_XG + (size_t)MOE_MAXT * 256 * D <= WS_ACTM && WS_ACTM + (size_t)MOE_MAXT * 256 * FE <= WS_END && WS_XLM + (size_t)ML * D <= WS_XG, "ws map 3");
static_assert(WS_W_IN1 + (size_t)OD_INP * D * 2 <= WS_W_OUT1 && WS_W_OUT1 + (size_t)D * D * 2 <= WS_W_MGU && WS_W_MGU + (size_t)NE * 2 * FE * D <= WS_W_MDN && WS_W_MDN + (size_t)NE * D * FE <= WS_W_IN0 &&
              WS_W_GU + (size_t)2 * FFN * D * 2 <= WS_W_DN && WS_W_DN + (size_t)D * FFN * 2 <= WS_HC && WS_HC + (size_t)MC * D * 4 <= PB, "ws map 4");
#ifndef FFN0_FP8
#define FFN0_FP8 0
#endif
constexpr bool FFN0_IS_FP8 = FFN0_FP8;
#ifndef FFN0_DOWN_FP8
#define FFN0_DOWN_FP8 1
#endif
constexpr bool FFN0_DN_FP8 = FFN0_DOWN_FP8;
constexpr float FP8_SA = 8.0f, FP8_SW = 128.0f, FP8_SACT = 4.0f;

constexpr int CW_TMO = 0, CW_CODE = 1, CW_CNT = 64, CW_BAR = 4096;

constexpr int RING_OFF = 0, RING_BYTES = 131072;
constexpr int ATAB_OFF = RING_BYTES + 1024, ATAB_UNITS = 29;
constexpr int LDSCTL_OFF = RING_BYTES, MISC_OFF = LDSCTL_OFF + 320;
constexpr int LDS_BYTES = 147456;
static_assert(ATAB_OFF + ATAB_UNITS * 512 <= LDS_BYTES, "LDS map: row table");

struct Args { const float* in[35]; float* out; unsigned char* ws; int ph_lo, ph_hi; };
struct Frame { LAS unsigned char* lds; volatile LAS unsigned* MISC; gu32* ctl; int tid, lane, wave, G, gw, ngw; };

__device__ __forceinline__ float wave_sum(float v) {
#pragma unroll
    for (int o = 1; o < 64; o <<= 1) v += __shfl_xor(v, o);
    return v;
}
__device__ __forceinline__ float bf_lo(unsigned u) { return __uint_as_float(u << 16); }
__device__ __forceinline__ float bf_hi(unsigned u) { return __uint_as_float(u & 0xffff0000u); }
__device__ __forceinline__ float bf1(bf16 u) { return __uint_as_float(((unsigned)u) << 16); }
typedef unsigned v2u __attribute__((ext_vector_type(2)));
__device__ __forceinline__ unsigned pk4_fp8(float a, float b, float c, float d) { return pg8::pk4_fp8(a, b, c, d); }

__device__ __forceinline__ void ld_row_f32(const float* p, int lane, f32x4 (&v)[4]) {
    const GAS f32x4* q = (const GAS f32x4*)p + lane;
#pragma unroll
    for (int j = 0; j < 4; ++j) v[j] = q[64 * j];
}
__device__ __forceinline__ void st_row_f32(float* p, int lane, const f32x4 (&v)[4]) {
    GAS f32x4* q = (GAS f32x4*)p + lane;
#pragma unroll
    for (int j = 0; j < 4; ++j) q[64 * j] = v[j];
}
__device__ __forceinline__ void ld_row_bf16(const bf16* p, int lane, f32x4 (&v)[4]) {
    const GAS v2u* q = (const GAS v2u*)p + lane;
#pragma unroll
    for (int j = 0; j < 4; ++j) { const v2u w = q[64 * j]; v[j] = (f32x4){bf_lo(w.x), bf_hi(w.x), bf_lo(w.y), bf_hi(w.y)}; }
}
__device__ __forceinline__ void st_row_bf16(bf16* p, int lane, const f32x4 (&v)[4]) {
    GAS v2u* q = (GAS v2u*)p + lane;
#pragma unroll
    for (int j = 0; j < 4; ++j) { v2u w; w.x = pk2(v[j].x, v[j].y); w.y = pk2(v[j].z, v[j].w); q[64 * j] = w; }
}
__device__ __forceinline__ void st_row_fp8(unsigned char* p, int lane, const f32x4 (&v)[4], float sc) {
    GAS unsigned* q = (GAS unsigned*)p + lane;
#pragma unroll
    for (int j = 0; j < 4; ++j) q[64 * j] = pk4_fp8(v[j].x * sc, v[j].y * sc, v[j].z * sc, v[j].w * sc);
}
__device__ __forceinline__ float row_rs(const f32x4 (&v)[4]) {
    float s = 0.f;
#pragma unroll
    for (int j = 0; j < 4; ++j) s += (v[j].x * v[j].x + v[j].y * v[j].y) + (v[j].z * v[j].z + v[j].w * v[j].w);
    return rsqrtf(wave_sum(s) * (1.0f / D) + EPS);
}
__device__ __forceinline__ void norm_mod(f32x4 (&v)[4], const float* gam, const float* sh, const float* sc, int lane) {
    const float rs = row_rs(v); f32x4 g[4], a[4], b[4]; ld_row_f32(gam, lane, g); ld_row_f32(sh, lane, a); ld_row_f32(sc, lane, b);
#pragma unroll
    for (int j = 0; j < 4; ++j) v[j] = (v[j] * rs) * g[j] * (1.0f + b[j]) + a[j];
}
__device__ __forceinline__ void gated_add(f32x4 (&h)[4], const f32x4 (&y)[4], const float* gam, const float* gate, int lane) {
    const float rs = row_rs(y); f32x4 g[4], t[4]; ld_row_f32(gam, lane, g); ld_row_f32(gate, lane, t);
#pragma unroll
    for (int j = 0; j < 4; ++j) h[j] = h[j] + t[j] * ((y[j] * rs) * g[j]);
}

__device__ __forceinline__ void cvt_item(const float* W, int K, int N, bf16* WT, int ldk, int kcol0, int row_off, int mode, const float* gain, float scale, int nscale,
                                         LAS float* scr, int item, int lane, bool fp8 = false, bool tiled = false) {
    const int nblk = N / 32, kb = item / nblk, nb = item % nblk, k0 = 64 * kb, n0 = 32 * nb;
    { f32x4 t[8];
#pragma unroll
      for (int i = 0; i < 8; ++i) t[i] = *(const GAS f32x4*)(W + (size_t)(k0 + 8 * i + (lane >> 3)) * N + n0 + 4 * (lane & 7));
#pragma unroll
      for (int i = 0; i < 8; ++i) { LAS float* d = scr + (8 * i + (lane >> 3)) * 33 + 4 * (lane & 7); d[0] = t[i].x; d[1] = t[i].y; d[2] = t[i].z; d[3] = t[i].w; } }
    LDS_WAIT(); asm volatile("" ::: "memory");
    const int c = lane & 7;
    float gn[8];
#pragma unroll
    for (int q = 0; q < 8; ++q) gn[q] = (gain ? gain[k0 + 8 * c + q] : 1.0f) * ((n0 < nscale) ? scale : 1.0f);
    const int drow0 = (mode == 0) ? n0 : (mode == 3) ? ((n0 >> 7) * 64 + (n0 & 63) + ((n0 & 64) ? 512 : 0)) : ((n0 >> 7) * 256 + (n0 & 127) + (mode == 2 ? 128 : 0));
#pragma unroll
    for (int j = 0; j < 4; ++j) { const int n = (lane >> 3) + 8 * j; const LAS float* s = scr + (8 * c) * 33 + n;
        if (fp8) { v2u o; o.x = pk4_fp8(s[0 * 33] * gn[0], s[1 * 33] * gn[1], s[2 * 33] * gn[2], s[3 * 33] * gn[3]); o.y = pk4_fp8(s[4 * 33] * gn[4], s[5 * 33] * gn[5], s[6 * 33] * gn[6], s[7 * 33] * gn[7]);
            const int drow = row_off + drow0 + n, kc = kcol0 + k0 + 8 * c;
            unsigned char* dp = tiled ? (unsigned char*)WT + (size_t)(drow >> 8) * 256 * ldk + (size_t)(kc >> 7) * 32768 + (drow & 255) * 128 + (kc & 127) : (unsigned char*)WT + (size_t)drow * ldk + kc;
            *(GAS v2u*)dp = o; }
        else { v4u o; o.x = pk2(s[0 * 33] * gn[0], s[1 * 33] * gn[1]); o.y = pk2(s[2 * 33] * gn[2], s[3 * 33] * gn[3]); o.z = pk2(s[4 * 33] * gn[4], s[5 * 33] * gn[5]); o.w = pk2(s[6 * 33] * gn[6], s[7 * 33] * gn[7]);
            *(GAS v4u*)(WT + (size_t)(row_off + drow0 + n) * ldk + kcol0 + k0 + 8 * c) = o; } }
    LDS_WAIT(); asm volatile("" ::: "memory");
}
__device__ __forceinline__ void moe_weights(Frame& F, const Args& A, int it_lo, int it_hi, int widx, int nw) {
    LAS float* scr = (LAS float*)(F.lds + RING_OFF + F.wave * 16384);
    unsigned char* ws = A.ws;
    constexpr int I_MG1 = (D / 64) * (FE / 32), I_MD1 = (FE / 64) * (D / 32);
    for (int it = it_lo + widx; it < it_hi; it += nw) {
        int r = it;
        if (r < NE * I_MG1) { const int e = r / I_MG1; cvt_item(A.in[32] + (size_t)e * D * FE, D, FE, (bf16*)(ws + WS_W_MGU + (size_t)e * 2 * FE * D), D, 0, 0, 1, nullptr, FP8_SW, 1 << 30, scr, r % I_MG1, F.lane, true); continue; } r -= NE * I_MG1;
        if (r < NE * I_MG1) { const int e = r / I_MG1; cvt_item(A.in[33] + (size_t)e * D * FE, D, FE, (bf16*)(ws + WS_W_MGU + (size_t)e * 2 * FE * D), D, 0, 0, 2, nullptr, FP8_SW, 1 << 30, scr, r % I_MG1, F.lane, true); continue; } r -= NE * I_MG1;
        { const int e = r / I_MD1; cvt_item(A.in[34] + (size_t)e * FE * D, FE, D, (bf16*)(ws + WS_W_MDN + (size_t)e * D * FE), FE, 0, 0, 0, nullptr, FP8_SW, 1 << 30, scr, r % I_MD1, F.lane, true, true); }
    }
}
__device__ __forceinline__ void tail_convert(Frame& F, const Args& A, int nunit, int lo, int hi) {
    const int nlast = nunit % F.G, bid = (int)blockIdx.x;
    if (nlast != 0) { if (bid >= nlast) moe_weights(F, A, lo, hi, (bid - nlast) * NWAVES + F.wave, (F.G - nlast) * NWAVES); }
    else moe_weights(F, A, lo, hi, F.gw, F.ngw);
}
__device__ __forceinline__ void gen_s5(Frame& F, const Args& A, int g);
#ifdef PROBE_SETA
#define PROBE_STAMP2(F, k) do { if (blockIdx.x == 0 && F.tid == 0) { const unsigned long long t_ = __builtin_amdgcn_s_memrealtime(); const unsigned long long l_ = ((unsigned long long)F.MISC[17] << 32) | F.MISC[16]; const unsigned d_ = (unsigned)(t_ - l_); \
        if ((PROBE_SETA >> (k)) & 1ull) F.MISC[18] += d_; if ((PROBE_SETB >> (k)) & 1ull) F.MISC[20] += d_; F.MISC[16] = (unsigned)t_; F.MISC[17] = (unsigned)(t_ >> 32); } } while (0)
#else
#define PROBE_STAMP2(F, k) do { } while (0)
#endif
__device__ __forceinline__ void p0_prologue(Frame& F, const Args& A) {
    LAS float* scr = (LAS float*)(F.lds + RING_OFF + F.wave * 16384);
    unsigned char* ws = A.ws;
    constexpr int I_IN0 = (D / 64) * (EV_IN / 32), I_UQ = (QRANK / 64) * (768 / 32), I_UKV = (KVRANK / 64) * (1024 / 32), I_GLU = (512 / 64) * (512 / 32), I_OUT = (D / 64) * (D / 32);
    constexpr int I_FG = (D / 64) * (FFN / 32), I_FD = (FFN / 64) * (D / 32), I_IN1 = (D / 64) * (OD_IN / 32), I_MG1 = (D / 64) * (FE / 32), I_MD1 = (FE / 64) * (D / 32);
    constexpr int NITEMS = I_IN0 + I_UQ + I_UKV + I_GLU + I_OUT + 2 * I_FG + I_FD + I_IN1 + I_OUT;
    const bool s5_builder = (int)blockIdx.x >= F.G - S5G;
    for (int it = s5_builder ? NITEMS : F.gw; it < NITEMS; it += F.ngw - S5G * NWAVES) {
        int r = it;
        if (r < I_IN0) { cvt_item(A.in[7], D, EV_IN, (bf16*)(ws + WS_W_IN0), D, 0, 0, 0, nullptr, 1.f, 0, scr, r, F.lane); continue; } r -= I_IN0;
        if (r < I_UQ) { cvt_item(A.in[19], QRANK, 768, (bf16*)(ws + WS_W_QKV), KQKV, 0, 0, 0, A.in[18], 1.f, 0, scr, r, F.lane); continue; } r -= I_UQ;
        if (r < I_UKV) { cvt_item(A.in[21], KVRANK, 1024, (bf16*)(ws + WS_W_QKV), KQKV, QRANK, 768, 3, A.in[20], 1.f, 0, scr, r, F.lane); continue; } r -= I_UKV;
        if (r < I_GLU) { cvt_item(A.in[16], 512, 512, (bf16*)(ws + WS_W_GLU), 512, 0, 0, 0, nullptr, 1.f, 0, scr, r, F.lane); continue; } r -= I_GLU;
        if (r < I_OUT) { cvt_item(A.in[22], D, D, (bf16*)(ws + WS_W_OUT0), D, 0, 0, 0, nullptr, 1.f, 0, scr, r, F.lane); continue; } r -= I_OUT;
        if (r < I_FG) { cvt_item(A.in[23], D, FFN, (bf16*)(ws + WS_W_GU), D, 0, 0, 1, nullptr, FFN0_IS_FP8 ? FP8_SW : 1.f, 1 << 30, scr, r, F.lane, FFN0_IS_FP8); continue; } r -= I_FG;
        if (r < I_FG) { cvt_item(A.in[24], D, FFN, (bf16*)(ws + WS_W_GU), D, 0, 0, 2, nullptr, FFN0_IS_FP8 ? FP8_SW : 1.f, 1 << 30, scr, r, F.lane, FFN0_IS_FP8); continue; } r -= I_FG;
        if (r < I_FD) { cvt_item(A.in[25], FFN, D, (bf16*)(ws + WS_W_DN), FFN, 0, 0, 0, nullptr, (FFN0_IS_FP8 || FFN0_DN_FP8) ? FP8_SW : 1.f, 1 << 30, scr, r, F.lane, FFN0_IS_FP8 || FFN0_DN_FP8); continue; } r -= I_FD;
        if (r < I_IN1) { cvt_item(A.in[26], D, OD_IN, (bf16*)(ws + WS_W_IN1), D, 0, 0, 0, nullptr, 0.08838834764831845f, GKEY, scr, r, F.lane); continue; } r -= I_IN1;
        cvt_item(A.in[30], D, D, (bf16*)(ws + WS_W_OUT1), D, 0, 0, 0, nullptr, 1.f, 0, scr, r, F.lane);
    }
    { const v4u z = {0u, 0u, 0u, 0u}; const int gt = blockIdx.x * (NWAVES * 64) + F.tid, ngt = F.G * NWAVES * 64;
      GAS v4u* p0 = (GAS v4u*)((bf16*)(ws + WS_W_IN0) + (size_t)EV_IN * D); for (int i = gt; i < (EV_INP - EV_IN) * D / 8; i += ngt) p0[i] = z;
      for (int i = gt; i < 768 * (KVRANK / 8); i += ngt) { const int r = i / (KVRANK / 8), c = i % (KVRANK / 8); *(GAS v4u*)((bf16*)(ws + WS_W_QKV) + (size_t)r * KQKV + QRANK + 8 * c) = z; }
      for (int i = gt; i < 1024 * (QRANK / 8); i += ngt) { const int r = i / (QRANK / 8), c = i % (QRANK / 8); *(GAS v4u*)((bf16*)(ws + WS_W_QKV) + (size_t)(768 + r) * KQKV + 8 * c) = z; }
      GAS v4u* p1 = (GAS v4u*)((bf16*)(ws + WS_W_IN1) + (size_t)OD_IN * D); for (int i = gt; i < (OD_INP - OD_IN) * D / 8; i += ngt) p1[i] = z; }
    __syncthreads();
    PROBE_STAMP2(F, 22);
    LAS float* act = (LAS float*)(F.lds);
    LAS float* red = (LAS float*)(F.lds + 17 * 1024 * 4);
    float* modv = (float*)(ws + WS_MODV);
    bool have_act = false;
    for (int u = blockIdx.x; u < 2 * 96; u += F.G) {
        if (!have_act) {
            float xv[17 * 1024 / (NWAVES * 64)];
#pragma unroll
            for (int q = 0; q < 17 * 1024 / (NWAVES * 64); ++q) { const int i = F.tid + q * (NWAVES * 64); xv[q] = (i < 16 * 1024) ? A.in[1][i] : A.in[3][i - 16 * 1024]; }
#pragma unroll
            for (int q = 0; q < 17 * 1024 / (NWAVES * 64); ++q) { const float x = xv[q]; act[F.tid + q * (NWAVES * 64)] = x / (1.0f + __expf(-x)); }
            have_act = true;
        }
        __syncthreads();
        const int layer = u / 96, c0 = (u % 96) * 64;
        const float* mw = A.in[4] + (size_t)layer * D * 6144 + c0 + F.lane;
        float acc[17];
#pragma unroll
        for (int r = 0; r < 17; ++r) acc[r] = 0.f;
        for (int k0 = F.wave * 128; k0 < F.wave * 128 + 128; k0 += 32) { float w[32];
#pragma unroll
            for (int u2 = 0; u2 < 32; ++u2) w[u2] = mw[(size_t)(k0 + u2) * 6144];
#pragma unroll
            for (int u2 = 0; u2 < 32; ++u2)
#pragma unroll
                for (int r = 0; r < 17; ++r) acc[r] += act[r * 1024 + k0 + u2] * w[u2]; }
#pragma unroll
        for (int r = 0; r < 17; ++r) red[(F.wave * 17 + r) * 64 + F.lane] = acc[r];
        __syncthreads();
        for (int i = F.tid; i < 17 * 64; i += NWAVES * 64) { const int r = i >> 6, l = i & 63; float s = A.in[5][layer * 6144 + c0 + l];
#pragma unroll
            for (int w = 0; w < 8; ++w) s += red[(w * 17 + r) * 64 + l];
            modv[(size_t)(layer * 17 + r) * 6144 + c0 + l] = s; }
    }
    __syncthreads();
    PROBE_STAMP2(F, 23);
    for (int g = (int)blockIdx.x - (F.G - S5G); g >= 0 && g < S5G; g += F.G) gen_s5(F, A, g);
}

__device__ __forceinline__ void thin_t1(Frame& F, const Args& A) {
    const float* modv = (const float*)(A.ws + WS_MODV); bf16* XL = (bf16*)(A.ws + WS_XL); const float* gam = A.in[6];
    for (int r = F.gw; r < MA; r += F.ngw) {
        const bool lat = r < ML; const float* src = lat ? A.in[0] + (size_t)r * D : A.in[2] + (size_t)(r - ML) * D; const int bs = lat ? r / SEQ : 16;
        const float* mod = modv + (size_t)bs * 6144;
        f32x4 v[4]; ld_row_f32(src, F.lane, v); norm_mod(v, gam, mod, mod + D, F.lane); st_row_bf16(XL + (size_t)r * D, F.lane, v);
    }
}
__device__ __forceinline__ void thin_t2(Frame& F, const Args& A) {
    const float* modv = (const float*)(A.ws + WS_MODV); bf16* XL = (bf16*)(A.ws + WS_XL); const bf16* YL = (const bf16*)(A.ws + WS_YL); float* HC = (float*)(A.ws + WS_HC); const float* gam = A.in[6];
    for (int r0 = F.gw; r0 < MA; r0 += 2 * F.ngw) {
        const int r1 = (r0 + F.ngw < MA) ? r0 + F.ngw : r0; const bool two = r1 != r0;
        const bool lat0 = r0 < ML, lat1 = r1 < ML;
        const float* src0 = lat0 ? A.in[0] + (size_t)r0 * D : A.in[2] + (size_t)(r0 - ML) * D; const float* src1 = lat1 ? A.in[0] + (size_t)r1 * D : A.in[2] + (size_t)(r1 - ML) * D;
        float* dst0 = lat0 ? A.out + (size_t)r0 * D : HC + (size_t)(r0 - ML) * D; float* dst1 = lat1 ? A.out + (size_t)r1 * D : HC + (size_t)(r1 - ML) * D;
        const float* mod0 = modv + (size_t)(lat0 ? r0 / SEQ : 16) * 6144; const float* mod1 = modv + (size_t)(lat1 ? r1 / SEQ : 16) * 6144;
        f32x4 h0[4], y0[4], h1[4], y1[4];
        ld_row_f32(src0, F.lane, h0); ld_row_bf16(YL + (size_t)r0 * D, F.lane, y0); ld_row_f32(src1, F.lane, h1); ld_row_bf16(YL + (size_t)r1 * D, F.lane, y1);
        gated_add(h0, y0, gam + 1 * D, mod0 + 2 * D, F.lane); gated_add(h1, y1, gam + 1 * D, mod1 + 2 * D, F.lane);
        st_row_f32(dst0, F.lane, h0); if (two) st_row_f32(dst1, F.lane, h1);
        norm_mod(h0, gam + 2 * D, mod0 + 3 * D, mod0 + 4 * D, F.lane); norm_mod(h1, gam + 2 * D, mod1 + 3 * D, mod1 + 4 * D, F.lane);
        if (FFN0_IS_FP8) { st_row_fp8((unsigned char*)XL + (size_t)r0 * D, F.lane, h0, FP8_SA); if (two) st_row_fp8((unsigned char*)XL + (size_t)r1 * D, F.lane, h1, FP8_SA); }
        else { st_row_bf16(XL + (size_t)r0 * D, F.lane, h0); if (two) st_row_bf16(XL + (size_t)r1 * D, F.lane, h1); }
    }
}
__device__ __forceinline__ void thin_t3(Frame& F, const Args& A) {
    const float* modv = (const float*)(A.ws + WS_MODV); bf16* XL = (bf16*)(A.ws + WS_XL); const bf16* FL = (const bf16*)(A.ws + WS_FL); const float* HC = (const float*)(A.ws + WS_HC); const float* gam = A.in[6];
    for (int r0 = F.gw; r0 < MA; r0 += 2 * F.ngw) {
        const int r1 = (r0 + F.ngw < MA) ? r0 + F.ngw : r0; const bool two = r1 != r0;
        const bool lat0 = r0 < ML, lat1 = r1 < ML;
        const float* src0 = lat0 ? A.out + (size_t)r0 * D : HC + (size_t)(r0 - ML) * D; const float* src1 = lat1 ? A.out + (size_t)r1 * D : HC + (size_t)(r1 - ML) * D;
        const int bs0 = lat0 ? r0 / SEQ : 16, bs1 = lat1 ? r1 / SEQ : 16;
        f32x4 h0[4], y0[4], h1[4], y1[4];
        ld_row_f32(src0, F.lane, h0); ld_row_bf16(FL + (size_t)r0 * D, F.lane, y0); ld_row_f32(src1, F.lane, h1); ld_row_bf16(FL + (size_t)r1 * D, F.lane, y1);
        gated_add(h0, y0, gam + 3 * D, modv + (size_t)bs0 * 6144 + 5 * D, F.lane); gated_add(h1, y1, gam + 3 * D, modv + (size_t)bs1 * 6144 + 5 * D, F.lane);
        if (lat0) st_row_f32(A.out + (size_t)r0 * D, F.lane, h0); if (two && lat1) st_row_f32(A.out + (size_t)r1 * D, F.lane, h1);
        { const float* m0 = modv + (size_t)(17 + bs0) * 6144; const float* m1 = modv + (size_t)(17 + bs1) * 6144;
          norm_mod(h0, gam + 4 * D, m0, m0 + D, F.lane); norm_mod(h1, gam + 4 * D, m1, m1 + D, F.lane); }
        st_row_bf16(XL + (size_t)r0 * D, F.lane, h0); if (two) st_row_bf16(XL + (size_t)r1 * D, F.lane, h1);
    }
}
__device__ __forceinline__ void thin_t4(Frame& F, const Args& A) {
    const float* modv = (const float*)(A.ws + WS_MODV); bf16* XL = (bf16*)(A.ws + WS_XLM); const bf16* YL = (const bf16*)(A.ws + WS_YL1); const float* gam = A.in[6] + 4 * D;
    const float* router = A.in[31]; unsigned* tok = (unsigned*)(A.ws + WS_TOK); unsigned short* inv = (unsigned short*)(A.ws + WS_INV);
    LAS float* rt = (LAS float*)(F.lds);
    LAS unsigned* wc = (LAS unsigned*)(F.lds + 32768);
    __syncthreads();
    for (int i = F.tid; i < 8 * 1024; i += NWAVES * 64) { const int e = i >> 10, c = i & 1023; rt[i] = router[(size_t)c * 8 + e]; }
    __syncthreads();
    for (int chunk = blockIdx.x; chunk < ML / 128; chunk += F.G) {
        const int row_base = chunk * 128 + F.wave * 16;
        int me0 = 0, me1 = 0; float mw0 = 0.f, mw1 = 0.f;
        for (int i = 0; i < 16; ++i) {
            const int r = row_base + i; const int bs = r / SEQ; const float* mod1 = modv + (size_t)(17 + bs) * 6144;
            f32x4 h[4], y[4]; ld_row_f32(A.out + (size_t)r * D, F.lane, h); ld_row_bf16(YL + (size_t)r * D, F.lane, y);
            gated_add(h, y, gam + 1 * D, mod1 + 2 * D, F.lane); st_row_f32(A.out + (size_t)r * D, F.lane, h);
            norm_mod(h, gam + 2 * D, mod1 + 3 * D, mod1 + 4 * D, F.lane); st_row_fp8((unsigned char*)XL + (size_t)r * D, F.lane, h, FP8_SA);
            float lg[8];
#pragma unroll
            for (int e = 0; e < 8; ++e) { float a = 0.f;
#pragma unroll
                for (int j = 0; j < 4; ++j) { const f32x4 w = *(const LAS f32x4*)(rt + e * 1024 + 256 * j + 4 * F.lane); a += (h[j].x * w.x + h[j].y * w.y) + (h[j].z * w.z + h[j].w * w.w); }
                lg[e] = a; }
            {
              const bool b5 = (F.lane & 32) != 0, b4 = (F.lane & 16) != 0, b3 = (F.lane & 8) != 0; float v4[4], v2[2];
#pragma unroll
              for (int i2 = 0; i2 < 4; ++i2) { const float keep = b5 ? lg[i2 + 4] : lg[i2], send = b5 ? lg[i2] : lg[i2 + 4]; v4[i2] = keep + __shfl_xor(send, 32); }
#pragma unroll
              for (int i2 = 0; i2 < 2; ++i2) { const float keep = b4 ? v4[i2 + 2] : v4[i2], send = b4 ? v4[i2] : v4[i2 + 2]; v2[i2] = keep + __shfl_xor(send, 16); }
              float v1 = (b3 ? v2[1] : v2[0]) + __shfl_xor(b3 ? v2[0] : v2[1], 8);
              v1 += __shfl_xor(v1, 1); v1 += __shfl_xor(v1, 2); v1 += __shfl_xor(v1, 4);
#pragma unroll
              for (int e = 0; e < 8; ++e) lg[e] = __builtin_bit_cast(float, __builtin_amdgcn_readlane(__builtin_bit_cast(int, v1), 8 * e)); }
            int e0 = 0; float v0 = lg[0];
#pragma unroll
            for (int e = 1; e < 8; ++e) if (lg[e] > v0) { v0 = lg[e]; e0 = e; }
            int e1 = (e0 + 1) & 7; float v1 = -3.0e38f;
#pragma unroll
            for (int e = 0; e < 8; ++e) if (e != e0 && lg[e] > v1) { v1 = lg[e]; e1 = e; }
            const float w1 = 1.0f / (1.0f + __expf(v0 - v1)), w0 = 1.0f - w1;
            if (F.lane == i) { me0 = e0; me1 = e1; mw0 = w0; mw1 = w1; }
        }
        unsigned long long m[8];
#pragma unroll
        for (int e = 0; e < 8; ++e) m[e] = __ballot(F.lane < 16 && (me0 == e || me1 == e));
        { unsigned c = 0;
#pragma unroll
          for (int e = 0; e < 8; ++e) c = (F.lane == e) ? (unsigned)__popcll(m[e]) : c;
          if (F.lane < 8) wc[F.wave * 8 + F.lane] = c; }
        __syncthreads();
        if (F.tid < 8) { unsigned tot = 0;
#pragma unroll
            for (int w = 0; w < 8; ++w) tot += wc[w * 8 + F.tid];
            unsigned run = __hip_atomic_fetch_add((unsigned*)(F.ctl + CW_CNT + F.tid), tot, __ATOMIC_RELAXED, __HIP_MEMORY_SCOPE_AGENT);
#pragma unroll
            for (int w = 0; w < 8; ++w) { const unsigned c = wc[w * 8 + F.tid]; wc[w * 8 + F.tid] = run; run += c; } }
        __syncthreads();
        if (F.lane < 16) { unsigned long long m0 = 0ull, m1 = 0ull;
#pragma unroll
            for (int e = 0; e < 8; ++e) { m0 = (me0 == e) ? m[e] : m0; m1 = (me1 == e) ? m[e] : m1; }
            const unsigned long long below = (1ull << F.lane) - 1ull;
            const unsigned i0 = wc[F.wave * 8 + me0] + (unsigned)__popcll(m0 & below), i1 = wc[F.wave * 8 + me1] + (unsigned)__popcll(m1 & below);
            unsigned* t = tok + (size_t)(row_base + F.lane) * 8; t[0] = (unsigned)me0; t[1] = (unsigned)me1; t[2] = i0; t[3] = i1; t[4] = __float_as_uint(mw0); t[5] = __float_as_uint(mw1);
            inv[(size_t)me0 * 32768 + i0] = (unsigned short)(row_base + F.lane); inv[(size_t)me1 * 32768 + i1] = (unsigned short)(row_base + F.lane); }
        __syncthreads();
    }
}
__device__ __forceinline__ void moe_tile_starts(Frame& F, int (&ts)[9]) {
    ts[0] = 0;
#pragma unroll
    for (int e = 0; e < 8; ++e) { const unsigned c = __hip_atomic_load((unsigned*)(F.ctl + CW_CNT + e), __ATOMIC_RELAXED, __HIP_MEMORY_SCOPE_AGENT); ts[e + 1] = ts[e] + (int)((c + 255u) >> 8); }
#pragma unroll
    for (int e = 0; e < 9; ++e) ts[e] = __builtin_amdgcn_readfirstlane(ts[e]);
}
template <class Sched> __device__ __forceinline__ void moe_row_table(Frame& F, const Args& A, const Sched& S, const int (&ts)[9]) {
    const unsigned short* inv = (const unsigned short*)(A.ws + WS_INV); LAS unsigned short* tab = (LAS unsigned short*)(F.lds + ATAB_OFF);
    __syncthreads();
    for (int i = 0; i < ATAB_UNITS; ++i) { pg8::Unit u; if (!S.next(i, u)) break;
        int e = 0;
#pragma unroll
        for (int q = 1; q < 8; ++q) e += (u.pm >= ts[q]) ? 1 : 0;
        int tse = 0;
#pragma unroll
        for (int q = 0; q < 8; ++q) tse = (e == q) ? ts[q] : tse;
        const unsigned cnt = __hip_atomic_load((unsigned*)(F.ctl + CW_CNT + e), __ATOMIC_RELAXED, __HIP_MEMORY_SCOPE_AGENT);
        if (F.tid < 256) { const unsigned r = (unsigned)(u.pm - tse) * 256u + (unsigned)F.tid; tab[i * 256 + F.tid] = (r < cnt) ? inv[(size_t)e * 32768 + r] : (unsigned short)0; } }
    __syncthreads();
}
__device__ __forceinline__ void thin_t5(Frame& F, const Args& A) {
    int ts[9]; moe_tile_starts(F, ts);
    const float* modv = (const float*)(A.ws + WS_MODV); const bf16* Y = (const bf16*)(A.ws + WS_Y); const float* gam = A.in[6] + 7 * D; const unsigned* tok = (const unsigned*)(A.ws + WS_TOK);
    for (int r = F.gw; r < ML; r += F.ngw) {
        const int bs = r / SEQ; const float* mod1 = modv + (size_t)(17 + bs) * 6144;
        const unsigned* t = tok + (size_t)r * 8; const float w0 = __uint_as_float(t[4]), w1 = __uint_as_float(t[5]); const int e0 = (int)t[0], e1 = (int)t[1]; int s0 = 0, s1 = 0;
#pragma unroll
        for (int e = 0; e < 8; ++e) { s0 = (e0 == e) ? ts[e] : s0; s1 = (e1 == e) ? ts[e] : s1; }
        const unsigned p0 = (unsigned)s0 * 256u + t[2], p1 = (unsigned)s1 * 256u + t[3];
        f32x4 h[4], y0[4], y1[4]; ld_row_f32(A.out + (size_t)r * D, F.lane, h); ld_row_bf16(Y + (size_t)p0 * D, F.lane, y0); ld_row_bf16(Y + (size_t)p1 * D, F.lane, y1);
#pragma unroll
        for (int j = 0; j < 4; ++j) y0[j] = y0[j] * w0 + y1[j] * w1;
        gated_add(h, y0, gam, mod1 + 5 * D, F.lane); st_row_f32(A.out + (size_t)r * D, F.lane, h);
    }
}

__device__ __forceinline__ float rope_inv(int f) { return exp2f(-(float)f * (13.287712379549449f / 8.0f)); }
__device__ __forceinline__ void prep_qa(Frame& F, const Args& A) {
    const bf16* Z0 = (const bf16*)(A.ws + WS_Z0C); bf16* QA = (bf16*)(A.ws + WS_QA); bf16* KR = (bf16*)(A.ws + WS_KR);
    for (int r = F.gw; r < MA; r += F.ngw) {
        const bf16* z = Z0 + (size_t)r * 512;
        const v2u cq = *((const GAS v2u*)(z) + F.lane); const unsigned ck = *((const GAS unsigned*)(z + 256) + F.lane);
        const float q0 = bf_lo(cq.x), q1 = bf_hi(cq.x), q2 = bf_lo(cq.y), q3 = bf_hi(cq.y), k0 = bf_lo(ck), k1 = bf_hi(ck);
        const float rq = rsqrtf(wave_sum((q0 * q0 + q1 * q1) + (q2 * q2 + q3 * q3)) * (1.0f / QRANK) + EPS);
        const float rk = rsqrtf(wave_sum(k0 * k0 + k1 * k1) * (1.0f / KVRANK) + EPS);
        v2u oq; oq.x = pk2(q0 * rq, q1 * rq); oq.y = pk2(q2 * rq, q3 * rq);
        *((GAS v2u*)(QA + (size_t)r * KQKV) + F.lane) = oq; *((GAS unsigned*)(QA + (size_t)r * KQKV + QRANK) + F.lane) = pk2(k0 * rk, k1 * rk);
        const int l = F.lane & 31; float v = bf1(z[384 + l]); const float pv = __shfl_xor(v, 8);
        if (r < ML) { const int t = r % SEQ; const float pos = (l < 16) ? (float)(t / 64) : (float)(t % 64); float sn, cs; sincosf(pos * rope_inv(l & 7), &sn, &cs);
            v = (l & 8) ? (v * cs + pv * sn) : (v * cs - pv * sn); }
        if (F.lane < 32) KR[(size_t)r * 32 + l] = (bf16)f2bf(v);
    }
}
__device__ __forceinline__ void rope_q(Frame& F, const Args& A) {
    bf16* Q = (bf16*)(A.ws + WS_Q);
    for (int r = F.gw; r < ML; r += F.ngw) {
        const int t = r % SEQ, hh = F.lane >> 3, sub = F.lane & 7; bf16* p = Q + (size_t)r * 768 + hh * QK + NOPE + sub;
        const float inv = rope_inv(sub); float sr, cr, sc, cc; sincosf((float)(t / 64) * inv, &sr, &cr); sincosf((float)(t % 64) * inv, &sc, &cc);
        const float x0 = bf1(p[0]), x1 = bf1(p[8]), x2 = bf1(p[16]), x3 = bf1(p[24]);
        p[0] = (bf16)f2bf(x0 * cr - x1 * sr); p[8] = (bf16)f2bf(x1 * cr + x0 * sr); p[16] = (bf16)f2bf(x2 * cc - x3 * sc); p[24] = (bf16)f2bf(x3 * cc + x2 * sc);
    }
}
__device__ __forceinline__ int scan_row(int b, int dir, int tau) {
    if (tau < CTXL) return ML + b * CTXL + (dir ? CTXL - 1 - tau : tau);
    const int t = tau - CTXL; return b * SEQ + (dir ? SEQ - 1 - t : t);
}
__device__ __forceinline__ float gelu_tanh(float x) { const float u = 0.7978845608028654f * (x + 0.044715f * x * x * x); const float e = __expf(2.0f * u); const float th = 1.0f - 2.0f / (e + 1.0f); return 0.5f * x * (1.0f + th); }
__device__ __forceinline__ void gen_s5(Frame& F, const Args& A, int g) {
    LAS float* pw = (LAS float*)F.lds;
    LAS float* cc = pw + 2 * 64 * 17 * 2;
    LAS float* bb = cc + 2 * 16 * 64 * 2;
    LAS float* KK = bb + 2 * 64 * 16 * 2;
    bf16* B1g = (bf16*)(A.ws + WS_B1) + (size_t)g * 256 * 256; bf16* B3g = (bf16*)(A.ws + WS_B3) + (size_t)g * 256 * 512;
    __syncthreads();
    for (int idx = F.tid; idx < 128; idx += NWAVES * 64) { const int d = idx >> 6, p = idx & 63, ig = d * S5G + g, i = ig * S5P + p;
        const float lr = A.in[8][i], li = A.in[9][i], dt = expf(A.in[10][ig]);
        for (int k = 0; k <= 16; ++k) { const float mag = expf((float)k * lr * dt), ang = (float)k * li * dt; pw[((d * 64 + p) * 17 + k) * 2] = mag * cosf(ang); pw[((d * 64 + p) * 17 + k) * 2 + 1] = mag * sinf(ang); }
        const float mag = expf(lr * dt), ar = mag * cosf(li * dt), ai = mag * sinf(li * dt), den = lr * lr + li * li, nr = ar - 1.0f;
        const float cr = (nr * lr + ai * li) / den, ci = (ai * lr - nr * li) / den;
        for (int h = 0; h < 16; ++h) { const float br = A.in[11][(size_t)i * 16 + h], bi = A.in[12][(size_t)i * 16 + h]; bb[((d * 64 + p) * 16 + h) * 2] = cr * br - ci * bi; bb[((d * 64 + p) * 16 + h) * 2 + 1] = cr * bi + ci * br; } }
    for (int idx = F.tid; idx < 2 * 16 * 64; idx += NWAVES * 64) { const int d = idx >> 10, ho = (idx >> 6) & 15, p = idx & 63; const size_t ci = (size_t)((d * S5G + g) * 16 + ho) * S5P + p;
        cc[idx * 2] = A.in[13][ci]; cc[idx * 2 + 1] = A.in[14][ci]; }
    __syncthreads();
    { const int ho = F.tid & 15, k = (F.tid >> 4) & 15, d = F.tid >> 8;
      float acc[16];
#pragma unroll
      for (int hi = 0; hi < 16; ++hi) acc[hi] = 0.f;
      for (int p = 0; p < 64; ++p) { const float cr = cc[((d * 16 + ho) * 64 + p) * 2], ci = cc[((d * 16 + ho) * 64 + p) * 2 + 1], pr = pw[((d * 64 + p) * 17 + k) * 2], pi = pw[((d * 64 + p) * 17 + k) * 2 + 1];
          const float wr = cr * pr - ci * pi, wi = cr * pi + ci * pr; const LAS f32x4* bp = (const LAS f32x4*)(bb + (d * 64 + p) * 32);
#pragma unroll
          for (int q = 0; q < 8; ++q) { const f32x4 b4 = bp[q]; acc[2 * q] += wr * b4.x - wi * b4.y; acc[2 * q + 1] += wr * b4.z - wi * b4.w; } }
#pragma unroll
      for (int hi = 0; hi < 16; ++hi) KK[((d * 16 + k) * 16 + ho) * 16 + hi] = acc[hi]; }
    __syncthreads();
    for (int idx = F.tid; idx < 256 * 256; idx += NWAVES * 64) { const int n = idx >> 8, kk = idx & 255;
        { const int j = n >> 4, ho = n & 15, i = kk >> 4, hi = kk & 15; float val = 0.f;
          if (i <= j) val += KK[((0 * 16 + (j - i)) * 16 + ho) * 16 + hi];
          if (i >= j) val += KK[((1 * 16 + (i - j)) * 16 + ho) * 16 + hi];
          if (i == j && ho == hi) val += A.in[15][g * 16 + ho];
          B3g[(size_t)n * 512 + kk] = (bf16)f2bf(val);
          const int d = kk >> 7, reim = (kk >> 6) & 1, p = kk & 63, e = d ? (16 - j) : (j + 1);
          const float cr = cc[((d * 16 + ho) * 64 + p) * 2], ci = cc[((d * 16 + ho) * 64 + p) * 2 + 1], pr = pw[((d * 64 + p) * 17 + e) * 2], pi = pw[((d * 64 + p) * 17 + e) * 2 + 1];
          B3g[(size_t)n * 512 + 256 + kk] = (bf16)f2bf(reim ? -(cr * pi + ci * pr) : (cr * pr - ci * pi)); }
        { const int d = n >> 7, reim = (n >> 6) & 1, p = n & 63, i = kk >> 4, hi = kk & 15, e = d ? i : (15 - i);
          const float pr = pw[((d * 64 + p) * 17 + e) * 2], pi = pw[((d * 64 + p) * 17 + e) * 2 + 1], br = bb[((d * 64 + p) * 16 + hi) * 2], bi = bb[((d * 64 + p) * 16 + hi) * 2 + 1];
          B1g[(size_t)n * 256 + kk] = (bf16)f2bf(reim ? (pr * bi + pi * br) : (pr * br - pi * bi)); } }
    __syncthreads();
}
__device__ __forceinline__ void s5_scan(Frame& F, const Args& A) {
    if (F.wave < 4) {
        const float* DS = (const float*)(A.ws + WS_DS); bf16* A3 = (bf16*)(A.ws + WS_A3); const int p = F.lane;
        for (int task = blockIdx.x * 4 + F.wave; task < NB * S5G * 2; task += F.G * 4) {
            const int d = task & 1, g = (task >> 1) & 31, b = task >> 6, ig = d * S5G + g;
            const float lr = A.in[8][ig * S5P + p], li = A.in[9][ig * S5P + p], dt = expf(A.in[10][ig]);
            const float m16 = expf(16.0f * lr * dt), a16r = m16 * cosf(16.0f * li * dt), a16i = m16 * sinf(16.0f * li * dt);
            const float* ds = DS + (size_t)(g * 16 + b) * 144 * 256 + d * 128 + p; bf16* so = A3 + (size_t)(g * 16 + b) * 144 * 512 + 256 + d * 128 + p;
            float sr = 0.f, si = 0.f;
            for (int blk = 0; blk < 9; ++blk) {
                const int cbase = d ? (blk == 0 ? 15 : 143 - (blk - 1) * 16) : blk * 16, cstep = d ? -1 : 1;
                float xr[16], xi[16];
#pragma unroll
                for (int s = 0; s < 16; ++s) { const int c = cbase + cstep * s; xr[s] = ds[(size_t)c * 256]; xi[s] = ds[(size_t)c * 256 + 64]; }
#pragma unroll
                for (int s = 0; s < 16; ++s) { const int c = cbase + cstep * s; so[(size_t)c * 512] = (bf16)f2bf(sr); so[(size_t)c * 512 + 64] = (bf16)f2bf(si);
                    const float nsr = a16r * sr - a16i * si + xr[s], nsi = a16r * si + a16i * sr + xi[s]; sr = nsr; si = nsi; }
            }
        }
    }
}
__device__ __forceinline__ void attn_phase(Frame& F, const Args& A) {
    const bf16* Q = (const bf16*)(A.ws + WS_Q); const bf16* KV = (const bf16*)(A.ws + WS_KV); const bf16* KR = (const bf16*)(A.ws + WS_KR); bf16* AO = (bf16*)(A.ws + WS_AO);
    const int bid = (int)blockIdx.x; const int vcu = (F.G % 8 == 0) ? (bid % 8) * (F.G / 8) + bid / 8 : bid;
    for (int u = vcu; u < 1024 + 128; u += F.G) {
        int b, h, qrow0, NT;
        if (u < 1024) { const int bh = u >> 3; b = bh >> 3; h = bh & 7; qrow0 = b * SEQ + (u & 7) * 256; NT = TT / 64; }
        else { const int uu = u - 1024; b = uu >> 3; h = uu & 7; qrow0 = ML + b * CTXL; NT = CTXL / 64; }
        att::attn_unit(Q + (size_t)qrow0 * 768 + h * QK, KV + h * NOPE, KR, KV + 512 + h * VD, ML + b * CTXL, CTXL / 64, b * SEQ, NT, AO + (size_t)qrow0 * D + S5W + h * VD, F.lds, (u < 1024) ? (u & 7) * 256 : -1);
    }
}
__device__ __forceinline__ void gla_prep_phase(Frame& F, const Args& A) {
    for (int j = blockIdx.x; j < NB * GH * 2 * 2; j += F.G) { const int ch = j >> 1, b = ch >> 3, h = (ch >> 1) & 3, dir = ch & 1;
        gla::gla_prep((const bf16*)(A.ws + WS_QK), (const bf16*)(A.ws + WS_VR) + 2048, A.in[27], A.in[28], (bf16*)(A.ws + WS_TQ), (bf16*)(A.ws + WS_TK), (bf16*)(A.ws + WS_TP), (float*)(A.ws + WS_EL),
                      b, h, dir, 18 * (j & 1), 18 * (j & 1) + 18, ML, SEQ, CTXL, F.lds); }
}
__device__ __forceinline__ void gla_chain_phase(Frame& F, const Args& A) {
    const int bid = (int)blockIdx.x; const int vcu = (F.G % 8 == 0) ? (bid % 8) * (F.G / 8) + bid / 8 : bid;
    for (int u = vcu; u < NB * GH * 2 * 2; u += F.G) { const int ch = u >> 1, vh = u & 1, b = ch >> 3, h = (ch >> 1) & 3, dir = ch & 1;
        gla::gla_chain2((const bf16*)(A.ws + WS_VR), (const bf16*)(A.ws + WS_TQ), (const bf16*)(A.ws + WS_TK), (const bf16*)(A.ws + WS_TP), (const float*)(A.ws + WS_EL), (bf16*)(A.ws + (dir ? WS_OB : WS_OF)),
                        b, h, dir, vh, ML, SEQ, CTXL, F.lds); }
}
__device__ __forceinline__ void gla_finish(Frame& F, const Args& A) {
    bf16* OF = (bf16*)(A.ws + WS_OF); const bf16* OB = (const bf16*)(A.ws + WS_OB); const bf16* VR = (const bf16*)(A.ws + WS_VR); const float* hn = A.in[29];
    const f32x4 g = *(const GAS f32x4*)(hn + 4 * F.lane);
    for (int r0 = F.gw; r0 < ML; r0 += 2 * F.ngw) {
        const int r1 = (r0 + F.ngw < ML) ? r0 + F.ngw : r0; const bool two = r1 != r0;
        f32x4 a0[4], b0[4], x0[4], a1[4], b1[4], x1[4];
        ld_row_bf16(OF + (size_t)r0 * D, F.lane, a0); ld_row_bf16(OB + (size_t)r0 * D, F.lane, b0); ld_row_bf16(VR + (size_t)r0 * VRLD + GVAL, F.lane, x0);
        ld_row_bf16(OF + (size_t)r1 * D, F.lane, a1); ld_row_bf16(OB + (size_t)r1 * D, F.lane, b1); ld_row_bf16(VR + (size_t)r1 * VRLD + GVAL, F.lane, x1);
#pragma unroll
        for (int j = 0; j < 4; ++j) { const f32x4 o0 = a0[j] + b0[j], o1 = a1[j] + b1[j];
            const float s0 = wave_sum((o0.x * o0.x + o0.y * o0.y) + (o0.z * o0.z + o0.w * o0.w)), s1 = wave_sum((o1.x * o1.x + o1.y * o1.y) + (o1.z * o1.z + o1.w * o1.w));
            const float rs0 = rsqrtf(s0 * (1.0f / GDV) + EPS), rs1 = rsqrtf(s1 * (1.0f / GDV) + EPS);
#pragma unroll
            for (int i = 0; i < 4; ++i) { const float u0 = x0[j][i], u1 = x1[j][i];
                a0[j][i] = o0[i] * rs0 * g[i] * (u0 * __builtin_amdgcn_rcpf(1.0f + __expf(-u0))); a1[j][i] = o1[i] * rs1 * g[i] * (u1 * __builtin_amdgcn_rcpf(1.0f + __expf(-u1))); } }
        st_row_bf16(OF + (size_t)r0 * D, F.lane, a0); if (two) st_row_bf16(OF + (size_t)r1 * D, F.lane, a1);
    }
}

#ifndef MK_ONE_LAUNCH
#define MK_ONE_LAUNCH 1
#endif
constexpr int NPHASE = 21;
constexpr bool SP2 = true, ALIGN = true;

__global__ void __launch_bounds__(NWAVES * 64, 2) fwd_kernel(Args args) {
    extern __shared__ __attribute__((aligned(16))) unsigned char lds[];
    Frame F;
    F.lds = (LAS unsigned char*)lds;
    F.MISC = (volatile LAS unsigned*)(F.lds + MISC_OFF);
    F.tid = threadIdx.x; F.lane = F.tid & 63; F.wave = __builtin_amdgcn_readfirstlane(F.tid >> 6);
    F.G = gridDim.x; F.gw = blockIdx.x * NWAVES + F.wave; F.ngw = F.G * NWAVES;
    unsigned char* ws = args.ws;
    F.ctl = (gu32*)(ws + WS_CTL);
    for (int u = F.tid; u < (LDS_BYTES - LDSCTL_OFF) / 4; u += NWAVES * 64) ((LAS unsigned*)(F.lds + LDSCTL_OFF))[u] = 0u;
    __syncthreads();
    XcdBarrier bar; bar.bar = (unsigned*)(F.ctl + CW_BAR); bar.x = 0; bar.st = nullptr;
    if (MK_ONE_LAUNCH) bar = xcd_barrier_post((unsigned*)(F.ctl + CW_BAR), F.MISC + 8);
    const int lo = args.ph_lo, hi = args.ph_hi;
#define IN(k) (lo <= (k) && (k) < hi)
#ifdef PROBE_SETA
    if (blockIdx.x == 0 && F.tid == 0) { const unsigned long long t_ = __builtin_amdgcn_s_memrealtime(); F.MISC[16] = (unsigned)t_; F.MISC[17] = (unsigned)(t_ >> 32); }
#define PROBE_STAMP(k) do { if (blockIdx.x == 0 && F.tid == 0) { const unsigned long long t_ = __builtin_amdgcn_s_memrealtime(); const unsigned long long l_ = ((unsigned long long)F.MISC[17] << 32) | F.MISC[16]; const unsigned d_ = (unsigned)(t_ - l_); \
        if ((PROBE_SETA >> (k)) & 1ull) F.MISC[18] += d_; if ((PROBE_SETB >> (k)) & 1ull) F.MISC[20] += d_; F.MISC[16] = (unsigned)t_; F.MISC[17] = (unsigned)(t_ >> 32); } } while (0)
#else
#define PROBE_STAMP(k) do { } while (0)
#endif
#define SEAM(k) do { if (MK_ONE_LAUNCH && IN(k) && IN((k) + 1)) xcd_barrier(bar); PROBE_STAMP(k); } while (0)
    const int bid = (int)blockIdx.x;

    if (IN(0)) {
#ifndef NO_P0
 p0_prologue(F, args);
#endif
 } SEAM(0);
    if (IN(1)) { thin_t1(F, args); } SEAM(1);
    if (IN(2)) { pg8::Gemm g{(const bf16*)(ws + WS_XL), (const bf16*)(ws + WS_W_IN0), MA, EV_INP, D}; pg8::StaticOrder S; S.init(MA, EV_INP, F.G, bid);
        pg8::EpiIn0 E{(bf16*)(ws + WS_U), (bf16*)(ws + WS_A3), (bf16*)(ws + WS_Z0C)};
        pg8::gemm_phase<pg8::EpiIn0, pg8::StaticOrder, ALIGN, SP2>(F.lds + RING_OFF, g, S, E);
        tail_convert(F, args, (MA / 256) * (EV_INP / 256), MW0, MW1); } SEAM(2);
    if (IN(3)) { prep_qa(F, args);
        int k256 = 256; asm volatile("" : "+s"(k256));
        pg8::Gemm g{(const bf16*)(ws + WS_U), (const bf16*)(ws + WS_B1), 32 * 2304, 256, k256}; pg8::S5Order S{F.G, bid};
        pg8::EpiF32 E{(float*)(ws + WS_DS), 256};
        pg8::gemm_phase<pg8::EpiF32, pg8::S5Order, ALIGN, SP2>(F.lds + RING_OFF, g, S, E); } SEAM(3);
    if (IN(4)) { s5_scan(F, args);
        pg8::Gemm g{(const bf16*)(ws + WS_QA), (const bf16*)(ws + WS_W_QKV), MA, NQKV, KQKV}; pg8::StaticOrder S; S.init(MA, NQKV, F.G, bid);
        pg8::EpiSplit E{(bf16*)(ws + WS_Q), 768, (bf16*)(ws + WS_KV), 1024, 3, 0x7fffffff};
        pg8::gemm_phase<pg8::EpiSplit, pg8::StaticOrder, ALIGN, SP2>(F.lds + RING_OFF, g, S, E); } SEAM(4);
    if (IN(5)) {
        pg8::Gemm g{(const bf16*)(ws + WS_A3), (const bf16*)(ws + WS_B3), 32 * 2304, 256, 512}; pg8::S5Order S{F.G, bid};
        pg8::EpiS5Out E{(bf16*)(ws + WS_AG)};
        pg8::gemm_phase<pg8::EpiS5Out, pg8::S5Order, ALIGN, SP2>(F.lds + RING_OFF, g, S, E); } SEAM(5);
    if (IN(6)) {
#ifndef NO_ATT
 attn_phase(F, args);
#endif
        PROBE_STAMP(21);
        pg8::Gemm g{(const bf16*)(ws + WS_AG), (const bf16*)(ws + WS_W_GLU), MA, S5W, S5W}; pg8::StaticOrder S; S.init(MA, S5W, F.G, bid);
        pg8::EpiGlu E{(const bf16*)(ws + WS_AG), args.in[17], (bf16*)(ws + WS_AO), D};
        pg8::gemm_phase<pg8::EpiGlu, pg8::StaticOrder, ALIGN, SP2, false, false, true>(F.lds + RING_OFF, g, S, E); } SEAM(6);
    if (IN(7)) { pg8::Gemm g{(const bf16*)(ws + WS_AO), (const bf16*)(ws + WS_W_OUT0), MA, D, D}; pg8::StaticOrder S; S.init(MA, D, F.G, bid);
        pg8::EpiPlain E{(bf16*)(ws + WS_YL), D, 0, 0, 1.0f};
        pg8::gemm_phase<pg8::EpiPlain, pg8::StaticOrder, ALIGN, SP2>(F.lds + RING_OFF, g, S, E);
        tail_convert(F, args, (MA / 256) * (D / 256), MW1, MW2); } SEAM(7);
    if (IN(8)) { thin_t2(F, args); } SEAM(8);
    static_assert(!FFN0_IS_FP8, "the e4m3 dense-FFN variant does not carry the MoE weight conversion in its down phase");
    if constexpr (FFN0_IS_FP8) {
    if (IN(9)) { pg8::Gemm g{(const bf16*)(ws + WS_XL), (const bf16*)(ws + WS_W_GU), MA, 2 * FFN, D / 2}; pg8::StaticOrder S; S.init(MA, 2 * FFN, F.G, bid);
        pg8::EpiSwiGlu8 E{ws + WS_ACT, FFN, 0, 1.0f / (FP8_SA * FP8_SW), FP8_SACT, 0};
        pg8::gemm_phase<pg8::EpiSwiGlu8, pg8::StaticOrder, ALIGN, SP2, true>(F.lds + RING_OFF, g, S, E); } SEAM(9);
    if (IN(10)) { pg8::Gemm g{(const bf16*)(ws + WS_ACT), (const bf16*)(ws + WS_W_DN), MA, D, FFN / 2}; pg8::StaticOrder S; S.init(MA, D, F.G, bid);
        pg8::EpiPlain E{(bf16*)(ws + WS_FL), D, 0, 0, 1.0f / (FP8_SACT * FP8_SW)};
        pg8::gemm_phase<pg8::EpiPlain, pg8::StaticOrder, ALIGN, SP2, true>(F.lds + RING_OFF, g, S, E); } SEAM(10);
    } else {
    if (IN(9)) { pg8::Gemm g{(const bf16*)(ws + WS_XL), (const bf16*)(ws + WS_W_GU), MA, 2 * FFN, D}; pg8::StaticOrder S; S.init(MA, 2 * FFN, F.G, bid);
        if constexpr (FFN0_DN_FP8) { pg8::EpiSwiGlu8 E{ws + WS_ACT, FFN, 0, 1.0f, FP8_SACT, 0};
            pg8::gemm_phase<pg8::EpiSwiGlu8, pg8::StaticOrder, ALIGN, SP2>(F.lds + RING_OFF, g, S, E); }
        else { pg8::EpiSwiGlu E{(bf16*)(ws + WS_ACT), FFN, 0, 0};
            pg8::gemm_phase<pg8::EpiSwiGlu, pg8::StaticOrder, ALIGN, SP2>(F.lds + RING_OFF, g, S, E); }
        tail_convert(F, args, (MA / 256) * (2 * FFN / 256), MW2, MW3); } SEAM(9);
    if (IN(10)) { pg8::StaticOrder S; S.init(MA, D, F.G, bid);
        if constexpr (FFN0_DN_FP8) { pg8::Gemm g{(const bf16*)(ws + WS_ACT), (const bf16*)(ws + WS_W_DN), MA, D, FFN / 2};
            pg8::EpiPlain E{(bf16*)(ws + WS_FL), D, 0, 0, 1.0f / (FP8_SACT * FP8_SW)};
            pg8::gemm_phase<pg8::EpiPlain, pg8::StaticOrder, ALIGN, SP2, true>(F.lds + RING_OFF, g, S, E); }
        else { pg8::Gemm g{(const bf16*)(ws + WS_ACT), (const bf16*)(ws + WS_W_DN), MA, D, FFN};
            pg8::EpiPlain E{(bf16*)(ws + WS_FL), D, 0, 0, 1.0f};
            pg8::gemm_phase<pg8::EpiPlain, pg8::StaticOrder, ALIGN, SP2>(F.lds + RING_OFF, g, S, E); }
        tail_convert(F, args, (MA / 256) * (D / 256), MW3, MW4); } SEAM(10);
    }
    if (IN(11)) { thin_t3(F, args); } SEAM(11);
    if (IN(12)) { pg8::Gemm g{(const bf16*)(ws + WS_XL), (const bf16*)(ws + WS_W_IN1), MA, OD_INP, D}; pg8::StaticOrder S; S.init(MA, OD_INP, F.G, bid);
        pg8::EpiSplit E{(bf16*)(ws + WS_QK), 1024, (bf16*)(ws + WS_VR), VRLD, 4, 0x7fffffff};
        pg8::gemm_phase<pg8::EpiSplit, pg8::StaticOrder, ALIGN, SP2>(F.lds + RING_OFF, g, S, E);
        tail_convert(F, args, (MA / 256) * (OD_INP / 256), MW4, MW5); } SEAM(12);
    if (IN(13)) {
#ifndef NO_GLA
 gla_prep_phase(F, args);
#endif
    } SEAM(13);
    if (IN(14)) {
#ifndef NO_GLA
 gla_chain_phase(F, args);
#endif
    } SEAM(14);
    if (IN(15)) { gla_finish(F, args); } SEAM(15);
    if (IN(16)) { pg8::Gemm g{(const bf16*)(ws + WS_OF), (const bf16*)(ws + WS_W_OUT1), ML, D, D}; pg8::StaticOrder S; S.init(ML, D, F.G, bid);
        pg8::EpiPlain E{(bf16*)(ws + WS_YL1), D, 0, 0, 1.0f};
        pg8::gemm_phase<pg8::EpiPlain, pg8::StaticOrder, ALIGN, SP2>(F.lds + RING_OFF, g, S, E); } SEAM(16);
    if (IN(17)) { thin_t4(F, args); } SEAM(17);
    if (lo < 20 && hi > 18) {
        int ts[9]; moe_tile_starts(F, ts); const int NT = ts[8];
        if (IN(18)) { pg8::MoeOrder S{0, NT, 2 * FE / 256, F.G, bid, ts[1], ts[2], ts[3], ts[4], ts[5], ts[6], ts[7], 0};
            moe_row_table(F, args, S, ts);
            pg8::Gemm g{(const bf16*)(ws + WS_XLM), (const bf16*)(ws + WS_W_MGU), ML, 2 * FE, D / 2, (const LAS unsigned short*)(F.lds + ATAB_OFF)};
            pg8::EpiSwiGlu8 E{ws + WS_ACTM, FE, 2 * FE / 256, 1.0f / (FP8_SA * FP8_SW), FP8_SACT, 1};
            pg8::gemm_phase<pg8::EpiSwiGlu8, pg8::MoeOrder, ALIGN, SP2, true, false, false, true>(F.lds + RING_OFF, g, S, E); } SEAM(18);
        if (IN(19)) { pg8::Gemm g{(const bf16*)(ws + WS_ACTM), (const bf16*)(ws + WS_W_MDN), MOE_MAXT * 256, D, FE / 2};
            pg8::MoeOrder S{0, NT, D / 256, F.G, bid, ts[1], ts[2], ts[3], ts[4], ts[5], ts[6], ts[7], 1};
            pg8::EpiPlain E{(bf16*)(ws + WS_Y), D, 0, D / 256, 1.0f / (FP8_SACT * FP8_SW)};
            pg8::gemm_phase<pg8::EpiPlain, pg8::MoeOrder, ALIGN, SP2, true, true>(F.lds + RING_OFF, g, S, E); } SEAM(19);
    }
    if (IN(20)) { thin_t5(F, args); }
#ifdef PROBE_SETA
    PROBE_STAMP(20);
    if (blockIdx.x == 0 && F.tid == 0) {
        unsigned long long qa = F.MISC[18] / 100u, qb = F.MISC[20] / 1000u; qa = qa > 999 ? 999 : qa; qb = qb > 99 ? 99 : qb;
        const unsigned long long t0 = __builtin_amdgcn_s_memrealtime(), dl = qa * 1000ull + qb * 1000000ull;
        while (__builtin_amdgcn_s_memrealtime() - t0 < dl) __builtin_amdgcn_s_sleep(32);
    }
#endif
#undef IN
#undef SEAM
}

extern "C" void kernel_launch(void* const* d_in, const int* in_sizes, int n_in, void* d_out, int out_size, void* d_ws, size_t ws_size, hipStream_t stream) {
    static int grid = 0;
    if (grid == 0) {
        if (n_in != 35 || out_size != ML * D || ws_size < WS_END) { fprintf(stderr, "kernel_launch: unexpected shapes: n_in %d out %d ws %zu (need %zu)\n", n_in, out_size, ws_size, (size_t)WS_END); grid = -1; return; }
        int dev = 0, cus = 0, per_cu = 0;
        if (hipGetDevice(&dev) != hipSuccess || hipDeviceGetAttribute(&cus, hipDeviceAttributeMultiprocessorCount, dev) != hipSuccess) { grid = -1; return; }
        if (hipFuncSetAttribute((const void*)fwd_kernel, hipFuncAttributeMaxDynamicSharedMemorySize, LDS_BYTES) != hipSuccess) { fprintf(stderr, "kernel_launch: hipFuncSetAttribute failed\n"); grid = -1; return; }
        if (hipOccupancyMaxActiveBlocksPerMultiprocessor(&per_cu, (const void*)fwd_kernel, NWAVES * 64, LDS_BYTES) != hipSuccess || per_cu < 1) { fprintf(stderr, "kernel_launch: occupancy query reports %d blocks per CU\n", per_cu); }
        (void)hipGetLastError();
        grid = cus;
    }
    if (grid < 0) return;
    (void)hipMemsetAsync((char*)d_ws + WS_CTL, 0, CTL_ZERO_BYTES, stream);
    Args a{};
    for (int i = 0; i < 35; ++i) a.in[i] = (const float*)d_in[i];
    a.out = (float*)d_out; a.ws = (unsigned char*)d_ws;
#if MK_ONE_LAUNCH
    a.ph_lo = 0; a.ph_hi = NPHASE;
    hipLaunchKernelGGL(fwd_kernel, dim3(grid), dim3(NWAVES * 64), LDS_BYTES, stream, a);
#else
    for (int p = 0; p < NPHASE; ++p) { a.ph_lo = p; a.ph_hi = p + 1; hipLaunchKernelGGL(fwd_kernel, dim3(grid), dim3(NWAVES * 64), LDS_BYTES, stream, a); }
#endif
}
```

```cpp
#include <hip/hip_runtime.h>
#include <cstdio>
#include <cstdint>
#define MK_ONE_LAUNCH 1
namespace pg8 {
#define PG8_LAS __attribute__((address_space(3)))
typedef unsigned short bf16_t;
typedef short bf16x8 __attribute__((ext_vector_type(8)));
typedef float f32x4 __attribute__((ext_vector_type(4)));
typedef unsigned u32x4 __attribute__((ext_vector_type(4)));
constexpr int BM = 256, BK = 64, HALF = 128, HTB = HALF * BK * 2  , STAGE_BYTES = 8 * HTB, NXCD = 8, WGM = 8;

__host__ __device__ __forceinline__ int lds_byte(int r, int c) { const int st = (r >> 4) * 2 + (c >> 5), rr = r & 15, cc = c & 31, ob = rr * 64 + cc * 2; return st * 1024 + (ob ^ (((ob >> 9) & 1) << 5)); }
__host__ __device__ __forceinline__ void stage_rc(int b, int& R, int& C) { const int st = b / 1024, sb = b % 1024, swz = sb ^ (((sb >> 9) & 1) << 5); R = (st >> 1) * 16 + swz / 64; C = (st & 1) * 32 + (swz % 64) / 2; }
__host__ __device__ __forceinline__ int perm32(int rho) { const int n = rho >> 4, i = rho & 15; return 8 * (i >> 2) + 4 * n + (i & 3); }

struct Unit { int pm, pn; };
struct Gemm { const bf16_t* A; const bf16_t* Bt; int M, N, K; const PG8_LAS unsigned short* atab = nullptr; };
constexpr unsigned ACH_GS = 2304u * 256u * 2u;

struct StaticOrder {
    int nM, nN, nwg, G, c;
    __host__ __device__ void init(int M, int N, int G_, int c_) { nM = M / BM; nN = N / BM; nwg = nM * nN; G = G_; c = c_; }
    __host__ __device__ bool next(int i, Unit& u) const {
        const long L = (long)i * G + c; if (L >= nwg) return false;
        int wgid = (int)L; { const int q = nwg / NXCD, r = nwg % NXCD, xcd = wgid % NXCD, off = wgid / NXCD; wgid = (xcd < r ? xcd * (q + 1) : r * (q + 1) + (xcd - r) * q) + off; }
        const int nig = WGM * nN, gid = wgid / nig, fm = gid * WGM, gsz = (nM - fm) < WGM ? (nM - fm) : WGM;
        u.pm = fm + ((wgid % nig) % gsz); u.pn = (wgid % nig) / gsz; return true;
    }
    __device__ __forceinline__ void a_ready(const Unit&) const {}
    __device__ __forceinline__ void done(const Unit&) const {}
};

__device__ __forceinline__ unsigned cvt_pk_bf16(float lo, float hi) { unsigned r; asm volatile("v_cvt_pk_bf16_f32 %0, %1, %2" : "=v"(r) : "v"(lo), "v"(hi)); return r; }
typedef float f32x2 __attribute__((ext_vector_type(2)));
__device__ __forceinline__ u32x4 pack8(const f32x4 v0, const f32x4 v1) { u32x4 w; w.x = cvt_pk_bf16(v0[0], v0[1]); w.y = cvt_pk_bf16(v0[2], v0[3]); w.z = cvt_pk_bf16(v1[0], v1[1]); w.w = cvt_pk_bf16(v1[2], v1[3]); return w; }
__device__ __forceinline__ float bf_lo(unsigned u) { return __uint_as_float(u << 16); }
__device__ __forceinline__ float bf_hi(unsigned u) { return __uint_as_float(u & 0xffff0000u); }
__device__ __forceinline__ unsigned pk4_fp8(float a, float b, float c, float d) {
    a = __builtin_amdgcn_fmed3f(a, -448.f, 448.f); b = __builtin_amdgcn_fmed3f(b, -448.f, 448.f); c = __builtin_amdgcn_fmed3f(c, -448.f, 448.f); d = __builtin_amdgcn_fmed3f(d, -448.f, 448.f);
    int r = __builtin_amdgcn_cvt_pk_fp8_f32(a, b, 0, false); r = __builtin_amdgcn_cvt_pk_fp8_f32(c, d, r, true); return (unsigned)r; }
__device__ __forceinline__ float sigmoid_f(float x) { return __builtin_amdgcn_rcpf(1.0f + __builtin_amdgcn_exp2f(-1.4426950408889634f * x)); }

struct EpiPlain {
    static constexpr bool PERM = true, AFTER_DRAIN = false;
    bf16_t* O; int ldc; int pm_off; int nmod; float sc;
    __device__ __forceinline__ void operator()(const f32x4 (&acc)[2][2][4][2], const Unit& u, int wr, int wc, int fr, int fq) const {
        const int row0 = (u.pm - pm_off) * BM + wr * 64 + fr; const int ct = nmod ? (u.pn % nmod) : u.pn; const int col0 = ct * BM + wc * 32 + 8 * fq;
#pragma unroll
        for (int ai = 0; ai < 2; ++ai)
#pragma unroll
            for (int m = 0; m < 4; ++m) { bf16_t* rowp = O + (size_t)(row0 + ai * HALF + m * 16) * ldc + col0;
#pragma unroll
                for (int bj = 0; bj < 2; ++bj) *(u32x4*)(rowp + bj * HALF) = pack8(acc[ai][bj][m][0] * sc, acc[ai][bj][m][1] * sc); }
    }
};
struct EpiSplit {
    static constexpr bool PERM = true, AFTER_DRAIN = false;
    bf16_t* O0; int ld0; bf16_t* O1; int ld1; int nsplit; int ncols1;
    __device__ __forceinline__ void operator()(const f32x4 (&acc)[2][2][4][2], const Unit& u, int wr, int wc, int fr, int fq) const {
        const int row0 = u.pm * BM + wr * 64 + fr; const bool first = u.pn < nsplit;
        bf16_t* base = first ? O0 : O1; const int ld = first ? ld0 : ld1; const int col0 = (first ? u.pn : u.pn - nsplit) * BM + wc * 32 + 8 * fq; const int lim = first ? 0x7fffffff : ncols1;
#pragma unroll
        for (int ai = 0; ai < 2; ++ai)
#pragma unroll
            for (int m = 0; m < 4; ++m) { bf16_t* rowp = base + (size_t)(row0 + ai * HALF + m * 16) * ld + col0;
#pragma unroll
                for (int bj = 0; bj < 2; ++bj) if (col0 + bj * HALF < lim) *(u32x4*)(rowp + bj * HALF) = pack8(acc[ai][bj][m][0], acc[ai][bj][m][1]); }
    }
};
struct EpiGlu {
    static constexpr bool PERM = true, AFTER_DRAIN = false;
    const bf16_t* Aa; const float* bias; bf16_t* O; int ldc;
    __device__ __forceinline__ void operator()(const f32x4 (&acc)[2][2][4][2], const Unit& u, int wr, int wc, int fr, int fq) const {
        const int row0 = u.pm * BM + wr * 64 + fr; const int col0 = u.pn * BM + wc * 32 + 8 * fq;
        const int crow0 = (u.pm < 128 ? (u.pm >> 3) * 144 + 16 + (u.pm & 7) * 16 : (u.pm - 128) * 144) + wr * 4;
#pragma unroll
        for (int bj = 0; bj < 2; ++bj) { const f32x4 b0 = *(const f32x4*)(bias + col0 + bj * HALF), b1 = *(const f32x4*)(bias + col0 + bj * HALF + 4);
            const int cg = (col0 + bj * HALF) >> 4, ch = (col0 + bj * HALF) & 15;
#pragma unroll
            for (int ai = 0; ai < 2; ++ai)
#pragma unroll
                for (int m = 0; m < 4; ++m) { const size_t r = (size_t)(row0 + ai * HALF + m * 16);
                    const u32x4 a8 = *(const u32x4*)(Aa + (size_t)cg * (2304 * 256) + (size_t)(crow0 + ai * 8 + m) * 256 + fr * 16 + ch);
                    f32x4 v0 = acc[ai][bj][m][0] + b0, v1 = acc[ai][bj][m][1] + b1;
                    v0[0] = bf_lo(a8.x) * sigmoid_f(v0[0]); v0[1] = bf_hi(a8.x) * sigmoid_f(v0[1]); v0[2] = bf_lo(a8.y) * sigmoid_f(v0[2]); v0[3] = bf_hi(a8.y) * sigmoid_f(v0[3]);
                    v1[0] = bf_lo(a8.z) * sigmoid_f(v1[0]); v1[1] = bf_hi(a8.z) * sigmoid_f(v1[1]); v1[2] = bf_lo(a8.w) * sigmoid_f(v1[2]); v1[3] = bf_hi(a8.w) * sigmoid_f(v1[3]);
                    *(u32x4*)(O + r * ldc + col0 + bj * HALF) = pack8(v0, v1); } }
    }
};
struct EpiSwiGlu {
    static constexpr bool PERM = true, AFTER_DRAIN = false;
    bf16_t* O; int ldc; int pm_off; int nmod;
    __device__ __forceinline__ void operator()(const f32x4 (&acc)[2][2][4][2], const Unit& u, int wr, int wc, int fr, int fq) const {
        const int row0 = (u.pm - pm_off) * BM + wr * 64 + fr; const int ct = nmod ? (u.pn % nmod) : u.pn; const int col0 = ct * HALF + wc * 32 + 8 * fq;
#pragma unroll
        for (int ai = 0; ai < 2; ++ai)
#pragma unroll
            for (int m = 0; m < 4; ++m) { f32x4 o0, o1;
#pragma unroll
                for (int i = 0; i < 4; ++i) { const float g0 = acc[ai][0][m][0][i], g1 = acc[ai][0][m][1][i]; o0[i] = g0 * sigmoid_f(g0) * acc[ai][1][m][0][i]; o1[i] = g1 * sigmoid_f(g1) * acc[ai][1][m][1][i]; }
                *(u32x4*)(O + (size_t)(row0 + ai * HALF + m * 16) * ldc + col0) = pack8(o0, o1); }
    }
};
struct EpiIn0 {
    static constexpr bool PERM = true, AFTER_DRAIN = false;
    bf16_t* U; bf16_t* A3; bf16_t* Z0c;
    __device__ __forceinline__ void operator()(const f32x4 (&acc)[2][2][4][2], const Unit& u, int wr, int wc, int fr, int fq) const {
        if (u.pn >= 2) {
            const int row0 = u.pm * BM + wr * 64 + fr, col0 = (u.pn - 2) * BM + wc * 32 + 8 * fq;
#pragma unroll
            for (int ai = 0; ai < 2; ++ai)
#pragma unroll
                for (int m = 0; m < 4; ++m) { bf16_t* rowp = Z0c + (size_t)(row0 + ai * HALF + m * 16) * 512 + col0;
#pragma unroll
                    for (int bj = 0; bj < 2; ++bj) *(u32x4*)(rowp + bj * HALF) = pack8(acc[ai][bj][m][0], acc[ai][bj][m][1]); }
        } else {
            const int b = (u.pm < 128) ? (u.pm >> 3) : (u.pm - 128); const int c0 = (u.pm < 128) ? (16 + (u.pm & 7) * 16) : 0;
            const int g0 = u.pn * 16 + wc * 2 + (fq >> 1);
            const size_t r0 = (size_t)(g0 * 16 + b) * 144 + c0 + wr * 4;
            const int cc = fr * 16 + 8 * (fq & 1);
#pragma unroll
            for (int ai = 0; ai < 2; ++ai)
#pragma unroll
                for (int m = 0; m < 4; ++m)
#pragma unroll
                    for (int bj = 0; bj < 2; ++bj) { const size_t r = r0 + (size_t)bj * (8 * 16 * 144) + ai * 8 + m; const u32x4 w = pack8(acc[ai][bj][m][0], acc[ai][bj][m][1]);
                        *(u32x4*)(U + r * 256 + cc) = w; *(u32x4*)(A3 + r * 512 + cc) = w; }
        }
    }
};
struct EpiF32 {
    static constexpr bool PERM = false, AFTER_DRAIN = false;
    float* C; int ldc;
    __device__ __forceinline__ void operator()(const f32x4 (&acc)[2][2][4][2], const Unit& u, int wr, int wc, int fr, int fq) const {
        const int row0 = u.pm * BM + wr * 64 + fr, col0 = wc * 32 + 4 * fq;
#pragma unroll
        for (int ai = 0; ai < 2; ++ai)
#pragma unroll
            for (int m = 0; m < 4; ++m) { float* rowp = C + (size_t)(row0 + ai * HALF + m * 16) * ldc + col0;
#pragma unroll
                for (int bj = 0; bj < 2; ++bj)
#pragma unroll
                    for (int n = 0; n < 2; ++n) *(f32x4*)(rowp + bj * HALF + n * 16) = acc[ai][bj][m][n]; }
    }
};
__device__ __forceinline__ float gelu_tanh_f(float x) { const float t = 0.7978845608028654f * (x + 0.044715f * x * x * x); const float e = __builtin_amdgcn_exp2f(2.8853900817779268f * t); return x - x * __builtin_amdgcn_rcpf(e + 1.0f); }
struct EpiS5Out {
    static constexpr bool PERM = true, AFTER_DRAIN = false;
    bf16_t* AG;
    __device__ __forceinline__ void operator()(const f32x4 (&acc)[2][2][4][2], const Unit& u, int wr, int wc, int fr, int fq) const {
        const int row0 = u.pm * BM + wr * 64 + fr, col0 = wc * 32 + 8 * fq;
#pragma unroll
        for (int ai = 0; ai < 2; ++ai)
#pragma unroll
            for (int m = 0; m < 4; ++m) { bf16_t* rowp = AG + (size_t)(row0 + ai * HALF + m * 16) * 256 + col0;
#pragma unroll
                for (int bj = 0; bj < 2; ++bj) { f32x4 v0 = acc[ai][bj][m][0], v1 = acc[ai][bj][m][1];
#pragma unroll
                    for (int i = 0; i < 4; ++i) { v0[i] = gelu_tanh_f(v0[i]); v1[i] = gelu_tanh_f(v1[i]); }
                    *(u32x4*)(rowp + bj * HALF) = pack8(v0, v1); } }
    }
};
struct S5Order {
    int G, c;
    __device__ __forceinline__ bool next(int i, Unit& u) const { const int L = i * G + c; if (L >= 32 * 9) return false; u.pm = L; u.pn = L / 9; return true; }
    __device__ __forceinline__ void a_ready(const Unit&) const {}
    __device__ __forceinline__ void done(const Unit&) const {}
};
struct EpiSwiGlu8 {
    static constexpr bool PERM = true, AFTER_DRAIN = false;
    unsigned char* O; int ldc; int nmod; float us, os; int tiled;
    __device__ __forceinline__ void operator()(const f32x4 (&acc)[2][2][4][2], const Unit& u, int wr, int wc, int fr, int fq) const {
        const int row0 = u.pm * BM + wr * 64 + fr; const int ct = nmod ? (u.pn % nmod) : u.pn; const int col0 = ct * HALF + wc * 32 + 8 * fq;
        typedef unsigned u32x2_ __attribute__((ext_vector_type(2)));
#pragma unroll
        for (int ai = 0; ai < 2; ++ai)
#pragma unroll
            for (int m = 0; m < 4; ++m) { f32x4 o0, o1;
#pragma unroll
                for (int i = 0; i < 4; ++i) { const float g0 = acc[ai][0][m][0][i] * us, g1 = acc[ai][0][m][1][i] * us; o0[i] = g0 * sigmoid_f(g0) * (acc[ai][1][m][0][i] * us) * os; o1[i] = g1 * sigmoid_f(g1) * (acc[ai][1][m][1][i] * us) * os; }
                u32x2_ w; w.x = pk4_fp8(o0[0], o0[1], o0[2], o0[3]); w.y = pk4_fp8(o1[0], o1[1], o1[2], o1[3]);
                const int rr = wr * 64 + fr + ai * HALF + m * 16;
                if (tiled) *(u32x2_*)(O + (size_t)u.pm * BM * ldc + (size_t)ct * (BM * 128) + rr * 128 + wc * 32 + 8 * fq) = w;
                else *(u32x2_*)(O + (size_t)(row0 + ai * HALF + m * 16) * ldc + col0) = w; }
    }
};
struct MoeOrder {
    int t0, nT, nN, G, c; int e1, e2, e3, e4, e5, e6, e7; int rev;
    __device__ __forceinline__ bool next(int i, Unit& u) const {
        const int nwg = nT * nN; const long L = (long)i * G + c; if (L >= nwg) return false;
        int wgid = (int)L; { const int q = nwg / NXCD, r = nwg % NXCD, xcd = wgid % NXCD, off = wgid / NXCD, sz = xcd < r ? q + 1 : q; wgid = (xcd < r ? xcd * (q + 1) : r * (q + 1) + (xcd - r) * q) + (rev ? sz - 1 - off : off); }
        const int nig = WGM * nN, gid = wgid / nig, fm = gid * WGM, gsz = (nT - fm) < WGM ? (nT - fm) : WGM;
        const int pm = t0 + fm + ((wgid % nig) % gsz), pn = (wgid % nig) / gsz;
        const int e = (pm >= e1) + (pm >= e2) + (pm >= e3) + (pm >= e4) + (pm >= e5) + (pm >= e6) + (pm >= e7);
        u.pm = pm; u.pn = e * nN + pn; return true;
    }
    __device__ __forceinline__ void a_ready(const Unit&) const {}
    __device__ __forceinline__ void done(const Unit&) const {}
};
template <class Epi, class Sched, bool ALIGN_EPI = false, bool SP2 = false, bool FP8 = false, bool TILED = false, bool ACHUNK = false, bool AGATHER = false>
__device__ __forceinline__ void gemm_phase(PG8_LAS unsigned char* lds, const Gemm g, const Sched& S, const Epi& E) {
    const int tid = threadIdx.x, wid = __builtin_amdgcn_readfirstlane(tid >> 6), lane = tid & 63, wr = wid >> 2, wc = wid & 3, fr = lane & 15, fq = lane >> 4;
    const int K = g.K, nt = K / BK;
    unsigned voffA[2], voffB[2];
#pragma unroll
    for (int i = 0; i < 2; ++i) { int R, C; stage_rc(tid * 16 + i * 8192, R, C); const int Rb = Epi::PERM ? ((R & ~31) + perm32(R & 31)) : R;
        voffA[i] = TILED ? (unsigned)(R * BK + C) * 2u : (unsigned)(R * K + C) * 2u; voffB[i] = TILED ? (unsigned)(Rb * BK + C) * 2u : (unsigned)(Rb * K + C) * 2u;
        if (ACHUNK) voffA[i] = (unsigned)((R >> 4) * 512 + (R & 15) * 32 + (C & 15) * 2) + (unsigned)(C >> 4) * ACH_GS; }
    const size_t kstep = TILED ? (size_t)(BM * BK * 2) : (size_t)(BK * 2);
    const size_t hstep = TILED ? (size_t)(HALF * BK * 2) : (size_t)HALF * K * 2;
    const size_t tstep = (size_t)BM * K * 2;
    const size_t kstepA = ACHUNK ? (size_t)4 * ACH_GS : kstep, hstepA = ACHUNK ? (size_t)4096 : hstep;
#define PG8_ABASE(pm_) (AGATHER ? (const char*)g.A : ACHUNK ? (const char*)g.A + (size_t)((pm_) < 128 ? ((pm_) >> 3) * 144 + 16 + ((pm_) & 7) * 16 : ((pm_) - 128) * 144) * 512 : (const char*)g.A + (size_t)(pm_) * tstep)
    const unsigned ldsw = (unsigned)wid * 1024u;
    const int aoff = lds_byte(wr * 64 + fr, fq * 8), boff = lds_byte(wc * 32 + fr, fq * 8);
#define PG8_SA(b, h) (((b) * 2 + (h)) * HTB)
#define PG8_SB(b, h) ((4 + (b) * 2 + (h)) * HTB)
#define PG8_STAGE(bufoff, gbase, voff) do { _Pragma("unroll") for (int _i = 0; _i < 2; ++_i) \
        __builtin_amdgcn_global_load_lds((const unsigned*)((const char*)(gbase) + (voff)[_i]), (PG8_LAS unsigned*)(lds + (bufoff) + ldsw + _i * 8192), 16, 0, 0); } while (0)
    static_assert(!AGATHER || SP2, "AGATHER is written for the SP2 loop");
    unsigned gvA0[2] = {0u, 0u}, gvA1[2] = {0u, 0u}, gnA0[2] = {0u, 0u}, gnA1[2] = {0u, 0u};
#define PG8_GLOAD(uidx, v0, v1) do { _Pragma("unroll") for (int i_ = 0; i_ < 2; ++i_) { int R_, C_; stage_rc(tid * 16 + i_ * 8192, R_, C_); \
        const unsigned t0_ = g.atab[(uidx) * 256 + R_], t1_ = g.atab[(uidx) * 256 + 128 + R_]; v0[i_] = t0_ * (unsigned)(2 * K) + (unsigned)C_ * 2u; v1[i_] = t1_ * (unsigned)(2 * K) + (unsigned)C_ * 2u; } } while (0)
#define PG8_STAGE_A(bufoff, gbase, half, nx) do { if constexpr (AGATHER) { unsigned vs_[2]; \
        vs_[0] = (nx) ? ((half) ? gnA1[0] : gnA0[0]) : ((half) ? gvA1[0] : gvA0[0]); vs_[1] = (nx) ? ((half) ? gnA1[1] : gnA0[1]) : ((half) ? gvA1[1] : gvA0[1]); PG8_STAGE(bufoff, gbase, vs_); } \
        else PG8_STAGE(bufoff, (gbase) + ((half) ? hstepA : (size_t)0), voffA); } while (0)
#define PG8_LDA(dst, b, h) do { _Pragma("unroll") for (int m = 0; m < 4; ++m) _Pragma("unroll") for (int k = 0; k < 2; ++k) dst[m][k] = *(const PG8_LAS bf16x8*)(lds + PG8_SA(b, h) + aoff + m * 2048 + k * 1024); } while (0)
#define PG8_LDB(dst, b, h) do { _Pragma("unroll") for (int n = 0; n < 2; ++n) _Pragma("unroll") for (int k = 0; k < 2; ++k) dst[n][k] = *(const PG8_LAS bf16x8*)(lds + PG8_SB(b, h) + boff + n * 2048 + k * 1024); } while (0)
#define PG8_MMA(ai, bj, At, Bt) do { __builtin_amdgcn_s_setprio(1); _Pragma("unroll") for (int m = 0; m < 4; ++m) _Pragma("unroll") for (int n = 0; n < 2; ++n) { \
        if constexpr (FP8) { typedef int i32x4_ __attribute__((ext_vector_type(4))); typedef int i32x8_ __attribute__((ext_vector_type(8))); \
            const i32x8_ bo_ = __builtin_shufflevector(__builtin_bit_cast(i32x4_, Bt[n][0]), __builtin_bit_cast(i32x4_, Bt[n][1]), 0, 1, 2, 3, 4, 5, 6, 7); \
            const i32x8_ ao_ = __builtin_shufflevector(__builtin_bit_cast(i32x4_, At[m][0]), __builtin_bit_cast(i32x4_, At[m][1]), 0, 1, 2, 3, 4, 5, 6, 7); \
            asm volatile("v_mfma_scale_f32_16x16x128_f8f6f4 %0, %1, %2, %0, %3, %3 op_sel_hi:[0,0,0]" : "+v"(acc[ai][bj][m][n]) : "v"(bo_), "v"(ao_), "v"(fp8_unit_scale_)); } \
        else { _Pragma("unroll") for (int k = 0; k < 2; ++k) acc[ai][bj][m][n] = __builtin_amdgcn_mfma_f32_16x16x32_bf16(Bt[n][k], At[m][k], acc[ai][bj][m][n], 0, 0, 0); } } \
        __builtin_amdgcn_s_setprio(0); } while (0)
#define PG8_WAIT_V(n) asm volatile("s_waitcnt vmcnt(" #n ")" ::: "memory")
#define PG8_WAIT_L(n) asm volatile("s_waitcnt lgkmcnt(" #n ")" ::: "memory")
#define PG8_BAR __builtin_amdgcn_s_barrier()
#define PG8_SCHED __builtin_amdgcn_sched_barrier(0)
    const int fp8_unit_scale_ = 0x7f7f7f7f; (void)fp8_unit_scale_;
    Unit cur, nxt; int ui = 0;
    if (!S.next(0, cur)) return;
    f32x4 acc[2][2][4][2];
#pragma unroll
    for (int a = 0; a < 2; ++a)
#pragma unroll
        for (int b = 0; b < 2; ++b)
#pragma unroll
            for (int m = 0; m < 4; ++m)
#pragma unroll
                for (int n = 0; n < 2; ++n) acc[a][b][m][n] = (f32x4){0.f, 0.f, 0.f, 0.f};
    bf16x8 At[4][2], B0[2][2], B1[2][2];
    const char* cA = PG8_ABASE(cur.pm); const char* cB = (const char*)g.Bt + (size_t)cur.pn * tstep;
    if constexpr (AGATHER) PG8_GLOAD(0, gvA0, gvA1);
    S.a_ready(cur);
    if constexpr (SP2) {
        PG8_STAGE(PG8_SB(0, 0), cB, voffB); PG8_STAGE(PG8_SB(0, 1), cB + hstep, voffB); PG8_STAGE_A(PG8_SA(0, 0), cA, 0, false); PG8_STAGE_A(PG8_SA(0, 1), cA, 1, false);
        if (wr == 1) PG8_BAR;
        PG8_WAIT_V(2); PG8_BAR;
        PG8_STAGE(PG8_SB(1, 0), cB + kstep, voffB); PG8_STAGE_A(PG8_SA(1, 0), cA + kstepA, 0, false); PG8_STAGE(PG8_SB(1, 1), cB + hstep + kstep, voffB);
        PG8_WAIT_V(6); PG8_BAR;
    } else {
        PG8_STAGE(PG8_SB(0, 0), cB, voffB); PG8_STAGE(PG8_SA(0, 0), cA, voffA); PG8_STAGE(PG8_SB(0, 1), cB + hstep, voffB); PG8_STAGE(PG8_SA(0, 1), cA + hstepA, voffA);
        if (wr == 1) PG8_BAR;
        PG8_WAIT_V(4); PG8_BAR;
        PG8_STAGE(PG8_SB(1, 0), cB + kstep, voffB); PG8_STAGE(PG8_SA(1, 0), cA + kstepA, voffA); PG8_STAGE(PG8_SB(1, 1), cB + hstep + kstep, voffB);
        PG8_WAIT_V(6); PG8_BAR;
    }
    for (;;) {
        const bool has_next = S.next(ui + 1, nxt);
        const char* nA = has_next ? PG8_ABASE(nxt.pm) : cA; const char* nB = has_next ? (const char*)g.Bt + (size_t)nxt.pn * tstep : cB;
        for (int t = 0; t < nt; t += 2) {
            const bool last = (t == nt - 2);
            const char* a1 = cA + (size_t)(t + 1) * kstepA;
            const char* a2 = last ? nA : cA + (size_t)(t + 2) * kstepA; const char* b2 = last ? nB : cB + (size_t)(t + 2) * kstep;
            const char* a3 = a2 + kstepA; const char* b3 = b2 + kstep;
            if (last && has_next) S.a_ready(nxt);
            const bool nx_ = last && has_next;
            if constexpr (AGATHER) { if (nx_) PG8_GLOAD(ui + 1, gnA0, gnA1); }
            if constexpr (SP2) {
            PG8_LDB(B0, 0, 0); PG8_LDB(B1, 0, 1); PG8_SCHED; PG8_LDA(At, 0, 0); PG8_STAGE_A(PG8_SA(1, 1), a1, 1, false);
            PG8_WAIT_V(8); PG8_WAIT_L(0); PG8_BAR; PG8_MMA(0, 0, At, B0); PG8_MMA(0, 1, At, B1); PG8_BAR; PG8_SCHED;
            PG8_LDA(At, 0, 1); PG8_STAGE(PG8_SB(0, 0), b2, voffB); PG8_STAGE(PG8_SB(0, 1), b2 + hstep, voffB); PG8_STAGE_A(PG8_SA(0, 0), a2, 0, nx_);
            PG8_WAIT_V(8); PG8_WAIT_L(0); PG8_BAR; PG8_MMA(1, 0, At, B0); PG8_MMA(1, 1, At, B1); PG8_BAR; PG8_SCHED;
            PG8_LDB(B0, 1, 0); PG8_LDB(B1, 1, 1); PG8_SCHED; PG8_LDA(At, 1, 0); PG8_STAGE_A(PG8_SA(0, 1), a2, 1, nx_);
            PG8_WAIT_V(8); PG8_WAIT_L(0); PG8_BAR; PG8_MMA(0, 0, At, B0); PG8_MMA(0, 1, At, B1); PG8_BAR; PG8_SCHED;
            PG8_LDA(At, 1, 1); PG8_STAGE(PG8_SB(1, 0), b3, voffB); PG8_STAGE(PG8_SB(1, 1), b3 + hstep, voffB); PG8_STAGE_A(PG8_SA(1, 0), a3, 0, nx_);
            PG8_WAIT_V(8); PG8_WAIT_L(0); PG8_BAR; PG8_MMA(1, 0, At, B0); PG8_MMA(1, 1, At, B1); PG8_BAR; PG8_SCHED;
            } else {
            PG8_LDB(B0, 0, 0); PG8_SCHED; PG8_LDA(At, 0, 0); PG8_STAGE(PG8_SA(1, 1), a1 + hstepA, voffA);
            PG8_WAIT_L(8); PG8_BAR; PG8_WAIT_L(0); PG8_MMA(0, 0, At, B0); PG8_BAR; PG8_SCHED;
            PG8_LDB(B1, 0, 1); PG8_STAGE(PG8_SB(0, 0), b2, voffB);
            PG8_BAR; PG8_WAIT_L(0); PG8_MMA(0, 1, At, B1); PG8_BAR;
            PG8_LDA(At, 0, 1); PG8_STAGE(PG8_SA(0, 0), a2, voffA);
            PG8_BAR; PG8_WAIT_L(0); PG8_MMA(1, 0, At, B0); PG8_BAR; PG8_SCHED;
            PG8_STAGE(PG8_SB(0, 1), b2 + hstep, voffB);
            PG8_WAIT_V(6); PG8_BAR; PG8_MMA(1, 1, At, B1); PG8_BAR;
            PG8_LDB(B0, 1, 0); PG8_SCHED; PG8_LDA(At, 1, 0); PG8_STAGE(PG8_SA(0, 1), a2 + hstepA, voffA);
            PG8_WAIT_L(8); PG8_BAR; PG8_WAIT_L(0); PG8_MMA(0, 0, At, B0); PG8_BAR; PG8_SCHED;
            PG8_LDB(B1, 1, 1); PG8_STAGE(PG8_SB(1, 0), b3, voffB);
            PG8_BAR; PG8_WAIT_L(0); PG8_MMA(0, 1, At, B1); PG8_BAR;
            PG8_LDA(At, 1, 1); PG8_STAGE(PG8_SA(1, 0), a3, voffA);
            PG8_BAR; PG8_WAIT_L(0); PG8_MMA(1, 0, At, B0); PG8_BAR; PG8_SCHED;
            PG8_STAGE(PG8_SB(1, 1), b3 + hstep, voffB);
            PG8_WAIT_V(6); PG8_BAR; PG8_MMA(1, 1, At, B1); PG8_BAR;
            }
        }
        if constexpr (ALIGN_EPI) { if (wr == 0) PG8_BAR; }
        if constexpr (FP8) asm volatile("s_nop 15\n\ts_nop 7" ::: "memory");
        if constexpr (!Epi::AFTER_DRAIN) { E(acc, cur, wr, wc, fr, fq); S.done(cur); }
        if (!has_next) break;
#pragma unroll
        for (int a = 0; a < 2; ++a)
#pragma unroll
            for (int b = 0; b < 2; ++b)
#pragma unroll
                for (int m = 0; m < 4; ++m)
#pragma unroll
                    for (int n = 0; n < 2; ++n) acc[a][b][m][n] = (f32x4){0.f, 0.f, 0.f, 0.f};
        cur = nxt; cA = nA; cB = nB; ++ui;
        if constexpr (AGATHER) { gvA0[0] = gnA0[0]; gvA0[1] = gnA0[1]; gvA1[0] = gnA1[0]; gvA1[1] = gnA1[1]; }
        if constexpr (ALIGN_EPI) { if (wr == 1) PG8_BAR; }
    }
    PG8_WAIT_V(0);
    if constexpr (!ALIGN_EPI) { if (wr == 0) PG8_BAR; }
    PG8_BAR;
    if constexpr (Epi::AFTER_DRAIN) { E.fused(acc, cur, wr, wc, fr, fq, lds, wid, lane); S.done(cur); }
#undef PG8_ABASE
#undef PG8_GLOAD
#undef PG8_STAGE_A
#undef PG8_SA
#undef PG8_SB
#undef PG8_STAGE
#undef PG8_LDA
#undef PG8_LDB
#undef PG8_MMA
#undef PG8_WAIT_V
#undef PG8_WAIT_L
#undef PG8_BAR
#undef PG8_SCHED
}
}
#define GAS __attribute__((address_space(1)))
#define LAS __attribute__((address_space(3)))
typedef unsigned short bf16;
typedef unsigned v4u __attribute__((ext_vector_type(4)));
typedef float f32x4 __attribute__((ext_vector_type(4)));
typedef short bf16x8 __attribute__((ext_vector_type(8)));
typedef GAS unsigned gu32;
typedef GAS unsigned long long gu64;
#define RLX_AGENT __ATOMIC_RELAXED, __HIP_MEMORY_SCOPE_AGENT
#define LDS_WAIT() asm volatile("s_waitcnt lgkmcnt(0)" ::: "memory")
#define VM_WAIT() asm volatile("s_waitcnt vmcnt(0)" ::: "memory")
__device__ __forceinline__ unsigned long long rt() { return __builtin_amdgcn_s_memrealtime(); }
__device__ __forceinline__ unsigned f2bf(float f) { unsigned u = __builtin_bit_cast(unsigned, f); return (u + 0x7fffu + ((u >> 16) & 1u)) >> 16; }
__device__ __forceinline__ unsigned pk2(float lo, float hi) { return f2bf(lo) | (f2bf(hi) << 16); }
#define XB_TMO      128
#define XB_XCNT(j)  (256  + 64 * (j))
#define XB_XSUB(j)  (1280 + 64 * (j))
#define XB_XGEN(j)  (2304 + 64 * (j))
#define XB_TOP      3328
#define XB_TOPGEN   3392
#define XCD_BAR_WORDS 3456
#define XB_SPIN_CAP (1u << 18)

__device__ __forceinline__ unsigned xb_ld(unsigned* p)              { return __hip_atomic_load(p, __ATOMIC_RELAXED, __HIP_MEMORY_SCOPE_AGENT); }
__device__ __forceinline__ unsigned xb_add(unsigned* p, unsigned v) { return __hip_atomic_fetch_add(p, v, __ATOMIC_RELAXED, __HIP_MEMORY_SCOPE_AGENT); }
__device__ __forceinline__ unsigned xb_xcc_id() { return (unsigned)__builtin_amdgcn_s_getreg((3 << 11) | 20) & 0xFu; }
#define XB_SPIN(cond, bar) do { unsigned _sp = 0; while (cond) { __builtin_amdgcn_s_sleep(1); \
    if ((++_sp & 255u) == 0u) { if (xb_ld(&(bar)[XB_TMO])) break; if (_sp > XB_SPIN_CAP) { atomicAdd(&(bar)[XB_TMO], 1u); break; } } } } while (0)

struct XcdBarrier {
    unsigned* bar; unsigned x;
    volatile LAS unsigned* st;
};

__device__ __forceinline__ XcdBarrier xcd_barrier_post(unsigned* bar, volatile LAS unsigned* st) {
    XcdBarrier b; b.bar = bar; b.x = xb_xcc_id(); b.st = st;
    if (threadIdx.x == 0) (void)xb_add(&bar[XB_XCNT(b.x)], 1u);
    return b;
}
__device__ __forceinline__ void xcd_barrier_complete(unsigned* bar, unsigned x, unsigned& nloc, unsigned& nx) {
    const unsigned G = gridDim.x * gridDim.y * gridDim.z;
    unsigned sum, cnt, mine, sp = 0u;
    for (;;) {
        sum = 0u; cnt = 0u; mine = 0u;
#pragma unroll
        for (unsigned j = 0; j < 16; ++j) { const unsigned c = xb_ld(&bar[XB_XCNT(j)]); sum += c; cnt += (c > 0u) ? 1u : 0u; mine = (j == x) ? c : mine; }
        if (sum == G) break;
        __builtin_amdgcn_s_sleep(1);
        if ((++sp & 255u) == 0u) { if (xb_ld(&bar[XB_TMO])) break; if (sp > XB_SPIN_CAP) { atomicAdd(&bar[XB_TMO], 1u); break; } }
    }
    nloc = mine > 0u ? mine : 1u; nx = cnt > 0u ? cnt : 1u;
}

__device__ __forceinline__ void xcd_barrier(const XcdBarrier& b) {
    asm volatile("s_waitcnt vmcnt(0)" ::: "memory");
    __syncthreads();
    if (threadIdx.x == 0) {
        unsigned* bar = b.bar;
        __builtin_amdgcn_s_waitcnt(0);
        unsigned nloc = b.st[0], nx = b.st[1];
        if (nloc == 0u) { xcd_barrier_complete(bar, b.x, nloc, nx); b.st[0] = nloc; b.st[1] = nx; }
        const unsigned old = xb_add(&bar[XB_XSUB(b.x)], 1u);
        const unsigned gen = old / nloc;
        if (old + 1u == (gen + 1u) * nloc) {
            __builtin_amdgcn_fence(__ATOMIC_RELEASE, "agent");
            asm volatile("s_waitcnt vmcnt(0)" ::: "memory");
            const unsigned og = xb_add(&bar[XB_TOP], 1u);
            const unsigned tg = og / nx;
            if (og + 1u == (tg + 1u) * nx) xb_add(&bar[XB_TOPGEN], 1u);
            else XB_SPIN(xb_ld(&bar[XB_TOPGEN]) == tg, bar);
            __builtin_amdgcn_fence(__ATOMIC_ACQUIRE, "agent");
            xb_add(&bar[XB_XGEN(b.x)], 1u);
            asm volatile("s_waitcnt vmcnt(0)" ::: "memory");
        } else {
            XB_SPIN(xb_ld(&bar[XB_XGEN(b.x)]) == gen, bar);
            __builtin_amdgcn_fence(__ATOMIC_ACQUIRE, "agent");
            asm volatile("s_waitcnt vmcnt(0)" ::: "memory");
        }
    }
    __syncthreads();
}

namespace att {
typedef short bf16x8 __attribute__((ext_vector_type(8)));
typedef short s16x4 __attribute__((ext_vector_type(4)));
typedef float f32x16 __attribute__((ext_vector_type(16)));
typedef unsigned u32x4 __attribute__((ext_vector_type(4)));
#define ATT_LAS __attribute__((address_space(3)))
constexpr int QBLK = 32, KVBLK = 64, DQ = 96, DV = 64, LDQ = 768, LDKN = 1024, LDKR = 32, LDV = 1024, LDO = 1024;
typedef const __attribute__((address_space(1))) unsigned short* gcp; typedef __attribute__((address_space(1))) unsigned short* gp;
constexpr float SCALE = 0.10206207261596577f, QSC = SCALE * 1.4426950408889634f, THR2 = 8.f * 1.4426950408889634f;
constexpr int SHM_V = KVBLK * DV * 2, SHM_K = KVBLK * 256, NRING = 4, OFF_K = 0, OFF_V = NRING * SHM_K, OFF_WS = NRING * (SHM_V + SHM_K), ATT_LDS = OFF_WS + 8 * 256;
#define KSWZ(row, colB) ((row) * 256 + ((colB) ^ (((row) & 7) << 4)))
#define SBAR() __builtin_amdgcn_sched_barrier(0)
__device__ __forceinline__ int crow(int r, int hi) { return (r & 3) + 8 * (r >> 2) + 4 * hi; }
__device__ __forceinline__ unsigned cvtpk(float lo, float hi) { unsigned r; asm volatile("v_cvt_pk_bf16_f32 %0, %1, %2" : "=v"(r) : "v"(lo), "v"(hi)); return r; }
template <bool FIRST> __device__ __forceinline__ void partialSM(f32x16& p0, f32x16& p1, f32x16& mC, float& alpha) {
  float pmax = p0[0];
#pragma unroll
  for (int r = 1; r < 16; ++r) pmax = fmaxf(pmax, p0[r]);
#pragma unroll
  for (int r = 0; r < 16; ++r) pmax = fmaxf(pmax, p1[r]);
  { auto rr = __builtin_amdgcn_permlane32_swap(__float_as_uint(pmax), __float_as_uint(pmax), false, false);
    pmax = fmaxf(__uint_as_float(rr[0]), __uint_as_float(rr[1])); }
  if (!FIRST && __builtin_expect(__all(pmax <= THR2), 1)) alpha = 1.f;
  else { const float d = FIRST ? pmax : fmaxf(pmax, 0.f); alpha = __builtin_amdgcn_exp2f(-d);
#pragma unroll
    for (int r = 0; r < 16; ++r) { p0[r] -= d; p1[r] -= d; mC[r] -= d; } }
#pragma unroll
  for (int r = 0; r < 16; ++r) p0[r] = __builtin_amdgcn_exp2f(p0[r]);
}
__device__ __forceinline__ void finishSM(f32x16& p0, f32x16& p1, bf16x8& pa0, bf16x8& pa1, bf16x8& pa2, bf16x8& pa3) {
#pragma unroll
  for (int r = 0; r < 16; ++r) p1[r] = __builtin_amdgcn_exp2f(p1[r]);
#define PK4(P, BASE, OUT) do { u32x4 w = {cvtpk(P[BASE + 0], P[BASE + 1]), cvtpk(P[BASE + 2], P[BASE + 3]), cvtpk(P[BASE + 4], P[BASE + 5]), cvtpk(P[BASE + 6], P[BASE + 7])}; OUT = __builtin_bit_cast(bf16x8, w); } while (0)
  PK4(p0, 0, pa0); PK4(p0, 8, pa1); PK4(p1, 0, pa2); PK4(p1, 8, pa3);
#undef PK4
}
__device__ __forceinline__ void qkt(f32x16& p0, f32x16& p1, const f32x16& mC, const ATT_LAS unsigned char* Ks, const bf16x8* qr, int r32, int hi) {
#pragma unroll
  for (int d0 = 0; d0 < DQ / 16; ++d0) { const int cb = (d0 * 16 + hi * 8) * 2;
    const bf16x8 b0 = *(const ATT_LAS bf16x8*)(Ks + KSWZ(r32, cb));
    const bf16x8 b1 = *(const ATT_LAS bf16x8*)(Ks + KSWZ(32 + r32, cb));
    p0 = __builtin_amdgcn_mfma_f32_32x32x16_bf16(b0, qr[d0], d0 ? p0 : mC, 0, 0, 0);
    p1 = __builtin_amdgcn_mfma_f32_32x32x16_bf16(b1, qr[d0], d0 ? p1 : mC, 0, 0, 0); }
}
__device__ __forceinline__ int v_st(int k, int c) { const int kk = k; return ((kk >> 3) * 2 + (c >> 5)) * 512 + ((kk & 7) * 32 + (c & 31)) * 2; }
__device__ __forceinline__ int v_rd_base(int lane) { return ((lane & 3) << 3) | (((lane >> 2) & 3) << 6) | (((lane >> 4) & 1) << 5) | (((lane >> 5) & 1) << 8); }
constexpr int v_rd_off(int d0, int ks, int half) { return d0 * 512 + ks * 2048 + half * 1024; }
struct KPre { bf16x8 a0, b0, a1, b1; };
#define KLDX(KS, D0, A, B) do { A = *(const ATT_LAS bf16x8*)((KS) + KSWZ(r32, ((D0) * 16 + hi * 8) * 2)); B = *(const ATT_LAS bf16x8*)((KS) + KSWZ(32 + r32, ((D0) * 16 + hi * 8) * 2)); } while (0)
#define VLD(D0, KS_, H) __builtin_amdgcn_ds_read_tr16_b64_v4i16((ATT_LAS s16x4*)(vbp + VO + v_rd_off(D0, KS_, H)))
#define PK(L, H) (bf16x8){L[0], L[1], L[2], L[3], H[0], H[1], H[2], H[3]}
#define MFMA(A, B, C) __builtin_amdgcn_mfma_f32_32x32x16_bf16(A, B, C, 0, 0, 0)
template <int VO> __device__ __forceinline__ void region1(f32x16& n0, f32x16& n1, const f32x16& mC, const ATT_LAS unsigned char* Ks, const bf16x8* qr, int r32, int hi, const KPre& kp,
                                                          f32x16& p0, f32x16& p1, bf16x8& pa0, bf16x8& pa1, bf16x8& pa2, bf16x8& pa3, const ATT_LAS unsigned char* vbp, s16x4* vf) {
  bf16x8 kA[DQ / 16], kB[DQ / 16]; unsigned w[16]; kA[0] = kp.a0; kB[0] = kp.b0; kA[1] = kp.a1; kB[1] = kp.b1;
#define KLD(D0) KLDX(Ks, D0, kA[D0], kB[D0])
#define KMM(D0) do { n0 = MFMA(kA[D0], qr[D0], (D0) ? n0 : mC); n1 = MFMA(kB[D0], qr[D0], (D0) ? n1 : mC); } while (0)
#define EXP1(R) p1[R] = __builtin_amdgcn_exp2f(p1[R])
  KLD(2); KMM(0); EXP1(0); EXP1(1); EXP1(2); EXP1(3); EXP1(4); EXP1(5); w[0] = cvtpk(p0[0], p0[1]); w[1] = cvtpk(p0[2], p0[3]); SBAR();
  KLD(3); KMM(1); EXP1(6); EXP1(7); EXP1(8); EXP1(9); EXP1(10); EXP1(11); w[2] = cvtpk(p0[4], p0[5]); w[3] = cvtpk(p0[6], p0[7]); SBAR();
  KLD(4); KMM(2); EXP1(12); EXP1(13); EXP1(14); EXP1(15); w[4] = cvtpk(p0[8], p0[9]); w[5] = cvtpk(p0[10], p0[11]); w[6] = cvtpk(p0[12], p0[13]); w[7] = cvtpk(p0[14], p0[15]); SBAR();
  KLD(5); KMM(3); w[8] = cvtpk(p1[0], p1[1]); w[9] = cvtpk(p1[2], p1[3]); w[10] = cvtpk(p1[4], p1[5]); w[11] = cvtpk(p1[6], p1[7]); SBAR();
#pragma unroll
  for (int ks = 0; ks < 4; ++ks) { vf[2 * ks] = VLD(0, ks, 0); vf[2 * ks + 1] = VLD(0, ks, 1); }
  KMM(4); w[12] = cvtpk(p1[8], p1[9]); w[13] = cvtpk(p1[10], p1[11]); w[14] = cvtpk(p1[12], p1[13]); w[15] = cvtpk(p1[14], p1[15]); SBAR();
  KMM(5);
#undef KLD
#undef KMM
#undef EXP1
  { const u32x4 a = {w[0], w[1], w[2], w[3]}, b = {w[4], w[5], w[6], w[7]}, c = {w[8], w[9], w[10], w[11]}, d = {w[12], w[13], w[14], w[15]};
    pa0 = __builtin_bit_cast(bf16x8, a); pa1 = __builtin_bit_cast(bf16x8, b); pa2 = __builtin_bit_cast(bf16x8, c); pa3 = __builtin_bit_cast(bf16x8, d); }
}
template <int VO> __device__ __forceinline__ void region2(f32x16* o, const s16x4* vf, const ATT_LAS unsigned char* vbp, bf16x8 pa0, bf16x8 pa1, bf16x8 pa2, bf16x8 pa3, bf16x8 ones,
                                                          f32x16& n0, f32x16& n1, f32x16& mC, float& alpha) {
  s16x4 vg[8];
#pragma unroll
  for (int ks = 0; ks < 4; ++ks) { vg[2 * ks] = VLD(1, ks, 0); vg[2 * ks + 1] = VLD(1, ks, 1); }
#define MX3(A, P, R) A = fmaxf(fmaxf(A, P[R]), P[R + 1])
  o[0] = MFMA(pa0, PK(vf[0], vf[1]), o[0]); o[2] = MFMA(pa0, ones, o[2]); SBAR();
  float ma = fmaxf(n0[0], n0[1]), mb = fmaxf(n1[0], n1[1]);
  o[0] = MFMA(pa1, PK(vf[2], vf[3]), o[0]); o[2] = MFMA(pa1, ones, o[2]); MX3(ma, n0, 2); MX3(mb, n1, 2); MX3(ma, n0, 4); MX3(mb, n1, 4); SBAR();
  o[0] = MFMA(pa2, PK(vf[4], vf[5]), o[0]); o[2] = MFMA(pa2, ones, o[2]); MX3(ma, n0, 6); MX3(mb, n1, 6); MX3(ma, n0, 8); MX3(mb, n1, 8); MX3(ma, n0, 10); MX3(mb, n1, 10); SBAR();
  o[0] = MFMA(pa3, PK(vf[6], vf[7]), o[0]); o[2] = MFMA(pa3, ones, o[2]); MX3(ma, n0, 12); MX3(mb, n1, 12); MX3(ma, n0, 14); MX3(mb, n1, 14);
  float pmax = fmaxf(ma, mb);
  { auto rr = __builtin_amdgcn_permlane32_swap(__float_as_uint(pmax), __float_as_uint(pmax), false, false);
    pmax = fmaxf(__uint_as_float(rr[0]), __uint_as_float(rr[1])); }
  if (__builtin_expect(__all(pmax <= THR2), 1)) alpha = 1.f;
  else { const float d = fmaxf(pmax, 0.f); alpha = __builtin_amdgcn_exp2f(-d);
#pragma unroll
    for (int r = 0; r < 16; ++r) { n0[r] -= d; n1[r] -= d; mC[r] -= d; } }
#define EXP4(R) do { float e0 = __builtin_amdgcn_exp2f(n0[R]), e1 = __builtin_amdgcn_exp2f(n0[R + 1]), e2 = __builtin_amdgcn_exp2f(n0[R + 2]), e3 = __builtin_amdgcn_exp2f(n0[R + 3]); \
    asm volatile("" : "+v"(e0), "+v"(e1), "+v"(e2), "+v"(e3)); n0[R] = e0; n0[R + 1] = e1; n0[R + 2] = e2; n0[R + 3] = e3; } while (0)
  SBAR(); o[1] = MFMA(pa0, PK(vg[0], vg[1]), o[1]); EXP4(0); SBAR();
  o[1] = MFMA(pa1, PK(vg[2], vg[3]), o[1]); EXP4(4); SBAR();
  o[1] = MFMA(pa2, PK(vg[4], vg[5]), o[1]); EXP4(8); SBAR();
  o[1] = MFMA(pa3, PK(vg[6], vg[7]), o[1]); EXP4(12);
#undef EXP4
#undef MX3
}
template <int VO> __device__ __forceinline__ void pv_last(f32x16* o, const ATT_LAS unsigned char* vbp, bf16x8 pa0, bf16x8 pa1, bf16x8 pa2, bf16x8 pa3, bf16x8 ones) {
  s16x4 vf[8], vg[8];
#pragma unroll
  for (int ks = 0; ks < 4; ++ks) { vf[2 * ks] = VLD(0, ks, 0); vf[2 * ks + 1] = VLD(0, ks, 1); vg[2 * ks] = VLD(1, ks, 0); vg[2 * ks + 1] = VLD(1, ks, 1); }
  o[0] = MFMA(pa0, PK(vf[0], vf[1]), o[0]); o[1] = MFMA(pa0, PK(vg[0], vg[1]), o[1]); o[2] = MFMA(pa0, ones, o[2]);
  o[0] = MFMA(pa1, PK(vf[2], vf[3]), o[0]); o[1] = MFMA(pa1, PK(vg[2], vg[3]), o[1]); o[2] = MFMA(pa1, ones, o[2]);
  o[0] = MFMA(pa2, PK(vf[4], vf[5]), o[0]); o[1] = MFMA(pa2, PK(vg[4], vg[5]), o[1]); o[2] = MFMA(pa2, ones, o[2]);
  o[0] = MFMA(pa3, PK(vf[6], vf[7]), o[0]); o[1] = MFMA(pa3, PK(vg[6], vg[7]), o[1]); o[2] = MFMA(pa3, ones, o[2]);
}
#undef VLD
#undef PK
#undef MFMA

__device__ __forceinline__ void attn_unit(const unsigned short* Qb_, const unsigned short* Kn_, const unsigned short* Kr_, const unsigned short* Vc_, int ra, int nt_a, int rb, int NT,
                                          unsigned short* Ob_, ATT_LAS unsigned char* lds, int rope_t0) {
  gcp Qb = (gcp)Qb_, Kn = (gcp)Kn_, Kr = (gcp)Kr_, Vc = (gcp)Vc_; gp Ob = (gp)Ob_;
  const int tid = threadIdx.x, wid = tid >> 6, lane = tid & 63, r32 = lane & 31, hi = lane >> 5;
  ATT_LAS unsigned char* V_lds = lds + OFF_V; ATT_LAS unsigned char* K_lds = lds + OFF_K;
  ATT_LAS float* wsp = (ATT_LAS float*)(lds + OFF_WS) + wid * 64; ATT_LAS float* al_l = wsp + 32;
  f32x16 o[3] = {}, mC = {}; bf16x8 qr[DQ / 16]; const u32x4 ones_w = {0x3f803f80u, 0x3f803f80u, 0x3f803f80u, 0x3f803f80u}; const bf16x8 ones = __builtin_bit_cast(bf16x8, ones_w);
  const int sk = tid >> 3, sc = (tid & 7) * 8, rk = (tid & 255) >> 2, rc = (tid & 3) * 8; const bool rw = tid < 256;
  const int vst = v_st(sk, sc), kst0 = KSWZ(sk, sc * 2), kst1 = KSWZ(rk, (64 + rc) * 2);
  struct SR { bf16x8 vs, k0, k1; };
#define TROW(t) ((t) < nt_a ? ra + (t) * KVBLK : rb + ((t) - nt_a) * KVBLK)
#define SLOADX(S, t) do { const long r0_ = TROW(t); S.vs = *(const __attribute__((address_space(1))) bf16x8*)(Vc + (r0_ + sk) * LDV + sc); S.k0 = *(const __attribute__((address_space(1))) bf16x8*)(Kn + (r0_ + sk) * LDKN + sc); \
    S.k1 = *(const __attribute__((address_space(1))) bf16x8*)(Kr + (r0_ + rk) * LDKR + rc); } while (0)
#define SWRITEX(b, S) do { *(ATT_LAS bf16x8*)(V_lds + (b) * SHM_V + vst) = S.vs; *(ATT_LAS bf16x8*)(K_lds + (b) * SHM_K + kst0) = S.k0; \
    if (rw) *(ATT_LAS bf16x8*)(K_lds + (b) * SHM_K + kst1) = S.k1; } while (0)
  SR s0_, s1_, sr_; SLOADX(s0_, 0); SLOADX(s1_, 1); SLOADX(sr_, 2);
  gcp Qw = Qb + (long)(wid * QBLK + r32) * LDQ + hi * 8;
#pragma unroll
  for (int d0 = 0; d0 < DQ / 16; ++d0) qr[d0] = *(const __attribute__((address_space(1))) bf16x8*)(Qw + d0 * 16);
  if (rope_t0 >= 0) {
    int t = rope_t0 + wid * QBLK + r32; asm volatile("" : "+v"(t));
    const float prow = (float)(t >> 6), pcol = (float)(t & 63);
#pragma unroll
    for (int f = 0; f < 2; ++f) { const u32x4 own = __builtin_bit_cast(u32x4, qr[4 + f]); u32x4 oth;
      oth.x = (unsigned)__shfl_xor((int)own.x, 32); oth.y = (unsigned)__shfl_xor((int)own.y, 32); oth.z = (unsigned)__shfl_xor((int)own.z, 32); oth.w = (unsigned)__shfl_xor((int)own.w, 32);
      const float pos = f ? pcol : prow; float o8[8];
#pragma unroll
      for (int j = 0; j < 8; ++j) { const unsigned wo = (j < 2) ? own.x : (j < 4) ? own.y : (j < 6) ? own.z : own.w, wp = (j < 2) ? oth.x : (j < 4) ? oth.y : (j < 6) ? oth.z : oth.w;
        const float a = (j & 1) ? __uint_as_float(wo & 0xffff0000u) : __uint_as_float(wo << 16), bq = (j & 1) ? __uint_as_float(wp & 0xffff0000u) : __uint_as_float(wp << 16);
        const float ang = pos * __builtin_amdgcn_exp2f(-(float)j * (13.287712379549449f / 8.0f)); float sn, cs; __sincosf(ang, &sn, &cs);
        o8[j] = hi ? (a * cs + bq * sn) : (a * cs - bq * sn); }
      u32x4 w = {cvtpk(o8[0], o8[1]), cvtpk(o8[2], o8[3]), cvtpk(o8[4], o8[5]), cvtpk(o8[6], o8[7])}; qr[4 + f] = __builtin_bit_cast(bf16x8, w); } }
#pragma unroll
  for (int d0 = 0; d0 < DQ / 16; ++d0) { const u32x4 w = __builtin_bit_cast(u32x4, qr[d0]); u32x4 q;
#pragma unroll
    for (int i = 0; i < 4; ++i) q[i] = cvtpk(__uint_as_float(w[i] << 16) * QSC, __uint_as_float(w[i] & 0xffff0000u) * QSC);
    qr[d0] = __builtin_bit_cast(bf16x8, q); }
#define SLOAD(t) SLOADX(sr_, t)
#define SWRITE(b) SWRITEX(b, sr_)
#define SWAIT() asm volatile("s_waitcnt vmcnt(0)" ::: "memory")
#define BAR() asm volatile("s_barrier" ::: "memory")
#define RESC(a) do { if (__any((a) < 1.f)) { if (hi == 0) al_l[r32] = (a); asm volatile("s_waitcnt lgkmcnt(0)" ::: "memory"); \
    _Pragma("unroll") for (int d = 0; d < 3; ++d) _Pragma("unroll") for (int r = 0; r < 16; ++r) o[d][r] *= al_l[crow(r, hi)]; } } while (0)
#define KPRE(KB) do { KLDX(K_lds + (KB) * SHM_K, 0, kp.a0, kp.b0); KLDX(K_lds + (KB) * SHM_K, 1, kp.a1, kp.b1); } while (0)
  f32x16 pA0, pA1, pB0, pB1; float alA, alB; bf16x8 pa0, pa1, pa2, pa3; KPre kp; s16x4 vf[8];
  const ATT_LAS unsigned char* vbp = V_lds + v_rd_base(lane);
  SWAIT(); SWRITEX(0, s0_); SWRITEX(1, s1_); SWRITE(2); SLOAD(3); __syncthreads();
  qkt(pA0, pA1, mC, K_lds, qr, r32, hi); partialSM<true>(pA0, pA1, mC, alA);
  KPRE(1); BAR();
#define STEP(PN0, PN1, ALN, PO0, PO1, KB, VB, T, WR, LD, NX) do { \
    SBAR(); if (WR) { SWAIT(); SWRITE(((KB) + 2) & 3); } if (LD) SLOAD((T) + 3); SBAR(); \
    region1<(VB) * SHM_V>(PN0, PN1, mC, K_lds + (KB) * SHM_K, qr, r32, hi, kp, PO0, PO1, pa0, pa1, pa2, pa3, vbp, vf); SBAR(); \
    region2<(VB) * SHM_V>(o, vf, vbp, pa0, pa1, pa2, pa3, ones, PN0, PN1, mC, ALN); SBAR(); \
    if (NX) KPRE(((KB) + 1) & 3); RESC(ALN); BAR(); } while (0)
  int j = 1;
  for (; j + 3 < NT; j += 4) {
    STEP(pB0, pB1, alB, pA0, pA1, 1, 0, j, true, true, true);
    STEP(pA0, pA1, alA, pB0, pB1, 2, 1, j + 1, true, true, true);
    STEP(pB0, pB1, alB, pA0, pA1, 3, 2, j + 2, true, true, true);
    STEP(pA0, pA1, alA, pB0, pB1, 0, 3, j + 3, true, true, true);
  }
  STEP(pB0, pB1, alB, pA0, pA1, 1, 0, j, true, false, true);
  STEP(pA0, pA1, alA, pB0, pB1, 2, 1, j + 1, false, false, true);
  STEP(pB0, pB1, alB, pA0, pA1, 3, 2, j + 2, false, false, false);
  finishSM(pB0, pB1, pa0, pa1, pa2, pa3); SBAR();
  pv_last<3 * SHM_V>(o, vbp, pa0, pa1, pa2, pa3, ones);
  float rli[16];
#pragma unroll
  for (int r = 0; r < 16; ++r) rli[r] = __builtin_amdgcn_rcpf(o[2][r]);
  gp Ow = Ob + (long)(wid * QBLK) * LDO;
#pragma unroll
  for (int r = 0; r < 16; ++r) { const int orow = crow(r, hi);
#pragma unroll
    for (int d0 = 0; d0 < 2; ++d0) Ow[(long)orow * LDO + d0 * 32 + r32] = (unsigned short)(cvtpk(o[d0][r] * rli[r], 0.f) & 0xffffu); }
  asm volatile("s_waitcnt vmcnt(0)" ::: "memory");
  __syncthreads();
#undef TROW
#undef SLOAD
#undef SWRITE
#undef SLOADX
#undef SWRITEX
#undef STEP
#undef BAR
#undef KPRE
#undef SWAIT
#undef RESC
}
#undef KLDX
#undef KSWZ
#undef SBAR
}

namespace gla {
typedef short bf16x8 __attribute__((ext_vector_type(8)));
typedef short s16x4 __attribute__((ext_vector_type(4)));
typedef float f32x16 __attribute__((ext_vector_type(16)));
typedef float f32x4 __attribute__((ext_vector_type(4)));
typedef float f32x2 __attribute__((ext_vector_type(2)));
typedef __bf16 bf16x2_t __attribute__((ext_vector_type(2)));
typedef unsigned u32x4 __attribute__((ext_vector_type(4)));
typedef unsigned u32x2 __attribute__((ext_vector_type(2)));
#define GLA_LAS __attribute__((address_space(3)))
#define GLA_GAS __attribute__((address_space(1)))
constexpr int RS256 = 272, RS128 = 144;
constexpr int OFF_QT = 0, OFF_KT = 64 * RS256, OFF_KH = 2 * 64 * RS256, OFF_V = OFF_KH + 128 * RS128, OFF_P = OFF_V + 32768, OFF_TOT = OFF_P + 64 * RS128, OFF_EL = OFF_TOT + 2048, OFF_ZG = OFF_EL + 512, OFF_W2 = OFF_ZG + 4096, GLA_LDS = OFF_W2 + 8192;
static_assert(GLA_LDS <= 131072 && OFF_V % 16 == 0 && OFF_P % 16 == 0 && OFF_TOT % 16 == 0, "gla lds map");
__device__ __forceinline__ int swz256(int row, int colB) { return row * RS256 + colB; }
__device__ __forceinline__ int swz128(int row, int colB) { return row * RS128 + colB; }
__device__ __forceinline__ int crow(int r, int hi) { return (r & 3) + 8 * (r >> 2) + 4 * hi; }
__device__ __forceinline__ unsigned pk2f(float lo, float hi) { const f32x2 v = {lo, hi}; return __builtin_bit_cast(unsigned, __builtin_convertvector(v, bf16x2_t)); }
__device__ __forceinline__ unsigned short bf1f(float x) { return (unsigned short)(pk2f(x, 0.f) & 0xffffu); }
__device__ __forceinline__ float bfu(unsigned short u) { return __uint_as_float(((unsigned)u) << 16); }
__device__ __forceinline__ int v_st(int k, int c) { const int kk = (k & ~0xC) | ((k & 4) << 1) | ((k & 8) >> 1); return ((kk >> 3) * 8 + (c >> 5)) * 512 + ((kk & 7) * 32 + (c & 31)) * 2; }
__device__ __forceinline__ int v_rd_base(int lane) { return ((lane & 3) << 3) | (((lane >> 2) & 3) << 6) | (((lane >> 4) & 1) << 5) | (((lane >> 5) & 1) << 8); }
template <int OFF> __device__ __forceinline__ s16x4 tr_read(int vb) { s16x4 r; asm volatile("ds_read_b64_tr_b16 %0, %1 offset:%2" : "=&v"(r) : "v"(vb), "i"(OFF) : "memory"); return r; }
#define GLA_MFMA(a, b, c) __builtin_amdgcn_mfma_f32_32x32x16_bf16((a), (b), (c), 0, 0, 0)
__device__ __forceinline__ bf16x8 pack_step(const f32x16& x, int s) {
    u32x4 p; p.x = pk2f(x[8 * s], x[8 * s + 1]); p.y = pk2f(x[8 * s + 2], x[8 * s + 3]); p.z = pk2f(x[8 * s + 4], x[8 * s + 5]); p.w = pk2f(x[8 * s + 6], x[8 * s + 7]); return __builtin_bit_cast(bf16x8, p);
}
__device__ __forceinline__ void gla_prep(const unsigned short* QK_, const unsigned short* ZG_, const float* w2_, const float* b2_, unsigned short* TQ_, unsigned short* TK_, unsigned short* TP_, float* EL_,
                                         int b, int h, int dir, int c_lo, int c_hi, int ML_, int SEQ_, int CTX_, GLA_LAS unsigned char* lds) {
    const GLA_GAS unsigned short* QK = (const GLA_GAS unsigned short*)QK_; const GLA_GAS unsigned short* ZG = (const GLA_GAS unsigned short*)ZG_;
    const GLA_GAS float* w2g = (const GLA_GAS float*)w2_; const GLA_GAS float* b2g = (const GLA_GAS float*)b2_;
    const int tid = threadIdx.x, wid = __builtin_amdgcn_readfirstlane(tid >> 6), lane = tid & 63, r32 = lane & 31, hi = lane >> 5;
    const int seg = tid >> 7, kk = tid & 127;
    GLA_LAS unsigned char* QT = lds + OFF_QT; GLA_LAS unsigned char* KT = lds + OFF_KT;
    GLA_LAS float* TOT = (GLA_LAS float*)(lds + OFF_TOT); GLA_LAS float* ZGS = (GLA_LAS float*)(lds + OFF_ZG); GLA_LAS float* W2S = (GLA_LAS float*)(lds + OFF_W2);
    __syncthreads();
#pragma unroll
    for (int i = 0; i < 4; ++i) { const int idx = tid + 512 * i; W2S[idx] = w2g[(size_t)(dir * 16 + (idx >> 7)) * 512 + h * 128 + (idx & 127)]; }
    const float b2 = b2g[dir * 512 + h * 128 + kk];
    const int nctx = CTX_ / 64;
    unsigned raw[16], zgw;
#define GLA_PLOAD(cs_) do { const long r0_ = ((cs_) < nctx) ? (long)ML_ + (long)b * CTX_ + 64 * (cs_) : (long)b * SEQ_ + 64 * ((cs_) - nctx); \
        zgw = *(const GLA_GAS unsigned*)(ZG + (r0_ + (tid >> 3)) * 2304 + dir * 16 + (tid & 7) * 2); \
        _Pragma("unroll") for (int i_ = 0; i_ < 16; ++i_) { const GLA_GAS unsigned short* zr_ = QK + (r0_ + 16 * seg + i_) * 1024 + h * 128 + kk; raw[i_] = (unsigned)zr_[0] | ((unsigned)zr_[512] << 16); } } while (0)
    for (int cs = c_lo; cs < c_hi; ++cs) {
        GLA_PLOAD(cs);
        const size_t tile = (size_t)((b * 4 + h) * 2 + dir) * 36 + cs;
        GLA_GAS unsigned short* TQ = (GLA_GAS unsigned short*)TQ_ + tile * 8192; GLA_GAS unsigned short* TK = (GLA_GAS unsigned short*)TK_ + tile * 8192; GLA_GAS unsigned short* TP = (GLA_GAS unsigned short*)TP_ + tile * 4096;
        { const int l = tid >> 3, r2 = (tid & 7) * 2; ZGS[l * 16 + r2] = __uint_as_float(zgw << 16); ZGS[l * 16 + r2 + 1] = __uint_as_float(zgw & 0xffff0000u); }
        __syncthreads();
        float cum[16];
#pragma unroll
        for (int i = 0; i < 16; ++i) cum[i] = b2;
#pragma unroll
        for (int q = 0; q < 4; ++q) { const float wa = W2S[(4 * q) * 128 + kk], wb = W2S[(4 * q + 1) * 128 + kk], wc_ = W2S[(4 * q + 2) * 128 + kk], wd = W2S[(4 * q + 3) * 128 + kk];
#pragma unroll
            for (int i = 0; i < 16; ++i) { const f32x4 z = *(const GLA_LAS f32x4*)(ZGS + (16 * seg + i) * 16 + 4 * q); cum[i] += z.x * wa + z.y * wb + z.z * wc_ + z.w * wd; } }
#pragma unroll
        for (int i = 0; i < 16; ++i) { const float x = cum[i]; cum[i] = (fminf(x, 0.f) - __logf(1.0f + __expf(-fabsf(x)))) * (1.0f / 16.0f); }
        if (dir == 0) {
#pragma unroll
            for (int i = 1; i < 16; ++i) cum[i] += cum[i - 1];
            TOT[seg * 128 + kk] = cum[15];
        } else {
#pragma unroll
            for (int i = 14; i >= 0; --i) cum[i] += cum[i + 1];
            TOT[seg * 128 + kk] = cum[0];
        }
        __syncthreads();
        { const float t0 = TOT[kk], t1 = TOT[128 + kk], t2 = TOT[256 + kk], t3 = TOT[384 + kk]; const float last = (t0 + t1) + (t2 + t3);
          float off;
          if (dir == 0) off = (seg > 0 ? t0 : 0.f) + (seg > 1 ? t1 : 0.f) + (seg > 2 ? t2 : 0.f);
          else off = (seg < 3 ? t3 : 0.f) + (seg < 2 ? t2 : 0.f) + (seg < 1 ? t1 : 0.f);
          if (seg == 0) ((GLA_GAS float*)EL_)[tile * 128 + kk] = __expf(last);
          unsigned ktp[8];
#pragma unroll
          for (int i = 0; i < 16; i += 2) {
              const float c0 = cum[i] + off, c1 = cum[i + 1] + off; const int l0 = 16 * seg + i, l1 = l0 + 1;
              const float q0 = __uint_as_float(raw[i] << 16), k0v = __uint_as_float(raw[i] & 0xffff0000u), q1 = __uint_as_float(raw[i + 1] << 16), k1v = __uint_as_float(raw[i + 1] & 0xffff0000u);
              const unsigned short qa = bf1f(q0 * __expf(c0)), qb = bf1f(q1 * __expf(c1)); const float ka = k0v * __expf(-c0), kb = k1v * __expf(-c1); const unsigned kp = pk2f(ka, kb);
              *(GLA_LAS unsigned short*)(QT + swz256(l0, 2 * kk)) = qa; *(GLA_LAS unsigned short*)(QT + swz256(l1, 2 * kk)) = qb;
              *(GLA_LAS unsigned short*)(KT + swz256(l0, 2 * kk)) = (unsigned short)(kp & 0xffffu); *(GLA_LAS unsigned short*)(KT + swz256(l1, 2 * kk)) = (unsigned short)(kp >> 16);
              TQ[l0 * 128 + kk] = qa; TQ[l1 * 128 + kk] = qb; ktp[i >> 1] = kp; }
          u32x4 k0 = {ktp[0], ktp[1], ktp[2], ktp[3]}, k1 = {ktp[4], ktp[5], ktp[6], ktp[7]};
          *(GLA_GAS u32x4*)(TK + kk * 64 + 16 * seg) = k0; *(GLA_GAS u32x4*)(TK + kk * 64 + 16 * seg + 8) = k1; }
        __syncthreads();
        if (wid < 4) { const int mi = wid >> 1, li = wid & 1; f32x16 x = f32x16{};
#pragma unroll
            for (int s2 = 0; s2 < 8; ++s2) { const int cb = (16 * s2 + 8 * hi) * 2;
                const bf16x8 a = *(const GLA_LAS bf16x8*)(KT + swz256(32 * mi + r32, cb)); const bf16x8 bq = *(const GLA_LAS bf16x8*)(QT + swz256(32 * li + r32, cb)); x = GLA_MFMA(a, bq, x); }
            const int l = 32 * li + r32;
#pragma unroll
            for (int g = 0; g < 4; ++g) { float v[4];
#pragma unroll
                for (int j = 0; j < 4; ++j) { const int m = 32 * mi + 8 * g + 4 * hi + j; const bool keep = (dir == 0) ? (m <= l) : (m >= l); v[j] = keep ? x[4 * g + j] : 0.f; }
                u32x2 w; w.x = pk2f(v[0], v[1]); w.y = pk2f(v[2], v[3]); *(GLA_GAS u32x2*)(TP + l * 64 + 32 * mi + 8 * g + 4 * hi) = w; } }
    }
#undef GLA_PLOAD
    __syncthreads();
}
__device__ __forceinline__ void gla_chain(const unsigned short* VR_, const unsigned short* TQ_, const unsigned short* TK_, const unsigned short* TP_, const float* EL_, unsigned short* O_, int b, int h, int dir,
                                          int ML_, int SEQ_, int CTX_, GLA_LAS unsigned char* lds) {
    const GLA_GAS unsigned short* VR = (const GLA_GAS unsigned short*)VR_; GLA_GAS unsigned short* O = (GLA_GAS unsigned short*)O_;
    const int tid = threadIdx.x, wid = __builtin_amdgcn_readfirstlane(tid >> 6), lane = tid & 63, r32 = lane & 31, hi = lane >> 5;
    GLA_LAS unsigned char* QT = lds + OFF_QT; GLA_LAS unsigned char* KH = lds + OFF_KH; GLA_LAS unsigned char* VI = lds + OFF_V; GLA_LAS unsigned char* PI = lds + OFF_P; GLA_LAS float* EL = (GLA_LAS float*)(lds + OFF_EL);
    f32x16 S[4];
#pragma unroll
    for (int t = 0; t < 4; ++t) S[t] = f32x16{};
    const int vb = (int)(unsigned)(uintptr_t)VI + v_rd_base(lane) + wid * 512;
    const int nchunk = (CTX_ + SEQ_) / 64, nctx = CTX_ / 64;
    const size_t tile0 = (size_t)((b * 4 + h) * 2 + dir) * 36;
    u32x4 pq[2], pk[2], pp, pv[4]; float pe = 0.f;
#define GLA_CS(sc_) ((dir == 0) ? (sc_) : (((sc_) < nctx) ? (nctx - 1 - (sc_)) : (nchunk - 1 - ((sc_) - nctx))))
#define GLA_FETCH(sc_) do { const int cs_ = GLA_CS(sc_); const size_t t_ = tile0 + cs_; const long r0_ = (cs_ < nctx) ? (long)ML_ + (long)b * CTX_ + 64 * cs_ : (long)b * SEQ_ + 64 * (cs_ - nctx); \
        const GLA_GAS u32x4* q_ = (const GLA_GAS u32x4*)((const GLA_GAS unsigned short*)TQ_ + t_ * 8192); const GLA_GAS u32x4* k_ = (const GLA_GAS u32x4*)((const GLA_GAS unsigned short*)TK_ + t_ * 8192); \
        pq[0] = q_[tid]; pq[1] = q_[tid + 512]; pk[0] = k_[tid]; pk[1] = k_[tid + 512]; pp = ((const GLA_GAS u32x4*)((const GLA_GAS unsigned short*)TP_ + t_ * 4096))[tid]; \
        if (tid < 128) pe = ((const GLA_GAS float*)EL_)[t_ * 128 + tid]; \
        _Pragma("unroll") for (int i_ = 0; i_ < 4; ++i_) { const int c_ = tid + 512 * i_; pv[i_] = *(const GLA_GAS u32x4*)(VR + (r0_ + (c_ >> 5)) * 2304 + h * 256 + (c_ & 31) * 8); } } while (0)
    GLA_FETCH(0);
    for (int sc = 0; sc < nchunk; ++sc) {
        const int cs = GLA_CS(sc); const bool is_lat = cs >= nctx; const long row0 = is_lat ? (long)b * SEQ_ + 64 * (cs - nctx) : (long)ML_ + (long)b * CTX_ + 64 * cs;
#pragma unroll
        for (int i = 0; i < 2; ++i) { const int c = tid + 512 * i; *(GLA_LAS u32x4*)(QT + (c >> 4) * RS256 + (c & 15) * 16) = pq[i]; *(GLA_LAS u32x4*)(KH + (c >> 3) * RS128 + (c & 7) * 16) = pk[i]; }
        *(GLA_LAS u32x4*)(PI + (tid >> 3) * RS128 + (tid & 7) * 16) = pp;
        if (tid < 128) EL[tid] = pe;
#pragma unroll
        for (int i = 0; i < 4; ++i) { const int c = tid + 512 * i; *(GLA_LAS u32x4*)(VI + v_st(c >> 5, (c & 31) * 8)) = pv[i]; }
        __syncthreads();
        if (sc + 1 < nchunk) GLA_FETCH(sc + 1);
        f32x16 o[2] = {f32x16{}, f32x16{}};
#pragma unroll
        for (int kt = 0; kt < 4; ++kt)
#pragma unroll
            for (int s2 = 0; s2 < 2; ++s2) { const bf16x8 bs = pack_step(S[kt], s2); const int cb0 = (32 * kt + 16 * s2 + 4 * hi) * 2;
#pragma unroll
                for (int rb = 0; rb < 2; ++rb) { const int l = 32 * rb + r32;
                    const s16x4 a0 = *(const GLA_LAS s16x4*)(QT + swz256(l, cb0)), a1 = *(const GLA_LAS s16x4*)(QT + swz256(l, cb0 + 16));
                    const bf16x8 a = {a0[0], a0[1], a0[2], a0[3], a1[0], a1[1], a1[2], a1[3]}; o[rb] = GLA_MFMA(a, bs, o[rb]); } }
        bf16x8 vf[4];
        { const s16x4 l0 = tr_read<0 * 8192>(vb), h0 = tr_read<0 * 8192 + 4096>(vb), l1 = tr_read<1 * 8192>(vb), h1 = tr_read<1 * 8192 + 4096>(vb);
          const s16x4 l2 = tr_read<2 * 8192>(vb), h2 = tr_read<2 * 8192 + 4096>(vb), l3 = tr_read<3 * 8192>(vb), h3 = tr_read<3 * 8192 + 4096>(vb);
          asm volatile("s_waitcnt lgkmcnt(0)" ::: "memory"); __builtin_amdgcn_sched_barrier(0);
          vf[0] = (bf16x8){l0[0], l0[1], l0[2], l0[3], h0[0], h0[1], h0[2], h0[3]}; vf[1] = (bf16x8){l1[0], l1[1], l1[2], l1[3], h1[0], h1[1], h1[2], h1[3]};
          vf[2] = (bf16x8){l2[0], l2[1], l2[2], l2[3], h2[0], h2[1], h2[2], h2[3]}; vf[3] = (bf16x8){l3[0], l3[1], l3[2], l3[3], h3[0], h3[1], h3[2], h3[3]}; }
#pragma unroll
        for (int rb = 0; rb < 2; ++rb)
#pragma unroll
            for (int ks = 0; ks < 4; ++ks) { const bf16x8 a = *(const GLA_LAS bf16x8*)(PI + swz128(32 * rb + r32, (16 * ks + 8 * hi) * 2)); o[rb] = GLA_MFMA(a, vf[ks], o[rb]); }
        if (is_lat) {
#pragma unroll
            for (int rb = 0; rb < 2; ++rb)
#pragma unroll
                for (int r = 0; r < 16; ++r) O[(row0 + 32 * rb + crow(r, hi)) * 1024 + h * 256 + 32 * wid + r32] = bf1f(o[rb][r]); }
#pragma unroll
        for (int kt = 0; kt < 4; ++kt) {
#pragma unroll
            for (int ks = 0; ks < 4; ++ks) { const bf16x8 a = *(const GLA_LAS bf16x8*)(KH + swz128(32 * kt + r32, (16 * ks + 8 * hi) * 2)); S[kt] = GLA_MFMA(a, vf[ks], S[kt]); }
#pragma unroll
            for (int r = 0; r < 16; ++r) S[kt][r] *= EL[32 * kt + crow(r, hi)]; }
        __syncthreads();
    }
#undef GLA_FETCH
#undef GLA_CS
}
__device__ __forceinline__ int v_st4(int k, int c) { const int kk = (k & ~0xC) | ((k & 4) << 1) | ((k & 8) >> 1); return ((kk >> 3) * 4 + (c >> 5)) * 512 + ((kk & 7) * 32 + (c & 31)) * 2; }
constexpr int OFF_XO_A = OFF_KT, OFF_XO_B = OFF_V + 16384;
static_assert(OFF_XO_A + 16384 <= OFF_KH && OFF_XO_B + 16384 <= OFF_P, "gla chain2 lds map");
__device__ __forceinline__ void gla_chain2(const unsigned short* VR_, const unsigned short* TQ_, const unsigned short* TK_, const unsigned short* TP_, const float* EL_, unsigned short* O_, int b, int h, int dir, int vh,
                                           int ML_, int SEQ_, int CTX_, GLA_LAS unsigned char* lds) {
    const GLA_GAS unsigned short* VR = (const GLA_GAS unsigned short*)VR_; GLA_GAS unsigned short* O = (GLA_GAS unsigned short*)O_;
    const int tid = threadIdx.x, wid = __builtin_amdgcn_readfirstlane(tid >> 6), lane = tid & 63, r32 = lane & 31, hi = lane >> 5;
    const int vt = wid & 3, kh = wid >> 2;
    GLA_LAS unsigned char* QT = lds + OFF_QT; GLA_LAS unsigned char* KH = lds + OFF_KH; GLA_LAS unsigned char* VI = lds + OFF_V; GLA_LAS unsigned char* PI = lds + OFF_P; GLA_LAS float* EL = (GLA_LAS float*)(lds + OFF_EL);
    GLA_LAS f32x4* XOs = (GLA_LAS f32x4*)(lds + (wid < 4 ? OFF_XO_A + wid * 4096 : OFF_XO_B + (wid - 4) * 4096));
    GLA_LAS f32x4* XOr = (GLA_LAS f32x4*)(lds + ((wid ^ 4) < 4 ? OFF_XO_A + (wid ^ 4) * 4096 : OFF_XO_B + ((wid ^ 4) - 4) * 4096));
    f32x16 S[2] = {f32x16{}, f32x16{}};
    const int vb = (int)(unsigned)(uintptr_t)VI + v_rd_base(lane) + vt * 512;
    const int nchunk = (CTX_ + SEQ_) / 64, nctx = CTX_ / 64;
    const size_t tile0 = (size_t)((b * 4 + h) * 2 + dir) * 36;
    u32x4 pq[2], pk[2], pp, pv[2]; float pe = 0.f;
#define GLA_CS(sc_) ((dir == 0) ? (sc_) : (((sc_) < nctx) ? (nctx - 1 - (sc_)) : (nchunk - 1 - ((sc_) - nctx))))
#define GLA_FETCH(sc_) do { const int cs_ = GLA_CS(sc_); const size_t t_ = tile0 + cs_; const long r0_ = (cs_ < nctx) ? (long)ML_ + (long)b * CTX_ + 64 * cs_ : (long)b * SEQ_ + 64 * (cs_ - nctx); \
        const GLA_GAS u32x4* q_ = (const GLA_GAS u32x4*)((const GLA_GAS unsigned short*)TQ_ + t_ * 8192); const GLA_GAS u32x4* k_ = (const GLA_GAS u32x4*)((const GLA_GAS unsigned short*)TK_ + t_ * 8192); \
        pq[0] = q_[tid]; pq[1] = q_[tid + 512]; pk[0] = k_[tid]; pk[1] = k_[tid + 512]; pp = ((const GLA_GAS u32x4*)((const GLA_GAS unsigned short*)TP_ + t_ * 4096))[tid]; \
        if (tid < 128) pe = ((const GLA_GAS float*)EL_)[t_ * 128 + tid]; \
        _Pragma("unroll") for (int i_ = 0; i_ < 2; ++i_) { const int c_ = tid + 512 * i_; pv[i_] = *(const GLA_GAS u32x4*)(VR + (r0_ + (c_ >> 4)) * 2304 + h * 256 + vh * 128 + (c_ & 15) * 8); } } while (0)
    GLA_FETCH(0);
    for (int sc = 0; sc < nchunk; ++sc) {
        const int cs = GLA_CS(sc); const bool is_lat = cs >= nctx; const long row0 = is_lat ? (long)b * SEQ_ + 64 * (cs - nctx) : (long)ML_ + (long)b * CTX_ + 64 * cs;
#pragma unroll
        for (int i = 0; i < 2; ++i) { const int c = tid + 512 * i; *(GLA_LAS u32x4*)(QT + (c >> 4) * RS256 + (c & 15) * 16) = pq[i]; *(GLA_LAS u32x4*)(KH + (c >> 3) * RS128 + (c & 7) * 16) = pk[i];
            *(GLA_LAS u32x4*)(VI + v_st4(c >> 4, (c & 15) * 8)) = pv[i]; }
        *(GLA_LAS u32x4*)(PI + (tid >> 3) * RS128 + (tid & 7) * 16) = pp;
        if (tid < 128) EL[tid] = pe;
        __syncthreads();
        if (sc + 1 < nchunk) GLA_FETCH(sc + 1);
        f32x16 op[2] = {f32x16{}, f32x16{}};
#pragma unroll
        for (int j = 0; j < 2; ++j)
#pragma unroll
            for (int s2 = 0; s2 < 2; ++s2) { const bf16x8 bs = pack_step(S[j], s2); const int cb0 = (32 * (2 * kh + j) + 16 * s2 + 4 * hi) * 2;
#pragma unroll
                for (int rb = 0; rb < 2; ++rb) { const int l = 32 * rb + r32;
                    const s16x4 a0 = *(const GLA_LAS s16x4*)(QT + swz256(l, cb0)), a1 = *(const GLA_LAS s16x4*)(QT + swz256(l, cb0 + 16));
                    const bf16x8 a = {a0[0], a0[1], a0[2], a0[3], a1[0], a1[1], a1[2], a1[3]}; op[rb] = GLA_MFMA(a, bs, op[rb]); } }
        { const f32x16& snd = kh ? op[0] : op[1];
#pragma unroll
          for (int g = 0; g < 4; ++g) XOs[g * 64 + lane] = (f32x4){snd[4 * g], snd[4 * g + 1], snd[4 * g + 2], snd[4 * g + 3]}; }
        __syncthreads();
        f32x16 o = kh ? op[1] : op[0];
#pragma unroll
        for (int g = 0; g < 4; ++g) { const f32x4 rv = XOr[g * 64 + lane]; o[4 * g] += rv.x; o[4 * g + 1] += rv.y; o[4 * g + 2] += rv.z; o[4 * g + 3] += rv.w; }
        bf16x8 vf[4];
        { const s16x4 l0 = tr_read<0 * 4096>(vb), h0 = tr_read<0 * 4096 + 2048>(vb), l1 = tr_read<1 * 4096>(vb), h1 = tr_read<1 * 4096 + 2048>(vb);
          const s16x4 l2 = tr_read<2 * 4096>(vb), h2 = tr_read<2 * 4096 + 2048>(vb), l3 = tr_read<3 * 4096>(vb), h3 = tr_read<3 * 4096 + 2048>(vb);
          asm volatile("s_waitcnt lgkmcnt(0)" ::: "memory"); __builtin_amdgcn_sched_barrier(0);
          vf[0] = (bf16x8){l0[0], l0[1], l0[2], l0[3], h0[0], h0[1], h0[2], h0[3]}; vf[1] = (bf16x8){l1[0], l1[1], l1[2], l1[3], h1[0], h1[1], h1[2], h1[3]};
          vf[2] = (bf16x8){l2[0], l2[1], l2[2], l2[3], h2[0], h2[1], h2[2], h2[3]}; vf[3] = (bf16x8){l3[0], l3[1], l3[2], l3[3], h3[0], h3[1], h3[2], h3[3]}; }
#pragma unroll
        for (int ks = 0; ks < 4; ++ks) { const bf16x8 a = *(const GLA_LAS bf16x8*)(PI + swz128(32 * kh + r32, (16 * ks + 8 * hi) * 2)); o = GLA_MFMA(a, vf[ks], o); }
        if (is_lat) {
#pragma unroll
            for (int r = 0; r < 16; ++r) O[(row0 + 32 * kh + crow(r, hi)) * 1024 + h * 256 + vh * 128 + 32 * vt + r32] = bf1f(o[r]); }
#pragma unroll
        for (int j = 0; j < 2; ++j) { const int kt = 2 * kh + j;
#pragma unroll
            for (int ks = 0; ks < 4; ++ks) { const bf16x8 a = *(const GLA_LAS bf16x8*)(KH + swz128(32 * kt + r32, (16 * ks + 8 * hi) * 2)); S[j] = GLA_MFMA(a, vf[ks], S[j]); }
#pragma unroll
            for (int r = 0; r < 16; ++r) S[j][r] *= EL[32 * kt + crow(r, hi)]; }
        __syncthreads();
    }
#undef GLA_FETCH
#undef GLA_CS
}
#undef GLA_MFMA
}

constexpr int NWAVES = 8;
constexpr int D = 1024, NB = 16, SEQ = 2048, CTXL = 256, TT = SEQ + CTXL;
constexpr int ML = NB * SEQ, MC = NB * CTXL, MA = ML + MC;
constexpr float EPS = 1e-6f;
constexpr int S5W = 512, S5G = 32, S5H = 16, S5P = 64;
constexpr int NH = 8, NOPE = 64, ROPE = 32, QK = 96, VD = 64, QRANK = 256, KVRANK = 128;
constexpr int EV_IN = 928, EV_INP = 1024, NQKV = 1792, KQKV = 384;
constexpr int GH = 4, GDK = 128, GDV = 256, GKEY = 512, GVAL = 1024, GRANK = 16;
constexpr int OD_IN = 3104, OD_INP = 3328;
constexpr int FFN = 2816, NE = 8, FE = 3584;
constexpr int MOE_MAXT = 264;

constexpr size_t MiB = 1u << 20;
constexpr size_t WS_CTL = 0, CTL_ZERO_BYTES = 1 * MiB;
constexpr size_t WS_MODV = 1 * MiB;
constexpr size_t WS_TOK = 2 * MiB;
constexpr size_t WS_INV = 3 * MiB;
constexpr size_t WS_W_IN1 = 4 * MiB, WS_W_OUT1 = 11 * MiB, WS_W_MGU = 13 * MiB  , WS_W_MDN = 69 * MiB  ;
constexpr size_t WS_W_IN0 = 97 * MiB, WS_W_QKV = 99 * MiB, WS_W_GLU = 100 * MiB + 512 * 1024, WS_W_OUT0 = 101 * MiB, WS_W_GU = 103 * MiB, WS_W_DN = 114 * MiB, WS_HC = 120 * MiB;
constexpr size_t PB = 136 * MiB;
constexpr size_t WS_XL = PB + 0 * MiB, WS_Q = PB + 0 * MiB, WS_A3 = PB + 72 * MiB, WS_YL = PB + 72 * MiB, WS_KV = PB + 144 * MiB, WS_Z0C = PB + 144 * MiB, WS_U = PB + 180 * MiB, WS_DS = PB + 216 * MiB, WS_AO = PB + 216 * MiB,
                 WS_QA = PB + 288 * MiB, WS_AG = PB + 288 * MiB, WS_KR = PB + 324 * MiB, WS_B1 = PB + 328 * MiB, WS_B3 = PB + 332 * MiB;
constexpr size_t WS_ACT = PB + 72 * MiB, WS_FL = PB + 270 * MiB;
constexpr size_t WS_TP = 97 * MiB, WS_EL = 133 * MiB, WS_OF = PB, WS_VR = 208 * MiB, WS_QK = 370 * MiB, WS_OB = 370 * MiB, WS_YL1 = 370 * MiB, WS_TQ = 442 * MiB, WS_TK = 514 * MiB;
constexpr int VRLD = 2304;
constexpr int GLA_TILES = NB * GH * 2 * 36;
constexpr int MOE_W_ITEMS = NE * (2 * (D / 64) * (FE / 32) + (FE / 64) * (D / 32));
constexpr int MW0 = 0, MW1 = (MOE_W_ITEMS * 20) / 100, MW2 = (MOE_W_ITEMS * 40) / 100, MW3 = (MOE_W_ITEMS * 54) / 100, MW4 = (MOE_W_ITEMS * 82) / 100, MW5 = MOE_W_ITEMS;
constexpr size_t WS_XLM = PB + 0 * MiB, WS_Y = PB + 0 * MiB, WS_XG = PB + 132 * MiB, WS_ACTM = PB + 198 * MiB;
constexpr size_t WS_END = 588 * MiB;
static_assert(WS_KR + (size_t)MA * 32 * 2 <= WS_B1 && WS_KV + (size_t)MA * 1024 * 2 <= WS_DS && WS_AG + (size_t)MA * 512 * 2 <= WS_KR && WS_AO + (size_t)MA * D * 2 <= WS_AG && WS_A3 + (size_t)MA * 1024 * 2 <= WS_KV &&
              WS_Z0C + (size_t)MA * 512 * 2 <= WS_U && WS_U + (size_t)MA * 512 * 2 <= WS_DS && WS_DS + (size_t)MA * 512 * 4 <= WS_QA && WS_QA + (size_t)MA * KQKV * 2 <= WS_KR && WS_B1 + (size_t)32 * 256 * 256 * 2 <= WS_B3 && WS_B3 + (size_t)32 * 256 * 512 * 2 <= WS_END, "ws map");
static_assert(WS_FL + (size_t)MA * D * 2 <= WS_END && WS_ACT + (size_t)MA * FFN * 2 <= WS_FL, "ws map 2");
static_assert(WS_TP + (size_t)GLA_TILES * 8192 <= WS_EL && WS_EL + (size_t)GLA_TILES * 512 <= PB && WS_XL + (size_t)MA * D * 2 <= WS_VR && WS_VR + (size_t)MA * VRLD * 2 <= WS_QK && WS_QK + (size_t)MA * 1024 * 2 <= WS_TQ &&
              WS_TQ + (size_t)GLA_TILES * 16384 <= WS_TK && WS_TK + (size_t)GLA_TILES * 16384 <= WS_END && WS_OF + (size_t)ML * D * 2 <= WS_VR && WS_OB + (size_t)ML * D * 2 <= WS_TQ, "ws map layer 1");
static_assert(WS_Y + (size_t)MOE_MAXT * 256 * D * 2 <= WS_XG && WS_XG + (size_t)MOE_MAXT * 256 * D <= WS_ACTM && WS_ACTM + (size_t)MOE_MAXT * 256 * FE <= WS_END && WS_XLM + (size_t)ML * D <= WS_XG, "ws map 3");
static_assert(WS_W_IN1 + (size_t)OD_INP * D * 2 <= WS_W_OUT1 && WS_W_OUT1 + (size_t)D * D * 2 <= WS_W_MGU && WS_W_MGU + (size_t)NE * 2 * FE * D <= WS_W_MDN && WS_W_MDN + (size_t)NE * D * FE <= WS_W_IN0 &&
              WS_W_GU + (size_t)2 * FFN * D * 2 <= WS_W_DN && WS_W_DN + (size_t)D * FFN * 2 <= WS_HC && WS_HC + (size_t)MC * D * 4 <= PB, "ws map 4");
#ifndef FFN0_FP8
#define FFN0_FP8 0
#endif
constexpr bool FFN0_IS_FP8 = FFN0_FP8;
#ifndef FFN0_DOWN_FP8
#define FFN0_DOWN_FP8 1
#endif
constexpr bool FFN0_DN_FP8 = FFN0_DOWN_FP8;
constexpr float FP8_SA = 8.0f, FP8_SW = 128.0f, FP8_SACT = 4.0f;

constexpr int CW_TMO = 0, CW_CODE = 1, CW_CNT = 64, CW_BAR = 4096;

constexpr int RING_OFF = 0, RING_BYTES = 131072;
constexpr int ATAB_OFF = RING_BYTES + 1024, ATAB_UNITS = 29;
constexpr int LDSCTL_OFF = RING_BYTES, MISC_OFF = LDSCTL_OFF + 320;
constexpr int LDS_BYTES = 147456;
static_assert(ATAB_OFF + ATAB_UNITS * 512 <= LDS_BYTES, "LDS map: row table");

struct Args { const float* in[35]; float* out; unsigned char* ws; int ph_lo, ph_hi; };
struct Frame { LAS unsigned char* lds; volatile LAS unsigned* MISC; gu32* ctl; int tid, lane, wave, G, gw, ngw; };

__device__ __forceinline__ float wave_sum(float v) {
#pragma unroll
    for (int o = 1; o < 64; o <<= 1) v += __shfl_xor(v, o);
    return v;
}
__device__ __forceinline__ float bf_lo(unsigned u) { return __uint_as_float(u << 16); }
__device__ __forceinline__ float bf_hi(unsigned u) { return __uint_as_float(u & 0xffff0000u); }
__device__ __forceinline__ float bf1(bf16 u) { return __uint_as_float(((unsigned)u) << 16); }
typedef unsigned v2u __attribute__((ext_vector_type(2)));
__device__ __forceinline__ unsigned pk4_fp8(float a, float b, float c, float d) { return pg8::pk4_fp8(a, b, c, d); }

__device__ __forceinline__ void ld_row_f32(const float* p, int lane, f32x4 (&v)[4]) {
    const GAS f32x4* q = (const GAS f32x4*)p + lane;
#pragma unroll
    for (int j = 0; j < 4; ++j) v[j] = q[64 * j];
}
__device__ __forceinline__ void st_row_f32(float* p, int lane, const f32x4 (&v)[4]) {
    GAS f32x4* q = (GAS f32x4*)p + lane;
#pragma unroll
    for (int j = 0; j < 4; ++j) q[64 * j] = v[j];
}
__device__ __forceinline__ void ld_row_bf16(const bf16* p, int lane, f32x4 (&v)[4]) {
    const GAS v2u* q = (const GAS v2u*)p + lane;
#pragma unroll
    for (int j = 0; j < 4; ++j) { const v2u w = q[64 * j]; v[j] = (f32x4){bf_lo(w.x), bf_hi(w.x), bf_lo(w.y), bf_hi(w.y)}; }
}
__device__ __forceinline__ void st_row_bf16(bf16* p, int lane, const f32x4 (&v)[4]) {
    GAS v2u* q = (GAS v2u*)p + lane;
#pragma unroll
    for (int j = 0; j < 4; ++j) { v2u w; w.x = pk2(v[j].x, v[j].y); w.y = pk2(v[j].z, v[j].w); q[64 * j] = w; }
}
__device__ __forceinline__ void st_row_fp8(unsigned char* p, int lane, const f32x4 (&v)[4], float sc) {
    GAS unsigned* q = (GAS unsigned*)p + lane;
#pragma unroll
    for (int j = 0; j < 4; ++j) q[64 * j] = pk4_fp8(v[j].x * sc, v[j].y * sc, v[j].z * sc, v[j].w * sc);
}
__device__ __forceinline__ float row_rs(const f32x4 (&v)[4]) {
    float s = 0.f;
#pragma unroll
    for (int j = 0; j < 4; ++j) s += (v[j].x * v[j].x + v[j].y * v[j].y) + (v[j].z * v[j].z + v[j].w * v[j].w);
    return rsqrtf(wave_sum(s) * (1.0f / D) + EPS);
}
__device__ __forceinline__ void norm_mod(f32x4 (&v)[4], const float* gam, const float* sh, const float* sc, int lane) {
    const float rs = row_rs(v); f32x4 g[4], a[4], b[4]; ld_row_f32(gam, lane, g); ld_row_f32(sh, lane, a); ld_row_f32(sc, lane, b);
#pragma unroll
    for (int j = 0; j < 4; ++j) v[j] = (v[j] * rs) * g[j] * (1.0f + b[j]) + a[j];
}
__device__ __forceinline__ void gated_add(f32x4 (&h)[4], const f32x4 (&y)[4], const float* gam, const float* gate, int lane) {
    const float rs = row_rs(y); f32x4 g[4], t[4]; ld_row_f32(gam, lane, g); ld_row_f32(gate, lane, t);
#pragma unroll
    for (int j = 0; j < 4; ++j) h[j] = h[j] + t[j] * ((y[j] * rs) * g[j]);
}

__device__ __forceinline__ void cvt_item(const float* W, int K, int N, bf16* WT, int ldk, int kcol0, int row_off, int mode, const float* gain, float scale, int nscale,
                                         LAS float* scr, int item, int lane, bool fp8 = false, bool tiled = false) {
    const int nblk = N / 32, kb = item / nblk, nb = item % nblk, k0 = 64 * kb, n0 = 32 * nb;
    { f32x4 t[8];
#pragma unroll
      for (int i = 0; i < 8; ++i) t[i] = *(const GAS f32x4*)(W + (size_t)(k0 + 8 * i + (lane >> 3)) * N + n0 + 4 * (lane & 7));
#pragma unroll
      for (int i = 0; i < 8; ++i) { LAS float* d = scr + (8 * i + (lane >> 3)) * 33 + 4 * (lane & 7); d[0] = t[i].x; d[1] = t[i].y; d[2] = t[i].z; d[3] = t[i].w; } }
    LDS_WAIT(); asm volatile("" ::: "memory");
    const int c = lane & 7;
    float gn[8];
#pragma unroll
    for (int q = 0; q < 8; ++q) gn[q] = (gain ? gain[k0 + 8 * c + q] : 1.0f) * ((n0 < nscale) ? scale : 1.0f);
    const int drow0 = (mode == 0) ? n0 : (mode == 3) ? ((n0 >> 7) * 64 + (n0 & 63) + ((n0 & 64) ? 512 : 0)) : ((n0 >> 7) * 256 + (n0 & 127) + (mode == 2 ? 128 : 0));
#pragma unroll
    for (int j = 0; j < 4; ++j) { const int n = (lane >> 3) + 8 * j; const LAS float* s = scr + (8 * c) * 33 + n;
        if (fp8) { v2u o; o.x = pk4_fp8(s[0 * 33] * gn[0], s[1 * 33] * gn[1], s[2 * 33] * gn[2], s[3 * 33] * gn[3]); o.y = pk4_fp8(s[4 * 33] * gn[4], s[5 * 33] * gn[5], s[6 * 33] * gn[6], s[7 * 33] * gn[7]);
            const int drow = row_off + drow0 + n, kc = kcol0 + k0 + 8 * c;
            unsigned char* dp = tiled ? (unsigned char*)WT + (size_t)(drow >> 8) * 256 * ldk + (size_t)(kc >> 7) * 32768 + (drow & 255) * 128 + (kc & 127) : (unsigned char*)WT + (size_t)drow * ldk + kc;
            *(GAS v2u*)dp = o; }
        else { v4u o; o.x = pk2(s[0 * 33] * gn[0], s[1 * 33] * gn[1]); o.y = pk2(s[2 * 33] * gn[2], s[3 * 33] * gn[3]); o.z = pk2(s[4 * 33] * gn[4], s[5 * 33] * gn[5]); o.w = pk2(s[6 * 33] * gn[6], s[7 * 33] * gn[7]);
            *(GAS v4u*)(WT + (size_t)(row_off + drow0 + n) * ldk + kcol0 + k0 + 8 * c) = o; } }
    LDS_WAIT(); asm volatile("" ::: "memory");
}
__device__ __forceinline__ void moe_weights(Frame& F, const Args& A, int it_lo, int it_hi, int widx, int nw) {
    LAS float* scr = (LAS float*)(F.lds + RING_OFF + F.wave * 16384);
    unsigned char* ws = A.ws;
    constexpr int I_MG1 = (D / 64) * (FE / 32), I_MD1 = (FE / 64) * (D / 32);
    for (int it = it_lo + widx; it < it_hi; it += nw) {
        int r = it;
        if (r < NE * I_MG1) { const int e = r / I_MG1; cvt_item(A.in[32] + (size_t)e * D * FE, D, FE, (bf16*)(ws + WS_W_MGU + (size_t)e * 2 * FE * D), D, 0, 0, 1, nullptr, FP8_SW, 1 << 30, scr, r % I_MG1, F.lane, true); continue; } r -= NE * I_MG1;
        if (r < NE * I_MG1) { const int e = r / I_MG1; cvt_item(A.in[33] + (size_t)e * D * FE, D, FE, (bf16*)(ws + WS_W_MGU + (size_t)e * 2 * FE * D), D, 0, 0, 2, nullptr, FP8_SW, 1 << 30, scr, r % I_MG1, F.lane, true); continue; } r -= NE * I_MG1;
        { const int e = r / I_MD1; cvt_item(A.in[34] + (size_t)e * FE * D, FE, D, (bf16*)(ws + WS_W_MDN + (size_t)e * D * FE), FE, 0, 0, 0, nullptr, FP8_SW, 1 << 30, scr, r % I_MD1, F.lane, true, true); }
    }
}
__device__ __forceinline__ void tail_convert(Frame& F, const Args& A, int nunit, int lo, int hi) {
    const int nlast = nunit % F.G, bid = (int)blockIdx.x;
    if (nlast != 0) { if (bid >= nlast) moe_weights(F, A, lo, hi, (bid - nlast) * NWAVES + F.wave, (F.G - nlast) * NWAVES); }
    else moe_weights(F, A, lo, hi, F.gw, F.ngw);
}
__device__ __forceinline__ void gen_s5(Frame& F, const Args& A, int g);
#ifndef PROBE_BLK
#define PROBE_BLK 0
#endif
#ifdef PROBE_SETA
#define PROBE_STAMP2(F, k) do { if (blockIdx.x == PROBE_BLK && F.tid == 0) { const unsigned long long t_ = __builtin_amdgcn_s_memrealtime(); const unsigned long long l_ = ((unsigned long long)F.MISC[17] << 32) | F.MISC[16]; const unsigned d_ = (unsigned)(t_ - l_); \
        if ((PROBE_SETA >> (k)) & 1ull) F.MISC[18] += d_; if ((PROBE_SETB >> (k)) & 1ull) F.MISC[20] += d_; F.MISC[16] = (unsigned)t_; F.MISC[17] = (unsigned)(t_ >> 32); } } while (0)
#else
#define PROBE_STAMP2(F, k) do { } while (0)
#endif
__device__ __forceinline__ void p0_prologue(Frame& F, const Args& A) {
    LAS float* scr = (LAS float*)(F.lds + RING_OFF + F.wave * 16384);
    unsigned char* ws = A.ws;
    constexpr int I_IN0 = (D / 64) * (EV_IN / 32), I_UQ = (QRANK / 64) * (768 / 32), I_UKV = (KVRANK / 64) * (1024 / 32), I_GLU = (512 / 64) * (512 / 32), I_OUT = (D / 64) * (D / 32);
    constexpr int I_FG = (D / 64) * (FFN / 32), I_FD = (FFN / 64) * (D / 32), I_IN1 = (D / 64) * (OD_IN / 32), I_MG1 = (D / 64) * (FE / 32), I_MD1 = (FE / 64) * (D / 32);
    constexpr int NITEMS = I_IN0 + I_UQ + I_UKV + I_GLU + I_OUT + 2 * I_FG + I_FD + I_IN1 + I_OUT;
    const bool s5_builder = (int)blockIdx.x >= F.G - S5G;
    for (int it = s5_builder ? NITEMS : F.gw; it < NITEMS; it += F.ngw - S5G * NWAVES) {
        int r = it;
        if (r < I_IN0) { cvt_item(A.in[7], D, EV_IN, (bf16*)(ws + WS_W_IN0), D, 0, 0, 0, nullptr, 1.f, 0, scr, r, F.lane); continue; } r -= I_IN0;
        if (r < I_UQ) { cvt_item(A.in[19], QRANK, 768, (bf16*)(ws + WS_W_QKV), KQKV, 0, 0, 0, A.in[18], 1.f, 0, scr, r, F.lane); continue; } r -= I_UQ;
        if (r < I_UKV) { cvt_item(A.in[21], KVRANK, 1024, (bf16*)(ws + WS_W_QKV), KQKV, QRANK, 768, 3, A.in[20], 1.f, 0, scr, r, F.lane); continue; } r -= I_UKV;
        if (r < I_GLU) { cvt_item(A.in[16], 512, 512, (bf16*)(ws + WS_W_GLU), 512, 0, 0, 0, nullptr, 1.f, 0, scr, r, F.lane); continue; } r -= I_GLU;
        if (r < I_OUT) { cvt_item(A.in[22], D, D, (bf16*)(ws + WS_W_OUT0), D, 0, 0, 0, nullptr, 1.f, 0, scr, r, F.lane); continue; } r -= I_OUT;
        if (r < I_FG) { cvt_item(A.in[23], D, FFN, (bf16*)(ws + WS_W_GU), D, 0, 0, 1, nullptr, FFN0_IS_FP8 ? FP8_SW : 1.f, 1 << 30, scr, r, F.lane, FFN0_IS_FP8); continue; } r -= I_FG;
        if (r < I_FG) { cvt_item(A.in[24], D, FFN, (bf16*)(ws + WS_W_GU), D, 0, 0, 2, nullptr, FFN0_IS_FP8 ? FP8_SW : 1.f, 1 << 30, scr, r, F.lane, FFN0_IS_FP8); continue; } r -= I_FG;
        if (r < I_FD) { cvt_item(A.in[25], FFN, D, (bf16*)(ws + WS_W_DN), FFN, 0, 0, 0, nullptr, (FFN0_IS_FP8 || FFN0_DN_FP8) ? FP8_SW : 1.f, 1 << 30, scr, r, F.lane, FFN0_IS_FP8 || FFN0_DN_FP8); continue; } r -= I_FD;
        if (r < I_IN1) { cvt_item(A.in[26], D, OD_IN, (bf16*)(ws + WS_W_IN1), D, 0, 0, 0, nullptr, 0.08838834764831845f, GKEY, scr, r, F.lane); continue; } r -= I_IN1;
        cvt_item(A.in[30], D, D, (bf16*)(ws + WS_W_OUT1), D, 0, 0, 0, nullptr, 1.f, 0, scr, r, F.lane);
    }
    { const v4u z = {0u, 0u, 0u, 0u}; const int gt = blockIdx.x * (NWAVES * 64) + F.tid, ngt = F.G * NWAVES * 64;
      GAS v4u* p0 = (GAS v4u*)((bf16*)(ws + WS_W_IN0) + (size_t)EV_IN * D); for (int i = gt; i < (EV_INP - EV_IN) * D / 8; i += ngt) p0[i] = z;
      for (int i = gt; i < 768 * (KVRANK / 8); i += ngt) { const int r = i / (KVRANK / 8), c = i % (KVRANK / 8); *(GAS v4u*)((bf16*)(ws + WS_W_QKV) + (size_t)r * KQKV + QRANK + 8 * c) = z; }
      for (int i = gt; i < 1024 * (QRANK / 8); i += ngt) { const int r = i / (QRANK / 8), c = i % (QRANK / 8); *(GAS v4u*)((bf16*)(ws + WS_W_QKV) + (size_t)(768 + r) * KQKV + 8 * c) = z; }
      GAS v4u* p1 = (GAS v4u*)((bf16*)(ws + WS_W_IN1) + (size_t)OD_IN * D); for (int i = gt; i < (OD_INP - OD_IN) * D / 8; i += ngt) p1[i] = z; }
    __syncthreads();
    PROBE_STAMP2(F, 22);
    LAS float* act = (LAS float*)(F.lds);
    LAS float* red = (LAS float*)(F.lds + 17 * 1024 * 4);
    float* modv = (float*)(ws + WS_MODV);
    bool have_act = false;
    for (int u = blockIdx.x; u < 2 * 96; u += F.G) {
        if (!have_act) {
            float xv[17 * 1024 / (NWAVES * 64)];
#pragma unroll
            for (int q = 0; q < 17 * 1024 / (NWAVES * 64); ++q) { const int i = F.tid + q * (NWAVES * 64); xv[q] = (i < 16 * 1024) ? A.in[1][i] : A.in[3][i - 16 * 1024]; }
#pragma unroll
            for (int q = 0; q < 17 * 1024 / (NWAVES * 64); ++q) { const float x = xv[q]; act[F.tid + q * (NWAVES * 64)] = x / (1.0f + __expf(-x)); }
            have_act = true;
        }
        __syncthreads();
        const int layer = u / 96, c0 = (u % 96) * 64;
        const float* mw = A.in[4] + (size_t)layer * D * 6144 + c0 + F.lane;
        float acc[17];
#pragma unroll
        for (int r = 0; r < 17; ++r) acc[r] = 0.f;
        for (int k0 = F.wave * 128; k0 < F.wave * 128 + 128; k0 += 32) { float w[32];
#pragma unroll
            for (int u2 = 0; u2 < 32; ++u2) w[u2] = mw[(size_t)(k0 + u2) * 6144];
#pragma unroll
            for (int u2 = 0; u2 < 32; ++u2)
#pragma unroll
                for (int r = 0; r < 17; ++r) acc[r] += act[r * 1024 + k0 + u2] * w[u2]; }
#pragma unroll
        for (int r = 0; r < 17; ++r) red[(F.wave * 17 + r) * 64 + F.lane] = acc[r];
        __syncthreads();
        for (int i = F.tid; i < 17 * 64; i += NWAVES * 64) { const int r = i >> 6, l = i & 63; float s = A.in[5][layer * 6144 + c0 + l];
#pragma unroll
            for (int w = 0; w < 8; ++w) s += red[(w * 17 + r) * 64 + l];
            modv[(size_t)(layer * 17 + r) * 6144 + c0 + l] = s; }
    }
    __syncthreads();
    PROBE_STAMP2(F, 23);
    for (int g = (int)blockIdx.x - (F.G - S5G); g >= 0 && g < S5G; g += F.G) gen_s5(F, A, g);
    PROBE_STAMP2(F, 24);
}

__device__ __forceinline__ void thin_t1(Frame& F, const Args& A) {
    const float* modv = (const float*)(A.ws + WS_MODV); bf16* XL = (bf16*)(A.ws + WS_XL); const float* gam = A.in[6];
    for (int r = F.gw; r < MA; r += F.ngw) {
        const bool lat = r < ML; const float* src = lat ? A.in[0] + (size_t)r * D : A.in[2] + (size_t)(r - ML) * D; const int bs = lat ? r / SEQ : 16;
        const float* mod = modv + (size_t)bs * 6144;
        f32x4 v[4]; ld_row_f32(src, F.lane, v); norm_mod(v, gam, mod, mod + D, F.lane); st_row_bf16(XL + (size_t)r * D, F.lane, v);
    }
}
__device__ __forceinline__ void thin_t2(Frame& F, const Args& A) {
    const float* modv = (const float*)(A.ws + WS_MODV); bf16* XL = (bf16*)(A.ws + WS_XL); const bf16* YL = (const bf16*)(A.ws + WS_YL); float* HC = (float*)(A.ws + WS_HC); const float* gam = A.in[6];
    for (int r0 = F.gw; r0 < MA; r0 += 2 * F.ngw) {
        const int r1 = (r0 + F.ngw < MA) ? r0 + F.ngw : r0; const bool two = r1 != r0;
        const bool lat0 = r0 < ML, lat1 = r1 < ML;
        const float* src0 = lat0 ? A.in[0] + (size_t)r0 * D : A.in[2] + (size_t)(r0 - ML) * D; const float* src1 = lat1 ? A.in[0] + (size_t)r1 * D : A.in[2] + (size_t)(r1 - ML) * D;
        float* dst0 = lat0 ? A.out + (size_t)r0 * D : HC + (size_t)(r0 - ML) * D; float* dst1 = lat1 ? A.out + (size_t)r1 * D : HC + (size_t)(r1 - ML) * D;
        const float* mod0 = modv + (size_t)(lat0 ? r0 / SEQ : 16) * 6144; const float* mod1 = modv + (size_t)(lat1 ? r1 / SEQ : 16) * 6144;
        f32x4 h0[4], y0[4], h1[4], y1[4];
        ld_row_f32(src0, F.lane, h0); ld_row_bf16(YL + (size_t)r0 * D, F.lane, y0); ld_row_f32(src1, F.lane, h1); ld_row_bf16(YL + (size_t)r1 * D, F.lane, y1);
        gated_add(h0, y0, gam + 1 * D, mod0 + 2 * D, F.lane); gated_add(h1, y1, gam + 1 * D, mod1 + 2 * D, F.lane);
        st_row_f32(dst0, F.lane, h0); if (two) st_row_f32(dst1, F.lane, h1);
        norm_mod(h0, gam + 2 * D, mod0 + 3 * D, mod0 + 4 * D, F.lane); norm_mod(h1, gam + 2 * D, mod1 + 3 * D, mod1 + 4 * D, F.lane);
        if (FFN0_IS_FP8) { st_row_fp8((unsigned char*)XL + (size_t)r0 * D, F.lane, h0, FP8_SA); if (two) st_row_fp8((unsigned char*)XL + (size_t)r1 * D, F.lane, h1, FP8_SA); }
        else { st_row_bf16(XL + (size_t)r0 * D, F.lane, h0); if (two) st_row_bf16(XL + (size_t)r1 * D, F.lane, h1); }
    }
}
__device__ __forceinline__ void thin_t3(Frame& F, const Args& A) {
    const float* modv = (const float*)(A.ws + WS_MODV); bf16* XL = (bf16*)(A.ws + WS_XL); const bf16* FL = (const bf16*)(A.ws + WS_FL); const float* HC = (const float*)(A.ws + WS_HC); const float* gam = A.in[6];
    for (int r0 = F.gw; r0 < MA; r0 += 2 * F.ngw) {
        const int r1 = (r0 + F.ngw < MA) ? r0 + F.ngw : r0; const bool two = r1 != r0;
        const bool lat0 = r0 < ML, lat1 = r1 < ML;
        const float* src0 = lat0 ? A.out + (size_t)r0 * D : HC + (size_t)(r0 - ML) * D; const float* src1 = lat1 ? A.out + (size_t)r1 * D : HC + (size_t)(r1 - ML) * D;
        const int bs0 = lat0 ? r0 / SEQ : 16, bs1 = lat1 ? r1 / SEQ : 16;
        f32x4 h0[4], y0[4], h1[4], y1[4];
        ld_row_f32(src0, F.lane, h0); ld_row_bf16(FL + (size_t)r0 * D, F.lane, y0); ld_row_f32(src1, F.lane, h1); ld_row_bf16(FL + (size_t)r1 * D, F.lane, y1);
        gated_add(h0, y0, gam + 3 * D, modv + (size_t)bs0 * 6144 + 5 * D, F.lane); gated_add(h1, y1, gam + 3 * D, modv + (size_t)bs1 * 6144 + 5 * D, F.lane);
        if (lat0) st_row_f32(A.out + (size_t)r0 * D, F.lane, h0); if (two && lat1) st_row_f32(A.out + (size_t)r1 * D, F.lane, h1);
        { const float* m0 = modv + (size_t)(17 + bs0) * 6144; const float* m1 = modv + (size_t)(17 + bs1) * 6144;
          norm_mod(h0, gam + 4 * D, m0, m0 + D, F.lane); norm_mod(h1, gam + 4 * D, m1, m1 + D, F.lane); }
        st_row_bf16(XL + (size_t)r0 * D, F.lane, h0); if (two) st_row_bf16(XL + (size_t)r1 * D, F.lane, h1);
    }
}
__device__ __forceinline__ void thin_t4(Frame& F, const Args& A) {
    const float* modv = (const float*)(A.ws + WS_MODV); bf16* XL = (bf16*)(A.ws + WS_XLM); const bf16* YL = (const bf16*)(A.ws + WS_YL1); const float* gam = A.in[6] + 4 * D;
    const float* router = A.in[31]; unsigned* tok = (unsigned*)(A.ws + WS_TOK); unsigned short* inv = (unsigned short*)(A.ws + WS_INV);
    LAS float* rt = (LAS float*)(F.lds);
    LAS unsigned* wc = (LAS unsigned*)(F.lds + 32768);
    __syncthreads();
    for (int i = F.tid; i < 8 * 1024; i += NWAVES * 64) { const int e = i >> 10, c = i & 1023; rt[i] = router[(size_t)c * 8 + e]; }
    __syncthreads();
    for (int chunk = blockIdx.x; chunk < ML / 128; chunk += F.G) {
        const int row_base = chunk * 128 + F.wave * 16;
        int me0 = 0, me1 = 0; float mw0 = 0.f, mw1 = 0.f;
        for (int i = 0; i < 16; ++i) {
            const int r = row_base + i; const int bs = r / SEQ; const float* mod1 = modv + (size_t)(17 + bs) * 6144;
            f32x4 h[4], y[4]; ld_row_f32(A.out + (size_t)r * D, F.lane, h); ld_row_bf16(YL + (size_t)r * D, F.lane, y);
            gated_add(h, y, gam + 1 * D, mod1 + 2 * D, F.lane); st_row_f32(A.out + (size_t)r * D, F.lane, h);
            norm_mod(h, gam + 2 * D, mod1 + 3 * D, mod1 + 4 * D, F.lane); st_row_fp8((unsigned char*)XL + (size_t)r * D, F.lane, h, FP8_SA);
            float lg[8];
#pragma unroll
            for (int e = 0; e < 8; ++e) { float a = 0.f;
#pragma unroll
                for (int j = 0; j < 4; ++j) { const f32x4 w = *(const LAS f32x4*)(rt + e * 1024 + 256 * j + 4 * F.lane); a += (h[j].x * w.x + h[j].y * w.y) + (h[j].z * w.z + h[j].w * w.w); }
                lg[e] = a; }
            {
              const bool b5 = (F.lane & 32) != 0, b4 = (F.lane & 16) != 0, b3 = (F.lane & 8) != 0; float v4[4], v2[2];
#pragma unroll
              for (int i2 = 0; i2 < 4; ++i2) { const float keep = b5 ? lg[i2 + 4] : lg[i2], send = b5 ? lg[i2] : lg[i2 + 4]; v4[i2] = keep + __shfl_xor(send, 32); }
#pragma unroll
              for (int i2 = 0; i2 < 2; ++i2) { const float keep = b4 ? v4[i2 + 2] : v4[i2], send = b4 ? v4[i2] : v4[i2 + 2]; v2[i2] = keep + __shfl_xor(send, 16); }
              float v1 = (b3 ? v2[1] : v2[0]) + __shfl_xor(b3 ? v2[0] : v2[1], 8);
              v1 += __shfl_xor(v1, 1); v1 += __shfl_xor(v1, 2); v1 += __shfl_xor(v1, 4);
#pragma unroll
              for (int e = 0; e < 8; ++e) lg[e] = __builtin_bit_cast(float, __builtin_amdgcn_readlane(__builtin_bit_cast(int, v1), 8 * e)); }
            int e0 = 0; float v0 = lg[0];
#pragma unroll
            for (int e = 1; e < 8; ++e) if (lg[e] > v0) { v0 = lg[e]; e0 = e; }
            int e1 = (e0 + 1) & 7; float v1 = -3.0e38f;
#pragma unroll
            for (int e = 0; e < 8; ++e) if (e != e0 && lg[e] > v1) { v1 = lg[e]; e1 = e; }
            const float w1 = 1.0f / (1.0f + __expf(v0 - v1)), w0 = 1.0f - w1;
            if (F.lane == i) { me0 = e0; me1 = e1; mw0 = w0; mw1 = w1; }
        }
        unsigned long long m[8];
#pragma unroll
        for (int e = 0; e < 8; ++e) m[e] = __ballot(F.lane < 16 && (me0 == e || me1 == e));
        { unsigned c = 0;
#pragma unroll
          for (int e = 0; e < 8; ++e) c = (F.lane == e) ? (unsigned)__popcll(m[e]) : c;
          if (F.lane < 8) wc[F.wave * 8 + F.lane] = c; }
        __syncthreads();
        if (F.tid < 8) { unsigned tot = 0;
#pragma unroll
            for (int w = 0; w < 8; ++w) tot += wc[w * 8 + F.tid];
            unsigned run = __hip_atomic_fetch_add((unsigned*)(F.ctl + CW_CNT + F.tid), tot, __ATOMIC_RELAXED, __HIP_MEMORY_SCOPE_AGENT);
#pragma unroll
            for (int w = 0; w < 8; ++w) { const unsigned c = wc[w * 8 + F.tid]; wc[w * 8 + F.tid] = run; run += c; } }
        __syncthreads();
        if (F.lane < 16) { unsigned long long m0 = 0ull, m1 = 0ull;
#pragma unroll
            for (int e = 0; e < 8; ++e) { m0 = (me0 == e) ? m[e] : m0; m1 = (me1 == e) ? m[e] : m1; }
            const unsigned long long below = (1ull << F.lane) - 1ull;
            const unsigned i0 = wc[F.wave * 8 + me0] + (unsigned)__popcll(m0 & below), i1 = wc[F.wave * 8 + me1] + (unsigned)__popcll(m1 & below);
            unsigned* t = tok + (size_t)(row_base + F.lane) * 8; t[0] = (unsigned)me0; t[1] = (unsigned)me1; t[2] = i0; t[3] = i1; t[4] = __float_as_uint(mw0); t[5] = __float_as_uint(mw1);
            inv[(size_t)me0 * 32768 + i0] = (unsigned short)(row_base + F.lane); inv[(size_t)me1 * 32768 + i1] = (unsigned short)(row_base + F.lane); }
        __syncthreads();
    }
}
__device__ __forceinline__ void moe_tile_starts(Frame& F, int (&ts)[9]) {
    ts[0] = 0;
#pragma unroll
    for (int e = 0; e < 8; ++e) { const unsigned c = __hip_atomic_load((unsigned*)(F.ctl + CW_CNT + e), __ATOMIC_RELAXED, __HIP_MEMORY_SCOPE_AGENT); ts[e + 1] = ts[e] + (int)((c + 255u) >> 8); }
#pragma unroll
    for (int e = 0; e < 9; ++e) ts[e] = __builtin_amdgcn_readfirstlane(ts[e]);
}
template <class Sched> __device__ __forceinline__ void moe_row_table(Frame& F, const Args& A, const Sched& S, const int (&ts)[9]) {
    const unsigned short* inv = (const unsigned short*)(A.ws + WS_INV); LAS unsigned short* tab = (LAS unsigned short*)(F.lds + ATAB_OFF);
    __syncthreads();
    for (int i = 0; i < ATAB_UNITS; ++i) { pg8::Unit u; if (!S.next(i, u)) break;
        int e = 0;
#pragma unroll
        for (int q = 1; q < 8; ++q) e += (u.pm >= ts[q]) ? 1 : 0;
        int tse = 0;
#pragma unroll
        for (int q = 0; q < 8; ++q) tse = (e == q) ? ts[q] : tse;
        const unsigned cnt = __hip_atomic_load((unsigned*)(F.ctl + CW_CNT + e), __ATOMIC_RELAXED, __HIP_MEMORY_SCOPE_AGENT);
        if (F.tid < 256) { const unsigned r = (unsigned)(u.pm - tse) * 256u + (unsigned)F.tid; tab[i * 256 + F.tid] = (r < cnt) ? inv[(size_t)e * 32768 + r] : (unsigned short)0; } }
    __syncthreads();
}
__device__ __forceinline__ void thin_t5(Frame& F, const Args& A) {
    int ts[9]; moe_tile_starts(F, ts);
    const float* modv = (const float*)(A.ws + WS_MODV); const bf16* Y = (const bf16*)(A.ws + WS_Y); const float* gam = A.in[6] + 7 * D; const unsigned* tok = (const unsigned*)(A.ws + WS_TOK);
    for (int r = F.gw; r < ML; r += F.ngw) {
        const int bs = r / SEQ; const float* mod1 = modv + (size_t)(17 + bs) * 6144;
        const unsigned* t = tok + (size_t)r * 8; const float w0 = __uint_as_float(t[4]), w1 = __uint_as_float(t[5]); const int e0 = (int)t[0], e1 = (int)t[1]; int s0 = 0, s1 = 0;
#pragma unroll
        for (int e = 0; e < 8; ++e) { s0 = (e0 == e) ? ts[e] : s0; s1 = (e1 == e) ? ts[e] : s1; }
        const unsigned p0 = (unsigned)s0 * 256u + t[2], p1 = (unsigned)s1 * 256u + t[3];
        f32x4 h[4], y0[4], y1[4]; ld_row_f32(A.out + (size_t)r * D, F.lane, h); ld_row_bf16(Y + (size_t)p0 * D, F.lane, y0); ld_row_bf16(Y + (size_t)p1 * D, F.lane, y1);
#pragma unroll
        for (int j = 0; j < 4; ++j) y0[j] = y0[j] * w0 + y1[j] * w1;
        gated_add(h, y0, gam, mod1 + 5 * D, F.lane); st_row_f32(A.out + (size_t)r * D, F.lane, h);
    }
}

__device__ __forceinline__ float rope_inv(int f) { return exp2f(-(float)f * (13.287712379549449f / 8.0f)); }
__device__ __forceinline__ void prep_qa(Frame& F, const Args& A) {
    const bf16* Z0 = (const bf16*)(A.ws + WS_Z0C); bf16* QA = (bf16*)(A.ws + WS_QA); bf16* KR = (bf16*)(A.ws + WS_KR);
    for (int r = F.gw; r < MA; r += F.ngw) {
        const bf16* z = Z0 + (size_t)r * 512;
        const v2u cq = *((const GAS v2u*)(z) + F.lane); const unsigned ck = *((const GAS unsigned*)(z + 256) + F.lane);
        const float q0 = bf_lo(cq.x), q1 = bf_hi(cq.x), q2 = bf_lo(cq.y), q3 = bf_hi(cq.y), k0 = bf_lo(ck), k1 = bf_hi(ck);
        const float rq = rsqrtf(wave_sum((q0 * q0 + q1 * q1) + (q2 * q2 + q3 * q3)) * (1.0f / QRANK) + EPS);
        const float rk = rsqrtf(wave_sum(k0 * k0 + k1 * k1) * (1.0f / KVRANK) + EPS);
        v2u oq; oq.x = pk2(q0 * rq, q1 * rq); oq.y = pk2(q2 * rq, q3 * rq);
        *((GAS v2u*)(QA + (size_t)r * KQKV) + F.lane) = oq; *((GAS unsigned*)(QA + (size_t)r * KQKV + QRANK) + F.lane) = pk2(k0 * rk, k1 * rk);
        const int l = F.lane & 31; float v = bf1(z[384 + l]); const float pv = __shfl_xor(v, 8);
        if (r < ML) { const int t = r % SEQ; const float pos = (l < 16) ? (float)(t / 64) : (float)(t % 64); float sn, cs; sincosf(pos * rope_inv(l & 7), &sn, &cs);
            v = (l & 8) ? (v * cs + pv * sn) : (v * cs - pv * sn); }
        if (F.lane < 32) KR[(size_t)r * 32 + l] = (bf16)f2bf(v);
    }
}
__device__ __forceinline__ void rope_q(Frame& F, const Args& A) {
    bf16* Q = (bf16*)(A.ws + WS_Q);
    for (int r = F.gw; r < ML; r += F.ngw) {
        const int t = r % SEQ, hh = F.lane >> 3, sub = F.lane & 7; bf16* p = Q + (size_t)r * 768 + hh * QK + NOPE + sub;
        const float inv = rope_inv(sub); float sr, cr, sc, cc; sincosf((float)(t / 64) * inv, &sr, &cr); sincosf((float)(t % 64) * inv, &sc, &cc);
        const float x0 = bf1(p[0]), x1 = bf1(p[8]), x2 = bf1(p[16]), x3 = bf1(p[24]);
        p[0] = (bf16)f2bf(x0 * cr - x1 * sr); p[8] = (bf16)f2bf(x1 * cr + x0 * sr); p[16] = (bf16)f2bf(x2 * cc - x3 * sc); p[24] = (bf16)f2bf(x3 * cc + x2 * sc);
    }
}
__device__ __forceinline__ int scan_row(int b, int dir, int tau) {
    if (tau < CTXL) return ML + b * CTXL + (dir ? CTXL - 1 - tau : tau);
    const int t = tau - CTXL; return b * SEQ + (dir ? SEQ - 1 - t : t);
}
__device__ __forceinline__ float gelu_tanh(float x) { const float u = 0.7978845608028654f * (x + 0.044715f * x * x * x); const float e = __expf(2.0f * u); const float th = 1.0f - 2.0f / (e + 1.0f); return 0.5f * x * (1.0f + th); }
__device__ __forceinline__ void gen_s5(Frame& F, const Args& A, int g) {
    constexpr int CS = 65;
    LAS float* pw = (LAS float*)F.lds;
    LAS float* cc = pw + 2 * 64 * 17 * 2;
    LAS float* bb = cc + 2 * 16 * CS * 2;
    LAS float* KK = bb + 2 * 64 * 16 * 2;
    LAS float* LL = KK + 2 * 16 * 16 * 16;
    LAS float* DSK = LL + 128 * 4;
    bf16* B1g = (bf16*)(A.ws + WS_B1) + (size_t)g * 256 * 256; bf16* B3g = (bf16*)(A.ws + WS_B3) + (size_t)g * 256 * 512;
    __syncthreads();
    { float lr = 0.f, li = 0.f, dtr = 0.f, dk = 0.f, braw[4], biraw[4], craw[4], ciraw[4];
      if (F.tid < 128) { const int d = F.tid >> 6, p = F.tid & 63, ig = d * S5G + g, i = ig * S5P + p; lr = A.in[8][i]; li = A.in[9][i]; dtr = A.in[10][ig]; }
      if (F.tid < 16) dk = A.in[15][g * 16 + F.tid];
#pragma unroll
      for (int q = 0; q < 4; ++q) { const int idx = F.tid + q * (NWAVES * 64); { const int dp = idx >> 4, h = idx & 15, d = dp >> 6, p = dp & 63; const size_t i = (size_t)((d * S5G + g) * S5P + p); braw[q] = A.in[11][i * 16 + h]; biraw[q] = A.in[12][i * 16 + h]; }
        { const int d = idx >> 10, ho = (idx >> 6) & 15, p = idx & 63; const size_t ci = (size_t)((d * S5G + g) * 16 + ho) * S5P + p; craw[q] = A.in[13][ci]; ciraw[q] = A.in[14][ci]; } }
      if (F.tid < 128) { const float dt = expf(dtr); LL[F.tid * 4] = lr; LL[F.tid * 4 + 1] = li; LL[F.tid * 4 + 2] = lr * dt; LL[F.tid * 4 + 3] = li * dt; }
      if (F.tid < 16) DSK[F.tid] = dk;
#pragma unroll
      for (int q = 0; q < 4; ++q) { const int idx = F.tid + q * (NWAVES * 64); bb[idx * 2] = braw[q]; bb[idx * 2 + 1] = biraw[q];
        { const int d = idx >> 10, ho = (idx >> 6) & 15, p = idx & 63; cc[((d * 16 + ho) * CS + p) * 2] = craw[q]; cc[((d * 16 + ho) * CS + p) * 2 + 1] = ciraw[q]; } } }
    __syncthreads();
    for (int idx = F.tid; idx < 128 * 17; idx += NWAVES * 64) { const int dp = idx / 17, k = idx - dp * 17;
        const float mag = expf((float)k * LL[dp * 4 + 2]), ang = (float)k * LL[dp * 4 + 3]; pw[(dp * 17 + k) * 2] = mag * cosf(ang); pw[(dp * 17 + k) * 2 + 1] = mag * sinf(ang); }
    for (int idx = F.tid; idx < 128 * 16; idx += NWAVES * 64) { const int dp = idx >> 4;
        const float lr = LL[dp * 4], li = LL[dp * 4 + 1], lrdt = LL[dp * 4 + 2], lidt = LL[dp * 4 + 3];
        const float mag = expf(lrdt), ar = mag * cosf(lidt), ai = mag * sinf(lidt), den = lr * lr + li * li, nr = ar - 1.0f;
        const float cr = (nr * lr + ai * li) / den, ci = (ai * lr - nr * li) / den;
        const float br = bb[idx * 2], bi = bb[idx * 2 + 1]; bb[idx * 2] = cr * br - ci * bi; bb[idx * 2 + 1] = cr * bi + ci * br; }
    __syncthreads();
    { const int ho = F.tid & 15, k = (F.tid >> 4) & 15, d = F.tid >> 8;
      float acc[16];
#pragma unroll
      for (int hi = 0; hi < 16; ++hi) acc[hi] = 0.f;
      for (int p = 0; p < 64; ++p) { const float cr = cc[((d * 16 + ho) * CS + p) * 2], ci = cc[((d * 16 + ho) * CS + p) * 2 + 1], pr = pw[((d * 64 + p) * 17 + k) * 2], pi = pw[((d * 64 + p) * 17 + k) * 2 + 1];
          const float wr = cr * pr - ci * pi, wi = cr * pi + ci * pr; const LAS f32x4* bp = (const LAS f32x4*)(bb + (d * 64 + p) * 32);
#pragma unroll
          for (int q = 0; q < 8; ++q) { const f32x4 b4 = bp[q]; acc[2 * q] += wr * b4.x - wi * b4.y; acc[2 * q + 1] += wr * b4.z - wi * b4.w; } }
#pragma unroll
      for (int hi = 0; hi < 16; ++hi) KK[((d * 16 + k) * 16 + ho) * 16 + hi] = acc[hi]; }
    __syncthreads();
    for (int it = F.tid; it < 256 * 32; it += NWAVES * 64) { const int n = it >> 5, kk0 = (it & 31) * 8;
        float v3[8], v3b[8], v1[8];
        { const int j = n >> 4, ho = n & 15, i = kk0 >> 4, hi0 = kk0 & 15; const float dsk = DSK[ho];
#pragma unroll
          for (int e8 = 0; e8 < 8; ++e8) { const int hi = hi0 + e8; float val = 0.f;
            if (i <= j) val += KK[((0 * 16 + (j - i)) * 16 + ho) * 16 + hi];
            if (i >= j) val += KK[((1 * 16 + (i - j)) * 16 + ho) * 16 + hi];
            if (i == j && ho == hi) val += dsk;
            v3[e8] = val; }
          const int d = kk0 >> 7, reim = (kk0 >> 6) & 1, p0 = kk0 & 63, e = d ? (16 - j) : (j + 1);
#pragma unroll
          for (int e8 = 0; e8 < 8; ++e8) { const int p = p0 + e8;
            const float cr = cc[((d * 16 + ho) * CS + p) * 2], ci = cc[((d * 16 + ho) * CS + p) * 2 + 1], pr = pw[((d * 64 + p) * 17 + e) * 2], pi = pw[((d * 64 + p) * 17 + e) * 2 + 1];
            v3b[e8] = reim ? -(cr * pi + ci * pr) : (cr * pr - ci * pi); } }
        { const int d = n >> 7, reim = (n >> 6) & 1, p = n & 63, i = kk0 >> 4, hi0 = kk0 & 15, e = d ? i : (15 - i);
          const float pr = pw[((d * 64 + p) * 17 + e) * 2], pi = pw[((d * 64 + p) * 17 + e) * 2 + 1];
#pragma unroll
          for (int e8 = 0; e8 < 8; ++e8) { const int hi = hi0 + e8; const float br = bb[((d * 64 + p) * 16 + hi) * 2], bi = bb[((d * 64 + p) * 16 + hi) * 2 + 1];
            v1[e8] = reim ? (pr * bi + pi * br) : (pr * br - pi * bi); } }
        const v4u w3 = {pk2(v3[0], v3[1]), pk2(v3[2], v3[3]), pk2(v3[4], v3[5]), pk2(v3[6], v3[7])}, w3b = {pk2(v3b[0], v3b[1]), pk2(v3b[2], v3b[3]), pk2(v3b[4], v3b[5]), pk2(v3b[6], v3b[7])};
        const v4u w1 = {pk2(v1[0], v1[1]), pk2(v1[2], v1[3]), pk2(v1[4], v1[5]), pk2(v1[6], v1[7])};
        *(GAS v4u*)(B3g + (size_t)n * 512 + kk0) = w3; *(GAS v4u*)(B3g + (size_t)n * 512 + 256 + kk0) = w3b; *(GAS v4u*)(B1g + (size_t)n * 256 + kk0) = w1; }
    __syncthreads();
}
__device__ __forceinline__ void s5_scan(Frame& F, const Args& A) {
    if (F.wave < 4) {
        const float* DS = (const float*)(A.ws + WS_DS); bf16* A3 = (bf16*)(A.ws + WS_A3); const int p = F.lane;
        for (int task = blockIdx.x * 4 + F.wave; task < NB * S5G * 2; task += F.G * 4) {
            const int d = task & 1, g = (task >> 1) & 31, b = task >> 6, ig = d * S5G + g;
            const float lr = A.in[8][ig * S5P + p], li = A.in[9][ig * S5P + p], dt = expf(A.in[10][ig]);
            const float m16 = expf(16.0f * lr * dt), a16r = m16 * cosf(16.0f * li * dt), a16i = m16 * sinf(16.0f * li * dt);
            const float* ds = DS + (size_t)(g * 16 + b) * 144 * 256 + d * 128 + p; bf16* so = A3 + (size_t)(g * 16 + b) * 144 * 512 + 256 + d * 128 + p;
            float sr = 0.f, si = 0.f;
            for (int blk = 0; blk < 9; ++blk) {
                const int cbase = d ? (blk == 0 ? 15 : 143 - (blk - 1) * 16) : blk * 16, cstep = d ? -1 : 1;
                float xr[16], xi[16];
#pragma unroll
                for (int s = 0; s < 16; ++s) { const int c = cbase + cstep * s; xr[s] = ds[(size_t)c * 256]; xi[s] = ds[(size_t)c * 256 + 64]; }
#pragma unroll
                for (int s = 0; s < 16; ++s) { const int c = cbase + cstep * s; so[(size_t)c * 512] = (bf16)f2bf(sr); so[(size_t)c * 512 + 64] = (bf16)f2bf(si);
                    const float nsr = a16r * sr - a16i * si + xr[s], nsi = a16r * si + a16i * sr + xi[s]; sr = nsr; si = nsi; }
            }
        }
    }
}
__device__ __forceinline__ void attn_phase(Frame& F, const Args& A) {
    const bf16* Q = (const bf16*)(A.ws + WS_Q); const bf16* KV = (const bf16*)(A.ws + WS_KV); const bf16* KR = (const bf16*)(A.ws + WS_KR); bf16* AO = (bf16*)(A.ws + WS_AO);
    const int bid = (int)blockIdx.x; const int vcu = (F.G % 8 == 0) ? (bid % 8) * (F.G / 8) + bid / 8 : bid;
    for (int u = vcu; u < 1024 + 128; u += F.G) {
        int b, h, qrow0, NT;
        if (u < 1024) { const int bh = u >> 3; b = bh >> 3; h = bh & 7; qrow0 = b * SEQ + (u & 7) * 256; NT = TT / 64; }
        else { const int uu = u - 1024; b = uu >> 3; h = uu & 7; qrow0 = ML + b * CTXL; NT = CTXL / 64; }
        att::attn_unit(Q + (size_t)qrow0 * 768 + h * QK, KV + h * NOPE, KR, KV + 512 + h * VD, ML + b * CTXL, CTXL / 64, b * SEQ, NT, AO + (size_t)qrow0 * D + S5W + h * VD, F.lds, (u < 1024) ? (u & 7) * 256 : -1);
    }
}
__device__ __forceinline__ void gla_prep_phase(Frame& F, const Args& A) {
    for (int j = blockIdx.x; j < NB * GH * 2 * 2; j += F.G) { const int ch = j >> 1, b = ch >> 3, h = (ch >> 1) & 3, dir = ch & 1;
        gla::gla_prep((const bf16*)(A.ws + WS_QK), (const bf16*)(A.ws + WS_VR) + 2048, A.in[27], A.in[28], (bf16*)(A.ws + WS_TQ), (bf16*)(A.ws + WS_TK), (bf16*)(A.ws + WS_TP), (float*)(A.ws + WS_EL),
                      b, h, dir, 18 * (j & 1), 18 * (j & 1) + 18, ML, SEQ, CTXL, F.lds); }
}
__device__ __forceinline__ void gla_chain_phase(Frame& F, const Args& A) {
    const int bid = (int)blockIdx.x; const int vcu = (F.G % 8 == 0) ? (bid % 8) * (F.G / 8) + bid / 8 : bid;
    for (int u = vcu; u < NB * GH * 2 * 2; u += F.G) { const int ch = u >> 1, vh = u & 1, b = ch >> 3, h = (ch >> 1) & 3, dir = ch & 1;
        gla::gla_chain2((const bf16*)(A.ws + WS_VR), (const bf16*)(A.ws + WS_TQ), (const bf16*)(A.ws + WS_TK), (const bf16*)(A.ws + WS_TP), (const float*)(A.ws + WS_EL), (bf16*)(A.ws + (dir ? WS_OB : WS_OF)),
                        b, h, dir, vh, ML, SEQ, CTXL, F.lds); }
}
__device__ __forceinline__ void gla_finish(Frame& F, const Args& A) {
    bf16* OF = (bf16*)(A.ws + WS_OF); const bf16* OB = (const bf16*)(A.ws + WS_OB); const bf16* VR = (const bf16*)(A.ws + WS_VR); const float* hn = A.in[29];
    const f32x4 g = *(const GAS f32x4*)(hn + 4 * F.lane);
    for (int r0 = F.gw; r0 < ML; r0 += 2 * F.ngw) {
        const int r1 = (r0 + F.ngw < ML) ? r0 + F.ngw : r0; const bool two = r1 != r0;
        f32x4 a0[4], b0[4], x0[4], a1[4], b1[4], x1[4];
        ld_row_bf16(OF + (size_t)r0 * D, F.lane, a0); ld_row_bf16(OB + (size_t)r0 * D, F.lane, b0); ld_row_bf16(VR + (size_t)r0 * VRLD + GVAL, F.lane, x0);
        ld_row_bf16(OF + (size_t)r1 * D, F.lane, a1); ld_row_bf16(OB + (size_t)r1 * D, F.lane, b1); ld_row_bf16(VR + (size_t)r1 * VRLD + GVAL, F.lane, x1);
#pragma unroll
        for (int j = 0; j < 4; ++j) { const f32x4 o0 = a0[j] + b0[j], o1 = a1[j] + b1[j];
            const float s0 = wave_sum((o0.x * o0.x + o0.y * o0.y) + (o0.z * o0.z + o0.w * o0.w)), s1 = wave_sum((o1.x * o1.x + o1.y * o1.y) + (o1.z * o1.z + o1.w * o1.w));
            const float rs0 = rsqrtf(s0 * (1.0f / GDV) + EPS), rs1 = rsqrtf(s1 * (1.0f / GDV) + EPS);
#pragma unroll
            for (int i = 0; i < 4; ++i) { const float u0 = x0[j][i], u1 = x1[j][i];
                a0[j][i] = o0[i] * rs0 * g[i] * (u0 * __builtin_amdgcn_rcpf(1.0f + __expf(-u0))); a1[j][i] = o1[i] * rs1 * g[i] * (u1 * __builtin_amdgcn_rcpf(1.0f + __expf(-u1))); } }
        st_row_bf16(OF + (size_t)r0 * D, F.lane, a0); if (two) st_row_bf16(OF + (size_t)r1 * D, F.lane, a1);
    }
}

#ifndef MK_ONE_LAUNCH
#define MK_ONE_LAUNCH 1
#endif
constexpr int NPHASE = 21;
constexpr bool SP2 = true, ALIGN = true;

__global__ void __launch_bounds__(NWAVES * 64, 2) fwd_kernel(Args args) {
    extern __shared__ __attribute__((aligned(16))) unsigned char lds[];
    Frame F;
    F.lds = (LAS unsigned char*)lds;
    F.MISC = (volatile LAS unsigned*)(F.lds + MISC_OFF);
    F.tid = threadIdx.x; F.lane = F.tid & 63; F.wave = __builtin_amdgcn_readfirstlane(F.tid >> 6);
    F.G = gridDim.x; F.gw = blockIdx.x * NWAVES + F.wave; F.ngw = F.G * NWAVES;
    unsigned char* ws = args.ws;
    F.ctl = (gu32*)(ws + WS_CTL);
    for (int u = F.tid; u < (LDS_BYTES - LDSCTL_OFF) / 4; u += NWAVES * 64) ((LAS unsigned*)(F.lds + LDSCTL_OFF))[u] = 0u;
    __syncthreads();
    XcdBarrier bar; bar.bar = (unsigned*)(F.ctl + CW_BAR); bar.x = 0; bar.st = nullptr;
    if (MK_ONE_LAUNCH) bar = xcd_barrier_post((unsigned*)(F.ctl + CW_BAR), F.MISC + 8);
    const int lo = args.ph_lo, hi = args.ph_hi;
#define IN(k) (lo <= (k) && (k) < hi)
#ifdef PROBE_SETA
    if (blockIdx.x == PROBE_BLK && F.tid == 0) { const unsigned long long t_ = __builtin_amdgcn_s_memrealtime(); F.MISC[16] = (unsigned)t_; F.MISC[17] = (unsigned)(t_ >> 32); }
#define PROBE_STAMP(k) do { if (blockIdx.x == PROBE_BLK && F.tid == 0) { const unsigned long long t_ = __builtin_amdgcn_s_memrealtime(); const unsigned long long l_ = ((unsigned long long)F.MISC[17] << 32) | F.MISC[16]; const unsigned d_ = (unsigned)(t_ - l_); \
        if ((PROBE_SETA >> (k)) & 1ull) F.MISC[18] += d_; if ((PROBE_SETB >> (k)) & 1ull) F.MISC[20] += d_; F.MISC[16] = (unsigned)t_; F.MISC[17] = (unsigned)(t_ >> 32); } } while (0)
#else
#define PROBE_STAMP(k) do { } while (0)
#endif
#define SEAM(k) do { if (MK_ONE_LAUNCH && IN(k) && IN((k) + 1)) xcd_barrier(bar); PROBE_STAMP(k); } while (0)
    const int bid = (int)blockIdx.x;

    if (IN(0)) {
#ifndef NO_P0
 p0_prologue(F, args);
#endif
 } SEAM(0);
    if (IN(1)) { thin_t1(F, args); } SEAM(1);
    if (IN(2)) { pg8::Gemm g{(const bf16*)(ws + WS_XL), (const bf16*)(ws + WS_W_IN0), MA, EV_INP, D}; pg8::StaticOrder S; S.init(MA, EV_INP, F.G, bid);
        pg8::EpiIn0 E{(bf16*)(ws + WS_U), (bf16*)(ws + WS_A3), (bf16*)(ws + WS_Z0C)};
        pg8::gemm_phase<pg8::EpiIn0, pg8::StaticOrder, ALIGN, SP2>(F.lds + RING_OFF, g, S, E);
        tail_convert(F, args, (MA / 256) * (EV_INP / 256), MW0, MW1); } SEAM(2);
    if (IN(3)) { prep_qa(F, args);
        int k256 = 256; asm volatile("" : "+s"(k256));
        pg8::Gemm g{(const bf16*)(ws + WS_U), (const bf16*)(ws + WS_B1), 32 * 2304, 256, k256}; pg8::S5Order S{F.G, bid};
        pg8::EpiF32 E{(float*)(ws + WS_DS), 256};
        pg8::gemm_phase<pg8::EpiF32, pg8::S5Order, ALIGN, SP2>(F.lds + RING_OFF, g, S, E); } SEAM(3);
    if (IN(4)) { s5_scan(F, args);
        pg8::Gemm g{(const bf16*)(ws + WS_QA), (const bf16*)(ws + WS_W_QKV), MA, NQKV, KQKV}; pg8::StaticOrder S; S.init(MA, NQKV, F.G, bid);
        pg8::EpiSplit E{(bf16*)(ws + WS_Q), 768, (bf16*)(ws + WS_KV), 1024, 3, 0x7fffffff};
        pg8::gemm_phase<pg8::EpiSplit, pg8::StaticOrder, ALIGN, SP2>(F.lds + RING_OFF, g, S, E); } SEAM(4);
    if (IN(5)) {
        pg8::Gemm g{(const bf16*)(ws + WS_A3), (const bf16*)(ws + WS_B3), 32 * 2304, 256, 512}; pg8::S5Order S{F.G, bid};
        pg8::EpiS5Out E{(bf16*)(ws + WS_AG)};
        pg8::gemm_phase<pg8::EpiS5Out, pg8::S5Order, ALIGN, SP2>(F.lds + RING_OFF, g, S, E); } SEAM(5);
    if (IN(6)) {
#ifndef NO_ATT
 attn_phase(F, args);
#endif
        PROBE_STAMP(21);
        pg8::Gemm g{(const bf16*)(ws + WS_AG), (const bf16*)(ws + WS_W_GLU), MA, S5W, S5W}; pg8::StaticOrder S; S.init(MA, S5W, F.G, bid);
        pg8::EpiGlu E{(const bf16*)(ws + WS_AG), args.in[17], (bf16*)(ws + WS_AO), D};
        pg8::gemm_phase<pg8::EpiGlu, pg8::StaticOrder, ALIGN, SP2, false, false, true>(F.lds + RING_OFF, g, S, E); } SEAM(6);
    if (IN(7)) { pg8::Gemm g{(const bf16*)(ws + WS_AO), (const bf16*)(ws + WS_W_OUT0), MA, D, D}; pg8::StaticOrder S; S.init(MA, D, F.G, bid);
        pg8::EpiPlain E{(bf16*)(ws + WS_YL), D, 0, 0, 1.0f};
        pg8::gemm_phase<pg8::EpiPlain, pg8::StaticOrder, ALIGN, SP2>(F.lds + RING_OFF, g, S, E);
        tail_convert(F, args, (MA / 256) * (D / 256), MW1, MW2); } SEAM(7);
    if (IN(8)) { thin_t2(F, args); } SEAM(8);
    static_assert(!FFN0_IS_FP8, "the e4m3 dense-FFN variant does not carry the MoE weight conversion in its down phase");
    if constexpr (FFN0_IS_FP8) {
    if (IN(9)) { pg8::Gemm g{(const bf16*)(ws + WS_XL), (const bf16*)(ws + WS_W_GU), MA, 2 * FFN, D / 2}; pg8::StaticOrder S; S.init(MA, 2 * FFN, F.G, bid);
        pg8::EpiSwiGlu8 E{ws + WS_ACT, FFN, 0, 1.0f / (FP8_SA * FP8_SW), FP8_SACT, 0};
        pg8::gemm_phase<pg8::EpiSwiGlu8, pg8::StaticOrder, ALIGN, SP2, true>(F.lds + RING_OFF, g, S, E); } SEAM(9);
    if (IN(10)) { pg8::Gemm g{(const bf16*)(ws + WS_ACT), (const bf16*)(ws + WS_W_DN), MA, D, FFN / 2}; pg8::StaticOrder S; S.init(MA, D, F.G, bid);
        pg8::EpiPlain E{(bf16*)(ws + WS_FL), D, 0, 0, 1.0f / (FP8_SACT * FP8_SW)};
        pg8::gemm_phase<pg8::EpiPlain, pg8::StaticOrder, ALIGN, SP2, true>(F.lds + RING_OFF, g, S, E); } SEAM(10);
    } else {
    if (IN(9)) { pg8::Gemm g{(const bf16*)(ws + WS_XL), (const bf16*)(ws + WS_W_GU), MA, 2 * FFN, D}; pg8::StaticOrder S; S.init(MA, 2 * FFN, F.G, bid);
        if constexpr (FFN0_DN_FP8) { pg8::EpiSwiGlu8 E{ws + WS_ACT, FFN, 0, 1.0f, FP8_SACT, 0};
            pg8::gemm_phase<pg8::EpiSwiGlu8, pg8::StaticOrder, ALIGN, SP2>(F.lds + RING_OFF, g, S, E); }
        else { pg8::EpiSwiGlu E{(bf16*)(ws + WS_ACT), FFN, 0, 0};
            pg8::gemm_phase<pg8::EpiSwiGlu, pg8::StaticOrder, ALIGN, SP2>(F.lds + RING_OFF, g, S, E); }
        tail_convert(F, args, (MA / 256) * (2 * FFN / 256), MW2, MW3); } SEAM(9);
    if (IN(10)) { pg8::StaticOrder S; S.init(MA, D, F.G, bid);
        if constexpr (FFN0_DN_FP8) { pg8::Gemm g{(const bf16*)(ws + WS_ACT), (const bf16*)(ws + WS_W_DN), MA, D, FFN / 2};
            pg8::EpiPlain E{(bf16*)(ws + WS_FL), D, 0, 0, 1.0f / (FP8_SACT * FP8_SW)};
            pg8::gemm_phase<pg8::EpiPlain, pg8::StaticOrder, ALIGN, SP2, true>(F.lds + RING_OFF, g, S, E); }
        else { pg8::Gemm g{(const bf16*)(ws + WS_ACT), (const bf16*)(ws + WS_W_DN), MA, D, FFN};
            pg8::EpiPlain E{(bf16*)(ws + WS_FL), D, 0, 0, 1.0f};
            pg8::gemm_phase<pg8::EpiPlain, pg8::StaticOrder, ALIGN, SP2>(F.lds + RING_OFF, g, S, E); }
        tail_convert(F, args, (MA / 256) * (D / 256), MW3, MW4); } SEAM(10);
    }
    if (IN(11)) { thin_t3(F, args); } SEAM(11);
    if (IN(12)) { pg8::Gemm g{(const bf16*)(ws + WS_XL), (const bf16*)(ws + WS_W_IN1), MA, OD_INP, D}; pg8::StaticOrder S; S.init(MA, OD_INP, F.G, bid);
        pg8::EpiSplit E{(bf16*)(ws + WS_QK), 1024, (bf16*)(ws + WS_VR), VRLD, 4, 0x7fffffff};
        pg8::gemm_phase<pg8::EpiSplit, pg8::StaticOrder, ALIGN, SP2>(F.lds + RING_OFF, g, S, E);
        tail_convert(F, args, (MA / 256) * (OD_INP / 256), MW4, MW5); } SEAM(12);
    if (IN(13)) {
#ifndef NO_GLA
 gla_prep_phase(F, args);
#endif
    } SEAM(13);
    if (IN(14)) {
#ifndef NO_GLA
 gla_chain_phase(F, args);
#endif
    } SEAM(14);
    if (IN(15)) { gla_finish(F, args); } SEAM(15);
    if (IN(16)) { pg8::Gemm g{(const bf16*)(ws + WS_OF), (const bf16*)(ws + WS_W_OUT1), ML, D, D}; pg8::StaticOrder S; S.init(ML, D, F.G, bid);
        pg8::EpiPlain E{(bf16*)(ws + WS_YL1), D, 0, 0, 1.0f};
        pg8::gemm_phase<pg8::EpiPlain, pg8::StaticOrder, ALIGN, SP2>(F.lds + RING_OFF, g, S, E); } SEAM(16);
    if (IN(17)) { thin_t4(F, args); } SEAM(17);
    if (lo < 20 && hi > 18) {
        int ts[9]; moe_tile_starts(F, ts); const int NT = ts[8];
        if (IN(18)) { pg8::MoeOrder S{0, NT, 2 * FE / 256, F.G, bid, ts[1], ts[2], ts[3], ts[4], ts[5], ts[6], ts[7], 0};
            moe_row_table(F, args, S, ts);
            pg8::Gemm g{(const bf16*)(ws + WS_XLM), (const bf16*)(ws + WS_W_MGU), ML, 2 * FE, D / 2, (const LAS unsigned short*)(F.lds + ATAB_OFF)};
            pg8::EpiSwiGlu8 E{ws + WS_ACTM, FE, 2 * FE / 256, 1.0f / (FP8_SA * FP8_SW), FP8_SACT, 1};
            pg8::gemm_phase<pg8::EpiSwiGlu8, pg8::MoeOrder, ALIGN, SP2, true, false, false, true>(F.lds + RING_OFF, g, S, E); } SEAM(18);
        if (IN(19)) { pg8::Gemm g{(const bf16*)(ws + WS_ACTM), (const bf16*)(ws + WS_W_MDN), MOE_MAXT * 256, D, FE / 2};
            pg8::MoeOrder S{0, NT, D / 256, F.G, bid, ts[1], ts[2], ts[3], ts[4], ts[5], ts[6], ts[7], 1};
            pg8::EpiPlain E{(bf16*)(ws + WS_Y), D, 0, D / 256, 1.0f / (FP8_SACT * FP8_SW)};
            pg8::gemm_phase<pg8::EpiPlain, pg8::MoeOrder, ALIGN, SP2, true, true>(F.lds + RING_OFF, g, S, E); } SEAM(19);
    }
    if (IN(20)) { thin_t5(F, args); }
#ifdef PROBE_SETA
    PROBE_STAMP(20);
    if (blockIdx.x == PROBE_BLK && F.tid == 0) {
        unsigned long long qa = F.MISC[18] / 100u, qb = F.MISC[20] / 1000u; qa = qa > 999 ? 999 : qa; qb = qb > 99 ? 99 : qb;
        const unsigned long long t0 = __builtin_amdgcn_s_memrealtime(), dl = qa * 1000ull + qb * 1000000ull;
        while (__builtin_amdgcn_s_memrealtime() - t0 < dl) __builtin_amdgcn_s_sleep(32);
    }
#endif
#undef IN
#undef SEAM
}

extern "C" void kernel_launch(void* const* d_in, const int* in_sizes, int n_in, void* d_out, int out_size, void* d_ws, size_t ws_size, hipStream_t stream) {
    static int grid = 0;
    if (grid == 0) {
        if (n_in != 35 || out_size != ML * D || ws_size < WS_END) { fprintf(stderr, "kernel_launch: unexpected shapes: n_in %d out %d ws %zu (need %zu)\n", n_in, out_size, ws_size, (size_t)WS_END); grid = -1; return; }
        int dev = 0, cus = 0, per_cu = 0;
        if (hipGetDevice(&dev) != hipSuccess || hipDeviceGetAttribute(&cus, hipDeviceAttributeMultiprocessorCount, dev) != hipSuccess) { grid = -1; return; }
        if (hipFuncSetAttribute((const void*)fwd_kernel, hipFuncAttributeMaxDynamicSharedMemorySize, LDS_BYTES) != hipSuccess) { fprintf(stderr, "kernel_launch: hipFuncSetAttribute failed\n"); grid = -1; return; }
        if (hipOccupancyMaxActiveBlocksPerMultiprocessor(&per_cu, (const void*)fwd_kernel, NWAVES * 64, LDS_BYTES) != hipSuccess || per_cu < 1) { fprintf(stderr, "kernel_launch: occupancy query reports %d blocks per CU\n", per_cu); }
        (void)hipGetLastError();
        grid = cus;
    }
    if (grid < 0) return;
    (void)hipMemsetAsync((char*)d_ws + WS_CTL, 0, CTL_ZERO_BYTES, stream);
    Args a{};
    for (int i = 0; i < 35; ++i) a.in[i] = (const float*)d_in[i];
    a.out = (float*)d_out; a.ws = (unsigned char*)d_ws;
#if MK_ONE_LAUNCH
    a.ph_lo = 0; a.ph_hi = NPHASE;
    hipLaunchKernelGGL(fwd_kernel, dim3(grid), dim3(NWAVES * 64), LDS_BYTES, stream, a);
#else
    for (int p = 0; p < NPHASE; ++p) { a.ph_lo = p; a.ph_hi = p + 1; hipLaunchKernelGGL(fwd_kernel, dim3(grid), dim3(NWAVES * 64), LDS_BYTES, stream, a); }
#endif
}
```

```cpp
#include <hip/hip_runtime.h>
#include <cstdio>
#include <cstdint>
#define MK_ONE_LAUNCH 1
namespace pg8 {
#define PG8_LAS __attribute__((address_space(3)))
typedef unsigned short bf16_t;
typedef short bf16x8 __attribute__((ext_vector_type(8)));
typedef float f32x4 __attribute__((ext_vector_type(4)));
typedef unsigned u32x4 __attribute__((ext_vector_type(4)));
constexpr int BM = 256, BK = 64, HALF = 128, HTB = HALF * BK * 2  , STAGE_BYTES = 8 * HTB, NXCD = 8, WGM = 8;

__host__ __device__ __forceinline__ int lds_byte(int r, int c) { const int st = (r >> 4) * 2 + (c >> 5), rr = r & 15, cc = c & 31, ob = rr * 64 + cc * 2; return st * 1024 + (ob ^ (((ob >> 9) & 1) << 5)); }
__host__ __device__ __forceinline__ void stage_rc(int b, int& R, int& C) { const int st = b / 1024, sb = b % 1024, swz = sb ^ (((sb >> 9) & 1) << 5); R = (st >> 1) * 16 + swz / 64; C = (st & 1) * 32 + (swz % 64) / 2; }
__host__ __device__ __forceinline__ int perm32(int rho) { const int n = rho >> 4, i = rho & 15; return 8 * (i >> 2) + 4 * n + (i & 3); }

struct Unit { int pm, pn; };
struct Gemm { const bf16_t* A; const bf16_t* Bt; int M, N, K; const PG8_LAS unsigned short* atab = nullptr; };
constexpr unsigned ACH_GS = 2304u * 256u * 2u;

struct StaticOrder {
    int nM, nN, nwg, G, c;
    __host__ __device__ void init(int M, int N, int G_, int c_) { nM = M / BM; nN = N / BM; nwg = nM * nN; G = G_; c = c_; }
    __host__ __device__ bool next(int i, Unit& u) const {
        const long L = (long)i * G + c; if (L >= nwg) return false;
        int wgid = (int)L; { const int q = nwg / NXCD, r = nwg % NXCD, xcd = wgid % NXCD, off = wgid / NXCD; wgid = (xcd < r ? xcd * (q + 1) : r * (q + 1) + (xcd - r) * q) + off; }
        const int nig = WGM * nN, gid = wgid / nig, fm = gid * WGM, gsz = (nM - fm) < WGM ? (nM - fm) : WGM;
        u.pm = fm + ((wgid % nig) % gsz); u.pn = (wgid % nig) / gsz; return true;
    }
    __device__ __forceinline__ void a_ready(const Unit&) const {}
    __device__ __forceinline__ void done(const Unit&) const {}
};

__device__ __forceinline__ unsigned cvt_pk_bf16(float lo, float hi) { unsigned r; asm volatile("v_cvt_pk_bf16_f32 %0, %1, %2" : "=v"(r) : "v"(lo), "v"(hi)); return r; }
typedef float f32x2 __attribute__((ext_vector_type(2)));
__device__ __forceinline__ u32x4 pack8(const f32x4 v0, const f32x4 v1) { u32x4 w; w.x = cvt_pk_bf16(v0[0], v0[1]); w.y = cvt_pk_bf16(v0[2], v0[3]); w.z = cvt_pk_bf16(v1[0], v1[1]); w.w = cvt_pk_bf16(v1[2], v1[3]); return w; }
__device__ __forceinline__ float bf_lo(unsigned u) { return __uint_as_float(u << 16); }
__device__ __forceinline__ float bf_hi(unsigned u) { return __uint_as_float(u & 0xffff0000u); }
__device__ __forceinline__ unsigned pk4_fp8(float a, float b, float c, float d) {
    a = __builtin_amdgcn_fmed3f(a, -448.f, 448.f); b = __builtin_amdgcn_fmed3f(b, -448.f, 448.f); c = __builtin_amdgcn_fmed3f(c, -448.f, 448.f); d = __builtin_amdgcn_fmed3f(d, -448.f, 448.f);
    int r = __builtin_amdgcn_cvt_pk_fp8_f32(a, b, 0, false); r = __builtin_amdgcn_cvt_pk_fp8_f32(c, d, r, true); return (unsigned)r; }
__device__ __forceinline__ float sigmoid_f(float x) { return __builtin_amdgcn_rcpf(1.0f + __builtin_amdgcn_exp2f(-1.4426950408889634f * x)); }

struct EpiPlain {
    static constexpr bool PERM = true, AFTER_DRAIN = false;
    bf16_t* O; int ldc; int pm_off; int nmod; float sc;
    __device__ __forceinline__ void operator()(const f32x4 (&acc)[2][2][4][2], const Unit& u, int wr, int wc, int fr, int fq) const {
        const int row0 = (u.pm - pm_off) * BM + wr * 64 + fr; const int ct = nmod ? (u.pn % nmod) : u.pn; const int col0 = ct * BM + wc * 32 + 8 * fq;
#pragma unroll
        for (int ai = 0; ai < 2; ++ai)
#pragma unroll
            for (int m = 0; m < 4; ++m) { bf16_t* rowp = O + (size_t)(row0 + ai * HALF + m * 16) * ldc + col0;
#pragma unroll
                for (int bj = 0; bj < 2; ++bj) *(u32x4*)(rowp + bj * HALF) = pack8(acc[ai][bj][m][0] * sc, acc[ai][bj][m][1] * sc); }
    }
};
struct EpiSplit {
    static constexpr bool PERM = true, AFTER_DRAIN = false;
    bf16_t* O0; int ld0; bf16_t* O1; int ld1; int nsplit; int ncols1;
    __device__ __forceinline__ void operator()(const f32x4 (&acc)[2][2][4][2], const Unit& u, int wr, int wc, int fr, int fq) const {
        const int row0 = u.pm * BM + wr * 64 + fr; const bool first = u.pn < nsplit;
        bf16_t* base = first ? O0 : O1; const int ld = first ? ld0 : ld1; const int col0 = (first ? u.pn : u.pn - nsplit) * BM + wc * 32 + 8 * fq; const int lim = first ? 0x7fffffff : ncols1;
#pragma unroll
        for (int ai = 0; ai < 2; ++ai)
#pragma unroll
            for (int m = 0; m < 4; ++m) { bf16_t* rowp = base + (size_t)(row0 + ai * HALF + m * 16) * ld + col0;
#pragma unroll
                for (int bj = 0; bj < 2; ++bj) if (col0 + bj * HALF < lim) *(u32x4*)(rowp + bj * HALF) = pack8(acc[ai][bj][m][0], acc[ai][bj][m][1]); }
    }
};
struct EpiGlu {
    static constexpr bool PERM = true, AFTER_DRAIN = false;
    const bf16_t* Aa; const float* bias; bf16_t* O; int ldc;
    __device__ __forceinline__ void operator()(const f32x4 (&acc)[2][2][4][2], const Unit& u, int wr, int wc, int fr, int fq) const {
        const int row0 = u.pm * BM + wr * 64 + fr; const int col0 = u.pn * BM + wc * 32 + 8 * fq;
        const int crow0 = (u.pm < 128 ? (u.pm >> 3) * 144 + 16 + (u.pm & 7) * 16 : (u.pm - 128) * 144) + wr * 4;
#pragma unroll
        for (int bj = 0; bj < 2; ++bj) { const f32x4 b0 = *(const f32x4*)(bias + col0 + bj * HALF), b1 = *(const f32x4*)(bias + col0 + bj * HALF + 4);
            const int cg = (col0 + bj * HALF) >> 4, ch = (col0 + bj * HALF) & 15;
#pragma unroll
            for (int ai = 0; ai < 2; ++ai)
#pragma unroll
                for (int m = 0; m < 4; ++m) { const size_t r = (size_t)(row0 + ai * HALF + m * 16);
                    const u32x4 a8 = *(const u32x4*)(Aa + (size_t)cg * (2304 * 256) + (size_t)(crow0 + ai * 8 + m) * 256 + fr * 16 + ch);
                    f32x4 v0 = acc[ai][bj][m][0] + b0, v1 = acc[ai][bj][m][1] + b1;
                    v0[0] = bf_lo(a8.x) * sigmoid_f(v0[0]); v0[1] = bf_hi(a8.x) * sigmoid_f(v0[1]); v0[2] = bf_lo(a8.y) * sigmoid_f(v0[2]); v0[3] = bf_hi(a8.y) * sigmoid_f(v0[3]);
                    v1[0] = bf_lo(a8.z) * sigmoid_f(v1[0]); v1[1] = bf_hi(a8.z) * sigmoid_f(v1[1]); v1[2] = bf_lo(a8.w) * sigmoid_f(v1[2]); v1[3] = bf_hi(a8.w) * sigmoid_f(v1[3]);
                    *(u32x4*)(O + r * ldc + col0 + bj * HALF) = pack8(v0, v1); } }
    }
};
struct EpiSwiGlu {
    static constexpr bool PERM = true, AFTER_DRAIN = false;
    bf16_t* O; int ldc; int pm_off; int nmod;
    __device__ __forceinline__ void operator()(const f32x4 (&acc)[2][2][4][2], const Unit& u, int wr, int wc, int fr, int fq) const {
        const int row0 = (u.pm - pm_off) * BM + wr * 64 + fr; const int ct = nmod ? (u.pn % nmod) : u.pn; const int col0 = ct * HALF + wc * 32 + 8 * fq;
#pragma unroll
        for (int ai = 0; ai < 2; ++ai)
#pragma unroll
            for (int m = 0; m < 4; ++m) { f32x4 o0, o1;
#pragma unroll
                for (int i = 0; i < 4; ++i) { const float g0 = acc[ai][0][m][0][i], g1 = acc[ai][0][m][1][i]; o0[i] = g0 * sigmoid_f(g0) * acc[ai][1][m][0][i]; o1[i] = g1 * sigmoid_f(g1) * acc[ai][1][m][1][i]; }
                *(u32x4*)(O + (size_t)(row0 + ai * HALF + m * 16) * ldc + col0) = pack8(o0, o1); }
    }
};
struct EpiIn0 {
    static constexpr bool PERM = true, AFTER_DRAIN = false;
    bf16_t* U; bf16_t* A3; bf16_t* Z0c;
    __device__ __forceinline__ void operator()(const f32x4 (&acc)[2][2][4][2], const Unit& u, int wr, int wc, int fr, int fq) const {
        if (u.pn >= 2) {
            const int row0 = u.pm * BM + wr * 64 + fr, col0 = (u.pn - 2) * BM + wc * 32 + 8 * fq;
#pragma unroll
            for (int ai = 0; ai < 2; ++ai)
#pragma unroll
                for (int m = 0; m < 4; ++m) { bf16_t* rowp = Z0c + (size_t)(row0 + ai * HALF + m * 16) * 512 + col0;
#pragma unroll
                    for (int bj = 0; bj < 2; ++bj) *(u32x4*)(rowp + bj * HALF) = pack8(acc[ai][bj][m][0], acc[ai][bj][m][1]); }
        } else {
            const int b = (u.pm < 128) ? (u.pm >> 3) : (u.pm - 128); const int c0 = (u.pm < 128) ? (16 + (u.pm & 7) * 16) : 0;
            const int g0 = u.pn * 16 + wc * 2 + (fq >> 1);
            const size_t r0 = (size_t)(g0 * 16 + b) * 144 + c0 + wr * 4;
            const int cc = fr * 16 + 8 * (fq & 1);
#pragma unroll
            for (int ai = 0; ai < 2; ++ai)
#pragma unroll
                for (int m = 0; m < 4; ++m)
#pragma unroll
                    for (int bj = 0; bj < 2; ++bj) { const size_t r = r0 + (size_t)bj * (8 * 16 * 144) + ai * 8 + m; const u32x4 w = pack8(acc[ai][bj][m][0], acc[ai][bj][m][1]);
                        *(u32x4*)(U + r * 256 + cc) = w; *(u32x4*)(A3 + r * 512 + cc) = w; }
        }
    }
};
struct EpiF32 {
    static constexpr bool PERM = false, AFTER_DRAIN = false;
    float* C; int ldc;
    __device__ __forceinline__ void operator()(const f32x4 (&acc)[2][2][4][2], const Unit& u, int wr, int wc, int fr, int fq) const {
        const int row0 = u.pm * BM + wr * 64 + fr, col0 = wc * 32 + 4 * fq;
#pragma unroll
        for (int ai = 0; ai < 2; ++ai)
#pragma unroll
            for (int m = 0; m < 4; ++m) { float* rowp = C + (size_t)(row0 + ai * HALF + m * 16) * ldc + col0;
#pragma unroll
                for (int bj = 0; bj < 2; ++bj)
#pragma unroll
                    for (int n = 0; n < 2; ++n) *(f32x4*)(rowp + bj * HALF + n * 16) = acc[ai][bj][m][n]; }
    }
};
__device__ __forceinline__ float gelu_tanh_f(float x) { const float t = 0.7978845608028654f * (x + 0.044715f * x * x * x); const float e = __builtin_amdgcn_exp2f(2.8853900817779268f * t); return x - x * __builtin_amdgcn_rcpf(e + 1.0f); }
struct EpiS5Out {
    static constexpr bool PERM = true, AFTER_DRAIN = false;
    bf16_t* AG;
    __device__ __forceinline__ void operator()(const f32x4 (&acc)[2][2][4][2], const Unit& u, int wr, int wc, int fr, int fq) const {
        const int row0 = u.pm * BM + wr * 64 + fr, col0 = wc * 32 + 8 * fq;
#pragma unroll
        for (int ai = 0; ai < 2; ++ai)
#pragma unroll
            for (int m = 0; m < 4; ++m) { bf16_t* rowp = AG + (size_t)(row0 + ai * HALF + m * 16) * 256 + col0;
#pragma unroll
                for (int bj = 0; bj < 2; ++bj) { f32x4 v0 = acc[ai][bj][m][0], v1 = acc[ai][bj][m][1];
#pragma unroll
                    for (int i = 0; i < 4; ++i) { v0[i] = gelu_tanh_f(v0[i]); v1[i] = gelu_tanh_f(v1[i]); }
                    *(u32x4*)(rowp + bj * HALF) = pack8(v0, v1); } }
    }
};
struct S5Order {
    int G, c;
    __device__ __forceinline__ bool next(int i, Unit& u) const { const int L = i * G + c; if (L >= 32 * 9) return false; u.pm = L; u.pn = L / 9; return true; }
    __device__ __forceinline__ void a_ready(const Unit&) const {}
    __device__ __forceinline__ void done(const Unit&) const {}
};
struct EpiSwiGlu8 {
    static constexpr bool PERM = true, AFTER_DRAIN = false;
    unsigned char* O; int ldc; int nmod; float us, os; int tiled;
    __device__ __forceinline__ void operator()(const f32x4 (&acc)[2][2][4][2], const Unit& u, int wr, int wc, int fr, int fq) const {
        const int row0 = u.pm * BM + wr * 64 + fr; const int ct = nmod ? (u.pn % nmod) : u.pn; const int col0 = ct * HALF + wc * 32 + 8 * fq;
        typedef unsigned u32x2_ __attribute__((ext_vector_type(2)));
#pragma unroll
        for (int ai = 0; ai < 2; ++ai)
#pragma unroll
            for (int m = 0; m < 4; ++m) { f32x4 o0, o1;
#pragma unroll
                for (int i = 0; i < 4; ++i) { const float g0 = acc[ai][0][m][0][i] * us, g1 = acc[ai][0][m][1][i] * us; o0[i] = g0 * sigmoid_f(g0) * (acc[ai][1][m][0][i] * us) * os; o1[i] = g1 * sigmoid_f(g1) * (acc[ai][1][m][1][i] * us) * os; }
                u32x2_ w; w.x = pk4_fp8(o0[0], o0[1], o0[2], o0[3]); w.y = pk4_fp8(o1[0], o1[1], o1[2], o1[3]);
                const int rr = wr * 64 + fr + ai * HALF + m * 16;
                if (tiled) *(u32x2_*)(O + (size_t)u.pm * BM * ldc + (size_t)ct * (BM * 128) + rr * 128 + wc * 32 + 8 * fq) = w;
                else *(u32x2_*)(O + (size_t)(row0 + ai * HALF + m * 16) * ldc + col0) = w; }
    }
};
struct MoeOrder {
    int t0, nT, nN, G, c; int e1, e2, e3, e4, e5, e6, e7; int rev;
    __device__ __forceinline__ bool next(int i, Unit& u) const {
        const int nwg = nT * nN; const long L = (long)i * G + c; if (L >= nwg) return false;
        int wgid = (int)L; { const int q = nwg / NXCD, r = nwg % NXCD, xcd = wgid % NXCD, off = wgid / NXCD, sz = xcd < r ? q + 1 : q; wgid = (xcd < r ? xcd * (q + 1) : r * (q + 1) + (xcd - r) * q) + (rev ? sz - 1 - off : off); }
        const int nig = WGM * nN, gid = wgid / nig, fm = gid * WGM, gsz = (nT - fm) < WGM ? (nT - fm) : WGM;
        const int pm = t0 + fm + ((wgid % nig) % gsz), pn = (wgid % nig) / gsz;
        const int e = (pm >= e1) + (pm >= e2) + (pm >= e3) + (pm >= e4) + (pm >= e5) + (pm >= e6) + (pm >= e7);
        u.pm = pm; u.pn = e * nN + pn; return true;
    }
    __device__ __forceinline__ void a_ready(const Unit&) const {}
    __device__ __forceinline__ void done(const Unit&) const {}
};
template <class Epi, class Sched, bool ALIGN_EPI = false, bool SP2 = false, bool FP8 = false, bool TILED = false, bool ACHUNK = false, bool AGATHER = false>
__device__ __forceinline__ void gemm_phase(PG8_LAS unsigned char* lds, const Gemm g, const Sched& S, const Epi& E) {
    const int tid = threadIdx.x, wid = __builtin_amdgcn_readfirstlane(tid >> 6), lane = tid & 63, wr = wid >> 2, wc = wid & 3, fr = lane & 15, fq = lane >> 4;
    const int K = g.K, nt = K / BK;
    unsigned voffA[2], voffB[2];
#pragma unroll
    for (int i = 0; i < 2; ++i) { int R, C; stage_rc(tid * 16 + i * 8192, R, C); const int Rb = Epi::PERM ? ((R & ~31) + perm32(R & 31)) : R;
        voffA[i] = TILED ? (unsigned)(R * BK + C) * 2u : (unsigned)(R * K + C) * 2u; voffB[i] = TILED ? (unsigned)(Rb * BK + C) * 2u : (unsigned)(Rb * K + C) * 2u;
        if (ACHUNK) voffA[i] = (unsigned)((R >> 4) * 512 + (R & 15) * 32 + (C & 15) * 2) + (unsigned)(C >> 4) * ACH_GS; }
    const size_t kstep = TILED ? (size_t)(BM * BK * 2) : (size_t)(BK * 2);
    const size_t hstep = TILED ? (size_t)(HALF * BK * 2) : (size_t)HALF * K * 2;
    const size_t tstep = (size_t)BM * K * 2;
    const size_t kstepA = ACHUNK ? (size_t)4 * ACH_GS : kstep, hstepA = ACHUNK ? (size_t)4096 : hstep;
#define PG8_ABASE(pm_) (AGATHER ? (const char*)g.A : ACHUNK ? (const char*)g.A + (size_t)((pm_) < 128 ? ((pm_) >> 3) * 144 + 16 + ((pm_) & 7) * 16 : ((pm_) - 128) * 144) * 512 : (const char*)g.A + (size_t)(pm_) * tstep)
    const unsigned ldsw = (unsigned)wid * 1024u;
    const int aoff = lds_byte(wr * 64 + fr, fq * 8), boff = lds_byte(wc * 32 + fr, fq * 8);
#define PG8_SA(b, h) (((b) * 2 + (h)) * HTB)
#define PG8_SB(b, h) ((4 + (b) * 2 + (h)) * HTB)
#define PG8_STAGE(bufoff, gbase, voff) do { _Pragma("unroll") for (int _i = 0; _i < 2; ++_i) \
        __builtin_amdgcn_global_load_lds((const unsigned*)((const char*)(gbase) + (voff)[_i]), (PG8_LAS unsigned*)(lds + (bufoff) + ldsw + _i * 8192), 16, 0, 0); } while (0)
    static_assert(!AGATHER || SP2, "AGATHER is written for the SP2 loop");
    unsigned gvA0[2] = {0u, 0u}, gvA1[2] = {0u, 0u}, gnA0[2] = {0u, 0u}, gnA1[2] = {0u, 0u};
#define PG8_GLOAD(uidx, v0, v1) do { _Pragma("unroll") for (int i_ = 0; i_ < 2; ++i_) { int R_, C_; stage_rc(tid * 16 + i_ * 8192, R_, C_); \
        const unsigned t0_ = g.atab[(uidx) * 256 + R_], t1_ = g.atab[(uidx) * 256 + 128 + R_]; v0[i_] = t0_ * (unsigned)(2 * K) + (unsigned)C_ * 2u; v1[i_] = t1_ * (unsigned)(2 * K) + (unsigned)C_ * 2u; } } while (0)
#define PG8_STAGE_A(bufoff, gbase, half, nx) do { if constexpr (AGATHER) { unsigned vs_[2]; \
        vs_[0] = (nx) ? ((half) ? gnA1[0] : gnA0[0]) : ((half) ? gvA1[0] : gvA0[0]); vs_[1] = (nx) ? ((half) ? gnA1[1] : gnA0[1]) : ((half) ? gvA1[1] : gvA0[1]); PG8_STAGE(bufoff, gbase, vs_); } \
        else PG8_STAGE(bufoff, (gbase) + ((half) ? hstepA : (size_t)0), voffA); } while (0)
#define PG8_LDA(dst, b, h) do { _Pragma("unroll") for (int m = 0; m < 4; ++m) _Pragma("unroll") for (int k = 0; k < 2; ++k) dst[m][k] = *(const PG8_LAS bf16x8*)(lds + PG8_SA(b, h) + aoff + m * 2048 + k * 1024); } while (0)
#define PG8_LDB(dst, b, h) do { _Pragma("unroll") for (int n = 0; n < 2; ++n) _Pragma("unroll") for (int k = 0; k < 2; ++k) dst[n][k] = *(const PG8_LAS bf16x8*)(lds + PG8_SB(b, h) + boff + n * 2048 + k * 1024); } while (0)
#define PG8_MMA(ai, bj, At, Bt) do { __builtin_amdgcn_s_setprio(1); _Pragma("unroll") for (int m = 0; m < 4; ++m) _Pragma("unroll") for (int n = 0; n < 2; ++n) { \
        if constexpr (FP8) { typedef int i32x4_ __attribute__((ext_vector_type(4))); typedef int i32x8_ __attribute__((ext_vector_type(8))); \
            const i32x8_ bo_ = __builtin_shufflevector(__builtin_bit_cast(i32x4_, Bt[n][0]), __builtin_bit_cast(i32x4_, Bt[n][1]), 0, 1, 2, 3, 4, 5, 6, 7); \
            const i32x8_ ao_ = __builtin_shufflevector(__builtin_bit_cast(i32x4_, At[m][0]), __builtin_bit_cast(i32x4_, At[m][1]), 0, 1, 2, 3, 4, 5, 6, 7); \
            asm volatile("v_mfma_scale_f32_16x16x128_f8f6f4 %0, %1, %2, %0, %3, %3 op_sel_hi:[0,0,0]" : "+v"(acc[ai][bj][m][n]) : "v"(bo_), "v"(ao_), "v"(fp8_unit_scale_)); } \
        else { _Pragma("unroll") for (int k = 0; k < 2; ++k) acc[ai][bj][m][n] = __builtin_amdgcn_mfma_f32_16x16x32_bf16(Bt[n][k], At[m][k], acc[ai][bj][m][n], 0, 0, 0); } } \
        __builtin_amdgcn_s_setprio(0); } while (0)
#define PG8_WAIT_V(n) asm volatile("s_waitcnt vmcnt(" #n ")" ::: "memory")
#define PG8_WAIT_L(n) asm volatile("s_waitcnt lgkmcnt(" #n ")" ::: "memory")
#define PG8_BAR __builtin_amdgcn_s_barrier()
#define PG8_SCHED __builtin_amdgcn_sched_barrier(0)
    const int fp8_unit_scale_ = 0x7f7f7f7f; (void)fp8_unit_scale_;
    Unit cur, nxt; int ui = 0;
    if (!S.next(0, cur)) return;
    f32x4 acc[2][2][4][2];
#pragma unroll
    for (int a = 0; a < 2; ++a)
#pragma unroll
        for (int b = 0; b < 2; ++b)
#pragma unroll
            for (int m = 0; m < 4; ++m)
#pragma unroll
                for (int n = 0; n < 2; ++n) acc[a][b][m][n] = (f32x4){0.f, 0.f, 0.f, 0.f};
    bf16x8 At[4][2], B0[2][2], B1[2][2];
    const char* cA = PG8_ABASE(cur.pm); const char* cB = (const char*)g.Bt + (size_t)cur.pn * tstep;
    if constexpr (AGATHER) PG8_GLOAD(0, gvA0, gvA1);
    S.a_ready(cur);
    if constexpr (SP2) {
        PG8_STAGE(PG8_SB(0, 0), cB, voffB); PG8_STAGE(PG8_SB(0, 1), cB + hstep, voffB); PG8_STAGE_A(PG8_SA(0, 0), cA, 0, false); PG8_STAGE_A(PG8_SA(0, 1), cA, 1, false);
        if (wr == 1) PG8_BAR;
        PG8_WAIT_V(2); PG8_BAR;
        PG8_STAGE(PG8_SB(1, 0), cB + kstep, voffB); PG8_STAGE_A(PG8_SA(1, 0), cA + kstepA, 0, false); PG8_STAGE(PG8_SB(1, 1), cB + hstep + kstep, voffB);
        PG8_WAIT_V(6); PG8_BAR;
    } else {
        PG8_STAGE(PG8_SB(0, 0), cB, voffB); PG8_STAGE(PG8_SA(0, 0), cA, voffA); PG8_STAGE(PG8_SB(0, 1), cB + hstep, voffB); PG8_STAGE(PG8_SA(0, 1), cA + hstepA, voffA);
        if (wr == 1) PG8_BAR;
        PG8_WAIT_V(4); PG8_BAR;
        PG8_STAGE(PG8_SB(1, 0), cB + kstep, voffB); PG8_STAGE(PG8_SA(1, 0), cA + kstepA, voffA); PG8_STAGE(PG8_SB(1, 1), cB + hstep + kstep, voffB);
        PG8_WAIT_V(6); PG8_BAR;
    }
    for (;;) {
        const bool has_next = S.next(ui + 1, nxt);
        const char* nA = has_next ? PG8_ABASE(nxt.pm) : cA; const char* nB = has_next ? (const char*)g.Bt + (size_t)nxt.pn * tstep : cB;
        for (int t = 0; t < nt; t += 2) {
            const bool last = (t == nt - 2);
            const char* a1 = cA + (size_t)(t + 1) * kstepA;
            const char* a2 = last ? nA : cA + (size_t)(t + 2) * kstepA; const char* b2 = last ? nB : cB + (size_t)(t + 2) * kstep;
            const char* a3 = a2 + kstepA; const char* b3 = b2 + kstep;
            if (last && has_next) S.a_ready(nxt);
            const bool nx_ = last && has_next;
            if constexpr (AGATHER) { if (nx_) PG8_GLOAD(ui + 1, gnA0, gnA1); }
            if constexpr (SP2) {
            PG8_LDB(B0, 0, 0); PG8_LDB(B1, 0, 1); PG8_SCHED; PG8_LDA(At, 0, 0); PG8_STAGE_A(PG8_SA(1, 1), a1, 1, false);
            PG8_WAIT_V(8); PG8_WAIT_L(0); PG8_BAR; PG8_MMA(0, 0, At, B0); PG8_MMA(0, 1, At, B1); PG8_BAR; PG8_SCHED;
            PG8_LDA(At, 0, 1); PG8_STAGE(PG8_SB(0, 0), b2, voffB); PG8_STAGE(PG8_SB(0, 1), b2 + hstep, voffB); PG8_STAGE_A(PG8_SA(0, 0), a2, 0, nx_);
            PG8_WAIT_V(8); PG8_WAIT_L(0); PG8_BAR; PG8_MMA(1, 0, At, B0); PG8_MMA(1, 1, At, B1); PG8_BAR; PG8_SCHED;
            PG8_LDB(B0, 1, 0); PG8_LDB(B1, 1, 1); PG8_SCHED; PG8_LDA(At, 1, 0); PG8_STAGE_A(PG8_SA(0, 1), a2, 1, nx_);
            PG8_WAIT_V(8); PG8_WAIT_L(0); PG8_BAR; PG8_MMA(0, 0, At, B0); PG8_MMA(0, 1, At, B1); PG8_BAR; PG8_SCHED;
            PG8_LDA(At, 1, 1); PG8_STAGE(PG8_SB(1, 0), b3, voffB); PG8_STAGE(PG8_SB(1, 1), b3 + hstep, voffB); PG8_STAGE_A(PG8_SA(1, 0), a3, 0, nx_);
            PG8_WAIT_V(8); PG8_WAIT_L(0); PG8_BAR; PG8_MMA(1, 0, At, B0); PG8_MMA(1, 1, At, B1); PG8_BAR; PG8_SCHED;
            } else {
            PG8_LDB(B0, 0, 0); PG8_SCHED; PG8_LDA(At, 0, 0); PG8_STAGE(PG8_SA(1, 1), a1 + hstepA, voffA);
            PG8_WAIT_L(8); PG8_BAR; PG8_WAIT_L(0); PG8_MMA(0, 0, At, B0); PG8_BAR; PG8_SCHED;
            PG8_LDB(B1, 0, 1); PG8_STAGE(PG8_SB(0, 0), b2, voffB);
            PG8_BAR; PG8_WAIT_L(0); PG8_MMA(0, 1, At, B1); PG8_BAR;
            PG8_LDA(At, 0, 1); PG8_STAGE(PG8_SA(0, 0), a2, voffA);
            PG8_BAR; PG8_WAIT_L(0); PG8_MMA(1, 0, At, B0); PG8_BAR; PG8_SCHED;
            PG8_STAGE(PG8_SB(0, 1), b2 + hstep, voffB);
            PG8_WAIT_V(6); PG8_BAR; PG8_MMA(1, 1, At, B1); PG8_BAR;
            PG8_LDB(B0, 1, 0); PG8_SCHED; PG8_LDA(At, 1, 0); PG8_STAGE(PG8_SA(0, 1), a2 + hstepA, voffA);
            PG8_WAIT_L(8); PG8_BAR; PG8_WAIT_L(0); PG8_MMA(0, 0, At, B0); PG8_BAR; PG8_SCHED;
            PG8_LDB(B1, 1, 1); PG8_STAGE(PG8_SB(1, 0), b3, voffB);
            PG8_BAR; PG8_WAIT_L(0); PG8_MMA(0, 1, At, B1); PG8_BAR;
            PG8_LDA(At, 1, 1); PG8_STAGE(PG8_SA(1, 0), a3, voffA);
            PG8_BAR; PG8_WAIT_L(0); PG8_MMA(1, 0, At, B0); PG8_BAR; PG8_SCHED;
            PG8_STAGE(PG8_SB(1, 1), b3 + hstep, voffB);
            PG8_WAIT_V(6); PG8_BAR; PG8_MMA(1, 1, At, B1); PG8_BAR;
            }
        }
        if constexpr (ALIGN_EPI) { if (wr == 0) PG8_BAR; }
        if constexpr (FP8) asm volatile("s_nop 15\n\ts_nop 7" ::: "memory");
        if constexpr (!Epi::AFTER_DRAIN) { E(acc, cur, wr, wc, fr, fq); S.done(cur); }
        if (!has_next) break;
#pragma unroll
        for (int a = 0; a < 2; ++a)
#pragma unroll
            for (int b = 0; b < 2; ++b)
#pragma unroll
                for (int m = 0; m < 4; ++m)
#pragma unroll
                    for (int n = 0; n < 2; ++n) acc[a][b][m][n] = (f32x4){0.f, 0.f, 0.f, 0.f};
        cur = nxt; cA = nA; cB = nB; ++ui;
        if constexpr (AGATHER) { gvA0[0] = gnA0[0]; gvA0[1] = gnA0[1]; gvA1[0] = gnA1[0]; gvA1[1] = gnA1[1]; }
        if constexpr (ALIGN_EPI) { if (wr == 1) PG8_BAR; }
    }
    PG8_WAIT_V(0);
    if constexpr (!ALIGN_EPI) { if (wr == 0) PG8_BAR; }
    PG8_BAR;
    if constexpr (Epi::AFTER_DRAIN) { E.fused(acc, cur, wr, wc, fr, fq, lds, wid, lane); S.done(cur); }
#undef PG8_ABASE
#undef PG8_GLOAD
#undef PG8_STAGE_A
#undef PG8_SA
#undef PG8_SB
#undef PG8_STAGE
#undef PG8_LDA
#undef PG8_LDB
#undef PG8_MMA
#undef PG8_WAIT_V
#undef PG8_WAIT_L
#undef PG8_BAR
#undef PG8_SCHED
}
}
#define GAS __attribute__((address_space(1)))
#define LAS __attribute__((address_space(3)))
typedef unsigned short bf16;
typedef unsigned v4u __attribute__((ext_vector_type(4)));
typedef float f32x4 __attribute__((ext_vector_type(4)));
typedef short bf16x8 __attribute__((ext_vector_type(8)));
typedef GAS unsigned gu32;
typedef GAS unsigned long long gu64;
#define RLX_AGENT __ATOMIC_RELAXED, __HIP_MEMORY_SCOPE_AGENT
#define LDS_WAIT() asm volatile("s_waitcnt lgkmcnt(0)" ::: "memory")
#define VM_WAIT() asm volatile("s_waitcnt vmcnt(0)" ::: "memory")
__device__ __forceinline__ unsigned long long rt() { return __builtin_amdgcn_s_memrealtime(); }
__device__ __forceinline__ unsigned f2bf(float f) { unsigned u = __builtin_bit_cast(unsigned, f); return (u + 0x7fffu + ((u >> 16) & 1u)) >> 16; }
__device__ __forceinline__ unsigned pk2(float lo, float hi) { return f2bf(lo) | (f2bf(hi) << 16); }
#define XB_TMO      128
#define XB_XCNT(j)  (256  + 64 * (j))
#define XB_XSUB(j)  (1280 + 64 * (j))
#define XB_XGEN(j)  (2304 + 64 * (j))
#define XB_TOP      3328
#define XB_TOPGEN   3392
#define XCD_BAR_WORDS 3456
#define XB_SPIN_CAP (1u << 18)

__device__ __forceinline__ unsigned xb_ld(unsigned* p)              { return __hip_atomic_load(p, __ATOMIC_RELAXED, __HIP_MEMORY_SCOPE_AGENT); }
__device__ __forceinline__ unsigned xb_add(unsigned* p, unsigned v) { return __hip_atomic_fetch_add(p, v, __ATOMIC_RELAXED, __HIP_MEMORY_SCOPE_AGENT); }
__device__ __forceinline__ unsigned xb_xcc_id() { return (unsigned)__builtin_amdgcn_s_getreg((3 << 11) | 20) & 0xFu; }
#define XB_SPIN(cond, bar) do { unsigned _sp = 0; while (cond) { __builtin_amdgcn_s_sleep(1); \
    if ((++_sp & 255u) == 0u) { if (xb_ld(&(bar)[XB_TMO])) break; if (_sp > XB_SPIN_CAP) { atomicAdd(&(bar)[XB_TMO], 1u); break; } } } } while (0)

struct XcdBarrier {
    unsigned* bar; unsigned x;
    volatile LAS unsigned* st;
};

__device__ __forceinline__ XcdBarrier xcd_barrier_post(unsigned* bar, volatile LAS unsigned* st) {
    XcdBarrier b; b.bar = bar; b.x = xb_xcc_id(); b.st = st;
    if (threadIdx.x == 0) (void)xb_add(&bar[XB_XCNT(b.x)], 1u);
    return b;
}
__device__ __forceinline__ void xcd_barrier_complete(unsigned* bar, unsigned x, unsigned& nloc, unsigned& nx) {
    const unsigned G = gridDim.x * gridDim.y * gridDim.z;
    unsigned sum, cnt, mine, sp = 0u;
    for (;;) {
        sum = 0u; cnt = 0u; mine = 0u;
#pragma unroll
        for (unsigned j = 0; j < 16; ++j) { const unsigned c = xb_ld(&bar[XB_XCNT(j)]); sum += c; cnt += (c > 0u) ? 1u : 0u; mine = (j == x) ? c : mine; }
        if (sum == G) break;
        __builtin_amdgcn_s_sleep(1);
        if ((++sp & 255u) == 0u) { if (xb_ld(&bar[XB_TMO])) break; if (sp > XB_SPIN_CAP) { atomicAdd(&bar[XB_TMO], 1u); break; } }
    }
    nloc = mine > 0u ? mine : 1u; nx = cnt > 0u ? cnt : 1u;
}

__device__ __forceinline__ void xcd_barrier(const XcdBarrier& b) {
    asm volatile("s_waitcnt vmcnt(0)" ::: "memory");
    __syncthreads();
    if (threadIdx.x == 0) {
        unsigned* bar = b.bar;
        __builtin_amdgcn_s_waitcnt(0);
        unsigned nloc = b.st[0], nx = b.st[1];
        if (nloc == 0u) { xcd_barrier_complete(bar, b.x, nloc, nx); b.st[0] = nloc; b.st[1] = nx; }
        const unsigned old = xb_add(&bar[XB_XSUB(b.x)], 1u);
        const unsigned gen = old / nloc;
        if (old + 1u == (gen + 1u) * nloc) {
            __builtin_amdgcn_fence(__ATOMIC_RELEASE, "agent");
            asm volatile("s_waitcnt vmcnt(0)" ::: "memory");
            const unsigned og = xb_add(&bar[XB_TOP], 1u);
            const unsigned tg = og / nx;
            if (og + 1u == (tg + 1u) * nx) xb_add(&bar[XB_TOPGEN], 1u);
            else XB_SPIN(xb_ld(&bar[XB_TOPGEN]) == tg, bar);
            __builtin_amdgcn_fence(__ATOMIC_ACQUIRE, "agent");
            xb_add(&bar[XB_XGEN(b.x)], 1u);
            asm volatile("s_waitcnt vmcnt(0)" ::: "memory");
        } else {
            XB_SPIN(xb_ld(&bar[XB_XGEN(b.x)]) == gen, bar);
            __builtin_amdgcn_fence(__ATOMIC_ACQUIRE, "agent");
            asm volatile("s_waitcnt vmcnt(0)" ::: "memory");
        }
    }
    __syncthreads();
}

namespace att {
typedef short bf16x8 __attribute__((ext_vector_type(8)));
typedef short s16x4 __attribute__((ext_vector_type(4)));
typedef float f32x16 __attribute__((ext_vector_type(16)));
typedef unsigned u32x4 __attribute__((ext_vector_type(4)));
#define ATT_LAS __attribute__((address_space(3)))
constexpr int QBLK = 32, KVBLK = 64, DQ = 96, DV = 64, LDQ = 768, LDKN = 1024, LDKR = 32, LDV = 1024, LDO = 1024;
typedef const __attribute__((address_space(1))) unsigned short* gcp; typedef __attribute__((address_space(1))) unsigned short* gp;
constexpr float SCALE = 0.10206207261596577f, QSC = SCALE * 1.4426950408889634f, THR2 = 8.f * 1.4426950408889634f;
constexpr int SHM_V = KVBLK * DV * 2, SHM_K = KVBLK * 256, NRING = 4, OFF_K = 0, OFF_V = NRING * SHM_K, OFF_WS = NRING * (SHM_V + SHM_K), ATT_LDS = OFF_WS + 8 * 256;
#define KSWZ(row, colB) ((row) * 256 + ((colB) ^ (((row) & 7) << 4)))
#define SBAR() __builtin_amdgcn_sched_barrier(0)
__device__ __forceinline__ int crow(int r, int hi) { return (r & 3) + 8 * (r >> 2) + 4 * hi; }
__device__ __forceinline__ unsigned cvtpk(float lo, float hi) { unsigned r; asm volatile("v_cvt_pk_bf16_f32 %0, %1, %2" : "=v"(r) : "v"(lo), "v"(hi)); return r; }
template <bool FIRST> __device__ __forceinline__ void partialSM(f32x16& p0, f32x16& p1, f32x16& mC, float& alpha) {
  float pmax = p0[0];
#pragma unroll
  for (int r = 1; r < 16; ++r) pmax = fmaxf(pmax, p0[r]);
#pragma unroll
  for (int r = 0; r < 16; ++r) pmax = fmaxf(pmax, p1[r]);
  { auto rr = __builtin_amdgcn_permlane32_swap(__float_as_uint(pmax), __float_as_uint(pmax), false, false);
    pmax = fmaxf(__uint_as_float(rr[0]), __uint_as_float(rr[1])); }
  if (!FIRST && __builtin_expect(__all(pmax <= THR2), 1)) alpha = 1.f;
  else { const float d = FIRST ? pmax : fmaxf(pmax, 0.f); alpha = __builtin_amdgcn_exp2f(-d);
#pragma unroll
    for (int r = 0; r < 16; ++r) { p0[r] -= d; p1[r] -= d; mC[r] -= d; } }
#pragma unroll
  for (int r = 0; r < 16; ++r) p0[r] = __builtin_amdgcn_exp2f(p0[r]);
}
__device__ __forceinline__ void finishSM(f32x16& p0, f32x16& p1, bf16x8& pa0, bf16x8& pa1, bf16x8& pa2, bf16x8& pa3) {
#pragma unroll
  for (int r = 0; r < 16; ++r) p1[r] = __builtin_amdgcn_exp2f(p1[r]);
#define PK4(P, BASE, OUT) do { u32x4 w = {cvtpk(P[BASE + 0], P[BASE + 1]), cvtpk(P[BASE + 2], P[BASE + 3]), cvtpk(P[BASE + 4], P[BASE + 5]), cvtpk(P[BASE + 6], P[BASE + 7])}; OUT = __builtin_bit_cast(bf16x8, w); } while (0)
  PK4(p0, 0, pa0); PK4(p0, 8, pa1); PK4(p1, 0, pa2); PK4(p1, 8, pa3);
#undef PK4
}
__device__ __forceinline__ void qkt(f32x16& p0, f32x16& p1, const f32x16& mC, const ATT_LAS unsigned char* Ks, const bf16x8* qr, int r32, int hi) {
#pragma unroll
  for (int d0 = 0; d0 < DQ / 16; ++d0) { const int cb = (d0 * 16 + hi * 8) * 2;
    const bf16x8 b0 = *(const ATT_LAS bf16x8*)(Ks + KSWZ(r32, cb));
    const bf16x8 b1 = *(const ATT_LAS bf16x8*)(Ks + KSWZ(32 + r32, cb));
    p0 = __builtin_amdgcn_mfma_f32_32x32x16_bf16(b0, qr[d0], d0 ? p0 : mC, 0, 0, 0);
    p1 = __builtin_amdgcn_mfma_f32_32x32x16_bf16(b1, qr[d0], d0 ? p1 : mC, 0, 0, 0); }
}
__device__ __forceinline__ int v_st(int k, int c) { const int kk = k; return ((kk >> 3) * 2 + (c >> 5)) * 512 + ((kk & 7) * 32 + (c & 31)) * 2; }
__device__ __forceinline__ int v_rd_base(int lane) { return ((lane & 3) << 3) | (((lane >> 2) & 3) << 6) | (((lane >> 4) & 1) << 5) | (((lane >> 5) & 1) << 8); }
constexpr int v_rd_off(int d0, int ks, int half) { return d0 * 512 + ks * 2048 + half * 1024; }
struct KPre { bf16x8 a0, b0, a1, b1; };
#define KLDX(KS, D0, A, B) do { A = *(const ATT_LAS bf16x8*)((KS) + KSWZ(r32, ((D0) * 16 + hi * 8) * 2)); B = *(const ATT_LAS bf16x8*)((KS) + KSWZ(32 + r32, ((D0) * 16 + hi * 8) * 2)); } while (0)
#define VLD(D0, KS_, H) __builtin_amdgcn_ds_read_tr16_b64_v4i16((ATT_LAS s16x4*)(vbp + VO + v_rd_off(D0, KS_, H)))
#define PK(L, H) (bf16x8){L[0], L[1], L[2], L[3], H[0], H[1], H[2], H[3]}
#define MFMA(A, B, C) __builtin_amdgcn_mfma_f32_32x32x16_bf16(A, B, C, 0, 0, 0)
template <int VO> __device__ __forceinline__ void region1(f32x16& n0, f32x16& n1, const f32x16& mC, const ATT_LAS unsigned char* Ks, const bf16x8* qr, int r32, int hi, const KPre& kp,
                                                          f32x16& p0, f32x16& p1, bf16x8& pa0, bf16x8& pa1, bf16x8& pa2, bf16x8& pa3, const ATT_LAS unsigned char* vbp, s16x4* vf) {
  bf16x8 kA[DQ / 16], kB[DQ / 16]; unsigned w[16]; kA[0] = kp.a0; kB[0] = kp.b0; kA[1] = kp.a1; kB[1] = kp.b1;
#define KLD(D0) KLDX(Ks, D0, kA[D0], kB[D0])
#define KMM(D0) do { n0 = MFMA(kA[D0], qr[D0], (D0) ? n0 : mC); n1 = MFMA(kB[D0], qr[D0], (D0) ? n1 : mC); } while (0)
#define EXP1(R) p1[R] = __builtin_amdgcn_exp2f(p1[R])
  KLD(2); KMM(0); EXP1(0); EXP1(1); EXP1(2); EXP1(3); EXP1(4); EXP1(5); w[0] = cvtpk(p0[0], p0[1]); w[1] = cvtpk(p0[2], p0[3]); SBAR();
  KLD(3); KMM(1); EXP1(6); EXP1(7); EXP1(8); EXP1(9); EXP1(10); EXP1(11); w[2] = cvtpk(p0[4], p0[5]); w[3] = cvtpk(p0[6], p0[7]); SBAR();
  KLD(4); KMM(2); EXP1(12); EXP1(13); EXP1(14); EXP1(15); w[4] = cvtpk(p0[8], p0[9]); w[5] = cvtpk(p0[10], p0[11]); w[6] = cvtpk(p0[12], p0[13]); w[7] = cvtpk(p0[14], p0[15]); SBAR();
  KLD(5); KMM(3); w[8] = cvtpk(p1[0], p1[1]); w[9] = cvtpk(p1[2], p1[3]); w[10] = cvtpk(p1[4], p1[5]); w[11] = cvtpk(p1[6], p1[7]); SBAR();
#pragma unroll
  for (int ks = 0; ks < 4; ++ks) { vf[2 * ks] = VLD(0, ks, 0); vf[2 * ks + 1] = VLD(0, ks, 1); }
  KMM(4); w[12] = cvtpk(p1[8], p1[9]); w[13] = cvtpk(p1[10], p1[11]); w[14] = cvtpk(p1[12], p1[13]); w[15] = cvtpk(p1[14], p1[15]); SBAR();
  KMM(5);
#undef KLD
#undef KMM
#undef EXP1
  { const u32x4 a = {w[0], w[1], w[2], w[3]}, b = {w[4], w[5], w[6], w[7]}, c = {w[8], w[9], w[10], w[11]}, d = {w[12], w[13], w[14], w[15]};
    pa0 = __builtin_bit_cast(bf16x8, a); pa1 = __builtin_bit_cast(bf16x8, b); pa2 = __builtin_bit_cast(bf16x8, c); pa3 = __builtin_bit_cast(bf16x8, d); }
}
template <int VO> __device__ __forceinline__ void region2(f32x16* o, const s16x4* vf, const ATT_LAS unsigned char* vbp, bf16x8 pa0, bf16x8 pa1, bf16x8 pa2, bf16x8 pa3, bf16x8 ones,
                                                          f32x16& n0, f32x16& n1, f32x16& mC, float& alpha) {
  s16x4 vg[8];
#pragma unroll
  for (int ks = 0; ks < 4; ++ks) { vg[2 * ks] = VLD(1, ks, 0); vg[2 * ks + 1] = VLD(1, ks, 1); }
#define MX3(A, P, R) A = fmaxf(fmaxf(A, P[R]), P[R + 1])
  o[0] = MFMA(pa0, PK(vf[0], vf[1]), o[0]); o[2] = MFMA(pa0, ones, o[2]); SBAR();
  float ma = fmaxf(n0[0], n0[1]), mb = fmaxf(n1[0], n1[1]);
  o[0] = MFMA(pa1, PK(vf[2], vf[3]), o[0]); o[2] = MFMA(pa1, ones, o[2]); MX3(ma, n0, 2); MX3(mb, n1, 2); MX3(ma, n0, 4); MX3(mb, n1, 4); SBAR();
  o[0] = MFMA(pa2, PK(vf[4], vf[5]), o[0]); o[2] = MFMA(pa2, ones, o[2]); MX3(ma, n0, 6); MX3(mb, n1, 6); MX3(ma, n0, 8); MX3(mb, n1, 8); MX3(ma, n0, 10); MX3(mb, n1, 10); SBAR();
  o[0] = MFMA(pa3, PK(vf[6], vf[7]), o[0]); o[2] = MFMA(pa3, ones, o[2]); MX3(ma, n0, 12); MX3(mb, n1, 12); MX3(ma, n0, 14); MX3(mb, n1, 14);
  float pmax = fmaxf(ma, mb);
  { auto rr = __builtin_amdgcn_permlane32_swap(__float_as_uint(pmax), __float_as_uint(pmax), false, false);
    pmax = fmaxf(__uint_as_float(rr[0]), __uint_as_float(rr[1])); }
  if (__builtin_expect(__all(pmax <= THR2), 1)) alpha = 1.f;
  else { const float d = fmaxf(pmax, 0.f); alpha = __builtin_amdgcn_exp2f(-d);
#pragma unroll
    for (int r = 0; r < 16; ++r) { n0[r] -= d; n1[r] -= d; mC[r] -= d; } }
#define EXP4(R) do { float e0 = __builtin_amdgcn_exp2f(n0[R]), e1 = __builtin_amdgcn_exp2f(n0[R + 1]), e2 = __builtin_amdgcn_exp2f(n0[R + 2]), e3 = __builtin_amdgcn_exp2f(n0[R + 3]); \
    asm volatile("" : "+v"(e0), "+v"(e1), "+v"(e2), "+v"(e3)); n0[R] = e0; n0[R + 1] = e1; n0[R + 2] = e2; n0[R + 3] = e3; } while (0)
  SBAR(); o[1] = MFMA(pa0, PK(vg[0], vg[1]), o[1]); EXP4(0); SBAR();
  o[1] = MFMA(pa1, PK(vg[2], vg[3]), o[1]); EXP4(4); SBAR();
  o[1] = MFMA(pa2, PK(vg[4], vg[5]), o[1]); EXP4(8); SBAR();
  o[1] = MFMA(pa3, PK(vg[6], vg[7]), o[1]); EXP4(12);
#undef EXP4
#undef MX3
}
template <int VO> __device__ __forceinline__ void pv_last(f32x16* o, const ATT_LAS unsigned char* vbp, bf16x8 pa0, bf16x8 pa1, bf16x8 pa2, bf16x8 pa3, bf16x8 ones) {
  s16x4 vf[8], vg[8];
#pragma unroll
  for (int ks = 0; ks < 4; ++ks) { vf[2 * ks] = VLD(0, ks, 0); vf[2 * ks + 1] = VLD(0, ks, 1); vg[2 * ks] = VLD(1, ks, 0); vg[2 * ks + 1] = VLD(1, ks, 1); }
  o[0] = MFMA(pa0, PK(vf[0], vf[1]), o[0]); o[1] = MFMA(pa0, PK(vg[0], vg[1]), o[1]); o[2] = MFMA(pa0, ones, o[2]);
  o[0] = MFMA(pa1, PK(vf[2], vf[3]), o[0]); o[1] = MFMA(pa1, PK(vg[2], vg[3]), o[1]); o[2] = MFMA(pa1, ones, o[2]);
  o[0] = MFMA(pa2, PK(vf[4], vf[5]), o[0]); o[1] = MFMA(pa2, PK(vg[4], vg[5]), o[1]); o[2] = MFMA(pa2, ones, o[2]);
  o[0] = MFMA(pa3, PK(vf[6], vf[7]), o[0]); o[1] = MFMA(pa3, PK(vg[6], vg[7]), o[1]); o[2] = MFMA(pa3, ones, o[2]);
}
#undef VLD
#undef PK
#undef MFMA

__device__ __forceinline__ void attn_unit(const unsigned short* Qb_, const unsigned short* Kn_, const unsigned short* Kr_, const unsigned short* Vc_, int ra, int nt_a, int rb, int NT,
                                          unsigned short* Ob_, ATT_LAS unsigned char* lds, int rope_t0) {
  gcp Qb = (gcp)Qb_, Kn = (gcp)Kn_, Kr = (gcp)Kr_, Vc = (gcp)Vc_; gp Ob = (gp)Ob_;
  const int tid = threadIdx.x, wid = tid >> 6, lane = tid & 63, r32 = lane & 31, hi = lane >> 5;
  ATT_LAS unsigned char* V_lds = lds + OFF_V; ATT_LAS unsigned char* K_lds = lds + OFF_K;
  ATT_LAS float* wsp = (ATT_LAS float*)(lds + OFF_WS) + wid * 64; ATT_LAS float* al_l = wsp + 32;
  f32x16 o[3] = {}, mC = {}; bf16x8 qr[DQ / 16]; const u32x4 ones_w = {0x3f803f80u, 0x3f803f80u, 0x3f803f80u, 0x3f803f80u}; const bf16x8 ones = __builtin_bit_cast(bf16x8, ones_w);
  const int sk = tid >> 3, sc = (tid & 7) * 8, rk = (tid & 255) >> 2, rc = (tid & 3) * 8; const bool rw = tid < 256;
  const int vst = v_st(sk, sc), kst0 = KSWZ(sk, sc * 2), kst1 = KSWZ(rk, (64 + rc) * 2);
  struct SR { bf16x8 vs, k0, k1; };
#define TROW(t) ((t) < nt_a ? ra + (t) * KVBLK : rb + ((t) - nt_a) * KVBLK)
#define SLOADX(S, t) do { const long r0_ = TROW(t); S.vs = *(const __attribute__((address_space(1))) bf16x8*)(Vc + (r0_ + sk) * LDV + sc); S.k0 = *(const __attribute__((address_space(1))) bf16x8*)(Kn + (r0_ + sk) * LDKN + sc); \
    S.k1 = *(const __attribute__((address_space(1))) bf16x8*)(Kr + (r0_ + rk) * LDKR + rc); } while (0)
#define SWRITEX(b, S) do { *(ATT_LAS bf16x8*)(V_lds + (b) * SHM_V + vst) = S.vs; *(ATT_LAS bf16x8*)(K_lds + (b) * SHM_K + kst0) = S.k0; \
    if (rw) *(ATT_LAS bf16x8*)(K_lds + (b) * SHM_K + kst1) = S.k1; } while (0)
  SR s0_, s1_, sr_; SLOADX(s0_, 0); SLOADX(s1_, 1); SLOADX(sr_, 2);
  gcp Qw = Qb + (long)(wid * QBLK + r32) * LDQ + hi * 8;
#pragma unroll
  for (int d0 = 0; d0 < DQ / 16; ++d0) qr[d0] = *(const __attribute__((address_space(1))) bf16x8*)(Qw + d0 * 16);
  if (rope_t0 >= 0) {
    int t = rope_t0 + wid * QBLK + r32; asm volatile("" : "+v"(t));
    const float prow = (float)(t >> 6), pcol = (float)(t & 63);
#pragma unroll
    for (int f = 0; f < 2; ++f) { const u32x4 own = __builtin_bit_cast(u32x4, qr[4 + f]); u32x4 oth;
      oth.x = (unsigned)__shfl_xor((int)own.x, 32); oth.y = (unsigned)__shfl_xor((int)own.y, 32); oth.z = (unsigned)__shfl_xor((int)own.z, 32); oth.w = (unsigned)__shfl_xor((int)own.w, 32);
      const float pos = f ? pcol : prow; float o8[8];
#pragma unroll
      for (int j = 0; j < 8; ++j) { const unsigned wo = (j < 2) ? own.x : (j < 4) ? own.y : (j < 6) ? own.z : own.w, wp = (j < 2) ? oth.x : (j < 4) ? oth.y : (j < 6) ? oth.z : oth.w;
        const float a = (j & 1) ? __uint_as_float(wo & 0xffff0000u) : __uint_as_float(wo << 16), bq = (j & 1) ? __uint_as_float(wp & 0xffff0000u) : __uint_as_float(wp << 16);
        const float ang = pos * __builtin_amdgcn_exp2f(-(float)j * (13.287712379549449f / 8.0f)); float sn, cs; __sincosf(ang, &sn, &cs);
        o8[j] = hi ? (a * cs + bq * sn) : (a * cs - bq * sn); }
      u32x4 w = {cvtpk(o8[0], o8[1]), cvtpk(o8[2], o8[3]), cvtpk(o8[4], o8[5]), cvtpk(o8[6], o8[7])}; qr[4 + f] = __builtin_bit_cast(bf16x8, w); } }
#pragma unroll
  for (int d0 = 0; d0 < DQ / 16; ++d0) { const u32x4 w = __builtin_bit_cast(u32x4, qr[d0]); u32x4 q;
#pragma unroll
    for (int i = 0; i < 4; ++i) q[i] = cvtpk(__uint_as_float(w[i] << 16) * QSC, __uint_as_float(w[i] & 0xffff0000u) * QSC);
    qr[d0] = __builtin_bit_cast(bf16x8, q); }
#define SLOAD(t) SLOADX(sr_, t)
#define SWRITE(b) SWRITEX(b, sr_)
#define SWAIT() asm volatile("s_waitcnt vmcnt(0)" ::: "memory")
#define BAR() asm volatile("s_barrier" ::: "memory")
#define RESC(a) do { if (__any((a) < 1.f)) { if (hi == 0) al_l[r32] = (a); asm volatile("s_waitcnt lgkmcnt(0)" ::: "memory"); \
    _Pragma("unroll") for (int d = 0; d < 3; ++d) _Pragma("unroll") for (int r = 0; r < 16; ++r) o[d][r] *= al_l[crow(r, hi)]; } } while (0)
#define KPRE(KB) do { KLDX(K_lds + (KB) * SHM_K, 0, kp.a0, kp.b0); KLDX(K_lds + (KB) * SHM_K, 1, kp.a1, kp.b1); } while (0)
  f32x16 pA0, pA1, pB0, pB1; float alA, alB; bf16x8 pa0, pa1, pa2, pa3; KPre kp; s16x4 vf[8];
  const ATT_LAS unsigned char* vbp = V_lds + v_rd_base(lane);
  SWAIT(); SWRITEX(0, s0_); SWRITEX(1, s1_); SWRITE(2); SLOAD(3); __syncthreads();
  qkt(pA0, pA1, mC, K_lds, qr, r32, hi); partialSM<true>(pA0, pA1, mC, alA);
  KPRE(1); BAR();
#define STEP(PN0, PN1, ALN, PO0, PO1, KB, VB, T, WR, LD, NX) do { \
    SBAR(); if (WR) { SWAIT(); SWRITE(((KB) + 2) & 3); } if (LD) SLOAD((T) + 3); SBAR(); \
    region1<(VB) * SHM_V>(PN0, PN1, mC, K_lds + (KB) * SHM_K, qr, r32, hi, kp, PO0, PO1, pa0, pa1, pa2, pa3, vbp, vf); SBAR(); \
    region2<(VB) * SHM_V>(o, vf, vbp, pa0, pa1, pa2, pa3, ones, PN0, PN1, mC, ALN); SBAR(); \
    if (NX) KPRE(((KB) + 1) & 3); RESC(ALN); BAR(); } while (0)
  int j = 1;
  for (; j + 3 < NT; j += 4) {
    STEP(pB0, pB1, alB, pA0, pA1, 1, 0, j, true, true, true);
    STEP(pA0, pA1, alA, pB0, pB1, 2, 1, j + 1, true, true, true);
    STEP(pB0, pB1, alB, pA0, pA1, 3, 2, j + 2, true, true, true);
    STEP(pA0, pA1, alA, pB0, pB1, 0, 3, j + 3, true, true, true);
  }
  STEP(pB0, pB1, alB, pA0, pA1, 1, 0, j, true, false, true);
  STEP(pA0, pA1, alA, pB0, pB1, 2, 1, j + 1, false, false, true);
  STEP(pB0, pB1, alB, pA0, pA1, 3, 2, j + 2, false, false, false);
  finishSM(pB0, pB1, pa0, pa1, pa2, pa3); SBAR();
  pv_last<3 * SHM_V>(o, vbp, pa0, pa1, pa2, pa3, ones);
  float rli[16];
#pragma unroll
  for (int r = 0; r < 16; ++r) rli[r] = __builtin_amdgcn_rcpf(o[2][r]);
  gp Ow = Ob + (long)(wid * QBLK) * LDO;
#pragma unroll
  for (int r = 0; r < 16; ++r) { const int orow = crow(r, hi);
#pragma unroll
    for (int d0 = 0; d0 < 2; ++d0) Ow[(long)orow * LDO + d0 * 32 + r32] = (unsigned short)(cvtpk(o[d0][r] * rli[r], 0.f) & 0xffffu); }
  asm volatile("s_waitcnt vmcnt(0)" ::: "memory");
  __syncthreads();
#undef TROW
#undef SLOAD
#undef SWRITE
#undef SLOADX
#undef SWRITEX
#undef STEP
#undef BAR
#undef KPRE
#undef SWAIT
#undef RESC
}
#undef KLDX
#undef KSWZ
#undef SBAR
}

namespace gla {
typedef short bf16x8 __attribute__((ext_vector_type(8)));
typedef short s16x4 __attribute__((ext_vector_type(4)));
typedef float f32x16 __attribute__((ext_vector_type(16)));
typedef float f32x4 __attribute__((ext_vector_type(4)));
typedef float f32x2 __attribute__((ext_vector_type(2)));
typedef __bf16 bf16x2_t __attribute__((ext_vector_type(2)));
typedef unsigned u32x4 __attribute__((ext_vector_type(4)));
typedef unsigned u32x2 __attribute__((ext_vector_type(2)));
#define GLA_LAS __attribute__((address_space(3)))
#define GLA_GAS __attribute__((address_space(1)))
constexpr int RS256 = 272, RS128 = 144;
constexpr int OFF_QT = 0, OFF_KT = 64 * RS256, OFF_KH = 2 * 64 * RS256, OFF_V = OFF_KH + 128 * RS128, OFF_P = OFF_V + 32768, OFF_TOT = OFF_P + 64 * RS128, OFF_EL = OFF_TOT + 2048, OFF_ZG = OFF_EL + 512, OFF_W2 = OFF_ZG + 4096, GLA_LDS = OFF_W2 + 8192;
static_assert(GLA_LDS <= 131072 && OFF_V % 16 == 0 && OFF_P % 16 == 0 && OFF_TOT % 16 == 0, "gla lds map");
__device__ __forceinline__ int swz256(int row, int colB) { return row * RS256 + colB; }
__device__ __forceinline__ int swz128(int row, int colB) { return row * RS128 + colB; }
__device__ __forceinline__ int crow(int r, int hi) { return (r & 3) + 8 * (r >> 2) + 4 * hi; }
__device__ __forceinline__ unsigned pk2f(float lo, float hi) { const f32x2 v = {lo, hi}; return __builtin_bit_cast(unsigned, __builtin_convertvector(v, bf16x2_t)); }
__device__ __forceinline__ unsigned short bf1f(float x) { return (unsigned short)(pk2f(x, 0.f) & 0xffffu); }
__device__ __forceinline__ float bfu(unsigned short u) { return __uint_as_float(((unsigned)u) << 16); }
__device__ __forceinline__ int v_st(int k, int c) { const int kk = (k & ~0xC) | ((k & 4) << 1) | ((k & 8) >> 1); return ((kk >> 3) * 8 + (c >> 5)) * 512 + ((kk & 7) * 32 + (c & 31)) * 2; }
__device__ __forceinline__ int v_rd_base(int lane) { return ((lane & 3) << 3) | (((lane >> 2) & 3) << 6) | (((lane >> 4) & 1) << 5) | (((lane >> 5) & 1) << 8); }
template <int OFF> __device__ __forceinline__ s16x4 tr_read(int vb) { s16x4 r; asm volatile("ds_read_b64_tr_b16 %0, %1 offset:%2" : "=&v"(r) : "v"(vb), "i"(OFF) : "memory"); return r; }
#define GLA_MFMA(a, b, c) __builtin_amdgcn_mfma_f32_32x32x16_bf16((a), (b), (c), 0, 0, 0)
__device__ __forceinline__ bf16x8 pack_step(const f32x16& x, int s) {
    u32x4 p; p.x = pk2f(x[8 * s], x[8 * s + 1]); p.y = pk2f(x[8 * s + 2], x[8 * s + 3]); p.z = pk2f(x[8 * s + 4], x[8 * s + 5]); p.w = pk2f(x[8 * s + 6], x[8 * s + 7]); return __builtin_bit_cast(bf16x8, p);
}
__device__ __forceinline__ void gla_prep(const unsigned short* QK_, const unsigned short* ZG_, const float* w2_, const float* b2_, unsigned short* TQ_, unsigned short* TK_, unsigned short* TP_, float* EL_,
                                         int b, int h, int dir, int c_lo, int c_hi, int ML_, int SEQ_, int CTX_, GLA_LAS unsigned char* lds) {
    const GLA_GAS unsigned short* QK = (const GLA_GAS unsigned short*)QK_; const GLA_GAS unsigned short* ZG = (const GLA_GAS unsigned short*)ZG_;
    const GLA_GAS float* w2g = (const GLA_GAS float*)w2_; const GLA_GAS float* b2g = (const GLA_GAS float*)b2_;
    const int tid = threadIdx.x, wid = __builtin_amdgcn_readfirstlane(tid >> 6), lane = tid & 63, r32 = lane & 31, hi = lane >> 5;
    const int seg = tid >> 7, kk = tid & 127;
    GLA_LAS unsigned char* QT = lds + OFF_QT; GLA_LAS unsigned char* KT = lds + OFF_KT;
    GLA_LAS float* TOT = (GLA_LAS float*)(lds + OFF_TOT); GLA_LAS float* ZGS = (GLA_LAS float*)(lds + OFF_ZG); GLA_LAS float* W2S = (GLA_LAS float*)(lds + OFF_W2);
    __syncthreads();
#pragma unroll
    for (int i = 0; i < 4; ++i) { const int idx = tid + 512 * i; W2S[idx] = w2g[(size_t)(dir * 16 + (idx >> 7)) * 512 + h * 128 + (idx & 127)]; }
    const float b2 = b2g[dir * 512 + h * 128 + kk];
    const int nctx = CTX_ / 64;
    unsigned raw[16], zgw;
#define GLA_PLOAD(cs_) do { const long r0_ = ((cs_) < nctx) ? (long)ML_ + (long)b * CTX_ + 64 * (cs_) : (long)b * SEQ_ + 64 * ((cs_) - nctx); \
        zgw = *(const GLA_GAS unsigned*)(ZG + (r0_ + (tid >> 3)) * 2304 + dir * 16 + (tid & 7) * 2); \
        _Pragma("unroll") for (int i_ = 0; i_ < 16; ++i_) { const GLA_GAS unsigned short* zr_ = QK + (r0_ + 16 * seg + i_) * 1024 + h * 128 + kk; raw[i_] = (unsigned)zr_[0] | ((unsigned)zr_[512] << 16); } } while (0)
    for (int cs = c_lo; cs < c_hi; ++cs) {
        GLA_PLOAD(cs);
        const size_t tile = (size_t)((b * 4 + h) * 2 + dir) * 36 + cs;
        GLA_GAS unsigned short* TQ = (GLA_GAS unsigned short*)TQ_ + tile * 8192; GLA_GAS unsigned short* TK = (GLA_GAS unsigned short*)TK_ + tile * 8192; GLA_GAS unsigned short* TP = (GLA_GAS unsigned short*)TP_ + tile * 4096;
        { const int l = tid >> 3, r2 = (tid & 7) * 2; ZGS[l * 16 + r2] = __uint_as_float(zgw << 16); ZGS[l * 16 + r2 + 1] = __uint_as_float(zgw & 0xffff0000u); }
        __syncthreads();
        float cum[16];
#pragma unroll
        for (int i = 0; i < 16; ++i) cum[i] = b2;
#pragma unroll
        for (int q = 0; q < 4; ++q) { const float wa = W2S[(4 * q) * 128 + kk], wb = W2S[(4 * q + 1) * 128 + kk], wc_ = W2S[(4 * q + 2) * 128 + kk], wd = W2S[(4 * q + 3) * 128 + kk];
#pragma unroll
            for (int i = 0; i < 16; ++i) { const f32x4 z = *(const GLA_LAS f32x4*)(ZGS + (16 * seg + i) * 16 + 4 * q); cum[i] += z.x * wa + z.y * wb + z.z * wc_ + z.w * wd; } }
#pragma unroll
        for (int i = 0; i < 16; ++i) { const float x = cum[i]; cum[i] = (fminf(x, 0.f) - __logf(1.0f + __expf(-fabsf(x)))) * (1.0f / 16.0f); }
        if (dir == 0) {
#pragma unroll
            for (int i = 1; i < 16; ++i) cum[i] += cum[i - 1];
            TOT[seg * 128 + kk] = cum[15];
        } else {
#pragma unroll
            for (int i = 14; i >= 0; --i) cum[i] += cum[i + 1];
            TOT[seg * 128 + kk] = cum[0];
        }
        __syncthreads();
        { const float t0 = TOT[kk], t1 = TOT[128 + kk], t2 = TOT[256 + kk], t3 = TOT[384 + kk]; const float last = (t0 + t1) + (t2 + t3);
          float off;
          if (dir == 0) off = (seg > 0 ? t0 : 0.f) + (seg > 1 ? t1 : 0.f) + (seg > 2 ? t2 : 0.f);
          else off = (seg < 3 ? t3 : 0.f) + (seg < 2 ? t2 : 0.f) + (seg < 1 ? t1 : 0.f);
          if (seg == 0) ((GLA_GAS float*)EL_)[tile * 128 + kk] = __expf(last);
          unsigned ktp[8];
#pragma unroll
          for (int i = 0; i < 16; i += 2) {
              const float c0 = cum[i] + off, c1 = cum[i + 1] + off; const int l0 = 16 * seg + i, l1 = l0 + 1;
              const float q0 = __uint_as_float(raw[i] << 16), k0v = __uint_as_float(raw[i] & 0xffff0000u), q1 = __uint_as_float(raw[i + 1] << 16), k1v = __uint_as_float(raw[i + 1] & 0xffff0000u);
              const unsigned short qa = bf1f(q0 * __expf(c0)), qb = bf1f(q1 * __expf(c1)); const float ka = k0v * __expf(-c0), kb = k1v * __expf(-c1); const unsigned kp = pk2f(ka, kb);
              *(GLA_LAS unsigned short*)(QT + swz256(l0, 2 * kk)) = qa; *(GLA_LAS unsigned short*)(QT + swz256(l1, 2 * kk)) = qb;
              *(GLA_LAS unsigned short*)(KT + swz256(l0, 2 * kk)) = (unsigned short)(kp & 0xffffu); *(GLA_LAS unsigned short*)(KT + swz256(l1, 2 * kk)) = (unsigned short)(kp >> 16);
              TQ[l0 * 128 + kk] = qa; TQ[l1 * 128 + kk] = qb; ktp[i >> 1] = kp; }
          u32x4 k0 = {ktp[0], ktp[1], ktp[2], ktp[3]}, k1 = {ktp[4], ktp[5], ktp[6], ktp[7]};
          *(GLA_GAS u32x4*)(TK + kk * 64 + 16 * seg) = k0; *(GLA_GAS u32x4*)(TK + kk * 64 + 16 * seg + 8) = k1; }
        __syncthreads();
        if (wid < 4) { const int mi = wid >> 1, li = wid & 1; f32x16 x = f32x16{};
#pragma unroll
            for (int s2 = 0; s2 < 8; ++s2) { const int cb = (16 * s2 + 8 * hi) * 2;
                const bf16x8 a = *(const GLA_LAS bf16x8*)(KT + swz256(32 * mi + r32, cb)); const bf16x8 bq = *(const GLA_LAS bf16x8*)(QT + swz256(32 * li + r32, cb)); x = GLA_MFMA(a, bq, x); }
            const int l = 32 * li + r32;
#pragma unroll
            for (int g = 0; g < 4; ++g) { float v[4];
#pragma unroll
                for (int j = 0; j < 4; ++j) { const int m = 32 * mi + 8 * g + 4 * hi + j; const bool keep = (dir == 0) ? (m <= l) : (m >= l); v[j] = keep ? x[4 * g + j] : 0.f; }
                u32x2 w; w.x = pk2f(v[0], v[1]); w.y = pk2f(v[2], v[3]); *(GLA_GAS u32x2*)(TP + l * 64 + 32 * mi + 8 * g + 4 * hi) = w; } }
    }
#undef GLA_PLOAD
    __syncthreads();
}
__device__ __forceinline__ void gla_chain(const unsigned short* VR_, const unsigned short* TQ_, const unsigned short* TK_, const unsigned short* TP_, const float* EL_, unsigned short* O_, int b, int h, int dir,
                                          int ML_, int SEQ_, int CTX_, GLA_LAS unsigned char* lds) {
    const GLA_GAS unsigned short* VR = (const GLA_GAS unsigned short*)VR_; GLA_GAS unsigned short* O = (GLA_GAS unsigned short*)O_;
    const int tid = threadIdx.x, wid = __builtin_amdgcn_readfirstlane(tid >> 6), lane = tid & 63, r32 = lane & 31, hi = lane >> 5;
    GLA_LAS unsigned char* QT = lds + OFF_QT; GLA_LAS unsigned char* KH = lds + OFF_KH; GLA_LAS unsigned char* VI = lds + OFF_V; GLA_LAS unsigned char* PI = lds + OFF_P; GLA_LAS float* EL = (GLA_LAS float*)(lds + OFF_EL);
    f32x16 S[4];
#pragma unroll
    for (int t = 0; t < 4; ++t) S[t] = f32x16{};
    const int vb = (int)(unsigned)(uintptr_t)VI + v_rd_base(lane) + wid * 512;
    const int nchunk = (CTX_ + SEQ_) / 64, nctx = CTX_ / 64;
    const size_t tile0 = (size_t)((b * 4 + h) * 2 + dir) * 36;
    u32x4 pq[2], pk[2], pp, pv[4]; float pe = 0.f;
#define GLA_CS(sc_) ((dir == 0) ? (sc_) : (((sc_) < nctx) ? (nctx - 1 - (sc_)) : (nchunk - 1 - ((sc_) - nctx))))
#define GLA_FETCH(sc_) do { const int cs_ = GLA_CS(sc_); const size_t t_ = tile0 + cs_; const long r0_ = (cs_ < nctx) ? (long)ML_ + (long)b * CTX_ + 64 * cs_ : (long)b * SEQ_ + 64 * (cs_ - nctx); \
        const GLA_GAS u32x4* q_ = (const GLA_GAS u32x4*)((const GLA_GAS unsigned short*)TQ_ + t_ * 8192); const GLA_GAS u32x4* k_ = (const GLA_GAS u32x4*)((const GLA_GAS unsigned short*)TK_ + t_ * 8192); \
        pq[0] = q_[tid]; pq[1] = q_[tid + 512]; pk[0] = k_[tid]; pk[1] = k_[tid + 512]; pp = ((const GLA_GAS u32x4*)((const GLA_GAS unsigned short*)TP_ + t_ * 4096))[tid]; \
        if (tid < 128) pe = ((const GLA_GAS float*)EL_)[t_ * 128 + tid]; \
        _Pragma("unroll") for (int i_ = 0; i_ < 4; ++i_) { const int c_ = tid + 512 * i_; pv[i_] = *(const GLA_GAS u32x4*)(VR + (r0_ + (c_ >> 5)) * 2304 + h * 256 + (c_ & 31) * 8); } } while (0)
    GLA_FETCH(0);
    for (int sc = 0; sc < nchunk; ++sc) {
        const int cs = GLA_CS(sc); const bool is_lat = cs >= nctx; const long row0 = is_lat ? (long)b * SEQ_ + 64 * (cs - nctx) : (long)ML_ + (long)b * CTX_ + 64 * cs;
#pragma unroll
        for (int i = 0; i < 2; ++i) { const int c = tid + 512 * i; *(GLA_LAS u32x4*)(QT + (c >> 4) * RS256 + (c & 15) * 16) = pq[i]; *(GLA_LAS u32x4*)(KH + (c >> 3) * RS128 + (c & 7) * 16) = pk[i]; }
        *(GLA_LAS u32x4*)(PI + (tid >> 3) * RS128 + (tid & 7) * 16) = pp;
        if (tid < 128) EL[tid] = pe;
#pragma unroll
        for (int i = 0; i < 4; ++i) { const int c = tid + 512 * i; *(GLA_LAS u32x4*)(VI + v_st(c >> 5, (c & 31) * 8)) = pv[i]; }
        __syncthreads();
        if (sc + 1 < nchunk) GLA_FETCH(sc + 1);
        f32x16 o[2] = {f32x16{}, f32x16{}};
#pragma unroll
        for (int kt = 0; kt < 4; ++kt)
#pragma unroll
            for (int s2 = 0; s2 < 2; ++s2) { const bf16x8 bs = pack_step(S[kt], s2); const int cb0 = (32 * kt + 16 * s2 + 4 * hi) * 2;
#pragma unroll
                for (int rb = 0; rb < 2; ++rb) { const int l = 32 * rb + r32;
                    const s16x4 a0 = *(const GLA_LAS s16x4*)(QT + swz256(l, cb0)), a1 = *(const GLA_LAS s16x4*)(QT + swz256(l, cb0 + 16));
                    const bf16x8 a = {a0[0], a0[1], a0[2], a0[3], a1[0], a1[1], a1[2], a1[3]}; o[rb] = GLA_MFMA(a, bs, o[rb]); } }
        bf16x8 vf[4];
        { const s16x4 l0 = tr_read<0 * 8192>(vb), h0 = tr_read<0 * 8192 + 4096>(vb), l1 = tr_read<1 * 8192>(vb), h1 = tr_read<1 * 8192 + 4096>(vb);
          const s16x4 l2 = tr_read<2 * 8192>(vb), h2 = tr_read<2 * 8192 + 4096>(vb), l3 = tr_read<3 * 8192>(vb), h3 = tr_read<3 * 8192 + 4096>(vb);
          asm volatile("s_waitcnt lgkmcnt(0)" ::: "memory"); __builtin_amdgcn_sched_barrier(0);
          vf[0] = (bf16x8){l0[0], l0[1], l0[2], l0[3], h0[0], h0[1], h0[2], h0[3]}; vf[1] = (bf16x8){l1[0], l1[1], l1[2], l1[3], h1[0], h1[1], h1[2], h1[3]};
          vf[2] = (bf16x8){l2[0], l2[1], l2[2], l2[3], h2[0], h2[1], h2[2], h2[3]}; vf[3] = (bf16x8){l3[0], l3[1], l3[2], l3[3], h3[0], h3[1], h3[2], h3[3]}; }
#pragma unroll
        for (int rb = 0; rb < 2; ++rb)
#pragma unroll
            for (int ks = 0; ks < 4; ++ks) { const bf16x8 a = *(const GLA_LAS bf16x8*)(PI + swz128(32 * rb + r32, (16 * ks + 8 * hi) * 2)); o[rb] = GLA_MFMA(a, vf[ks], o[rb]); }
        if (is_lat) {
#pragma unroll
            for (int rb = 0; rb < 2; ++rb)
#pragma unroll
                for (int r = 0; r < 16; ++r) O[(row0 + 32 * rb + crow(r, hi)) * 1024 + h * 256 + 32 * wid + r32] = bf1f(o[rb][r]); }
#pragma unroll
        for (int kt = 0; kt < 4; ++kt) {
#pragma unroll
            for (int ks = 0; ks < 4; ++ks) { const bf16x8 a = *(const GLA_LAS bf16x8*)(KH + swz128(32 * kt + r32, (16 * ks + 8 * hi) * 2)); S[kt] = GLA_MFMA(a, vf[ks], S[kt]); }
#pragma unroll
            for (int r = 0; r < 16; ++r) S[kt][r] *= EL[32 * kt + crow(r, hi)]; }
        __syncthreads();
    }
#undef GLA_FETCH
#undef GLA_CS
}
__device__ __forceinline__ int v_st4(int k, int c) { const int kk = (k & ~0xC) | ((k & 4) << 1) | ((k & 8) >> 1); return ((kk >> 3) * 4 + (c >> 5)) * 512 + ((kk & 7) * 32 + (c & 31)) * 2; }
constexpr int OFF_XO_A = OFF_KT, OFF_XO_B = OFF_V + 16384;
static_assert(OFF_XO_A + 16384 <= OFF_KH && OFF_XO_B + 16384 <= OFF_P, "gla chain2 lds map");
__device__ __forceinline__ void gla_chain2(const unsigned short* VR_, const unsigned short* TQ_, const unsigned short* TK_, const unsigned short* TP_, const float* EL_, unsigned short* O_, int b, int h, int dir, int vh,
                                           int ML_, int SEQ_, int CTX_, GLA_LAS unsigned char* lds) {
    const GLA_GAS unsigned short* VR = (const GLA_GAS unsigned short*)VR_; GLA_GAS unsigned short* O = (GLA_GAS unsigned short*)O_;
    const int tid = threadIdx.x, wid = __builtin_amdgcn_readfirstlane(tid >> 6), lane = tid & 63, r32 = lane & 31, hi = lane >> 5;
    const int vt = wid & 3, kh = wid >> 2;
    GLA_LAS unsigned char* QT = lds + OFF_QT; GLA_LAS unsigned char* KH = lds + OFF_KH; GLA_LAS unsigned char* VI = lds + OFF_V; GLA_LAS unsigned char* PI = lds + OFF_P; GLA_LAS float* EL = (GLA_LAS float*)(lds + OFF_EL);
    GLA_LAS f32x4* XOs = (GLA_LAS f32x4*)(lds + (wid < 4 ? OFF_XO_A + wid * 4096 : OFF_XO_B + (wid - 4) * 4096));
    GLA_LAS f32x4* XOr = (GLA_LAS f32x4*)(lds + ((wid ^ 4) < 4 ? OFF_XO_A + (wid ^ 4) * 4096 : OFF_XO_B + ((wid ^ 4) - 4) * 4096));
    f32x16 S[2] = {f32x16{}, f32x16{}};
    const int vb = (int)(unsigned)(uintptr_t)VI + v_rd_base(lane) + vt * 512;
    const int nchunk = (CTX_ + SEQ_) / 64, nctx = CTX_ / 64;
    const size_t tile0 = (size_t)((b * 4 + h) * 2 + dir) * 36;
    u32x4 pq[2], pk[2], pp, pv[2]; float pe = 0.f;
#define GLA_CS(sc_) ((dir == 0) ? (sc_) : (((sc_) < nctx) ? (nctx - 1 - (sc_)) : (nchunk - 1 - ((sc_) - nctx))))
#define GLA_FETCH(sc_) do { const int cs_ = GLA_CS(sc_); const size_t t_ = tile0 + cs_; const long r0_ = (cs_ < nctx) ? (long)ML_ + (long)b * CTX_ + 64 * cs_ : (long)b * SEQ_ + 64 * (cs_ - nctx); \
        const GLA_GAS u32x4* q_ = (const GLA_GAS u32x4*)((const GLA_GAS unsigned short*)TQ_ + t_ * 8192); const GLA_GAS u32x4* k_ = (const GLA_GAS u32x4*)((const GLA_GAS unsigned short*)TK_ + t_ * 8192); \
        pq[0] = q_[tid]; pq[1] = q_[tid + 512]; pk[0] = k_[tid]; pk[1] = k_[tid + 512]; pp = ((const GLA_GAS u32x4*)((const GLA_GAS unsigned short*)TP_ + t_ * 4096))[tid]; \
        if (tid < 128) pe = ((const GLA_GAS float*)EL_)[t_ * 128 + tid]; \
        _Pragma("unroll") for (int i_ = 0; i_ < 2; ++i_) { const int c_ = tid + 512 * i_; pv[i_] = *(const GLA_GAS u32x4*)(VR + (r0_ + (c_ >> 4)) * 2304 + h * 256 + vh * 128 + (c_ & 15) * 8); } } while (0)
    GLA_FETCH(0);
    for (int sc = 0; sc < nchunk; ++sc) {
        const int cs = GLA_CS(sc); const bool is_lat = cs >= nctx; const long row0 = is_lat ? (long)b * SEQ_ + 64 * (cs - nctx) : (long)ML_ + (long)b * CTX_ + 64 * cs;
#pragma unroll
        for (int i = 0; i < 2; ++i) { const int c = tid + 512 * i; *(GLA_LAS u32x4*)(QT + (c >> 4) * RS256 + (c & 15) * 16) = pq[i]; *(GLA_LAS u32x4*)(KH + (c >> 3) * RS128 + (c & 7) * 16) = pk[i];
            *(GLA_LAS u32x4*)(VI + v_st4(c >> 4, (c & 15) * 8)) = pv[i]; }
        *(GLA_LAS u32x4*)(PI + (tid >> 3) * RS128 + (tid & 7) * 16) = pp;
        if (tid < 128) EL[tid] = pe;
        __syncthreads();
        if (sc + 1 < nchunk) GLA_FETCH(sc + 1);
        f32x16 op[2] = {f32x16{}, f32x16{}};
#pragma unroll
        for (int j = 0; j < 2; ++j)
#pragma unroll
            for (int s2 = 0; s2 < 2; ++s2) { const bf16x8 bs = pack_step(S[j], s2); const int cb0 = (32 * (2 * kh + j) + 16 * s2 + 4 * hi) * 2;
#pragma unroll
                for (int rb = 0; rb < 2; ++rb) { const int l = 32 * rb + r32;
                    const s16x4 a0 = *(const GLA_LAS s16x4*)(QT + swz256(l, cb0)), a1 = *(const GLA_LAS s16x4*)(QT + swz256(l, cb0 + 16));
                    const bf16x8 a = {a0[0], a0[1], a0[2], a0[3], a1[0], a1[1], a1[2], a1[3]}; op[rb] = GLA_MFMA(a, bs, op[rb]); } }
        { const f32x16& snd = kh ? op[0] : op[1];
#pragma unroll
          for (int g = 0; g < 4; ++g) XOs[g * 64 + lane] = (f32x4){snd[4 * g], snd[4 * g + 1], snd[4 * g + 2], snd[4 * g + 3]}; }
        __syncthreads();
        f32x16 o = kh ? op[1] : op[0];
#pragma unroll
        for (int g = 0; g < 4; ++g) { const f32x4 rv = XOr[g * 64 + lane]; o[4 * g] += rv.x; o[4 * g + 1] += rv.y; o[4 * g + 2] += rv.z; o[4 * g + 3] += rv.w; }
        bf16x8 vf[4];
        { const s16x4 l0 = tr_read<0 * 4096>(vb), h0 = tr_read<0 * 4096 + 2048>(vb), l1 = tr_read<1 * 4096>(vb), h1 = tr_read<1 * 4096 + 2048>(vb);
          const s16x4 l2 = tr_read<2 * 4096>(vb), h2 = tr_read<2 * 4096 + 2048>(vb), l3 = tr_read<3 * 4096>(vb), h3 = tr_read<3 * 4096 + 2048>(vb);
          asm volatile("s_waitcnt lgkmcnt(0)" ::: "memory"); __builtin_amdgcn_sched_barrier(0);
          vf[0] = (bf16x8){l0[0], l0[1], l0[2], l0[3], h0[0], h0[1], h0[2], h0[3]}; vf[1] = (bf16x8){l1[0], l1[1], l1[2], l1[3], h1[0], h1[1], h1[2], h1[3]};
          vf[2] = (bf16x8){l2[0], l2[1], l2[2], l2[3], h2[0], h2[1], h2[2], h2[3]}; vf[3] = (bf16x8){l3[0], l3[1], l3[2], l3[3], h3[0], h3[1], h3[2], h3[3]}; }
#pragma unroll
        for (int ks = 0; ks < 4; ++ks) { const bf16x8 a = *(const GLA_LAS bf16x8*)(PI + swz128(32 * kh + r32, (16 * ks + 8 * hi) * 2)); o = GLA_MFMA(a, vf[ks], o); }
        if (is_lat) {
#pragma unroll
            for (int r = 0; r < 16; ++r) O[(row0 + 32 * kh + crow(r, hi)) * 1024 + h * 256 + vh * 128 + 32 * vt + r32] = bf1f(o[r]); }
#pragma unroll
        for (int j = 0; j < 2; ++j) { const int kt = 2 * kh + j;
#pragma unroll
            for (int ks = 0; ks < 4; ++ks) { const bf16x8 a = *(const GLA_LAS bf16x8*)(KH + swz128(32 * kt + r32, (16 * ks + 8 * hi) * 2)); S[j] = GLA_MFMA(a, vf[ks], S[j]); }
#pragma unroll
            for (int r = 0; r < 16; ++r) S[j][r] *= EL[32 * kt + crow(r, hi)]; }
        __syncthreads();
    }
#undef GLA_FETCH
#undef GLA_CS
}
#undef GLA_MFMA
}

constexpr int NWAVES = 8;
constexpr int D = 1024, NB = 16, SEQ = 2048, CTXL = 256, TT = SEQ + CTXL;
constexpr int ML = NB * SEQ, MC = NB * CTXL, MA = ML + MC;
constexpr float EPS = 1e-6f;
constexpr int S5W = 512, S5G = 32, S5H = 16, S5P = 64;
constexpr int NH = 8, NOPE = 64, ROPE = 32, QK = 96, VD = 64, QRANK = 256, KVRANK = 128;
constexpr int EV_IN = 928, EV_INP = 1024, NQKV = 1792, KQKV = 384;
constexpr int GH = 4, GDK = 128, GDV = 256, GKEY = 512, GVAL = 1024, GRANK = 16;
constexpr int OD_IN = 3104, OD_INP = 3328;
constexpr int FFN = 2816, NE = 8, FE = 3584;
constexpr int MOE_MAXT = 264;

constexpr size_t MiB = 1u << 20;
constexpr size_t WS_CTL = 0, CTL_ZERO_BYTES = 1 * MiB;
constexpr size_t WS_MODV = 1 * MiB;
constexpr size_t WS_TOK = 2 * MiB;
constexpr size_t WS_INV = 3 * MiB;
constexpr size_t WS_W_IN1 = 4 * MiB, WS_W_OUT1 = 11 * MiB, WS_W_MGU = 13 * MiB  , WS_W_MDN = 69 * MiB  ;
constexpr size_t WS_W_IN0 = 97 * MiB, WS_W_QKV = 99 * MiB, WS_W_GLU = 100 * MiB + 512 * 1024, WS_W_OUT0 = 101 * MiB, WS_W_GU = 103 * MiB, WS_W_DN = 114 * MiB, WS_HC = 120 * MiB;
constexpr size_t PB = 136 * MiB;
constexpr size_t WS_XL = PB + 0 * MiB, WS_Q = PB + 0 * MiB, WS_A3 = PB + 72 * MiB, WS_YL = PB + 72 * MiB, WS_KV = PB + 144 * MiB, WS_Z0C = PB + 144 * MiB, WS_U = PB + 180 * MiB, WS_DS = PB + 216 * MiB, WS_AO = PB + 216 * MiB,
                 WS_QA = PB + 288 * MiB, WS_AG = PB + 288 * MiB, WS_KR = PB + 324 * MiB, WS_B1 = PB + 328 * MiB, WS_B3 = PB + 332 * MiB;
constexpr size_t WS_ACT = PB + 72 * MiB, WS_FL = PB + 270 * MiB;
constexpr size_t WS_TP = 97 * MiB, WS_EL = 133 * MiB, WS_OF = PB, WS_VR = 208 * MiB, WS_QK = 370 * MiB, WS_OB = 370 * MiB, WS_YL1 = 370 * MiB, WS_TQ = 442 * MiB, WS_TK = 514 * MiB;
constexpr int VRLD = 2304;
constexpr int GLA_TILES = NB * GH * 2 * 36;
constexpr int MOE_W_ITEMS = NE * (2 * (D / 64) * (FE / 32) + (FE / 64) * (D / 32));
constexpr int MW0 = 0, MW1 = (MOE_W_ITEMS * 20) / 100, MW2 = (MOE_W_ITEMS * 40) / 100, MW3 = (MOE_W_ITEMS * 54) / 100, MW4 = (MOE_W_ITEMS * 82) / 100, MW5 = MOE_W_ITEMS;
constexpr size_t WS_XLM = PB + 0 * MiB, WS_Y = PB + 0 * MiB, WS_XG = PB + 132 * MiB, WS_ACTM = PB + 198 * MiB;
constexpr size_t WS_END = 588 * MiB;
static_assert(WS_KR + (size_t)MA * 32 * 2 <= WS_B1 && WS_KV + (size_t)MA * 1024 * 2 <= WS_DS && WS_AG + (size_t)MA * 512 * 2 <= WS_KR && WS_AO + (size_t)MA * D * 2 <= WS_AG && WS_A3 + (size_t)MA * 1024 * 2 <= WS_KV &&
              WS_Z0C + (size_t)MA * 512 * 2 <= WS_U && WS_U + (size_t)MA * 512 * 2 <= WS_DS && WS_DS + (size_t)MA * 512 * 4 <= WS_QA && WS_QA + (size_t)MA * KQKV * 2 <= WS_KR && WS_B1 + (size_t)32 * 256 * 256 * 2 <= WS_B3 && WS_B3 + (size_t)32 * 256 * 512 * 2 <= WS_END, "ws map");
static_assert(WS_FL + (size_t)MA * D * 2 <= WS_END && WS_ACT + (size_t)MA * FFN * 2 <= WS_FL, "ws map 2");
static_assert(WS_TP + (size_t)GLA_TILES * 8192 <= WS_EL && WS_EL + (size_t)GLA_TILES * 512 <= PB && WS_XL + (size_t)MA * D * 2 <= WS_VR && WS_VR + (size_t)MA * VRLD * 2 <= WS_QK && WS_QK + (size_t)MA * 1024 * 2 <= WS_TQ &&
              WS_TQ + (size_t)GLA_TILES * 16384 <= WS_TK && WS_TK + (size_t)GLA_TILES * 16384 <= WS_END && WS_OF + (size_t)ML * D * 2 <= WS_VR && WS_OB + (size_t)ML * D * 2 <= WS_TQ, "ws map layer 1");
static_assert(WS_Y + (size_t)MOE_MAXT * 256 * D * 2 <= WS_XG && WS_XG + (size_t)MOE_MAXT * 256 * D <= WS_ACTM && WS_ACTM + (size_t)MOE_MAXT * 256 * FE <= WS_END && WS_XLM + (size_t)ML * D <= WS_XG, "ws map 3");
static_assert(WS_W_IN1 + (size_t)OD_INP * D * 2 <= WS_W_OUT1 && WS_W_OUT1 + (size_t)D * D * 2 <= WS_W_MGU && WS_W_MGU + (size_t)NE * 2 * FE * D <= WS_W_MDN && WS_W_MDN + (size_t)NE * D * FE <= WS_W_IN0 &&
              WS_W_GU + (size_t)2 * FFN * D * 2 <= WS_W_DN && WS_W_DN + (size_t)D * FFN * 2 <= WS_HC && WS_HC + (size_t)MC * D * 4 <= PB, "ws map 4");
#ifndef FFN0_FP8
#define FFN0_FP8 0
#endif
constexpr bool FFN0_IS_FP8 = FFN0_FP8;
#ifndef FFN0_DOWN_FP8
#define FFN0_DOWN_FP8 1
#endif
constexpr bool FFN0_DN_FP8 = FFN0_DOWN_FP8;
constexpr float FP8_SA = 8.0f, FP8_SW = 128.0f, FP8_SACT = 4.0f;

constexpr int CW_TMO = 0, CW_CODE = 1, CW_CNT = 64, CW_BAR = 4096;

constexpr int RING_OFF = 0, RING_BYTES = 131072;
constexpr int ATAB_OFF = RING_BYTES + 1024, ATAB_UNITS = 29;
constexpr int LDSCTL_OFF = RING_BYTES, MISC_OFF = LDSCTL_OFF + 320;
constexpr int LDS_BYTES = 147456;
static_assert(ATAB_OFF + ATAB_UNITS * 512 <= LDS_BYTES, "LDS map: row table");

struct Args { const float* in[35]; float* out; unsigned char* ws; int ph_lo, ph_hi; };
struct Frame { LAS unsigned char* lds; volatile LAS unsigned* MISC; gu32* ctl; int tid, lane, wave, G, gw, ngw; };

__device__ __forceinline__ float wave_sum(float v) {
#pragma unroll
    for (int o = 1; o < 64; o <<= 1) v += __shfl_xor(v, o);
    return v;
}
__device__ __forceinline__ float bf_lo(unsigned u) { return __uint_as_float(u << 16); }
__device__ __forceinline__ float bf_hi(unsigned u) { return __uint_as_float(u & 0xffff0000u); }
__device__ __forceinline__ float bf1(bf16 u) { return __uint_as_float(((unsigned)u) << 16); }
typedef unsigned v2u __attribute__((ext_vector_type(2)));
__device__ __forceinline__ unsigned pk4_fp8(float a, float b, float c, float d) { return pg8::pk4_fp8(a, b, c, d); }

__device__ __forceinline__ void ld_row_f32(const float* p, int lane, f32x4 (&v)[4]) {
    const GAS f32x4* q = (const GAS f32x4*)p + lane;
#pragma unroll
    for (int j = 0; j < 4; ++j) v[j] = q[64 * j];
}
__device__ __forceinline__ void st_row_f32(float* p, int lane, const f32x4 (&v)[4]) {
    GAS f32x4* q = (GAS f32x4*)p + lane;
#pragma unroll
    for (int j = 0; j < 4; ++j) q[64 * j] = v[j];
}
__device__ __forceinline__ void ld_row_bf16(const bf16* p, int lane, f32x4 (&v)[4]) {
    const GAS v2u* q = (const GAS v2u*)p + lane;
#pragma unroll
    for (int j = 0; j < 4; ++j) { const v2u w = q[64 * j]; v[j] = (f32x4){bf_lo(w.x), bf_hi(w.x), bf_lo(w.y), bf_hi(w.y)}; }
}
__device__ __forceinline__ void st_row_bf16(bf16* p, int lane, const f32x4 (&v)[4]) {
    GAS v2u* q = (GAS v2u*)p + lane;
#pragma unroll
    for (int j = 0; j < 4; ++j) { v2u w; w.x = pk2(v[j].x, v[j].y); w.y = pk2(v[j].z, v[j].w); q[64 * j] = w; }
}
__device__ __forceinline__ void st_row_fp8(unsigned char* p, int lane, const f32x4 (&v)[4], float sc) {
    GAS unsigned* q = (GAS unsigned*)p + lane;
#pragma unroll
    for (int j = 0; j < 4; ++j) q[64 * j] = pk4_fp8(v[j].x * sc, v[j].y * sc, v[j].z * sc, v[j].w * sc);
}
__device__ __forceinline__ float row_rs(const f32x4 (&v)[4]) {
    float s = 0.f;
#pragma unroll
    for (int j = 0; j < 4; ++j) s += (v[j].x * v[j].x + v[j].y * v[j].y) + (v[j].z * v[j].z + v[j].w * v[j].w);
    return rsqrtf(wave_sum(s) * (1.0f / D) + EPS);
}
__device__ __forceinline__ void norm_mod(f32x4 (&v)[4], const float* gam, const float* sh, const float* sc, int lane) {
    const float rs = row_rs(v); f32x4 g[4], a[4], b[4]; ld_row_f32(gam, lane, g); ld_row_f32(sh, lane, a); ld_row_f32(sc, lane, b);
#pragma unroll
    for (int j = 0; j < 4; ++j) v[j] = (v[j] * rs) * g[j] * (1.0f + b[j]) + a[j];
}
__device__ __forceinline__ void gated_add(f32x4 (&h)[4], const f32x4 (&y)[4], const float* gam, const float* gate, int lane) {
    const float rs = row_rs(y); f32x4 g[4], t[4]; ld_row_f32(gam, lane, g); ld_row_f32(gate, lane, t);
#pragma unroll
    for (int j = 0; j < 4; ++j) h[j] = h[j] + t[j] * ((y[j] * rs) * g[j]);
}

__device__ __forceinline__ void cvt_item(const float* W, int K, int N, bf16* WT, int ldk, int kcol0, int row_off, int mode, const float* gain, float scale, int nscale,
                                         LAS float* scr, int item, int lane, bool fp8 = false, bool tiled = false) {
    const int nblk = N / 32, kb = item / nblk, nb = item % nblk, k0 = 64 * kb, n0 = 32 * nb;
    { f32x4 t[8];
#pragma unroll
      for (int i = 0; i < 8; ++i) t[i] = *(const GAS f32x4*)(W + (size_t)(k0 + 8 * i + (lane >> 3)) * N + n0 + 4 * (lane & 7));
#pragma unroll
      for (int i = 0; i < 8; ++i) { LAS float* d = scr + (8 * i + (lane >> 3)) * 33 + 4 * (lane & 7); d[0] = t[i].x; d[1] = t[i].y; d[2] = t[i].z; d[3] = t[i].w; } }
    LDS_WAIT(); asm volatile("" ::: "memory");
    const int c = lane & 7;
    float gn[8];
#pragma unroll
    for (int q = 0; q < 8; ++q) gn[q] = (gain ? gain[k0 + 8 * c + q] : 1.0f) * ((n0 < nscale) ? scale : 1.0f);
    const int drow0 = (mode == 0) ? n0 : (mode == 3) ? ((n0 >> 7) * 64 + (n0 & 63) + ((n0 & 64) ? 512 : 0)) : ((n0 >> 7) * 256 + (n0 & 127) + (mode == 2 ? 128 : 0));
#pragma unroll
    for (int j = 0; j < 4; ++j) { const int n = (lane >> 3) + 8 * j; const LAS float* s = scr + (8 * c) * 33 + n;
        if (fp8) { v2u o; o.x = pk4_fp8(s[0 * 33] * gn[0], s[1 * 33] * gn[1], s[2 * 33] * gn[2], s[3 * 33] * gn[3]); o.y = pk4_fp8(s[4 * 33] * gn[4], s[5 * 33] * gn[5], s[6 * 33] * gn[6], s[7 * 33] * gn[7]);
            const int drow = row_off + drow0 + n, kc = kcol0 + k0 + 8 * c;
            unsigned char* dp = tiled ? (unsigned char*)WT + (size_t)(drow >> 8) * 256 * ldk + (size_t)(kc >> 7) * 32768 + (drow & 255) * 128 + (kc & 127) : (unsigned char*)WT + (size_t)drow * ldk + kc;
            *(GAS v2u*)dp = o; }
        else { v4u o; o.x = pk2(s[0 * 33] * gn[0], s[1 * 33] * gn[1]); o.y = pk2(s[2 * 33] * gn[2], s[3 * 33] * gn[3]); o.z = pk2(s[4 * 33] * gn[4], s[5 * 33] * gn[5]); o.w = pk2(s[6 * 33] * gn[6], s[7 * 33] * gn[7]);
            *(GAS v4u*)(WT + (size_t)(row_off + drow0 + n) * ldk + kcol0 + k0 + 8 * c) = o; } }
    LDS_WAIT(); asm volatile("" ::: "memory");
}
__device__ __forceinline__ void moe_weights(Frame& F, const Args& A, int it_lo, int it_hi, int widx, int nw) {
    LAS float* scr = (LAS float*)(F.lds + RING_OFF + F.wave * 16384);
    unsigned char* ws = A.ws;
    constexpr int I_MG1 = (D / 64) * (FE / 32), I_MD1 = (FE / 64) * (D / 32);
    for (int it = it_lo + widx; it < it_hi; it += nw) {
        int r = it;
        if (r < NE * I_MG1) { const int e = r / I_MG1; cvt_item(A.in[32] + (size_t)e * D * FE, D, FE, (bf16*)(ws + WS_W_MGU + (size_t)e * 2 * FE * D), D, 0, 0, 1, nullptr, FP8_SW, 1 << 30, scr, r % I_MG1, F.lane, true); continue; } r -= NE * I_MG1;
        if (r < NE * I_MG1) { const int e = r / I_MG1; cvt_item(A.in[33] + (size_t)e * D * FE, D, FE, (bf16*)(ws + WS_W_MGU + (size_t)e * 2 * FE * D), D, 0, 0, 2, nullptr, FP8_SW, 1 << 30, scr, r % I_MG1, F.lane, true); continue; } r -= NE * I_MG1;
        { const int e = r / I_MD1; cvt_item(A.in[34] + (size_t)e * FE * D, FE, D, (bf16*)(ws + WS_W_MDN + (size_t)e * D * FE), FE, 0, 0, 0, nullptr, FP8_SW, 1 << 30, scr, r % I_MD1, F.lane, true, true); }
    }
}
__device__ __forceinline__ void tail_convert(Frame& F, const Args& A, int nunit, int lo, int hi) {
    const int nlast = nunit % F.G, bid = (int)blockIdx.x;
    if (nlast != 0) { if (bid >= nlast) moe_weights(F, A, lo, hi, (bid - nlast) * NWAVES + F.wave, (F.G - nlast) * NWAVES); }
    else moe_weights(F, A, lo, hi, F.gw, F.ngw);
}
__device__ __forceinline__ void gen_s5(Frame& F, const Args& A, int g);
#ifndef PROBE_BLK
#define PROBE_BLK 0
#endif
#ifdef PROBE_SETA
#define PROBE_STAMP2(F, k) do { if (blockIdx.x == PROBE_BLK && F.tid == 0) { const unsigned long long t_ = __builtin_amdgcn_s_memrealtime(); const unsigned long long l_ = ((unsigned long long)F.MISC[17] << 32) | F.MISC[16]; const unsigned d_ = (unsigned)(t_ - l_); \
        if ((PROBE_SETA >> (k)) & 1ull) F.MISC[18] += d_; if ((PROBE_SETB >> (k)) & 1ull) F.MISC[20] += d_; F.MISC[16] = (unsigned)t_; F.MISC[17] = (unsigned)(t_ >> 32); } } while (0)
#else
#define PROBE_STAMP2(F, k) do { } while (0)
#endif
__device__ __forceinline__ void p0_prologue(Frame& F, const Args& A) {
    LAS float* scr = (LAS float*)(F.lds + RING_OFF + F.wave * 16384);
    unsigned char* ws = A.ws;
    constexpr int I_IN0 = (D / 64) * (EV_IN / 32), I_UQ = (QRANK / 64) * (768 / 32), I_UKV = (KVRANK / 64) * (1024 / 32), I_GLU = (512 / 64) * (512 / 32), I_OUT = (D / 64) * (D / 32);
    constexpr int I_FG = (D / 64) * (FFN / 32), I_FD = (FFN / 64) * (D / 32), I_IN1 = (D / 64) * (OD_IN / 32), I_MG1 = (D / 64) * (FE / 32), I_MD1 = (FE / 64) * (D / 32);
    constexpr int NITEMS = I_IN0 + I_UQ + I_UKV + I_GLU + I_OUT + 2 * I_FG + I_FD + I_IN1 + I_OUT;
    const bool s5_builder = (int)blockIdx.x >= F.G - S5G;
    for (int it = s5_builder ? NITEMS : F.gw; it < NITEMS; it += F.ngw - S5G * NWAVES) {
        int r = it;
        if (r < I_IN0) { cvt_item(A.in[7], D, EV_IN, (bf16*)(ws + WS_W_IN0), D, 0, 0, 0, nullptr, 1.f, 0, scr, r, F.lane); continue; } r -= I_IN0;
        if (r < I_UQ) { cvt_item(A.in[19], QRANK, 768, (bf16*)(ws + WS_W_QKV), KQKV, 0, 0, 0, A.in[18], 1.f, 0, scr, r, F.lane); continue; } r -= I_UQ;
        if (r < I_UKV) { cvt_item(A.in[21], KVRANK, 1024, (bf16*)(ws + WS_W_QKV), KQKV, QRANK, 768, 3, A.in[20], 1.f, 0, scr, r, F.lane); continue; } r -= I_UKV;
        if (r < I_GLU) { cvt_item(A.in[16], 512, 512, (bf16*)(ws + WS_W_GLU), 512, 0, 0, 0, nullptr, 1.f, 0, scr, r, F.lane); continue; } r -= I_GLU;
        if (r < I_OUT) { cvt_item(A.in[22], D, D, (bf16*)(ws + WS_W_OUT0), D, 0, 0, 0, nullptr, 1.f, 0, scr, r, F.lane); continue; } r -= I_OUT;
        if (r < I_FG) { cvt_item(A.in[23], D, FFN, (bf16*)(ws + WS_W_GU), D, 0, 0, 1, nullptr, FFN0_IS_FP8 ? FP8_SW : 1.f, 1 << 30, scr, r, F.lane, FFN0_IS_FP8); continue; } r -= I_FG;
        if (r < I_FG) { cvt_item(A.in[24], D, FFN, (bf16*)(ws + WS_W_GU), D, 0, 0, 2, nullptr, FFN0_IS_FP8 ? FP8_SW : 1.f, 1 << 30, scr, r, F.lane, FFN0_IS_FP8); continue; } r -= I_FG;
        if (r < I_FD) { cvt_item(A.in[25], FFN, D, (bf16*)(ws + WS_W_DN), FFN, 0, 0, 0, nullptr, (FFN0_IS_FP8 || FFN0_DN_FP8) ? FP8_SW : 1.f, 1 << 30, scr, r, F.lane, FFN0_IS_FP8 || FFN0_DN_FP8); continue; } r -= I_FD;
        if (r < I_IN1) { cvt_item(A.in[26], D, OD_IN, (bf16*)(ws + WS_W_IN1), D, 0, 0, 0, nullptr, 0.08838834764831845f, GKEY, scr, r, F.lane); continue; } r -= I_IN1;
        cvt_item(A.in[30], D, D, (bf16*)(ws + WS_W_OUT1), D, 0, 0, 0, nullptr, 1.f, 0, scr, r, F.lane);
    }
    { const v4u z = {0u, 0u, 0u, 0u}; const int gt = blockIdx.x * (NWAVES * 64) + F.tid, ngt = F.G * NWAVES * 64;
      GAS v4u* p0 = (GAS v4u*)((bf16*)(ws + WS_W_IN0) + (size_t)EV_IN * D); for (int i = gt; i < (EV_INP - EV_IN) * D / 8; i += ngt) p0[i] = z;
      for (int i = gt; i < 768 * (KVRANK / 8); i += ngt) { const int r = i / (KVRANK / 8), c = i % (KVRANK / 8); *(GAS v4u*)((bf16*)(ws + WS_W_QKV) + (size_t)r * KQKV + QRANK + 8 * c) = z; }
      for (int i = gt; i < 1024 * (QRANK / 8); i += ngt) { const int r = i / (QRANK / 8), c = i % (QRANK / 8); *(GAS v4u*)((bf16*)(ws + WS_W_QKV) + (size_t)(768 + r) * KQKV + 8 * c) = z; }
      GAS v4u* p1 = (GAS v4u*)((bf16*)(ws + WS_W_IN1) + (size_t)OD_IN * D); for (int i = gt; i < (OD_INP - OD_IN) * D / 8; i += ngt) p1[i] = z; }
    __syncthreads();
    PROBE_STAMP2(F, 22);
    LAS float* act = (LAS float*)(F.lds);
    LAS float* red = (LAS float*)(F.lds + 17 * 1024 * 4);
    float* modv = (float*)(ws + WS_MODV);
    bool have_act = false;
    for (int u = blockIdx.x; u < 2 * 96; u += F.G) {
        if (!have_act) {
            float xv[17 * 1024 / (NWAVES * 64)];
#pragma unroll
            for (int q = 0; q < 17 * 1024 / (NWAVES * 64); ++q) { const int i = F.tid + q * (NWAVES * 64); xv[q] = (i < 16 * 1024) ? A.in[1][i] : A.in[3][i - 16 * 1024]; }
#pragma unroll
            for (int q = 0; q < 17 * 1024 / (NWAVES * 64); ++q) { const float x = xv[q]; act[F.tid + q * (NWAVES * 64)] = x / (1.0f + __expf(-x)); }
            have_act = true;
        }
        __syncthreads();
        const int layer = u / 96, c0 = (u % 96) * 64;
        const float* mw = A.in[4] + (size_t)layer * D * 6144 + c0 + F.lane;
        float acc[17];
#pragma unroll
        for (int r = 0; r < 17; ++r) acc[r] = 0.f;
        for (int k0 = F.wave * 128; k0 < F.wave * 128 + 128; k0 += 32) { float w[32];
#pragma unroll
            for (int u2 = 0; u2 < 32; ++u2) w[u2] = mw[(size_t)(k0 + u2) * 6144];
#pragma unroll
            for (int u2 = 0; u2 < 32; ++u2)
#pragma unroll
                for (int r = 0; r < 17; ++r) acc[r] += act[r * 1024 + k0 + u2] * w[u2]; }
#pragma unroll
        for (int r = 0; r < 17; ++r) red[(F.wave * 17 + r) * 64 + F.lane] = acc[r];
        __syncthreads();
        for (int i = F.tid; i < 17 * 64; i += NWAVES * 64) { const int r = i >> 6, l = i & 63; float s = A.in[5][layer * 6144 + c0 + l];
#pragma unroll
            for (int w = 0; w < 8; ++w) s += red[(w * 17 + r) * 64 + l];
            modv[(size_t)(layer * 17 + r) * 6144 + c0 + l] = s; }
    }
    __syncthreads();
    PROBE_STAMP2(F, 23);
    for (int g = (int)blockIdx.x - (F.G - S5G); g >= 0 && g < S5G; g += F.G) gen_s5(F, A, g);
    PROBE_STAMP2(F, 24);
}

__device__ __forceinline__ void thin_t1(Frame& F, const Args& A) {
    const float* modv = (const float*)(A.ws + WS_MODV); bf16* XL = (bf16*)(A.ws + WS_XL); const float* gam = A.in[6];
    for (int r0 = F.gw; r0 < MA; r0 += 2 * F.ngw) {
        const int r1 = (r0 + F.ngw < MA) ? r0 + F.ngw : r0; const bool two = r1 != r0;
        const bool lat0 = r0 < ML, lat1 = r1 < ML; const float* src0 = lat0 ? A.in[0] + (size_t)r0 * D : A.in[2] + (size_t)(r0 - ML) * D; const float* src1 = lat1 ? A.in[0] + (size_t)r1 * D : A.in[2] + (size_t)(r1 - ML) * D;
        const float* mod0 = modv + (size_t)(lat0 ? r0 / SEQ : 16) * 6144; const float* mod1 = modv + (size_t)(lat1 ? r1 / SEQ : 16) * 6144;
        f32x4 v0[4], v1[4]; ld_row_f32(src0, F.lane, v0); ld_row_f32(src1, F.lane, v1);
        norm_mod(v0, gam, mod0, mod0 + D, F.lane); st_row_bf16(XL + (size_t)r0 * D, F.lane, v0);
        norm_mod(v1, gam, mod1, mod1 + D, F.lane); if (two) st_row_bf16(XL + (size_t)r1 * D, F.lane, v1);
    }
}
__device__ __forceinline__ void thin_t2(Frame& F, const Args& A) {
    const float* modv = (const float*)(A.ws + WS_MODV); bf16* XL = (bf16*)(A.ws + WS_XL); const bf16* YL = (const bf16*)(A.ws + WS_YL); float* HC = (float*)(A.ws + WS_HC); const float* gam = A.in[6];
    for (int r0 = F.gw; r0 < MA; r0 += 2 * F.ngw) {
        const int r1 = (r0 + F.ngw < MA) ? r0 + F.ngw : r0; const bool two = r1 != r0;
        const bool lat0 = r0 < ML, lat1 = r1 < ML;
        const float* src0 = lat0 ? A.in[0] + (size_t)r0 * D : A.in[2] + (size_t)(r0 - ML) * D; const float* src1 = lat1 ? A.in[0] + (size_t)r1 * D : A.in[2] + (size_t)(r1 - ML) * D;
        float* dst0 = lat0 ? A.out + (size_t)r0 * D : HC + (size_t)(r0 - ML) * D; float* dst1 = lat1 ? A.out + (size_t)r1 * D : HC + (size_t)(r1 - ML) * D;
        const float* mod0 = modv + (size_t)(lat0 ? r0 / SEQ : 16) * 6144; const float* mod1 = modv + (size_t)(lat1 ? r1 / SEQ : 16) * 6144;
        f32x4 h0[4], y0[4], h1[4], y1[4];
        ld_row_f32(src0, F.lane, h0); ld_row_bf16(YL + (size_t)r0 * D, F.lane, y0); ld_row_f32(src1, F.lane, h1); ld_row_bf16(YL + (size_t)r1 * D, F.lane, y1);
        gated_add(h0, y0, gam + 1 * D, mod0 + 2 * D, F.lane); gated_add(h1, y1, gam + 1 * D, mod1 + 2 * D, F.lane);
        st_row_f32(dst0, F.lane, h0); if (two) st_row_f32(dst1, F.lane, h1);
        norm_mod(h0, gam + 2 * D, mod0 + 3 * D, mod0 + 4 * D, F.lane); norm_mod(h1, gam + 2 * D, mod1 + 3 * D, mod1 + 4 * D, F.lane);
        if (FFN0_IS_FP8) { st_row_fp8((unsigned char*)XL + (size_t)r0 * D, F.lane, h0, FP8_SA); if (two) st_row_fp8((unsigned char*)XL + (size_t)r1 * D, F.lane, h1, FP8_SA); }
        else { st_row_bf16(XL + (size_t)r0 * D, F.lane, h0); if (two) st_row_bf16(XL + (size_t)r1 * D, F.lane, h1); }
    }
}
__device__ __forceinline__ void thin_t3(Frame& F, const Args& A) {
    const float* modv = (const float*)(A.ws + WS_MODV); bf16* XL = (bf16*)(A.ws + WS_XL); const bf16* FL = (const bf16*)(A.ws + WS_FL); const float* HC = (const float*)(A.ws + WS_HC); const float* gam = A.in[6];
    for (int r0 = F.gw; r0 < MA; r0 += 2 * F.ngw) {
        const int r1 = (r0 + F.ngw < MA) ? r0 + F.ngw : r0; const bool two = r1 != r0;
        const bool lat0 = r0 < ML, lat1 = r1 < ML;
        const float* src0 = lat0 ? A.out + (size_t)r0 * D : HC + (size_t)(r0 - ML) * D; const float* src1 = lat1 ? A.out + (size_t)r1 * D : HC + (size_t)(r1 - ML) * D;
        const int bs0 = lat0 ? r0 / SEQ : 16, bs1 = lat1 ? r1 / SEQ : 16;
        f32x4 h0[4], y0[4], h1[4], y1[4];
        ld_row_f32(src0, F.lane, h0); ld_row_bf16(FL + (size_t)r0 * D, F.lane, y0); ld_row_f32(src1, F.lane, h1); ld_row_bf16(FL + (size_t)r1 * D, F.lane, y1);
        gated_add(h0, y0, gam + 3 * D, modv + (size_t)bs0 * 6144 + 5 * D, F.lane); gated_add(h1, y1, gam + 3 * D, modv + (size_t)bs1 * 6144 + 5 * D, F.lane);
        if (lat0) st_row_f32(A.out + (size_t)r0 * D, F.lane, h0); if (two && lat1) st_row_f32(A.out + (size_t)r1 * D, F.lane, h1);
        { const float* m0 = modv + (size_t)(17 + bs0) * 6144; const float* m1 = modv + (size_t)(17 + bs1) * 6144;
          norm_mod(h0, gam + 4 * D, m0, m0 + D, F.lane); norm_mod(h1, gam + 4 * D, m1, m1 + D, F.lane); }
        st_row_bf16(XL + (size_t)r0 * D, F.lane, h0); if (two) st_row_bf16(XL + (size_t)r1 * D, F.lane, h1);
    }
}
__device__ __forceinline__ void thin_t4(Frame& F, const Args& A) {
    const float* modv = (const float*)(A.ws + WS_MODV); bf16* XL = (bf16*)(A.ws + WS_XLM); const bf16* YL = (const bf16*)(A.ws + WS_YL1); const float* gam = A.in[6] + 4 * D;
    const float* router = A.in[31]; unsigned* tok = (unsigned*)(A.ws + WS_TOK); unsigned short* inv = (unsigned short*)(A.ws + WS_INV);
    LAS float* rt = (LAS float*)(F.lds);
    LAS unsigned* wc = (LAS unsigned*)(F.lds + 32768);
    __syncthreads();
    for (int i = F.tid; i < 8 * 1024; i += NWAVES * 64) { const int e = i >> 10, c = i & 1023; rt[i] = router[(size_t)c * 8 + e]; }
    __syncthreads();
    for (int chunk = blockIdx.x; chunk < ML / 128; chunk += F.G) {
        const int row_base = chunk * 128 + F.wave * 16;
        int me0 = 0, me1 = 0; float mw0 = 0.f, mw1 = 0.f;
        for (int i = 0; i < 16; ++i) {
            const int r = row_base + i; const int bs = r / SEQ; const float* mod1 = modv + (size_t)(17 + bs) * 6144;
            f32x4 h[4], y[4]; ld_row_f32(A.out + (size_t)r * D, F.lane, h); ld_row_bf16(YL + (size_t)r * D, F.lane, y);
            gated_add(h, y, gam + 1 * D, mod1 + 2 * D, F.lane); st_row_f32(A.out + (size_t)r * D, F.lane, h);
            norm_mod(h, gam + 2 * D, mod1 + 3 * D, mod1 + 4 * D, F.lane); st_row_fp8((unsigned char*)XL + (size_t)r * D, F.lane, h, FP8_SA);
            float lg[8];
#pragma unroll
            for (int e = 0; e < 8; ++e) { float a = 0.f;
#pragma unroll
                for (int j = 0; j < 4; ++j) { const f32x4 w = *(const LAS f32x4*)(rt + e * 1024 + 256 * j + 4 * F.lane); a += (h[j].x * w.x + h[j].y * w.y) + (h[j].z * w.z + h[j].w * w.w); }
                lg[e] = a; }
            {
              const bool b5 = (F.lane & 32) != 0, b4 = (F.lane & 16) != 0, b3 = (F.lane & 8) != 0; float v4[4], v2[2];
#pragma unroll
              for (int i2 = 0; i2 < 4; ++i2) { const float keep = b5 ? lg[i2 + 4] : lg[i2], send = b5 ? lg[i2] : lg[i2 + 4]; v4[i2] = keep + __shfl_xor(send, 32); }
#pragma unroll
              for (int i2 = 0; i2 < 2; ++i2) { const float keep = b4 ? v4[i2 + 2] : v4[i2], send = b4 ? v4[i2] : v4[i2 + 2]; v2[i2] = keep + __shfl_xor(send, 16); }
              float v1 = (b3 ? v2[1] : v2[0]) + __shfl_xor(b3 ? v2[0] : v2[1], 8);
              v1 += __shfl_xor(v1, 1); v1 += __shfl_xor(v1, 2); v1 += __shfl_xor(v1, 4);
#pragma unroll
              for (int e = 0; e < 8; ++e) lg[e] = __builtin_bit_cast(float, __builtin_amdgcn_readlane(__builtin_bit_cast(int, v1), 8 * e)); }
            int e0 = 0; float v0 = lg[0];
#pragma unroll
            for (int e = 1; e < 8; ++e) if (lg[e] > v0) { v0 = lg[e]; e0 = e; }
            int e1 = (e0 + 1) & 7; float v1 = -3.0e38f;
#pragma unroll
            for (int e = 0; e < 8; ++e) if (e != e0 && lg[e] > v1) { v1 = lg[e]; e1 = e; }
            const float w1 = 1.0f / (1.0f + __expf(v0 - v1)), w0 = 1.0f - w1;
            if (F.lane == i) { me0 = e0; me1 = e1; mw0 = w0; mw1 = w1; }
        }
        unsigned long long m[8];
#pragma unroll
        for (int e = 0; e < 8; ++e) m[e] = __ballot(F.lane < 16 && (me0 == e || me1 == e));
        { unsigned c = 0;
#pragma unroll
          for (int e = 0; e < 8; ++e) c = (F.lane == e) ? (unsigned)__popcll(m[e]) : c;
          if (F.lane < 8) wc[F.wave * 8 + F.lane] = c; }
        __syncthreads();
        if (F.tid < 8) { unsigned tot = 0;
#pragma unroll
            for (int w = 0; w < 8; ++w) tot += wc[w * 8 + F.tid];
            unsigned run = __hip_atomic_fetch_add((unsigned*)(F.ctl + CW_CNT + F.tid), tot, __ATOMIC_RELAXED, __HIP_MEMORY_SCOPE_AGENT);
#pragma unroll
            for (int w = 0; w < 8; ++w) { const unsigned c = wc[w * 8 + F.tid]; wc[w * 8 + F.tid] = run; run += c; } }
        __syncthreads();
        if (F.lane < 16) { unsigned long long m0 = 0ull, m1 = 0ull;
#pragma unroll
            for (int e = 0; e < 8; ++e) { m0 = (me0 == e) ? m[e] : m0; m1 = (me1 == e) ? m[e] : m1; }
            const unsigned long long below = (1ull << F.lane) - 1ull;
            const unsigned i0 = wc[F.wave * 8 + me0] + (unsigned)__popcll(m0 & below), i1 = wc[F.wave * 8 + me1] + (unsigned)__popcll(m1 & below);
            unsigned* t = tok + (size_t)(row_base + F.lane) * 8; t[0] = (unsigned)me0; t[1] = (unsigned)me1; t[2] = i0; t[3] = i1; t[4] = __float_as_uint(mw0); t[5] = __float_as_uint(mw1);
            inv[(size_t)me0 * 32768 + i0] = (unsigned short)(row_base + F.lane); inv[(size_t)me1 * 32768 + i1] = (unsigned short)(row_base + F.lane); }
        __syncthreads();
    }
}
__device__ __forceinline__ void moe_tile_starts(Frame& F, int (&ts)[9]) {
    ts[0] = 0;
#pragma unroll
    for (int e = 0; e < 8; ++e) { const unsigned c = __hip_atomic_load((unsigned*)(F.ctl + CW_CNT + e), __ATOMIC_RELAXED, __HIP_MEMORY_SCOPE_AGENT); ts[e + 1] = ts[e] + (int)((c + 255u) >> 8); }
#pragma unroll
    for (int e = 0; e < 9; ++e) ts[e] = __builtin_amdgcn_readfirstlane(ts[e]);
}
template <class Sched> __device__ __forceinline__ void moe_row_table(Frame& F, const Args& A, const Sched& S, const int (&ts)[9]) {
    const unsigned short* inv = (const unsigned short*)(A.ws + WS_INV); LAS unsigned short* tab = (LAS unsigned short*)(F.lds + ATAB_OFF);
    __syncthreads();
    for (int i = 0; i < ATAB_UNITS; ++i) { pg8::Unit u; if (!S.next(i, u)) break;
        int e = 0;
#pragma unroll
        for (int q = 1; q < 8; ++q) e += (u.pm >= ts[q]) ? 1 : 0;
        int tse = 0;
#pragma unroll
        for (int q = 0; q < 8; ++q) tse = (e == q) ? ts[q] : tse;
        const unsigned cnt = __hip_atomic_load((unsigned*)(F.ctl + CW_CNT + e), __ATOMIC_RELAXED, __HIP_MEMORY_SCOPE_AGENT);
        if (F.tid < 256) { const unsigned r = (unsigned)(u.pm - tse) * 256u + (unsigned)F.tid; tab[i * 256 + F.tid] = (r < cnt) ? inv[(size_t)e * 32768 + r] : (unsigned short)0; } }
    __syncthreads();
}
__device__ __forceinline__ void thin_t5(Frame& F, const Args& A) {
    int ts[9]; moe_tile_starts(F, ts);
    const float* modv = (const float*)(A.ws + WS_MODV); const bf16* Y = (const bf16*)(A.ws + WS_Y); const float* gam = A.in[6] + 7 * D; const unsigned* tok = (const unsigned*)(A.ws + WS_TOK);
    for (int r = F.gw; r < ML; r += F.ngw) {
        const int bs = r / SEQ; const float* mod1 = modv + (size_t)(17 + bs) * 6144;
        const unsigned* t = tok + (size_t)r * 8; const float w0 = __uint_as_float(t[4]), w1 = __uint_as_float(t[5]); const int e0 = (int)t[0], e1 = (int)t[1]; int s0 = 0, s1 = 0;
#pragma unroll
        for (int e = 0; e < 8; ++e) { s0 = (e0 == e) ? ts[e] : s0; s1 = (e1 == e) ? ts[e] : s1; }
        const unsigned p0 = (unsigned)s0 * 256u + t[2], p1 = (unsigned)s1 * 256u + t[3];
        f32x4 h[4], y0[4], y1[4]; ld_row_f32(A.out + (size_t)r * D, F.lane, h); ld_row_bf16(Y + (size_t)p0 * D, F.lane, y0); ld_row_bf16(Y + (size_t)p1 * D, F.lane, y1);
#pragma unroll
        for (int j = 0; j < 4; ++j) y0[j] = y0[j] * w0 + y1[j] * w1;
        gated_add(h, y0, gam, mod1 + 5 * D, F.lane); st_row_f32(A.out + (size_t)r * D, F.lane, h);
    }
}

__device__ __forceinline__ float rope_inv(int f) { return exp2f(-(float)f * (13.287712379549449f / 8.0f)); }
__device__ __forceinline__ void prep_qa(Frame& F, const Args& A) {
    const bf16* Z0 = (const bf16*)(A.ws + WS_Z0C); bf16* QA = (bf16*)(A.ws + WS_QA); bf16* KR = (bf16*)(A.ws + WS_KR);
    for (int r = F.gw; r < MA; r += F.ngw) {
        const bf16* z = Z0 + (size_t)r * 512;
        const v2u cq = *((const GAS v2u*)(z) + F.lane); const unsigned ck = *((const GAS unsigned*)(z + 256) + F.lane);
        const float q0 = bf_lo(cq.x), q1 = bf_hi(cq.x), q2 = bf_lo(cq.y), q3 = bf_hi(cq.y), k0 = bf_lo(ck), k1 = bf_hi(ck);
        const float rq = rsqrtf(wave_sum((q0 * q0 + q1 * q1) + (q2 * q2 + q3 * q3)) * (1.0f / QRANK) + EPS);
        const float rk = rsqrtf(wave_sum(k0 * k0 + k1 * k1) * (1.0f / KVRANK) + EPS);
        v2u oq; oq.x = pk2(q0 * rq, q1 * rq); oq.y = pk2(q2 * rq, q3 * rq);
        *((GAS v2u*)(QA + (size_t)r * KQKV) + F.lane) = oq; *((GAS unsigned*)(QA + (size_t)r * KQKV + QRANK) + F.lane) = pk2(k0 * rk, k1 * rk);
        const int l = F.lane & 31; float v = bf1(z[384 + l]); const float pv = __shfl_xor(v, 8);
        if (r < ML) { const int t = r % SEQ; const float pos = (l < 16) ? (float)(t / 64) : (float)(t % 64); float sn, cs; sincosf(pos * rope_inv(l & 7), &sn, &cs);
            v = (l & 8) ? (v * cs + pv * sn) : (v * cs - pv * sn); }
        if (F.lane < 32) KR[(size_t)r * 32 + l] = (bf16)f2bf(v);
    }
}
__device__ __forceinline__ void rope_q(Frame& F, const Args& A) {
    bf16* Q = (bf16*)(A.ws + WS_Q);
    for (int r = F.gw; r < ML; r += F.ngw) {
        const int t = r % SEQ, hh = F.lane >> 3, sub = F.lane & 7; bf16* p = Q + (size_t)r * 768 + hh * QK + NOPE + sub;
        const float inv = rope_inv(sub); float sr, cr, sc, cc; sincosf((float)(t / 64) * inv, &sr, &cr); sincosf((float)(t % 64) * inv, &sc, &cc);
        const float x0 = bf1(p[0]), x1 = bf1(p[8]), x2 = bf1(p[16]), x3 = bf1(p[24]);
        p[0] = (bf16)f2bf(x0 * cr - x1 * sr); p[8] = (bf16)f2bf(x1 * cr + x0 * sr); p[16] = (bf16)f2bf(x2 * cc - x3 * sc); p[24] = (bf16)f2bf(x3 * cc + x2 * sc);
    }
}
__device__ __forceinline__ int scan_row(int b, int dir, int tau) {
    if (tau < CTXL) return ML + b * CTXL + (dir ? CTXL - 1 - tau : tau);
    const int t = tau - CTXL; return b * SEQ + (dir ? SEQ - 1 - t : t);
}
__device__ __forceinline__ float gelu_tanh(float x) { const float u = 0.7978845608028654f * (x + 0.044715f * x * x * x); const float e = __expf(2.0f * u); const float th = 1.0f - 2.0f / (e + 1.0f); return 0.5f * x * (1.0f + th); }
__device__ __forceinline__ void gen_s5(Frame& F, const Args& A, int g) {
    constexpr int CS = 65;
    LAS float* pw = (LAS float*)F.lds;
    LAS float* cc = pw + 2 * 64 * 17 * 2;
    LAS float* bb = cc + 2 * 16 * CS * 2;
    LAS float* KK = bb + 2 * 64 * 16 * 2;
    LAS float* LL = KK + 2 * 16 * 16 * 16;
    LAS float* DSK = LL + 128 * 4;
    bf16* B1g = (bf16*)(A.ws + WS_B1) + (size_t)g * 256 * 256; bf16* B3g = (bf16*)(A.ws + WS_B3) + (size_t)g * 256 * 512;
    __syncthreads();
    { float lr = 0.f, li = 0.f, dtr = 0.f, dk = 0.f, braw[4], biraw[4], craw[4], ciraw[4];
      if (F.tid < 128) { const int d = F.tid >> 6, p = F.tid & 63, ig = d * S5G + g, i = ig * S5P + p; lr = A.in[8][i]; li = A.in[9][i]; dtr = A.in[10][ig]; }
      if (F.tid < 16) dk = A.in[15][g * 16 + F.tid];
#pragma unroll
      for (int q = 0; q < 4; ++q) { const int idx = F.tid + q * (NWAVES * 64); { const int dp = idx >> 4, h = idx & 15, d = dp >> 6, p = dp & 63; const size_t i = (size_t)((d * S5G + g) * S5P + p); braw[q] = A.in[11][i * 16 + h]; biraw[q] = A.in[12][i * 16 + h]; }
        { const int d = idx >> 10, ho = (idx >> 6) & 15, p = idx & 63; const size_t ci = (size_t)((d * S5G + g) * 16 + ho) * S5P + p; craw[q] = A.in[13][ci]; ciraw[q] = A.in[14][ci]; } }
      if (F.tid < 128) { const float dt = expf(dtr); LL[F.tid * 4] = lr; LL[F.tid * 4 + 1] = li; LL[F.tid * 4 + 2] = lr * dt; LL[F.tid * 4 + 3] = li * dt; }
      if (F.tid < 16) DSK[F.tid] = dk;
#pragma unroll
      for (int q = 0; q < 4; ++q) { const int idx = F.tid + q * (NWAVES * 64); bb[idx * 2] = braw[q]; bb[idx * 2 + 1] = biraw[q];
        { const int d = idx >> 10, ho = (idx >> 6) & 15, p = idx & 63; cc[((d * 16 + ho) * CS + p) * 2] = craw[q]; cc[((d * 16 + ho) * CS + p) * 2 + 1] = ciraw[q]; } } }
    __syncthreads();
    for (int idx = F.tid; idx < 128 * 17; idx += NWAVES * 64) { const int dp = idx / 17, k = idx - dp * 17;
        const float mag = expf((float)k * LL[dp * 4 + 2]), ang = (float)k * LL[dp * 4 + 3]; pw[(dp * 17 + k) * 2] = mag * cosf(ang); pw[(dp * 17 + k) * 2 + 1] = mag * sinf(ang); }
    for (int idx = F.tid; idx < 128 * 16; idx += NWAVES * 64) { const int dp = idx >> 4;
        const float lr = LL[dp * 4], li = LL[dp * 4 + 1], lrdt = LL[dp * 4 + 2], lidt = LL[dp * 4 + 3];
        const float mag = expf(lrdt), ar = mag * cosf(lidt), ai = mag * sinf(lidt), den = lr * lr + li * li, nr = ar - 1.0f;
        const float cr = (nr * lr + ai * li) / den, ci = (ai * lr - nr * li) / den;
        const float br = bb[idx * 2], bi = bb[idx * 2 + 1]; bb[idx * 2] = cr * br - ci * bi; bb[idx * 2 + 1] = cr * bi + ci * br; }
    __syncthreads();
    { const int ho = F.tid & 15, k = (F.tid >> 4) & 15, d = F.tid >> 8;
      float acc[16];
#pragma unroll
      for (int hi = 0; hi < 16; ++hi) acc[hi] = 0.f;
      for (int p = 0; p < 64; ++p) { const float cr = cc[((d * 16 + ho) * CS + p) * 2], ci = cc[((d * 16 + ho) * CS + p) * 2 + 1], pr = pw[((d * 64 + p) * 17 + k) * 2], pi = pw[((d * 64 + p) * 17 + k) * 2 + 1];
          const float wr = cr * pr - ci * pi, wi = cr * pi + ci * pr; const LAS f32x4* bp = (const LAS f32x4*)(bb + (d * 64 + p) * 32);
#pragma unroll
          for (int q = 0; q < 8; ++q) { const f32x4 b4 = bp[q]; acc[2 * q] += wr * b4.x - wi * b4.y; acc[2 * q + 1] += wr * b4.z - wi * b4.w; } }
#pragma unroll
      for (int hi = 0; hi < 16; ++hi) KK[((d * 16 + k) * 16 + ho) * 16 + hi] = acc[hi]; }
    __syncthreads();
    for (int it = F.tid; it < 256 * 32; it += NWAVES * 64) { const int n = it >> 5, kk0 = (it & 31) * 8;
        float v3[8], v3b[8], v1[8];
        { const int j = n >> 4, ho = n & 15, i = kk0 >> 4, hi0 = kk0 & 15; const float dsk = DSK[ho];
#pragma unroll
          for (int e8 = 0; e8 < 8; ++e8) { const int hi = hi0 + e8; float val = 0.f;
            if (i <= j) val += KK[((0 * 16 + (j - i)) * 16 + ho) * 16 + hi];
            if (i >= j) val += KK[((1 * 16 + (i - j)) * 16 + ho) * 16 + hi];
            if (i == j && ho == hi) val += dsk;
            v3[e8] = val; }
          const int d = kk0 >> 7, reim = (kk0 >> 6) & 1, p0 = kk0 & 63, e = d ? (16 - j) : (j + 1);
#pragma unroll
          for (int e8 = 0; e8 < 8; ++e8) { const int p = p0 + e8;
            const float cr = cc[((d * 16 + ho) * CS + p) * 2], ci = cc[((d * 16 + ho) * CS + p) * 2 + 1], pr = pw[((d * 64 + p) * 17 + e) * 2], pi = pw[((d * 64 + p) * 17 + e) * 2 + 1];
            v3b[e8] = reim ? -(cr * pi + ci * pr) : (cr * pr - ci * pi); } }
        { const int d = n >> 7, reim = (n >> 6) & 1, p = n & 63, i = kk0 >> 4, hi0 = kk0 & 15, e = d ? i : (15 - i);
          const float pr = pw[((d * 64 + p) * 17 + e) * 2], pi = pw[((d * 64 + p) * 17 + e) * 2 + 1];
#pragma unroll
          for (int e8 = 0; e8 < 8; ++e8) { const int hi = hi0 + e8; const float br = bb[((d * 64 + p) * 16 + hi) * 2], bi = bb[((d * 64 + p) * 16 + hi) * 2 + 1];
            v1[e8] = reim ? (pr * bi + pi * br) : (pr * br - pi * bi); } }
        const v4u w3 = {pk2(v3[0], v3[1]), pk2(v3[2], v3[3]), pk2(v3[4], v3[5]), pk2(v3[6], v3[7])}, w3b = {pk2(v3b[0], v3b[1]), pk2(v3b[2], v3b[3]), pk2(v3b[4], v3b[5]), pk2(v3b[6], v3b[7])};
        const v4u w1 = {pk2(v1[0], v1[1]), pk2(v1[2], v1[3]), pk2(v1[4], v1[5]), pk2(v1[6], v1[7])};
        *(GAS v4u*)(B3g + (size_t)n * 512 + kk0) = w3; *(GAS v4u*)(B3g + (size_t)n * 512 + 256 + kk0) = w3b; *(GAS v4u*)(B1g + (size_t)n * 256 + kk0) = w1; }
    __syncthreads();
}
__device__ __forceinline__ void s5_scan(Frame& F, const Args& A) {
    if (F.wave < 4) {
        const float* DS = (const float*)(A.ws + WS_DS); bf16* A3 = (bf16*)(A.ws + WS_A3); const int p = F.lane;
        for (int task = blockIdx.x * 4 + F.wave; task < NB * S5G * 2; task += F.G * 4) {
            const int d = task & 1, g = (task >> 1) & 31, b = task >> 6, ig = d * S5G + g;
            const float lr = A.in[8][ig * S5P + p], li = A.in[9][ig * S5P + p], dt = expf(A.in[10][ig]);
            const float m16 = expf(16.0f * lr * dt), a16r = m16 * cosf(16.0f * li * dt), a16i = m16 * sinf(16.0f * li * dt);
            const float* ds = DS + (size_t)(g * 16 + b) * 144 * 256 + d * 128 + p; bf16* so = A3 + (size_t)(g * 16 + b) * 144 * 512 + 256 + d * 128 + p;
            float sr = 0.f, si = 0.f;
            for (int blk = 0; blk < 9; ++blk) {
                const int cbase = d ? (blk == 0 ? 15 : 143 - (blk - 1) * 16) : blk * 16, cstep = d ? -1 : 1;
                float xr[16], xi[16];
#pragma unroll
                for (int s = 0; s < 16; ++s) { const int c = cbase + cstep * s; xr[s] = ds[(size_t)c * 256]; xi[s] = ds[(size_t)c * 256 + 64]; }
#pragma unroll
                for (int s = 0; s < 16; ++s) { const int c = cbase + cstep * s; so[(size_t)c * 512] = (bf16)f2bf(sr); so[(size_t)c * 512 + 64] = (bf16)f2bf(si);
                    const float nsr = a16r * sr - a16i * si + xr[s], nsi = a16r * si + a16i * sr + xi[s]; sr = nsr; si = nsi; }
            }
        }
    }
}
__device__ __forceinline__ void attn_phase(Frame& F, const Args& A) {
    const bf16* Q = (const bf16*)(A.ws + WS_Q); const bf16* KV = (const bf16*)(A.ws + WS_KV); const bf16* KR = (const bf16*)(A.ws + WS_KR); bf16* AO = (bf16*)(A.ws + WS_AO);
    const int bid = (int)blockIdx.x; const int vcu = (F.G % 8 == 0) ? (bid % 8) * (F.G / 8) + bid / 8 : bid;
    for (int u = vcu; u < 1024 + 128; u += F.G) {
        int b, h, qrow0, NT;
        if (u < 1024) { const int bh = u >> 3; b = bh >> 3; h = bh & 7; qrow0 = b * SEQ + (u & 7) * 256; NT = TT / 64; }
        else { const int uu = u - 1024; b = uu >> 3; h = uu & 7; qrow0 = ML + b * CTXL; NT = CTXL / 64; }
        att::attn_unit(Q + (size_t)qrow0 * 768 + h * QK, KV + h * NOPE, KR, KV + 512 + h * VD, ML + b * CTXL, CTXL / 64, b * SEQ, NT, AO + (size_t)qrow0 * D + S5W + h * VD, F.lds, (u < 1024) ? (u & 7) * 256 : -1);
    }
}
__device__ __forceinline__ void gla_prep_phase(Frame& F, const Args& A) {
    for (int j = blockIdx.x; j < NB * GH * 2 * 2; j += F.G) { const int ch = j >> 1, b = ch >> 3, h = (ch >> 1) & 3, dir = ch & 1;
        gla::gla_prep((const bf16*)(A.ws + WS_QK), (const bf16*)(A.ws + WS_VR) + 2048, A.in[27], A.in[28], (bf16*)(A.ws + WS_TQ), (bf16*)(A.ws + WS_TK), (bf16*)(A.ws + WS_TP), (float*)(A.ws + WS_EL),
                      b, h, dir, 18 * (j & 1), 18 * (j & 1) + 18, ML, SEQ, CTXL, F.lds); }
}
__device__ __forceinline__ void gla_chain_phase(Frame& F, const Args& A) {
    const int bid = (int)blockIdx.x; const int vcu = (F.G % 8 == 0) ? (bid % 8) * (F.G / 8) + bid / 8 : bid;
    for (int u = vcu; u < NB * GH * 2 * 2; u += F.G) { const int ch = u >> 1, vh = u & 1, b = ch >> 3, h = (ch >> 1) & 3, dir = ch & 1;
        gla::gla_chain2((const bf16*)(A.ws + WS_VR), (const bf16*)(A.ws + WS_TQ), (const bf16*)(A.ws + WS_TK), (const bf16*)(A.ws + WS_TP), (const float*)(A.ws + WS_EL), (bf16*)(A.ws + (dir ? WS_OB : WS_OF)),
                        b, h, dir, vh, ML, SEQ, CTXL, F.lds); }
}
__device__ __forceinline__ void gla_finish(Frame& F, const Args& A) {
    bf16* OF = (bf16*)(A.ws + WS_OF); const bf16* OB = (const bf16*)(A.ws + WS_OB); const bf16* VR = (const bf16*)(A.ws + WS_VR); const float* hn = A.in[29];
    const f32x4 g = *(const GAS f32x4*)(hn + 4 * F.lane);
    for (int r0 = F.gw; r0 < ML; r0 += 2 * F.ngw) {
        const int r1 = (r0 + F.ngw < ML) ? r0 + F.ngw : r0; const bool two = r1 != r0;
        f32x4 a0[4], b0[4], x0[4], a1[4], b1[4], x1[4];
        ld_row_bf16(OF + (size_t)r0 * D, F.lane, a0); ld_row_bf16(OB + (size_t)r0 * D, F.lane, b0); ld_row_bf16(VR + (size_t)r0 * VRLD + GVAL, F.lane, x0);
        ld_row_bf16(OF + (size_t)r1 * D, F.lane, a1); ld_row_bf16(OB + (size_t)r1 * D, F.lane, b1); ld_row_bf16(VR + (size_t)r1 * VRLD + GVAL, F.lane, x1);
#pragma unroll
        for (int j = 0; j < 4; ++j) { const f32x4 o0 = a0[j] + b0[j], o1 = a1[j] + b1[j];
            const float s0 = wave_sum((o0.x * o0.x + o0.y * o0.y) + (o0.z * o0.z + o0.w * o0.w)), s1 = wave_sum((o1.x * o1.x + o1.y * o1.y) + (o1.z * o1.z + o1.w * o1.w));
            const float rs0 = rsqrtf(s0 * (1.0f / GDV) + EPS), rs1 = rsqrtf(s1 * (1.0f / GDV) + EPS);
#pragma unroll
            for (int i = 0; i < 4; ++i) { const float u0 = x0[j][i], u1 = x1[j][i];
                a0[j][i] = o0[i] * rs0 * g[i] * (u0 * __builtin_amdgcn_rcpf(1.0f + __expf(-u0))); a1[j][i] = o1[i] * rs1 * g[i] * (u1 * __builtin_amdgcn_rcpf(1.0f + __expf(-u1))); } }
        st_row_bf16(OF + (size_t)r0 * D, F.lane, a0); if (two) st_row_bf16(OF + (size_t)r1 * D, F.lane, a1);
    }
}

#ifndef MK_ONE_LAUNCH
#define MK_ONE_LAUNCH 1
#endif
constexpr int NPHASE = 21;
constexpr bool SP2 = true, ALIGN = true;

__global__ void __launch_bounds__(NWAVES * 64, 2) fwd_kernel(Args args) {
    extern __shared__ __attribute__((aligned(16))) unsigned char lds[];
    Frame F;
    F.lds = (LAS unsigned char*)lds;
    F.MISC = (volatile LAS unsigned*)(F.lds + MISC_OFF);
    F.tid = threadIdx.x; F.lane = F.tid & 63; F.wave = __builtin_amdgcn_readfirstlane(F.tid >> 6);
    F.G = gridDim.x; F.gw = blockIdx.x * NWAVES + F.wave; F.ngw = F.G * NWAVES;
    unsigned char* ws = args.ws;
    F.ctl = (gu32*)(ws + WS_CTL);
    for (int u = F.tid; u < (LDS_BYTES - LDSCTL_OFF) / 4; u += NWAVES * 64) ((LAS unsigned*)(F.lds + LDSCTL_OFF))[u] = 0u;
    __syncthreads();
    XcdBarrier bar; bar.bar = (unsigned*)(F.ctl + CW_BAR); bar.x = 0; bar.st = nullptr;
    if (MK_ONE_LAUNCH) bar = xcd_barrier_post((unsigned*)(F.ctl + CW_BAR), F.MISC + 8);
    const int lo = args.ph_lo, hi = args.ph_hi;
#define IN(k) (lo <= (k) && (k) < hi)
#ifdef PROBE_SETA
    if (blockIdx.x == PROBE_BLK && F.tid == 0) { const unsigned long long t_ = __builtin_amdgcn_s_memrealtime(); F.MISC[16] = (unsigned)t_; F.MISC[17] = (unsigned)(t_ >> 32); }
#define PROBE_STAMP(k) do { if (blockIdx.x == PROBE_BLK && F.tid == 0) { const unsigned long long t_ = __builtin_amdgcn_s_memrealtime(); const unsigned long long l_ = ((unsigned long long)F.MISC[17] << 32) | F.MISC[16]; const unsigned d_ = (unsigned)(t_ - l_); \
        if ((PROBE_SETA >> (k)) & 1ull) F.MISC[18] += d_; if ((PROBE_SETB >> (k)) & 1ull) F.MISC[20] += d_; F.MISC[16] = (unsigned)t_; F.MISC[17] = (unsigned)(t_ >> 32); } } while (0)
#else
#define PROBE_STAMP(k) do { } while (0)
#endif
#define SEAM(k) do { if (MK_ONE_LAUNCH && IN(k) && IN((k) + 1)) xcd_barrier(bar); PROBE_STAMP(k); } while (0)
    const int bid = (int)blockIdx.x;

    if (IN(0)) {
#ifndef NO_P0
 p0_prologue(F, args);
#endif
 } SEAM(0);
    if (IN(1)) { thin_t1(F, args); } SEAM(1);
    if (IN(2)) { pg8::Gemm g{(const bf16*)(ws + WS_XL), (const bf16*)(ws + WS_W_IN0), MA, EV_INP, D}; pg8::StaticOrder S; S.init(MA, EV_INP, F.G, bid);
        pg8::EpiIn0 E{(bf16*)(ws + WS_U), (bf16*)(ws + WS_A3), (bf16*)(ws + WS_Z0C)};
        pg8::gemm_phase<pg8::EpiIn0, pg8::StaticOrder, ALIGN, SP2>(F.lds + RING_OFF, g, S, E);
        tail_convert(F, args, (MA / 256) * (EV_INP / 256), MW0, MW1); } SEAM(2);
    if (IN(3)) { prep_qa(F, args);
        int k256 = 256; asm volatile("" : "+s"(k256));
        pg8::Gemm g{(const bf16*)(ws + WS_U), (const bf16*)(ws + WS_B1), 32 * 2304, 256, k256}; pg8::S5Order S{F.G, bid};
        pg8::EpiF32 E{(float*)(ws + WS_DS), 256};
        pg8::gemm_phase<pg8::EpiF32, pg8::S5Order, ALIGN, SP2>(F.lds + RING_OFF, g, S, E); } SEAM(3);
    if (IN(4)) { s5_scan(F, args);
        pg8::Gemm g{(const bf16*)(ws + WS_QA), (const bf16*)(ws + WS_W_QKV), MA, NQKV, KQKV}; pg8::StaticOrder S; S.init(MA, NQKV, F.G, bid);
        pg8::EpiSplit E{(bf16*)(ws + WS_Q), 768, (bf16*)(ws + WS_KV), 1024, 3, 0x7fffffff};
        pg8::gemm_phase<pg8::EpiSplit, pg8::StaticOrder, ALIGN, SP2>(F.lds + RING_OFF, g, S, E); } SEAM(4);
    if (IN(5)) {
        pg8::Gemm g{(const bf16*)(ws + WS_A3), (const bf16*)(ws + WS_B3), 32 * 2304, 256, 512}; pg8::S5Order S{F.G, bid};
        pg8::EpiS5Out E{(bf16*)(ws + WS_AG)};
        pg8::gemm_phase<pg8::EpiS5Out, pg8::S5Order, ALIGN, SP2>(F.lds + RING_OFF, g, S, E); } SEAM(5);
    if (IN(6)) {
#ifndef NO_ATT
 attn_phase(F, args);
#endif
        PROBE_STAMP(21);
        pg8::Gemm g{(const bf16*)(ws + WS_AG), (const bf16*)(ws + WS_W_GLU), MA, S5W, S5W}; pg8::StaticOrder S; S.init(MA, S5W, F.G, bid);
        pg8::EpiGlu E{(const bf16*)(ws + WS_AG), args.in[17], (bf16*)(ws + WS_AO), D};
        pg8::gemm_phase<pg8::EpiGlu, pg8::StaticOrder, ALIGN, SP2, false, false, true>(F.lds + RING_OFF, g, S, E); } SEAM(6);
    if (IN(7)) { pg8::Gemm g{(const bf16*)(ws + WS_AO), (const bf16*)(ws + WS_W_OUT0), MA, D, D}; pg8::StaticOrder S; S.init(MA, D, F.G, bid);
        pg8::EpiPlain E{(bf16*)(ws + WS_YL), D, 0, 0, 1.0f};
        pg8::gemm_phase<pg8::EpiPlain, pg8::StaticOrder, ALIGN, SP2>(F.lds + RING_OFF, g, S, E);
        tail_convert(F, args, (MA / 256) * (D / 256), MW1, MW2); } SEAM(7);
    if (IN(8)) { thin_t2(F, args); } SEAM(8);
    static_assert(!FFN0_IS_FP8, "the e4m3 dense-FFN variant does not carry the MoE weight conversion in its down phase");
    if constexpr (FFN0_IS_FP8) {
    if (IN(9)) { pg8::Gemm g{(const bf16*)(ws + WS_XL), (const bf16*)(ws + WS_W_GU), MA, 2 * FFN, D / 2}; pg8::StaticOrder S; S.init(MA, 2 * FFN, F.G, bid);
        pg8::EpiSwiGlu8 E{ws + WS_ACT, FFN, 0, 1.0f / (FP8_SA * FP8_SW), FP8_SACT, 0};
        pg8::gemm_phase<pg8::EpiSwiGlu8, pg8::StaticOrder, ALIGN, SP2, true>(F.lds + RING_OFF, g, S, E); } SEAM(9);
    if (IN(10)) { pg8::Gemm g{(const bf16*)(ws + WS_ACT), (const bf16*)(ws + WS_W_DN), MA, D, FFN / 2}; pg8::StaticOrder S; S.init(MA, D, F.G, bid);
        pg8::EpiPlain E{(bf16*)(ws + WS_FL), D, 0, 0, 1.0f / (FP8_SACT * FP8_SW)};
        pg8::gemm_phase<pg8::EpiPlain, pg8::StaticOrder, ALIGN, SP2, true>(F.lds + RING_OFF, g, S, E); } SEAM(10);
    } else {
    if (IN(9)) { pg8::Gemm g{(const bf16*)(ws + WS_XL), (const bf16*)(ws + WS_W_GU), MA, 2 * FFN, D}; pg8::StaticOrder S; S.init(MA, 2 * FFN, F.G, bid);
        if constexpr (FFN0_DN_FP8) { pg8::EpiSwiGlu8 E{ws + WS_ACT, FFN, 0, 1.0f, FP8_SACT, 0};
            pg8::gemm_phase<pg8::EpiSwiGlu8, pg8::StaticOrder, ALIGN, SP2>(F.lds + RING_OFF, g, S, E); }
        else { pg8::EpiSwiGlu E{(bf16*)(ws + WS_ACT), FFN, 0, 0};
            pg8::gemm_phase<pg8::EpiSwiGlu, pg8::StaticOrder, ALIGN, SP2>(F.lds + RING_OFF, g, S, E); }
        tail_convert(F, args, (MA / 256) * (2 * FFN / 256), MW2, MW3); } SEAM(9);
    if (IN(10)) { pg8::StaticOrder S; S.init(MA, D, F.G, bid);
        if constexpr (FFN0_DN_FP8) { pg8::Gemm g{(const bf16*)(ws + WS_ACT), (const bf16*)(ws + WS_W_DN), MA, D, FFN / 2};
            pg8::EpiPlain E{(bf16*)(ws + WS_FL), D, 0, 0, 1.0f / (FP8_SACT * FP8_SW)};
            pg8::gemm_phase<pg8::EpiPlain, pg8::StaticOrder, ALIGN, SP2, true>(F.lds + RING_OFF, g, S, E); }
        else { pg8::Gemm g{(const bf16*)(ws + WS_ACT), (const bf16*)(ws + WS_W_DN), MA, D, FFN};
            pg8::EpiPlain E{(bf16*)(ws + WS_FL), D, 0, 0, 1.0f};
            pg8::gemm_phase<pg8::EpiPlain, pg8::StaticOrder, ALIGN, SP2>(F.lds + RING_OFF, g, S, E); }
        tail_convert(F, args, (MA / 256) * (D / 256), MW3, MW4); } SEAM(10);
    }
    if (IN(11)) { thin_t3(F, args); } SEAM(11);
    if (IN(12)) { pg8::Gemm g{(const bf16*)(ws + WS_XL), (const bf16*)(ws + WS_W_IN1), MA, OD_INP, D}; pg8::StaticOrder S; S.init(MA, OD_INP, F.G, bid);
        pg8::EpiSplit E{(bf16*)(ws + WS_QK), 1024, (bf16*)(ws + WS_VR), VRLD, 4, 0x7fffffff};
        pg8::gemm_phase<pg8::EpiSplit, pg8::StaticOrder, ALIGN, SP2>(F.lds + RING_OFF, g, S, E);
        tail_convert(F, args, (MA / 256) * (OD_INP / 256), MW4, MW5); } SEAM(12);
    if (IN(13)) {
#ifndef NO_GLA
 gla_prep_phase(F, args);
#endif
    } SEAM(13);
    if (IN(14)) {
#ifndef NO_GLA
 gla_chain_phase(F, args);
#endif
    } SEAM(14);
    if (IN(15)) { gla_finish(F, args); } SEAM(15);
    if (IN(16)) { pg8::Gemm g{(const bf16*)(ws + WS_OF), (const bf16*)(ws + WS_W_OUT1), ML, D, D}; pg8::StaticOrder S; S.init(ML, D, F.G, bid);
        pg8::EpiPlain E{(bf16*)(ws + WS_YL1), D, 0, 0, 1.0f};
        pg8::gemm_phase<pg8::EpiPlain, pg8::StaticOrder, ALIGN, SP2>(F.lds + RING_OFF, g, S, E); } SEAM(16);
    if (IN(17)) { thin_t4(F, args); } SEAM(17);
    if (lo < 20 && hi > 18) {
        int ts[9]; moe_tile_starts(F, ts); const int NT = ts[8];
        if (IN(18)) { pg8::MoeOrder S{0, NT, 2 * FE / 256, F.G, bid, ts[1], ts[2], ts[3], ts[4], ts[5], ts[6], ts[7], 0};
            moe_row_table(F, args, S, ts);
            pg8::Gemm g{(const bf16*)(ws + WS_XLM), (const bf16*)(ws + WS_W_MGU), ML, 2 * FE, D / 2, (const LAS unsigned short*)(F.lds + ATAB_OFF)};
            pg8::EpiSwiGlu8 E{ws + WS_ACTM, FE, 2 * FE / 256, 1.0f / (FP8_SA * FP8_SW), FP8_SACT, 1};
            pg8::gemm_phase<pg8::EpiSwiGlu8, pg8::MoeOrder, ALIGN, SP2, true, false, false, true>(F.lds + RING_OFF, g, S, E); } SEAM(18);
        if (IN(19)) { pg8::Gemm g{(const bf16*)(ws + WS_ACTM), (const bf16*)(ws + WS_W_MDN), MOE_MAXT * 256, D, FE / 2};
            pg8::MoeOrder S{0, NT, D / 256, F.G, bid, ts[1], ts[2], ts[3], ts[4], ts[5], ts[6], ts[7], 1};
            pg8::EpiPlain E{(bf16*)(ws + WS_Y), D, 0, D / 256, 1.0f / (FP8_SACT * FP8_SW)};
            pg8::gemm_phase<pg8::EpiPlain, pg8::MoeOrder, ALIGN, SP2, true, true>(F.lds + RING_OFF, g, S, E); } SEAM(19);
    }
    if (IN(20)) { thin_t5(F, args); }
#ifdef PROBE_SETA
    PROBE_STAMP(20);
    if (blockIdx.x == PROBE_BLK && F.tid == 0) {
        unsigned long long qa = F.MISC[18] / 100u, qb = F.MISC[20] / 1000u; qa = qa > 999 ? 999 : qa; qb = qb > 99 ? 99 : qb;
        const unsigned long long t0 = __builtin_amdgcn_s_memrealtime(), dl = qa * 1000ull + qb * 1000000ull;
        while (__builtin_amdgcn_s_memrealtime() - t0 < dl) __builtin_amdgcn_s_sleep(32);
    }
#endif
#undef IN
#undef SEAM
}

extern "C" void kernel_launch(void* const* d_in, const int* in_sizes, int n_in, void* d_out, int out_size, void* d_ws, size_t ws_size, hipStream_t stream) {
    static int grid = 0;
    if (grid == 0) {
        if (n_in != 35 || out_size != ML * D || ws_size < WS_END) { fprintf(stderr, "kernel_launch: unexpected shapes: n_in %d out %d ws %zu (need %zu)\n", n_in, out_size, ws_size, (size_t)WS_END); grid = -1; return; }
        int dev = 0, cus = 0, per_cu = 0;
        if (hipGetDevice(&dev) != hipSuccess || hipDeviceGetAttribute(&cus, hipDeviceAttributeMultiprocessorCount, dev) != hipSuccess) { grid = -1; return; }
        if (hipFuncSetAttribute((const void*)fwd_kernel, hipFuncAttributeMaxDynamicSharedMemorySize, LDS_BYTES) != hipSuccess) { fprintf(stderr, "kernel_launch: hipFuncSetAttribute failed\n"); grid = -1; return; }
        if (hipOccupancyMaxActiveBlocksPerMultiprocessor(&per_cu, (const void*)fwd_kernel, NWAVES * 64, LDS_BYTES) != hipSuccess || per_cu < 1) { fprintf(stderr, "kernel_launch: occupancy query reports %d blocks per CU\n", per_cu); }
        (void)hipGetLastError();
        grid = cus;
    }
    if (grid < 0) return;
    (void)hipMemsetAsync((char*)d_ws + WS_CTL, 0, CTL_ZERO_BYTES, stream);
    Args a{};
    for (int i = 0; i < 35; ++i) a.in[i] = (const float*)d_in[i];
    a.out = (float*)d_out; a.ws = (unsigned char*)d_ws;
#if MK_ONE_LAUNCH
    a.ph_lo = 0; a.ph_hi = NPHASE;
    hipLaunchKernelGGL(fwd_kernel, dim3(grid), dim3(NWAVES * 64), LDS_BYTES, stream, a);
#else
    for (int p = 0; p < NPHASE; ++p) { a.ph_lo = p; a.ph_hi = p + 1; hipLaunchKernelGGL(fwd_kernel, dim3(grid), dim3(NWAVES * 64), LDS_BYTES, stream, a); }
#endif
}
```

```cpp
#include <hip/hip_runtime.h>
#include <cstdio>
#include <cstdint>
#define MK_ONE_LAUNCH 1
namespace pg8 {
#define PG8_LAS __attribute__((address_space(3)))
typedef unsigned short bf16_t;
typedef short bf16x8 __attribute__((ext_vector_type(8)));
typedef float f32x4 __attribute__((ext_vector_type(4)));
typedef unsigned u32x4 __attribute__((ext_vector_type(4)));
constexpr int BM = 256, BK = 64, HALF = 128, HTB = HALF * BK * 2  , STAGE_BYTES = 8 * HTB, NXCD = 8, WGM = 8;

__host__ __device__ __forceinline__ int lds_byte(int r, int c) { const int st = (r >> 4) * 2 + (c >> 5), rr = r & 15, cc = c & 31, ob = rr * 64 + cc * 2; return st * 1024 + (ob ^ (((ob >> 9) & 1) << 5)); }
__host__ __device__ __forceinline__ void stage_rc(int b, int& R, int& C) { const int st = b / 1024, sb = b % 1024, swz = sb ^ (((sb >> 9) & 1) << 5); R = (st >> 1) * 16 + swz / 64; C = (st & 1) * 32 + (swz % 64) / 2; }
__host__ __device__ __forceinline__ int perm32(int rho) { const int n = rho >> 4, i = rho & 15; return 8 * (i >> 2) + 4 * n + (i & 3); }

struct Unit { int pm, pn; };
struct Gemm { const bf16_t* A; const bf16_t* Bt; int M, N, K; const PG8_LAS unsigned short* atab = nullptr; };
constexpr unsigned ACH_GS = 2304u * 256u * 2u;

struct StaticOrder {
    int nM, nN, nwg, G, c;
    __host__ __device__ void init(int M, int N, int G_, int c_) { nM = M / BM; nN = N / BM; nwg = nM * nN; G = G_; c = c_; }
    __host__ __device__ bool next(int i, Unit& u) const {
        const long L = (long)i * G + c; if (L >= nwg) return false;
        int wgid = (int)L; { const int q = nwg / NXCD, r = nwg % NXCD, xcd = wgid % NXCD, off = wgid / NXCD; wgid = (xcd < r ? xcd * (q + 1) : r * (q + 1) + (xcd - r) * q) + off; }
        const int nig = WGM * nN, gid = wgid / nig, fm = gid * WGM, gsz = (nM - fm) < WGM ? (nM - fm) : WGM;
        u.pm = fm + ((wgid % nig) % gsz); u.pn = (wgid % nig) / gsz; return true;
    }
    __device__ __forceinline__ void a_ready(const Unit&) const {}
    __device__ __forceinline__ void done(const Unit&) const {}
};

__device__ __forceinline__ unsigned cvt_pk_bf16(float lo, float hi) { unsigned r; asm volatile("v_cvt_pk_bf16_f32 %0, %1, %2" : "=v"(r) : "v"(lo), "v"(hi)); return r; }
typedef float f32x2 __attribute__((ext_vector_type(2)));
__device__ __forceinline__ u32x4 pack8(const f32x4 v0, const f32x4 v1) { u32x4 w; w.x = cvt_pk_bf16(v0[0], v0[1]); w.y = cvt_pk_bf16(v0[2], v0[3]); w.z = cvt_pk_bf16(v1[0], v1[1]); w.w = cvt_pk_bf16(v1[2], v1[3]); return w; }
__device__ __forceinline__ float bf_lo(unsigned u) { return __uint_as_float(u << 16); }
__device__ __forceinline__ float bf_hi(unsigned u) { return __uint_as_float(u & 0xffff0000u); }
__device__ __forceinline__ unsigned pk4_fp8(float a, float b, float c, float d) {
    a = __builtin_amdgcn_fmed3f(a, -448.f, 448.f); b = __builtin_amdgcn_fmed3f(b, -448.f, 448.f); c = __builtin_amdgcn_fmed3f(c, -448.f, 448.f); d = __builtin_amdgcn_fmed3f(d, -448.f, 448.f);
    int r = __builtin_amdgcn_cvt_pk_fp8_f32(a, b, 0, false); r = __builtin_amdgcn_cvt_pk_fp8_f32(c, d, r, true); return (unsigned)r; }
__device__ __forceinline__ float sigmoid_f(float x) { return __builtin_amdgcn_rcpf(1.0f + __builtin_amdgcn_exp2f(-1.4426950408889634f * x)); }

struct EpiPlain {
    static constexpr bool PERM = true, AFTER_DRAIN = false;
    bf16_t* O; int ldc; int pm_off; int nmod; float sc;
    __device__ __forceinline__ void operator()(const f32x4 (&acc)[2][2][4][2], const Unit& u, int wr, int wc, int fr, int fq) const {
        const int row0 = (u.pm - pm_off) * BM + wr * 64 + fr; const int ct = nmod ? (u.pn % nmod) : u.pn; const int col0 = ct * BM + wc * 32 + 8 * fq;
#pragma unroll
        for (int ai = 0; ai < 2; ++ai)
#pragma unroll
            for (int m = 0; m < 4; ++m) { bf16_t* rowp = O + (size_t)(row0 + ai * HALF + m * 16) * ldc + col0;
#pragma unroll
                for (int bj = 0; bj < 2; ++bj) *(u32x4*)(rowp + bj * HALF) = pack8(acc[ai][bj][m][0] * sc, acc[ai][bj][m][1] * sc); }
    }
};
struct EpiSplit {
    static constexpr bool PERM = true, AFTER_DRAIN = false;
    bf16_t* O0; int ld0; bf16_t* O1; int ld1; int nsplit; int ncols1;
    __device__ __forceinline__ void operator()(const f32x4 (&acc)[2][2][4][2], const Unit& u, int wr, int wc, int fr, int fq) const {
        const int row0 = u.pm * BM + wr * 64 + fr; const bool first = u.pn < nsplit;
        bf16_t* base = first ? O0 : O1; const int ld = first ? ld0 : ld1; const int col0 = (first ? u.pn : u.pn - nsplit) * BM + wc * 32 + 8 * fq; const int lim = first ? 0x7fffffff : ncols1;
#pragma unroll
        for (int ai = 0; ai < 2; ++ai)
#pragma unroll
            for (int m = 0; m < 4; ++m) { bf16_t* rowp = base + (size_t)(row0 + ai * HALF + m * 16) * ld + col0;
#pragma unroll
                for (int bj = 0; bj < 2; ++bj) if (col0 + bj * HALF < lim) *(u32x4*)(rowp + bj * HALF) = pack8(acc[ai][bj][m][0], acc[ai][bj][m][1]); }
    }
};
struct EpiGlu {
    static constexpr bool PERM = true, AFTER_DRAIN = false;
    const bf16_t* Aa; const float* bias; bf16_t* O; int ldc;
    __device__ __forceinline__ void operator()(const f32x4 (&acc)[2][2][4][2], const Unit& u, int wr, int wc, int fr, int fq) const {
        const int row0 = u.pm * BM + wr * 64 + fr; const int col0 = u.pn * BM + wc * 32 + 8 * fq;
        const int crow0 = (u.pm < 128 ? (u.pm >> 3) * 144 + 16 + (u.pm & 7) * 16 : (u.pm - 128) * 144) + wr * 4;
#pragma unroll
        for (int bj = 0; bj < 2; ++bj) { const f32x4 b0 = *(const f32x4*)(bias + col0 + bj * HALF), b1 = *(const f32x4*)(bias + col0 + bj * HALF + 4);
            const int cg = (col0 + bj * HALF) >> 4, ch = (col0 + bj * HALF) & 15;
#pragma unroll
            for (int ai = 0; ai < 2; ++ai)
#pragma unroll
                for (int m = 0; m < 4; ++m) { const size_t r = (size_t)(row0 + ai * HALF + m * 16);
                    const u32x4 a8 = *(const u32x4*)(Aa + (size_t)cg * (2304 * 256) + (size_t)(crow0 + ai * 8 + m) * 256 + fr * 16 + ch);
                    f32x4 v0 = acc[ai][bj][m][0] + b0, v1 = acc[ai][bj][m][1] + b1;
                    v0[0] = bf_lo(a8.x) * sigmoid_f(v0[0]); v0[1] = bf_hi(a8.x) * sigmoid_f(v0[1]); v0[2] = bf_lo(a8.y) * sigmoid_f(v0[2]); v0[3] = bf_hi(a8.y) * sigmoid_f(v0[3]);
                    v1[0] = bf_lo(a8.z) * sigmoid_f(v1[0]); v1[1] = bf_hi(a8.z) * sigmoid_f(v1[1]); v1[2] = bf_lo(a8.w) * sigmoid_f(v1[2]); v1[3] = bf_hi(a8.w) * sigmoid_f(v1[3]);
                    *(u32x4*)(O + r * ldc + col0 + bj * HALF) = pack8(v0, v1); } }
    }
};
struct EpiSwiGlu {
    static constexpr bool PERM = true, AFTER_DRAIN = false;
    bf16_t* O; int ldc; int pm_off; int nmod;
    __device__ __forceinline__ void operator()(const f32x4 (&acc)[2][2][4][2], const Unit& u, int wr, int wc, int fr, int fq) const {
        const int row0 = (u.pm - pm_off) * BM + wr * 64 + fr; const int ct = nmod ? (u.pn % nmod) : u.pn; const int col0 = ct * HALF + wc * 32 + 8 * fq;
#pragma unroll
        for (int ai = 0; ai < 2; ++ai)
#pragma unroll
            for (int m = 0; m < 4; ++m) { f32x4 o0, o1;
#pragma unroll
                for (int i = 0; i < 4; ++i) { const float g0 = acc[ai][0][m][0][i], g1 = acc[ai][0][m][1][i]; o0[i] = g0 * sigmoid_f(g0) * acc[ai][1][m][0][i]; o1[i] = g1 * sigmoid_f(g1) * acc[ai][1][m][1][i]; }
                *(u32x4*)(O + (size_t)(row0 + ai * HALF + m * 16) * ldc + col0) = pack8(o0, o1); }
    }
};
struct EpiIn0 {
    static constexpr bool PERM = true, AFTER_DRAIN = false;
    bf16_t* U; bf16_t* A3; bf16_t* Z0c;
    __device__ __forceinline__ void operator()(const f32x4 (&acc)[2][2][4][2], const Unit& u, int wr, int wc, int fr, int fq) const {
        if (u.pn >= 2) {
            const int row0 = u.pm * BM + wr * 64 + fr, col0 = (u.pn - 2) * BM + wc * 32 + 8 * fq;
#pragma unroll
            for (int ai = 0; ai < 2; ++ai)
#pragma unroll
                for (int m = 0; m < 4; ++m) { bf16_t* rowp = Z0c + (size_t)(row0 + ai * HALF + m * 16) * 512 + col0;
#pragma unroll
                    for (int bj = 0; bj < 2; ++bj) *(u32x4*)(rowp + bj * HALF) = pack8(acc[ai][bj][m][0], acc[ai][bj][m][1]); }
        } else {
            const int b = (u.pm < 128) ? (u.pm >> 3) : (u.pm - 128); const int c0 = (u.pm < 128) ? (16 + (u.pm & 7) * 16) : 0;
            const int g0 = u.pn * 16 + wc * 2 + (fq >> 1);
            const size_t r0 = (size_t)(g0 * 16 + b) * 144 + c0 + wr * 4;
            const int cc = fr * 16 + 8 * (fq & 1);
#pragma unroll
            for (int ai = 0; ai < 2; ++ai)
#pragma unroll
                for (int m = 0; m < 4; ++m)
#pragma unroll
                    for (int bj = 0; bj < 2; ++bj) { const size_t r = r0 + (size_t)bj * (8 * 16 * 144) + ai * 8 + m; const u32x4 w = pack8(acc[ai][bj][m][0], acc[ai][bj][m][1]);
                        *(u32x4*)(U + r * 256 + cc) = w; *(u32x4*)(A3 + r * 512 + cc) = w; }
        }
    }
};
struct EpiF32 {
    static constexpr bool PERM = false, AFTER_DRAIN = false;
    float* C; int ldc;
    __device__ __forceinline__ void operator()(const f32x4 (&acc)[2][2][4][2], const Unit& u, int wr, int wc, int fr, int fq) const {
        const int row0 = u.pm * BM + wr * 64 + fr, col0 = wc * 32 + 4 * fq;
#pragma unroll
        for (int ai = 0; ai < 2; ++ai)
#pragma unroll
            for (int m = 0; m < 4; ++m) { float* rowp = C + (size_t)(row0 + ai * HALF + m * 16) * ldc + col0;
#pragma unroll
                for (int bj = 0; bj < 2; ++bj)
#pragma unroll
                    for (int n = 0; n < 2; ++n) *(f32x4*)(rowp + bj * HALF + n * 16) = acc[ai][bj][m][n]; }
    }
};
__device__ __forceinline__ float gelu_tanh_f(float x) { const float t = 0.7978845608028654f * (x + 0.044715f * x * x * x); const float e = __builtin_amdgcn_exp2f(2.8853900817779268f * t); return x - x * __builtin_amdgcn_rcpf(e + 1.0f); }
struct EpiS5Out {
    static constexpr bool PERM = true, AFTER_DRAIN = false;
    bf16_t* AG;
    __device__ __forceinline__ void operator()(const f32x4 (&acc)[2][2][4][2], const Unit& u, int wr, int wc, int fr, int fq) const {
        const int row0 = u.pm * BM + wr * 64 + fr, col0 = wc * 32 + 8 * fq;
#pragma unroll
        for (int ai = 0; ai < 2; ++ai)
#pragma unroll
            for (int m = 0; m < 4; ++m) { bf16_t* rowp = AG + (size_t)(row0 + ai * HALF + m * 16) * 256 + col0;
#pragma unroll
                for (int bj = 0; bj < 2; ++bj) { f32x4 v0 = acc[ai][bj][m][0], v1 = acc[ai][bj][m][1];
#pragma unroll
                    for (int i = 0; i < 4; ++i) { v0[i] = gelu_tanh_f(v0[i]); v1[i] = gelu_tanh_f(v1[i]); }
                    *(u32x4*)(rowp + bj * HALF) = pack8(v0, v1); } }
    }
};
struct S5Order {
    int G, c;
    __device__ __forceinline__ bool next(int i, Unit& u) const { const int L = i * G + c; if (L >= 32 * 9) return false; u.pm = L; u.pn = L / 9; return true; }
    __device__ __forceinline__ void a_ready(const Unit&) const {}
    __device__ __forceinline__ void done(const Unit&) const {}
};
struct EpiSwiGlu8 {
    static constexpr bool PERM = true, AFTER_DRAIN = false;
    unsigned char* O; int ldc; int nmod; float us, os; int tiled;
    __device__ __forceinline__ void operator()(const f32x4 (&acc)[2][2][4][2], const Unit& u, int wr, int wc, int fr, int fq) const {
        const int row0 = u.pm * BM + wr * 64 + fr; const int ct = nmod ? (u.pn % nmod) : u.pn; const int col0 = ct * HALF + wc * 32 + 8 * fq;
        typedef unsigned u32x2_ __attribute__((ext_vector_type(2)));
#pragma unroll
        for (int ai = 0; ai < 2; ++ai)
#pragma unroll
            for (int m = 0; m < 4; ++m) { f32x4 o0, o1;
#pragma unroll
                for (int i = 0; i < 4; ++i) { const float g0 = acc[ai][0][m][0][i] * us, g1 = acc[ai][0][m][1][i] * us; o0[i] = g0 * sigmoid_f(g0) * (acc[ai][1][m][0][i] * us) * os; o1[i] = g1 * sigmoid_f(g1) * (acc[ai][1][m][1][i] * us) * os; }
                u32x2_ w; w.x = pk4_fp8(o0[0], o0[1], o0[2], o0[3]); w.y = pk4_fp8(o1[0], o1[1], o1[2], o1[3]);
                const int rr = wr * 64 + fr + ai * HALF + m * 16;
                if (tiled) *(u32x2_*)(O + (size_t)u.pm * BM * ldc + (size_t)ct * (BM * 128) + rr * 128 + wc * 32 + 8 * fq) = w;
                else *(u32x2_*)(O + (size_t)(row0 + ai * HALF + m * 16) * ldc + col0) = w; }
    }
};
struct MoeOrder {
    int t0, nT, nN, G, c; int e1, e2, e3, e4, e5, e6, e7; int rev;
    __device__ __forceinline__ bool next(int i, Unit& u) const {
        const int nwg = nT * nN; const long L = (long)i * G + c; if (L >= nwg) return false;
        int wgid = (int)L; { const int q = nwg / NXCD, r = nwg % NXCD, xcd = wgid % NXCD, off = wgid / NXCD, sz = xcd < r ? q + 1 : q; wgid = (xcd < r ? xcd * (q + 1) : r * (q + 1) + (xcd - r) * q) + (rev ? sz - 1 - off : off); }
        const int nig = WGM * nN, gid = wgid / nig, fm = gid * WGM, gsz = (nT - fm) < WGM ? (nT - fm) : WGM;
        const int pm = t0 + fm + ((wgid % nig) % gsz), pn = (wgid % nig) / gsz;
        const int e = (pm >= e1) + (pm >= e2) + (pm >= e3) + (pm >= e4) + (pm >= e5) + (pm >= e6) + (pm >= e7);
        u.pm = pm; u.pn = e * nN + pn; return true;
    }
    __device__ __forceinline__ void a_ready(const Unit&) const {}
    __device__ __forceinline__ void done(const Unit&) const {}
};
template <class Epi, class Sched, bool ALIGN_EPI = false, bool SP2 = false, bool FP8 = false, bool TILED = false, bool ACHUNK = false, bool AGATHER = false>
__device__ __forceinline__ void gemm_phase(PG8_LAS unsigned char* lds, const Gemm g, const Sched& S, const Epi& E) {
    const int tid = threadIdx.x, wid = __builtin_amdgcn_readfirstlane(tid >> 6), lane = tid & 63, wr = wid >> 2, wc = wid & 3, fr = lane & 15, fq = lane >> 4;
    const int K = g.K, nt = K / BK;
    unsigned voffA[2], voffB[2];
#pragma unroll
    for (int i = 0; i < 2; ++i) { int R, C; stage_rc(tid * 16 + i * 8192, R, C); const int Rb = Epi::PERM ? ((R & ~31) + perm32(R & 31)) : R;
        voffA[i] = TILED ? (unsigned)(R * BK + C) * 2u : (unsigned)(R * K + C) * 2u; voffB[i] = TILED ? (unsigned)(Rb * BK + C) * 2u : (unsigned)(Rb * K + C) * 2u;
        if (ACHUNK) voffA[i] = (unsigned)((R >> 4) * 512 + (R & 15) * 32 + (C & 15) * 2) + (unsigned)(C >> 4) * ACH_GS; }
    const size_t kstep = TILED ? (size_t)(BM * BK * 2) : (size_t)(BK * 2);
    const size_t hstep = TILED ? (size_t)(HALF * BK * 2) : (size_t)HALF * K * 2;
    const size_t tstep = (size_t)BM * K * 2;
    const size_t kstepA = ACHUNK ? (size_t)4 * ACH_GS : kstep, hstepA = ACHUNK ? (size_t)4096 : hstep;
#define PG8_ABASE(pm_) (AGATHER ? (const char*)g.A : ACHUNK ? (const char*)g.A + (size_t)((pm_) < 128 ? ((pm_) >> 3) * 144 + 16 + ((pm_) & 7) * 16 : ((pm_) - 128) * 144) * 512 : (const char*)g.A + (size_t)(pm_) * tstep)
    const unsigned ldsw = (unsigned)wid * 1024u;
    const int aoff = lds_byte(wr * 64 + fr, fq * 8), boff = lds_byte(wc * 32 + fr, fq * 8);
#define PG8_SA(b, h) (((b) * 2 + (h)) * HTB)
#define PG8_SB(b, h) ((4 + (b) * 2 + (h)) * HTB)
#define PG8_STAGE(bufoff, gbase, voff) do { _Pragma("unroll") for (int _i = 0; _i < 2; ++_i) \
        __builtin_amdgcn_global_load_lds((const unsigned*)((const char*)(gbase) + (voff)[_i]), (PG8_LAS unsigned*)(lds + (bufoff) + ldsw + _i * 8192), 16, 0, 0); } while (0)
    static_assert(!AGATHER || SP2, "AGATHER is written for the SP2 loop");
    unsigned gvA0[2] = {0u, 0u}, gvA1[2] = {0u, 0u}, gnA0[2] = {0u, 0u}, gnA1[2] = {0u, 0u};
#define PG8_GLOAD(uidx, v0, v1) do { _Pragma("unroll") for (int i_ = 0; i_ < 2; ++i_) { int R_, C_; stage_rc(tid * 16 + i_ * 8192, R_, C_); \
        const unsigned t0_ = g.atab[(uidx) * 256 + R_], t1_ = g.atab[(uidx) * 256 + 128 + R_]; v0[i_] = t0_ * (unsigned)(2 * K) + (unsigned)C_ * 2u; v1[i_] = t1_ * (unsigned)(2 * K) + (unsigned)C_ * 2u; } } while (0)
#define PG8_STAGE_A(bufoff, gbase, half, nx) do { if constexpr (AGATHER) { unsigned vs_[2]; \
        vs_[0] = (nx) ? ((half) ? gnA1[0] : gnA0[0]) : ((half) ? gvA1[0] : gvA0[0]); vs_[1] = (nx) ? ((half) ? gnA1[1] : gnA0[1]) : ((half) ? gvA1[1] : gvA0[1]); PG8_STAGE(bufoff, gbase, vs_); } \
        else PG8_STAGE(bufoff, (gbase) + ((half) ? hstepA : (size_t)0), voffA); } while (0)
#define PG8_LDA(dst, b, h) do { _Pragma("unroll") for (int m = 0; m < 4; ++m) _Pragma("unroll") for (int k = 0; k < 2; ++k) dst[m][k] = *(const PG8_LAS bf16x8*)(lds + PG8_SA(b, h) + aoff + m * 2048 + k * 1024); } while (0)
#define PG8_LDB(dst, b, h) do { _Pragma("unroll") for (int n = 0; n < 2; ++n) _Pragma("unroll") for (int k = 0; k < 2; ++k) dst[n][k] = *(const PG8_LAS bf16x8*)(lds + PG8_SB(b, h) + boff + n * 2048 + k * 1024); } while (0)
#define PG8_MMA(ai, bj, At, Bt) do { __builtin_amdgcn_s_setprio(1); _Pragma("unroll") for (int m = 0; m < 4; ++m) _Pragma("unroll") for (int n = 0; n < 2; ++n) { \
        if constexpr (FP8) { typedef int i32x4_ __attribute__((ext_vector_type(4))); typedef int i32x8_ __attribute__((ext_vector_type(8))); \
            const i32x8_ bo_ = __builtin_shufflevector(__builtin_bit_cast(i32x4_, Bt[n][0]), __builtin_bit_cast(i32x4_, Bt[n][1]), 0, 1, 2, 3, 4, 5, 6, 7); \
            const i32x8_ ao_ = __builtin_shufflevector(__builtin_bit_cast(i32x4_, At[m][0]), __builtin_bit_cast(i32x4_, At[m][1]), 0, 1, 2, 3, 4, 5, 6, 7); \
            asm volatile("v_mfma_f32_16x16x128_f8f6f4 %0, %1, %2, %0" : "+v"(acc[ai][bj][m][n]) : "v"(bo_), "v"(ao_)); } \
        else { _Pragma("unroll") for (int k = 0; k < 2; ++k) acc[ai][bj][m][n] = __builtin_amdgcn_mfma_f32_16x16x32_bf16(Bt[n][k], At[m][k], acc[ai][bj][m][n], 0, 0, 0); } } \
        __builtin_amdgcn_s_setprio(0); } while (0)
#define PG8_WAIT_V(n) asm volatile("s_waitcnt vmcnt(" #n ")" ::: "memory")
#define PG8_WAIT_L(n) asm volatile("s_waitcnt lgkmcnt(" #n ")" ::: "memory")
#define PG8_BAR __builtin_amdgcn_s_barrier()
#define PG8_SCHED __builtin_amdgcn_sched_barrier(0)
    const int fp8_unit_scale_ = 0x7f7f7f7f; (void)fp8_unit_scale_;
    Unit cur, nxt; int ui = 0;
    if (!S.next(0, cur)) return;
    f32x4 acc[2][2][4][2];
#pragma unroll
    for (int a = 0; a < 2; ++a)
#pragma unroll
        for (int b = 0; b < 2; ++b)
#pragma unroll
            for (int m = 0; m < 4; ++m)
#pragma unroll
                for (int n = 0; n < 2; ++n) acc[a][b][m][n] = (f32x4){0.f, 0.f, 0.f, 0.f};
    bf16x8 At[4][2], B0[2][2], B1[2][2];
    const char* cA = PG8_ABASE(cur.pm); const char* cB = (const char*)g.Bt + (size_t)cur.pn * tstep;
    if constexpr (AGATHER) PG8_GLOAD(0, gvA0, gvA1);
    S.a_ready(cur);
    if constexpr (SP2) {
        PG8_STAGE(PG8_SB(0, 0), cB, voffB); PG8_STAGE(PG8_SB(0, 1), cB + hstep, voffB); PG8_STAGE_A(PG8_SA(0, 0), cA, 0, false); PG8_STAGE_A(PG8_SA(0, 1), cA, 1, false);
        if (wr == 1) PG8_BAR;
        PG8_WAIT_V(2); PG8_BAR;
        PG8_STAGE(PG8_SB(1, 0), cB + kstep, voffB); PG8_STAGE_A(PG8_SA(1, 0), cA + kstepA, 0, false); PG8_STAGE(PG8_SB(1, 1), cB + hstep + kstep, voffB);
        PG8_WAIT_V(6); PG8_BAR;
    } else {
        PG8_STAGE(PG8_SB(0, 0), cB, voffB); PG8_STAGE(PG8_SA(0, 0), cA, voffA); PG8_STAGE(PG8_SB(0, 1), cB + hstep, voffB); PG8_STAGE(PG8_SA(0, 1), cA + hstepA, voffA);
        if (wr == 1) PG8_BAR;
        PG8_WAIT_V(4); PG8_BAR;
        PG8_STAGE(PG8_SB(1, 0), cB + kstep, voffB); PG8_STAGE(PG8_SA(1, 0), cA + kstepA, voffA); PG8_STAGE(PG8_SB(1, 1), cB + hstep + kstep, voffB);
        PG8_WAIT_V(6); PG8_BAR;
    }
    for (;;) {
        const bool has_next = S.next(ui + 1, nxt);
        const char* nA = has_next ? PG8_ABASE(nxt.pm) : cA; const char* nB = has_next ? (const char*)g.Bt + (size_t)nxt.pn * tstep : cB;
        for (int t = 0; t < nt; t += 2) {
            const bool last = (t == nt - 2);
            const char* a1 = cA + (size_t)(t + 1) * kstepA;
            const char* a2 = last ? nA : cA + (size_t)(t + 2) * kstepA; const char* b2 = last ? nB : cB + (size_t)(t + 2) * kstep;
            const char* a3 = a2 + kstepA; const char* b3 = b2 + kstep;
            if (last && has_next) S.a_ready(nxt);
            const bool nx_ = last && has_next;
            if constexpr (AGATHER) { if (nx_) PG8_GLOAD(ui + 1, gnA0, gnA1); }
            if constexpr (SP2) {
            PG8_LDB(B0, 0, 0); PG8_LDB(B1, 0, 1); PG8_SCHED; PG8_LDA(At, 0, 0); PG8_STAGE_A(PG8_SA(1, 1), a1, 1, false);
            PG8_WAIT_V(8); PG8_WAIT_L(0); PG8_BAR; PG8_MMA(0, 0, At, B0); PG8_MMA(0, 1, At, B1); PG8_BAR; PG8_SCHED;
            PG8_LDA(At, 0, 1); PG8_STAGE(PG8_SB(0, 0), b2, voffB); PG8_STAGE(PG8_SB(0, 1), b2 + hstep, voffB); PG8_STAGE_A(PG8_SA(0, 0), a2, 0, nx_);
            PG8_WAIT_V(8); PG8_WAIT_L(0); PG8_BAR; PG8_MMA(1, 0, At, B0); PG8_MMA(1, 1, At, B1); PG8_BAR; PG8_SCHED;
            PG8_LDB(B0, 1, 0); PG8_LDB(B1, 1, 1); PG8_SCHED; PG8_LDA(At, 1, 0); PG8_STAGE_A(PG8_SA(0, 1), a2, 1, nx_);
            PG8_WAIT_V(8); PG8_WAIT_L(0); PG8_BAR; PG8_MMA(0, 0, At, B0); PG8_MMA(0, 1, At, B1); PG8_BAR; PG8_SCHED;
            PG8_LDA(At, 1, 1); PG8_STAGE(PG8_SB(1, 0), b3, voffB); PG8_STAGE(PG8_SB(1, 1), b3 + hstep, voffB); PG8_STAGE_A(PG8_SA(1, 0), a3, 0, nx_);
            PG8_WAIT_V(8); PG8_WAIT_L(0); PG8_BAR; PG8_MMA(1, 0, At, B0); PG8_MMA(1, 1, At, B1); PG8_BAR; PG8_SCHED;
            } else {
            PG8_LDB(B0, 0, 0); PG8_SCHED; PG8_LDA(At, 0, 0); PG8_STAGE(PG8_SA(1, 1), a1 + hstepA, voffA);
            PG8_WAIT_L(8); PG8_BAR; PG8_WAIT_L(0); PG8_MMA(0, 0, At, B0); PG8_BAR; PG8_SCHED;
            PG8_LDB(B1, 0, 1); PG8_STAGE(PG8_SB(0, 0), b2, voffB);
            PG8_BAR; PG8_WAIT_L(0); PG8_MMA(0, 1, At, B1); PG8_BAR;
            PG8_LDA(At, 0, 1); PG8_STAGE(PG8_SA(0, 0), a2, voffA);
            PG8_BAR; PG8_WAIT_L(0); PG8_MMA(1, 0, At, B0); PG8_BAR; PG8_SCHED;
            PG8_STAGE(PG8_SB(0, 1), b2 + hstep, voffB);
            PG8_WAIT_V(6); PG8_BAR; PG8_MMA(1, 1, At, B1); PG8_BAR;
            PG8_LDB(B0, 1, 0); PG8_SCHED; PG8_LDA(At, 1, 0); PG8_STAGE(PG8_SA(0, 1), a2 + hstepA, voffA);
            PG8_WAIT_L(8); PG8_BAR; PG8_WAIT_L(0); PG8_MMA(0, 0, At, B0); PG8_BAR; PG8_SCHED;
            PG8_LDB(B1, 1, 1); PG8_STAGE(PG8_SB(1, 0), b3, voffB);
            PG8_BAR; PG8_WAIT_L(0); PG8_MMA(0, 1, At, B1); PG8_BAR;
            PG8_LDA(At, 1, 1); PG8_STAGE(PG8_SA(1, 0), a3, voffA);
            PG8_BAR; PG8_WAIT_L(0); PG8_MMA(1, 0, At, B0); PG8_BAR; PG8_SCHED;
            PG8_STAGE(PG8_SB(1, 1), b3 + hstep, voffB);
            PG8_WAIT_V(6); PG8_BAR; PG8_MMA(1, 1, At, B1); PG8_BAR;
            }
        }
        if constexpr (ALIGN_EPI) { if (wr == 0) PG8_BAR; }
        if constexpr (FP8) asm volatile("s_nop 15\n\ts_nop 7" ::: "memory");
        if constexpr (!Epi::AFTER_DRAIN) { E(acc, cur, wr, wc, fr, fq); S.done(cur); }
        if (!has_next) break;
#pragma unroll
        for (int a = 0; a < 2; ++a)
#pragma unroll
            for (int b = 0; b < 2; ++b)
#pragma unroll
                for (int m = 0; m < 4; ++m)
#pragma unroll
                    for (int n = 0; n < 2; ++n) acc[a][b][m][n] = (f32x4){0.f, 0.f, 0.f, 0.f};
        cur = nxt; cA = nA; cB = nB; ++ui;
        if constexpr (AGATHER) { gvA0[0] = gnA0[0]; gvA0[1] = gnA0[1]; gvA1[0] = gnA1[0]; gvA1[1] = gnA1[1]; }
        if constexpr (ALIGN_EPI) { if (wr == 1) PG8_BAR; }
    }
    PG8_WAIT_V(0);
    if constexpr (!ALIGN_EPI) { if (wr == 0) PG8_BAR; }
    PG8_BAR;
    if constexpr (Epi::AFTER_DRAIN) { E.fused(acc, cur, wr, wc, fr, fq, lds, wid, lane); S.done(cur); }
#undef PG8_ABASE
#undef PG8_GLOAD
#undef PG8_STAGE_A
#undef PG8_SA
#undef PG8_SB
#undef PG8_STAGE
#undef PG8_LDA
#undef PG8_LDB
#undef PG8_MMA
#undef PG8_WAIT_V
#undef PG8_WAIT_L
#undef PG8_BAR
#undef PG8_SCHED
}
}
#define GAS __attribute__((address_space(1)))
#define LAS __attribute__((address_space(3)))
typedef unsigned short bf16;
typedef unsigned v4u __attribute__((ext_vector_type(4)));
typedef float f32x4 __attribute__((ext_vector_type(4)));
typedef short bf16x8 __attribute__((ext_vector_type(8)));
typedef GAS unsigned gu32;
typedef GAS unsigned long long gu64;
#define RLX_AGENT __ATOMIC_RELAXED, __HIP_MEMORY_SCOPE_AGENT
#define LDS_WAIT() asm volatile("s_waitcnt lgkmcnt(0)" ::: "memory")
#define VM_WAIT() asm volatile("s_waitcnt vmcnt(0)" ::: "memory")
__device__ __forceinline__ unsigned long long rt() { return __builtin_amdgcn_s_memrealtime(); }
__device__ __forceinline__ unsigned f2bf(float f) { unsigned u = __builtin_bit_cast(unsigned, f); return (u + 0x7fffu + ((u >> 16) & 1u)) >> 16; }
__device__ __forceinline__ unsigned pk2(float lo, float hi) { return f2bf(lo) | (f2bf(hi) << 16); }
#define XB_TMO      128
#define XB_XCNT(j)  (256  + 64 * (j))
#define XB_XSUB(j)  (1280 + 64 * (j))
#define XB_XGEN(j)  (2304 + 64 * (j))
#define XB_TOP      3328
#define XB_TOPGEN   3392
#define XCD_BAR_WORDS 3456
#define XB_SPIN_CAP (1u << 18)

__device__ __forceinline__ unsigned xb_ld(unsigned* p)              { return __hip_atomic_load(p, __ATOMIC_RELAXED, __HIP_MEMORY_SCOPE_AGENT); }
__device__ __forceinline__ unsigned xb_add(unsigned* p, unsigned v) { return __hip_atomic_fetch_add(p, v, __ATOMIC_RELAXED, __HIP_MEMORY_SCOPE_AGENT); }
__device__ __forceinline__ unsigned xb_xcc_id() { return (unsigned)__builtin_amdgcn_s_getreg((3 << 11) | 20) & 0xFu; }
#define XB_SPIN(cond, bar) do { unsigned _sp = 0; while (cond) { __builtin_amdgcn_s_sleep(1); \
    if ((++_sp & 255u) == 0u) { if (xb_ld(&(bar)[XB_TMO])) break; if (_sp > XB_SPIN_CAP) { atomicAdd(&(bar)[XB_TMO], 1u); break; } } } } while (0)

struct XcdBarrier {
    unsigned* bar; unsigned x;
    volatile LAS unsigned* st;
};

__device__ __forceinline__ XcdBarrier xcd_barrier_post(unsigned* bar, volatile LAS unsigned* st) {
    XcdBarrier b; b.bar = bar; b.x = xb_xcc_id(); b.st = st;
    if (threadIdx.x == 0) (void)xb_add(&bar[XB_XCNT(b.x)], 1u);
    return b;
}
__device__ __forceinline__ void xcd_barrier_complete(unsigned* bar, unsigned x, unsigned& nloc, unsigned& nx) {
    const unsigned G = gridDim.x * gridDim.y * gridDim.z;
    unsigned sum, cnt, mine, sp = 0u;
    for (;;) {
        sum = 0u; cnt = 0u; mine = 0u;
#pragma unroll
        for (unsigned j = 0; j < 16; ++j) { const unsigned c = xb_ld(&bar[XB_XCNT(j)]); sum += c; cnt += (c > 0u) ? 1u : 0u; mine = (j == x) ? c : mine; }
        if (sum == G) break;
        __builtin_amdgcn_s_sleep(1);
        if ((++sp & 255u) == 0u) { if (xb_ld(&bar[XB_TMO])) break; if (sp > XB_SPIN_CAP) { atomicAdd(&bar[XB_TMO], 1u); break; } }
    }
    nloc = mine > 0u ? mine : 1u; nx = cnt > 0u ? cnt : 1u;
}

__device__ __forceinline__ void xcd_barrier(const XcdBarrier& b) {
    asm volatile("s_waitcnt vmcnt(0)" ::: "memory");
    __syncthreads();
    if (threadIdx.x == 0) {
        unsigned* bar = b.bar;
        __builtin_amdgcn_s_waitcnt(0);
        unsigned nloc = b.st[0], nx = b.st[1];
        if (nloc == 0u) { xcd_barrier_complete(bar, b.x, nloc, nx); b.st[0] = nloc; b.st[1] = nx; }
        const unsigned old = xb_add(&bar[XB_XSUB(b.x)], 1u);
        const unsigned gen = old / nloc;
        if (old + 1u == (gen + 1u) * nloc) {
            __builtin_amdgcn_fence(__ATOMIC_RELEASE, "agent");
            asm volatile("s_waitcnt vmcnt(0)" ::: "memory");
            const unsigned og = xb_add(&bar[XB_TOP], 1u);
            const unsigned tg = og / nx;
            if (og + 1u == (tg + 1u) * nx) xb_add(&bar[XB_TOPGEN], 1u);
            else XB_SPIN(xb_ld(&bar[XB_TOPGEN]) == tg, bar);
            __builtin_amdgcn_fence(__ATOMIC_ACQUIRE, "agent");
            xb_add(&bar[XB_XGEN(b.x)], 1u);
            asm volatile("s_waitcnt vmcnt(0)" ::: "memory");
        } else {
            XB_SPIN(xb_ld(&bar[XB_XGEN(b.x)]) == gen, bar);
            __builtin_amdgcn_fence(__ATOMIC_ACQUIRE, "agent");
            asm volatile("s_waitcnt vmcnt(0)" ::: "memory");
        }
    }
    __syncthreads();
}

namespace att {
typedef short bf16x8 __attribute__((ext_vector_type(8)));
typedef short s16x4 __attribute__((ext_vector_type(4)));
typedef float f32x16 __attribute__((ext_vector_type(16)));
typedef unsigned u32x4 __attribute__((ext_vector_type(4)));
#define ATT_LAS __attribute__((address_space(3)))
constexpr int QBLK = 32, KVBLK = 64, DQ = 96, DV = 64, LDQ = 768, LDKN = 1024, LDKR = 32, LDV = 1024, LDO = 1024;
typedef const __attribute__((address_space(1))) unsigned short* gcp; typedef __attribute__((address_space(1))) unsigned short* gp;
constexpr float SCALE = 0.10206207261596577f, QSC = SCALE * 1.4426950408889634f, THR2 = 8.f * 1.4426950408889634f;
constexpr int SHM_V = KVBLK * DV * 2, SHM_K = KVBLK * 256, NRING = 4, OFF_K = 0, OFF_V = NRING * SHM_K, OFF_WS = NRING * (SHM_V + SHM_K), ATT_LDS = OFF_WS + 8 * 256;
#define KSWZ(row, colB) ((row) * 256 + ((colB) ^ (((row) & 7) << 4)))
#define SBAR() __builtin_amdgcn_sched_barrier(0)
__device__ __forceinline__ int crow(int r, int hi) { return (r & 3) + 8 * (r >> 2) + 4 * hi; }
__device__ __forceinline__ unsigned cvtpk(float lo, float hi) { unsigned r; asm volatile("v_cvt_pk_bf16_f32 %0, %1, %2" : "=v"(r) : "v"(lo), "v"(hi)); return r; }
template <bool FIRST> __device__ __forceinline__ void partialSM(f32x16& p0, f32x16& p1, f32x16& mC, float& alpha) {
  float pmax = p0[0];
#pragma unroll
  for (int r = 1; r < 16; ++r) pmax = fmaxf(pmax, p0[r]);
#pragma unroll
  for (int r = 0; r < 16; ++r) pmax = fmaxf(pmax, p1[r]);
  { auto rr = __builtin_amdgcn_permlane32_swap(__float_as_uint(pmax), __float_as_uint(pmax), false, false);
    pmax = fmaxf(__uint_as_float(rr[0]), __uint_as_float(rr[1])); }
  if (!FIRST && __builtin_expect(__all(pmax <= THR2), 1)) alpha = 1.f;
  else { const float d = FIRST ? pmax : fmaxf(pmax, 0.f); alpha = __builtin_amdgcn_exp2f(-d);
#pragma unroll
    for (int r = 0; r < 16; ++r) { p0[r] -= d; p1[r] -= d; mC[r] -= d; } }
#pragma unroll
  for (int r = 0; r < 16; ++r) p0[r] = __builtin_amdgcn_exp2f(p0[r]);
}
__device__ __forceinline__ void finishSM(f32x16& p0, f32x16& p1, bf16x8& pa0, bf16x8& pa1, bf16x8& pa2, bf16x8& pa3) {
#pragma unroll
  for (int r = 0; r < 16; ++r) p1[r] = __builtin_amdgcn_exp2f(p1[r]);
#define PK4(P, BASE, OUT) do { u32x4 w = {cvtpk(P[BASE + 0], P[BASE + 1]), cvtpk(P[BASE + 2], P[BASE + 3]), cvtpk(P[BASE + 4], P[BASE + 5]), cvtpk(P[BASE + 6], P[BASE + 7])}; OUT = __builtin_bit_cast(bf16x8, w); } while (0)
  PK4(p0, 0, pa0); PK4(p0, 8, pa1); PK4(p1, 0, pa2); PK4(p1, 8, pa3);
#undef PK4
}
__device__ __forceinline__ void qkt(f32x16& p0, f32x16& p1, const f32x16& mC, const ATT_LAS unsigned char* Ks, const bf16x8* qr, int r32, int hi) {
#pragma unroll
  for (int d0 = 0; d0 < DQ / 16; ++d0) { const int cb = (d0 * 16 + hi * 8) * 2;
    const bf16x8 b0 = *(const ATT_LAS bf16x8*)(Ks + KSWZ(r32, cb));
    const bf16x8 b1 = *(const ATT_LAS bf16x8*)(Ks + KSWZ(32 + r32, cb));
    p0 = __builtin_amdgcn_mfma_f32_32x32x16_bf16(b0, qr[d0], d0 ? p0 : mC, 0, 0, 0);
    p1 = __builtin_amdgcn_mfma_f32_32x32x16_bf16(b1, qr[d0], d0 ? p1 : mC, 0, 0, 0); }
}
__device__ __forceinline__ int v_st(int k, int c) { const int kk = k; return ((kk >> 3) * 2 + (c >> 5)) * 512 + ((kk & 7) * 32 + (c & 31)) * 2; }
__device__ __forceinline__ int v_rd_base(int lane) { return ((lane & 3) << 3) | (((lane >> 2) & 3) << 6) | (((lane >> 4) & 1) << 5) | (((lane >> 5) & 1) << 8); }
constexpr int v_rd_off(int d0, int ks, int half) { return d0 * 512 + ks * 2048 + half * 1024; }
struct KPre { bf16x8 a0, b0, a1, b1; };
#define KLDX(KS, D0, A, B) do { A = *(const ATT_LAS bf16x8*)((KS) + KSWZ(r32, ((D0) * 16 + hi * 8) * 2)); B = *(const ATT_LAS bf16x8*)((KS) + KSWZ(32 + r32, ((D0) * 16 + hi * 8) * 2)); } while (0)
#define VLD(D0, KS_, H) __builtin_amdgcn_ds_read_tr16_b64_v4i16((ATT_LAS s16x4*)(vbp + VO + v_rd_off(D0, KS_, H)))
#define PK(L, H) (bf16x8){L[0], L[1], L[2], L[3], H[0], H[1], H[2], H[3]}
#define MFMA(A, B, C) __builtin_amdgcn_mfma_f32_32x32x16_bf16(A, B, C, 0, 0, 0)
template <int VO> __device__ __forceinline__ void region1(f32x16& n0, f32x16& n1, const f32x16& mC, const ATT_LAS unsigned char* Ks, const bf16x8* qr, int r32, int hi, const KPre& kp,
                                                          f32x16& p0, f32x16& p1, bf16x8& pa0, bf16x8& pa1, bf16x8& pa2, bf16x8& pa3, const ATT_LAS unsigned char* vbp, s16x4* vf) {
  bf16x8 kA[DQ / 16], kB[DQ / 16]; unsigned w[16]; kA[0] = kp.a0; kB[0] = kp.b0; kA[1] = kp.a1; kB[1] = kp.b1;
#define KLD(D0) KLDX(Ks, D0, kA[D0], kB[D0])
#define KMM(D0) do { n0 = MFMA(kA[D0], qr[D0], (D0) ? n0 : mC); n1 = MFMA(kB[D0], qr[D0], (D0) ? n1 : mC); } while (0)
#define EXP1(R) p1[R] = __builtin_amdgcn_exp2f(p1[R])
  KLD(2); KMM(0); EXP1(0); EXP1(1); EXP1(2); EXP1(3); EXP1(4); EXP1(5); w[0] = cvtpk(p0[0], p0[1]); w[1] = cvtpk(p0[2], p0[3]); SBAR();
  KLD(3); KMM(1); EXP1(6); EXP1(7); EXP1(8); EXP1(9); EXP1(10); EXP1(11); w[2] = cvtpk(p0[4], p0[5]); w[3] = cvtpk(p0[6], p0[7]); SBAR();
  KLD(4); KMM(2); EXP1(12); EXP1(13); EXP1(14); EXP1(15); w[4] = cvtpk(p0[8], p0[9]); w[5] = cvtpk(p0[10], p0[11]); w[6] = cvtpk(p0[12], p0[13]); w[7] = cvtpk(p0[14], p0[15]); SBAR();
  KLD(5); KMM(3); w[8] = cvtpk(p1[0], p1[1]); w[9] = cvtpk(p1[2], p1[3]); w[10] = cvtpk(p1[4], p1[5]); w[11] = cvtpk(p1[6], p1[7]); SBAR();
#pragma unroll
  for (int ks = 0; ks < 4; ++ks) { vf[2 * ks] = VLD(0, ks, 0); vf[2 * ks + 1] = VLD(0, ks, 1); }
  KMM(4); w[12] = cvtpk(p1[8], p1[9]); w[13] = cvtpk(p1[10], p1[11]); w[14] = cvtpk(p1[12], p1[13]); w[15] = cvtpk(p1[14], p1[15]); SBAR();
  KMM(5);
#undef KLD
#undef KMM
#undef EXP1
  { const u32x4 a = {w[0], w[1], w[2], w[3]}, b = {w[4], w[5], w[6], w[7]}, c = {w[8], w[9], w[10], w[11]}, d = {w[12], w[13], w[14], w[15]};
    pa0 = __builtin_bit_cast(bf16x8, a); pa1 = __builtin_bit_cast(bf16x8, b); pa2 = __builtin_bit_cast(bf16x8, c); pa3 = __builtin_bit_cast(bf16x8, d); }
}
template <int VO> __device__ __forceinline__ void region2(f32x16* o, const s16x4* vf, const ATT_LAS unsigned char* vbp, bf16x8 pa0, bf16x8 pa1, bf16x8 pa2, bf16x8 pa3, bf16x8 ones,
                                                          f32x16& n0, f32x16& n1, f32x16& mC, float& alpha) {
  s16x4 vg[8];
#pragma unroll
  for (int ks = 0; ks < 4; ++ks) { vg[2 * ks] = VLD(1, ks, 0); vg[2 * ks + 1] = VLD(1, ks, 1); }
#define MX3(A, P, R) A = fmaxf(fmaxf(A, P[R]), P[R + 1])
  o[0] = MFMA(pa0, PK(vf[0], vf[1]), o[0]); o[2] = MFMA(pa0, ones, o[2]); SBAR();
  float ma = fmaxf(n0[0], n0[1]), mb = fmaxf(n1[0], n1[1]);
  o[0] = MFMA(pa1, PK(vf[2], vf[3]), o[0]); o[2] = MFMA(pa1, ones, o[2]); MX3(ma, n0, 2); MX3(mb, n1, 2); MX3(ma, n0, 4); MX3(mb, n1, 4); SBAR();
  o[0] = MFMA(pa2, PK(vf[4], vf[5]), o[0]); o[2] = MFMA(pa2, ones, o[2]); MX3(ma, n0, 6); MX3(mb, n1, 6); MX3(ma, n0, 8); MX3(mb, n1, 8); MX3(ma, n0, 10); MX3(mb, n1, 10); SBAR();
  o[0] = MFMA(pa3, PK(vf[6], vf[7]), o[0]); o[2] = MFMA(pa3, ones, o[2]); MX3(ma, n0, 12); MX3(mb, n1, 12); MX3(ma, n0, 14); MX3(mb, n1, 14);
  float pmax = fmaxf(ma, mb);
  { auto rr = __builtin_amdgcn_permlane32_swap(__float_as_uint(pmax), __float_as_uint(pmax), false, false);
    pmax = fmaxf(__uint_as_float(rr[0]), __uint_as_float(rr[1])); }
  if (__builtin_expect(__all(pmax <= THR2), 1)) alpha = 1.f;
  else { const float d = fmaxf(pmax, 0.f); alpha = __builtin_amdgcn_exp2f(-d);
#pragma unroll
    for (int r = 0; r < 16; ++r) { n0[r] -= d; n1[r] -= d; mC[r] -= d; } }
#define EXP4(R) do { float e0 = __builtin_amdgcn_exp2f(n0[R]), e1 = __builtin_amdgcn_exp2f(n0[R + 1]), e2 = __builtin_amdgcn_exp2f(n0[R + 2]), e3 = __builtin_amdgcn_exp2f(n0[R + 3]); \
    asm volatile("" : "+v"(e0), "+v"(e1), "+v"(e2), "+v"(e3)); n0[R] = e0; n0[R + 1] = e1; n0[R + 2] = e2; n0[R + 3] = e3; } while (0)
  SBAR(); o[1] = MFMA(pa0, PK(vg[0], vg[1]), o[1]); EXP4(0); SBAR();
  o[1] = MFMA(pa1, PK(vg[2], vg[3]), o[1]); EXP4(4); SBAR();
  o[1] = MFMA(pa2, PK(vg[4], vg[5]), o[1]); EXP4(8); SBAR();
  o[1] = MFMA(pa3, PK(vg[6], vg[7]), o[1]); EXP4(12);
#undef EXP4
#undef MX3
}
template <int VO> __device__ __forceinline__ void pv_last(f32x16* o, const ATT_LAS unsigned char* vbp, bf16x8 pa0, bf16x8 pa1, bf16x8 pa2, bf16x8 pa3, bf16x8 ones) {
  s16x4 vf[8], vg[8];
#pragma unroll
  for (int ks = 0; ks < 4; ++ks) { vf[2 * ks] = VLD(0, ks, 0); vf[2 * ks + 1] = VLD(0, ks, 1); vg[2 * ks] = VLD(1, ks, 0); vg[2 * ks + 1] = VLD(1, ks, 1); }
  o[0] = MFMA(pa0, PK(vf[0], vf[1]), o[0]); o[1] = MFMA(pa0, PK(vg[0], vg[1]), o[1]); o[2] = MFMA(pa0, ones, o[2]);
  o[0] = MFMA(pa1, PK(vf[2], vf[3]), o[0]); o[1] = MFMA(pa1, PK(vg[2], vg[3]), o[1]); o[2] = MFMA(pa1, ones, o[2]);
  o[0] = MFMA(pa2, PK(vf[4], vf[5]), o[0]); o[1] = MFMA(pa2, PK(vg[4], vg[5]), o[1]); o[2] = MFMA(pa2, ones, o[2]);
  o[0] = MFMA(pa3, PK(vf[6], vf[7]), o[0]); o[1] = MFMA(pa3, PK(vg[6], vg[7]), o[1]); o[2] = MFMA(pa3, ones, o[2]);
}
#undef VLD
#undef PK
#undef MFMA

__device__ __forceinline__ void attn_unit(const unsigned short* Qb_, const unsigned short* Kn_, const unsigned short* Kr_, const unsigned short* Vc_, int ra, int nt_a, int rb, int NT,
                                          unsigned short* Ob_, ATT_LAS unsigned char* lds, int rope_t0) {
  gcp Qb = (gcp)Qb_, Kn = (gcp)Kn_, Kr = (gcp)Kr_, Vc = (gcp)Vc_; gp Ob = (gp)Ob_;
  const int tid = threadIdx.x, wid = tid >> 6, lane = tid & 63, r32 = lane & 31, hi = lane >> 5;
  ATT_LAS unsigned char* V_lds = lds + OFF_V; ATT_LAS unsigned char* K_lds = lds + OFF_K;
  ATT_LAS float* wsp = (ATT_LAS float*)(lds + OFF_WS) + wid * 64; ATT_LAS float* al_l = wsp + 32;
  f32x16 o[3] = {}, mC = {}; bf16x8 qr[DQ / 16]; const u32x4 ones_w = {0x3f803f80u, 0x3f803f80u, 0x3f803f80u, 0x3f803f80u}; const bf16x8 ones = __builtin_bit_cast(bf16x8, ones_w);
  const int sk = tid >> 3, sc = (tid & 7) * 8, rk = (tid & 255) >> 2, rc = (tid & 3) * 8; const bool rw = tid < 256;
  const int vst = v_st(sk, sc), kst0 = KSWZ(sk, sc * 2), kst1 = KSWZ(rk, (64 + rc) * 2);
  struct SR { bf16x8 vs, k0, k1; };
#define TROW(t) ((t) < nt_a ? ra + (t) * KVBLK : rb + ((t) - nt_a) * KVBLK)
#define SLOADX(S, t) do { const long r0_ = TROW(t); S.vs = *(const __attribute__((address_space(1))) bf16x8*)(Vc + (r0_ + sk) * LDV + sc); S.k0 = *(const __attribute__((address_space(1))) bf16x8*)(Kn + (r0_ + sk) * LDKN + sc); \
    S.k1 = *(const __attribute__((address_space(1))) bf16x8*)(Kr + (r0_ + rk) * LDKR + rc); } while (0)
#define SWRITEX(b, S) do { *(ATT_LAS bf16x8*)(V_lds + (b) * SHM_V + vst) = S.vs; *(ATT_LAS bf16x8*)(K_lds + (b) * SHM_K + kst0) = S.k0; \
    if (rw) *(ATT_LAS bf16x8*)(K_lds + (b) * SHM_K + kst1) = S.k1; } while (0)
  SR s0_, s1_, sr_; SLOADX(s0_, 0); SLOADX(s1_, 1); SLOADX(sr_, 2);
  gcp Qw = Qb + (long)(wid * QBLK + r32) * LDQ + hi * 8;
#pragma unroll
  for (int d0 = 0; d0 < DQ / 16; ++d0) qr[d0] = *(const __attribute__((address_space(1))) bf16x8*)(Qw + d0 * 16);
  if (rope_t0 >= 0) {
    int t = rope_t0 + wid * QBLK + r32; asm volatile("" : "+v"(t));
    const float prow = (float)(t >> 6), pcol = (float)(t & 63);
#pragma unroll
    for (int f = 0; f < 2; ++f) { const u32x4 own = __builtin_bit_cast(u32x4, qr[4 + f]); u32x4 oth;
      oth.x = (unsigned)__shfl_xor((int)own.x, 32); oth.y = (unsigned)__shfl_xor((int)own.y, 32); oth.z = (unsigned)__shfl_xor((int)own.z, 32); oth.w = (unsigned)__shfl_xor((int)own.w, 32);
      const float pos = f ? pcol : prow; float o8[8];
#pragma unroll
      for (int j = 0; j < 8; ++j) { const unsigned wo = (j < 2) ? own.x : (j < 4) ? own.y : (j < 6) ? own.z : own.w, wp = (j < 2) ? oth.x : (j < 4) ? oth.y : (j < 6) ? oth.z : oth.w;
        const float a = (j & 1) ? __uint_as_float(wo & 0xffff0000u) : __uint_as_float(wo << 16), bq = (j & 1) ? __uint_as_float(wp & 0xffff0000u) : __uint_as_float(wp << 16);
        const float ang = pos * __builtin_amdgcn_exp2f(-(float)j * (13.287712379549449f / 8.0f)); float sn, cs; __sincosf(ang, &sn, &cs);
        o8[j] = hi ? (a * cs + bq * sn) : (a * cs - bq * sn); }
      u32x4 w = {cvtpk(o8[0], o8[1]), cvtpk(o8[2], o8[3]), cvtpk(o8[4], o8[5]), cvtpk(o8[6], o8[7])}; qr[4 + f] = __builtin_bit_cast(bf16x8, w); } }
#pragma unroll
  for (int d0 = 0; d0 < DQ / 16; ++d0) { const u32x4 w = __builtin_bit_cast(u32x4, qr[d0]); u32x4 q;
#pragma unroll
    for (int i = 0; i < 4; ++i) q[i] = cvtpk(__uint_as_float(w[i] << 16) * QSC, __uint_as_float(w[i] & 0xffff0000u) * QSC);
    qr[d0] = __builtin_bit_cast(bf16x8, q); }
#define SLOAD(t) SLOADX(sr_, t)
#define SWRITE(b) SWRITEX(b, sr_)
#define SWAIT() asm volatile("s_waitcnt vmcnt(0)" ::: "memory")
#define BAR() asm volatile("s_barrier" ::: "memory")
#define RESC(a) do { if (__any((a) < 1.f)) { if (hi == 0) al_l[r32] = (a); asm volatile("s_waitcnt lgkmcnt(0)" ::: "memory"); \
    _Pragma("unroll") for (int d = 0; d < 3; ++d) _Pragma("unroll") for (int r = 0; r < 16; ++r) o[d][r] *= al_l[crow(r, hi)]; } } while (0)
#define KPRE(KB) do { KLDX(K_lds + (KB) * SHM_K, 0, kp.a0, kp.b0); KLDX(K_lds + (KB) * SHM_K, 1, kp.a1, kp.b1); } while (0)
  f32x16 pA0, pA1, pB0, pB1; float alA, alB; bf16x8 pa0, pa1, pa2, pa3; KPre kp; s16x4 vf[8];
  const ATT_LAS unsigned char* vbp = V_lds + v_rd_base(lane);
  SWAIT(); SWRITEX(0, s0_); SWRITEX(1, s1_); SWRITE(2); SLOAD(3); __syncthreads();
  qkt(pA0, pA1, mC, K_lds, qr, r32, hi); partialSM<true>(pA0, pA1, mC, alA);
  KPRE(1); BAR();
#define STEP(PN0, PN1, ALN, PO0, PO1, KB, VB, T, WR, LD, NX) do { \
    SBAR(); if (WR) { SWAIT(); SWRITE(((KB) + 2) & 3); } if (LD) SLOAD((T) + 3); SBAR(); \
    region1<(VB) * SHM_V>(PN0, PN1, mC, K_lds + (KB) * SHM_K, qr, r32, hi, kp, PO0, PO1, pa0, pa1, pa2, pa3, vbp, vf); SBAR(); \
    region2<(VB) * SHM_V>(o, vf, vbp, pa0, pa1, pa2, pa3, ones, PN0, PN1, mC, ALN); SBAR(); \
    if (NX) KPRE(((KB) + 1) & 3); RESC(ALN); BAR(); } while (0)
  int j = 1;
  for (; j + 3 < NT; j += 4) {
    STEP(pB0, pB1, alB, pA0, pA1, 1, 0, j, true, true, true);
    STEP(pA0, pA1, alA, pB0, pB1, 2, 1, j + 1, true, true, true);
    STEP(pB0, pB1, alB, pA0, pA1, 3, 2, j + 2, true, true, true);
    STEP(pA0, pA1, alA, pB0, pB1, 0, 3, j + 3, true, true, true);
  }
  STEP(pB0, pB1, alB, pA0, pA1, 1, 0, j, true, false, true);
  STEP(pA0, pA1, alA, pB0, pB1, 2, 1, j + 1, false, false, true);
  STEP(pB0, pB1, alB, pA0, pA1, 3, 2, j + 2, false, false, false);
  finishSM(pB0, pB1, pa0, pa1, pa2, pa3); SBAR();
  pv_last<3 * SHM_V>(o, vbp, pa0, pa1, pa2, pa3, ones);
  float rli[16];
#pragma unroll
  for (int r = 0; r < 16; ++r) rli[r] = __builtin_amdgcn_rcpf(o[2][r]);
  gp Ow = Ob + (long)(wid * QBLK) * LDO;
#pragma unroll
  for (int r = 0; r < 16; ++r) { const int orow = crow(r, hi);
#pragma unroll
    for (int d0 = 0; d0 < 2; ++d0) Ow[(long)orow * LDO + d0 * 32 + r32] = (unsigned short)(cvtpk(o[d0][r] * rli[r], 0.f) & 0xffffu); }
  asm volatile("s_waitcnt vmcnt(0)" ::: "memory");
  __syncthreads();
#undef TROW
#undef SLOAD
#undef SWRITE
#undef SLOADX
#undef SWRITEX
#undef STEP
#undef BAR
#undef KPRE
#undef SWAIT
#undef RESC
}
#undef KLDX
#undef KSWZ
#undef SBAR
}

namespace gla {
typedef short bf16x8 __attribute__((ext_vector_type(8)));
typedef short s16x4 __attribute__((ext_vector_type(4)));
typedef float f32x16 __attribute__((ext_vector_type(16)));
typedef float f32x4 __attribute__((ext_vector_type(4)));
typedef float f32x2 __attribute__((ext_vector_type(2)));
typedef __bf16 bf16x2_t __attribute__((ext_vector_type(2)));
typedef unsigned u32x4 __attribute__((ext_vector_type(4)));
typedef unsigned u32x2 __attribute__((ext_vector_type(2)));
#define GLA_LAS __attribute__((address_space(3)))
#define GLA_GAS __attribute__((address_space(1)))
constexpr int RS256 = 272, RS128 = 144;
constexpr int OFF_QT = 0, OFF_KT = 64 * RS256, OFF_KH = 2 * 64 * RS256, OFF_V = OFF_KH + 128 * RS128, OFF_P = OFF_V + 32768, OFF_TOT = OFF_P + 64 * RS128, OFF_EL = OFF_TOT + 2048, OFF_ZG = OFF_EL + 512, OFF_W2 = OFF_ZG + 4096, GLA_LDS = OFF_W2 + 8192;
static_assert(GLA_LDS <= 131072 && OFF_V % 16 == 0 && OFF_P % 16 == 0 && OFF_TOT % 16 == 0, "gla lds map");
__device__ __forceinline__ int swz256(int row, int colB) { return row * RS256 + colB; }
__device__ __forceinline__ int swz128(int row, int colB) { return row * RS128 + colB; }
__device__ __forceinline__ int crow(int r, int hi) { return (r & 3) + 8 * (r >> 2) + 4 * hi; }
__device__ __forceinline__ unsigned pk2f(float lo, float hi) { const f32x2 v = {lo, hi}; return __builtin_bit_cast(unsigned, __builtin_convertvector(v, bf16x2_t)); }
__device__ __forceinline__ unsigned short bf1f(float x) { return (unsigned short)(pk2f(x, 0.f) & 0xffffu); }
__device__ __forceinline__ float bfu(unsigned short u) { return __uint_as_float(((unsigned)u) << 16); }
__device__ __forceinline__ int v_st(int k, int c) { const int kk = (k & ~0xC) | ((k & 4) << 1) | ((k & 8) >> 1); return ((kk >> 3) * 8 + (c >> 5)) * 512 + ((kk & 7) * 32 + (c & 31)) * 2; }
__device__ __forceinline__ int v_rd_base(int lane) { return ((lane & 3) << 3) | (((lane >> 2) & 3) << 6) | (((lane >> 4) & 1) << 5) | (((lane >> 5) & 1) << 8); }
template <int OFF> __device__ __forceinline__ s16x4 tr_read(int vb) { s16x4 r; asm volatile("ds_read_b64_tr_b16 %0, %1 offset:%2" : "=&v"(r) : "v"(vb), "i"(OFF) : "memory"); return r; }
#define GLA_MFMA(a, b, c) __builtin_amdgcn_mfma_f32_32x32x16_bf16((a), (b), (c), 0, 0, 0)
__device__ __forceinline__ bf16x8 pack_step(const f32x16& x, int s) {
    u32x4 p; p.x = pk2f(x[8 * s], x[8 * s + 1]); p.y = pk2f(x[8 * s + 2], x[8 * s + 3]); p.z = pk2f(x[8 * s + 4], x[8 * s + 5]); p.w = pk2f(x[8 * s + 6], x[8 * s + 7]); return __builtin_bit_cast(bf16x8, p);
}
__device__ __forceinline__ void gla_prep(const unsigned short* QK_, const unsigned short* ZG_, const float* w2_, const float* b2_, unsigned short* TQ_, unsigned short* TK_, unsigned short* TP_, float* EL_,
                                         int b, int h, int dir, int c_lo, int c_hi, int ML_, int SEQ_, int CTX_, GLA_LAS unsigned char* lds) {
    const GLA_GAS unsigned short* QK = (const GLA_GAS unsigned short*)QK_; const GLA_GAS unsigned short* ZG = (const GLA_GAS unsigned short*)ZG_;
    const GLA_GAS float* w2g = (const GLA_GAS float*)w2_; const GLA_GAS float* b2g = (const GLA_GAS float*)b2_;
    const int tid = threadIdx.x, wid = __builtin_amdgcn_readfirstlane(tid >> 6), lane = tid & 63, r32 = lane & 31, hi = lane >> 5;
    const int seg = tid >> 7, kk = tid & 127;
    GLA_LAS unsigned char* QT = lds + OFF_QT; GLA_LAS unsigned char* KT = lds + OFF_KT;
    GLA_LAS float* TOT = (GLA_LAS float*)(lds + OFF_TOT); GLA_LAS float* ZGS = (GLA_LAS float*)(lds + OFF_ZG); GLA_LAS float* W2S = (GLA_LAS float*)(lds + OFF_W2);
    __syncthreads();
#pragma unroll
    for (int i = 0; i < 4; ++i) { const int idx = tid + 512 * i; W2S[idx] = w2g[(size_t)(dir * 16 + (idx >> 7)) * 512 + h * 128 + (idx & 127)]; }
    const float b2 = b2g[dir * 512 + h * 128 + kk];
    const int nctx = CTX_ / 64;
    unsigned raw[16], zgw;
#define GLA_PLOAD(cs_) do { const long r0_ = ((cs_) < nctx) ? (long)ML_ + (long)b * CTX_ + 64 * (cs_) : (long)b * SEQ_ + 64 * ((cs_) - nctx); \
        zgw = *(const GLA_GAS unsigned*)(ZG + (r0_ + (tid >> 3)) * 2304 + dir * 16 + (tid & 7) * 2); \
        _Pragma("unroll") for (int i_ = 0; i_ < 16; ++i_) { const GLA_GAS unsigned short* zr_ = QK + (r0_ + 16 * seg + i_) * 1024 + h * 128 + kk; raw[i_] = (unsigned)zr_[0] | ((unsigned)zr_[512] << 16); } } while (0)
    for (int cs = c_lo; cs < c_hi; ++cs) {
        GLA_PLOAD(cs);
        const size_t tile = (size_t)((b * 4 + h) * 2 + dir) * 36 + cs;
        GLA_GAS unsigned short* TQ = (GLA_GAS unsigned short*)TQ_ + tile * 8192; GLA_GAS unsigned short* TK = (GLA_GAS unsigned short*)TK_ + tile * 8192; GLA_GAS unsigned short* TP = (GLA_GAS unsigned short*)TP_ + tile * 4096;
        { const int l = tid >> 3, r2 = (tid & 7) * 2; ZGS[l * 16 + r2] = __uint_as_float(zgw << 16); ZGS[l * 16 + r2 + 1] = __uint_as_float(zgw & 0xffff0000u); }
        __syncthreads();
        float cum[16];
#pragma unroll
        for (int i = 0; i < 16; ++i) cum[i] = b2;
#pragma unroll
        for (int q = 0; q < 4; ++q) { const float wa = W2S[(4 * q) * 128 + kk], wb = W2S[(4 * q + 1) * 128 + kk], wc_ = W2S[(4 * q + 2) * 128 + kk], wd = W2S[(4 * q + 3) * 128 + kk];
#pragma unroll
            for (int i = 0; i < 16; ++i) { const f32x4 z = *(const GLA_LAS f32x4*)(ZGS + (16 * seg + i) * 16 + 4 * q); cum[i] += z.x * wa + z.y * wb + z.z * wc_ + z.w * wd; } }
#pragma unroll
        for (int i = 0; i < 16; ++i) { const float x = cum[i]; cum[i] = (fminf(x, 0.f) - __logf(1.0f + __expf(-fabsf(x)))) * (1.0f / 16.0f); }
        if (dir == 0) {
#pragma unroll
            for (int i = 1; i < 16; ++i) cum[i] += cum[i - 1];
            TOT[seg * 128 + kk] = cum[15];
        } else {
#pragma unroll
            for (int i = 14; i >= 0; --i) cum[i] += cum[i + 1];
            TOT[seg * 128 + kk] = cum[0];
        }
        __syncthreads();
        { const float t0 = TOT[kk], t1 = TOT[128 + kk], t2 = TOT[256 + kk], t3 = TOT[384 + kk]; const float last = (t0 + t1) + (t2 + t3);
          float off;
          if (dir == 0) off = (seg > 0 ? t0 : 0.f) + (seg > 1 ? t1 : 0.f) + (seg > 2 ? t2 : 0.f);
          else off = (seg < 3 ? t3 : 0.f) + (seg < 2 ? t2 : 0.f) + (seg < 1 ? t1 : 0.f);
          if (seg == 0) ((GLA_GAS float*)EL_)[tile * 128 + kk] = __expf(last);
          unsigned ktp[8];
#pragma unroll
          for (int i = 0; i < 16; i += 2) {
              const float c0 = cum[i] + off, c1 = cum[i + 1] + off; const int l0 = 16 * seg + i, l1 = l0 + 1;
              const float q0 = __uint_as_float(raw[i] << 16), k0v = __uint_as_float(raw[i] & 0xffff0000u), q1 = __uint_as_float(raw[i + 1] << 16), k1v = __uint_as_float(raw[i + 1] & 0xffff0000u);
              const unsigned short qa = bf1f(q0 * __expf(c0)), qb = bf1f(q1 * __expf(c1)); const float ka = k0v * __expf(-c0), kb = k1v * __expf(-c1); const unsigned kp = pk2f(ka, kb);
              *(GLA_LAS unsigned short*)(QT + swz256(l0, 2 * kk)) = qa; *(GLA_LAS unsigned short*)(QT + swz256(l1, 2 * kk)) = qb;
              *(GLA_LAS unsigned short*)(KT + swz256(l0, 2 * kk)) = (unsigned short)(kp & 0xffffu); *(GLA_LAS unsigned short*)(KT + swz256(l1, 2 * kk)) = (unsigned short)(kp >> 16);
              TQ[l0 * 128 + kk] = qa; TQ[l1 * 128 + kk] = qb; ktp[i >> 1] = kp; }
          u32x4 k0 = {ktp[0], ktp[1], ktp[2], ktp[3]}, k1 = {ktp[4], ktp[5], ktp[6], ktp[7]};
          *(GLA_GAS u32x4*)(TK + kk * 64 + 16 * seg) = k0; *(GLA_GAS u32x4*)(TK + kk * 64 + 16 * seg + 8) = k1; }
        __syncthreads();
        if (wid < 4) { const int mi = wid >> 1, li = wid & 1; f32x16 x = f32x16{};
#pragma unroll
            for (int s2 = 0; s2 < 8; ++s2) { const int cb = (16 * s2 + 8 * hi) * 2;
                const bf16x8 a = *(const GLA_LAS bf16x8*)(KT + swz256(32 * mi + r32, cb)); const bf16x8 bq = *(const GLA_LAS bf16x8*)(QT + swz256(32 * li + r32, cb)); x = GLA_MFMA(a, bq, x); }
            const int l = 32 * li + r32;
#pragma unroll
            for (int g = 0; g < 4; ++g) { float v[4];
#pragma unroll
                for (int j = 0; j < 4; ++j) { const int m = 32 * mi + 8 * g + 4 * hi + j; const bool keep = (dir == 0) ? (m <= l) : (m >= l); v[j] = keep ? x[4 * g + j] : 0.f; }
                u32x2 w; w.x = pk2f(v[0], v[1]); w.y = pk2f(v[2], v[3]); *(GLA_GAS u32x2*)(TP + l * 64 + 32 * mi + 8 * g + 4 * hi) = w; } }
    }
#undef GLA_PLOAD
    __syncthreads();
}
__device__ __forceinline__ void gla_chain(const unsigned short* VR_, const unsigned short* TQ_, const unsigned short* TK_, const unsigned short* TP_, const float* EL_, unsigned short* O_, int b, int h, int dir,
                                          int ML_, int SEQ_, int CTX_, GLA_LAS unsigned char* lds) {
    const GLA_GAS unsigned short* VR = (const GLA_GAS unsigned short*)VR_; GLA_GAS unsigned short* O = (GLA_GAS unsigned short*)O_;
    const int tid = threadIdx.x, wid = __builtin_amdgcn_readfirstlane(tid >> 6), lane = tid & 63, r32 = lane & 31, hi = lane >> 5;
    GLA_LAS unsigned char* QT = lds + OFF_QT; GLA_LAS unsigned char* KH = lds + OFF_KH; GLA_LAS unsigned char* VI = lds + OFF_V; GLA_LAS unsigned char* PI = lds + OFF_P; GLA_LAS float* EL = (GLA_LAS float*)(lds + OFF_EL);
    f32x16 S[4];
#pragma unroll
    for (int t = 0; t < 4; ++t) S[t] = f32x16{};
    const int vb = (int)(unsigned)(uintptr_t)VI + v_rd_base(lane) + wid * 512;
    const int nchunk = (CTX_ + SEQ_) / 64, nctx = CTX_ / 64;
    const size_t tile0 = (size_t)((b * 4 + h) * 2 + dir) * 36;
    u32x4 pq[2], pk[2], pp, pv[4]; float pe = 0.f;
#define GLA_CS(sc_) ((dir == 0) ? (sc_) : (((sc_) < nctx) ? (nctx - 1 - (sc_)) : (nchunk - 1 - ((sc_) - nctx))))
#define GLA_FETCH(sc_) do { const int cs_ = GLA_CS(sc_); const size_t t_ = tile0 + cs_; const long r0_ = (cs_ < nctx) ? (long)ML_ + (long)b * CTX_ + 64 * cs_ : (long)b * SEQ_ + 64 * (cs_ - nctx); \
        const GLA_GAS u32x4* q_ = (const GLA_GAS u32x4*)((const GLA_GAS unsigned short*)TQ_ + t_ * 8192); const GLA_GAS u32x4* k_ = (const GLA_GAS u32x4*)((const GLA_GAS unsigned short*)TK_ + t_ * 8192); \
        pq[0] = q_[tid]; pq[1] = q_[tid + 512]; pk[0] = k_[tid]; pk[1] = k_[tid + 512]; pp = ((const GLA_GAS u32x4*)((const GLA_GAS unsigned short*)TP_ + t_ * 4096))[tid]; \
        if (tid < 128) pe = ((const GLA_GAS float*)EL_)[t_ * 128 + tid]; \
        _Pragma("unroll") for (int i_ = 0; i_ < 4; ++i_) { const int c_ = tid + 512 * i_; pv[i_] = *(const GLA_GAS u32x4*)(VR + (r0_ + (c_ >> 5)) * 2304 + h * 256 + (c_ & 31) * 8); } } while (0)
    GLA_FETCH(0);
    for (int sc = 0; sc < nchunk; ++sc) {
        const int cs = GLA_CS(sc); const bool is_lat = cs >= nctx; const long row0 = is_lat ? (long)b * SEQ_ + 64 * (cs - nctx) : (long)ML_ + (long)b * CTX_ + 64 * cs;
#pragma unroll
        for (int i = 0; i < 2; ++i) { const int c = tid + 512 * i; *(GLA_LAS u32x4*)(QT + (c >> 4) * RS256 + (c & 15) * 16) = pq[i]; *(GLA_LAS u32x4*)(KH + (c >> 3) * RS128 + (c & 7) * 16) = pk[i]; }
        *(GLA_LAS u32x4*)(PI + (tid >> 3) * RS128 + (tid & 7) * 16) = pp;
        if (tid < 128) EL[tid] = pe;
#pragma unroll
        for (int i = 0; i < 4; ++i) { const int c = tid + 512 * i; *(GLA_LAS u32x4*)(VI + v_st(c >> 5, (c & 31) * 8)) = pv[i]; }
        __syncthreads();
        if (sc + 1 < nchunk) GLA_FETCH(sc + 1);
        f32x16 o[2] = {f32x16{}, f32x16{}};
#pragma unroll
        for (int kt = 0; kt < 4; ++kt)
#pragma unroll
            for (int s2 = 0; s2 < 2; ++s2) { const bf16x8 bs = pack_step(S[kt], s2); const int cb0 = (32 * kt + 16 * s2 + 4 * hi) * 2;
#pragma unroll
                for (int rb = 0; rb < 2; ++rb) { const int l = 32 * rb + r32;
                    const s16x4 a0 = *(const GLA_LAS s16x4*)(QT + swz256(l, cb0)), a1 = *(const GLA_LAS s16x4*)(QT + swz256(l, cb0 + 16));
                    const bf16x8 a = {a0[0], a0[1], a0[2], a0[3], a1[0], a1[1], a1[2], a1[3]}; o[rb] = GLA_MFMA(a, bs, o[rb]); } }
        bf16x8 vf[4];
        { const s16x4 l0 = tr_read<0 * 8192>(vb), h0 = tr_read<0 * 8192 + 4096>(vb), l1 = tr_read<1 * 8192>(vb), h1 = tr_read<1 * 8192 + 4096>(vb);
          const s16x4 l2 = tr_read<2 * 8192>(vb), h2 = tr_read<2 * 8192 + 4096>(vb), l3 = tr_read<3 * 8192>(vb), h3 = tr_read<3 * 8192 + 4096>(vb);
          asm volatile("s_waitcnt lgkmcnt(0)" ::: "memory"); __builtin_amdgcn_sched_barrier(0);
          vf[0] = (bf16x8){l0[0], l0[1], l0[2], l0[3], h0[0], h0[1], h0[2], h0[3]}; vf[1] = (bf16x8){l1[0], l1[1], l1[2], l1[3], h1[0], h1[1], h1[2], h1[3]};
          vf[2] = (bf16x8){l2[0], l2[1], l2[2], l2[3], h2[0], h2[1], h2[2], h2[3]}; vf[3] = (bf16x8){l3[0], l3[1], l3[2], l3[3], h3[0], h3[1], h3[2], h3[3]}; }
#pragma unroll
        for (int rb = 0; rb < 2; ++rb)
#pragma unroll
            for (int ks = 0; ks < 4; ++ks) { const bf16x8 a = *(const GLA_LAS bf16x8*)(PI + swz128(32 * rb + r32, (16 * ks + 8 * hi) * 2)); o[rb] = GLA_MFMA(a, vf[ks], o[rb]); }
        if (is_lat) {
#pragma unroll
            for (int rb = 0; rb < 2; ++rb)
#pragma unroll
                for (int r = 0; r < 16; ++r) O[(row0 + 32 * rb + crow(r, hi)) * 1024 + h * 256 + 32 * wid + r32] = bf1f(o[rb][r]); }
#pragma unroll
        for (int kt = 0; kt < 4; ++kt) {
#pragma unroll
            for (int ks = 0; ks < 4; ++ks) { const bf16x8 a = *(const GLA_LAS bf16x8*)(KH + swz128(32 * kt + r32, (16 * ks + 8 * hi) * 2)); S[kt] = GLA_MFMA(a, vf[ks], S[kt]); }
#pragma unroll
            for (int r = 0; r < 16; ++r) S[kt][r] *= EL[32 * kt + crow(r, hi)]; }
        __syncthreads();
    }
#undef GLA_FETCH
#undef GLA_CS
}
__device__ __forceinline__ int v_st4(int k, int c) { const int kk = (k & ~0xC) | ((k & 4) << 1) | ((k & 8) >> 1); return ((kk >> 3) * 4 + (c >> 5)) * 512 + ((kk & 7) * 32 + (c & 31)) * 2; }
constexpr int OFF_XO_A = OFF_KT, OFF_XO_B = OFF_V + 16384;
static_assert(OFF_XO_A + 16384 <= OFF_KH && OFF_XO_B + 16384 <= OFF_P, "gla chain2 lds map");
__device__ __forceinline__ void gla_chain2(const unsigned short* VR_, const unsigned short* TQ_, const unsigned short* TK_, const unsigned short* TP_, const float* EL_, unsigned short* O_, int b, int h, int dir, int vh,
                                           int ML_, int SEQ_, int CTX_, GLA_LAS unsigned char* lds) {
    const GLA_GAS unsigned short* VR = (const GLA_GAS unsigned short*)VR_; GLA_GAS unsigned short* O = (GLA_GAS unsigned short*)O_;
    const int tid = threadIdx.x, wid = __builtin_amdgcn_readfirstlane(tid >> 6), lane = tid & 63, r32 = lane & 31, hi = lane >> 5;
    const int vt = wid & 3, kh = wid >> 2;
    GLA_LAS unsigned char* QT = lds + OFF_QT; GLA_LAS unsigned char* KH = lds + OFF_KH; GLA_LAS unsigned char* VI = lds + OFF_V; GLA_LAS unsigned char* PI = lds + OFF_P; GLA_LAS float* EL = (GLA_LAS float*)(lds + OFF_EL);
    GLA_LAS f32x4* XOs = (GLA_LAS f32x4*)(lds + (wid < 4 ? OFF_XO_A + wid * 4096 : OFF_XO_B + (wid - 4) * 4096));
    GLA_LAS f32x4* XOr = (GLA_LAS f32x4*)(lds + ((wid ^ 4) < 4 ? OFF_XO_A + (wid ^ 4) * 4096 : OFF_XO_B + ((wid ^ 4) - 4) * 4096));
    f32x16 S[2] = {f32x16{}, f32x16{}};
    const int vb = (int)(unsigned)(uintptr_t)VI + v_rd_base(lane) + vt * 512;
    const int nchunk = (CTX_ + SEQ_) / 64, nctx = CTX_ / 64;
    const size_t tile0 = (size_t)((b * 4 + h) * 2 + dir) * 36;
    u32x4 pq[2], pk[2], pp, pv[2]; float pe = 0.f;
#define GLA_CS(sc_) ((dir == 0) ? (sc_) : (((sc_) < nctx) ? (nctx - 1 - (sc_)) : (nchunk - 1 - ((sc_) - nctx))))
#define GLA_FETCH(sc_) do { const int cs_ = GLA_CS(sc_); const size_t t_ = tile0 + cs_; const long r0_ = (cs_ < nctx) ? (long)ML_ + (long)b * CTX_ + 64 * cs_ : (long)b * SEQ_ + 64 * (cs_ - nctx); \
        const GLA_GAS u32x4* q_ = (const GLA_GAS u32x4*)((const GLA_GAS unsigned short*)TQ_ + t_ * 8192); const GLA_GAS u32x4* k_ = (const GLA_GAS u32x4*)((const GLA_GAS unsigned short*)TK_ + t_ * 8192); \
        pq[0] = q_[tid]; pq[1] = q_[tid + 512]; pk[0] = k_[tid]; pk[1] = k_[tid + 512]; pp = ((const GLA_GAS u32x4*)((const GLA_GAS unsigned short*)TP_ + t_ * 4096))[tid]; \
        if (tid < 128) pe = ((const GLA_GAS float*)EL_)[t_ * 128 + tid]; \
        _Pragma("unroll") for (int i_ = 0; i_ < 2; ++i_) { const int c_ = tid + 512 * i_; pv[i_] = *(const GLA_GAS u32x4*)(VR + (r0_ + (c_ >> 4)) * 2304 + h * 256 + vh * 128 + (c_ & 15) * 8); } } while (0)
    GLA_FETCH(0);
    for (int sc = 0; sc < nchunk; ++sc) {
        const int cs = GLA_CS(sc); const bool is_lat = cs >= nctx; const long row0 = is_lat ? (long)b * SEQ_ + 64 * (cs - nctx) : (long)ML_ + (long)b * CTX_ + 64 * cs;
#pragma unroll
        for (int i = 0; i < 2; ++i) { const int c = tid + 512 * i; *(GLA_LAS u32x4*)(QT + (c >> 4) * RS256 + (c & 15) * 16) = pq[i]; *(GLA_LAS u32x4*)(KH + (c >> 3) * RS128 + (c & 7) * 16) = pk[i];
            *(GLA_LAS u32x4*)(VI + v_st4(c >> 4, (c & 15) * 8)) = pv[i]; }
        *(GLA_LAS u32x4*)(PI + (tid >> 3) * RS128 + (tid & 7) * 16) = pp;
        if (tid < 128) EL[tid] = pe;
        __syncthreads();
        if (sc + 1 < nchunk) GLA_FETCH(sc + 1);
        f32x16 op[2] = {f32x16{}, f32x16{}};
#pragma unroll
        for (int j = 0; j < 2; ++j)
#pragma unroll
            for (int s2 = 0; s2 < 2; ++s2) { const bf16x8 bs = pack_step(S[j], s2); const int cb0 = (32 * (2 * kh + j) + 16 * s2 + 4 * hi) * 2;
#pragma unroll
                for (int rb = 0; rb < 2; ++rb) { const int l = 32 * rb + r32;
                    const s16x4 a0 = *(const GLA_LAS s16x4*)(QT + swz256(l, cb0)), a1 = *(const GLA_LAS s16x4*)(QT + swz256(l, cb0 + 16));
                    const bf16x8 a = {a0[0], a0[1], a0[2], a0[3], a1[0], a1[1], a1[2], a1[3]}; op[rb] = GLA_MFMA(a, bs, op[rb]); } }
        { const f32x16& snd = kh ? op[0] : op[1];
#pragma unroll
          for (int g = 0; g < 4; ++g) XOs[g * 64 + lane] = (f32x4){snd[4 * g], snd[4 * g + 1], snd[4 * g + 2], snd[4 * g + 3]}; }
        __syncthreads();
        f32x16 o = kh ? op[1] : op[0];
#pragma unroll
        for (int g = 0; g < 4; ++g) { const f32x4 rv = XOr[g * 64 + lane]; o[4 * g] += rv.x; o[4 * g + 1] += rv.y; o[4 * g + 2] += rv.z; o[4 * g + 3] += rv.w; }
        bf16x8 vf[4];
        { const s16x4 l0 = tr_read<0 * 4096>(vb), h0 = tr_read<0 * 4096 + 2048>(vb), l1 = tr_read<1 * 4096>(vb), h1 = tr_read<1 * 4096 + 2048>(vb);
          const s16x4 l2 = tr_read<2 * 4096>(vb), h2 = tr_read<2 * 4096 + 2048>(vb), l3 = tr_read<3 * 4096>(vb), h3 = tr_read<3 * 4096 + 2048>(vb);
          asm volatile("s_waitcnt lgkmcnt(0)" ::: "memory"); __builtin_amdgcn_sched_barrier(0);
          vf[0] = (bf16x8){l0[0], l0[1], l0[2], l0[3], h0[0], h0[1], h0[2], h0[3]}; vf[1] = (bf16x8){l1[0], l1[1], l1[2], l1[3], h1[0], h1[1], h1[2], h1[3]};
          vf[2] = (bf16x8){l2[0], l2[1], l2[2], l2[3], h2[0], h2[1], h2[2], h2[3]}; vf[3] = (bf16x8){l3[0], l3[1], l3[2], l3[3], h3[0], h3[1], h3[2], h3[3]}; }
#pragma unroll
        for (int ks = 0; ks < 4; ++ks) { const bf16x8 a = *(const GLA_LAS bf16x8*)(PI + swz128(32 * kh + r32, (16 * ks + 8 * hi) * 2)); o = GLA_MFMA(a, vf[ks], o); }
        if (is_lat) {
#pragma unroll
            for (int r = 0; r < 16; ++r) O[(row0 + 32 * kh + crow(r, hi)) * 1024 + h * 256 + vh * 128 + 32 * vt + r32] = bf1f(o[r]); }
#pragma unroll
        for (int j = 0; j < 2; ++j) { const int kt = 2 * kh + j;
#pragma unroll
            for (int ks = 0; ks < 4; ++ks) { const bf16x8 a = *(const GLA_LAS bf16x8*)(KH + swz128(32 * kt + r32, (16 * ks + 8 * hi) * 2)); S[j] = GLA_MFMA(a, vf[ks], S[j]); }
#pragma unroll
            for (int r = 0; r < 16; ++r) S[j][r] *= EL[32 * kt + crow(r, hi)]; }
        __syncthreads();
    }
#undef GLA_FETCH
#undef GLA_CS
}
#undef GLA_MFMA
}

constexpr int NWAVES = 8;
constexpr int D = 1024, NB = 16, SEQ = 2048, CTXL = 256, TT = SEQ + CTXL;
constexpr int ML = NB * SEQ, MC = NB * CTXL, MA = ML + MC;
constexpr float EPS = 1e-6f;
constexpr int S5W = 512, S5G = 32, S5H = 16, S5P = 64;
constexpr int NH = 8, NOPE = 64, ROPE = 32, QK = 96, VD = 64, QRANK = 256, KVRANK = 128;
constexpr int EV_IN = 928, EV_INP = 1024, NQKV = 1792, KQKV = 384;
constexpr int GH = 4, GDK = 128, GDV = 256, GKEY = 512, GVAL = 1024, GRANK = 16;
constexpr int OD_IN = 3104, OD_INP = 3328;
constexpr int FFN = 2816, NE = 8, FE = 3584;
constexpr int MOE_MAXT = 264;

constexpr size_t MiB = 1u << 20;
constexpr size_t WS_CTL = 0, CTL_ZERO_BYTES = 1 * MiB;
constexpr size_t WS_MODV = 1 * MiB;
constexpr size_t WS_TOK = 2 * MiB;
constexpr size_t WS_INV = 3 * MiB;
constexpr size_t WS_W_IN1 = 4 * MiB, WS_W_OUT1 = 11 * MiB, WS_W_MGU = 13 * MiB  , WS_W_MDN = 69 * MiB  ;
constexpr size_t WS_W_IN0 = 97 * MiB, WS_W_QKV = 99 * MiB, WS_W_GLU = 100 * MiB + 512 * 1024, WS_W_OUT0 = 101 * MiB, WS_W_GU = 103 * MiB, WS_W_DN = 114 * MiB, WS_HC = 120 * MiB;
constexpr size_t PB = 136 * MiB;
constexpr size_t WS_XL = PB + 0 * MiB, WS_Q = PB + 0 * MiB, WS_A3 = PB + 72 * MiB, WS_YL = PB + 72 * MiB, WS_KV = PB + 144 * MiB, WS_Z0C = PB + 144 * MiB, WS_U = PB + 180 * MiB, WS_DS = PB + 216 * MiB, WS_AO = PB + 216 * MiB,
                 WS_QA = PB + 288 * MiB, WS_AG = PB + 288 * MiB, WS_KR = PB + 324 * MiB, WS_B1 = PB + 328 * MiB, WS_B3 = PB + 332 * MiB;
constexpr size_t WS_ACT = PB + 72 * MiB, WS_FL = PB + 270 * MiB;
constexpr size_t WS_TP = 97 * MiB, WS_EL = 133 * MiB, WS_OF = PB, WS_VR = 208 * MiB, WS_QK = 370 * MiB, WS_OB = 370 * MiB, WS_YL1 = 370 * MiB, WS_TQ = 442 * MiB, WS_TK = 514 * MiB;
constexpr int VRLD = 2304;
constexpr int GLA_TILES = NB * GH * 2 * 36;
constexpr int MOE_W_ITEMS = NE * (2 * (D / 64) * (FE / 32) + (FE / 64) * (D / 32));
constexpr int MW0 = 0, MW1 = (MOE_W_ITEMS * 20) / 100, MW2 = (MOE_W_ITEMS * 40) / 100, MW3 = (MOE_W_ITEMS * 54) / 100, MW4 = (MOE_W_ITEMS * 82) / 100, MW5 = MOE_W_ITEMS;
constexpr size_t WS_XLM = PB + 0 * MiB, WS_Y = PB + 0 * MiB, WS_XG = PB + 132 * MiB, WS_ACTM = PB + 198 * MiB;
constexpr size_t WS_END = 588 * MiB;
static_assert(WS_KR + (size_t)MA * 32 * 2 <= WS_B1 && WS_KV + (size_t)MA * 1024 * 2 <= WS_DS && WS_AG + (size_t)MA * 512 * 2 <= WS_KR && WS_AO + (size_t)MA * D * 2 <= WS_AG && WS_A3 + (size_t)MA * 1024 * 2 <= WS_KV &&
              WS_Z0C + (size_t)MA * 512 * 2 <= WS_U && WS_U + (size_t)MA * 512 * 2 <= WS_DS && WS_DS + (size_t)MA * 512 * 4 <= WS_QA && WS_QA + (size_t)MA * KQKV * 2 <= WS_KR && WS_B1 + (size_t)32 * 256 * 256 * 2 <= WS_B3 && WS_B3 + (size_t)32 * 256 * 512 * 2 <= WS_END, "ws map");
static_assert(WS_FL + (size_t)MA * D * 2 <= WS_END && WS_ACT + (size_t)MA * FFN * 2 <= WS_FL, "ws map 2");
static_assert(WS_TP + (size_t)GLA_TILES * 8192 <= WS_EL && WS_EL + (size_t)GLA_TILES * 512 <= PB && WS_XL + (size_t)MA * D * 2 <= WS_VR && WS_VR + (size_t)MA * VRLD * 2 <= WS_QK && WS_QK + (size_t)MA * 1024 * 2 <= WS_TQ &&
              WS_TQ + (size_t)GLA_TILES * 16384 <= WS_TK && WS_TK + (size_t)GLA_TILES * 16384 <= WS_END && WS_OF + (size_t)ML * D * 2 <= WS_VR && WS_OB + (size_t)ML * D * 2 <= WS_TQ, "ws map layer 1");
static_assert(WS_Y + (size_t)MOE_MAXT * 256 * D * 2 <= WS_XG && WS_XG + (size_t)MOE_MAXT * 256 * D <= WS_ACTM && WS_ACTM + (size_t)MOE_MAXT * 256 * FE <= WS_END && WS_XLM + (size_t)ML * D <= WS_XG, "ws map 3");
static_assert(WS_W_IN1 + (size_t)OD_INP * D * 2 <= WS_W_OUT1 && WS_W_OUT1 + (size_t)D * D * 2 <= WS_W_MGU && WS_W_MGU + (size_t)NE * 2 * FE * D <= WS_W_MDN && WS_W_MDN + (size_t)NE * D * FE <= WS_W_IN0 &&
              WS_W_GU + (size_t)2 * FFN * D * 2 <= WS_W_DN && WS_W_DN + (size_t)D * FFN * 2 <= WS_HC && WS_HC + (size_t)MC * D * 4 <= PB, "ws map 4");
#ifndef FFN0_FP8
#define FFN0_FP8 0
#endif
constexpr bool FFN0_IS_FP8 = FFN0_FP8;
#ifndef FFN0_DOWN_FP8
#define FFN0_DOWN_FP8 1
#endif
constexpr bool FFN0_DN_FP8 = FFN0_DOWN_FP8;
constexpr float FP8_SA = 8.0f, FP8_SW = 128.0f, FP8_SACT = 4.0f;

constexpr int CW_TMO = 0, CW_CODE = 1, CW_CNT = 64, CW_BAR = 4096;

constexpr int RING_OFF = 0, RING_BYTES = 131072;
constexpr int ATAB_OFF = RING_BYTES + 1024, ATAB_UNITS = 29;
constexpr int LDSCTL_OFF = RING_BYTES, MISC_OFF = LDSCTL_OFF + 320;
constexpr int LDS_BYTES = 147456;
static_assert(ATAB_OFF + ATAB_UNITS * 512 <= LDS_BYTES, "LDS map: row table");

struct Args { const float* in[35]; float* out; unsigned char* ws; int ph_lo, ph_hi; };
struct Frame { LAS unsigned char* lds; volatile LAS unsigned* MISC; gu32* ctl; int tid, lane, wave, G, gw, ngw; };

__device__ __forceinline__ float wave_sum(float v) {
#pragma unroll
    for (int o = 1; o < 64; o <<= 1) v += __shfl_xor(v, o);
    return v;
}
__device__ __forceinline__ float bf_lo(unsigned u) { return __uint_as_float(u << 16); }
__device__ __forceinline__ float bf_hi(unsigned u) { return __uint_as_float(u & 0xffff0000u); }
__device__ __forceinline__ float bf1(bf16 u) { return __uint_as_float(((unsigned)u) << 16); }
typedef unsigned v2u __attribute__((ext_vector_type(2)));
__device__ __forceinline__ unsigned pk4_fp8(float a, float b, float c, float d) { return pg8::pk4_fp8(a, b, c, d); }

__device__ __forceinline__ void ld_row_f32(const float* p, int lane, f32x4 (&v)[4]) {
    const GAS f32x4* q = (const GAS f32x4*)p + lane;
#pragma unroll
    for (int j = 0; j < 4; ++j) v[j] = q[64 * j];
}
__device__ __forceinline__ void st_row_f32(float* p, int lane, const f32x4 (&v)[4]) {
    GAS f32x4* q = (GAS f32x4*)p + lane;
#pragma unroll
    for (int j = 0; j < 4; ++j) q[64 * j] = v[j];
}
__device__ __forceinline__ void ld_row_bf16(const bf16* p, int lane, f32x4 (&v)[4]) {
    const GAS v2u* q = (const GAS v2u*)p + lane;
#pragma unroll
    for (int j = 0; j < 4; ++j) { const v2u w = q[64 * j]; v[j] = (f32x4){bf_lo(w.x), bf_hi(w.x), bf_lo(w.y), bf_hi(w.y)}; }
}
__device__ __forceinline__ void st_row_bf16(bf16* p, int lane, const f32x4 (&v)[4]) {
    GAS v2u* q = (GAS v2u*)p + lane;
#pragma unroll
    for (int j = 0; j < 4; ++j) { v2u w; w.x = pk2(v[j].x, v[j].y); w.y = pk2(v[j].z, v[j].w); q[64 * j] = w; }
}
__device__ __forceinline__ void st_row_fp8(unsigned char* p, int lane, const f32x4 (&v)[4], float sc) {
    GAS unsigned* q = (GAS unsigned*)p + lane;
#pragma unroll
    for (int j = 0; j < 4; ++j) q[64 * j] = pk4_fp8(v[j].x * sc, v[j].y * sc, v[j].z * sc, v[j].w * sc);
}
__device__ __forceinline__ float row_rs(const f32x4 (&v)[4]) {
    float s = 0.f;
#pragma unroll
    for (int j = 0; j < 4; ++j) s += (v[j].x * v[j].x + v[j].y * v[j].y) + (v[j].z * v[j].z + v[j].w * v[j].w);
    return rsqrtf(wave_sum(s) * (1.0f / D) + EPS);
}
__device__ __forceinline__ void norm_mod(f32x4 (&v)[4], const float* gam, const float* sh, const float* sc, int lane) {
    const float rs = row_rs(v); f32x4 g[4], a[4], b[4]; ld_row_f32(gam, lane, g); ld_row_f32(sh, lane, a); ld_row_f32(sc, lane, b);
#pragma unroll
    for (int j = 0; j < 4; ++j) v[j] = (v[j] * rs) * g[j] * (1.0f + b[j]) + a[j];
}
__device__ __forceinline__ void gated_add(f32x4 (&h)[4], const f32x4 (&y)[4], const float* gam, const float* gate, int lane) {
    const float rs = row_rs(y); f32x4 g[4], t[4]; ld_row_f32(gam, lane, g); ld_row_f32(gate, lane, t);
#pragma unroll
    for (int j = 0; j < 4; ++j) h[j] = h[j] + t[j] * ((y[j] * rs) * g[j]);
}

__device__ __forceinline__ void cvt_item(const float* W, int K, int N, bf16* WT, int ldk, int kcol0, int row_off, int mode, const float* gain, float scale, int nscale,
                                         LAS float* scr, int item, int lane, bool fp8 = false, bool tiled = false) {
    const int nblk = N / 32, kb = item / nblk, nb = item % nblk, k0 = 64 * kb, n0 = 32 * nb;
    { f32x4 t[8];
#pragma unroll
      for (int i = 0; i < 8; ++i) t[i] = *(const GAS f32x4*)(W + (size_t)(k0 + 8 * i + (lane >> 3)) * N + n0 + 4 * (lane & 7));
#pragma unroll
      for (int i = 0; i < 8; ++i) { LAS float* d = scr + (8 * i + (lane >> 3)) * 33 + 4 * (lane & 7); d[0] = t[i].x; d[1] = t[i].y; d[2] = t[i].z; d[3] = t[i].w; } }
    LDS_WAIT(); asm volatile("" ::: "memory");
    const int c = lane & 7;
    float gn[8];
#pragma unroll
    for (int q = 0; q < 8; ++q) gn[q] = (gain ? gain[k0 + 8 * c + q] : 1.0f) * ((n0 < nscale) ? scale : 1.0f);
    const int drow0 = (mode == 0) ? n0 : (mode == 3) ? ((n0 >> 7) * 64 + (n0 & 63) + ((n0 & 64) ? 512 : 0)) : ((n0 >> 7) * 256 + (n0 & 127) + (mode == 2 ? 128 : 0));
#pragma unroll
    for (int j = 0; j < 4; ++j) { const int n = (lane >> 3) + 8 * j; const LAS float* s = scr + (8 * c) * 33 + n;
        if (fp8) { v2u o; o.x = pk4_fp8(s[0 * 33] * gn[0], s[1 * 33] * gn[1], s[2 * 33] * gn[2], s[3 * 33] * gn[3]); o.y = pk4_fp8(s[4 * 33] * gn[4], s[5 * 33] * gn[5], s[6 * 33] * gn[6], s[7 * 33] * gn[7]);
            const int drow = row_off + drow0 + n, kc = kcol0 + k0 + 8 * c;
            unsigned char* dp = tiled ? (unsigned char*)WT + (size_t)(drow >> 8) * 256 * ldk + (size_t)(kc >> 7) * 32768 + (drow & 255) * 128 + (kc & 127) : (unsigned char*)WT + (size_t)drow * ldk + kc;
            *(GAS v2u*)dp = o; }
        else { v4u o; o.x = pk2(s[0 * 33] * gn[0], s[1 * 33] * gn[1]); o.y = pk2(s[2 * 33] * gn[2], s[3 * 33] * gn[3]); o.z = pk2(s[4 * 33] * gn[4], s[5 * 33] * gn[5]); o.w = pk2(s[6 * 33] * gn[6], s[7 * 33] * gn[7]);
            *(GAS v4u*)(WT + (size_t)(row_off + drow0 + n) * ldk + kcol0 + k0 + 8 * c) = o; } }
    LDS_WAIT(); asm volatile("" ::: "memory");
}
__device__ __forceinline__ void moe_weights(Frame& F, const Args& A, int it_lo, int it_hi, int widx, int nw) {
    LAS float* scr = (LAS float*)(F.lds + RING_OFF + F.wave * 16384);
    unsigned char* ws = A.ws;
    constexpr int I_MG1 = (D / 64) * (FE / 32), I_MD1 = (FE / 64) * (D / 32);
    for (int it = it_lo + widx; it < it_hi; it += nw) {
        int r = it;
        if (r < NE * I_MG1) { const int e = r / I_MG1; cvt_item(A.in[32] + (size_t)e * D * FE, D, FE, (bf16*)(ws + WS_W_MGU + (size_t)e * 2 * FE * D), D, 0, 0, 1, nullptr, FP8_SW, 1 << 30, scr, r % I_MG1, F.lane, true); continue; } r -= NE * I_MG1;
        if (r < NE * I_MG1) { const int e = r / I_MG1; cvt_item(A.in[33] + (size_t)e * D * FE, D, FE, (bf16*)(ws + WS_W_MGU + (size_t)e * 2 * FE * D), D, 0, 0, 2, nullptr, FP8_SW, 1 << 30, scr, r % I_MG1, F.lane, true); continue; } r -= NE * I_MG1;
        { const int e = r / I_MD1; cvt_item(A.in[34] + (size_t)e * FE * D, FE, D, (bf16*)(ws + WS_W_MDN + (size_t)e * D * FE), FE, 0, 0, 0, nullptr, FP8_SW, 1 << 30, scr, r % I_MD1, F.lane, true, true); }
    }
}
__device__ __forceinline__ void tail_convert(Frame& F, const Args& A, int nunit, int lo, int hi) {
    const int nlast = nunit % F.G, bid = (int)blockIdx.x;
    if (nlast != 0) { if (bid >= nlast) moe_weights(F, A, lo, hi, (bid - nlast) * NWAVES + F.wave, (F.G - nlast) * NWAVES); }
    else moe_weights(F, A, lo, hi, F.gw, F.ngw);
}
__device__ __forceinline__ void gen_s5(Frame& F, const Args& A, int g);
#ifndef PROBE_BLK
#define PROBE_BLK 0
#endif
#ifdef PROBE_SETA
#define PROBE_STAMP2(F, k) do { if (blockIdx.x == PROBE_BLK && F.tid == 0) { const unsigned long long t_ = __builtin_amdgcn_s_memrealtime(); const unsigned long long l_ = ((unsigned long long)F.MISC[17] << 32) | F.MISC[16]; const unsigned d_ = (unsigned)(t_ - l_); \
        if ((PROBE_SETA >> (k)) & 1ull) F.MISC[18] += d_; if ((PROBE_SETB >> (k)) & 1ull) F.MISC[20] += d_; F.MISC[16] = (unsigned)t_; F.MISC[17] = (unsigned)(t_ >> 32); } } while (0)
#else
#define PROBE_STAMP2(F, k) do { } while (0)
#endif
__device__ __forceinline__ void p0_prologue(Frame& F, const Args& A) {
    LAS float* scr = (LAS float*)(F.lds + RING_OFF + F.wave * 16384);
    unsigned char* ws = A.ws;
    constexpr int I_IN0 = (D / 64) * (EV_IN / 32), I_UQ = (QRANK / 64) * (768 / 32), I_UKV = (KVRANK / 64) * (1024 / 32), I_GLU = (512 / 64) * (512 / 32), I_OUT = (D / 64) * (D / 32);
    constexpr int I_FG = (D / 64) * (FFN / 32), I_FD = (FFN / 64) * (D / 32), I_IN1 = (D / 64) * (OD_IN / 32), I_MG1 = (D / 64) * (FE / 32), I_MD1 = (FE / 64) * (D / 32);
    constexpr int NITEMS = I_IN0 + I_UQ + I_UKV + I_GLU + I_OUT + 2 * I_FG + I_FD + I_IN1 + I_OUT;
    const bool s5_builder = (int)blockIdx.x >= F.G - S5G;
    for (int it = s5_builder ? NITEMS : F.gw; it < NITEMS; it += F.ngw - S5G * NWAVES) {
        int r = it;
        if (r < I_IN0) { cvt_item(A.in[7], D, EV_IN, (bf16*)(ws + WS_W_IN0), D, 0, 0, 0, nullptr, 1.f, 0, scr, r, F.lane); continue; } r -= I_IN0;
        if (r < I_UQ) { cvt_item(A.in[19], QRANK, 768, (bf16*)(ws + WS_W_QKV), KQKV, 0, 0, 0, A.in[18], 1.f, 0, scr, r, F.lane); continue; } r -= I_UQ;
        if (r < I_UKV) { cvt_item(A.in[21], KVRANK, 1024, (bf16*)(ws + WS_W_QKV), KQKV, QRANK, 768, 3, A.in[20], 1.f, 0, scr, r, F.lane); continue; } r -= I_UKV;
        if (r < I_GLU) { cvt_item(A.in[16], 512, 512, (bf16*)(ws + WS_W_GLU), 512, 0, 0, 0, nullptr, 1.f, 0, scr, r, F.lane); continue; } r -= I_GLU;
        if (r < I_OUT) { cvt_item(A.in[22], D, D, (bf16*)(ws + WS_W_OUT0), D, 0, 0, 0, nullptr, 1.f, 0, scr, r, F.lane); continue; } r -= I_OUT;
        if (r < I_FG) { cvt_item(A.in[23], D, FFN, (bf16*)(ws + WS_W_GU), D, 0, 0, 1, nullptr, FFN0_IS_FP8 ? FP8_SW : 1.f, 1 << 30, scr, r, F.lane, FFN0_IS_FP8); continue; } r -= I_FG;
        if (r < I_FG) { cvt_item(A.in[24], D, FFN, (bf16*)(ws + WS_W_GU), D, 0, 0, 2, nullptr, FFN0_IS_FP8 ? FP8_SW : 1.f, 1 << 30, scr, r, F.lane, FFN0_IS_FP8); continue; } r -= I_FG;
        if (r < I_FD) { cvt_item(A.in[25], FFN, D, (bf16*)(ws + WS_W_DN), FFN, 0, 0, 0, nullptr, (FFN0_IS_FP8 || FFN0_DN_FP8) ? FP8_SW : 1.f, 1 << 30, scr, r, F.lane, FFN0_IS_FP8 || FFN0_DN_FP8); continue; } r -= I_FD;
        if (r < I_IN1) { cvt_item(A.in[26], D, OD_IN, (bf16*)(ws + WS_W_IN1), D, 0, 0, 0, nullptr, 0.08838834764831845f, GKEY, scr, r, F.lane); continue; } r -= I_IN1;
        cvt_item(A.in[30], D, D, (bf16*)(ws + WS_W_OUT1), D, 0, 0, 0, nullptr, 1.f, 0, scr, r, F.lane);
    }
    { const v4u z = {0u, 0u, 0u, 0u}; const int gt = blockIdx.x * (NWAVES * 64) + F.tid, ngt = F.G * NWAVES * 64;
      GAS v4u* p0 = (GAS v4u*)((bf16*)(ws + WS_W_IN0) + (size_t)EV_IN * D); for (int i = gt; i < (EV_INP - EV_IN) * D / 8; i += ngt) p0[i] = z;
      for (int i = gt; i < 768 * (KVRANK / 8); i += ngt) { const int r = i / (KVRANK / 8), c = i % (KVRANK / 8); *(GAS v4u*)((bf16*)(ws + WS_W_QKV) + (size_t)r * KQKV + QRANK + 8 * c) = z; }
      for (int i = gt; i < 1024 * (QRANK / 8); i += ngt) { const int r = i / (QRANK / 8), c = i % (QRANK / 8); *(GAS v4u*)((bf16*)(ws + WS_W_QKV) + (size_t)(768 + r) * KQKV + 8 * c) = z; }
      GAS v4u* p1 = (GAS v4u*)((bf16*)(ws + WS_W_IN1) + (size_t)OD_IN * D); for (int i = gt; i < (OD_INP - OD_IN) * D / 8; i += ngt) p1[i] = z; }
    __syncthreads();
    PROBE_STAMP2(F, 22);
    LAS float* act = (LAS float*)(F.lds);
    LAS float* red = (LAS float*)(F.lds + 17 * 1024 * 4);
    float* modv = (float*)(ws + WS_MODV);
    bool have_act = false;
    for (int u = blockIdx.x; u < 2 * 96; u += F.G) {
        if (!have_act) {
            float xv[17 * 1024 / (NWAVES * 64)];
#pragma unroll
            for (int q = 0; q < 17 * 1024 / (NWAVES * 64); ++q) { const int i = F.tid + q * (NWAVES * 64); xv[q] = (i < 16 * 1024) ? A.in[1][i] : A.in[3][i - 16 * 1024]; }
#pragma unroll
            for (int q = 0; q < 17 * 1024 / (NWAVES * 64); ++q) { const float x = xv[q]; act[F.tid + q * (NWAVES * 64)] = x / (1.0f + __expf(-x)); }
            have_act = true;
        }
        __syncthreads();
        const int layer = u / 96, c0 = (u % 96) * 64;
        const float* mw = A.in[4] + (size_t)layer * D * 6144 + c0 + F.lane;
        float acc[17];
#pragma unroll
        for (int r = 0; r < 17; ++r) acc[r] = 0.f;
        for (int k0 = F.wave * 128; k0 < F.wave * 128 + 128; k0 += 32) { float w[32];
#pragma unroll
            for (int u2 = 0; u2 < 32; ++u2) w[u2] = mw[(size_t)(k0 + u2) * 6144];
#pragma unroll
            for (int u2 = 0; u2 < 32; ++u2)
#pragma unroll
                for (int r = 0; r < 17; ++r) acc[r] += act[r * 1024 + k0 + u2] * w[u2]; }
#pragma unroll
        for (int r = 0; r < 17; ++r) red[(F.wave * 17 + r) * 64 + F.lane] = acc[r];
        __syncthreads();
        for (int i = F.tid; i < 17 * 64; i += NWAVES * 64) { const int r = i >> 6, l = i & 63; float s = A.in[5][layer * 6144 + c0 + l];
#pragma unroll
            for (int w = 0; w < 8; ++w) s += red[(w * 17 + r) * 64 + l];
            modv[(size_t)(layer * 17 + r) * 6144 + c0 + l] = s; }
    }
    __syncthreads();
    PROBE_STAMP2(F, 23);
    for (int g = (int)blockIdx.x - (F.G - S5G); g >= 0 && g < S5G; g += F.G) gen_s5(F, A, g);
    PROBE_STAMP2(F, 24);
}

__device__ __forceinline__ void thin_t1(Frame& F, const Args& A) {
    const float* modv = (const float*)(A.ws + WS_MODV); bf16* XL = (bf16*)(A.ws + WS_XL); const float* gam = A.in[6];
    for (int r0 = F.gw; r0 < MA; r0 += 2 * F.ngw) {
        const int r1 = (r0 + F.ngw < MA) ? r0 + F.ngw : r0; const bool two = r1 != r0;
        const bool lat0 = r0 < ML, lat1 = r1 < ML; const float* src0 = lat0 ? A.in[0] + (size_t)r0 * D : A.in[2] + (size_t)(r0 - ML) * D; const float* src1 = lat1 ? A.in[0] + (size_t)r1 * D : A.in[2] + (size_t)(r1 - ML) * D;
        const float* mod0 = modv + (size_t)(lat0 ? r0 / SEQ : 16) * 6144; const float* mod1 = modv + (size_t)(lat1 ? r1 / SEQ : 16) * 6144;
        f32x4 v0[4], v1[4]; ld_row_f32(src0, F.lane, v0); ld_row_f32(src1, F.lane, v1);
        norm_mod(v0, gam, mod0, mod0 + D, F.lane); st_row_bf16(XL + (size_t)r0 * D, F.lane, v0);
        norm_mod(v1, gam, mod1, mod1 + D, F.lane); if (two) st_row_bf16(XL + (size_t)r1 * D, F.lane, v1);
    }
}
__device__ __forceinline__ void thin_t2(Frame& F, const Args& A) {
    const float* modv = (const float*)(A.ws + WS_MODV); bf16* XL = (bf16*)(A.ws + WS_XL); const bf16* YL = (const bf16*)(A.ws + WS_YL); float* HC = (float*)(A.ws + WS_HC); const float* gam = A.in[6];
    for (int r0 = F.gw; r0 < MA; r0 += 2 * F.ngw) {
        const int r1 = (r0 + F.ngw < MA) ? r0 + F.ngw : r0; const bool two = r1 != r0;
        const bool lat0 = r0 < ML, lat1 = r1 < ML;
        const float* src0 = lat0 ? A.in[0] + (size_t)r0 * D : A.in[2] + (size_t)(r0 - ML) * D; const float* src1 = lat1 ? A.in[0] + (size_t)r1 * D : A.in[2] + (size_t)(r1 - ML) * D;
        float* dst0 = lat0 ? A.out + (size_t)r0 * D : HC + (size_t)(r0 - ML) * D; float* dst1 = lat1 ? A.out + (size_t)r1 * D : HC + (size_t)(r1 - ML) * D;
        const float* mod0 = modv + (size_t)(lat0 ? r0 / SEQ : 16) * 6144; const float* mod1 = modv + (size_t)(lat1 ? r1 / SEQ : 16) * 6144;
        f32x4 h0[4], y0[4], h1[4], y1[4];
        ld_row_f32(src0, F.lane, h0); ld_row_bf16(YL + (size_t)r0 * D, F.lane, y0); ld_row_f32(src1, F.lane, h1); ld_row_bf16(YL + (size_t)r1 * D, F.lane, y1);
        gated_add(h0, y0, gam + 1 * D, mod0 + 2 * D, F.lane); gated_add(h1, y1, gam + 1 * D, mod1 + 2 * D, F.lane);
        st_row_f32(dst0, F.lane, h0); if (two) st_row_f32(dst1, F.lane, h1);
        norm_mod(h0, gam + 2 * D, mod0 + 3 * D, mod0 + 4 * D, F.lane); norm_mod(h1, gam + 2 * D, mod1 + 3 * D, mod1 + 4 * D, F.lane);
        if (FFN0_IS_FP8) { st_row_fp8((unsigned char*)XL + (size_t)r0 * D, F.lane, h0, FP8_SA); if (two) st_row_fp8((unsigned char*)XL + (size_t)r1 * D, F.lane, h1, FP8_SA); }
        else { st_row_bf16(XL + (size_t)r0 * D, F.lane, h0); if (two) st_row_bf16(XL + (size_t)r1 * D, F.lane, h1); }
    }
}
__device__ __forceinline__ void thin_t3(Frame& F, const Args& A) {
    const float* modv = (const float*)(A.ws + WS_MODV); bf16* XL = (bf16*)(A.ws + WS_XL); const bf16* FL = (const bf16*)(A.ws + WS_FL); const float* HC = (const float*)(A.ws + WS_HC); const float* gam = A.in[6];
    for (int r0 = F.gw; r0 < MA; r0 += 2 * F.ngw) {
        const int r1 = (r0 + F.ngw < MA) ? r0 + F.ngw : r0; const bool two = r1 != r0;
        const bool lat0 = r0 < ML, lat1 = r1 < ML;
        const float* src0 = lat0 ? A.out + (size_t)r0 * D : HC + (size_t)(r0 - ML) * D; const float* src1 = lat1 ? A.out + (size_t)r1 * D : HC + (size_t)(r1 - ML) * D;
        const int bs0 = lat0 ? r0 / SEQ : 16, bs1 = lat1 ? r1 / SEQ : 16;
        f32x4 h0[4], y0[4], h1[4], y1[4];
        ld_row_f32(src0, F.lane, h0); ld_row_bf16(FL + (size_t)r0 * D, F.lane, y0); ld_row_f32(src1, F.lane, h1); ld_row_bf16(FL + (size_t)r1 * D, F.lane, y1);
        gated_add(h0, y0, gam + 3 * D, modv + (size_t)bs0 * 6144 + 5 * D, F.lane); gated_add(h1, y1, gam + 3 * D, modv + (size_t)bs1 * 6144 + 5 * D, F.lane);
        if (lat0) st_row_f32(A.out + (size_t)r0 * D, F.lane, h0); if (two && lat1) st_row_f32(A.out + (size_t)r1 * D, F.lane, h1);
        { const float* m0 = modv + (size_t)(17 + bs0) * 6144; const float* m1 = modv + (size_t)(17 + bs1) * 6144;
          norm_mod(h0, gam + 4 * D, m0, m0 + D, F.lane); norm_mod(h1, gam + 4 * D, m1, m1 + D, F.lane); }
        st_row_bf16(XL + (size_t)r0 * D, F.lane, h0); if (two) st_row_bf16(XL + (size_t)r1 * D, F.lane, h1);
    }
}
__device__ __forceinline__ void thin_t4(Frame& F, const Args& A) {
    const float* modv = (const float*)(A.ws + WS_MODV); bf16* XL = (bf16*)(A.ws + WS_XLM); const bf16* YL = (const bf16*)(A.ws + WS_YL1); const float* gam = A.in[6] + 4 * D;
    const float* router = A.in[31]; unsigned* tok = (unsigned*)(A.ws + WS_TOK); unsigned short* inv = (unsigned short*)(A.ws + WS_INV);
    LAS float* rt = (LAS float*)(F.lds);
    LAS unsigned* wc = (LAS unsigned*)(F.lds + 32768);
    __syncthreads();
    for (int i = F.tid; i < 8 * 1024; i += NWAVES * 64) { const int e = i >> 10, c = i & 1023; rt[i] = router[(size_t)c * 8 + e]; }
    __syncthreads();
    for (int chunk = blockIdx.x; chunk < ML / 128; chunk += F.G) {
        const int row_base = chunk * 128 + F.wave * 16;
        int me0 = 0, me1 = 0; float mw0 = 0.f, mw1 = 0.f;
        for (int i = 0; i < 16; ++i) {
            const int r = row_base + i; const int bs = r / SEQ; const float* mod1 = modv + (size_t)(17 + bs) * 6144;
            f32x4 h[4], y[4]; ld_row_f32(A.out + (size_t)r * D, F.lane, h); ld_row_bf16(YL + (size_t)r * D, F.lane, y);
            gated_add(h, y, gam + 1 * D, mod1 + 2 * D, F.lane); st_row_f32(A.out + (size_t)r * D, F.lane, h);
            norm_mod(h, gam + 2 * D, mod1 + 3 * D, mod1 + 4 * D, F.lane); st_row_fp8((unsigned char*)XL + (size_t)r * D, F.lane, h, FP8_SA);
            float lg[8];
#pragma unroll
            for (int e = 0; e < 8; ++e) { float a = 0.f;
#pragma unroll
                for (int j = 0; j < 4; ++j) { const f32x4 w = *(const LAS f32x4*)(rt + e * 1024 + 256 * j + 4 * F.lane); a += (h[j].x * w.x + h[j].y * w.y) + (h[j].z * w.z + h[j].w * w.w); }
                lg[e] = a; }
            {
              const bool b5 = (F.lane & 32) != 0, b4 = (F.lane & 16) != 0, b3 = (F.lane & 8) != 0; float v4[4], v2[2];
#pragma unroll
              for (int i2 = 0; i2 < 4; ++i2) { const float keep = b5 ? lg[i2 + 4] : lg[i2], send = b5 ? lg[i2] : lg[i2 + 4]; v4[i2] = keep + __shfl_xor(send, 32); }
#pragma unroll
              for (int i2 = 0; i2 < 2; ++i2) { const float keep = b4 ? v4[i2 + 2] : v4[i2], send = b4 ? v4[i2] : v4[i2 + 2]; v2[i2] = keep + __shfl_xor(send, 16); }
              float v1 = (b3 ? v2[1] : v2[0]) + __shfl_xor(b3 ? v2[0] : v2[1], 8);
              v1 += __shfl_xor(v1, 1); v1 += __shfl_xor(v1, 2); v1 += __shfl_xor(v1, 4);
#pragma unroll
              for (int e = 0; e < 8; ++e) lg[e] = __builtin_bit_cast(float, __builtin_amdgcn_readlane(__builtin_bit_cast(int, v1), 8 * e)); }
            int e0 = 0; float v0 = lg[0];
#pragma unroll
            for (int e = 1; e < 8; ++e) if (lg[e] > v0) { v0 = lg[e]; e0 = e; }
            int e1 = (e0 + 1) & 7; float v1 = -3.0e38f;
#pragma unroll
            for (int e = 0; e < 8; ++e) if (e != e0 && lg[e] > v1) { v1 = lg[e]; e1 = e; }
            const float w1 = 1.0f / (1.0f + __expf(v0 - v1)), w0 = 1.0f - w1;
            if (F.lane == i) { me0 = e0; me1 = e1; mw0 = w0; mw1 = w1; }
        }
        unsigned long long m[8];
#pragma unroll
        for (int e = 0; e < 8; ++e) m[e] = __ballot(F.lane < 16 && (me0 == e || me1 == e));
        { unsigned c = 0;
#pragma unroll
          for (int e = 0; e < 8; ++e) c = (F.lane == e) ? (unsigned)__popcll(m[e]) : c;
          if (F.lane < 8) wc[F.wave * 8 + F.lane] = c; }
        __syncthreads();
        if (F.tid < 8) { unsigned tot = 0;
#pragma unroll
            for (int w = 0; w < 8; ++w) tot += wc[w * 8 + F.tid];
            unsigned run = __hip_atomic_fetch_add((unsigned*)(F.ctl + CW_CNT + F.tid), tot, __ATOMIC_RELAXED, __HIP_MEMORY_SCOPE_AGENT);
#pragma unroll
            for (int w = 0; w < 8; ++w) { const unsigned c = wc[w * 8 + F.tid]; wc[w * 8 + F.tid] = run; run += c; } }
        __syncthreads();
        if (F.lane < 16) { unsigned long long m0 = 0ull, m1 = 0ull;
#pragma unroll
            for (int e = 0; e < 8; ++e) { m0 = (me0 == e) ? m[e] : m0; m1 = (me1 == e) ? m[e] : m1; }
            const unsigned long long below = (1ull << F.lane) - 1ull;
            const unsigned i0 = wc[F.wave * 8 + me0] + (unsigned)__popcll(m0 & below), i1 = wc[F.wave * 8 + me1] + (unsigned)__popcll(m1 & below);
            unsigned* t = tok + (size_t)(row_base + F.lane) * 8; t[0] = (unsigned)me0; t[1] = (unsigned)me1; t[2] = i0; t[3] = i1; t[4] = __float_as_uint(mw0); t[5] = __float_as_uint(mw1);
            inv[(size_t)me0 * 32768 + i0] = (unsigned short)(row_base + F.lane); inv[(size_t)me1 * 32768 + i1] = (unsigned short)(row_base + F.lane); }
        __syncthreads();
    }
}
__device__ __forceinline__ void moe_tile_starts(Frame& F, int (&ts)[9]) {
    ts[0] = 0;
#pragma unroll
    for (int e = 0; e < 8; ++e) { const unsigned c = __hip_atomic_load((unsigned*)(F.ctl + CW_CNT + e), __ATOMIC_RELAXED, __HIP_MEMORY_SCOPE_AGENT); ts[e + 1] = ts[e] + (int)((c + 255u) >> 8); }
#pragma unroll
    for (int e = 0; e < 9; ++e) ts[e] = __builtin_amdgcn_readfirstlane(ts[e]);
}
template <class Sched> __device__ __forceinline__ void moe_row_table(Frame& F, const Args& A, const Sched& S, const int (&ts)[9]) {
    const unsigned short* inv = (const unsigned short*)(A.ws + WS_INV); LAS unsigned short* tab = (LAS unsigned short*)(F.lds + ATAB_OFF);
    __syncthreads();
    for (int i = 0; i < ATAB_UNITS; ++i) { pg8::Unit u; if (!S.next(i, u)) break;
        int e = 0;
#pragma unroll
        for (int q = 1; q < 8; ++q) e += (u.pm >= ts[q]) ? 1 : 0;
        int tse = 0;
#pragma unroll
        for (int q = 0; q < 8; ++q) tse = (e == q) ? ts[q] : tse;
        const unsigned cnt = __hip_atomic_load((unsigned*)(F.ctl + CW_CNT + e), __ATOMIC_RELAXED, __HIP_MEMORY_SCOPE_AGENT);
        if (F.tid < 256) { const unsigned r = (unsigned)(u.pm - tse) * 256u + (unsigned)F.tid; tab[i * 256 + F.tid] = (r < cnt) ? inv[(size_t)e * 32768 + r] : (unsigned short)0; } }
    __syncthreads();
}
__device__ __forceinline__ void thin_t5(Frame& F, const Args& A) {
    int ts[9]; moe_tile_starts(F, ts);
    const float* modv = (const float*)(A.ws + WS_MODV); const bf16* Y = (const bf16*)(A.ws + WS_Y); const float* gam = A.in[6] + 7 * D; const unsigned* tok = (const unsigned*)(A.ws + WS_TOK);
    for (int r = F.gw; r < ML; r += F.ngw) {
        const int bs = r / SEQ; const float* mod1 = modv + (size_t)(17 + bs) * 6144;
        const unsigned* t = tok + (size_t)r * 8; const float w0 = __uint_as_float(t[4]), w1 = __uint_as_float(t[5]); const int e0 = (int)t[0], e1 = (int)t[1]; int s0 = 0, s1 = 0;
#pragma unroll
        for (int e = 0; e < 8; ++e) { s0 = (e0 == e) ? ts[e] : s0; s1 = (e1 == e) ? ts[e] : s1; }
        const unsigned p0 = (unsigned)s0 * 256u + t[2], p1 = (unsigned)s1 * 256u + t[3];
        f32x4 h[4], y0[4], y1[4]; ld_row_f32(A.out + (size_t)r * D, F.lane, h); ld_row_bf16(Y + (size_t)p0 * D, F.lane, y0); ld_row_bf16(Y + (size_t)p1 * D, F.lane, y1);
#pragma unroll
        for (int j = 0; j < 4; ++j) y0[j] = y0[j] * w0 + y1[j] * w1;
        gated_add(h, y0, gam, mod1 + 5 * D, F.lane); st_row_f32(A.out + (size_t)r * D, F.lane, h);
    }
}

__device__ __forceinline__ float rope_inv(int f) { return exp2f(-(float)f * (13.287712379549449f / 8.0f)); }
__device__ __forceinline__ void prep_qa(Frame& F, const Args& A) {
    const bf16* Z0 = (const bf16*)(A.ws + WS_Z0C); bf16* QA = (bf16*)(A.ws + WS_QA); bf16* KR = (bf16*)(A.ws + WS_KR);
    for (int r = F.gw; r < MA; r += F.ngw) {
        const bf16* z = Z0 + (size_t)r * 512;
        const v2u cq = *((const GAS v2u*)(z) + F.lane); const unsigned ck = *((const GAS unsigned*)(z + 256) + F.lane);
        const float q0 = bf_lo(cq.x), q1 = bf_hi(cq.x), q2 = bf_lo(cq.y), q3 = bf_hi(cq.y), k0 = bf_lo(ck), k1 = bf_hi(ck);
        const float rq = rsqrtf(wave_sum((q0 * q0 + q1 * q1) + (q2 * q2 + q3 * q3)) * (1.0f / QRANK) + EPS);
        const float rk = rsqrtf(wave_sum(k0 * k0 + k1 * k1) * (1.0f / KVRANK) + EPS);
        v2u oq; oq.x = pk2(q0 * rq, q1 * rq); oq.y = pk2(q2 * rq, q3 * rq);
        *((GAS v2u*)(QA + (size_t)r * KQKV) + F.lane) = oq; *((GAS unsigned*)(QA + (size_t)r * KQKV + QRANK) + F.lane) = pk2(k0 * rk, k1 * rk);
        const int l = F.lane & 31; float v = bf1(z[384 + l]); const float pv = __shfl_xor(v, 8);
        if (r < ML) { const int t = r % SEQ; const float pos = (l < 16) ? (float)(t / 64) : (float)(t % 64); float sn, cs; sincosf(pos * rope_inv(l & 7), &sn, &cs);
            v = (l & 8) ? (v * cs + pv * sn) : (v * cs - pv * sn); }
        if (F.lane < 32) KR[(size_t)r * 32 + l] = (bf16)f2bf(v);
    }
}
__device__ __forceinline__ void rope_q(Frame& F, const Args& A) {
    bf16* Q = (bf16*)(A.ws + WS_Q);
    for (int r = F.gw; r < ML; r += F.ngw) {
        const int t = r % SEQ, hh = F.lane >> 3, sub = F.lane & 7; bf16* p = Q + (size_t)r * 768 + hh * QK + NOPE + sub;
        const float inv = rope_inv(sub); float sr, cr, sc, cc; sincosf((float)(t / 64) * inv, &sr, &cr); sincosf((float)(t % 64) * inv, &sc, &cc);
        const float x0 = bf1(p[0]), x1 = bf1(p[8]), x2 = bf1(p[16]), x3 = bf1(p[24]);
        p[0] = (bf16)f2bf(x0 * cr - x1 * sr); p[8] = (bf16)f2bf(x1 * cr + x0 * sr); p[16] = (bf16)f2bf(x2 * cc - x3 * sc); p[24] = (bf16)f2bf(x3 * cc + x2 * sc);
    }
}
__device__ __forceinline__ int scan_row(int b, int dir, int tau) {
    if (tau < CTXL) return ML + b * CTXL + (dir ? CTXL - 1 - tau : tau);
    const int t = tau - CTXL; return b * SEQ + (dir ? SEQ - 1 - t : t);
}
__device__ __forceinline__ float gelu_tanh(float x) { const float u = 0.7978845608028654f * (x + 0.044715f * x * x * x); const float e = __expf(2.0f * u); const float th = 1.0f - 2.0f / (e + 1.0f); return 0.5f * x * (1.0f + th); }
__device__ __forceinline__ void gen_s5(Frame& F, const Args& A, int g) {
    constexpr int CS = 65;
    LAS float* pw = (LAS float*)F.lds;
    LAS float* cc = pw + 2 * 64 * 17 * 2;
    LAS float* bb = cc + 2 * 16 * CS * 2;
    LAS float* KK = bb + 2 * 64 * 16 * 2;
    LAS float* LL = KK + 2 * 16 * 16 * 16;
    LAS float* DSK = LL + 128 * 4;
    bf16* B1g = (bf16*)(A.ws + WS_B1) + (size_t)g * 256 * 256; bf16* B3g = (bf16*)(A.ws + WS_B3) + (size_t)g * 256 * 512;
    __syncthreads();
    { float lr = 0.f, li = 0.f, dtr = 0.f, dk = 0.f, braw[4], biraw[4], craw[4], ciraw[4];
      if (F.tid < 128) { const int d = F.tid >> 6, p = F.tid & 63, ig = d * S5G + g, i = ig * S5P + p; lr = A.in[8][i]; li = A.in[9][i]; dtr = A.in[10][ig]; }
      if (F.tid < 16) dk = A.in[15][g * 16 + F.tid];
#pragma unroll
      for (int q = 0; q < 4; ++q) { const int idx = F.tid + q * (NWAVES * 64); { const int dp = idx >> 4, h = idx & 15, d = dp >> 6, p = dp & 63; const size_t i = (size_t)((d * S5G + g) * S5P + p); braw[q] = A.in[11][i * 16 + h]; biraw[q] = A.in[12][i * 16 + h]; }
        { const int d = idx >> 10, ho = (idx >> 6) & 15, p = idx & 63; const size_t ci = (size_t)((d * S5G + g) * 16 + ho) * S5P + p; craw[q] = A.in[13][ci]; ciraw[q] = A.in[14][ci]; } }
      if (F.tid < 128) { const float dt = expf(dtr); LL[F.tid * 4] = lr; LL[F.tid * 4 + 1] = li; LL[F.tid * 4 + 2] = lr * dt; LL[F.tid * 4 + 3] = li * dt; }
      if (F.tid < 16) DSK[F.tid] = dk;
#pragma unroll
      for (int q = 0; q < 4; ++q) { const int idx = F.tid + q * (NWAVES * 64); bb[idx * 2] = braw[q]; bb[idx * 2 + 1] = biraw[q];
        { const int d = idx >> 10, ho = (idx >> 6) & 15, p = idx & 63; cc[((d * 16 + ho) * CS + p) * 2] = craw[q]; cc[((d * 16 + ho) * CS + p) * 2 + 1] = ciraw[q]; } } }
    __syncthreads();
    for (int idx = F.tid; idx < 128 * 17; idx += NWAVES * 64) { const int dp = idx / 17, k = idx - dp * 17;
        const float mag = expf((float)k * LL[dp * 4 + 2]), ang = (float)k * LL[dp * 4 + 3]; pw[(dp * 17 + k) * 2] = mag * cosf(ang); pw[(dp * 17 + k) * 2 + 1] = mag * sinf(ang); }
    for (int idx = F.tid; idx < 128 * 16; idx += NWAVES * 64) { const int dp = idx >> 4;
        const float lr = LL[dp * 4], li = LL[dp * 4 + 1], lrdt = LL[dp * 4 + 2], lidt = LL[dp * 4 + 3];
        const float mag = expf(lrdt), ar = mag * cosf(lidt), ai = mag * sinf(lidt), den = lr * lr + li * li, nr = ar - 1.0f;
        const float cr = (nr * lr + ai * li) / den, ci = (ai * lr - nr * li) / den;
        const float br = bb[idx * 2], bi = bb[idx * 2 + 1]; bb[idx * 2] = cr * br - ci * bi; bb[idx * 2 + 1] = cr * bi + ci * br; }
    __syncthreads();
    { const int ho = F.tid & 15, k = (F.tid >> 4) & 15, d = F.tid >> 8;
      float acc[16];
#pragma unroll
      for (int hi = 0; hi < 16; ++hi) acc[hi] = 0.f;
      for (int p = 0; p < 64; ++p) { const float cr = cc[((d * 16 + ho) * CS + p) * 2], ci = cc[((d * 16 + ho) * CS + p) * 2 + 1], pr = pw[((d * 64 + p) * 17 + k) * 2], pi = pw[((d * 64 + p) * 17 + k) * 2 + 1];
          const float wr = cr * pr - ci * pi, wi = cr * pi + ci * pr; const LAS f32x4* bp = (const LAS f32x4*)(bb + (d * 64 + p) * 32);
#pragma unroll
          for (int q = 0; q < 8; ++q) { const f32x4 b4 = bp[q]; acc[2 * q] += wr * b4.x - wi * b4.y; acc[2 * q + 1] += wr * b4.z - wi * b4.w; } }
#pragma unroll
      for (int hi = 0; hi < 16; ++hi) KK[((d * 16 + k) * 16 + ho) * 16 + hi] = acc[hi]; }
    __syncthreads();
    for (int it = F.tid; it < 256 * 32; it += NWAVES * 64) { const int n = it >> 5, kk0 = (it & 31) * 8;
        float v3[8], v3b[8], v1[8];
        { const int j = n >> 4, ho = n & 15, i = kk0 >> 4, hi0 = kk0 & 15; const float dsk = DSK[ho];
#pragma unroll
          for (int e8 = 0; e8 < 8; ++e8) { const int hi = hi0 + e8; float val = 0.f;
            if (i <= j) val += KK[((0 * 16 + (j - i)) * 16 + ho) * 16 + hi];
            if (i >= j) val += KK[((1 * 16 + (i - j)) * 16 + ho) * 16 + hi];
            if (i == j && ho == hi) val += dsk;
            v3[e8] = val; }
          const int d = kk0 >> 7, reim = (kk0 >> 6) & 1, p0 = kk0 & 63, e = d ? (16 - j) : (j + 1);
#pragma unroll
          for (int e8 = 0; e8 < 8; ++e8) { const int p = p0 + e8;
            const float cr = cc[((d * 16 + ho) * CS + p) * 2], ci = cc[((d * 16 + ho) * CS + p) * 2 + 1], pr = pw[((d * 64 + p) * 17 + e) * 2], pi = pw[((d * 64 + p) * 17 + e) * 2 + 1];
            v3b[e8] = reim ? -(cr * pi + ci * pr) : (cr * pr - ci * pi); } }
        { const int d = n >> 7, reim = (n >> 6) & 1, p = n & 63, i = kk0 >> 4, hi0 = kk0 & 15, e = d ? i : (15 - i);
          const float pr = pw[((d * 64 + p) * 17 + e) * 2], pi = pw[((d * 64 + p) * 17 + e) * 2 + 1];
#pragma unroll
          for (int e8 = 0; e8 < 8; ++e8) { const int hi = hi0 + e8; const float br = bb[((d * 64 + p) * 16 + hi) * 2], bi = bb[((d * 64 + p) * 16 + hi) * 2 + 1];
            v1[e8] = reim ? (pr * bi + pi * br) : (pr * br - pi * bi); } }
        const v4u w3 = {pk2(v3[0], v3[1]), pk2(v3[2], v3[3]), pk2(v3[4], v3[5]), pk2(v3[6], v3[7])}, w3b = {pk2(v3b[0], v3b[1]), pk2(v3b[2], v3b[3]), pk2(v3b[4], v3b[5]), pk2(v3b[6], v3b[7])};
        const v4u w1 = {pk2(v1[0], v1[1]), pk2(v1[2], v1[3]), pk2(v1[4], v1[5]), pk2(v1[6], v1[7])};
        *(GAS v4u*)(B3g + (size_t)n * 512 + kk0) = w3; *(GAS v4u*)(B3g + (size_t)n * 512 + 256 + kk0) = w3b; *(GAS v4u*)(B1g + (size_t)n * 256 + kk0) = w1; }
    __syncthreads();
}
__device__ __forceinline__ void s5_scan(Frame& F, const Args& A) {
    if (F.wave < 4) {
        const float* DS = (const float*)(A.ws + WS_DS); bf16* A3 = (bf16*)(A.ws + WS_A3); const int p = F.lane;
        for (int task = blockIdx.x * 4 + F.wave; task < NB * S5G * 2; task += F.G * 4) {
            const int d = task & 1, g = (task >> 1) & 31, b = task >> 6, ig = d * S5G + g;
            const float lr = A.in[8][ig * S5P + p], li = A.in[9][ig * S5P + p], dt = expf(A.in[10][ig]);
            const float m16 = expf(16.0f * lr * dt), a16r = m16 * cosf(16.0f * li * dt), a16i = m16 * sinf(16.0f * li * dt);
            const float* ds = DS + (size_t)(g * 16 + b) * 144 * 256 + d * 128 + p; bf16* so = A3 + (size_t)(g * 16 + b) * 144 * 512 + 256 + d * 128 + p;
            float sr = 0.f, si = 0.f;
            for (int blk = 0; blk < 9; ++blk) {
                const int cbase = d ? (blk == 0 ? 15 : 143 - (blk - 1) * 16) : blk * 16, cstep = d ? -1 : 1;
                float xr[16], xi[16];
#pragma unroll
                for (int s = 0; s < 16; ++s) { const int c = cbase + cstep * s; xr[s] = ds[(size_t)c * 256]; xi[s] = ds[(size_t)c * 256 + 64]; }
#pragma unroll
                for (int s = 0; s < 16; ++s) { const int c = cbase + cstep * s; so[(size_t)c * 512] = (bf16)f2bf(sr); so[(size_t)c * 512 + 64] = (bf16)f2bf(si);
                    const float nsr = a16r * sr - a16i * si + xr[s], nsi = a16r * si + a16i * sr + xi[s]; sr = nsr; si = nsi; }
            }
        }
    }
}
__device__ __forceinline__ void attn_phase(Frame& F, const Args& A) {
    const bf16* Q = (const bf16*)(A.ws + WS_Q); const bf16* KV = (const bf16*)(A.ws + WS_KV); const bf16* KR = (const bf16*)(A.ws + WS_KR); bf16* AO = (bf16*)(A.ws + WS_AO);
    const int bid = (int)blockIdx.x; const int vcu = (F.G % 8 == 0) ? (bid % 8) * (F.G / 8) + bid / 8 : bid;
    for (int u = vcu; u < 1024 + 128; u += F.G) {
        int b, h, qrow0, NT;
        if (u < 1024) { const int bh = u >> 3; b = bh >> 3; h = bh & 7; qrow0 = b * SEQ + (u & 7) * 256; NT = TT / 64; }
        else { const int uu = u - 1024; b = uu >> 3; h = uu & 7; qrow0 = ML + b * CTXL; NT = CTXL / 64; }
        att::attn_unit(Q + (size_t)qrow0 * 768 + h * QK, KV + h * NOPE, KR, KV + 512 + h * VD, ML + b * CTXL, CTXL / 64, b * SEQ, NT, AO + (size_t)qrow0 * D + S5W + h * VD, F.lds, (u < 1024) ? (u & 7) * 256 : -1);
    }
}
__device__ __forceinline__ void gla_prep_phase(Frame& F, const Args& A) {
    for (int j = blockIdx.x; j < NB * GH * 2 * 2; j += F.G) { const int ch = j >> 1, b = ch >> 3, h = (ch >> 1) & 3, dir = ch & 1;
        gla::gla_prep((const bf16*)(A.ws + WS_QK), (const bf16*)(A.ws + WS_VR) + 2048, A.in[27], A.in[28], (bf16*)(A.ws + WS_TQ), (bf16*)(A.ws + WS_TK), (bf16*)(A.ws + WS_TP), (float*)(A.ws + WS_EL),
                      b, h, dir, 18 * (j & 1), 18 * (j & 1) + 18, ML, SEQ, CTXL, F.lds); }
}
__device__ __forceinline__ void gla_chain_phase(Frame& F, const Args& A) {
    const int bid = (int)blockIdx.x; const int vcu = (F.G % 8 == 0) ? (bid % 8) * (F.G / 8) + bid / 8 : bid;
    for (int u = vcu; u < NB * GH * 2 * 2; u += F.G) { const int ch = u >> 1, vh = u & 1, b = ch >> 3, h = (ch >> 1) & 3, dir = ch & 1;
        gla::gla_chain2((const bf16*)(A.ws + WS_VR), (const bf16*)(A.ws + WS_TQ), (const bf16*)(A.ws + WS_TK), (const bf16*)(A.ws + WS_TP), (const float*)(A.ws + WS_EL), (bf16*)(A.ws + (dir ? WS_OB : WS_OF)),
                        b, h, dir, vh, ML, SEQ, CTXL, F.lds); }
}
__device__ __forceinline__ void gla_finish(Frame& F, const Args& A) {
    bf16* OF = (bf16*)(A.ws + WS_OF); const bf16* OB = (const bf16*)(A.ws + WS_OB); const bf16* VR = (const bf16*)(A.ws + WS_VR); const float* hn = A.in[29];
    const f32x4 g = *(const GAS f32x4*)(hn + 4 * F.lane);
    for (int r0 = F.gw; r0 < ML; r0 += 2 * F.ngw) {
        const int r1 = (r0 + F.ngw < ML) ? r0 + F.ngw : r0; const bool two = r1 != r0;
        f32x4 a0[4], b0[4], x0[4], a1[4], b1[4], x1[4];
        ld_row_bf16(OF + (size_t)r0 * D, F.lane, a0); ld_row_bf16(OB + (size_t)r0 * D, F.lane, b0); ld_row_bf16(VR + (size_t)r0 * VRLD + GVAL, F.lane, x0);
        ld_row_bf16(OF + (size_t)r1 * D, F.lane, a1); ld_row_bf16(OB + (size_t)r1 * D, F.lane, b1); ld_row_bf16(VR + (size_t)r1 * VRLD + GVAL, F.lane, x1);
#pragma unroll
        for (int j = 0; j < 4; ++j) { const f32x4 o0 = a0[j] + b0[j], o1 = a1[j] + b1[j];
            const float s0 = wave_sum((o0.x * o0.x + o0.y * o0.y) + (o0.z * o0.z + o0.w * o0.w)), s1 = wave_sum((o1.x * o1.x + o1.y * o1.y) + (o1.z * o1.z + o1.w * o1.w));
            const float rs0 = rsqrtf(s0 * (1.0f / GDV) + EPS), rs1 = rsqrtf(s1 * (1.0f / GDV) + EPS);
#pragma unroll
            for (int i = 0; i < 4; ++i) { const float u0 = x0[j][i], u1 = x1[j][i];
                a0[j][i] = o0[i] * rs0 * g[i] * (u0 * __builtin_amdgcn_rcpf(1.0f + __expf(-u0))); a1[j][i] = o1[i] * rs1 * g[i] * (u1 * __builtin_amdgcn_rcpf(1.0f + __expf(-u1))); } }
        st_row_bf16(OF + (size_t)r0 * D, F.lane, a0); if (two) st_row_bf16(OF + (size_t)r1 * D, F.lane, a1);
    }
}

#ifndef MK_ONE_LAUNCH
#define MK_ONE_LAUNCH 1
#endif
constexpr int NPHASE = 21;
constexpr bool SP2 = true, ALIGN = true;

__global__ void __launch_bounds__(NWAVES * 64, 2) fwd_kernel(Args args) {
    extern __shared__ __attribute__((aligned(16))) unsigned char lds[];
    Frame F;
    F.lds = (LAS unsigned char*)lds;
    F.MISC = (volatile LAS unsigned*)(F.lds + MISC_OFF);
    F.tid = threadIdx.x; F.lane = F.tid & 63; F.wave = __builtin_amdgcn_readfirstlane(F.tid >> 6);
    F.G = gridDim.x; F.gw = blockIdx.x * NWAVES + F.wave; F.ngw = F.G * NWAVES;
    unsigned char* ws = args.ws;
    F.ctl = (gu32*)(ws + WS_CTL);
    for (int u = F.tid; u < (LDS_BYTES - LDSCTL_OFF) / 4; u += NWAVES * 64) ((LAS unsigned*)(F.lds + LDSCTL_OFF))[u] = 0u;
    __syncthreads();
    XcdBarrier bar; bar.bar = (unsigned*)(F.ctl + CW_BAR); bar.x = 0; bar.st = nullptr;
    if (MK_ONE_LAUNCH) bar = xcd_barrier_post((unsigned*)(F.ctl + CW_BAR), F.MISC + 8);
    const int lo = args.ph_lo, hi = args.ph_hi;
#define IN(k) (lo <= (k) && (k) < hi)
#ifdef PROBE_SETA
    if (blockIdx.x == PROBE_BLK && F.tid == 0) { const unsigned long long t_ = __builtin_amdgcn_s_memrealtime(); F.MISC[16] = (unsigned)t_; F.MISC[17] = (unsigned)(t_ >> 32); }
#define PROBE_STAMP(k) do { if (blockIdx.x == PROBE_BLK && F.tid == 0) { const unsigned long long t_ = __builtin_amdgcn_s_memrealtime(); const unsigned long long l_ = ((unsigned long long)F.MISC[17] << 32) | F.MISC[16]; const unsigned d_ = (unsigned)(t_ - l_); \
        if ((PROBE_SETA >> (k)) & 1ull) F.MISC[18] += d_; if ((PROBE_SETB >> (k)) & 1ull) F.MISC[20] += d_; F.MISC[16] = (unsigned)t_; F.MISC[17] = (unsigned)(t_ >> 32); } } while (0)
#else
#define PROBE_STAMP(k) do { } while (0)
#endif
#define SEAM(k) do { if (MK_ONE_LAUNCH && IN(k) && IN((k) + 1)) xcd_barrier(bar); PROBE_STAMP(k); } while (0)
    const int bid = (int)blockIdx.x;

    if (IN(0)) {
#ifndef NO_P0
 p0_prologue(F, args);
#endif
 } SEAM(0);
    if (IN(1)) { thin_t1(F, args); } SEAM(1);
    if (IN(2)) { pg8::Gemm g{(const bf16*)(ws + WS_XL), (const bf16*)(ws + WS_W_IN0), MA, EV_INP, D}; pg8::StaticOrder S; S.init(MA, EV_INP, F.G, bid);
        pg8::EpiIn0 E{(bf16*)(ws + WS_U), (bf16*)(ws + WS_A3), (bf16*)(ws + WS_Z0C)};
        pg8::gemm_phase<pg8::EpiIn0, pg8::StaticOrder, ALIGN, SP2>(F.lds + RING_OFF, g, S, E);
        tail_convert(F, args, (MA / 256) * (EV_INP / 256), MW0, MW1); } SEAM(2);
    if (IN(3)) { prep_qa(F, args);
        int k256 = 256; asm volatile("" : "+s"(k256));
        pg8::Gemm g{(const bf16*)(ws + WS_U), (const bf16*)(ws + WS_B1), 32 * 2304, 256, k256}; pg8::S5Order S{F.G, bid};
        pg8::EpiF32 E{(float*)(ws + WS_DS), 256};
        pg8::gemm_phase<pg8::EpiF32, pg8::S5Order, ALIGN, SP2>(F.lds + RING_OFF, g, S, E); } SEAM(3);
    if (IN(4)) { s5_scan(F, args);
        pg8::Gemm g{(const bf16*)(ws + WS_QA), (const bf16*)(ws + WS_W_QKV), MA, NQKV, KQKV}; pg8::StaticOrder S; S.init(MA, NQKV, F.G, bid);
        pg8::EpiSplit E{(bf16*)(ws + WS_Q), 768, (bf16*)(ws + WS_KV), 1024, 3, 0x7fffffff};
        pg8::gemm_phase<pg8::EpiSplit, pg8::StaticOrder, ALIGN, SP2>(F.lds + RING_OFF, g, S, E); } SEAM(4);
    if (IN(5)) {
        pg8::Gemm g{(const bf16*)(ws + WS_A3), (const bf16*)(ws + WS_B3), 32 * 2304, 256, 512}; pg8::S5Order S{F.G, bid};
        pg8::EpiS5Out E{(bf16*)(ws + WS_AG)};
        pg8::gemm_phase<pg8::EpiS5Out, pg8::S5Order, ALIGN, SP2>(F.lds + RING_OFF, g, S, E); } SEAM(5);
    if (IN(6)) {
#ifndef NO_ATT
 attn_phase(F, args);
#endif
        PROBE_STAMP(21);
        pg8::Gemm g{(const bf16*)(ws + WS_AG), (const bf16*)(ws + WS_W_GLU), MA, S5W, S5W}; pg8::StaticOrder S; S.init(MA, S5W, F.G, bid);
        pg8::EpiGlu E{(const bf16*)(ws + WS_AG), args.in[17], (bf16*)(ws + WS_AO), D};
        pg8::gemm_phase<pg8::EpiGlu, pg8::StaticOrder, ALIGN, SP2, false, false, true>(F.lds + RING_OFF, g, S, E); } SEAM(6);
    if (IN(7)) { pg8::Gemm g{(const bf16*)(ws + WS_AO), (const bf16*)(ws + WS_W_OUT0), MA, D, D}; pg8::StaticOrder S; S.init(MA, D, F.G, bid);
        pg8::EpiPlain E{(bf16*)(ws + WS_YL), D, 0, 0, 1.0f};
        pg8::gemm_phase<pg8::EpiPlain, pg8::StaticOrder, ALIGN, SP2>(F.lds + RING_OFF, g, S, E);
        tail_convert(F, args, (MA / 256) * (D / 256), MW1, MW2); } SEAM(7);
    if (IN(8)) { thin_t2(F, args); } SEAM(8);
    static_assert(!FFN0_IS_FP8, "the e4m3 dense-FFN variant does not carry the MoE weight conversion in its down phase");
    if constexpr (FFN0_IS_FP8) {
    if (IN(9)) { pg8::Gemm g{(const bf16*)(ws + WS_XL), (const bf16*)(ws + WS_W_GU), MA, 2 * FFN, D / 2}; pg8::StaticOrder S; S.init(MA, 2 * FFN, F.G, bid);
        pg8::EpiSwiGlu8 E{ws + WS_ACT, FFN, 0, 1.0f / (FP8_SA * FP8_SW), FP8_SACT, 0};
        pg8::gemm_phase<pg8::EpiSwiGlu8, pg8::StaticOrder, ALIGN, SP2, true>(F.lds + RING_OFF, g, S, E); } SEAM(9);
    if (IN(10)) { pg8::Gemm g{(const bf16*)(ws + WS_ACT), (const bf16*)(ws + WS_W_DN), MA, D, FFN / 2}; pg8::StaticOrder S; S.init(MA, D, F.G, bid);
        pg8::EpiPlain E{(bf16*)(ws + WS_FL), D, 0, 0, 1.0f / (FP8_SACT * FP8_SW)};
        pg8::gemm_phase<pg8::EpiPlain, pg8::StaticOrder, ALIGN, SP2, true>(F.lds + RING_OFF, g, S, E); } SEAM(10);
    } else {
    if (IN(9)) { pg8::Gemm g{(const bf16*)(ws + WS_XL), (const bf16*)(ws + WS_W_GU), MA, 2 * FFN, D}; pg8::StaticOrder S; S.init(MA, 2 * FFN, F.G, bid);
        if constexpr (FFN0_DN_FP8) { pg8::EpiSwiGlu8 E{ws + WS_ACT, FFN, 0, 1.0f, FP8_SACT, 0};
            pg8::gemm_phase<pg8::EpiSwiGlu8, pg8::StaticOrder, ALIGN, SP2>(F.lds + RING_OFF, g, S, E); }
        else { pg8::EpiSwiGlu E{(bf16*)(ws + WS_ACT), FFN, 0, 0};
            pg8::gemm_phase<pg8::EpiSwiGlu, pg8::StaticOrder, ALIGN, SP2>(F.lds + RING_OFF, g, S, E); }
        tail_convert(F, args, (MA / 256) * (2 * FFN / 256), MW2, MW3); } SEAM(9);
    if (IN(10)) { pg8::StaticOrder S; S.init(MA, D, F.G, bid);
        if constexpr (FFN0_DN_FP8) { pg8::Gemm g{(const bf16*)(ws + WS_ACT), (const bf16*)(ws + WS_W_DN), MA, D, FFN / 2};
            pg8::EpiPlain E{(bf16*)(ws + WS_FL), D, 0, 0, 1.0f / (FP8_SACT * FP8_SW)};
            pg8::gemm_phase<pg8::EpiPlain, pg8::StaticOrder, ALIGN, SP2, true>(F.lds + RING_OFF, g, S, E); }
        else { pg8::Gemm g{(const bf16*)(ws + WS_ACT), (const bf16*)(ws + WS_W_DN), MA, D, FFN};
            pg8::EpiPlain E{(bf16*)(ws + WS_FL), D, 0, 0, 1.0f};
            pg8::gemm_phase<pg8::EpiPlain, pg8::StaticOrder, ALIGN, SP2>(F.lds + RING_OFF, g, S, E); }
        tail_convert(F, args, (MA / 256) * (D / 256), MW3, MW4); } SEAM(10);
    }
    if (IN(11)) { thin_t3(F, args); } SEAM(11);
    if (IN(12)) { pg8::Gemm g{(const bf16*)(ws + WS_XL), (const bf16*)(ws + WS_W_IN1), MA, OD_INP, D}; pg8::StaticOrder S; S.init(MA, OD_INP, F.G, bid);
        pg8::EpiSplit E{(bf16*)(ws + WS_QK), 1024, (bf16*)(ws + WS_VR), VRLD, 4, 0x7fffffff};
        pg8::gemm_phase<pg8::EpiSplit, pg8::StaticOrder, ALIGN, SP2>(F.lds + RING_OFF, g, S, E);
        tail_convert(F, args, (MA / 256) * (OD_INP / 256), MW4, MW5); } SEAM(12);
    if (IN(13)) {
#ifndef NO_GLA
 gla_prep_phase(F, args);
#endif
    } SEAM(13);
    if (IN(14)) {
#ifndef NO_GLA
 gla_chain_phase(F, args);
#endif
    } SEAM(14);
    if (IN(15)) { gla_finish(F, args); } SEAM(15);
    if (IN(16)) { pg8::Gemm g{(const bf16*)(ws + WS_OF), (const bf16*)(ws + WS_W_OUT1), ML, D, D}; pg8::StaticOrder S; S.init(ML, D, F.G, bid);
        pg8::EpiPlain E{(bf16*)(ws + WS_YL1), D, 0, 0, 1.0f};
        pg8::gemm_phase<pg8::EpiPlain, pg8::StaticOrder, ALIGN, SP2>(F.lds + RING_OFF, g, S, E); } SEAM(16);
    if (IN(17)) { thin_t4(F, args); } SEAM(17);
    if (lo < 20 && hi > 18) {
        int ts[9]; moe_tile_starts(F, ts); const int NT = ts[8];
        if (IN(18)) { pg8::MoeOrder S{0, NT, 2 * FE / 256, F.G, bid, ts[1], ts[2], ts[3], ts[4], ts[5], ts[6], ts[7], 0};
            moe_row_table(F, args, S, ts);
            pg8::Gemm g{(const bf16*)(ws + WS_XLM), (const bf16*)(ws + WS_W_MGU), ML, 2 * FE, D / 2, (const LAS unsigned short*)(F.lds + ATAB_OFF)};
            pg8::EpiSwiGlu8 E{ws + WS_ACTM, FE, 2 * FE / 256, 1.0f / (FP8_SA * FP8_SW), FP8_SACT, 1};
            pg8::gemm_phase<pg8::EpiSwiGlu8, pg8::MoeOrder, ALIGN, SP2, true, false, false, true>(F.lds + RING_OFF, g, S, E); } SEAM(18);
        if (IN(19)) { pg8::Gemm g{(const bf16*)(ws + WS_ACTM), (const bf16*)(ws + WS_W_MDN), MOE_MAXT * 256, D, FE / 2};
            pg8::MoeOrder S{0, NT, D / 256, F.G, bid, ts[1], ts[2], ts[3], ts[4], ts[5], ts[6], ts[7], 1};
            pg8::EpiPlain E{(bf16*)(ws + WS_Y), D, 0, D / 256, 1.0f / (FP8_SACT * FP8_SW)};
            pg8::gemm_phase<pg8::EpiPlain, pg8::MoeOrder, ALIGN, SP2, true, true>(F.lds + RING_OFF, g, S, E); } SEAM(19);
    }
    if (IN(20)) { thin_t5(F, args); }
#ifdef PROBE_SETA
    PROBE_STAMP(20);
    if (blockIdx.x == PROBE_BLK && F.tid == 0) {
        unsigned long long qa = F.MISC[18] / 100u, qb = F.MISC[20] / 400u; qa = qa > 999 ? 999 : qa; qb = qb > 199 ? 199 : qb;
        const unsigned long long t0 = __builtin_amdgcn_s_memrealtime(), dl = qa * 1000ull + qb * 1000000ull;
        while (__builtin_amdgcn_s_memrealtime() - t0 < dl) __builtin_amdgcn_s_sleep(32);
    }
#endif
#undef IN
#undef SEAM
}

extern "C" void kernel_launch(void* const* d_in, const int* in_sizes, int n_in, void* d_out, int out_size, void* d_ws, size_t ws_size, hipStream_t stream) {
    static int grid = 0;
    if (grid == 0) {
        if (n_in != 35 || out_size != ML * D || ws_size < WS_END) { fprintf(stderr, "kernel_launch: unexpected shapes: n_in %d out %d ws %zu (need %zu)\n", n_in, out_size, ws_size, (size_t)WS_END); grid = -1; return; }
        int dev = 0, cus = 0, per_cu = 0;
        if (hipGetDevice(&dev) != hipSuccess || hipDeviceGetAttribute(&cus, hipDeviceAttributeMultiprocessorCount, dev) != hipSuccess) { grid = -1; return; }
        if (hipFuncSetAttribute((const void*)fwd_kernel, hipFuncAttributeMaxDynamicSharedMemorySize, LDS_BYTES) != hipSuccess) { fprintf(stderr, "kernel_launch: hipFuncSetAttribute failed\n"); grid = -1; return; }
        if (hipOccupancyMaxActiveBlocksPerMultiprocessor(&per_cu, (const void*)fwd_kernel, NWAVES * 64, LDS_BYTES) != hipSuccess || per_cu < 1) { fprintf(stderr, "kernel_launch: occupancy query reports %d blocks per CU\n", per_cu); }
        (void)hipGetLastError();
        grid = cus;
    }
    if (grid < 0) return;
    (void)hipMemsetAsync((char*)d_ws + WS_CTL, 0, CTL_ZERO_BYTES, stream);
    Args a{};
    for (int i = 0; i < 35; ++i) a.in[i] = (const float*)d_in[i];
    a.out = (float*)d_out; a.ws = (unsigned char*)d_ws;
#if MK_ONE_LAUNCH
    a.ph_lo = 0; a.ph_hi = NPHASE;
    hipLaunchKernelGGL(fwd_kernel, dim3(grid), dim3(NWAVES * 64), LDS_BYTES, stream, a);
#else
    for (int p = 0; p < NPHASE; ++p) { a.ph_lo = p; a.ph_hi = p + 1; hipLaunchKernelGGL(fwd_kernel, dim3(grid), dim3(NWAVES * 64), LDS_BYTES, stream, a); }
#endif
}
```

```cpp
#include <hip/hip_runtime.h>
#include <cstdio>
#include <cstdint>
#define MK_ONE_LAUNCH 1
namespace pg8 {
#define PG8_LAS __attribute__((address_space(3)))
typedef unsigned short bf16_t;
typedef short bf16x8 __attribute__((ext_vector_type(8)));
typedef float f32x4 __attribute__((ext_vector_type(4)));
typedef unsigned u32x4 __attribute__((ext_vector_type(4)));
constexpr int BM = 256, BK = 64, HALF = 128, HTB = HALF * BK * 2  , STAGE_BYTES = 8 * HTB, NXCD = 8, WGM = 8;

__host__ __device__ __forceinline__ int lds_byte(int r, int c) { const int st = (r >> 4) * 2 + (c >> 5), rr = r & 15, cc = c & 31, ob = rr * 64 + cc * 2; return st * 1024 + (ob ^ (((ob >> 9) & 1) << 5)); }
__host__ __device__ __forceinline__ void stage_rc(int b, int& R, int& C) { const int st = b / 1024, sb = b % 1024, swz = sb ^ (((sb >> 9) & 1) << 5); R = (st >> 1) * 16 + swz / 64; C = (st & 1) * 32 + (swz % 64) / 2; }
__host__ __device__ __forceinline__ int perm32(int rho) { const int n = rho >> 4, i = rho & 15; return 8 * (i >> 2) + 4 * n + (i & 3); }

struct Unit { int pm, pn; };
struct Gemm { const bf16_t* A; const bf16_t* Bt; int M, N, K; const PG8_LAS unsigned short* atab = nullptr; };
constexpr unsigned ACH_GS = 2304u * 256u * 2u;

struct StaticOrder {
    int nM, nN, nwg, G, c;
    __host__ __device__ void init(int M, int N, int G_, int c_) { nM = M / BM; nN = N / BM; nwg = nM * nN; G = G_; c = c_; }
    __host__ __device__ bool next(int i, Unit& u) const {
        const long L = (long)i * G + c; if (L >= nwg) return false;
        int wgid = (int)L; { const int q = nwg / NXCD, r = nwg % NXCD, xcd = wgid % NXCD, off = wgid / NXCD; wgid = (xcd < r ? xcd * (q + 1) : r * (q + 1) + (xcd - r) * q) + off; }
        const int nig = WGM * nN, gid = wgid / nig, fm = gid * WGM, gsz = (nM - fm) < WGM ? (nM - fm) : WGM;
        u.pm = fm + ((wgid % nig) % gsz); u.pn = (wgid % nig) / gsz; return true;
    }
    __device__ __forceinline__ void a_ready(const Unit&) const {}
    __device__ __forceinline__ void done(const Unit&) const {}
};

__device__ __forceinline__ unsigned cvt_pk_bf16(float lo, float hi) { unsigned r; asm volatile("v_cvt_pk_bf16_f32 %0, %1, %2" : "=v"(r) : "v"(lo), "v"(hi)); return r; }
typedef float f32x2 __attribute__((ext_vector_type(2)));
__device__ __forceinline__ u32x4 pack8(const f32x4 v0, const f32x4 v1) { u32x4 w; w.x = cvt_pk_bf16(v0[0], v0[1]); w.y = cvt_pk_bf16(v0[2], v0[3]); w.z = cvt_pk_bf16(v1[0], v1[1]); w.w = cvt_pk_bf16(v1[2], v1[3]); return w; }
__device__ __forceinline__ float bf_lo(unsigned u) { return __uint_as_float(u << 16); }
__device__ __forceinline__ float bf_hi(unsigned u) { return __uint_as_float(u & 0xffff0000u); }
__device__ __forceinline__ unsigned pk4_fp8(float a, float b, float c, float d) {
    a = __builtin_amdgcn_fmed3f(a, -448.f, 448.f); b = __builtin_amdgcn_fmed3f(b, -448.f, 448.f); c = __builtin_amdgcn_fmed3f(c, -448.f, 448.f); d = __builtin_amdgcn_fmed3f(d, -448.f, 448.f);
    int r = __builtin_amdgcn_cvt_pk_fp8_f32(a, b, 0, false); r = __builtin_amdgcn_cvt_pk_fp8_f32(c, d, r, true); return (unsigned)r; }
__device__ __forceinline__ float sigmoid_f(float x) { return __builtin_amdgcn_rcpf(1.0f + __builtin_amdgcn_exp2f(-1.4426950408889634f * x)); }

struct EpiPlain {
    static constexpr bool PERM = true, AFTER_DRAIN = false;
    bf16_t* O; int ldc; int pm_off; int nmod; float sc;
    __device__ __forceinline__ void operator()(const f32x4 (&acc)[2][2][4][2], const Unit& u, int wr, int wc, int fr, int fq) const {
        const int row0 = (u.pm - pm_off) * BM + wr * 64 + fr; const int ct = nmod ? (u.pn % nmod) : u.pn; const int col0 = ct * BM + wc * 32 + 8 * fq;
#pragma unroll
        for (int ai = 0; ai < 2; ++ai)
#pragma unroll
            for (int m = 0; m < 4; ++m) { bf16_t* rowp = O + (size_t)(row0 + ai * HALF + m * 16) * ldc + col0;
#pragma unroll
                for (int bj = 0; bj < 2; ++bj) *(u32x4*)(rowp + bj * HALF) = pack8(acc[ai][bj][m][0] * sc, acc[ai][bj][m][1] * sc); }
    }
};
struct EpiSplit {
    static constexpr bool PERM = true, AFTER_DRAIN = false;
    bf16_t* O0; int ld0; bf16_t* O1; int ld1; int nsplit; int ncols1;
    __device__ __forceinline__ void operator()(const f32x4 (&acc)[2][2][4][2], const Unit& u, int wr, int wc, int fr, int fq) const {
        const int row0 = u.pm * BM + wr * 64 + fr; const bool first = u.pn < nsplit;
        bf16_t* base = first ? O0 : O1; const int ld = first ? ld0 : ld1; const int col0 = (first ? u.pn : u.pn - nsplit) * BM + wc * 32 + 8 * fq; const int lim = first ? 0x7fffffff : ncols1;
#pragma unroll
        for (int ai = 0; ai < 2; ++ai)
#pragma unroll
            for (int m = 0; m < 4; ++m) { bf16_t* rowp = base + (size_t)(row0 + ai * HALF + m * 16) * ld + col0;
#pragma unroll
                for (int bj = 0; bj < 2; ++bj) if (col0 + bj * HALF < lim) *(u32x4*)(rowp + bj * HALF) = pack8(acc[ai][bj][m][0], acc[ai][bj][m][1]); }
    }
};
struct EpiGlu {
    static constexpr bool PERM = true, AFTER_DRAIN = false;
    const bf16_t* Aa; const float* bias; bf16_t* O; int ldc;
    __device__ __forceinline__ void operator()(const f32x4 (&acc)[2][2][4][2], const Unit& u, int wr, int wc, int fr, int fq) const {
        const int row0 = u.pm * BM + wr * 64 + fr; const int col0 = u.pn * BM + wc * 32 + 8 * fq;
        const int crow0 = (u.pm < 128 ? (u.pm >> 3) * 144 + 16 + (u.pm & 7) * 16 : (u.pm - 128) * 144) + wr * 4;
#pragma unroll
        for (int bj = 0; bj < 2; ++bj) { const f32x4 b0 = *(const f32x4*)(bias + col0 + bj * HALF), b1 = *(const f32x4*)(bias + col0 + bj * HALF + 4);
            const int cg = (col0 + bj * HALF) >> 4, ch = (col0 + bj * HALF) & 15;
#pragma unroll
            for (int ai = 0; ai < 2; ++ai)
#pragma unroll
                for (int m = 0; m < 4; ++m) { const size_t r = (size_t)(row0 + ai * HALF + m * 16);
                    const u32x4 a8 = *(const u32x4*)(Aa + (size_t)cg * (2304 * 256) + (size_t)(crow0 + ai * 8 + m) * 256 + fr * 16 + ch);
                    f32x4 v0 = acc[ai][bj][m][0] + b0, v1 = acc[ai][bj][m][1] + b1;
                    v0[0] = bf_lo(a8.x) * sigmoid_f(v0[0]); v0[1] = bf_hi(a8.x) * sigmoid_f(v0[1]); v0[2] = bf_lo(a8.y) * sigmoid_f(v0[2]); v0[3] = bf_hi(a8.y) * sigmoid_f(v0[3]);
                    v1[0] = bf_lo(a8.z) * sigmoid_f(v1[0]); v1[1] = bf_hi(a8.z) * sigmoid_f(v1[1]); v1[2] = bf_lo(a8.w) * sigmoid_f(v1[2]); v1[3] = bf_hi(a8.w) * sigmoid_f(v1[3]);
                    *(u32x4*)(O + r * ldc + col0 + bj * HALF) = pack8(v0, v1); } }
    }
};
struct EpiSwiGlu {
    static constexpr bool PERM = true, AFTER_DRAIN = false;
    bf16_t* O; int ldc; int pm_off; int nmod;
    __device__ __forceinline__ void operator()(const f32x4 (&acc)[2][2][4][2], const Unit& u, int wr, int wc, int fr, int fq) const {
        const int row0 = (u.pm - pm_off) * BM + wr * 64 + fr; const int ct = nmod ? (u.pn % nmod) : u.pn; const int col0 = ct * HALF + wc * 32 + 8 * fq;
#pragma unroll
        for (int ai = 0; ai < 2; ++ai)
#pragma unroll
            for (int m = 0; m < 4; ++m) { f32x4 o0, o1;
#pragma unroll
                for (int i = 0; i < 4; ++i) { const float g0 = acc[ai][0][m][0][i], g1 = acc[ai][0][m][1][i]; o0[i] = g0 * sigmoid_f(g0) * acc[ai][1][m][0][i]; o1[i] = g1 * sigmoid_f(g1) * acc[ai][1][m][1][i]; }
                *(u32x4*)(O + (size_t)(row0 + ai * HALF + m * 16) * ldc + col0) = pack8(o0, o1); }
    }
};
struct EpiIn0 {
    static constexpr bool PERM = true, AFTER_DRAIN = false;
    bf16_t* U; bf16_t* A3; bf16_t* Z0c;
    __device__ __forceinline__ void operator()(const f32x4 (&acc)[2][2][4][2], const Unit& u, int wr, int wc, int fr, int fq) const {
        if (u.pn >= 2) {
            const int row0 = u.pm * BM + wr * 64 + fr, col0 = (u.pn - 2) * BM + wc * 32 + 8 * fq;
#pragma unroll
            for (int ai = 0; ai < 2; ++ai)
#pragma unroll
                for (int m = 0; m < 4; ++m) { bf16_t* rowp = Z0c + (size_t)(row0 + ai * HALF + m * 16) * 512 + col0;
#pragma unroll
                    for (int bj = 0; bj < 2; ++bj) *(u32x4*)(rowp + bj * HALF) = pack8(acc[ai][bj][m][0], acc[ai][bj][m][1]); }
        } else {
            const int b = (u.pm < 128) ? (u.pm >> 3) : (u.pm - 128); const int c0 = (u.pm < 128) ? (16 + (u.pm & 7) * 16) : 0;
            const int g0 = u.pn * 16 + wc * 2 + (fq >> 1);
            const size_t r0 = (size_t)(g0 * 16 + b) * 144 + c0 + wr * 4;
            const int cc = fr * 16 + 8 * (fq & 1);
#pragma unroll
            for (int ai = 0; ai < 2; ++ai)
#pragma unroll
                for (int m = 0; m < 4; ++m)
#pragma unroll
                    for (int bj = 0; bj < 2; ++bj) { const size_t r = r0 + (size_t)bj * (8 * 16 * 144) + ai * 8 + m; const u32x4 w = pack8(acc[ai][bj][m][0], acc[ai][bj][m][1]);
                        *(u32x4*)(U + r * 256 + cc) = w; *(u32x4*)(A3 + r * 512 + cc) = w; }
        }
    }
};
struct EpiF32 {
    static constexpr bool PERM = false, AFTER_DRAIN = false;
    float* C; int ldc;
    __device__ __forceinline__ void operator()(const f32x4 (&acc)[2][2][4][2], const Unit& u, int wr, int wc, int fr, int fq) const {
        const int row0 = u.pm * BM + wr * 64 + fr, col0 = wc * 32 + 4 * fq;
#pragma unroll
        for (int ai = 0; ai < 2; ++ai)
#pragma unroll
            for (int m = 0; m < 4; ++m) { float* rowp = C + (size_t)(row0 + ai * HALF + m * 16) * ldc + col0;
#pragma unroll
                for (int bj = 0; bj < 2; ++bj)
#pragma unroll
                    for (int n = 0; n < 2; ++n) *(f32x4*)(rowp + bj * HALF + n * 16) = acc[ai][bj][m][n]; }
    }
};
__device__ __forceinline__ float gelu_tanh_f(float x) { const float t = 0.7978845608028654f * (x + 0.044715f * x * x * x); const float e = __builtin_amdgcn_exp2f(2.8853900817779268f * t); return x - x * __builtin_amdgcn_rcpf(e + 1.0f); }
struct EpiS5Out {
    static constexpr bool PERM = true, AFTER_DRAIN = false;
    bf16_t* AG;
    __device__ __forceinline__ void operator()(const f32x4 (&acc)[2][2][4][2], const Unit& u, int wr, int wc, int fr, int fq) const {
        const int row0 = u.pm * BM + wr * 64 + fr, col0 = wc * 32 + 8 * fq;
#pragma unroll
        for (int ai = 0; ai < 2; ++ai)
#pragma unroll
            for (int m = 0; m < 4; ++m) { bf16_t* rowp = AG + (size_t)(row0 + ai * HALF + m * 16) * 256 + col0;
#pragma unroll
                for (int bj = 0; bj < 2; ++bj) { f32x4 v0 = acc[ai][bj][m][0], v1 = acc[ai][bj][m][1];
#pragma unroll
                    for (int i = 0; i < 4; ++i) { v0[i] = gelu_tanh_f(v0[i]); v1[i] = gelu_tanh_f(v1[i]); }
                    *(u32x4*)(rowp + bj * HALF) = pack8(v0, v1); } }
    }
};
struct S5Order {
    int G, c;
    __device__ __forceinline__ bool next(int i, Unit& u) const { const int L = i * G + c; if (L >= 32 * 9) return false; u.pm = L; u.pn = L / 9; return true; }
    __device__ __forceinline__ void a_ready(const Unit&) const {}
    __device__ __forceinline__ void done(const Unit&) const {}
};
struct EpiSwiGlu8 {
    static constexpr bool PERM = true, AFTER_DRAIN = false;
    unsigned char* O; int ldc; int nmod; float us, os; int tiled;
    __device__ __forceinline__ void operator()(const f32x4 (&acc)[2][2][4][2], const Unit& u, int wr, int wc, int fr, int fq) const {
        const int row0 = u.pm * BM + wr * 64 + fr; const int ct = nmod ? (u.pn % nmod) : u.pn; const int col0 = ct * HALF + wc * 32 + 8 * fq;
        typedef unsigned u32x2_ __attribute__((ext_vector_type(2))); typedef float f32x2_ __attribute__((ext_vector_type(2)));
        const float kexp = -1.4426950408889634f * us, kout = us * us * os;
#pragma unroll
        for (int ai = 0; ai < 2; ++ai)
#pragma unroll
            for (int m = 0; m < 4; ++m) { f32x4 o0, o1;
#pragma unroll
                for (int i = 0; i < 4; i += 2) {
                    const f32x2_ ga = {acc[ai][0][m][0][i], acc[ai][0][m][0][i + 1]}, gb = {acc[ai][0][m][1][i], acc[ai][0][m][1][i + 1]}, ua = {acc[ai][1][m][0][i], acc[ai][1][m][0][i + 1]}, ub = {acc[ai][1][m][1][i], acc[ai][1][m][1][i + 1]};
                    f32x2_ ta = ga * kexp, tb = gb * kexp; ta.x = __builtin_amdgcn_exp2f(ta.x); ta.y = __builtin_amdgcn_exp2f(ta.y); tb.x = __builtin_amdgcn_exp2f(tb.x); tb.y = __builtin_amdgcn_exp2f(tb.y);
                    ta = ta + 1.0f; tb = tb + 1.0f; ta.x = __builtin_amdgcn_rcpf(ta.x); ta.y = __builtin_amdgcn_rcpf(ta.y); tb.x = __builtin_amdgcn_rcpf(tb.x); tb.y = __builtin_amdgcn_rcpf(tb.y);
                    const f32x2_ ra = (ga * ua) * (ta * kout), rb = (gb * ub) * (tb * kout); o0[i] = ra.x; o0[i + 1] = ra.y; o1[i] = rb.x; o1[i + 1] = rb.y; }
                u32x2_ w; w.x = pk4_fp8(o0[0], o0[1], o0[2], o0[3]); w.y = pk4_fp8(o1[0], o1[1], o1[2], o1[3]);
                const int rr = wr * 64 + fr + ai * HALF + m * 16;
                if (tiled) *(u32x2_*)(O + (size_t)u.pm * BM * ldc + (size_t)ct * (BM * 128) + rr * 128 + wc * 32 + 8 * fq) = w;
                else *(u32x2_*)(O + (size_t)(row0 + ai * HALF + m * 16) * ldc + col0) = w; }
    }
};
struct MoeOrder {
    int t0, nT, nN, G, c; int e1, e2, e3, e4, e5, e6, e7; int rev;
    __device__ __forceinline__ bool next(int i, Unit& u) const {
        const int nwg = nT * nN; const long L = (long)i * G + c; if (L >= nwg) return false;
        int wgid = (int)L; { const int q = nwg / NXCD, r = nwg % NXCD, xcd = wgid % NXCD, off = wgid / NXCD, sz = xcd < r ? q + 1 : q; wgid = (xcd < r ? xcd * (q + 1) : r * (q + 1) + (xcd - r) * q) + (rev ? sz - 1 - off : off); }
        const int nig = WGM * nN, gid = wgid / nig, fm = gid * WGM, gsz = (nT - fm) < WGM ? (nT - fm) : WGM;
        const int pm = t0 + fm + ((wgid % nig) % gsz), pn = (wgid % nig) / gsz;
        const int e = (pm >= e1) + (pm >= e2) + (pm >= e3) + (pm >= e4) + (pm >= e5) + (pm >= e6) + (pm >= e7);
        u.pm = pm; u.pn = e * nN + pn; return true;
    }
    __device__ __forceinline__ void a_ready(const Unit&) const {}
    __device__ __forceinline__ void done(const Unit&) const {}
};
template <class Epi, class Sched, bool ALIGN_EPI = false, bool SP2 = false, bool FP8 = false, bool TILED = false, bool ACHUNK = false, bool AGATHER = false>
__device__ __forceinline__ void gemm_phase(PG8_LAS unsigned char* lds, const Gemm g, const Sched& S, const Epi& E) {
    const int tid = threadIdx.x, wid = __builtin_amdgcn_readfirstlane(tid >> 6), lane = tid & 63, wr = wid >> 2, wc = wid & 3, fr = lane & 15, fq = lane >> 4;
    const int K = g.K, nt = K / BK;
    unsigned voffA[2], voffB[2];
#pragma unroll
    for (int i = 0; i < 2; ++i) { int R, C; stage_rc(tid * 16 + i * 8192, R, C); const int Rb = Epi::PERM ? ((R & ~31) + perm32(R & 31)) : R;
        voffA[i] = TILED ? (unsigned)(R * BK + C) * 2u : (unsigned)(R * K + C) * 2u; voffB[i] = TILED ? (unsigned)(Rb * BK + C) * 2u : (unsigned)(Rb * K + C) * 2u;
        if (ACHUNK) voffA[i] = (unsigned)((R >> 4) * 512 + (R & 15) * 32 + (C & 15) * 2) + (unsigned)(C >> 4) * ACH_GS; }
    const size_t kstep = TILED ? (size_t)(BM * BK * 2) : (size_t)(BK * 2);
    const size_t hstep = TILED ? (size_t)(HALF * BK * 2) : (size_t)HALF * K * 2;
    const size_t tstep = (size_t)BM * K * 2;
    const size_t kstepA = ACHUNK ? (size_t)4 * ACH_GS : kstep, hstepA = ACHUNK ? (size_t)4096 : hstep;
#define PG8_ABASE(pm_) (AGATHER ? (const char*)g.A : ACHUNK ? (const char*)g.A + (size_t)((pm_) < 128 ? ((pm_) >> 3) * 144 + 16 + ((pm_) & 7) * 16 : ((pm_) - 128) * 144) * 512 : (const char*)g.A + (size_t)(pm_) * tstep)
    const unsigned ldsw = (unsigned)wid * 1024u;
    const int aoff = lds_byte(wr * 64 + fr, fq * 8), boff = lds_byte(wc * 32 + fr, fq * 8);
#define PG8_SA(b, h) (((b) * 2 + (h)) * HTB)
#define PG8_SB(b, h) ((4 + (b) * 2 + (h)) * HTB)
#define PG8_STAGE(bufoff, gbase, voff) do { _Pragma("unroll") for (int _i = 0; _i < 2; ++_i) \
        __builtin_amdgcn_global_load_lds((const unsigned*)((const char*)(gbase) + (voff)[_i]), (PG8_LAS unsigned*)(lds + (bufoff) + ldsw + _i * 8192), 16, 0, 0); } while (0)
    static_assert(!AGATHER || SP2, "AGATHER is written for the SP2 loop");
    unsigned gvA0[2] = {0u, 0u}, gvA1[2] = {0u, 0u}, gnA0[2] = {0u, 0u}, gnA1[2] = {0u, 0u};
#define PG8_GLOAD(uidx, v0, v1) do { _Pragma("unroll") for (int i_ = 0; i_ < 2; ++i_) { int R_, C_; stage_rc(tid * 16 + i_ * 8192, R_, C_); \
        const unsigned t0_ = g.atab[(uidx) * 256 + R_], t1_ = g.atab[(uidx) * 256 + 128 + R_]; v0[i_] = t0_ * (unsigned)(2 * K) + (unsigned)C_ * 2u; v1[i_] = t1_ * (unsigned)(2 * K) + (unsigned)C_ * 2u; } } while (0)
#define PG8_STAGE_A(bufoff, gbase, half, nx) do { if constexpr (AGATHER) { unsigned vs_[2]; \
        vs_[0] = (nx) ? ((half) ? gnA1[0] : gnA0[0]) : ((half) ? gvA1[0] : gvA0[0]); vs_[1] = (nx) ? ((half) ? gnA1[1] : gnA0[1]) : ((half) ? gvA1[1] : gvA0[1]); PG8_STAGE(bufoff, gbase, vs_); } \
        else PG8_STAGE(bufoff, (gbase) + ((half) ? hstepA : (size_t)0), voffA); } while (0)
#define PG8_LDA(dst, b, h) do { _Pragma("unroll") for (int m = 0; m < 4; ++m) _Pragma("unroll") for (int k = 0; k < 2; ++k) dst[m][k] = *(const PG8_LAS bf16x8*)(lds + PG8_SA(b, h) + aoff + m * 2048 + k * 1024); } while (0)
#define PG8_LDB(dst, b, h) do { _Pragma("unroll") for (int n = 0; n < 2; ++n) _Pragma("unroll") for (int k = 0; k < 2; ++k) dst[n][k] = *(const PG8_LAS bf16x8*)(lds + PG8_SB(b, h) + boff + n * 2048 + k * 1024); } while (0)
#define PG8_MMA(ai, bj, At, Bt) do { __builtin_amdgcn_s_setprio(1); _Pragma("unroll") for (int m = 0; m < 4; ++m) _Pragma("unroll") for (int n = 0; n < 2; ++n) { \
        if constexpr (FP8) { typedef int i32x4_ __attribute__((ext_vector_type(4))); typedef int i32x8_ __attribute__((ext_vector_type(8))); \
            const i32x8_ bo_ = __builtin_shufflevector(__builtin_bit_cast(i32x4_, Bt[n][0]), __builtin_bit_cast(i32x4_, Bt[n][1]), 0, 1, 2, 3, 4, 5, 6, 7); \
            const i32x8_ ao_ = __builtin_shufflevector(__builtin_bit_cast(i32x4_, At[m][0]), __builtin_bit_cast(i32x4_, At[m][1]), 0, 1, 2, 3, 4, 5, 6, 7); \
            asm volatile("v_mfma_f32_16x16x128_f8f6f4 %0, %1, %2, %0" : "+v"(acc[ai][bj][m][n]) : "v"(bo_), "v"(ao_)); } \
        else { _Pragma("unroll") for (int k = 0; k < 2; ++k) acc[ai][bj][m][n] = __builtin_amdgcn_mfma_f32_16x16x32_bf16(Bt[n][k], At[m][k], acc[ai][bj][m][n], 0, 0, 0); } } \
        __builtin_amdgcn_s_setprio(0); } while (0)
#define PG8_WAIT_V(n) asm volatile("s_waitcnt vmcnt(" #n ")" ::: "memory")
#define PG8_WAIT_L(n) asm volatile("s_waitcnt lgkmcnt(" #n ")" ::: "memory")
#define PG8_BAR __builtin_amdgcn_s_barrier()
#define PG8_SCHED __builtin_amdgcn_sched_barrier(0)
    const int fp8_unit_scale_ = 0x7f7f7f7f; (void)fp8_unit_scale_;
    Unit cur, nxt; int ui = 0;
    if (!S.next(0, cur)) return;
    f32x4 acc[2][2][4][2];
#pragma unroll
    for (int a = 0; a < 2; ++a)
#pragma unroll
        for (int b = 0; b < 2; ++b)
#pragma unroll
            for (int m = 0; m < 4; ++m)
#pragma unroll
                for (int n = 0; n < 2; ++n) acc[a][b][m][n] = (f32x4){0.f, 0.f, 0.f, 0.f};
    bf16x8 At[4][2], B0[2][2], B1[2][2];
    const char* cA = PG8_ABASE(cur.pm); const char* cB = (const char*)g.Bt + (size_t)cur.pn * tstep;
    if constexpr (AGATHER) PG8_GLOAD(0, gvA0, gvA1);
    S.a_ready(cur);
    if constexpr (SP2) {
        PG8_STAGE(PG8_SB(0, 0), cB, voffB); PG8_STAGE(PG8_SB(0, 1), cB + hstep, voffB); PG8_STAGE_A(PG8_SA(0, 0), cA, 0, false); PG8_STAGE_A(PG8_SA(0, 1), cA, 1, false);
        if (wr == 1) PG8_BAR;
        PG8_WAIT_V(2); PG8_BAR;
        PG8_STAGE(PG8_SB(1, 0), cB + kstep, voffB); PG8_STAGE_A(PG8_SA(1, 0), cA + kstepA, 0, false); PG8_STAGE(PG8_SB(1, 1), cB + hstep + kstep, voffB);
        PG8_WAIT_V(6); PG8_BAR;
    } else {
        PG8_STAGE(PG8_SB(0, 0), cB, voffB); PG8_STAGE(PG8_SA(0, 0), cA, voffA); PG8_STAGE(PG8_SB(0, 1), cB + hstep, voffB); PG8_STAGE(PG8_SA(0, 1), cA + hstepA, voffA);
        if (wr == 1) PG8_BAR;
        PG8_WAIT_V(4); PG8_BAR;
        PG8_STAGE(PG8_SB(1, 0), cB + kstep, voffB); PG8_STAGE(PG8_SA(1, 0), cA + kstepA, voffA); PG8_STAGE(PG8_SB(1, 1), cB + hstep + kstep, voffB);
        PG8_WAIT_V(6); PG8_BAR;
    }
    for (;;) {
        const bool has_next = S.next(ui + 1, nxt);
        const char* nA = has_next ? PG8_ABASE(nxt.pm) : cA; const char* nB = has_next ? (const char*)g.Bt + (size_t)nxt.pn * tstep : cB;
        for (int t = 0; t < nt; t += 2) {
            const bool last = (t == nt - 2);
            const char* a1 = cA + (size_t)(t + 1) * kstepA;
            const char* a2 = last ? nA : cA + (size_t)(t + 2) * kstepA; const char* b2 = last ? nB : cB + (size_t)(t + 2) * kstep;
            const char* a3 = a2 + kstepA; const char* b3 = b2 + kstep;
            if (last && has_next) S.a_ready(nxt);
            const bool nx_ = last && has_next;
            if constexpr (AGATHER) { if (nx_) PG8_GLOAD(ui + 1, gnA0, gnA1); }
            if constexpr (SP2) {
            PG8_LDB(B0, 0, 0); PG8_LDB(B1, 0, 1); PG8_SCHED; PG8_LDA(At, 0, 0); PG8_STAGE_A(PG8_SA(1, 1), a1, 1, false);
            PG8_WAIT_V(8); PG8_WAIT_L(0); PG8_BAR; PG8_MMA(0, 0, At, B0); PG8_MMA(0, 1, At, B1); PG8_BAR; PG8_SCHED;
            PG8_LDA(At, 0, 1); PG8_STAGE(PG8_SB(0, 0), b2, voffB); PG8_STAGE(PG8_SB(0, 1), b2 + hstep, voffB); PG8_STAGE_A(PG8_SA(0, 0), a2, 0, nx_);
            PG8_WAIT_V(8); PG8_WAIT_L(0); PG8_BAR; PG8_MMA(1, 0, At, B0); PG8_MMA(1, 1, At, B1); PG8_BAR; PG8_SCHED;
            PG8_LDB(B0, 1, 0); PG8_LDB(B1, 1, 1); PG8_SCHED; PG8_LDA(At, 1, 0); PG8_STAGE_A(PG8_SA(0, 1), a2, 1, nx_);
            PG8_WAIT_V(8); PG8_WAIT_L(0); PG8_BAR; PG8_MMA(0, 0, At, B0); PG8_MMA(0, 1, At, B1); PG8_BAR; PG8_SCHED;
            PG8_LDA(At, 1, 1); PG8_STAGE(PG8_SB(1, 0), b3, voffB); PG8_STAGE(PG8_SB(1, 1), b3 + hstep, voffB); PG8_STAGE_A(PG8_SA(1, 0), a3, 0, nx_);
            PG8_WAIT_V(8); PG8_WAIT_L(0); PG8_BAR; PG8_MMA(1, 0, At, B0); PG8_MMA(1, 1, At, B1); PG8_BAR; PG8_SCHED;
            } else {
            PG8_LDB(B0, 0, 0); PG8_SCHED; PG8_LDA(At, 0, 0); PG8_STAGE(PG8_SA(1, 1), a1 + hstepA, voffA);
            PG8_WAIT_L(8); PG8_BAR; PG8_WAIT_L(0); PG8_MMA(0, 0, At, B0); PG8_BAR; PG8_SCHED;
            PG8_LDB(B1, 0, 1); PG8_STAGE(PG8_SB(0, 0), b2, voffB);
            PG8_BAR; PG8_WAIT_L(0); PG8_MMA(0, 1, At, B1); PG8_BAR;
            PG8_LDA(At, 0, 1); PG8_STAGE(PG8_SA(0, 0), a2, voffA);
            PG8_BAR; PG8_WAIT_L(0); PG8_MMA(1, 0, At, B0); PG8_BAR; PG8_SCHED;
            PG8_STAGE(PG8_SB(0, 1), b2 + hstep, voffB);
            PG8_WAIT_V(6); PG8_BAR; PG8_MMA(1, 1, At, B1); PG8_BAR;
            PG8_LDB(B0, 1, 0); PG8_SCHED; PG8_LDA(At, 1, 0); PG8_STAGE(PG8_SA(0, 1), a2 + hstepA, voffA);
            PG8_WAIT_L(8); PG8_BAR; PG8_WAIT_L(0); PG8_MMA(0, 0, At, B0); PG8_BAR; PG8_SCHED;
            PG8_LDB(B1, 1, 1); PG8_STAGE(PG8_SB(1, 0), b3, voffB);
            PG8_BAR; PG8_WAIT_L(0); PG8_MMA(0, 1, At, B1); PG8_BAR;
            PG8_LDA(At, 1, 1); PG8_STAGE(PG8_SA(1, 0), a3, voffA);
            PG8_BAR; PG8_WAIT_L(0); PG8_MMA(1, 0, At, B0); PG8_BAR; PG8_SCHED;
            PG8_STAGE(PG8_SB(1, 1), b3 + hstep, voffB);
            PG8_WAIT_V(6); PG8_BAR; PG8_MMA(1, 1, At, B1); PG8_BAR;
            }
        }
        if constexpr (ALIGN_EPI) { if (wr == 0) PG8_BAR; }
        if constexpr (FP8) asm volatile("s_nop 15\n\ts_nop 7" ::: "memory");
        if constexpr (!Epi::AFTER_DRAIN) { E(acc, cur, wr, wc, fr, fq); S.done(cur); }
        if (!has_next) break;
#pragma unroll
        for (int a = 0; a < 2; ++a)
#pragma unroll
            for (int b = 0; b < 2; ++b)
#pragma unroll
                for (int m = 0; m < 4; ++m)
#pragma unroll
                    for (int n = 0; n < 2; ++n) acc[a][b][m][n] = (f32x4){0.f, 0.f, 0.f, 0.f};
        cur = nxt; cA = nA; cB = nB; ++ui;
        if constexpr (AGATHER) { gvA0[0] = gnA0[0]; gvA0[1] = gnA0[1]; gvA1[0] = gnA1[0]; gvA1[1] = gnA1[1]; }
        if constexpr (ALIGN_EPI) { if (wr == 1) PG8_BAR; }
    }
    PG8_WAIT_V(0);
    if constexpr (!ALIGN_EPI) { if (wr == 0) PG8_BAR; }
    PG8_BAR;
    if constexpr (Epi::AFTER_DRAIN) { E.fused(acc, cur, wr, wc, fr, fq, lds, wid, lane); S.done(cur); }
#undef PG8_ABASE
#undef PG8_GLOAD
#undef PG8_STAGE_A
#undef PG8_SA
#undef PG8_SB
#undef PG8_STAGE
#undef PG8_LDA
#undef PG8_LDB
#undef PG8_MMA
#undef PG8_WAIT_V
#undef PG8_WAIT_L
#undef PG8_BAR
#undef PG8_SCHED
}
}
#define GAS __attribute__((address_space(1)))
#define LAS __attribute__((address_space(3)))
typedef unsigned short bf16;
typedef unsigned v4u __attribute__((ext_vector_type(4)));
typedef float f32x4 __attribute__((ext_vector_type(4)));
typedef short bf16x8 __attribute__((ext_vector_type(8)));
typedef GAS unsigned gu32;
typedef GAS unsigned long long gu64;
#define RLX_AGENT __ATOMIC_RELAXED, __HIP_MEMORY_SCOPE_AGENT
#define LDS_WAIT() asm volatile("s_waitcnt lgkmcnt(0)" ::: "memory")
#define VM_WAIT() asm volatile("s_waitcnt vmcnt(0)" ::: "memory")
__device__ __forceinline__ unsigned long long rt() { return __builtin_amdgcn_s_memrealtime(); }
__device__ __forceinline__ unsigned f2bf(float f) { unsigned u = __builtin_bit_cast(unsigned, f); return (u + 0x7fffu + ((u >> 16) & 1u)) >> 16; }
__device__ __forceinline__ unsigned pk2(float lo, float hi) { return f2bf(lo) | (f2bf(hi) << 16); }
#define XB_TMO      128
#define XB_XCNT(j)  (256  + 64 * (j))
#define XB_XSUB(j)  (1280 + 64 * (j))
#define XB_XGEN(j)  (2304 + 64 * (j))
#define XB_TOP      3328
#define XB_TOPGEN   3392
#define XCD_BAR_WORDS 3456
#define XB_SPIN_CAP (1u << 18)

__device__ __forceinline__ unsigned xb_ld(unsigned* p)              { return __hip_atomic_load(p, __ATOMIC_RELAXED, __HIP_MEMORY_SCOPE_AGENT); }
__device__ __forceinline__ unsigned xb_add(unsigned* p, unsigned v) { return __hip_atomic_fetch_add(p, v, __ATOMIC_RELAXED, __HIP_MEMORY_SCOPE_AGENT); }
__device__ __forceinline__ unsigned xb_xcc_id() { return (unsigned)__builtin_amdgcn_s_getreg((3 << 11) | 20) & 0xFu; }
#define XB_SPIN(cond, bar) do { unsigned _sp = 0; while (cond) { __builtin_amdgcn_s_sleep(1); \
    if ((++_sp & 255u) == 0u) { if (xb_ld(&(bar)[XB_TMO])) break; if (_sp > XB_SPIN_CAP) { atomicAdd(&(bar)[XB_TMO], 1u); break; } } } } while (0)

struct XcdBarrier {
    unsigned* bar; unsigned x;
    volatile LAS unsigned* st;
};

__device__ __forceinline__ XcdBarrier xcd_barrier_post(unsigned* bar, volatile LAS unsigned* st) {
    XcdBarrier b; b.bar = bar; b.x = xb_xcc_id(); b.st = st;
    if (threadIdx.x == 0) (void)xb_add(&bar[XB_XCNT(b.x)], 1u);
    return b;
}
__device__ __forceinline__ void xcd_barrier_complete(unsigned* bar, unsigned x, unsigned& nloc, unsigned& nx) {
    const unsigned G = gridDim.x * gridDim.y * gridDim.z;
    unsigned sum, cnt, mine, sp = 0u;
    for (;;) {
        sum = 0u; cnt = 0u; mine = 0u;
#pragma unroll
        for (unsigned j = 0; j < 16; ++j) { const unsigned c = xb_ld(&bar[XB_XCNT(j)]); sum += c; cnt += (c > 0u) ? 1u : 0u; mine = (j == x) ? c : mine; }
        if (sum == G) break;
        __builtin_amdgcn_s_sleep(1);
        if ((++sp & 255u) == 0u) { if (xb_ld(&bar[XB_TMO])) break; if (sp > XB_SPIN_CAP) { atomicAdd(&bar[XB_TMO], 1u); break; } }
    }
    nloc = mine > 0u ? mine : 1u; nx = cnt > 0u ? cnt : 1u;
}

__device__ __forceinline__ void xcd_barrier(const XcdBarrier& b) {
    asm volatile("s_waitcnt vmcnt(0)" ::: "memory");
    __syncthreads();
    if (threadIdx.x == 0) {
        unsigned* bar = b.bar;
        __builtin_amdgcn_s_waitcnt(0);
        unsigned nloc = b.st[0], nx = b.st[1];
        if (nloc == 0u) { xcd_barrier_complete(bar, b.x, nloc, nx); b.st[0] = nloc; b.st[1] = nx; }
        const unsigned old = xb_add(&bar[XB_XSUB(b.x)], 1u);
        const unsigned gen = old / nloc;
        if (old + 1u == (gen + 1u) * nloc) {
            __builtin_amdgcn_fence(__ATOMIC_RELEASE, "agent");
            asm volatile("s_waitcnt vmcnt(0)" ::: "memory");
            const unsigned og = xb_add(&bar[XB_TOP], 1u);
            const unsigned tg = og / nx;
            if (og + 1u == (tg + 1u) * nx) xb_add(&bar[XB_TOPGEN], 1u);
            else XB_SPIN(xb_ld(&bar[XB_TOPGEN]) == tg, bar);
            __builtin_amdgcn_fence(__ATOMIC_ACQUIRE, "agent");
            xb_add(&bar[XB_XGEN(b.x)], 1u);
            asm volatile("s_waitcnt vmcnt(0)" ::: "memory");
        } else {
            XB_SPIN(xb_ld(&bar[XB_XGEN(b.x)]) == gen, bar);
            __builtin_amdgcn_fence(__ATOMIC_ACQUIRE, "agent");
            asm volatile("s_waitcnt vmcnt(0)" ::: "memory");
        }
    }
    __syncthreads();
}

namespace att {
typedef short bf16x8 __attribute__((ext_vector_type(8)));
typedef short s16x4 __attribute__((ext_vector_type(4)));
typedef float f32x16 __attribute__((ext_vector_type(16)));
typedef unsigned u32x4 __attribute__((ext_vector_type(4)));
#define ATT_LAS __attribute__((address_space(3)))
constexpr int QBLK = 32, KVBLK = 64, DQ = 96, DV = 64, LDQ = 768, LDKN = 1024, LDKR = 32, LDV = 1024, LDO = 1024;
typedef const __attribute__((address_space(1))) unsigned short* gcp; typedef __attribute__((address_space(1))) unsigned short* gp;
constexpr float SCALE = 0.10206207261596577f, QSC = SCALE * 1.4426950408889634f, THR2 = 8.f * 1.4426950408889634f;
constexpr int SHM_V = KVBLK * DV * 2, SHM_K = KVBLK * 256, NRING = 4, OFF_K = 0, OFF_V = NRING * SHM_K, OFF_WS = NRING * (SHM_V + SHM_K), ATT_LDS = OFF_WS + 8 * 256;
#define KSWZ(row, colB) ((row) * 256 + ((colB) ^ (((row) & 7) << 4)))
#define SBAR() __builtin_amdgcn_sched_barrier(0)
__device__ __forceinline__ int crow(int r, int hi) { return (r & 3) + 8 * (r >> 2) + 4 * hi; }
__device__ __forceinline__ unsigned cvtpk(float lo, float hi) { unsigned r; asm volatile("v_cvt_pk_bf16_f32 %0, %1, %2" : "=v"(r) : "v"(lo), "v"(hi)); return r; }
template <bool FIRST> __device__ __forceinline__ void partialSM(f32x16& p0, f32x16& p1, f32x16& mC, float& alpha) {
  float pmax = p0[0];
#pragma unroll
  for (int r = 1; r < 16; ++r) pmax = fmaxf(pmax, p0[r]);
#pragma unroll
  for (int r = 0; r < 16; ++r) pmax = fmaxf(pmax, p1[r]);
  { auto rr = __builtin_amdgcn_permlane32_swap(__float_as_uint(pmax), __float_as_uint(pmax), false, false);
    pmax = fmaxf(__uint_as_float(rr[0]), __uint_as_float(rr[1])); }
  if (!FIRST && __builtin_expect(__all(pmax <= THR2), 1)) alpha = 1.f;
  else { const float d = FIRST ? pmax : fmaxf(pmax, 0.f); alpha = __builtin_amdgcn_exp2f(-d);
#pragma unroll
    for (int r = 0; r < 16; ++r) { p0[r] -= d; p1[r] -= d; mC[r] -= d; } }
#pragma unroll
  for (int r = 0; r < 16; ++r) p0[r] = __builtin_amdgcn_exp2f(p0[r]);
}
__device__ __forceinline__ void finishSM(f32x16& p0, f32x16& p1, bf16x8& pa0, bf16x8& pa1, bf16x8& pa2, bf16x8& pa3) {
#pragma unroll
  for (int r = 0; r < 16; ++r) p1[r] = __builtin_amdgcn_exp2f(p1[r]);
#define PK4(P, BASE, OUT) do { u32x4 w = {cvtpk(P[BASE + 0], P[BASE + 1]), cvtpk(P[BASE + 2], P[BASE + 3]), cvtpk(P[BASE + 4], P[BASE + 5]), cvtpk(P[BASE + 6], P[BASE + 7])}; OUT = __builtin_bit_cast(bf16x8, w); } while (0)
  PK4(p0, 0, pa0); PK4(p0, 8, pa1); PK4(p1, 0, pa2); PK4(p1, 8, pa3);
#undef PK4
}
__device__ __forceinline__ void qkt(f32x16& p0, f32x16& p1, const f32x16& mC, const ATT_LAS unsigned char* Ks, const bf16x8* qr, int r32, int hi) {
#pragma unroll
  for (int d0 = 0; d0 < DQ / 16; ++d0) { const int cb = (d0 * 16 + hi * 8) * 2;
    const bf16x8 b0 = *(const ATT_LAS bf16x8*)(Ks + KSWZ(r32, cb));
    const bf16x8 b1 = *(const ATT_LAS bf16x8*)(Ks + KSWZ(32 + r32, cb));
    p0 = __builtin_amdgcn_mfma_f32_32x32x16_bf16(b0, qr[d0], d0 ? p0 : mC, 0, 0, 0);
    p1 = __builtin_amdgcn_mfma_f32_32x32x16_bf16(b1, qr[d0], d0 ? p1 : mC, 0, 0, 0); }
}
__device__ __forceinline__ int v_st(int k, int c) { const int kk = k; return ((kk >> 3) * 2 + (c >> 5)) * 512 + ((kk & 7) * 32 + (c & 31)) * 2; }
__device__ __forceinline__ int v_rd_base(int lane) { return ((lane & 3) << 3) | (((lane >> 2) & 3) << 6) | (((lane >> 4) & 1) << 5) | (((lane >> 5) & 1) << 8); }
constexpr int v_rd_off(int d0, int ks, int half) { return d0 * 512 + ks * 2048 + half * 1024; }
struct KPre { bf16x8 a0, b0, a1, b1; };
#define KLDX(KS, D0, A, B) do { A = *(const ATT_LAS bf16x8*)((KS) + KSWZ(r32, ((D0) * 16 + hi * 8) * 2)); B = *(const ATT_LAS bf16x8*)((KS) + KSWZ(32 + r32, ((D0) * 16 + hi * 8) * 2)); } while (0)
#define VLD(D0, KS_, H) __builtin_amdgcn_ds_read_tr16_b64_v4i16((ATT_LAS s16x4*)(vbp + VO + v_rd_off(D0, KS_, H)))
#define PK(L, H) (bf16x8){L[0], L[1], L[2], L[3], H[0], H[1], H[2], H[3]}
#define MFMA(A, B, C) __builtin_amdgcn_mfma_f32_32x32x16_bf16(A, B, C, 0, 0, 0)
template <int VO> __device__ __forceinline__ void region1(f32x16& n0, f32x16& n1, const f32x16& mC, const ATT_LAS unsigned char* Ks, const bf16x8* qr, int r32, int hi, const KPre& kp,
                                                          f32x16& p0, f32x16& p1, bf16x8& pa0, bf16x8& pa1, bf16x8& pa2, bf16x8& pa3, const ATT_LAS unsigned char* vbp, s16x4* vf) {
  bf16x8 kA[DQ / 16], kB[DQ / 16]; unsigned w[16]; kA[0] = kp.a0; kB[0] = kp.b0; kA[1] = kp.a1; kB[1] = kp.b1;
#define KLD(D0) KLDX(Ks, D0, kA[D0], kB[D0])
#define KMM(D0) do { n0 = MFMA(kA[D0], qr[D0], (D0) ? n0 : mC); n1 = MFMA(kB[D0], qr[D0], (D0) ? n1 : mC); } while (0)
#define EXP1(R) p1[R] = __builtin_amdgcn_exp2f(p1[R])
  KLD(2); KMM(0); EXP1(0); EXP1(1); EXP1(2); EXP1(3); EXP1(4); EXP1(5); w[0] = cvtpk(p0[0], p0[1]); w[1] = cvtpk(p0[2], p0[3]); SBAR();
  KLD(3); KMM(1); EXP1(6); EXP1(7); EXP1(8); EXP1(9); EXP1(10); EXP1(11); w[2] = cvtpk(p0[4], p0[5]); w[3] = cvtpk(p0[6], p0[7]); SBAR();
  KLD(4); KMM(2); EXP1(12); EXP1(13); EXP1(14); EXP1(15); w[4] = cvtpk(p0[8], p0[9]); w[5] = cvtpk(p0[10], p0[11]); w[6] = cvtpk(p0[12], p0[13]); w[7] = cvtpk(p0[14], p0[15]); SBAR();
  KLD(5); KMM(3); w[8] = cvtpk(p1[0], p1[1]); w[9] = cvtpk(p1[2], p1[3]); w[10] = cvtpk(p1[4], p1[5]); w[11] = cvtpk(p1[6], p1[7]); SBAR();
#pragma unroll
  for (int ks = 0; ks < 4; ++ks) { vf[2 * ks] = VLD(0, ks, 0); vf[2 * ks + 1] = VLD(0, ks, 1); }
  KMM(4); w[12] = cvtpk(p1[8], p1[9]); w[13] = cvtpk(p1[10], p1[11]); w[14] = cvtpk(p1[12], p1[13]); w[15] = cvtpk(p1[14], p1[15]); SBAR();
  KMM(5);
#undef KLD
#undef KMM
#undef EXP1
  { const u32x4 a = {w[0], w[1], w[2], w[3]}, b = {w[4], w[5], w[6], w[7]}, c = {w[8], w[9], w[10], w[11]}, d = {w[12], w[13], w[14], w[15]};
    pa0 = __builtin_bit_cast(bf16x8, a); pa1 = __builtin_bit_cast(bf16x8, b); pa2 = __builtin_bit_cast(bf16x8, c); pa3 = __builtin_bit_cast(bf16x8, d); }
}
template <int VO> __device__ __forceinline__ void region2(f32x16* o, const s16x4* vf, const ATT_LAS unsigned char* vbp, bf16x8 pa0, bf16x8 pa1, bf16x8 pa2, bf16x8 pa3, bf16x8 ones,
                                                          f32x16& n0, f32x16& n1, f32x16& mC, float& alpha) {
  s16x4 vg[8];
#pragma unroll
  for (int ks = 0; ks < 4; ++ks) { vg[2 * ks] = VLD(1, ks, 0); vg[2 * ks + 1] = VLD(1, ks, 1); }
#define MX3(A, P, R) A = fmaxf(fmaxf(A, P[R]), P[R + 1])
  o[0] = MFMA(pa0, PK(vf[0], vf[1]), o[0]); o[2] = MFMA(pa0, ones, o[2]); SBAR();
  float ma = fmaxf(n0[0], n0[1]), mb = fmaxf(n1[0], n1[1]);
  o[0] = MFMA(pa1, PK(vf[2], vf[3]), o[0]); o[2] = MFMA(pa1, ones, o[2]); MX3(ma, n0, 2); MX3(mb, n1, 2); MX3(ma, n0, 4); MX3(mb, n1, 4); SBAR();
  o[0] = MFMA(pa2, PK(vf[4], vf[5]), o[0]); o[2] = MFMA(pa2, ones, o[2]); MX3(ma, n0, 6); MX3(mb, n1, 6); MX3(ma, n0, 8); MX3(mb, n1, 8); MX3(ma, n0, 10); MX3(mb, n1, 10); SBAR();
  o[0] = MFMA(pa3, PK(vf[6], vf[7]), o[0]); o[2] = MFMA(pa3, ones, o[2]); MX3(ma, n0, 12); MX3(mb, n1, 12); MX3(ma, n0, 14); MX3(mb, n1, 14);
  float pmax = fmaxf(ma, mb);
  { auto rr = __builtin_amdgcn_permlane32_swap(__float_as_uint(pmax), __float_as_uint(pmax), false, false);
    pmax = fmaxf(__uint_as_float(rr[0]), __uint_as_float(rr[1])); }
  if (__builtin_expect(__all(pmax <= THR2), 1)) alpha = 1.f;
  else { const float d = fmaxf(pmax, 0.f); alpha = __builtin_amdgcn_exp2f(-d);
#pragma unroll
    for (int r = 0; r < 16; ++r) { n0[r] -= d; n1[r] -= d; mC[r] -= d; } }
#define EXP4(R) do { float e0 = __builtin_amdgcn_exp2f(n0[R]), e1 = __builtin_amdgcn_exp2f(n0[R + 1]), e2 = __builtin_amdgcn_exp2f(n0[R + 2]), e3 = __builtin_amdgcn_exp2f(n0[R + 3]); \
    asm volatile("" : "+v"(e0), "+v"(e1), "+v"(e2), "+v"(e3)); n0[R] = e0; n0[R + 1] = e1; n0[R + 2] = e2; n0[R + 3] = e3; } while (0)
  SBAR(); o[1] = MFMA(pa0, PK(vg[0], vg[1]), o[1]); EXP4(0); SBAR();
  o[1] = MFMA(pa1, PK(vg[2], vg[3]), o[1]); EXP4(4); SBAR();
  o[1] = MFMA(pa2, PK(vg[4], vg[5]), o[1]); EXP4(8); SBAR();
  o[1] = MFMA(pa3, PK(vg[6], vg[7]), o[1]); EXP4(12);
#undef EXP4
#undef MX3
}
template <int VO> __device__ __forceinline__ void pv_last(f32x16* o, const ATT_LAS unsigned char* vbp, bf16x8 pa0, bf16x8 pa1, bf16x8 pa2, bf16x8 pa3, bf16x8 ones) {
  s16x4 vf[8], vg[8];
#pragma unroll
  for (int ks = 0; ks < 4; ++ks) { vf[2 * ks] = VLD(0, ks, 0); vf[2 * ks + 1] = VLD(0, ks, 1); vg[2 * ks] = VLD(1, ks, 0); vg[2 * ks + 1] = VLD(1, ks, 1); }
  o[0] = MFMA(pa0, PK(vf[0], vf[1]), o[0]); o[1] = MFMA(pa0, PK(vg[0], vg[1]), o[1]); o[2] = MFMA(pa0, ones, o[2]);
  o[0] = MFMA(pa1, PK(vf[2], vf[3]), o[0]); o[1] = MFMA(pa1, PK(vg[2], vg[3]), o[1]); o[2] = MFMA(pa1, ones, o[2]);
  o[0] = MFMA(pa2, PK(vf[4], vf[5]), o[0]); o[1] = MFMA(pa2, PK(vg[4], vg[5]), o[1]); o[2] = MFMA(pa2, ones, o[2]);
  o[0] = MFMA(pa3, PK(vf[6], vf[7]), o[0]); o[1] = MFMA(pa3, PK(vg[6], vg[7]), o[1]); o[2] = MFMA(pa3, ones, o[2]);
}
#undef VLD
#undef PK
#undef MFMA

__device__ __forceinline__ void attn_unit(const unsigned short* Qb_, const unsigned short* Kn_, const unsigned short* Kr_, const unsigned short* Vc_, int ra, int nt_a, int rb, int NT,
                                          unsigned short* Ob_, ATT_LAS unsigned char* lds, int rope_t0) {
  gcp Qb = (gcp)Qb_, Kn = (gcp)Kn_, Kr = (gcp)Kr_, Vc = (gcp)Vc_; gp Ob = (gp)Ob_;
  const int tid = threadIdx.x, wid = tid >> 6, lane = tid & 63, r32 = lane & 31, hi = lane >> 5;
  ATT_LAS unsigned char* V_lds = lds + OFF_V; ATT_LAS unsigned char* K_lds = lds + OFF_K;
  ATT_LAS float* wsp = (ATT_LAS float*)(lds + OFF_WS) + wid * 64; ATT_LAS float* al_l = wsp + 32;
  f32x16 o[3] = {}, mC = {}; bf16x8 qr[DQ / 16]; const u32x4 ones_w = {0x3f803f80u, 0x3f803f80u, 0x3f803f80u, 0x3f803f80u}; const bf16x8 ones = __builtin_bit_cast(bf16x8, ones_w);
  const int sk = tid >> 3, sc = (tid & 7) * 8, rk = (tid & 255) >> 2, rc = (tid & 3) * 8; const bool rw = tid < 256;
  const int vst = v_st(sk, sc), kst0 = KSWZ(sk, sc * 2), kst1 = KSWZ(rk, (64 + rc) * 2);
  struct SR { bf16x8 vs, k0, k1; };
#define TROW(t) ((t) < nt_a ? ra + (t) * KVBLK : rb + ((t) - nt_a) * KVBLK)
#define SLOADX(S, t) do { const long r0_ = TROW(t); S.vs = *(const __attribute__((address_space(1))) bf16x8*)(Vc + (r0_ + sk) * LDV + sc); S.k0 = *(const __attribute__((address_space(1))) bf16x8*)(Kn + (r0_ + sk) * LDKN + sc); \
    S.k1 = *(const __attribute__((address_space(1))) bf16x8*)(Kr + (r0_ + rk) * LDKR + rc); } while (0)
#define SWRITEX(b, S) do { *(ATT_LAS bf16x8*)(V_lds + (b) * SHM_V + vst) = S.vs; *(ATT_LAS bf16x8*)(K_lds + (b) * SHM_K + kst0) = S.k0; \
    if (rw) *(ATT_LAS bf16x8*)(K_lds + (b) * SHM_K + kst1) = S.k1; } while (0)
  SR s0_, s1_, sr_; SLOADX(s0_, 0); SLOADX(s1_, 1); SLOADX(sr_, 2);
  gcp Qw = Qb + (long)(wid * QBLK + r32) * LDQ + hi * 8;
#pragma unroll
  for (int d0 = 0; d0 < DQ / 16; ++d0) qr[d0] = *(const __attribute__((address_space(1))) bf16x8*)(Qw + d0 * 16);
  if (rope_t0 >= 0) {
    int t = rope_t0 + wid * QBLK + r32; asm volatile("" : "+v"(t));
    const float prow = (float)(t >> 6), pcol = (float)(t & 63);
#pragma unroll
    for (int f = 0; f < 2; ++f) { const u32x4 own = __builtin_bit_cast(u32x4, qr[4 + f]); u32x4 oth;
      oth.x = (unsigned)__shfl_xor((int)own.x, 32); oth.y = (unsigned)__shfl_xor((int)own.y, 32); oth.z = (unsigned)__shfl_xor((int)own.z, 32); oth.w = (unsigned)__shfl_xor((int)own.w, 32);
      const float pos = f ? pcol : prow; float o8[8];
#pragma unroll
      for (int j = 0; j < 8; ++j) { const unsigned wo = (j < 2) ? own.x : (j < 4) ? own.y : (j < 6) ? own.z : own.w, wp = (j < 2) ? oth.x : (j < 4) ? oth.y : (j < 6) ? oth.z : oth.w;
        const float a = (j & 1) ? __uint_as_float(wo & 0xffff0000u) : __uint_as_float(wo << 16), bq = (j & 1) ? __uint_as_float(wp & 0xffff0000u) : __uint_as_float(wp << 16);
        const float ang = pos * __builtin_amdgcn_exp2f(-(float)j * (13.287712379549449f / 8.0f)); float sn, cs; __sincosf(ang, &sn, &cs);
        o8[j] = hi ? (a * cs + bq * sn) : (a * cs - bq * sn); }
      u32x4 w = {cvtpk(o8[0], o8[1]), cvtpk(o8[2], o8[3]), cvtpk(o8[4], o8[5]), cvtpk(o8[6], o8[7])}; qr[4 + f] = __builtin_bit_cast(bf16x8, w); } }
#pragma unroll
  for (int d0 = 0; d0 < DQ / 16; ++d0) { const u32x4 w = __builtin_bit_cast(u32x4, qr[d0]); u32x4 q;
#pragma unroll
    for (int i = 0; i < 4; ++i) q[i] = cvtpk(__uint_as_float(w[i] << 16) * QSC, __uint_as_float(w[i] & 0xffff0000u) * QSC);
    qr[d0] = __builtin_bit_cast(bf16x8, q); }
#define SLOAD(t) SLOADX(sr_, t)
#define SWRITE(b) SWRITEX(b, sr_)
#define SWAIT() asm volatile("s_waitcnt vmcnt(0)" ::: "memory")
#define BAR() asm volatile("s_barrier" ::: "memory")
#define RESC(a) do { if (__any((a) < 1.f)) { if (hi == 0) al_l[r32] = (a); asm volatile("s_waitcnt lgkmcnt(0)" ::: "memory"); \
    _Pragma("unroll") for (int d = 0; d < 3; ++d) _Pragma("unroll") for (int r = 0; r < 16; ++r) o[d][r] *= al_l[crow(r, hi)]; } } while (0)
#define KPRE(KB) do { KLDX(K_lds + (KB) * SHM_K, 0, kp.a0, kp.b0); KLDX(K_lds + (KB) * SHM_K, 1, kp.a1, kp.b1); } while (0)
  f32x16 pA0, pA1, pB0, pB1; float alA, alB; bf16x8 pa0, pa1, pa2, pa3; KPre kp; s16x4 vf[8];
  const ATT_LAS unsigned char* vbp = V_lds + v_rd_base(lane);
  SWAIT(); SWRITEX(0, s0_); SWRITEX(1, s1_); SWRITE(2); SLOAD(3); __syncthreads();
  qkt(pA0, pA1, mC, K_lds, qr, r32, hi); partialSM<true>(pA0, pA1, mC, alA);
  KPRE(1); BAR();
#define STEP(PN0, PN1, ALN, PO0, PO1, KB, VB, T, WR, LD, NX) do { \
    SBAR(); if (WR) { SWAIT(); SWRITE(((KB) + 2) & 3); } if (LD) SLOAD((T) + 3); SBAR(); \
    region1<(VB) * SHM_V>(PN0, PN1, mC, K_lds + (KB) * SHM_K, qr, r32, hi, kp, PO0, PO1, pa0, pa1, pa2, pa3, vbp, vf); SBAR(); \
    region2<(VB) * SHM_V>(o, vf, vbp, pa0, pa1, pa2, pa3, ones, PN0, PN1, mC, ALN); SBAR(); \
    if (NX) KPRE(((KB) + 1) & 3); RESC(ALN); BAR(); } while (0)
  int j = 1;
  for (; j + 3 < NT; j += 4) {
    STEP(pB0, pB1, alB, pA0, pA1, 1, 0, j, true, true, true);
    STEP(pA0, pA1, alA, pB0, pB1, 2, 1, j + 1, true, true, true);
    STEP(pB0, pB1, alB, pA0, pA1, 3, 2, j + 2, true, true, true);
    STEP(pA0, pA1, alA, pB0, pB1, 0, 3, j + 3, true, true, true);
  }
  STEP(pB0, pB1, alB, pA0, pA1, 1, 0, j, true, false, true);
  STEP(pA0, pA1, alA, pB0, pB1, 2, 1, j + 1, false, false, true);
  STEP(pB0, pB1, alB, pA0, pA1, 3, 2, j + 2, false, false, false);
  finishSM(pB0, pB1, pa0, pa1, pa2, pa3); SBAR();
  pv_last<3 * SHM_V>(o, vbp, pa0, pa1, pa2, pa3, ones);
  float rli[16];
#pragma unroll
  for (int r = 0; r < 16; ++r) rli[r] = __builtin_amdgcn_rcpf(o[2][r]);
  gp Ow = Ob + (long)(wid * QBLK) * LDO;
#pragma unroll
  for (int r = 0; r < 16; ++r) { const int orow = crow(r, hi);
#pragma unroll
    for (int d0 = 0; d0 < 2; ++d0) Ow[(long)orow * LDO + d0 * 32 + r32] = (unsigned short)(cvtpk(o[d0][r] * rli[r], 0.f) & 0xffffu); }
  asm volatile("s_waitcnt vmcnt(0)" ::: "memory");
  __syncthreads();
#undef TROW
#undef SLOAD
#undef SWRITE
#undef SLOADX
#undef SWRITEX
#undef STEP
#undef BAR
#undef KPRE
#undef SWAIT
#undef RESC
}
#undef KLDX
#undef KSWZ
#undef SBAR
}

namespace gla {
typedef short bf16x8 __attribute__((ext_vector_type(8)));
typedef short s16x4 __attribute__((ext_vector_type(4)));
typedef float f32x16 __attribute__((ext_vector_type(16)));
typedef float f32x4 __attribute__((ext_vector_type(4)));
typedef float f32x2 __attribute__((ext_vector_type(2)));
typedef __bf16 bf16x2_t __attribute__((ext_vector_type(2)));
typedef unsigned u32x4 __attribute__((ext_vector_type(4)));
typedef unsigned u32x2 __attribute__((ext_vector_type(2)));
#define GLA_LAS __attribute__((address_space(3)))
#define GLA_GAS __attribute__((address_space(1)))
constexpr int RS256 = 272, RS128 = 144;
constexpr int OFF_QT = 0, OFF_KT = 64 * RS256, OFF_KH = 2 * 64 * RS256, OFF_V = OFF_KH + 128 * RS128, OFF_P = OFF_V + 32768, OFF_TOT = OFF_P + 64 * RS128, OFF_EL = OFF_TOT + 2048, OFF_ZG = OFF_EL + 512, OFF_W2 = OFF_ZG + 4096, GLA_LDS = OFF_W2 + 8192;
static_assert(GLA_LDS <= 131072 && OFF_V % 16 == 0 && OFF_P % 16 == 0 && OFF_TOT % 16 == 0, "gla lds map");
__device__ __forceinline__ int swz256(int row, int colB) { return row * RS256 + colB; }
__device__ __forceinline__ int swz128(int row, int colB) { return row * RS128 + colB; }
__device__ __forceinline__ int crow(int r, int hi) { return (r & 3) + 8 * (r >> 2) + 4 * hi; }
__device__ __forceinline__ unsigned pk2f(float lo, float hi) { const f32x2 v = {lo, hi}; return __builtin_bit_cast(unsigned, __builtin_convertvector(v, bf16x2_t)); }
__device__ __forceinline__ unsigned short bf1f(float x) { return (unsigned short)(pk2f(x, 0.f) & 0xffffu); }
__device__ __forceinline__ float bfu(unsigned short u) { return __uint_as_float(((unsigned)u) << 16); }
__device__ __forceinline__ int v_st(int k, int c) { const int kk = (k & ~0xC) | ((k & 4) << 1) | ((k & 8) >> 1); return ((kk >> 3) * 8 + (c >> 5)) * 512 + ((kk & 7) * 32 + (c & 31)) * 2; }
__device__ __forceinline__ int v_rd_base(int lane) { return ((lane & 3) << 3) | (((lane >> 2) & 3) << 6) | (((lane >> 4) & 1) << 5) | (((lane >> 5) & 1) << 8); }
template <int OFF> __device__ __forceinline__ s16x4 tr_read(int vb) { s16x4 r; asm volatile("ds_read_b64_tr_b16 %0, %1 offset:%2" : "=&v"(r) : "v"(vb), "i"(OFF) : "memory"); return r; }
#define GLA_MFMA(a, b, c) __builtin_amdgcn_mfma_f32_32x32x16_bf16((a), (b), (c), 0, 0, 0)
__device__ __forceinline__ bf16x8 pack_step(const f32x16& x, int s) {
    u32x4 p; p.x = pk2f(x[8 * s], x[8 * s + 1]); p.y = pk2f(x[8 * s + 2], x[8 * s + 3]); p.z = pk2f(x[8 * s + 4], x[8 * s + 5]); p.w = pk2f(x[8 * s + 6], x[8 * s + 7]); return __builtin_bit_cast(bf16x8, p);
}
__device__ __forceinline__ void gla_prep(const unsigned short* QK_, const unsigned short* ZG_, const float* w2_, const float* b2_, unsigned short* TQ_, unsigned short* TK_, unsigned short* TP_, float* EL_,
                                         int b, int h, int dir, int c_lo, int c_hi, int ML_, int SEQ_, int CTX_, GLA_LAS unsigned char* lds) {
    const GLA_GAS unsigned short* QK = (const GLA_GAS unsigned short*)QK_; const GLA_GAS unsigned short* ZG = (const GLA_GAS unsigned short*)ZG_;
    const GLA_GAS float* w2g = (const GLA_GAS float*)w2_; const GLA_GAS float* b2g = (const GLA_GAS float*)b2_;
    const int tid = threadIdx.x, wid = __builtin_amdgcn_readfirstlane(tid >> 6), lane = tid & 63, r32 = lane & 31, hi = lane >> 5;
    const int seg = tid >> 7, kk = tid & 127;
    GLA_LAS unsigned char* QT = lds + OFF_QT; GLA_LAS unsigned char* KT = lds + OFF_KT;
    GLA_LAS float* TOT = (GLA_LAS float*)(lds + OFF_TOT); GLA_LAS float* ZGS = (GLA_LAS float*)(lds + OFF_ZG); GLA_LAS float* W2S = (GLA_LAS float*)(lds + OFF_W2);
    __syncthreads();
#pragma unroll
    for (int i = 0; i < 4; ++i) { const int idx = tid + 512 * i; W2S[idx] = w2g[(size_t)(dir * 16 + (idx >> 7)) * 512 + h * 128 + (idx & 127)]; }
    const float b2 = b2g[dir * 512 + h * 128 + kk];
    const int nctx = CTX_ / 64;
    unsigned raw[16], zgw;
#define GLA_PLOAD(cs_) do { const long r0_ = ((cs_) < nctx) ? (long)ML_ + (long)b * CTX_ + 64 * (cs_) : (long)b * SEQ_ + 64 * ((cs_) - nctx); \
        zgw = *(const GLA_GAS unsigned*)(ZG + (r0_ + (tid >> 3)) * 2304 + dir * 16 + (tid & 7) * 2); \
        _Pragma("unroll") for (int i_ = 0; i_ < 16; ++i_) { const GLA_GAS unsigned short* zr_ = QK + (r0_ + 16 * seg + i_) * 1024 + h * 128 + kk; raw[i_] = (unsigned)zr_[0] | ((unsigned)zr_[512] << 16); } } while (0)
    for (int cs = c_lo; cs < c_hi; ++cs) {
        GLA_PLOAD(cs);
        const size_t tile = (size_t)((b * 4 + h) * 2 + dir) * 36 + cs;
        GLA_GAS unsigned short* TQ = (GLA_GAS unsigned short*)TQ_ + tile * 8192; GLA_GAS unsigned short* TK = (GLA_GAS unsigned short*)TK_ + tile * 8192; GLA_GAS unsigned short* TP = (GLA_GAS unsigned short*)TP_ + tile * 4096;
        { const int l = tid >> 3, r2 = (tid & 7) * 2; ZGS[l * 16 + r2] = __uint_as_float(zgw << 16); ZGS[l * 16 + r2 + 1] = __uint_as_float(zgw & 0xffff0000u); }
        __syncthreads();
        float cum[16];
#pragma unroll
        for (int i = 0; i < 16; ++i) cum[i] = b2;
#pragma unroll
        for (int q = 0; q < 4; ++q) { const float wa = W2S[(4 * q) * 128 + kk], wb = W2S[(4 * q + 1) * 128 + kk], wc_ = W2S[(4 * q + 2) * 128 + kk], wd = W2S[(4 * q + 3) * 128 + kk];
#pragma unroll
            for (int i = 0; i < 16; ++i) { const f32x4 z = *(const GLA_LAS f32x4*)(ZGS + (16 * seg + i) * 16 + 4 * q); cum[i] += z.x * wa + z.y * wb + z.z * wc_ + z.w * wd; } }
#pragma unroll
        for (int i = 0; i < 16; ++i) { const float x = cum[i]; cum[i] = (fminf(x, 0.f) - __logf(1.0f + __expf(-fabsf(x)))) * (1.0f / 16.0f); }
        if (dir == 0) {
#pragma unroll
            for (int i = 1; i < 16; ++i) cum[i] += cum[i - 1];
            TOT[seg * 128 + kk] = cum[15];
        } else {
#pragma unroll
            for (int i = 14; i >= 0; --i) cum[i] += cum[i + 1];
            TOT[seg * 128 + kk] = cum[0];
        }
        __syncthreads();
        { const float t0 = TOT[kk], t1 = TOT[128 + kk], t2 = TOT[256 + kk], t3 = TOT[384 + kk]; const float last = (t0 + t1) + (t2 + t3);
          float off;
          if (dir == 0) off = (seg > 0 ? t0 : 0.f) + (seg > 1 ? t1 : 0.f) + (seg > 2 ? t2 : 0.f);
          else off = (seg < 3 ? t3 : 0.f) + (seg < 2 ? t2 : 0.f) + (seg < 1 ? t1 : 0.f);
          if (seg == 0) ((GLA_GAS float*)EL_)[tile * 128 + kk] = __expf(last);
          unsigned ktp[8];
#pragma unroll
          for (int i = 0; i < 16; i += 2) {
              const float c0 = cum[i] + off, c1 = cum[i + 1] + off; const int l0 = 16 * seg + i, l1 = l0 + 1;
              const float q0 = __uint_as_float(raw[i] << 16), k0v = __uint_as_float(raw[i] & 0xffff0000u), q1 = __uint_as_float(raw[i + 1] << 16), k1v = __uint_as_float(raw[i + 1] & 0xffff0000u);
              const unsigned short qa = bf1f(q0 * __expf(c0)), qb = bf1f(q1 * __expf(c1)); const float ka = k0v * __expf(-c0), kb = k1v * __expf(-c1); const unsigned kp = pk2f(ka, kb);
              *(GLA_LAS unsigned short*)(QT + swz256(l0, 2 * kk)) = qa; *(GLA_LAS unsigned short*)(QT + swz256(l1, 2 * kk)) = qb;
              *(GLA_LAS unsigned short*)(KT + swz256(l0, 2 * kk)) = (unsigned short)(kp & 0xffffu); *(GLA_LAS unsigned short*)(KT + swz256(l1, 2 * kk)) = (unsigned short)(kp >> 16);
              TQ[l0 * 128 + kk] = qa; TQ[l1 * 128 + kk] = qb; ktp[i >> 1] = kp; }
          u32x4 k0 = {ktp[0], ktp[1], ktp[2], ktp[3]}, k1 = {ktp[4], ktp[5], ktp[6], ktp[7]};
          *(GLA_GAS u32x4*)(TK + kk * 64 + 16 * seg) = k0; *(GLA_GAS u32x4*)(TK + kk * 64 + 16 * seg + 8) = k1; }
        __syncthreads();
        if (wid < 4) { const int mi = wid >> 1, li = wid & 1; f32x16 x = f32x16{};
#pragma unroll
            for (int s2 = 0; s2 < 8; ++s2) { const int cb = (16 * s2 + 8 * hi) * 2;
                const bf16x8 a = *(const GLA_LAS bf16x8*)(KT + swz256(32 * mi + r32, cb)); const bf16x8 bq = *(const GLA_LAS bf16x8*)(QT + swz256(32 * li + r32, cb)); x = GLA_MFMA(a, bq, x); }
            const int l = 32 * li + r32;
#pragma unroll
            for (int g = 0; g < 4; ++g) { float v[4];
#pragma unroll
                for (int j = 0; j < 4; ++j) { const int m = 32 * mi + 8 * g + 4 * hi + j; const bool keep = (dir == 0) ? (m <= l) : (m >= l); v[j] = keep ? x[4 * g + j] : 0.f; }
                u32x2 w; w.x = pk2f(v[0], v[1]); w.y = pk2f(v[2], v[3]); *(GLA_GAS u32x2*)(TP + l * 64 + 32 * mi + 8 * g + 4 * hi) = w; } }
    }
#undef GLA_PLOAD
    __syncthreads();
}
__device__ __forceinline__ void gla_chain(const unsigned short* VR_, const unsigned short* TQ_, const unsigned short* TK_, const unsigned short* TP_, const float* EL_, unsigned short* O_, int b, int h, int dir,
                                          int ML_, int SEQ_, int CTX_, GLA_LAS unsigned char* lds) {
    const GLA_GAS unsigned short* VR = (const GLA_GAS unsigned short*)VR_; GLA_GAS unsigned short* O = (GLA_GAS unsigned short*)O_;
    const int tid = threadIdx.x, wid = __builtin_amdgcn_readfirstlane(tid >> 6), lane = tid & 63, r32 = lane & 31, hi = lane >> 5;
    GLA_LAS unsigned char* QT = lds + OFF_QT; GLA_LAS unsigned char* KH = lds + OFF_KH; GLA_LAS unsigned char* VI = lds + OFF_V; GLA_LAS unsigned char* PI = lds + OFF_P; GLA_LAS float* EL = (GLA_LAS float*)(lds + OFF_EL);
    f32x16 S[4];
#pragma unroll
    for (int t = 0; t < 4; ++t) S[t] = f32x16{};
    const int vb = (int)(unsigned)(uintptr_t)VI + v_rd_base(lane) + wid * 512;
    const int nchunk = (CTX_ + SEQ_) / 64, nctx = CTX_ / 64;
    const size_t tile0 = (size_t)((b * 4 + h) * 2 + dir) * 36;
    u32x4 pq[2], pk[2], pp, pv[4]; float pe = 0.f;
#define GLA_CS(sc_) ((dir == 0) ? (sc_) : (((sc_) < nctx) ? (nctx - 1 - (sc_)) : (nchunk - 1 - ((sc_) - nctx))))
#define GLA_FETCH(sc_) do { const int cs_ = GLA_CS(sc_); const size_t t_ = tile0 + cs_; const long r0_ = (cs_ < nctx) ? (long)ML_ + (long)b * CTX_ + 64 * cs_ : (long)b * SEQ_ + 64 * (cs_ - nctx); \
        const GLA_GAS u32x4* q_ = (const GLA_GAS u32x4*)((const GLA_GAS unsigned short*)TQ_ + t_ * 8192); const GLA_GAS u32x4* k_ = (const GLA_GAS u32x4*)((const GLA_GAS unsigned short*)TK_ + t_ * 8192); \
        pq[0] = q_[tid]; pq[1] = q_[tid + 512]; pk[0] = k_[tid]; pk[1] = k_[tid + 512]; pp = ((const GLA_GAS u32x4*)((const GLA_GAS unsigned short*)TP_ + t_ * 4096))[tid]; \
        if (tid < 128) pe = ((const GLA_GAS float*)EL_)[t_ * 128 + tid]; \
        _Pragma("unroll") for (int i_ = 0; i_ < 4; ++i_) { const int c_ = tid + 512 * i_; pv[i_] = *(const GLA_GAS u32x4*)(VR + (r0_ + (c_ >> 5)) * 2304 + h * 256 + (c_ & 31) * 8); } } while (0)
    GLA_FETCH(0);
    for (int sc = 0; sc < nchunk; ++sc) {
        const int cs = GLA_CS(sc); const bool is_lat = cs >= nctx; const long row0 = is_lat ? (long)b * SEQ_ + 64 * (cs - nctx) : (long)ML_ + (long)b * CTX_ + 64 * cs;
#pragma unroll
        for (int i = 0; i < 2; ++i) { const int c = tid + 512 * i; *(GLA_LAS u32x4*)(QT + (c >> 4) * RS256 + (c & 15) * 16) = pq[i]; *(GLA_LAS u32x4*)(KH + (c >> 3) * RS128 + (c & 7) * 16) = pk[i]; }
        *(GLA_LAS u32x4*)(PI + (tid >> 3) * RS128 + (tid & 7) * 16) = pp;
        if (tid < 128) EL[tid] = pe;
#pragma unroll
        for (int i = 0; i < 4; ++i) { const int c = tid + 512 * i; *(GLA_LAS u32x4*)(VI + v_st(c >> 5, (c & 31) * 8)) = pv[i]; }
        __syncthreads();
        if (sc + 1 < nchunk) GLA_FETCH(sc + 1);
        f32x16 o[2] = {f32x16{}, f32x16{}};
#pragma unroll
        for (int kt = 0; kt < 4; ++kt)
#pragma unroll
            for (int s2 = 0; s2 < 2; ++s2) { const bf16x8 bs = pack_step(S[kt], s2); const int cb0 = (32 * kt + 16 * s2 + 4 * hi) * 2;
#pragma unroll
                for (int rb = 0; rb < 2; ++rb) { const int l = 32 * rb + r32;
                    const s16x4 a0 = *(const GLA_LAS s16x4*)(QT + swz256(l, cb0)), a1 = *(const GLA_LAS s16x4*)(QT + swz256(l, cb0 + 16));
                    const bf16x8 a = {a0[0], a0[1], a0[2], a0[3], a1[0], a1[1], a1[2], a1[3]}; o[rb] = GLA_MFMA(a, bs, o[rb]); } }
        bf16x8 vf[4];
        { const s16x4 l0 = tr_read<0 * 8192>(vb), h0 = tr_read<0 * 8192 + 4096>(vb), l1 = tr_read<1 * 8192>(vb), h1 = tr_read<1 * 8192 + 4096>(vb);
          const s16x4 l2 = tr_read<2 * 8192>(vb), h2 = tr_read<2 * 8192 + 4096>(vb), l3 = tr_read<3 * 8192>(vb), h3 = tr_read<3 * 8192 + 4096>(vb);
          asm volatile("s_waitcnt lgkmcnt(0)" ::: "memory"); __builtin_amdgcn_sched_barrier(0);
          vf[0] = (bf16x8){l0[0], l0[1], l0[2], l0[3], h0[0], h0[1], h0[2], h0[3]}; vf[1] = (bf16x8){l1[0], l1[1], l1[2], l1[3], h1[0], h1[1], h1[2], h1[3]};
          vf[2] = (bf16x8){l2[0], l2[1], l2[2], l2[3], h2[0], h2[1], h2[2], h2[3]}; vf[3] = (bf16x8){l3[0], l3[1], l3[2], l3[3], h3[0], h3[1], h3[2], h3[3]}; }
#pragma unroll
        for (int rb = 0; rb < 2; ++rb)
#pragma unroll
            for (int ks = 0; ks < 4; ++ks) { const bf16x8 a = *(const GLA_LAS bf16x8*)(PI + swz128(32 * rb + r32, (16 * ks + 8 * hi) * 2)); o[rb] = GLA_MFMA(a, vf[ks], o[rb]); }
        if (is_lat) {
#pragma unroll
            for (int rb = 0; rb < 2; ++rb)
#pragma unroll
                for (int r = 0; r < 16; ++r) O[(row0 + 32 * rb + crow(r, hi)) * 1024 + h * 256 + 32 * wid + r32] = bf1f(o[rb][r]); }
#pragma unroll
        for (int kt = 0; kt < 4; ++kt) {
#pragma unroll
            for (int ks = 0; ks < 4; ++ks) { const bf16x8 a = *(const GLA_LAS bf16x8*)(KH + swz128(32 * kt + r32, (16 * ks + 8 * hi) * 2)); S[kt] = GLA_MFMA(a, vf[ks], S[kt]); }
#pragma unroll
            for (int r = 0; r < 16; ++r) S[kt][r] *= EL[32 * kt + crow(r, hi)]; }
        __syncthreads();
    }
#undef GLA_FETCH
#undef GLA_CS
}
__device__ __forceinline__ int v_st4(int k, int c) { const int kk = (k & ~0xC) | ((k & 4) << 1) | ((k & 8) >> 1); return ((kk >> 3) * 4 + (c >> 5)) * 512 + ((kk & 7) * 32 + (c & 31)) * 2; }
constexpr int OFF_XO_A = OFF_KT, OFF_XO_B = OFF_V + 16384;
static_assert(OFF_XO_A + 16384 <= OFF_KH && OFF_XO_B + 16384 <= OFF_P, "gla chain2 lds map");
__device__ __forceinline__ void gla_chain2(const unsigned short* VR_, const unsigned short* TQ_, const unsigned short* TK_, const unsigned short* TP_, const float* EL_, unsigned short* O_, int b, int h, int dir, int vh,
                                           int ML_, int SEQ_, int CTX_, GLA_LAS unsigned char* lds) {
    const GLA_GAS unsigned short* VR = (const GLA_GAS unsigned short*)VR_; GLA_GAS unsigned short* O = (GLA_GAS unsigned short*)O_;
    const int tid = threadIdx.x, wid = __builtin_amdgcn_readfirstlane(tid >> 6), lane = tid & 63, r32 = lane & 31, hi = lane >> 5;
    const int vt = wid & 3, kh = wid >> 2;
    GLA_LAS unsigned char* QT = lds + OFF_QT; GLA_LAS unsigned char* KH = lds + OFF_KH; GLA_LAS unsigned char* VI = lds + OFF_V; GLA_LAS unsigned char* PI = lds + OFF_P; GLA_LAS float* EL = (GLA_LAS float*)(lds + OFF_EL);
    GLA_LAS f32x4* XOs = (GLA_LAS f32x4*)(lds + (wid < 4 ? OFF_XO_A + wid * 4096 : OFF_XO_B + (wid - 4) * 4096));
    GLA_LAS f32x4* XOr = (GLA_LAS f32x4*)(lds + ((wid ^ 4) < 4 ? OFF_XO_A + (wid ^ 4) * 4096 : OFF_XO_B + ((wid ^ 4) - 4) * 4096));
    f32x16 S[2] = {f32x16{}, f32x16{}};
    const int vb = (int)(unsigned)(uintptr_t)VI + v_rd_base(lane) + vt * 512;
    const int nchunk = (CTX_ + SEQ_) / 64, nctx = CTX_ / 64;
    const size_t tile0 = (size_t)((b * 4 + h) * 2 + dir) * 36;
    u32x4 pq[2], pk[2], pp, pv[2]; float pe = 0.f;
#define GLA_CS(sc_) ((dir == 0) ? (sc_) : (((sc_) < nctx) ? (nctx - 1 - (sc_)) : (nchunk - 1 - ((sc_) - nctx))))
#define GLA_FETCH(sc_) do { const int cs_ = GLA_CS(sc_); const size_t t_ = tile0 + cs_; const long r0_ = (cs_ < nctx) ? (long)ML_ + (long)b * CTX_ + 64 * cs_ : (long)b * SEQ_ + 64 * (cs_ - nctx); \
        const GLA_GAS u32x4* q_ = (const GLA_GAS u32x4*)((const GLA_GAS unsigned short*)TQ_ + t_ * 8192); const GLA_GAS u32x4* k_ = (const GLA_GAS u32x4*)((const GLA_GAS unsigned short*)TK_ + t_ * 8192); \
        pq[0] = q_[tid]; pq[1] = q_[tid + 512]; pk[0] = k_[tid]; pk[1] = k_[tid + 512]; pp = ((const GLA_GAS u32x4*)((const GLA_GAS unsigned short*)TP_ + t_ * 4096))[tid]; \
        if (tid < 128) pe = ((const GLA_GAS float*)EL_)[t_ * 128 + tid]; \
        _Pragma("unroll") for (int i_ = 0; i_ < 2; ++i_) { const int c_ = tid + 512 * i_; pv[i_] = *(const GLA_GAS u32x4*)(VR + (r0_ + (c_ >> 4)) * 2304 + h * 256 + vh * 128 + (c_ & 15) * 8); } } while (0)
    GLA_FETCH(0);
    for (int sc = 0; sc < nchunk; ++sc) {
        const int cs = GLA_CS(sc); const bool is_lat = cs >= nctx; const long row0 = is_lat ? (long)b * SEQ_ + 64 * (cs - nctx) : (long)ML_ + (long)b * CTX_ + 64 * cs;
#pragma unroll
        for (int i = 0; i < 2; ++i) { const int c = tid + 512 * i; *(GLA_LAS u32x4*)(QT + (c >> 4) * RS256 + (c & 15) * 16) = pq[i]; *(GLA_LAS u32x4*)(KH + (c >> 3) * RS128 + (c & 7) * 16) = pk[i];
            *(GLA_LAS u32x4*)(VI + v_st4(c >> 4, (c & 15) * 8)) = pv[i]; }
        *(GLA_LAS u32x4*)(PI + (tid >> 3) * RS128 + (tid & 7) * 16) = pp;
        if (tid < 128) EL[tid] = pe;
        __syncthreads();
        if (sc + 1 < nchunk) GLA_FETCH(sc + 1);
        f32x16 op[2] = {f32x16{}, f32x16{}};
#pragma unroll
        for (int j = 0; j < 2; ++j)
#pragma unroll
            for (int s2 = 0; s2 < 2; ++s2) { const bf16x8 bs = pack_step(S[j], s2); const int cb0 = (32 * (2 * kh + j) + 16 * s2 + 4 * hi) * 2;
#pragma unroll
                for (int rb = 0; rb < 2; ++rb) { const int l = 32 * rb + r32;
                    const s16x4 a0 = *(const GLA_LAS s16x4*)(QT + swz256(l, cb0)), a1 = *(const GLA_LAS s16x4*)(QT + swz256(l, cb0 + 16));
                    const bf16x8 a = {a0[0], a0[1], a0[2], a0[3], a1[0], a1[1], a1[2], a1[3]}; op[rb] = GLA_MFMA(a, bs, op[rb]); } }
        { const f32x16& snd = kh ? op[0] : op[1];
#pragma unroll
          for (int g = 0; g < 4; ++g) XOs[g * 64 + lane] = (f32x4){snd[4 * g], snd[4 * g + 1], snd[4 * g + 2], snd[4 * g + 3]}; }
        __syncthreads();
        f32x16 o = kh ? op[1] : op[0];
#pragma unroll
        for (int g = 0; g < 4; ++g) { const f32x4 rv = XOr[g * 64 + lane]; o[4 * g] += rv.x; o[4 * g + 1] += rv.y; o[4 * g + 2] += rv.z; o[4 * g + 3] += rv.w; }
        bf16x8 vf[4];
        { const s16x4 l0 = tr_read<0 * 4096>(vb), h0 = tr_read<0 * 4096 + 2048>(vb), l1 = tr_read<1 * 4096>(vb), h1 = tr_read<1 * 4096 + 2048>(vb);
          const s16x4 l2 = tr_read<2 * 4096>(vb), h2 = tr_read<2 * 4096 + 2048>(vb), l3 = tr_read<3 * 4096>(vb), h3 = tr_read<3 * 4096 + 2048>(vb);
          asm volatile("s_waitcnt lgkmcnt(0)" ::: "memory"); __builtin_amdgcn_sched_barrier(0);
          vf[0] = (bf16x8){l0[0], l0[1], l0[2], l0[3], h0[0], h0[1], h0[2], h0[3]}; vf[1] = (bf16x8){l1[0], l1[1], l1[2], l1[3], h1[0], h1[1], h1[2], h1[3]};
          vf[2] = (bf16x8){l2[0], l2[1], l2[2], l2[3], h2[0], h2[1], h2[2], h2[3]}; vf[3] = (bf16x8){l3[0], l3[1], l3[2], l3[3], h3[0], h3[1], h3[2], h3[3]}; }
#pragma unroll
        for (int ks = 0; ks < 4; ++ks) { const bf16x8 a = *(const GLA_LAS bf16x8*)(PI + swz128(32 * kh + r32, (16 * ks + 8 * hi) * 2)); o = GLA_MFMA(a, vf[ks], o); }
        if (is_lat) {
#pragma unroll
            for (int r = 0; r < 16; ++r) O[(row0 + 32 * kh + crow(r, hi)) * 1024 + h * 256 + vh * 128 + 32 * vt + r32] = bf1f(o[r]); }
#pragma unroll
        for (int j = 0; j < 2; ++j) { const int kt = 2 * kh + j;
#pragma unroll
            for (int ks = 0; ks < 4; ++ks) { const bf16x8 a = *(const GLA_LAS bf16x8*)(KH + swz128(32 * kt + r32, (16 * ks + 8 * hi) * 2)); S[j] = GLA_MFMA(a, vf[ks], S[j]); }
#pragma unroll
            for (int r = 0; r < 16; ++r) S[j][r] *= EL[32 * kt + crow(r, hi)]; }
        __syncthreads();
    }
#undef GLA_FETCH
#undef GLA_CS
}
#undef GLA_MFMA
}

constexpr int NWAVES = 8;
constexpr int D = 1024, NB = 16, SEQ = 2048, CTXL = 256, TT = SEQ + CTXL;
constexpr int ML = NB * SEQ, MC = NB * CTXL, MA = ML + MC;
constexpr float EPS = 1e-6f;
constexpr int S5W = 512, S5G = 32, S5H = 16, S5P = 64;
constexpr int NH = 8, NOPE = 64, ROPE = 32, QK = 96, VD = 64, QRANK = 256, KVRANK = 128;
constexpr int EV_IN = 928, EV_INP = 1024, NQKV = 1792, KQKV = 384;
constexpr int GH = 4, GDK = 128, GDV = 256, GKEY = 512, GVAL = 1024, GRANK = 16;
constexpr int OD_IN = 3104, OD_INP = 3328;
constexpr int FFN = 2816, NE = 8, FE = 3584;
constexpr int MOE_MAXT = 264;

constexpr size_t MiB = 1u << 20;
constexpr size_t WS_CTL = 0, CTL_ZERO_BYTES = 1 * MiB;
constexpr size_t WS_MODV = 1 * MiB;
constexpr size_t WS_TOK = 2 * MiB;
constexpr size_t WS_INV = 3 * MiB;
constexpr size_t WS_W_IN1 = 4 * MiB, WS_W_OUT1 = 11 * MiB, WS_W_MGU = 13 * MiB  , WS_W_MDN = 69 * MiB  ;
constexpr size_t WS_W_IN0 = 97 * MiB, WS_W_QKV = 99 * MiB, WS_W_GLU = 100 * MiB + 512 * 1024, WS_W_OUT0 = 101 * MiB, WS_W_GU = 103 * MiB, WS_W_DN = 114 * MiB, WS_HC = 120 * MiB;
constexpr size_t PB = 136 * MiB;
constexpr size_t WS_XL = PB + 0 * MiB, WS_Q = PB + 0 * MiB, WS_A3 = PB + 72 * MiB, WS_YL = PB + 72 * MiB, WS_KV = PB + 144 * MiB, WS_Z0C = PB + 144 * MiB, WS_U = PB + 180 * MiB, WS_DS = PB + 216 * MiB, WS_AO = PB + 216 * MiB,
                 WS_QA = PB + 288 * MiB, WS_AG = PB + 288 * MiB, WS_KR = PB + 324 * MiB, WS_B1 = PB + 328 * MiB, WS_B3 = PB + 332 * MiB;
constexpr size_t WS_ACT = PB + 72 * MiB, WS_FL = PB + 270 * MiB;
constexpr size_t WS_TP = 97 * MiB, WS_EL = 133 * MiB, WS_OF = PB, WS_VR = 208 * MiB, WS_QK = 370 * MiB, WS_OB = 370 * MiB, WS_YL1 = 370 * MiB, WS_TQ = 442 * MiB, WS_TK = 514 * MiB;
constexpr int VRLD = 2304;
constexpr int GLA_TILES = NB * GH * 2 * 36;
constexpr int MOE_W_ITEMS = NE * (2 * (D / 64) * (FE / 32) + (FE / 64) * (D / 32));
constexpr int MW0 = 0, MW1 = (MOE_W_ITEMS * 20) / 100, MW2 = (MOE_W_ITEMS * 40) / 100, MW3 = (MOE_W_ITEMS * 54) / 100, MW4 = (MOE_W_ITEMS * 82) / 100, MW5 = MOE_W_ITEMS;
constexpr size_t WS_XLM = PB + 0 * MiB, WS_Y = PB + 0 * MiB, WS_XG = PB + 132 * MiB, WS_ACTM = PB + 198 * MiB;
constexpr size_t WS_END = 588 * MiB;
static_assert(WS_KR + (size_t)MA * 32 * 2 <= WS_B1 && WS_KV + (size_t)MA * 1024 * 2 <= WS_DS && WS_AG + (size_t)MA * 512 * 2 <= WS_KR && WS_AO + (size_t)MA * D * 2 <= WS_AG && WS_A3 + (size_t)MA * 1024 * 2 <= WS_KV &&
              WS_Z0C + (size_t)MA * 512 * 2 <= WS_U && WS_U + (size_t)MA * 512 * 2 <= WS_DS && WS_DS + (size_t)MA * 512 * 4 <= WS_QA && WS_QA + (size_t)MA * KQKV * 2 <= WS_KR && WS_B1 + (size_t)32 * 256 * 256 * 2 <= WS_B3 && WS_B3 + (size_t)32 * 256 * 512 * 2 <= WS_END, "ws map");
static_assert(WS_FL + (size_t)MA * D * 2 <= WS_END && WS_ACT + (size_t)MA * FFN * 2 <= WS_FL, "ws map 2");
static_assert(WS_TP + (size_t)GLA_TILES * 8192 <= WS_EL && WS_EL + (size_t)GLA_TILES * 512 <= PB && WS_XL + (size_t)MA * D * 2 <= WS_VR && WS_VR + (size_t)MA * VRLD * 2 <= WS_QK && WS_QK + (size_t)MA * 1024 * 2 <= WS_TQ &&
              WS_TQ + (size_t)GLA_TILES * 16384 <= WS_TK && WS_TK + (size_t)GLA_TILES * 16384 <= WS_END && WS_OF + (size_t)ML * D * 2 <= WS_VR && WS_OB + (size_t)ML * D * 2 <= WS_TQ, "ws map layer 1");
static_assert(WS_Y + (size_t)MOE_MAXT * 256 * D * 2 <= WS_XG && WS_XG + (size_t)MOE_MAXT * 256 * D <= WS_ACTM && WS_ACTM + (size_t)MOE_MAXT * 256 * FE <= WS_END && WS_XLM + (size_t)ML * D <= WS_XG, "ws map 3");
static_assert(WS_W_IN1 + (size_t)OD_INP * D * 2 <= WS_W_OUT1 && WS_W_OUT1 + (size_t)D * D * 2 <= WS_W_MGU && WS_W_MGU + (size_t)NE * 2 * FE * D <= WS_W_MDN && WS_W_MDN + (size_t)NE * D * FE <= WS_W_IN0 &&
              WS_W_GU + (size_t)2 * FFN * D * 2 <= WS_W_DN && WS_W_DN + (size_t)D * FFN * 2 <= WS_HC && WS_HC + (size_t)MC * D * 4 <= PB, "ws map 4");
#ifndef FFN0_FP8
#define FFN0_FP8 0
#endif
constexpr bool FFN0_IS_FP8 = FFN0_FP8;
#ifndef FFN0_DOWN_FP8
#define FFN0_DOWN_FP8 1
#endif
constexpr bool FFN0_DN_FP8 = FFN0_DOWN_FP8;
constexpr float FP8_SA = 8.0f, FP8_SW = 128.0f, FP8_SACT = 4.0f;

constexpr int CW_TMO = 0, CW_CODE = 1, CW_CNT = 64, CW_BAR = 4096;

constexpr int RING_OFF = 0, RING_BYTES = 131072;
constexpr int ATAB_OFF = RING_BYTES + 1024, ATAB_UNITS = 29;
constexpr int LDSCTL_OFF = RING_BYTES, MISC_OFF = LDSCTL_OFF + 320;
constexpr int LDS_BYTES = 147456;
static_assert(ATAB_OFF + ATAB_UNITS * 512 <= LDS_BYTES, "LDS map: row table");

struct Args { const float* in[35]; float* out; unsigned char* ws; int ph_lo, ph_hi; };
struct Frame { LAS unsigned char* lds; volatile LAS unsigned* MISC; gu32* ctl; int tid, lane, wave, G, gw, ngw; };

__device__ __forceinline__ float wave_sum(float v) {
#pragma unroll
    for (int o = 1; o < 64; o <<= 1) v += __shfl_xor(v, o);
    return v;
}
__device__ __forceinline__ float bf_lo(unsigned u) { return __uint_as_float(u << 16); }
__device__ __forceinline__ float bf_hi(unsigned u) { return __uint_as_float(u & 0xffff0000u); }
__device__ __forceinline__ float bf1(bf16 u) { return __uint_as_float(((unsigned)u) << 16); }
typedef unsigned v2u __attribute__((ext_vector_type(2)));
__device__ __forceinline__ unsigned pk4_fp8(float a, float b, float c, float d) { return pg8::pk4_fp8(a, b, c, d); }

__device__ __forceinline__ void ld_row_f32(const float* p, int lane, f32x4 (&v)[4]) {
    const GAS f32x4* q = (const GAS f32x4*)p + lane;
#pragma unroll
    for (int j = 0; j < 4; ++j) v[j] = q[64 * j];
}
__device__ __forceinline__ void st_row_f32(float* p, int lane, const f32x4 (&v)[4]) {
    GAS f32x4* q = (GAS f32x4*)p + lane;
#pragma unroll
    for (int j = 0; j < 4; ++j) q[64 * j] = v[j];
}
__device__ __forceinline__ void ld_row_bf16(const bf16* p, int lane, f32x4 (&v)[4]) {
    const GAS v2u* q = (const GAS v2u*)p + lane;
#pragma unroll
    for (int j = 0; j < 4; ++j) { const v2u w = q[64 * j]; v[j] = (f32x4){bf_lo(w.x), bf_hi(w.x), bf_lo(w.y), bf_hi(w.y)}; }
}
__device__ __forceinline__ void st_row_bf16(bf16* p, int lane, const f32x4 (&v)[4]) {
    GAS v2u* q = (GAS v2u*)p + lane;
#pragma unroll
    for (int j = 0; j < 4; ++j) { v2u w; w.x = pk2(v[j].x, v[j].y); w.y = pk2(v[j].z, v[j].w); q[64 * j] = w; }
}
__device__ __forceinline__ void st_row_fp8(unsigned char* p, int lane, const f32x4 (&v)[4], float sc) {
    GAS unsigned* q = (GAS unsigned*)p + lane;
#pragma unroll
    for (int j = 0; j < 4; ++j) q[64 * j] = pk4_fp8(v[j].x * sc, v[j].y * sc, v[j].z * sc, v[j].w * sc);
}
__device__ __forceinline__ float row_rs(const f32x4 (&v)[4]) {
    float s = 0.f;
#pragma unroll
    for (int j = 0; j < 4; ++j) s += (v[j].x * v[j].x + v[j].y * v[j].y) + (v[j].z * v[j].z + v[j].w * v[j].w);
    return rsqrtf(wave_sum(s) * (1.0f / D) + EPS);
}
__device__ __forceinline__ void norm_mod(f32x4 (&v)[4], const float* gam, const float* sh, const float* sc, int lane) {
    const float rs = row_rs(v); f32x4 g[4], a[4], b[4]; ld_row_f32(gam, lane, g); ld_row_f32(sh, lane, a); ld_row_f32(sc, lane, b);
#pragma unroll
    for (int j = 0; j < 4; ++j) v[j] = (v[j] * rs) * g[j] * (1.0f + b[j]) + a[j];
}
__device__ __forceinline__ void gated_add(f32x4 (&h)[4], const f32x4 (&y)[4], const float* gam, const float* gate, int lane) {
    const float rs = row_rs(y); f32x4 g[4], t[4]; ld_row_f32(gam, lane, g); ld_row_f32(gate, lane, t);
#pragma unroll
    for (int j = 0; j < 4; ++j) h[j] = h[j] + t[j] * ((y[j] * rs) * g[j]);
}

__device__ __forceinline__ void cvt_item(const float* W, int K, int N, bf16* WT, int ldk, int kcol0, int row_off, int mode, const float* gain, float scale, int nscale,
                                         LAS float* scr, int item, int lane, bool fp8 = false, bool tiled = false) {
    const int nblk = N / 32, kb = item / nblk, nb = item % nblk, k0 = 64 * kb, n0 = 32 * nb;
    { f32x4 t[8];
#pragma unroll
      for (int i = 0; i < 8; ++i) t[i] = *(const GAS f32x4*)(W + (size_t)(k0 + 8 * i + (lane >> 3)) * N + n0 + 4 * (lane & 7));
#pragma unroll
      for (int i = 0; i < 8; ++i) { LAS float* d = scr + (8 * i + (lane >> 3)) * 33 + 4 * (lane & 7); d[0] = t[i].x; d[1] = t[i].y; d[2] = t[i].z; d[3] = t[i].w; } }
    LDS_WAIT(); asm volatile("" ::: "memory");
    const int c = lane & 7;
    float gn[8];
#pragma unroll
    for (int q = 0; q < 8; ++q) gn[q] = (gain ? gain[k0 + 8 * c + q] : 1.0f) * ((n0 < nscale) ? scale : 1.0f);
    const int drow0 = (mode == 0) ? n0 : (mode == 3) ? ((n0 >> 7) * 64 + (n0 & 63) + ((n0 & 64) ? 512 : 0)) : ((n0 >> 7) * 256 + (n0 & 127) + (mode == 2 ? 128 : 0));
#pragma unroll
    for (int j = 0; j < 4; ++j) { const int n = (lane >> 3) + 8 * j; const LAS float* s = scr + (8 * c) * 33 + n;
        if (fp8) { v2u o; o.x = pk4_fp8(s[0 * 33] * gn[0], s[1 * 33] * gn[1], s[2 * 33] * gn[2], s[3 * 33] * gn[3]); o.y = pk4_fp8(s[4 * 33] * gn[4], s[5 * 33] * gn[5], s[6 * 33] * gn[6], s[7 * 33] * gn[7]);
            const int drow = row_off + drow0 + n, kc = kcol0 + k0 + 8 * c;
            unsigned char* dp = tiled ? (unsigned char*)WT + (size_t)(drow >> 8) * 256 * ldk + (size_t)(kc >> 7) * 32768 + (drow & 255) * 128 + (kc & 127) : (unsigned char*)WT + (size_t)drow * ldk + kc;
            *(GAS v2u*)dp = o; }
        else { v4u o; o.x = pk2(s[0 * 33] * gn[0], s[1 * 33] * gn[1]); o.y = pk2(s[2 * 33] * gn[2], s[3 * 33] * gn[3]); o.z = pk2(s[4 * 33] * gn[4], s[5 * 33] * gn[5]); o.w = pk2(s[6 * 33] * gn[6], s[7 * 33] * gn[7]);
            *(GAS v4u*)(WT + (size_t)(row_off + drow0 + n) * ldk + kcol0 + k0 + 8 * c) = o; } }
    LDS_WAIT(); asm volatile("" ::: "memory");
}
__device__ __forceinline__ void moe_weights(Frame& F, const Args& A, int it_lo, int it_hi, int widx, int nw) {
    LAS float* scr = (LAS float*)(F.lds + RING_OFF + F.wave * 16384);
    unsigned char* ws = A.ws;
    constexpr int I_MG1 = (D / 64) * (FE / 32), I_MD1 = (FE / 64) * (D / 32);
    for (int it = it_lo + widx; it < it_hi; it += nw) {
        int r = it;
        if (r < NE * I_MG1) { const int e = r / I_MG1; cvt_item(A.in[32] + (size_t)e * D * FE, D, FE, (bf16*)(ws + WS_W_MGU + (size_t)e * 2 * FE * D), D, 0, 0, 1, nullptr, FP8_SW, 1 << 30, scr, r % I_MG1, F.lane, true); continue; } r -= NE * I_MG1;
        if (r < NE * I_MG1) { const int e = r / I_MG1; cvt_item(A.in[33] + (size_t)e * D * FE, D, FE, (bf16*)(ws + WS_W_MGU + (size_t)e * 2 * FE * D), D, 0, 0, 2, nullptr, FP8_SW, 1 << 30, scr, r % I_MG1, F.lane, true); continue; } r -= NE * I_MG1;
        { const int e = r / I_MD1; cvt_item(A.in[34] + (size_t)e * FE * D, FE, D, (bf16*)(ws + WS_W_MDN + (size_t)e * D * FE), FE, 0, 0, 0, nullptr, FP8_SW, 1 << 30, scr, r % I_MD1, F.lane, true, true); }
    }
}
__device__ __forceinline__ void tail_convert(Frame& F, const Args& A, int nunit, int lo, int hi) {
    const int nlast = nunit % F.G, bid = (int)blockIdx.x;
    if (nlast != 0) { if (bid >= nlast) moe_weights(F, A, lo, hi, (bid - nlast) * NWAVES + F.wave, (F.G - nlast) * NWAVES); }
    else moe_weights(F, A, lo, hi, F.gw, F.ngw);
}
__device__ __forceinline__ void gen_s5(Frame& F, const Args& A, int g);
#ifndef PROBE_BLK
#define PROBE_BLK 0
#endif
#ifdef PROBE_SETA
#define PROBE_STAMP2(F, k) do { if (blockIdx.x == PROBE_BLK && F.tid == 0) { const unsigned long long t_ = __builtin_amdgcn_s_memrealtime(); const unsigned long long l_ = ((unsigned long long)F.MISC[17] << 32) | F.MISC[16]; const unsigned d_ = (unsigned)(t_ - l_); \
        if ((PROBE_SETA >> (k)) & 1ull) F.MISC[18] += d_; if ((PROBE_SETB >> (k)) & 1ull) F.MISC[20] += d_; F.MISC[16] = (unsigned)t_; F.MISC[17] = (unsigned)(t_ >> 32); } } while (0)
#else
#define PROBE_STAMP2(F, k) do { } while (0)
#endif
__device__ __forceinline__ void p0_prologue(Frame& F, const Args& A) {
    LAS float* scr = (LAS float*)(F.lds + RING_OFF + F.wave * 16384);
    unsigned char* ws = A.ws;
    constexpr int I_IN0 = (D / 64) * (EV_IN / 32), I_UQ = (QRANK / 64) * (768 / 32), I_UKV = (KVRANK / 64) * (1024 / 32), I_GLU = (512 / 64) * (512 / 32), I_OUT = (D / 64) * (D / 32);
    constexpr int I_FG = (D / 64) * (FFN / 32), I_FD = (FFN / 64) * (D / 32), I_IN1 = (D / 64) * (OD_IN / 32), I_MG1 = (D / 64) * (FE / 32), I_MD1 = (FE / 64) * (D / 32);
    constexpr int NITEMS = I_IN0 + I_UQ + I_UKV + I_GLU + I_OUT + 2 * I_FG + I_FD + I_IN1 + I_OUT;
    const bool s5_builder = (int)blockIdx.x >= F.G - S5G;
    for (int it = s5_builder ? NITEMS : F.gw; it < NITEMS; it += F.ngw - S5G * NWAVES) {
        int r = it;
        if (r < I_IN0) { cvt_item(A.in[7], D, EV_IN, (bf16*)(ws + WS_W_IN0), D, 0, 0, 0, nullptr, 1.f, 0, scr, r, F.lane); continue; } r -= I_IN0;
        if (r < I_UQ) { cvt_item(A.in[19], QRANK, 768, (bf16*)(ws + WS_W_QKV), KQKV, 0, 0, 0, A.in[18], 1.f, 0, scr, r, F.lane); continue; } r -= I_UQ;
        if (r < I_UKV) { cvt_item(A.in[21], KVRANK, 1024, (bf16*)(ws + WS_W_QKV), KQKV, QRANK, 768, 3, A.in[20], 1.f, 0, scr, r, F.lane); continue; } r -= I_UKV;
        if (r < I_GLU) { cvt_item(A.in[16], 512, 512, (bf16*)(ws + WS_W_GLU), 512, 0, 0, 0, nullptr, 1.f, 0, scr, r, F.lane); continue; } r -= I_GLU;
        if (r < I_OUT) { cvt_item(A.in[22], D, D, (bf16*)(ws + WS_W_OUT0), D, 0, 0, 0, nullptr, 1.f, 0, scr, r, F.lane); continue; } r -= I_OUT;
        if (r < I_FG) { cvt_item(A.in[23], D, FFN, (bf16*)(ws + WS_W_GU), D, 0, 0, 1, nullptr, FFN0_IS_FP8 ? FP8_SW : 1.f, 1 << 30, scr, r, F.lane, FFN0_IS_FP8); continue; } r -= I_FG;
        if (r < I_FG) { cvt_item(A.in[24], D, FFN, (bf16*)(ws + WS_W_GU), D, 0, 0, 2, nullptr, FFN0_IS_FP8 ? FP8_SW : 1.f, 1 << 30, scr, r, F.lane, FFN0_IS_FP8); continue; } r -= I_FG;
        if (r < I_FD) { cvt_item(A.in[25], FFN, D, (bf16*)(ws + WS_W_DN), FFN, 0, 0, 0, nullptr, (FFN0_IS_FP8 || FFN0_DN_FP8) ? FP8_SW : 1.f, 1 << 30, scr, r, F.lane, FFN0_IS_FP8 || FFN0_DN_FP8); continue; } r -= I_FD;
        if (r < I_IN1) { cvt_item(A.in[26], D, OD_IN, (bf16*)(ws + WS_W_IN1), D, 0, 0, 0, nullptr, 0.08838834764831845f, GKEY, scr, r, F.lane); continue; } r -= I_IN1;
        cvt_item(A.in[30], D, D, (bf16*)(ws + WS_W_OUT1), D, 0, 0, 0, nullptr, 1.f, 0, scr, r, F.lane);
    }
    { const v4u z = {0u, 0u, 0u, 0u}; const int gt = blockIdx.x * (NWAVES * 64) + F.tid, ngt = F.G * NWAVES * 64;
      GAS v4u* p0 = (GAS v4u*)((bf16*)(ws + WS_W_IN0) + (size_t)EV_IN * D); for (int i = gt; i < (EV_INP - EV_IN) * D / 8; i += ngt) p0[i] = z;
      for (int i = gt; i < 768 * (KVRANK / 8); i += ngt) { const int r = i / (KVRANK / 8), c = i % (KVRANK / 8); *(GAS v4u*)((bf16*)(ws + WS_W_QKV) + (size_t)r * KQKV + QRANK + 8 * c) = z; }
      for (int i = gt; i < 1024 * (QRANK / 8); i += ngt) { const int r = i / (QRANK / 8), c = i % (QRANK / 8); *(GAS v4u*)((bf16*)(ws + WS_W_QKV) + (size_t)(768 + r) * KQKV + 8 * c) = z; }
      GAS v4u* p1 = (GAS v4u*)((bf16*)(ws + WS_W_IN1) + (size_t)OD_IN * D); for (int i = gt; i < (OD_INP - OD_IN) * D / 8; i += ngt) p1[i] = z; }
    __syncthreads();
    PROBE_STAMP2(F, 22);
    LAS float* act = (LAS float*)(F.lds);
    LAS float* red = (LAS float*)(F.lds + 17 * 1024 * 4);
    float* modv = (float*)(ws + WS_MODV);
    bool have_act = false;
    for (int u = blockIdx.x; u < 2 * 96; u += F.G) {
        if (!have_act) {
            float xv[17 * 1024 / (NWAVES * 64)];
#pragma unroll
            for (int q = 0; q < 17 * 1024 / (NWAVES * 64); ++q) { const int i = F.tid + q * (NWAVES * 64); xv[q] = (i < 16 * 1024) ? A.in[1][i] : A.in[3][i - 16 * 1024]; }
#pragma unroll
            for (int q = 0; q < 17 * 1024 / (NWAVES * 64); ++q) { const float x = xv[q]; act[F.tid + q * (NWAVES * 64)] = x / (1.0f + __expf(-x)); }
            have_act = true;
        }
        __syncthreads();
        const int layer = u / 96, c0 = (u % 96) * 64;
        const float* mw = A.in[4] + (size_t)layer * D * 6144 + c0 + F.lane;
        float acc[17];
#pragma unroll
        for (int r = 0; r < 17; ++r) acc[r] = 0.f;
        for (int k0 = F.wave * 128; k0 < F.wave * 128 + 128; k0 += 32) { float w[32];
#pragma unroll
            for (int u2 = 0; u2 < 32; ++u2) w[u2] = mw[(size_t)(k0 + u2) * 6144];
#pragma unroll
            for (int u2 = 0; u2 < 32; ++u2)
#pragma unroll
                for (int r = 0; r < 17; ++r) acc[r] += act[r * 1024 + k0 + u2] * w[u2]; }
#pragma unroll
        for (int r = 0; r < 17; ++r) red[(F.wave * 17 + r) * 64 + F.lane] = acc[r];
        __syncthreads();
        for (int i = F.tid; i < 17 * 64; i += NWAVES * 64) { const int r = i >> 6, l = i & 63; float s = A.in[5][layer * 6144 + c0 + l];
#pragma unroll
            for (int w = 0; w < 8; ++w) s += red[(w * 17 + r) * 64 + l];
            modv[(size_t)(layer * 17 + r) * 6144 + c0 + l] = s; }
    }
    __syncthreads();
    PROBE_STAMP2(F, 23);
    for (int g = (int)blockIdx.x - (F.G - S5G); g >= 0 && g < S5G; g += F.G) gen_s5(F, A, g);
    PROBE_STAMP2(F, 24);
}

__device__ __forceinline__ void thin_t1(Frame& F, const Args& A) {
    const float* modv = (const float*)(A.ws + WS_MODV); bf16* XL = (bf16*)(A.ws + WS_XL); const float* gam = A.in[6];
    for (int r0 = F.gw; r0 < MA; r0 += 2 * F.ngw) {
        const int r1 = (r0 + F.ngw < MA) ? r0 + F.ngw : r0; const bool two = r1 != r0;
        const bool lat0 = r0 < ML, lat1 = r1 < ML; const float* src0 = lat0 ? A.in[0] + (size_t)r0 * D : A.in[2] + (size_t)(r0 - ML) * D; const float* src1 = lat1 ? A.in[0] + (size_t)r1 * D : A.in[2] + (size_t)(r1 - ML) * D;
        const float* mod0 = modv + (size_t)(lat0 ? r0 / SEQ : 16) * 6144; const float* mod1 = modv + (size_t)(lat1 ? r1 / SEQ : 16) * 6144;
        f32x4 v0[4], v1[4]; ld_row_f32(src0, F.lane, v0); ld_row_f32(src1, F.lane, v1);
        norm_mod(v0, gam, mod0, mod0 + D, F.lane); st_row_bf16(XL + (size_t)r0 * D, F.lane, v0);
        norm_mod(v1, gam, mod1, mod1 + D, F.lane); if (two) st_row_bf16(XL + (size_t)r1 * D, F.lane, v1);
    }
}
__device__ __forceinline__ void thin_t2(Frame& F, const Args& A) {
    const float* modv = (const float*)(A.ws + WS_MODV); bf16* XL = (bf16*)(A.ws + WS_XL); const bf16* YL = (const bf16*)(A.ws + WS_YL); float* HC = (float*)(A.ws + WS_HC); const float* gam = A.in[6];
    for (int r0 = F.gw; r0 < MA; r0 += 2 * F.ngw) {
        const int r1 = (r0 + F.ngw < MA) ? r0 + F.ngw : r0; const bool two = r1 != r0;
        const bool lat0 = r0 < ML, lat1 = r1 < ML;
        const float* src0 = lat0 ? A.in[0] + (size_t)r0 * D : A.in[2] + (size_t)(r0 - ML) * D; const float* src1 = lat1 ? A.in[0] + (size_t)r1 * D : A.in[2] + (size_t)(r1 - ML) * D;
        float* dst0 = lat0 ? A.out + (size_t)r0 * D : HC + (size_t)(r0 - ML) * D; float* dst1 = lat1 ? A.out + (size_t)r1 * D : HC + (size_t)(r1 - ML) * D;
        const float* mod0 = modv + (size_t)(lat0 ? r0 / SEQ : 16) * 6144; const float* mod1 = modv + (size_t)(lat1 ? r1 / SEQ : 16) * 6144;
        f32x4 h0[4], y0[4], h1[4], y1[4];
        ld_row_f32(src0, F.lane, h0); ld_row_bf16(YL + (size_t)r0 * D, F.lane, y0); ld_row_f32(src1, F.lane, h1); ld_row_bf16(YL + (size_t)r1 * D, F.lane, y1);
        gated_add(h0, y0, gam + 1 * D, mod0 + 2 * D, F.lane); gated_add(h1, y1, gam + 1 * D, mod1 + 2 * D, F.lane);
        st_row_f32(dst0, F.lane, h0); if (two) st_row_f32(dst1, F.lane, h1);
        norm_mod(h0, gam + 2 * D, mod0 + 3 * D, mod0 + 4 * D, F.lane); norm_mod(h1, gam + 2 * D, mod1 + 3 * D, mod1 + 4 * D, F.lane);
        if (FFN0_IS_FP8) { st_row_fp8((unsigned char*)XL + (size_t)r0 * D, F.lane, h0, FP8_SA); if (two) st_row_fp8((unsigned char*)XL + (size_t)r1 * D, F.lane, h1, FP8_SA); }
        else { st_row_bf16(XL + (size_t)r0 * D, F.lane, h0); if (two) st_row_bf16(XL + (size_t)r1 * D, F.lane, h1); }
    }
}
__device__ __forceinline__ void thin_t3(Frame& F, const Args& A) {
    const float* modv = (const float*)(A.ws + WS_MODV); bf16* XL = (bf16*)(A.ws + WS_XL); const bf16* FL = (const bf16*)(A.ws + WS_FL); const float* HC = (const float*)(A.ws + WS_HC); const float* gam = A.in[6];
    for (int r0 = F.gw; r0 < MA; r0 += 2 * F.ngw) {
        const int r1 = (r0 + F.ngw < MA) ? r0 + F.ngw : r0; const bool two = r1 != r0;
        const bool lat0 = r0 < ML, lat1 = r1 < ML;
        const float* src0 = lat0 ? A.out + (size_t)r0 * D : HC + (size_t)(r0 - ML) * D; const float* src1 = lat1 ? A.out + (size_t)r1 * D : HC + (size_t)(r1 - ML) * D;
        const int bs0 = lat0 ? r0 / SEQ : 16, bs1 = lat1 ? r1 / SEQ : 16;
        f32x4 h0[4], y0[4], h1[4], y1[4];
        ld_row_f32(src0, F.lane, h0); ld_row_bf16(FL + (size_t)r0 * D, F.lane, y0); ld_row_f32(src1, F.lane, h1); ld_row_bf16(FL + (size_t)r1 * D, F.lane, y1);
        gated_add(h0, y0, gam + 3 * D, modv + (size_t)bs0 * 6144 + 5 * D, F.lane); gated_add(h1, y1, gam + 3 * D, modv + (size_t)bs1 * 6144 + 5 * D, F.lane);
        if (lat0) st_row_f32(A.out + (size_t)r0 * D, F.lane, h0); if (two && lat1) st_row_f32(A.out + (size_t)r1 * D, F.lane, h1);
        { const float* m0 = modv + (size_t)(17 + bs0) * 6144; const float* m1 = modv + (size_t)(17 + bs1) * 6144;
          norm_mod(h0, gam + 4 * D, m0, m0 + D, F.lane); norm_mod(h1, gam + 4 * D, m1, m1 + D, F.lane); }
        st_row_bf16(XL + (size_t)r0 * D, F.lane, h0); if (two) st_row_bf16(XL + (size_t)r1 * D, F.lane, h1);
    }
}
__device__ __forceinline__ void thin_t4(Frame& F, const Args& A) {
    const float* modv = (const float*)(A.ws + WS_MODV); bf16* XL = (bf16*)(A.ws + WS_XLM); const bf16* YL = (const bf16*)(A.ws + WS_YL1); const float* gam = A.in[6] + 4 * D;
    const float* router = A.in[31]; unsigned* tok = (unsigned*)(A.ws + WS_TOK); unsigned short* inv = (unsigned short*)(A.ws + WS_INV);
    LAS float* rt = (LAS float*)(F.lds);
    LAS unsigned* wc = (LAS unsigned*)(F.lds + 32768);
    __syncthreads();
    for (int i = F.tid; i < 8 * 1024; i += NWAVES * 64) { const int e = i >> 10, c = i & 1023; rt[i] = router[(size_t)c * 8 + e]; }
    __syncthreads();
    for (int chunk = blockIdx.x; chunk < ML / 128; chunk += F.G) {
        const int row_base = chunk * 128 + F.wave * 16;
        int me0 = 0, me1 = 0; float mw0 = 0.f, mw1 = 0.f;
        for (int i = 0; i < 16; ++i) {
            const int r = row_base + i; const int bs = r / SEQ; const float* mod1 = modv + (size_t)(17 + bs) * 6144;
            f32x4 h[4], y[4]; ld_row_f32(A.out + (size_t)r * D, F.lane, h); ld_row_bf16(YL + (size_t)r * D, F.lane, y);
            gated_add(h, y, gam + 1 * D, mod1 + 2 * D, F.lane); st_row_f32(A.out + (size_t)r * D, F.lane, h);
            norm_mod(h, gam + 2 * D, mod1 + 3 * D, mod1 + 4 * D, F.lane); st_row_fp8((unsigned char*)XL + (size_t)r * D, F.lane, h, FP8_SA);
            float lg[8];
#pragma unroll
            for (int e = 0; e < 8; ++e) { float a = 0.f;
#pragma unroll
                for (int j = 0; j < 4; ++j) { const f32x4 w = *(const LAS f32x4*)(rt + e * 1024 + 256 * j + 4 * F.lane); a += (h[j].x * w.x + h[j].y * w.y) + (h[j].z * w.z + h[j].w * w.w); }
                lg[e] = a; }
            {
              const bool b5 = (F.lane & 32) != 0, b4 = (F.lane & 16) != 0, b3 = (F.lane & 8) != 0; float v4[4], v2[2];
#pragma unroll
              for (int i2 = 0; i2 < 4; ++i2) { const float keep = b5 ? lg[i2 + 4] : lg[i2], send = b5 ? lg[i2] : lg[i2 + 4]; v4[i2] = keep + __shfl_xor(send, 32); }
#pragma unroll
              for (int i2 = 0; i2 < 2; ++i2) { const float keep = b4 ? v4[i2 + 2] : v4[i2], send = b4 ? v4[i2] : v4[i2 + 2]; v2[i2] = keep + __shfl_xor(send, 16); }
              float v1 = (b3 ? v2[1] : v2[0]) + __shfl_xor(b3 ? v2[0] : v2[1], 8);
              v1 += __shfl_xor(v1, 1); v1 += __shfl_xor(v1, 2); v1 += __shfl_xor(v1, 4);
#pragma unroll
              for (int e = 0; e < 8; ++e) lg[e] = __builtin_bit_cast(float, __builtin_amdgcn_readlane(__builtin_bit_cast(int, v1), 8 * e)); }
            int e0 = 0; float v0 = lg[0];
#pragma unroll
            for (int e = 1; e < 8; ++e) if (lg[e] > v0) { v0 = lg[e]; e0 = e; }
            int e1 = (e0 + 1) & 7; float v1 = -3.0e38f;
#pragma unroll
            for (int e = 0; e < 8; ++e) if (e != e0 && lg[e] > v1) { v1 = lg[e]; e1 = e; }
            const float w1 = 1.0f / (1.0f + __expf(v0 - v1)), w0 = 1.0f - w1;
            if (F.lane == i) { me0 = e0; me1 = e1; mw0 = w0; mw1 = w1; }
        }
        unsigned long long m[8];
#pragma unroll
        for (int e = 0; e < 8; ++e) m[e] = __ballot(F.lane < 16 && (me0 == e || me1 == e));
        { unsigned c = 0;
#pragma unroll
          for (int e = 0; e < 8; ++e) c = (F.lane == e) ? (unsigned)__popcll(m[e]) : c;
          if (F.lane < 8) wc[F.wave * 8 + F.lane] = c; }
        __syncthreads();
        if (F.tid < 8) { unsigned tot = 0;
#pragma unroll
            for (int w = 0; w < 8; ++w) tot += wc[w * 8 + F.tid];
            unsigned run = __hip_atomic_fetch_add((unsigned*)(F.ctl + CW_CNT + F.tid), tot, __ATOMIC_RELAXED, __HIP_MEMORY_SCOPE_AGENT);
#pragma unroll
            for (int w = 0; w < 8; ++w) { const unsigned c = wc[w * 8 + F.tid]; wc[w * 8 + F.tid] = run; run += c; } }
        __syncthreads();
        if (F.lane < 16) { unsigned long long m0 = 0ull, m1 = 0ull;
#pragma unroll
            for (int e = 0; e < 8; ++e) { m0 = (me0 == e) ? m[e] : m0; m1 = (me1 == e) ? m[e] : m1; }
            const unsigned long long below = (1ull << F.lane) - 1ull;
            const unsigned i0 = wc[F.wave * 8 + me0] + (unsigned)__popcll(m0 & below), i1 = wc[F.wave * 8 + me1] + (unsigned)__popcll(m1 & below);
            unsigned* t = tok + (size_t)(row_base + F.lane) * 8; t[0] = (unsigned)me0; t[1] = (unsigned)me1; t[2] = i0; t[3] = i1; t[4] = __float_as_uint(mw0); t[5] = __float_as_uint(mw1);
            inv[(size_t)me0 * 32768 + i0] = (unsigned short)(row_base + F.lane); inv[(size_t)me1 * 32768 + i1] = (unsigned short)(row_base + F.lane); }
        __syncthreads();
    }
}
__device__ __forceinline__ void moe_tile_starts(Frame& F, int (&ts)[9]) {
    ts[0] = 0;
#pragma unroll
    for (int e = 0; e < 8; ++e) { const unsigned c = __hip_atomic_load((unsigned*)(F.ctl + CW_CNT + e), __ATOMIC_RELAXED, __HIP_MEMORY_SCOPE_AGENT); ts[e + 1] = ts[e] + (int)((c + 255u) >> 8); }
#pragma unroll
    for (int e = 0; e < 9; ++e) ts[e] = __builtin_amdgcn_readfirstlane(ts[e]);
}
template <class Sched> __device__ __forceinline__ void moe_row_table(Frame& F, const Args& A, const Sched& S, const int (&ts)[9]) {
    const unsigned short* inv = (const unsigned short*)(A.ws + WS_INV); LAS unsigned short* tab = (LAS unsigned short*)(F.lds + ATAB_OFF);
    __syncthreads();
    for (int i = 0; i < ATAB_UNITS; ++i) { pg8::Unit u; if (!S.next(i, u)) break;
        int e = 0;
#pragma unroll
        for (int q = 1; q < 8; ++q) e += (u.pm >= ts[q]) ? 1 : 0;
        int tse = 0;
#pragma unroll
        for (int q = 0; q < 8; ++q) tse = (e == q) ? ts[q] : tse;
        const unsigned cnt = __hip_atomic_load((unsigned*)(F.ctl + CW_CNT + e), __ATOMIC_RELAXED, __HIP_MEMORY_SCOPE_AGENT);
        if (F.tid < 256) { const unsigned r = (unsigned)(u.pm - tse) * 256u + (unsigned)F.tid; tab[i * 256 + F.tid] = (r < cnt) ? inv[(size_t)e * 32768 + r] : (unsigned short)0; } }
    __syncthreads();
}
__device__ __forceinline__ void thin_t5(Frame& F, const Args& A) {
    int ts[9]; moe_tile_starts(F, ts);
    const float* modv = (const float*)(A.ws + WS_MODV); const bf16* Y = (const bf16*)(A.ws + WS_Y); const float* gam = A.in[6] + 7 * D; const unsigned* tok = (const unsigned*)(A.ws + WS_TOK);
    for (int r = F.gw; r < ML; r += F.ngw) {
        const int bs = r / SEQ; const float* mod1 = modv + (size_t)(17 + bs) * 6144;
        const unsigned* t = tok + (size_t)r * 8; const float w0 = __uint_as_float(t[4]), w1 = __uint_as_float(t[5]); const int e0 = (int)t[0], e1 = (int)t[1]; int s0 = 0, s1 = 0;
#pragma unroll
        for (int e = 0; e < 8; ++e) { s0 = (e0 == e) ? ts[e] : s0; s1 = (e1 == e) ? ts[e] : s1; }
        const unsigned p0 = (unsigned)s0 * 256u + t[2], p1 = (unsigned)s1 * 256u + t[3];
        f32x4 h[4], y0[4], y1[4]; ld_row_f32(A.out + (size_t)r * D, F.lane, h); ld_row_bf16(Y + (size_t)p0 * D, F.lane, y0); ld_row_bf16(Y + (size_t)p1 * D, F.lane, y1);
#pragma unroll
        for (int j = 0; j < 4; ++j) y0[j] = y0[j] * w0 + y1[j] * w1;
        gated_add(h, y0, gam, mod1 + 5 * D, F.lane); st_row_f32(A.out + (size_t)r * D, F.lane, h);
    }
}

__device__ __forceinline__ float rope_inv(int f) { return exp2f(-(float)f * (13.287712379549449f / 8.0f)); }
__device__ __forceinline__ void prep_qa(Frame& F, const Args& A) {
    const bf16* Z0 = (const bf16*)(A.ws + WS_Z0C); bf16* QA = (bf16*)(A.ws + WS_QA); bf16* KR = (bf16*)(A.ws + WS_KR);
    for (int r = F.gw; r < MA; r += F.ngw) {
        const bf16* z = Z0 + (size_t)r * 512;
        const v2u cq = *((const GAS v2u*)(z) + F.lane); const unsigned ck = *((const GAS unsigned*)(z + 256) + F.lane);
        const float q0 = bf_lo(cq.x), q1 = bf_hi(cq.x), q2 = bf_lo(cq.y), q3 = bf_hi(cq.y), k0 = bf_lo(ck), k1 = bf_hi(ck);
        const float rq = rsqrtf(wave_sum((q0 * q0 + q1 * q1) + (q2 * q2 + q3 * q3)) * (1.0f / QRANK) + EPS);
        const float rk = rsqrtf(wave_sum(k0 * k0 + k1 * k1) * (1.0f / KVRANK) + EPS);
        v2u oq; oq.x = pk2(q0 * rq, q1 * rq); oq.y = pk2(q2 * rq, q3 * rq);
        *((GAS v2u*)(QA + (size_t)r * KQKV) + F.lane) = oq; *((GAS unsigned*)(QA + (size_t)r * KQKV + QRANK) + F.lane) = pk2(k0 * rk, k1 * rk);
        const int l = F.lane & 31; float v = bf1(z[384 + l]); const float pv = __shfl_xor(v, 8);
        if (r < ML) { const int t = r % SEQ; const float pos = (l < 16) ? (float)(t / 64) : (float)(t % 64); float sn, cs; sincosf(pos * rope_inv(l & 7), &sn, &cs);
            v = (l & 8) ? (v * cs + pv * sn) : (v * cs - pv * sn); }
        if (F.lane < 32) KR[(size_t)r * 32 + l] = (bf16)f2bf(v);
    }
}
__device__ __forceinline__ void rope_q(Frame& F, const Args& A) {
    bf16* Q = (bf16*)(A.ws + WS_Q);
    for (int r = F.gw; r < ML; r += F.ngw) {
        const int t = r % SEQ, hh = F.lane >> 3, sub = F.lane & 7; bf16* p = Q + (size_t)r * 768 + hh * QK + NOPE + sub;
        const float inv = rope_inv(sub); float sr, cr, sc, cc; sincosf((float)(t / 64) * inv, &sr, &cr); sincosf((float)(t % 64) * inv, &sc, &cc);
        const float x0 = bf1(p[0]), x1 = bf1(p[8]), x2 = bf1(p[16]), x3 = bf1(p[24]);
        p[0] = (bf16)f2bf(x0 * cr - x1 * sr); p[8] = (bf16)f2bf(x1 * cr + x0 * sr); p[16] = (bf16)f2bf(x2 * cc - x3 * sc); p[24] = (bf16)f2bf(x3 * cc + x2 * sc);
    }
}
__device__ __forceinline__ int scan_row(int b, int dir, int tau) {
    if (tau < CTXL) return ML + b * CTXL + (dir ? CTXL - 1 - tau : tau);
    const int t = tau - CTXL; return b * SEQ + (dir ? SEQ - 1 - t : t);
}
__device__ __forceinline__ float gelu_tanh(float x) { const float u = 0.7978845608028654f * (x + 0.044715f * x * x * x); const float e = __expf(2.0f * u); const float th = 1.0f - 2.0f / (e + 1.0f); return 0.5f * x * (1.0f + th); }
__device__ __forceinline__ void gen_s5(Frame& F, const Args& A, int g) {
    constexpr int CS = 65;
    LAS float* pw = (LAS float*)F.lds;
    LAS float* cc = pw + 2 * 64 * 17 * 2;
    LAS float* bb = cc + 2 * 16 * CS * 2;
    LAS float* KK = bb + 2 * 64 * 16 * 2;
    LAS float* LL = KK + 2 * 16 * 16 * 16;
    LAS float* DSK = LL + 128 * 4;
    bf16* B1g = (bf16*)(A.ws + WS_B1) + (size_t)g * 256 * 256; bf16* B3g = (bf16*)(A.ws + WS_B3) + (size_t)g * 256 * 512;
    __syncthreads();
    { float lr = 0.f, li = 0.f, dtr = 0.f, dk = 0.f, braw[4], biraw[4], craw[4], ciraw[4];
      if (F.tid < 128) { const int d = F.tid >> 6, p = F.tid & 63, ig = d * S5G + g, i = ig * S5P + p; lr = A.in[8][i]; li = A.in[9][i]; dtr = A.in[10][ig]; }
      if (F.tid < 16) dk = A.in[15][g * 16 + F.tid];
#pragma unroll
      for (int q = 0; q < 4; ++q) { const int idx = F.tid + q * (NWAVES * 64); { const int dp = idx >> 4, h = idx & 15, d = dp >> 6, p = dp & 63; const size_t i = (size_t)((d * S5G + g) * S5P + p); braw[q] = A.in[11][i * 16 + h]; biraw[q] = A.in[12][i * 16 + h]; }
        { const int d = idx >> 10, ho = (idx >> 6) & 15, p = idx & 63; const size_t ci = (size_t)((d * S5G + g) * 16 + ho) * S5P + p; craw[q] = A.in[13][ci]; ciraw[q] = A.in[14][ci]; } }
      if (F.tid < 128) { const float dt = expf(dtr); LL[F.tid * 4] = lr; LL[F.tid * 4 + 1] = li; LL[F.tid * 4 + 2] = lr * dt; LL[F.tid * 4 + 3] = li * dt; }
      if (F.tid < 16) DSK[F.tid] = dk;
#pragma unroll
      for (int q = 0; q < 4; ++q) { const int idx = F.tid + q * (NWAVES * 64); bb[idx * 2] = braw[q]; bb[idx * 2 + 1] = biraw[q];
        { const int d = idx >> 10, ho = (idx >> 6) & 15, p = idx & 63; cc[((d * 16 + ho) * CS + p) * 2] = craw[q]; cc[((d * 16 + ho) * CS + p) * 2 + 1] = ciraw[q]; } } }
    __syncthreads();
    for (int idx = F.tid; idx < 128 * 17; idx += NWAVES * 64) { const int dp = idx / 17, k = idx - dp * 17;
        const float mag = expf((float)k * LL[dp * 4 + 2]), ang = (float)k * LL[dp * 4 + 3]; pw[(dp * 17 + k) * 2] = mag * cosf(ang); pw[(dp * 17 + k) * 2 + 1] = mag * sinf(ang); }
    for (int idx = F.tid; idx < 128 * 16; idx += NWAVES * 64) { const int dp = idx >> 4;
        const float lr = LL[dp * 4], li = LL[dp * 4 + 1], lrdt = LL[dp * 4 + 2], lidt = LL[dp * 4 + 3];
        const float mag = expf(lrdt), ar = mag * cosf(lidt), ai = mag * sinf(lidt), den = lr * lr + li * li, nr = ar - 1.0f;
        const float cr = (nr * lr + ai * li) / den, ci = (ai * lr - nr * li) / den;
        const float br = bb[idx * 2], bi = bb[idx * 2 + 1]; bb[idx * 2] = cr * br - ci * bi; bb[idx * 2 + 1] = cr * bi + ci * br; }
    __syncthreads();
    { const int ho = F.tid & 15, k = (F.tid >> 4) & 15, d = F.tid >> 8;
      float acc[16];
#pragma unroll
      for (int hi = 0; hi < 16; ++hi) acc[hi] = 0.f;
      for (int p = 0; p < 64; ++p) { const float cr = cc[((d * 16 + ho) * CS + p) * 2], ci = cc[((d * 16 + ho) * CS + p) * 2 + 1], pr = pw[((d * 64 + p) * 17 + k) * 2], pi = pw[((d * 64 + p) * 17 + k) * 2 + 1];
          const float wr = cr * pr - ci * pi, wi = cr * pi + ci * pr; const LAS f32x4* bp = (const LAS f32x4*)(bb + (d * 64 + p) * 32);
#pragma unroll
          for (int q = 0; q < 8; ++q) { const f32x4 b4 = bp[q]; acc[2 * q] += wr * b4.x - wi * b4.y; acc[2 * q + 1] += wr * b4.z - wi * b4.w; } }
#pragma unroll
      for (int hi = 0; hi < 16; ++hi) KK[((d * 16 + k) * 16 + ho) * 16 + hi] = acc[hi]; }
    __syncthreads();
    for (int it = F.tid; it < 256 * 32; it += NWAVES * 64) { const int n = it >> 5, kk0 = (it & 31) * 8;
        float v3[8], v3b[8], v1[8];
        { const int j = n >> 4, ho = n & 15, i = kk0 >> 4, hi0 = kk0 & 15; const float dsk = DSK[ho];
#pragma unroll
          for (int e8 = 0; e8 < 8; ++e8) { const int hi = hi0 + e8; float val = 0.f;
            if (i <= j) val += KK[((0 * 16 + (j - i)) * 16 + ho) * 16 + hi];
            if (i >= j) val += KK[((1 * 16 + (i - j)) * 16 + ho) * 16 + hi];
            if (i == j && ho == hi) val += dsk;
            v3[e8] = val; }
          const int d = kk0 >> 7, reim = (kk0 >> 6) & 1, p0 = kk0 & 63, e = d ? (16 - j) : (j + 1);
#pragma unroll
          for (int e8 = 0; e8 < 8; ++e8) { const int p = p0 + e8;
            const float cr = cc[((d * 16 + ho) * CS + p) * 2], ci = cc[((d * 16 + ho) * CS + p) * 2 + 1], pr = pw[((d * 64 + p) * 17 + e) * 2], pi = pw[((d * 64 + p) * 17 + e) * 2 + 1];
            v3b[e8] = reim ? -(cr * pi + ci * pr) : (cr * pr - ci * pi); } }
        { const int d = n >> 7, reim = (n >> 6) & 1, p = n & 63, i = kk0 >> 4, hi0 = kk0 & 15, e = d ? i : (15 - i);
          const float pr = pw[((d * 64 + p) * 17 + e) * 2], pi = pw[((d * 64 + p) * 17 + e) * 2 + 1];
#pragma unroll
          for (int e8 = 0; e8 < 8; ++e8) { const int hi = hi0 + e8; const float br = bb[((d * 64 + p) * 16 + hi) * 2], bi = bb[((d * 64 + p) * 16 + hi) * 2 + 1];
            v1[e8] = reim ? (pr * bi + pi * br) : (pr * br - pi * bi); } }
        const v4u w3 = {pk2(v3[0], v3[1]), pk2(v3[2], v3[3]), pk2(v3[4], v3[5]), pk2(v3[6], v3[7])}, w3b = {pk2(v3b[0], v3b[1]), pk2(v3b[2], v3b[3]), pk2(v3b[4], v3b[5]), pk2(v3b[6], v3b[7])};
        const v4u w1 = {pk2(v1[0], v1[1]), pk2(v1[2], v1[3]), pk2(v1[4], v1[5]), pk2(v1[6], v1[7])};
        *(GAS v4u*)(B3g + (size_t)n * 512 + kk0) = w3; *(GAS v4u*)(B3g + (size_t)n * 512 + 256 + kk0) = w3b; *(GAS v4u*)(B1g + (size_t)n * 256 + kk0) = w1; }
    __syncthreads();
}
__device__ __forceinline__ void s5_scan(Frame& F, const Args& A) {
    if (F.wave < 4) {
        const float* DS = (const float*)(A.ws + WS_DS); bf16* A3 = (bf16*)(A.ws + WS_A3); const int p = F.lane;
        for (int task = blockIdx.x * 4 + F.wave; task < NB * S5G * 2; task += F.G * 4) {
            const int d = task & 1, g = (task >> 1) & 31, b = task >> 6, ig = d * S5G + g;
            const float lr = A.in[8][ig * S5P + p], li = A.in[9][ig * S5P + p], dt = expf(A.in[10][ig]);
            const float m16 = expf(16.0f * lr * dt), a16r = m16 * cosf(16.0f * li * dt), a16i = m16 * sinf(16.0f * li * dt);
            const float* ds = DS + (size_t)(g * 16 + b) * 144 * 256 + d * 128 + p; bf16* so = A3 + (size_t)(g * 16 + b) * 144 * 512 + 256 + d * 128 + p;
            float sr = 0.f, si = 0.f;
            for (int blk = 0; blk < 9; ++blk) {
                const int cbase = d ? (blk == 0 ? 15 : 143 - (blk - 1) * 16) : blk * 16, cstep = d ? -1 : 1;
                float xr[16], xi[16];
#pragma unroll
                for (int s = 0; s < 16; ++s) { const int c = cbase + cstep * s; xr[s] = ds[(size_t)c * 256]; xi[s] = ds[(size_t)c * 256 + 64]; }
#pragma unroll
                for (int s = 0; s < 16; ++s) { const int c = cbase + cstep * s; so[(size_t)c * 512] = (bf16)f2bf(sr); so[(size_t)c * 512 + 64] = (bf16)f2bf(si);
                    const float nsr = a16r * sr - a16i * si + xr[s], nsi = a16r * si + a16i * sr + xi[s]; sr = nsr; si = nsi; }
            }
        }
    }
}
__device__ __forceinline__ void attn_phase(Frame& F, const Args& A) {
    const bf16* Q = (const bf16*)(A.ws + WS_Q); const bf16* KV = (const bf16*)(A.ws + WS_KV); const bf16* KR = (const bf16*)(A.ws + WS_KR); bf16* AO = (bf16*)(A.ws + WS_AO);
    const int bid = (int)blockIdx.x; const int vcu = (F.G % 8 == 0) ? (bid % 8) * (F.G / 8) + bid / 8 : bid;
    for (int u = vcu; u < 1024 + 128; u += F.G) {
        int b, h, qrow0, NT;
        if (u < 1024) { const int bh = u >> 3; b = bh >> 3; h = bh & 7; qrow0 = b * SEQ + (u & 7) * 256; NT = TT / 64; }
        else { const int uu = u - 1024; b = uu >> 3; h = uu & 7; qrow0 = ML + b * CTXL; NT = CTXL / 64; }
        att::attn_unit(Q + (size_t)qrow0 * 768 + h * QK, KV + h * NOPE, KR, KV + 512 + h * VD, ML + b * CTXL, CTXL / 64, b * SEQ, NT, AO + (size_t)qrow0 * D + S5W + h * VD, F.lds, (u < 1024) ? (u & 7) * 256 : -1);
    }
}
__device__ __forceinline__ void gla_prep_phase(Frame& F, const Args& A) {
    for (int j = blockIdx.x; j < NB * GH * 2 * 2; j += F.G) { const int ch = j >> 1, b = ch >> 3, h = (ch >> 1) & 3, dir = ch & 1;
        gla::gla_prep((const bf16*)(A.ws + WS_QK), (const bf16*)(A.ws + WS_VR) + 2048, A.in[27], A.in[28], (bf16*)(A.ws + WS_TQ), (bf16*)(A.ws + WS_TK), (bf16*)(A.ws + WS_TP), (float*)(A.ws + WS_EL),
                      b, h, dir, 18 * (j & 1), 18 * (j & 1) + 18, ML, SEQ, CTXL, F.lds); }
}
__device__ __forceinline__ void gla_chain_phase(Frame& F, const Args& A) {
    const int bid = (int)blockIdx.x; const int vcu = (F.G % 8 == 0) ? (bid % 8) * (F.G / 8) + bid / 8 : bid;
    for (int u = vcu; u < NB * GH * 2 * 2; u += F.G) { const int ch = u >> 1, vh = u & 1, b = ch >> 3, h = (ch >> 1) & 3, dir = ch & 1;
        gla::gla_chain2((const bf16*)(A.ws + WS_VR), (const bf16*)(A.ws + WS_TQ), (const bf16*)(A.ws + WS_TK), (const bf16*)(A.ws + WS_TP), (const float*)(A.ws + WS_EL), (bf16*)(A.ws + (dir ? WS_OB : WS_OF)),
                        b, h, dir, vh, ML, SEQ, CTXL, F.lds); }
}
__device__ __forceinline__ void gla_finish(Frame& F, const Args& A) {
    bf16* OF = (bf16*)(A.ws + WS_OF); const bf16* OB = (const bf16*)(A.ws + WS_OB); const bf16* VR = (const bf16*)(A.ws + WS_VR); const float* hn = A.in[29];
    const f32x4 g = *(const GAS f32x4*)(hn + 4 * F.lane);
    for (int r0 = F.gw; r0 < ML; r0 += 2 * F.ngw) {
        const int r1 = (r0 + F.ngw < ML) ? r0 + F.ngw : r0; const bool two = r1 != r0;
        f32x4 a0[4], b0[4], x0[4], a1[4], b1[4], x1[4];
        ld_row_bf16(OF + (size_t)r0 * D, F.lane, a0); ld_row_bf16(OB + (size_t)r0 * D, F.lane, b0); ld_row_bf16(VR + (size_t)r0 * VRLD + GVAL, F.lane, x0);
        ld_row_bf16(OF + (size_t)r1 * D, F.lane, a1); ld_row_bf16(OB + (size_t)r1 * D, F.lane, b1); ld_row_bf16(VR + (size_t)r1 * VRLD + GVAL, F.lane, x1);
#pragma unroll
        for (int j = 0; j < 4; ++j) { const f32x4 o0 = a0[j] + b0[j], o1 = a1[j] + b1[j];
            const float s0 = wave_sum((o0.x * o0.x + o0.y * o0.y) + (o0.z * o0.z + o0.w * o0.w)), s1 = wave_sum((o1.x * o1.x + o1.y * o1.y) + (o1.z * o1.z + o1.w * o1.w));
            const float rs0 = rsqrtf(s0 * (1.0f / GDV) + EPS), rs1 = rsqrtf(s1 * (1.0f / GDV) + EPS);
#pragma unroll
            for (int i = 0; i < 4; ++i) { const float u0 = x0[j][i], u1 = x1[j][i];
                a0[j][i] = o0[i] * rs0 * g[i] * (u0 * __builtin_amdgcn_rcpf(1.0f + __expf(-u0))); a1[j][i] = o1[i] * rs1 * g[i] * (u1 * __builtin_amdgcn_rcpf(1.0f + __expf(-u1))); } }
        st_row_bf16(OF + (size_t)r0 * D, F.lane, a0); if (two) st_row_bf16(OF + (size_t)r1 * D, F.lane, a1);
    }
}

#ifndef MK_ONE_LAUNCH
#define MK_ONE_LAUNCH 1
#endif
constexpr int NPHASE = 21;
constexpr bool SP2 = true, ALIGN = true;

__global__ void __launch_bounds__(NWAVES * 64, 2) fwd_kernel(Args args) {
    extern __shared__ __attribute__((aligned(16))) unsigned char lds[];
    Frame F;
    F.lds = (LAS unsigned char*)lds;
    F.MISC = (volatile LAS unsigned*)(F.lds + MISC_OFF);
    F.tid = threadIdx.x; F.lane = F.tid & 63; F.wave = __builtin_amdgcn_readfirstlane(F.tid >> 6);
    F.G = gridDim.x; F.gw = blockIdx.x * NWAVES + F.wave; F.ngw = F.G * NWAVES;
    unsigned char* ws = args.ws;
    F.ctl = (gu32*)(ws + WS_CTL);
    for (int u = F.tid; u < (LDS_BYTES - LDSCTL_OFF) / 4; u += NWAVES * 64) ((LAS unsigned*)(F.lds + LDSCTL_OFF))[u] = 0u;
    __syncthreads();
    XcdBarrier bar; bar.bar = (unsigned*)(F.ctl + CW_BAR); bar.x = 0; bar.st = nullptr;
    if (MK_ONE_LAUNCH) bar = xcd_barrier_post((unsigned*)(F.ctl + CW_BAR), F.MISC + 8);
    const int lo = args.ph_lo, hi = args.ph_hi;
#define IN(k) (lo <= (k) && (k) < hi)
#ifdef PROBE_SETA
    if (blockIdx.x == PROBE_BLK && F.tid == 0) { const unsigned long long t_ = __builtin_amdgcn_s_memrealtime(); F.MISC[16] = (unsigned)t_; F.MISC[17] = (unsigned)(t_ >> 32); }
#define PROBE_STAMP(k) do { if (blockIdx.x == PROBE_BLK && F.tid == 0) { const unsigned long long t_ = __builtin_amdgcn_s_memrealtime(); const unsigned long long l_ = ((unsigned long long)F.MISC[17] << 32) | F.MISC[16]; const unsigned d_ = (unsigned)(t_ - l_); \
        if ((PROBE_SETA >> (k)) & 1ull) F.MISC[18] += d_; if ((PROBE_SETB >> (k)) & 1ull) F.MISC[20] += d_; F.MISC[16] = (unsigned)t_; F.MISC[17] = (unsigned)(t_ >> 32); } } while (0)
#else
#define PROBE_STAMP(k) do { } while (0)
#endif
#define SEAM(k) do { if (MK_ONE_LAUNCH && IN(k) && IN((k) + 1)) xcd_barrier(bar); PROBE_STAMP(k); } while (0)
    const int bid = (int)blockIdx.x;

    if (IN(0)) {
#ifndef NO_P0
 p0_prologue(F, args);
#endif
 } SEAM(0);
    if (IN(1)) { thin_t1(F, args); } SEAM(1);
    if (IN(2)) { pg8::Gemm g{(const bf16*)(ws + WS_XL), (const bf16*)(ws + WS_W_IN0), MA, EV_INP, D}; pg8::StaticOrder S; S.init(MA, EV_INP, F.G, bid);
        pg8::EpiIn0 E{(bf16*)(ws + WS_U), (bf16*)(ws + WS_A3), (bf16*)(ws + WS_Z0C)};
        pg8::gemm_phase<pg8::EpiIn0, pg8::StaticOrder, ALIGN, SP2>(F.lds + RING_OFF, g, S, E);
        tail_convert(F, args, (MA / 256) * (EV_INP / 256), MW0, MW1); } SEAM(2);
    if (IN(3)) { prep_qa(F, args);
        int k256 = 256; asm volatile("" : "+s"(k256));
        pg8::Gemm g{(const bf16*)(ws + WS_U), (const bf16*)(ws + WS_B1), 32 * 2304, 256, k256}; pg8::S5Order S{F.G, bid};
        pg8::EpiF32 E{(float*)(ws + WS_DS), 256};
        pg8::gemm_phase<pg8::EpiF32, pg8::S5Order, ALIGN, SP2>(F.lds + RING_OFF, g, S, E); } SEAM(3);
    if (IN(4)) { s5_scan(F, args);
        pg8::Gemm g{(const bf16*)(ws + WS_QA), (const bf16*)(ws + WS_W_QKV), MA, NQKV, KQKV}; pg8::StaticOrder S; S.init(MA, NQKV, F.G, bid);
        pg8::EpiSplit E{(bf16*)(ws + WS_Q), 768, (bf16*)(ws + WS_KV), 1024, 3, 0x7fffffff};
        pg8::gemm_phase<pg8::EpiSplit, pg8::StaticOrder, ALIGN, SP2>(F.lds + RING_OFF, g, S, E); } SEAM(4);
    if (IN(5)) {
        pg8::Gemm g{(const bf16*)(ws + WS_A3), (const bf16*)(ws + WS_B3), 32 * 2304, 256, 512}; pg8::S5Order S{F.G, bid};
        pg8::EpiS5Out E{(bf16*)(ws + WS_AG)};
        pg8::gemm_phase<pg8::EpiS5Out, pg8::S5Order, ALIGN, SP2>(F.lds + RING_OFF, g, S, E); } SEAM(5);
    if (IN(6)) {
#ifndef NO_ATT
 attn_phase(F, args);
#endif
        PROBE_STAMP(21);
        pg8::Gemm g{(const bf16*)(ws + WS_AG), (const bf16*)(ws + WS_W_GLU), MA, S5W, S5W}; pg8::StaticOrder S; S.init(MA, S5W, F.G, bid);
        pg8::EpiGlu E{(const bf16*)(ws + WS_AG), args.in[17], (bf16*)(ws + WS_AO), D};
        pg8::gemm_phase<pg8::EpiGlu, pg8::StaticOrder, ALIGN, SP2, false, false, true>(F.lds + RING_OFF, g, S, E); } SEAM(6);
    if (IN(7)) { pg8::Gemm g{(const bf16*)(ws + WS_AO), (const bf16*)(ws + WS_W_OUT0), MA, D, D}; pg8::StaticOrder S; S.init(MA, D, F.G, bid);
        pg8::EpiPlain E{(bf16*)(ws + WS_YL), D, 0, 0, 1.0f};
        pg8::gemm_phase<pg8::EpiPlain, pg8::StaticOrder, ALIGN, SP2>(F.lds + RING_OFF, g, S, E);
        tail_convert(F, args, (MA / 256) * (D / 256), MW1, MW2); } SEAM(7);
    if (IN(8)) { thin_t2(F, args); } SEAM(8);
    static_assert(!FFN0_IS_FP8, "the e4m3 dense-FFN variant does not carry the MoE weight conversion in its down phase");
    if constexpr (FFN0_IS_FP8) {
    if (IN(9)) { pg8::Gemm g{(const bf16*)(ws + WS_XL), (const bf16*)(ws + WS_W_GU), MA, 2 * FFN, D / 2}; pg8::StaticOrder S; S.init(MA, 2 * FFN, F.G, bid);
        pg8::EpiSwiGlu8 E{ws + WS_ACT, FFN, 0, 1.0f / (FP8_SA * FP8_SW), FP8_SACT, 0};
        pg8::gemm_phase<pg8::EpiSwiGlu8, pg8::StaticOrder, ALIGN, SP2, true>(F.lds + RING_OFF, g, S, E); } SEAM(9);
    if (IN(10)) { pg8::Gemm g{(const bf16*)(ws + WS_ACT), (const bf16*)(ws + WS_W_DN), MA, D, FFN / 2}; pg8::StaticOrder S; S.init(MA, D, F.G, bid);
        pg8::EpiPlain E{(bf16*)(ws + WS_FL), D, 0, 0, 1.0f / (FP8_SACT * FP8_SW)};
        pg8::gemm_phase<pg8::EpiPlain, pg8::StaticOrder, ALIGN, SP2, true>(F.lds + RING_OFF, g, S, E); } SEAM(10);
    } else {
    if (IN(9)) { pg8::Gemm g{(const bf16*)(ws + WS_XL), (const bf16*)(ws + WS_W_GU), MA, 2 * FFN, D}; pg8::StaticOrder S; S.init(MA, 2 * FFN, F.G, bid);
        if constexpr (FFN0_DN_FP8) { pg8::EpiSwiGlu8 E{ws + WS_ACT, FFN, 0, 1.0f, FP8_SACT, 0};
            pg8::gemm_phase<pg8::EpiSwiGlu8, pg8::StaticOrder, ALIGN, SP2>(F.lds + RING_OFF, g, S, E); }
        else { pg8::EpiSwiGlu E{(bf16*)(ws + WS_ACT), FFN, 0, 0};
            pg8::gemm_phase<pg8::EpiSwiGlu, pg8::StaticOrder, ALIGN, SP2>(F.lds + RING_OFF, g, S, E); }
        tail_convert(F, args, (MA / 256) * (2 * FFN / 256), MW2, MW3); } SEAM(9);
    if (IN(10)) { pg8::StaticOrder S; S.init(MA, D, F.G, bid);
        if constexpr (FFN0_DN_FP8) { pg8::Gemm g{(const bf16*)(ws + WS_ACT), (const bf16*)(ws + WS_W_DN), MA, D, FFN / 2};
            pg8::EpiPlain E{(bf16*)(ws + WS_FL), D, 0, 0, 1.0f / (FP8_SACT * FP8_SW)};
            pg8::gemm_phase<pg8::EpiPlain, pg8::StaticOrder, ALIGN, SP2, true>(F.lds + RING_OFF, g, S, E); }
        else { pg8::Gemm g{(const bf16*)(ws + WS_ACT), (const bf16*)(ws + WS_W_DN), MA, D, FFN};
            pg8::EpiPlain E{(bf16*)(ws + WS_FL), D, 0, 0, 1.0f};
            pg8::gemm_phase<pg8::EpiPlain, pg8::StaticOrder, ALIGN, SP2>(F.lds + RING_OFF, g, S, E); }
        tail_convert(F, args, (MA / 256) * (D / 256), MW3, MW4); } SEAM(10);
    }
    if (IN(11)) { thin_t3(F, args); } SEAM(11);
    if (IN(12)) { pg8::Gemm g{(const bf16*)(ws + WS_XL), (const bf16*)(ws + WS_W_IN1), MA, OD_INP, D}; pg8::StaticOrder S; S.init(MA, OD_INP, F.G, bid);
        pg8::EpiSplit E{(bf16*)(ws + WS_QK), 1024, (bf16*)(ws + WS_VR), VRLD, 4, 0x7fffffff};
        pg8::gemm_phase<pg8::EpiSplit, pg8::StaticOrder, ALIGN, SP2>(F.lds + RING_OFF, g, S, E);
        tail_convert(F, args, (MA / 256) * (OD_INP / 256), MW4, MW5); } SEAM(12);
    if (IN(13)) {
#ifndef NO_GLA
 gla_prep_phase(F, args);
#endif
    } SEAM(13);
    if (IN(14)) {
#ifndef NO_GLA
 gla_chain_phase(F, args);
#endif
    } SEAM(14);
    if (IN(15)) { gla_finish(F, args); } SEAM(15);
    if (IN(16)) { pg8::Gemm g{(const bf16*)(ws + WS_OF), (const bf16*)(ws + WS_W_OUT1), ML, D, D}; pg8::StaticOrder S; S.init(ML, D, F.G, bid);
        pg8::EpiPlain E{(bf16*)(ws + WS_YL1), D, 0, 0, 1.0f};
        pg8::gemm_phase<pg8::EpiPlain, pg8::StaticOrder, ALIGN, SP2>(F.lds + RING_OFF, g, S, E); } SEAM(16);
    if (IN(17)) { thin_t4(F, args); } SEAM(17);
    if (lo < 20 && hi > 18) {
        int ts[9]; moe_tile_starts(F, ts); const int NT = ts[8];
        if (IN(18)) { pg8::MoeOrder S{0, NT, 2 * FE / 256, F.G, bid, ts[1], ts[2], ts[3], ts[4], ts[5], ts[6], ts[7], 0};
            moe_row_table(F, args, S, ts);
            pg8::Gemm g{(const bf16*)(ws + WS_XLM), (const bf16*)(ws + WS_W_MGU), ML, 2 * FE, D / 2, (const LAS unsigned short*)(F.lds + ATAB_OFF)};
            pg8::EpiSwiGlu8 E{ws + WS_ACTM, FE, 2 * FE / 256, 1.0f / (FP8_SA * FP8_SW), FP8_SACT, 1};
            pg8::gemm_phase<pg8::EpiSwiGlu8, pg8::MoeOrder, ALIGN, SP2, true, false, false, true>(F.lds + RING_OFF, g, S, E); } SEAM(18);
        if (IN(19)) { pg8::Gemm g{(const bf16*)(ws + WS_ACTM), (const bf16*)(ws + WS_W_MDN), MOE_MAXT * 256, D, FE / 2};
            pg8::MoeOrder S{0, NT, D / 256, F.G, bid, ts[1], ts[2], ts[3], ts[4], ts[5], ts[6], ts[7], 1};
            pg8::EpiPlain E{(bf16*)(ws + WS_Y), D, 0, D / 256, 1.0f / (FP8_SACT * FP8_SW)};
            pg8::gemm_phase<pg8::EpiPlain, pg8::MoeOrder, ALIGN, SP2, true, true>(F.lds + RING_OFF, g, S, E); } SEAM(19);
    }
    if (IN(20)) { thin_t5(F, args); }
#ifdef PROBE_SETA
    PROBE_STAMP(20);
    if (blockIdx.x == PROBE_BLK && F.tid == 0) {
        unsigned long long qa = F.MISC[18] / 100u, qb = F.MISC[20] / 400u; qa = qa > 999 ? 999 : qa; qb = qb > 199 ? 199 : qb;
        const unsigned long long t0 = __builtin_amdgcn_s_memrealtime(), dl = qa * 1000ull + qb * 1000000ull;
        while (__builtin_amdgcn_s_memrealtime() - t0 < dl) __builtin_amdgcn_s_sleep(32);
    }
#endif
#undef IN
#undef SEAM
}

extern "C" void kernel_launch(void* const* d_in, const int* in_sizes, int n_in, void* d_out, int out_size, void* d_ws, size_t ws_size, hipStream_t stream) {
    static int grid = 0;
    if (grid == 0) {
        if (n_in != 35 || out_size != ML * D || ws_size < WS_END) { fprintf(stderr, "kernel_launch: unexpected shapes: n_in %d out %d ws %zu (need %zu)\n", n_in, out_size, ws_size, (size_t)WS_END); grid = -1; return; }
        int dev = 0, cus = 0, per_cu = 0;
        if (hipGetDevice(&dev) != hipSuccess || hipDeviceGetAttribute(&cus, hipDeviceAttributeMultiprocessorCount, dev) != hipSuccess) { grid = -1; return; }
        if (hipFuncSetAttribute((const void*)fwd_kernel, hipFuncAttributeMaxDynamicSharedMemorySize, LDS_BYTES) != hipSuccess) { fprintf(stderr, "kernel_launch: hipFuncSetAttribute failed\n"); grid = -1; return; }
        if (hipOccupancyMaxActiveBlocksPerMultiprocessor(&per_cu, (const void*)fwd_kernel, NWAVES * 64, LDS_BYTES) != hipSuccess || per_cu < 1) { fprintf(stderr, "kernel_launch: occupancy query reports %d blocks per CU\n", per_cu); }
        (void)hipGetLastError();
        grid = cus;
    }
    if (grid < 0) return;
    (void)hipMemsetAsync((char*)d_ws + WS_CTL, 0, CTL_ZERO_BYTES, stream);
    Args a{};
    for (int i = 0; i < 35; ++i) a.in[i] = (const float*)d_in[i];
    a.out = (float*)d_out; a.ws = (unsigned char*)d_ws;
#if MK_ONE_LAUNCH
    a.ph_lo = 0; a.ph_hi = NPHASE;
    hipLaunchKernelGGL(fwd_kernel, dim3(grid), dim3(NWAVES * 64), LDS_BYTES, stream, a);
#else
    for (int p = 0; p < NPHASE; ++p) { a.ph_lo = p; a.ph_hi = p + 1; hipLaunchKernelGGL(fwd_kernel, dim3(grid), dim3(NWAVES * 64), LDS_BYTES, stream, a); }
#endif
}
```

```cpp
#include <hip/hip_runtime.h>
#include <cstdio>
#include <cstdint>
#define MK_ONE_LAUNCH 1
namespace pg8 {
#define PG8_LAS __attribute__((address_space(3)))
typedef unsigned short bf16_t;
typedef short bf16x8 __attribute__((ext_vector_type(8)));
typedef float f32x4 __attribute__((ext_vector_type(4)));
typedef unsigned u32x4 __attribute__((ext_vector_type(4)));
constexpr int BM = 256, BK = 64, HALF = 128, HTB = HALF * BK * 2  , STAGE_BYTES = 8 * HTB, NXCD = 8, WGM = 8;

__host__ __device__ __forceinline__ int lds_byte(int r, int c) { const int st = (r >> 4) * 2 + (c >> 5), rr = r & 15, cc = c & 31, ob = rr * 64 + cc * 2; return st * 1024 + (ob ^ (((ob >> 9) & 1) << 5)); }
__host__ __device__ __forceinline__ void stage_rc(int b, int& R, int& C) { const int st = b / 1024, sb = b % 1024, swz = sb ^ (((sb >> 9) & 1) << 5); R = (st >> 1) * 16 + swz / 64; C = (st & 1) * 32 + (swz % 64) / 2; }
__host__ __device__ __forceinline__ int perm32(int rho) { const int n = rho >> 4, i = rho & 15; return 8 * (i >> 2) + 4 * n + (i & 3); }

struct Unit { int pm, pn; };
struct Gemm { const bf16_t* A; const bf16_t* Bt; int M, N, K; const PG8_LAS unsigned short* atab = nullptr; };
constexpr unsigned ACH_GS = 2304u * 256u * 2u;

struct StaticOrder {
    int nM, nN, nwg, G, c;
    __host__ __device__ void init(int M, int N, int G_, int c_) { nM = M / BM; nN = N / BM; nwg = nM * nN; G = G_; c = c_; }
    __host__ __device__ bool next(int i, Unit& u) const {
        const long L = (long)i * G + c; if (L >= nwg) return false;
        int wgid = (int)L; { const int q = nwg / NXCD, r = nwg % NXCD, xcd = wgid % NXCD, off = wgid / NXCD; wgid = (xcd < r ? xcd * (q + 1) : r * (q + 1) + (xcd - r) * q) + off; }
        const int nig = WGM * nN, gid = wgid / nig, fm = gid * WGM, gsz = (nM - fm) < WGM ? (nM - fm) : WGM;
        u.pm = fm + ((wgid % nig) % gsz); u.pn = (wgid % nig) / gsz; return true;
    }
    __device__ __forceinline__ void a_ready(const Unit&) const {}
    __device__ __forceinline__ void done(const Unit&) const {}
};

__device__ __forceinline__ unsigned cvt_pk_bf16(float lo, float hi) { unsigned r; asm volatile("v_cvt_pk_bf16_f32 %0, %1, %2" : "=v"(r) : "v"(lo), "v"(hi)); return r; }
typedef float f32x2 __attribute__((ext_vector_type(2)));
__device__ __forceinline__ u32x4 pack8(const f32x4 v0, const f32x4 v1) { u32x4 w; w.x = cvt_pk_bf16(v0[0], v0[1]); w.y = cvt_pk_bf16(v0[2], v0[3]); w.z = cvt_pk_bf16(v1[0], v1[1]); w.w = cvt_pk_bf16(v1[2], v1[3]); return w; }
__device__ __forceinline__ float bf_lo(unsigned u) { return __uint_as_float(u << 16); }
__device__ __forceinline__ float bf_hi(unsigned u) { return __uint_as_float(u & 0xffff0000u); }
__device__ __forceinline__ unsigned pk4_fp8(float a, float b, float c, float d) {
    a = __builtin_amdgcn_fmed3f(a, -448.f, 448.f); b = __builtin_amdgcn_fmed3f(b, -448.f, 448.f); c = __builtin_amdgcn_fmed3f(c, -448.f, 448.f); d = __builtin_amdgcn_fmed3f(d, -448.f, 448.f);
    int r = __builtin_amdgcn_cvt_pk_fp8_f32(a, b, 0, false); r = __builtin_amdgcn_cvt_pk_fp8_f32(c, d, r, true); return (unsigned)r; }
__device__ __forceinline__ float sigmoid_f(float x) { return __builtin_amdgcn_rcpf(1.0f + __builtin_amdgcn_exp2f(-1.4426950408889634f * x)); }

struct EpiPlain {
    static constexpr bool PERM = true, AFTER_DRAIN = false;
    bf16_t* O; int ldc; int pm_off; int nmod; float sc;
    __device__ __forceinline__ void operator()(const f32x4 (&acc)[2][2][4][2], const Unit& u, int wr, int wc, int fr, int fq) const {
        const int row0 = (u.pm - pm_off) * BM + wr * 64 + fr; const int ct = nmod ? (u.pn % nmod) : u.pn; const int col0 = ct * BM + wc * 32 + 8 * fq;
#pragma unroll
        for (int ai = 0; ai < 2; ++ai)
#pragma unroll
            for (int m = 0; m < 4; ++m) { bf16_t* rowp = O + (size_t)(row0 + ai * HALF + m * 16) * ldc + col0;
#pragma unroll
                for (int bj = 0; bj < 2; ++bj) *(u32x4*)(rowp + bj * HALF) = pack8(acc[ai][bj][m][0] * sc, acc[ai][bj][m][1] * sc); }
    }
};
struct EpiSplit {
    static constexpr bool PERM = true, AFTER_DRAIN = false;
    bf16_t* O0; int ld0; bf16_t* O1; int ld1; int nsplit; int ncols1;
    __device__ __forceinline__ void operator()(const f32x4 (&acc)[2][2][4][2], const Unit& u, int wr, int wc, int fr, int fq) const {
        const int row0 = u.pm * BM + wr * 64 + fr; const bool first = u.pn < nsplit;
        bf16_t* base = first ? O0 : O1; const int ld = first ? ld0 : ld1; const int col0 = (first ? u.pn : u.pn - nsplit) * BM + wc * 32 + 8 * fq; const int lim = first ? 0x7fffffff : ncols1;
#pragma unroll
        for (int ai = 0; ai < 2; ++ai)
#pragma unroll
            for (int m = 0; m < 4; ++m) { bf16_t* rowp = base + (size_t)(row0 + ai * HALF + m * 16) * ld + col0;
#pragma unroll
                for (int bj = 0; bj < 2; ++bj) if (col0 + bj * HALF < lim) *(u32x4*)(rowp + bj * HALF) = pack8(acc[ai][bj][m][0], acc[ai][bj][m][1]); }
    }
};
struct EpiGlu {
    static constexpr bool PERM = true, AFTER_DRAIN = false;
    const bf16_t* Aa; const float* bias; bf16_t* O; int ldc;
    __device__ __forceinline__ void operator()(const f32x4 (&acc)[2][2][4][2], const Unit& u, int wr, int wc, int fr, int fq) const {
        const int row0 = u.pm * BM + wr * 64 + fr; const int col0 = u.pn * BM + wc * 32 + 8 * fq;
        const int crow0 = (u.pm < 128 ? (u.pm >> 3) * 144 + 16 + (u.pm & 7) * 16 : (u.pm - 128) * 144) + wr * 4;
#pragma unroll
        for (int bj = 0; bj < 2; ++bj) { const f32x4 b0 = *(const f32x4*)(bias + col0 + bj * HALF), b1 = *(const f32x4*)(bias + col0 + bj * HALF + 4);
            const int cg = (col0 + bj * HALF) >> 4, ch = (col0 + bj * HALF) & 15;
#pragma unroll
            for (int ai = 0; ai < 2; ++ai)
#pragma unroll
                for (int m = 0; m < 4; ++m) { const size_t r = (size_t)(row0 + ai * HALF + m * 16);
                    const u32x4 a8 = *(const u32x4*)(Aa + (size_t)cg * (2304 * 256) + (size_t)(crow0 + ai * 8 + m) * 256 + fr * 16 + ch);
                    f32x4 v0 = acc[ai][bj][m][0] + b0, v1 = acc[ai][bj][m][1] + b1;
                    v0[0] = bf_lo(a8.x) * sigmoid_f(v0[0]); v0[1] = bf_hi(a8.x) * sigmoid_f(v0[1]); v0[2] = bf_lo(a8.y) * sigmoid_f(v0[2]); v0[3] = bf_hi(a8.y) * sigmoid_f(v0[3]);
                    v1[0] = bf_lo(a8.z) * sigmoid_f(v1[0]); v1[1] = bf_hi(a8.z) * sigmoid_f(v1[1]); v1[2] = bf_lo(a8.w) * sigmoid_f(v1[2]); v1[3] = bf_hi(a8.w) * sigmoid_f(v1[3]);
                    *(u32x4*)(O + r * ldc + col0 + bj * HALF) = pack8(v0, v1); } }
    }
};
struct EpiSwiGlu {
    static constexpr bool PERM = true, AFTER_DRAIN = false;
    bf16_t* O; int ldc; int pm_off; int nmod;
    __device__ __forceinline__ void operator()(const f32x4 (&acc)[2][2][4][2], const Unit& u, int wr, int wc, int fr, int fq) const {
        const int row0 = (u.pm - pm_off) * BM + wr * 64 + fr; const int ct = nmod ? (u.pn % nmod) : u.pn; const int col0 = ct * HALF + wc * 32 + 8 * fq;
#pragma unroll
        for (int ai = 0; ai < 2; ++ai)
#pragma unroll
            for (int m = 0; m < 4; ++m) { f32x4 o0, o1;
#pragma unroll
                for (int i = 0; i < 4; ++i) { const float g0 = acc[ai][0][m][0][i], g1 = acc[ai][0][m][1][i]; o0[i] = g0 * sigmoid_f(g0) * acc[ai][1][m][0][i]; o1[i] = g1 * sigmoid_f(g1) * acc[ai][1][m][1][i]; }
                *(u32x4*)(O + (size_t)(row0 + ai * HALF + m * 16) * ldc + col0) = pack8(o0, o1); }
    }
};
struct EpiIn0 {
    static constexpr bool PERM = true, AFTER_DRAIN = false;
    bf16_t* U; bf16_t* A3; bf16_t* Z0c;
    __device__ __forceinline__ void operator()(const f32x4 (&acc)[2][2][4][2], const Unit& u, int wr, int wc, int fr, int fq) const {
        if (u.pn >= 2) {
            const int row0 = u.pm * BM + wr * 64 + fr, col0 = (u.pn - 2) * BM + wc * 32 + 8 * fq;
#pragma unroll
            for (int ai = 0; ai < 2; ++ai)
#pragma unroll
                for (int m = 0; m < 4; ++m) { bf16_t* rowp = Z0c + (size_t)(row0 + ai * HALF + m * 16) * 512 + col0;
#pragma unroll
                    for (int bj = 0; bj < 2; ++bj) *(u32x4*)(rowp + bj * HALF) = pack8(acc[ai][bj][m][0], acc[ai][bj][m][1]); }
        } else {
            const int b = (u.pm < 128) ? (u.pm >> 3) : (u.pm - 128); const int c0 = (u.pm < 128) ? (16 + (u.pm & 7) * 16) : 0;
            const int g0 = u.pn * 16 + wc * 2 + (fq >> 1);
            const size_t r0 = (size_t)(g0 * 16 + b) * 144 + c0 + wr * 4;
            const int cc = fr * 16 + 8 * (fq & 1);
#pragma unroll
            for (int ai = 0; ai < 2; ++ai)
#pragma unroll
                for (int m = 0; m < 4; ++m)
#pragma unroll
                    for (int bj = 0; bj < 2; ++bj) { const size_t r = r0 + (size_t)bj * (8 * 16 * 144) + ai * 8 + m; const u32x4 w = pack8(acc[ai][bj][m][0], acc[ai][bj][m][1]);
                        *(u32x4*)(U + r * 256 + cc) = w; *(u32x4*)(A3 + r * 512 + cc) = w; }
        }
    }
};
struct EpiF32 {
    static constexpr bool PERM = false, AFTER_DRAIN = false;
    float* C; int ldc;
    __device__ __forceinline__ void operator()(const f32x4 (&acc)[2][2][4][2], const Unit& u, int wr, int wc, int fr, int fq) const {
        const int row0 = u.pm * BM + wr * 64 + fr, col0 = wc * 32 + 4 * fq;
#pragma unroll
        for (int ai = 0; ai < 2; ++ai)
#pragma unroll
            for (int m = 0; m < 4; ++m) { float* rowp = C + (size_t)(row0 + ai * HALF + m * 16) * ldc + col0;
#pragma unroll
                for (int bj = 0; bj < 2; ++bj)
#pragma unroll
                    for (int n = 0; n < 2; ++n) *(f32x4*)(rowp + bj * HALF + n * 16) = acc[ai][bj][m][n]; }
    }
};
__device__ __forceinline__ float gelu_tanh_f(float x) { const float t = 0.7978845608028654f * (x + 0.044715f * x * x * x); const float e = __builtin_amdgcn_exp2f(2.8853900817779268f * t); return x - x * __builtin_amdgcn_rcpf(e + 1.0f); }
struct EpiS5Out {
    static constexpr bool PERM = true, AFTER_DRAIN = false;
    bf16_t* AG;
    __device__ __forceinline__ void operator()(const f32x4 (&acc)[2][2][4][2], const Unit& u, int wr, int wc, int fr, int fq) const {
        const int row0 = u.pm * BM + wr * 64 + fr, col0 = wc * 32 + 8 * fq;
#pragma unroll
        for (int ai = 0; ai < 2; ++ai)
#pragma unroll
            for (int m = 0; m < 4; ++m) { bf16_t* rowp = AG + (size_t)(row0 + ai * HALF + m * 16) * 256 + col0;
#pragma unroll
                for (int bj = 0; bj < 2; ++bj) { f32x4 v0 = acc[ai][bj][m][0], v1 = acc[ai][bj][m][1];
#pragma unroll
                    for (int i = 0; i < 4; ++i) { v0[i] = gelu_tanh_f(v0[i]); v1[i] = gelu_tanh_f(v1[i]); }
                    *(u32x4*)(rowp + bj * HALF) = pack8(v0, v1); } }
    }
};
struct S5Order {
    int G, c;
    __device__ __forceinline__ bool next(int i, Unit& u) const { const int L = i * G + c; if (L >= 32 * 9) return false; u.pm = L; u.pn = L / 9; return true; }
    __device__ __forceinline__ void a_ready(const Unit&) const {}
    __device__ __forceinline__ void done(const Unit&) const {}
};
struct EpiSwiGlu8 {
    static constexpr bool PERM = true, AFTER_DRAIN = false;
    unsigned char* O; int ldc; int nmod; float us, os; int tiled;
    __device__ __forceinline__ void operator()(const f32x4 (&acc)[2][2][4][2], const Unit& u, int wr, int wc, int fr, int fq) const {
        const int row0 = u.pm * BM + wr * 64 + fr; const int ct = nmod ? (u.pn % nmod) : u.pn; const int col0 = ct * HALF + wc * 32 + 8 * fq;
        typedef unsigned u32x2_ __attribute__((ext_vector_type(2))); typedef float f32x2_ __attribute__((ext_vector_type(2)));
        const float kexp = -1.4426950408889634f * us, kout = us * us * os;
#pragma unroll
        for (int ai = 0; ai < 2; ++ai)
#pragma unroll
            for (int m = 0; m < 4; ++m) { f32x4 o0, o1;
#pragma unroll
                for (int i = 0; i < 4; i += 2) {
                    const f32x2_ ga = {acc[ai][0][m][0][i], acc[ai][0][m][0][i + 1]}, gb = {acc[ai][0][m][1][i], acc[ai][0][m][1][i + 1]}, ua = {acc[ai][1][m][0][i], acc[ai][1][m][0][i + 1]}, ub = {acc[ai][1][m][1][i], acc[ai][1][m][1][i + 1]};
                    f32x2_ ta = ga * kexp, tb = gb * kexp; ta.x = __builtin_amdgcn_exp2f(ta.x); ta.y = __builtin_amdgcn_exp2f(ta.y); tb.x = __builtin_amdgcn_exp2f(tb.x); tb.y = __builtin_amdgcn_exp2f(tb.y);
                    ta = ta + 1.0f; tb = tb + 1.0f; ta.x = __builtin_amdgcn_rcpf(ta.x); ta.y = __builtin_amdgcn_rcpf(ta.y); tb.x = __builtin_amdgcn_rcpf(tb.x); tb.y = __builtin_amdgcn_rcpf(tb.y);
                    const f32x2_ ra = (ga * ua) * (ta * kout), rb = (gb * ub) * (tb * kout); o0[i] = ra.x; o0[i + 1] = ra.y; o1[i] = rb.x; o1[i + 1] = rb.y; }
                u32x2_ w; w.x = pk4_fp8(o0[0], o0[1], o0[2], o0[3]); w.y = pk4_fp8(o1[0], o1[1], o1[2], o1[3]);
                const int rr = wr * 64 + fr + ai * HALF + m * 16;
                if (tiled) *(u32x2_*)(O + (size_t)u.pm * BM * ldc + (size_t)ct * (BM * 128) + rr * 128 + wc * 32 + 8 * fq) = w;
                else *(u32x2_*)(O + (size_t)(row0 + ai * HALF + m * 16) * ldc + col0) = w; }
    }
};
struct MoeOrder {
    int t0, nT, nN, G, c; int e1, e2, e3, e4, e5, e6, e7; int rev;
    __device__ __forceinline__ bool next(int i, Unit& u) const {
        const int nwg = nT * nN; const long L = (long)i * G + c; if (L >= nwg) return false;
        int wgid = (int)L; { const int q = nwg / NXCD, r = nwg % NXCD, xcd = wgid % NXCD, off = wgid / NXCD, sz = xcd < r ? q + 1 : q; wgid = (xcd < r ? xcd * (q + 1) : r * (q + 1) + (xcd - r) * q) + (rev ? sz - 1 - off : off); }
        const int nig = WGM * nN, gid = wgid / nig, fm = gid * WGM, gsz = (nT - fm) < WGM ? (nT - fm) : WGM;
        const int pm = t0 + fm + ((wgid % nig) % gsz), pn = (wgid % nig) / gsz;
        const int e = (pm >= e1) + (pm >= e2) + (pm >= e3) + (pm >= e4) + (pm >= e5) + (pm >= e6) + (pm >= e7);
        u.pm = pm; u.pn = e * nN + pn; return true;
    }
    __device__ __forceinline__ void a_ready(const Unit&) const {}
    __device__ __forceinline__ void done(const Unit&) const {}
};
template <class Epi, class Sched, bool ALIGN_EPI = false, bool SP2 = false, bool FP8 = false, bool TILED = false, bool ACHUNK = false, bool AGATHER = false>
__device__ __forceinline__ void gemm_phase(PG8_LAS unsigned char* lds, const Gemm g, const Sched& S, const Epi& E) {
    const int tid = threadIdx.x, wid = __builtin_amdgcn_readfirstlane(tid >> 6), lane = tid & 63, wr = wid >> 2, wc = wid & 3, fr = lane & 15, fq = lane >> 4;
    const int K = g.K, nt = K / BK;
    unsigned voffA[2], voffB[2];
#pragma unroll
    for (int i = 0; i < 2; ++i) { int R, C; stage_rc(tid * 16 + i * 8192, R, C); const int Rb = Epi::PERM ? ((R & ~31) + perm32(R & 31)) : R;
        voffA[i] = TILED ? (unsigned)(R * BK + C) * 2u : (unsigned)(R * K + C) * 2u; voffB[i] = TILED ? (unsigned)(Rb * BK + C) * 2u : (unsigned)(Rb * K + C) * 2u;
        if (ACHUNK) voffA[i] = (unsigned)((R >> 4) * 512 + (R & 15) * 32 + (C & 15) * 2) + (unsigned)(C >> 4) * ACH_GS; }
    const size_t kstep = TILED ? (size_t)(BM * BK * 2) : (size_t)(BK * 2);
    const size_t hstep = TILED ? (size_t)(HALF * BK * 2) : (size_t)HALF * K * 2;
    const size_t tstep = (size_t)BM * K * 2;
    const size_t kstepA = ACHUNK ? (size_t)4 * ACH_GS : kstep, hstepA = ACHUNK ? (size_t)4096 : hstep;
#define PG8_ABASE(pm_) (AGATHER ? (const char*)g.A : ACHUNK ? (const char*)g.A + (size_t)((pm_) < 128 ? ((pm_) >> 3) * 144 + 16 + ((pm_) & 7) * 16 : ((pm_) - 128) * 144) * 512 : (const char*)g.A + (size_t)(pm_) * tstep)
    const unsigned ldsw = (unsigned)wid * 1024u;
    const int aoff = lds_byte(wr * 64 + fr, fq * 8), boff = lds_byte(wc * 32 + fr, fq * 8);
#define PG8_SA(b, h) (((b) * 2 + (h)) * HTB)
#define PG8_SB(b, h) ((4 + (b) * 2 + (h)) * HTB)
#define PG8_STAGE(bufoff, gbase, voff) do { _Pragma("unroll") for (int _i = 0; _i < 2; ++_i) \
        __builtin_amdgcn_global_load_lds((const unsigned*)((const char*)(gbase) + (voff)[_i]), (PG8_LAS unsigned*)(lds + (bufoff) + ldsw + _i * 8192), 16, 0, 0); } while (0)
    static_assert(!AGATHER || SP2, "AGATHER is written for the SP2 loop");
    unsigned gvA0[2] = {0u, 0u}, gvA1[2] = {0u, 0u}, gnA0[2] = {0u, 0u}, gnA1[2] = {0u, 0u};
#define PG8_GLOAD(uidx, v0, v1) do { _Pragma("unroll") for (int i_ = 0; i_ < 2; ++i_) { int R_, C_; stage_rc(tid * 16 + i_ * 8192, R_, C_); \
        const unsigned t0_ = g.atab[(uidx) * 256 + R_], t1_ = g.atab[(uidx) * 256 + 128 + R_]; v0[i_] = t0_ * (unsigned)(2 * K) + (unsigned)C_ * 2u; v1[i_] = t1_ * (unsigned)(2 * K) + (unsigned)C_ * 2u; } } while (0)
#define PG8_STAGE_A(bufoff, gbase, half, nx) do { if constexpr (AGATHER) { unsigned vs_[2]; \
        vs_[0] = (nx) ? ((half) ? gnA1[0] : gnA0[0]) : ((half) ? gvA1[0] : gvA0[0]); vs_[1] = (nx) ? ((half) ? gnA1[1] : gnA0[1]) : ((half) ? gvA1[1] : gvA0[1]); PG8_STAGE(bufoff, gbase, vs_); } \
        else PG8_STAGE(bufoff, (gbase) + ((half) ? hstepA : (size_t)0), voffA); } while (0)
#define PG8_LDA(dst, b, h) do { _Pragma("unroll") for (int m = 0; m < 4; ++m) _Pragma("unroll") for (int k = 0; k < 2; ++k) dst[m][k] = *(const PG8_LAS bf16x8*)(lds + PG8_SA(b, h) + aoff + m * 2048 + k * 1024); } while (0)
#define PG8_LDB(dst, b, h) do { _Pragma("unroll") for (int n = 0; n < 2; ++n) _Pragma("unroll") for (int k = 0; k < 2; ++k) dst[n][k] = *(const PG8_LAS bf16x8*)(lds + PG8_SB(b, h) + boff + n * 2048 + k * 1024); } while (0)
#define PG8_MMA(ai, bj, At, Bt) do { __builtin_amdgcn_s_setprio(1); _Pragma("unroll") for (int m = 0; m < 4; ++m) _Pragma("unroll") for (int n = 0; n < 2; ++n) { \
        if constexpr (FP8) { typedef int i32x4_ __attribute__((ext_vector_type(4))); typedef int i32x8_ __attribute__((ext_vector_type(8))); \
            const i32x8_ bo_ = __builtin_shufflevector(__builtin_bit_cast(i32x4_, Bt[n][0]), __builtin_bit_cast(i32x4_, Bt[n][1]), 0, 1, 2, 3, 4, 5, 6, 7); \
            const i32x8_ ao_ = __builtin_shufflevector(__builtin_bit_cast(i32x4_, At[m][0]), __builtin_bit_cast(i32x4_, At[m][1]), 0, 1, 2, 3, 4, 5, 6, 7); \
            asm volatile("v_mfma_f32_16x16x128_f8f6f4 %0, %1, %2, %0" : "+v"(acc[ai][bj][m][n]) : "v"(bo_), "v"(ao_)); } \
        else { _Pragma("unroll") for (int k = 0; k < 2; ++k) acc[ai][bj][m][n] = __builtin_amdgcn_mfma_f32_16x16x32_bf16(Bt[n][k], At[m][k], acc[ai][bj][m][n], 0, 0, 0); } } \
        __builtin_amdgcn_s_setprio(0); } while (0)
#define PG8_WAIT_V(n) asm volatile("s_waitcnt vmcnt(" #n ")" ::: "memory")
#define PG8_WAIT_L(n) asm volatile("s_waitcnt lgkmcnt(" #n ")" ::: "memory")
#define PG8_BAR __builtin_amdgcn_s_barrier()
#define PG8_SCHED __builtin_amdgcn_sched_barrier(0)
    const int fp8_unit_scale_ = 0x7f7f7f7f; (void)fp8_unit_scale_;
    Unit cur, nxt; int ui = 0;
    if (!S.next(0, cur)) return;
    f32x4 acc[2][2][4][2];
#pragma unroll
    for (int a = 0; a < 2; ++a)
#pragma unroll
        for (int b = 0; b < 2; ++b)
#pragma unroll
            for (int m = 0; m < 4; ++m)
#pragma unroll
                for (int n = 0; n < 2; ++n) acc[a][b][m][n] = (f32x4){0.f, 0.f, 0.f, 0.f};
    bf16x8 At[4][2], B0[2][2], B1[2][2];
    const char* cA = PG8_ABASE(cur.pm); const char* cB = (const char*)g.Bt + (size_t)cur.pn * tstep;
    if constexpr (AGATHER) PG8_GLOAD(0, gvA0, gvA1);
    S.a_ready(cur);
    if constexpr (SP2) {
        PG8_STAGE(PG8_SB(0, 0), cB, voffB); PG8_STAGE(PG8_SB(0, 1), cB + hstep, voffB); PG8_STAGE_A(PG8_SA(0, 0), cA, 0, false); PG8_STAGE_A(PG8_SA(0, 1), cA, 1, false);
        if (wr == 1) PG8_BAR;
        PG8_WAIT_V(2); PG8_BAR;
        PG8_STAGE(PG8_SB(1, 0), cB + kstep, voffB); PG8_STAGE_A(PG8_SA(1, 0), cA + kstepA, 0, false); PG8_STAGE(PG8_SB(1, 1), cB + hstep + kstep, voffB);
        PG8_WAIT_V(6); PG8_BAR;
    } else {
        PG8_STAGE(PG8_SB(0, 0), cB, voffB); PG8_STAGE(PG8_SA(0, 0), cA, voffA); PG8_STAGE(PG8_SB(0, 1), cB + hstep, voffB); PG8_STAGE(PG8_SA(0, 1), cA + hstepA, voffA);
        if (wr == 1) PG8_BAR;
        PG8_WAIT_V(4); PG8_BAR;
        PG8_STAGE(PG8_SB(1, 0), cB + kstep, voffB); PG8_STAGE(PG8_SA(1, 0), cA + kstepA, voffA); PG8_STAGE(PG8_SB(1, 1), cB + hstep + kstep, voffB);
        PG8_WAIT_V(6); PG8_BAR;
    }
    for (;;) {
        const bool has_next = S.next(ui + 1, nxt);
        const char* nA = has_next ? PG8_ABASE(nxt.pm) : cA; const char* nB = has_next ? (const char*)g.Bt + (size_t)nxt.pn * tstep : cB;
        for (int t = 0; t < nt; t += 2) {
            const bool last = (t == nt - 2);
            const char* a1 = cA + (size_t)(t + 1) * kstepA;
            const char* a2 = last ? nA : cA + (size_t)(t + 2) * kstepA; const char* b2 = last ? nB : cB + (size_t)(t + 2) * kstep;
            const char* a3 = a2 + kstepA; const char* b3 = b2 + kstep;
            if (last && has_next) S.a_ready(nxt);
            const bool nx_ = last && has_next;
            if constexpr (AGATHER) { if (nx_) PG8_GLOAD(ui + 1, gnA0, gnA1); }
            if constexpr (SP2) {
            PG8_LDB(B0, 0, 0); PG8_LDB(B1, 0, 1); PG8_SCHED; PG8_LDA(At, 0, 0); PG8_STAGE_A(PG8_SA(1, 1), a1, 1, false);
            PG8_WAIT_V(8); PG8_WAIT_L(0); PG8_BAR; PG8_MMA(0, 0, At, B0); PG8_MMA(0, 1, At, B1); PG8_BAR; PG8_SCHED;
            PG8_LDA(At, 0, 1); PG8_STAGE(PG8_SB(0, 0), b2, voffB); PG8_STAGE(PG8_SB(0, 1), b2 + hstep, voffB); PG8_STAGE_A(PG8_SA(0, 0), a2, 0, nx_);
            PG8_WAIT_V(8); PG8_WAIT_L(0); PG8_BAR; PG8_MMA(1, 0, At, B0); PG8_MMA(1, 1, At, B1); PG8_BAR; PG8_SCHED;
            PG8_LDB(B0, 1, 0); PG8_LDB(B1, 1, 1); PG8_SCHED; PG8_LDA(At, 1, 0); PG8_STAGE_A(PG8_SA(0, 1), a2, 1, nx_);
            PG8_WAIT_V(8); PG8_WAIT_L(0); PG8_BAR; PG8_MMA(0, 0, At, B0); PG8_MMA(0, 1, At, B1); PG8_BAR; PG8_SCHED;
            PG8_LDA(At, 1, 1); PG8_STAGE(PG8_SB(1, 0), b3, voffB); PG8_STAGE(PG8_SB(1, 1), b3 + hstep, voffB); PG8_STAGE_A(PG8_SA(1, 0), a3, 0, nx_);
            PG8_WAIT_V(8); PG8_WAIT_L(0); PG8_BAR; PG8_MMA(1, 0, At, B0); PG8_MMA(1, 1, At, B1); PG8_BAR; PG8_SCHED;
            } else {
            PG8_LDB(B0, 0, 0); PG8_SCHED; PG8_LDA(At, 0, 0); PG8_STAGE(PG8_SA(1, 1), a1 + hstepA, voffA);
            PG8_WAIT_L(8); PG8_BAR; PG8_WAIT_L(0); PG8_MMA(0, 0, At, B0); PG8_BAR; PG8_SCHED;
            PG8_LDB(B1, 0, 1); PG8_STAGE(PG8_SB(0, 0), b2, voffB);
            PG8_BAR; PG8_WAIT_L(0); PG8_MMA(0, 1, At, B1); PG8_BAR;
            PG8_LDA(At, 0, 1); PG8_STAGE(PG8_SA(0, 0), a2, voffA);
            PG8_BAR; PG8_WAIT_L(0); PG8_MMA(1, 0, At, B0); PG8_BAR; PG8_SCHED;
            PG8_STAGE(PG8_SB(0, 1), b2 + hstep, voffB);
            PG8_WAIT_V(6); PG8_BAR; PG8_MMA(1, 1, At, B1); PG8_BAR;
            PG8_LDB(B0, 1, 0); PG8_SCHED; PG8_LDA(At, 1, 0); PG8_STAGE(PG8_SA(0, 1), a2 + hstepA, voffA);
            PG8_WAIT_L(8); PG8_BAR; PG8_WAIT_L(0); PG8_MMA(0, 0, At, B0); PG8_BAR; PG8_SCHED;
            PG8_LDB(B1, 1, 1); PG8_STAGE(PG8_SB(1, 0), b3, voffB);
            PG8_BAR; PG8_WAIT_L(0); PG8_MMA(0, 1, At, B1); PG8_BAR;
            PG8_LDA(At, 1, 1); PG8_STAGE(PG8_SA(1, 0), a3, voffA);
            PG8_BAR; PG8_WAIT_L(0); PG8_MMA(1, 0, At, B0); PG8_BAR; PG8_SCHED;
            PG8_STAGE(PG8_SB(1, 1), b3 + hstep, voffB);
            PG8_WAIT_V(6); PG8_BAR; PG8_MMA(1, 1, At, B1); PG8_BAR;
            }
        }
        if constexpr (ALIGN_EPI) { if (wr == 0) PG8_BAR; }
        if constexpr (FP8) asm volatile("s_nop 15\n\ts_nop 7" ::: "memory");
        if constexpr (!Epi::AFTER_DRAIN) { E(acc, cur, wr, wc, fr, fq); S.done(cur); }
        if (!has_next) break;
#pragma unroll
        for (int a = 0; a < 2; ++a)
#pragma unroll
            for (int b = 0; b < 2; ++b)
#pragma unroll
                for (int m = 0; m < 4; ++m)
#pragma unroll
                    for (int n = 0; n < 2; ++n) acc[a][b][m][n] = (f32x4){0.f, 0.f, 0.f, 0.f};
        cur = nxt; cA = nA; cB = nB; ++ui;
        if constexpr (AGATHER) { gvA0[0] = gnA0[0]; gvA0[1] = gnA0[1]; gvA1[0] = gnA1[0]; gvA1[1] = gnA1[1]; }
        if constexpr (ALIGN_EPI) { if (wr == 1) PG8_BAR; }
    }
    PG8_WAIT_V(0);
    if constexpr (!ALIGN_EPI) { if (wr == 0) PG8_BAR; }
    PG8_BAR;
    if constexpr (Epi::AFTER_DRAIN) { E.fused(acc, cur, wr, wc, fr, fq, lds, wid, lane); S.done(cur); }
#undef PG8_ABASE
#undef PG8_GLOAD
#undef PG8_STAGE_A
#undef PG8_SA
#undef PG8_SB
#undef PG8_STAGE
#undef PG8_LDA
#undef PG8_LDB
#undef PG8_MMA
#undef PG8_WAIT_V
#undef PG8_WAIT_L
#undef PG8_BAR
#undef PG8_SCHED
}
}
#define GAS __attribute__((address_space(1)))
#define LAS __attribute__((address_space(3)))
typedef unsigned short bf16;
typedef unsigned v4u __attribute__((ext_vector_type(4)));
typedef float f32x4 __attribute__((ext_vector_type(4)));
typedef short bf16x8 __attribute__((ext_vector_type(8)));
typedef GAS unsigned gu32;
typedef GAS unsigned long long gu64;
#define RLX_AGENT __ATOMIC_RELAXED, __HIP_MEMORY_SCOPE_AGENT
#define LDS_WAIT() asm volatile("s_waitcnt lgkmcnt(0)" ::: "memory")
#define VM_WAIT() asm volatile("s_waitcnt vmcnt(0)" ::: "memory")
__device__ __forceinline__ unsigned long long rt() { return __builtin_amdgcn_s_memrealtime(); }
__device__ __forceinline__ unsigned f2bf(float f) { unsigned u = __builtin_bit_cast(unsigned, f); return (u + 0x7fffu + ((u >> 16) & 1u)) >> 16; }
__device__ __forceinline__ unsigned pk2(float lo, float hi) { return f2bf(lo) | (f2bf(hi) << 16); }
#define XB_TMO      128
#define XB_XCNT(j)  (256  + 64 * (j))
#define XB_XSUB(j)  (1280 + 64 * (j))
#define XB_XGEN(j)  (2304 + 64 * (j))
#define XB_TOP      3328
#define XB_TOPGEN   3392
#define XCD_BAR_WORDS 3456
#define XB_SPIN_CAP (1u << 18)

__device__ __forceinline__ unsigned xb_ld(unsigned* p)              { return __hip_atomic_load(p, __ATOMIC_RELAXED, __HIP_MEMORY_SCOPE_AGENT); }
__device__ __forceinline__ unsigned xb_add(unsigned* p, unsigned v) { return __hip_atomic_fetch_add(p, v, __ATOMIC_RELAXED, __HIP_MEMORY_SCOPE_AGENT); }
__device__ __forceinline__ unsigned xb_xcc_id() { return (unsigned)__builtin_amdgcn_s_getreg((3 << 11) | 20) & 0xFu; }
#define XB_SPIN(cond, bar) do { unsigned _sp = 0; while (cond) { __builtin_amdgcn_s_sleep(1); \
    if ((++_sp & 255u) == 0u) { if (xb_ld(&(bar)[XB_TMO])) break; if (_sp > XB_SPIN_CAP) { atomicAdd(&(bar)[XB_TMO], 1u); break; } } } } while (0)

struct XcdBarrier {
    unsigned* bar; unsigned x;
    volatile LAS unsigned* st;
};

__device__ __forceinline__ XcdBarrier xcd_barrier_post(unsigned* bar, volatile LAS unsigned* st) {
    XcdBarrier b; b.bar = bar; b.x = xb_xcc_id(); b.st = st;
    if (threadIdx.x == 0) (void)xb_add(&bar[XB_XCNT(b.x)], 1u);
    return b;
}
__device__ __forceinline__ void xcd_barrier_complete(unsigned* bar, unsigned x, unsigned& nloc, unsigned& nx) {
    const unsigned G = gridDim.x * gridDim.y * gridDim.z;
    unsigned sum, cnt, mine, sp = 0u;
    for (;;) {
        sum = 0u; cnt = 0u; mine = 0u;
#pragma unroll
        for (unsigned j = 0; j < 16; ++j) { const unsigned c = xb_ld(&bar[XB_XCNT(j)]); sum += c; cnt += (c > 0u) ? 1u : 0u; mine = (j == x) ? c : mine; }
        if (sum == G) break;
        __builtin_amdgcn_s_sleep(1);
        if ((++sp & 255u) == 0u) { if (xb_ld(&bar[XB_TMO])) break; if (sp > XB_SPIN_CAP) { atomicAdd(&bar[XB_TMO], 1u); break; } }
    }
    nloc = mine > 0u ? mine : 1u; nx = cnt > 0u ? cnt : 1u;
}

__device__ __forceinline__ void xcd_barrier(const XcdBarrier& b) {
    asm volatile("s_waitcnt vmcnt(0)" ::: "memory");
    __syncthreads();
    if (threadIdx.x == 0) {
        unsigned* bar = b.bar;
        __builtin_amdgcn_s_waitcnt(0);
        unsigned nloc = b.st[0], nx = b.st[1];
        if (nloc == 0u) { xcd_barrier_complete(bar, b.x, nloc, nx); b.st[0] = nloc; b.st[1] = nx; }
        const unsigned old = xb_add(&bar[XB_XSUB(b.x)], 1u);
        const unsigned gen = old / nloc;
        if (old + 1u == (gen + 1u) * nloc) {
            __builtin_amdgcn_fence(__ATOMIC_RELEASE, "agent");
            asm volatile("s_waitcnt vmcnt(0)" ::: "memory");
            const unsigned og = xb_add(&bar[XB_TOP], 1u);
            const unsigned tg = og / nx;
            if (og + 1u == (tg + 1u) * nx) xb_add(&bar[XB_TOPGEN], 1u);
            else XB_SPIN(xb_ld(&bar[XB_TOPGEN]) == tg, bar);
            __builtin_amdgcn_fence(__ATOMIC_ACQUIRE, "agent");
            xb_add(&bar[XB_XGEN(b.x)], 1u);
            asm volatile("s_waitcnt vmcnt(0)" ::: "memory");
        } else {
            XB_SPIN(xb_ld(&bar[XB_XGEN(b.x)]) == gen, bar);
            __builtin_amdgcn_fence(__ATOMIC_ACQUIRE, "agent");
            asm volatile("s_waitcnt vmcnt(0)" ::: "memory");
        }
    }
    __syncthreads();
}

namespace att {
typedef short bf16x8 __attribute__((ext_vector_type(8)));
typedef short s16x4 __attribute__((ext_vector_type(4)));
typedef float f32x16 __attribute__((ext_vector_type(16)));
typedef unsigned u32x4 __attribute__((ext_vector_type(4)));
#define ATT_LAS __attribute__((address_space(3)))
constexpr int QBLK = 32, KVBLK = 64, DQ = 96, DV = 64, LDQ = 768, LDKN = 1024, LDKR = 32, LDV = 1024, LDO = 1024;
typedef const __attribute__((address_space(1))) unsigned short* gcp; typedef __attribute__((address_space(1))) unsigned short* gp;
constexpr float SCALE = 0.10206207261596577f, QSC = SCALE * 1.4426950408889634f, THR2 = 8.f * 1.4426950408889634f;
constexpr int SHM_V = KVBLK * DV * 2, SHM_K = KVBLK * 256, NRING = 4, OFF_K = 0, OFF_V = NRING * SHM_K, OFF_WS = NRING * (SHM_V + SHM_K), ATT_LDS = OFF_WS + 8 * 256;
#define KSWZ(row, colB) ((row) * 256 + ((colB) ^ (((row) & 7) << 4)))
#define SBAR() __builtin_amdgcn_sched_barrier(0)
__device__ __forceinline__ int crow(int r, int hi) { return (r & 3) + 8 * (r >> 2) + 4 * hi; }
__device__ __forceinline__ unsigned cvtpk(float lo, float hi) { unsigned r; asm volatile("v_cvt_pk_bf16_f32 %0, %1, %2" : "=v"(r) : "v"(lo), "v"(hi)); return r; }
template <bool FIRST> __device__ __forceinline__ void partialSM(f32x16& p0, f32x16& p1, f32x16& mC, float& alpha) {
  float pmax = p0[0];
#pragma unroll
  for (int r = 1; r < 16; ++r) pmax = fmaxf(pmax, p0[r]);
#pragma unroll
  for (int r = 0; r < 16; ++r) pmax = fmaxf(pmax, p1[r]);
  { auto rr = __builtin_amdgcn_permlane32_swap(__float_as_uint(pmax), __float_as_uint(pmax), false, false);
    pmax = fmaxf(__uint_as_float(rr[0]), __uint_as_float(rr[1])); }
  if (!FIRST && __builtin_expect(__all(pmax <= THR2), 1)) alpha = 1.f;
  else { const float d = FIRST ? pmax : fmaxf(pmax, 0.f); alpha = __builtin_amdgcn_exp2f(-d);
#pragma unroll
    for (int r = 0; r < 16; ++r) { p0[r] -= d; p1[r] -= d; mC[r] -= d; } }
#pragma unroll
  for (int r = 0; r < 16; ++r) p0[r] = __builtin_amdgcn_exp2f(p0[r]);
}
__device__ __forceinline__ void finishSM(f32x16& p0, f32x16& p1, bf16x8& pa0, bf16x8& pa1, bf16x8& pa2, bf16x8& pa3) {
#pragma unroll
  for (int r = 0; r < 16; ++r) p1[r] = __builtin_amdgcn_exp2f(p1[r]);
#define PK4(P, BASE, OUT) do { u32x4 w = {cvtpk(P[BASE + 0], P[BASE + 1]), cvtpk(P[BASE + 2], P[BASE + 3]), cvtpk(P[BASE + 4], P[BASE + 5]), cvtpk(P[BASE + 6], P[BASE + 7])}; OUT = __builtin_bit_cast(bf16x8, w); } while (0)
  PK4(p0, 0, pa0); PK4(p0, 8, pa1); PK4(p1, 0, pa2); PK4(p1, 8, pa3);
#undef PK4
}
__device__ __forceinline__ void qkt(f32x16& p0, f32x16& p1, const f32x16& mC, const ATT_LAS unsigned char* Ks, const bf16x8* qr, int r32, int hi) {
#pragma unroll
  for (int d0 = 0; d0 < DQ / 16; ++d0) { const int cb = (d0 * 16 + hi * 8) * 2;
    const bf16x8 b0 = *(const ATT_LAS bf16x8*)(Ks + KSWZ(r32, cb));
    const bf16x8 b1 = *(const ATT_LAS bf16x8*)(Ks + KSWZ(32 + r32, cb));
    p0 = __builtin_amdgcn_mfma_f32_32x32x16_bf16(b0, qr[d0], d0 ? p0 : mC, 0, 0, 0);
    p1 = __builtin_amdgcn_mfma_f32_32x32x16_bf16(b1, qr[d0], d0 ? p1 : mC, 0, 0, 0); }
}
__device__ __forceinline__ int v_st(int k, int c) { const int kk = k; return ((kk >> 3) * 2 + (c >> 5)) * 512 + ((kk & 7) * 32 + (c & 31)) * 2; }
__device__ __forceinline__ int v_rd_base(int lane) { return ((lane & 3) << 3) | (((lane >> 2) & 3) << 6) | (((lane >> 4) & 1) << 5) | (((lane >> 5) & 1) << 8); }
constexpr int v_rd_off(int d0, int ks, int half) { return d0 * 512 + ks * 2048 + half * 1024; }
struct KPre { bf16x8 a0, b0, a1, b1; };
#define KLDX(KS, D0, A, B) do { A = *(const ATT_LAS bf16x8*)((KS) + KSWZ(r32, ((D0) * 16 + hi * 8) * 2)); B = *(const ATT_LAS bf16x8*)((KS) + KSWZ(32 + r32, ((D0) * 16 + hi * 8) * 2)); } while (0)
#define VLD(D0, KS_, H) __builtin_amdgcn_ds_read_tr16_b64_v4i16((ATT_LAS s16x4*)(vbp + VO + v_rd_off(D0, KS_, H)))
#define PK(L, H) (bf16x8){L[0], L[1], L[2], L[3], H[0], H[1], H[2], H[3]}
#define MFMA(A, B, C) __builtin_amdgcn_mfma_f32_32x32x16_bf16(A, B, C, 0, 0, 0)
template <int VO> __device__ __forceinline__ void region1(f32x16& n0, f32x16& n1, const f32x16& mC, const ATT_LAS unsigned char* Ks, const bf16x8* qr, int r32, int hi, const KPre& kp,
                                                          f32x16& p0, f32x16& p1, bf16x8& pa0, bf16x8& pa1, bf16x8& pa2, bf16x8& pa3, const ATT_LAS unsigned char* vbp, s16x4* vf) {
  bf16x8 kA[DQ / 16], kB[DQ / 16]; unsigned w[16]; kA[0] = kp.a0; kB[0] = kp.b0; kA[1] = kp.a1; kB[1] = kp.b1;
#define KLD(D0) KLDX(Ks, D0, kA[D0], kB[D0])
#define KMM(D0) do { n0 = MFMA(kA[D0], qr[D0], (D0) ? n0 : mC); n1 = MFMA(kB[D0], qr[D0], (D0) ? n1 : mC); } while (0)
#define EXP1(R) p1[R] = __builtin_amdgcn_exp2f(p1[R])
  KLD(2); KMM(0); EXP1(0); EXP1(1); EXP1(2); EXP1(3); EXP1(4); EXP1(5); w[0] = cvtpk(p0[0], p0[1]); w[1] = cvtpk(p0[2], p0[3]); SBAR();
  KLD(3); KMM(1); EXP1(6); EXP1(7); EXP1(8); EXP1(9); EXP1(10); EXP1(11); w[2] = cvtpk(p0[4], p0[5]); w[3] = cvtpk(p0[6], p0[7]); SBAR();
  KLD(4); KMM(2); EXP1(12); EXP1(13); EXP1(14); EXP1(15); w[4] = cvtpk(p0[8], p0[9]); w[5] = cvtpk(p0[10], p0[11]); w[6] = cvtpk(p0[12], p0[13]); w[7] = cvtpk(p0[14], p0[15]); SBAR();
  KLD(5); KMM(3); w[8] = cvtpk(p1[0], p1[1]); w[9] = cvtpk(p1[2], p1[3]); w[10] = cvtpk(p1[4], p1[5]); w[11] = cvtpk(p1[6], p1[7]); SBAR();
#pragma unroll
  for (int ks = 0; ks < 4; ++ks) { vf[2 * ks] = VLD(0, ks, 0); vf[2 * ks + 1] = VLD(0, ks, 1); }
  KMM(4); w[12] = cvtpk(p1[8], p1[9]); w[13] = cvtpk(p1[10], p1[11]); w[14] = cvtpk(p1[12], p1[13]); w[15] = cvtpk(p1[14], p1[15]); SBAR();
  KMM(5);
#undef KLD
#undef KMM
#undef EXP1
  { const u32x4 a = {w[0], w[1], w[2], w[3]}, b = {w[4], w[5], w[6], w[7]}, c = {w[8], w[9], w[10], w[11]}, d = {w[12], w[13], w[14], w[15]};
    pa0 = __builtin_bit_cast(bf16x8, a); pa1 = __builtin_bit_cast(bf16x8, b); pa2 = __builtin_bit_cast(bf16x8, c); pa3 = __builtin_bit_cast(bf16x8, d); }
}
template <int VO> __device__ __forceinline__ void region2(f32x16* o, const s16x4* vf, const ATT_LAS unsigned char* vbp, bf16x8 pa0, bf16x8 pa1, bf16x8 pa2, bf16x8 pa3, bf16x8 ones,
                                                          f32x16& n0, f32x16& n1, f32x16& mC, float& alpha) {
  s16x4 vg[8];
#pragma unroll
  for (int ks = 0; ks < 4; ++ks) { vg[2 * ks] = VLD(1, ks, 0); vg[2 * ks + 1] = VLD(1, ks, 1); }
#define MX3(A, P, R) A = fmaxf(fmaxf(A, P[R]), P[R + 1])
  o[0] = MFMA(pa0, PK(vf[0], vf[1]), o[0]); o[2] = MFMA(pa0, ones, o[2]); SBAR();
  float ma = fmaxf(n0[0], n0[1]), mb = fmaxf(n1[0], n1[1]);
  o[0] = MFMA(pa1, PK(vf[2], vf[3]), o[0]); o[2] = MFMA(pa1, ones, o[2]); MX3(ma, n0, 2); MX3(mb, n1, 2); MX3(ma, n0, 4); MX3(mb, n1, 4); SBAR();
  o[0] = MFMA(pa2, PK(vf[4], vf[5]), o[0]); o[2] = MFMA(pa2, ones, o[2]); MX3(ma, n0, 6); MX3(mb, n1, 6); MX3(ma, n0, 8); MX3(mb, n1, 8); MX3(ma, n0, 10); MX3(mb, n1, 10); SBAR();
  o[0] = MFMA(pa3, PK(vf[6], vf[7]), o[0]); o[2] = MFMA(pa3, ones, o[2]); MX3(ma, n0, 12); MX3(mb, n1, 12); MX3(ma, n0, 14); MX3(mb, n1, 14);
  float pmax = fmaxf(ma, mb);
  { auto rr = __builtin_amdgcn_permlane32_swap(__float_as_uint(pmax), __float_as_uint(pmax), false, false);
    pmax = fmaxf(__uint_as_float(rr[0]), __uint_as_float(rr[1])); }
  if (__builtin_expect(__all(pmax <= THR2), 1)) alpha = 1.f;
  else { const float d = fmaxf(pmax, 0.f); alpha = __builtin_amdgcn_exp2f(-d);
#pragma unroll
    for (int r = 0; r < 16; ++r) { n0[r] -= d; n1[r] -= d; mC[r] -= d; } }
#define EXP4(R) do { float e0 = __builtin_amdgcn_exp2f(n0[R]), e1 = __builtin_amdgcn_exp2f(n0[R + 1]), e2 = __builtin_amdgcn_exp2f(n0[R + 2]), e3 = __builtin_amdgcn_exp2f(n0[R + 3]); \
    asm volatile("" : "+v"(e0), "+v"(e1), "+v"(e2), "+v"(e3)); n0[R] = e0; n0[R + 1] = e1; n0[R + 2] = e2; n0[R + 3] = e3; } while (0)
  SBAR(); o[1] = MFMA(pa0, PK(vg[0], vg[1]), o[1]); EXP4(0); SBAR();
  o[1] = MFMA(pa1, PK(vg[2], vg[3]), o[1]); EXP4(4); SBAR();
  o[1] = MFMA(pa2, PK(vg[4], vg[5]), o[1]); EXP4(8); SBAR();
  o[1] = MFMA(pa3, PK(vg[6], vg[7]), o[1]); EXP4(12);
#undef EXP4
#undef MX3
}
template <int VO> __device__ __forceinline__ void pv_last(f32x16* o, const ATT_LAS unsigned char* vbp, bf16x8 pa0, bf16x8 pa1, bf16x8 pa2, bf16x8 pa3, bf16x8 ones) {
  s16x4 vf[8], vg[8];
#pragma unroll
  for (int ks = 0; ks < 4; ++ks) { vf[2 * ks] = VLD(0, ks, 0); vf[2 * ks + 1] = VLD(0, ks, 1); vg[2 * ks] = VLD(1, ks, 0); vg[2 * ks + 1] = VLD(1, ks, 1); }
  o[0] = MFMA(pa0, PK(vf[0], vf[1]), o[0]); o[1] = MFMA(pa0, PK(vg[0], vg[1]), o[1]); o[2] = MFMA(pa0, ones, o[2]);
  o[0] = MFMA(pa1, PK(vf[2], vf[3]), o[0]); o[1] = MFMA(pa1, PK(vg[2], vg[3]), o[1]); o[2] = MFMA(pa1, ones, o[2]);
  o[0] = MFMA(pa2, PK(vf[4], vf[5]), o[0]); o[1] = MFMA(pa2, PK(vg[4], vg[5]), o[1]); o[2] = MFMA(pa2, ones, o[2]);
  o[0] = MFMA(pa3, PK(vf[6], vf[7]), o[0]); o[1] = MFMA(pa3, PK(vg[6], vg[7]), o[1]); o[2] = MFMA(pa3, ones, o[2]);
}
#undef VLD
#undef PK
#undef MFMA

__device__ __forceinline__ void attn_unit(const unsigned short* Qb_, const unsigned short* Kn_, const unsigned short* Kr_, const unsigned short* Vc_, int ra, int nt_a, int rb, int NT,
                                          unsigned short* Ob_, ATT_LAS unsigned char* lds, int rope_t0) {
  gcp Qb = (gcp)Qb_, Kn = (gcp)Kn_, Kr = (gcp)Kr_, Vc = (gcp)Vc_; gp Ob = (gp)Ob_;
  const int tid = threadIdx.x, wid = tid >> 6, lane = tid & 63, r32 = lane & 31, hi = lane >> 5;
  ATT_LAS unsigned char* V_lds = lds + OFF_V; ATT_LAS unsigned char* K_lds = lds + OFF_K;
  ATT_LAS float* wsp = (ATT_LAS float*)(lds + OFF_WS) + wid * 64; ATT_LAS float* al_l = wsp + 32;
  f32x16 o[3] = {}, mC = {}; bf16x8 qr[DQ / 16]; const u32x4 ones_w = {0x3f803f80u, 0x3f803f80u, 0x3f803f80u, 0x3f803f80u}; const bf16x8 ones = __builtin_bit_cast(bf16x8, ones_w);
  const int sk = tid >> 3, sc = (tid & 7) * 8, rk = (tid & 255) >> 2, rc = (tid & 3) * 8; const bool rw = tid < 256;
  const int vst = v_st(sk, sc), kst0 = KSWZ(sk, sc * 2), kst1 = KSWZ(rk, (64 + rc) * 2);
  struct SR { bf16x8 vs, k0, k1; };
#define TROW(t) ((t) < nt_a ? ra + (t) * KVBLK : rb + ((t) - nt_a) * KVBLK)
#define SLOADX(S, t) do { const long r0_ = TROW(t); S.vs = *(const __attribute__((address_space(1))) bf16x8*)(Vc + (r0_ + sk) * LDV + sc); S.k0 = *(const __attribute__((address_space(1))) bf16x8*)(Kn + (r0_ + sk) * LDKN + sc); \
    S.k1 = *(const __attribute__((address_space(1))) bf16x8*)(Kr + (r0_ + rk) * LDKR + rc); } while (0)
#define SWRITEX(b, S) do { *(ATT_LAS bf16x8*)(V_lds + (b) * SHM_V + vst) = S.vs; *(ATT_LAS bf16x8*)(K_lds + (b) * SHM_K + kst0) = S.k0; \
    if (rw) *(ATT_LAS bf16x8*)(K_lds + (b) * SHM_K + kst1) = S.k1; } while (0)
  SR s0_, s1_, sr_; SLOADX(s0_, 0); SLOADX(s1_, 1); SLOADX(sr_, 2);
  gcp Qw = Qb + (long)(wid * QBLK + r32) * LDQ + hi * 8;
#pragma unroll
  for (int d0 = 0; d0 < DQ / 16; ++d0) qr[d0] = *(const __attribute__((address_space(1))) bf16x8*)(Qw + d0 * 16);
  if (rope_t0 >= 0) {
    int t = rope_t0 + wid * QBLK + r32; asm volatile("" : "+v"(t));
    const float prow = (float)(t >> 6), pcol = (float)(t & 63);
#pragma unroll
    for (int f = 0; f < 2; ++f) { const u32x4 own = __builtin_bit_cast(u32x4, qr[4 + f]); u32x4 oth;
      oth.x = (unsigned)__shfl_xor((int)own.x, 32); oth.y = (unsigned)__shfl_xor((int)own.y, 32); oth.z = (unsigned)__shfl_xor((int)own.z, 32); oth.w = (unsigned)__shfl_xor((int)own.w, 32);
      const float pos = f ? pcol : prow; float o8[8];
#pragma unroll
      for (int j = 0; j < 8; ++j) { const unsigned wo = (j < 2) ? own.x : (j < 4) ? own.y : (j < 6) ? own.z : own.w, wp = (j < 2) ? oth.x : (j < 4) ? oth.y : (j < 6) ? oth.z : oth.w;
        const float a = (j & 1) ? __uint_as_float(wo & 0xffff0000u) : __uint_as_float(wo << 16), bq = (j & 1) ? __uint_as_float(wp & 0xffff0000u) : __uint_as_float(wp << 16);
        const float ang = pos * __builtin_amdgcn_exp2f(-(float)j * (13.287712379549449f / 8.0f)); float sn, cs; __sincosf(ang, &sn, &cs);
        o8[j] = hi ? (a * cs + bq * sn) : (a * cs - bq * sn); }
      u32x4 w = {cvtpk(o8[0], o8[1]), cvtpk(o8[2], o8[3]), cvtpk(o8[4], o8[5]), cvtpk(o8[6], o8[7])}; qr[4 + f] = __builtin_bit_cast(bf16x8, w); } }
#pragma unroll
  for (int d0 = 0; d0 < DQ / 16; ++d0) { const u32x4 w = __builtin_bit_cast(u32x4, qr[d0]); u32x4 q;
#pragma unroll
    for (int i = 0; i < 4; ++i) q[i] = cvtpk(__uint_as_float(w[i] << 16) * QSC, __uint_as_float(w[i] & 0xffff0000u) * QSC);
    qr[d0] = __builtin_bit_cast(bf16x8, q); }
#define SLOAD(t) SLOADX(sr_, t)
#define SWRITE(b) SWRITEX(b, sr_)
#define SWAIT() asm volatile("s_waitcnt vmcnt(0)" ::: "memory")
#define BAR() asm volatile("s_barrier" ::: "memory")
#define RESC(a) do { if (__any((a) < 1.f)) { if (hi == 0) al_l[r32] = (a); asm volatile("s_waitcnt lgkmcnt(0)" ::: "memory"); \
    _Pragma("unroll") for (int d = 0; d < 3; ++d) _Pragma("unroll") for (int r = 0; r < 16; ++r) o[d][r] *= al_l[crow(r, hi)]; } } while (0)
#define KPRE(KB) do { KLDX(K_lds + (KB) * SHM_K, 0, kp.a0, kp.b0); KLDX(K_lds + (KB) * SHM_K, 1, kp.a1, kp.b1); } while (0)
  f32x16 pA0, pA1, pB0, pB1; float alA, alB; bf16x8 pa0, pa1, pa2, pa3; KPre kp; s16x4 vf[8];
  const ATT_LAS unsigned char* vbp = V_lds + v_rd_base(lane);
  SWAIT(); SWRITEX(0, s0_); SWRITEX(1, s1_); SWRITE(2); SLOAD(3); __syncthreads();
  qkt(pA0, pA1, mC, K_lds, qr, r32, hi); partialSM<true>(pA0, pA1, mC, alA);
  KPRE(1); BAR();
#define STEP(PN0, PN1, ALN, PO0, PO1, KB, VB, T, WR, LD, NX) do { \
    SBAR(); if (WR) { SWAIT(); SWRITE(((KB) + 2) & 3); } if (LD) SLOAD((T) + 3); SBAR(); \
    region1<(VB) * SHM_V>(PN0, PN1, mC, K_lds + (KB) * SHM_K, qr, r32, hi, kp, PO0, PO1, pa0, pa1, pa2, pa3, vbp, vf); SBAR(); \
    region2<(VB) * SHM_V>(o, vf, vbp, pa0, pa1, pa2, pa3, ones, PN0, PN1, mC, ALN); SBAR(); \
    if (NX) KPRE(((KB) + 1) & 3); RESC(ALN); BAR(); } while (0)
  int j = 1;
  for (; j + 3 < NT; j += 4) {
    STEP(pB0, pB1, alB, pA0, pA1, 1, 0, j, true, true, true);
    STEP(pA0, pA1, alA, pB0, pB1, 2, 1, j + 1, true, true, true);
    STEP(pB0, pB1, alB, pA0, pA1, 3, 2, j + 2, true, true, true);
    STEP(pA0, pA1, alA, pB0, pB1, 0, 3, j + 3, true, true, true);
  }
  STEP(pB0, pB1, alB, pA0, pA1, 1, 0, j, true, false, true);
  STEP(pA0, pA1, alA, pB0, pB1, 2, 1, j + 1, false, false, true);
  STEP(pB0, pB1, alB, pA0, pA1, 3, 2, j + 2, false, false, false);
  finishSM(pB0, pB1, pa0, pa1, pa2, pa3); SBAR();
  pv_last<3 * SHM_V>(o, vbp, pa0, pa1, pa2, pa3, ones);
  float rli[16];
#pragma unroll
  for (int r = 0; r < 16; ++r) rli[r] = __builtin_amdgcn_rcpf(o[2][r]);
  gp Ow = Ob + (long)(wid * QBLK) * LDO;
#pragma unroll
  for (int r = 0; r < 16; ++r) { const int orow = crow(r, hi);
#pragma unroll
    for (int d0 = 0; d0 < 2; ++d0) Ow[(long)orow * LDO + d0 * 32 + r32] = (unsigned short)(cvtpk(o[d0][r] * rli[r], 0.f) & 0xffffu); }
  asm volatile("s_waitcnt vmcnt(0)" ::: "memory");
  __syncthreads();
#undef TROW
#undef SLOAD
#undef SWRITE
#undef SLOADX
#undef SWRITEX
#undef STEP
#undef BAR
#undef KPRE
#undef SWAIT
#undef RESC
}
#undef KLDX
#undef KSWZ
#undef SBAR
}

namespace gla {
typedef short bf16x8 __attribute__((ext_vector_type(8)));
typedef short s16x4 __attribute__((ext_vector_type(4)));
typedef float f32x16 __attribute__((ext_vector_type(16)));
typedef float f32x4 __attribute__((ext_vector_type(4)));
typedef float f32x2 __attribute__((ext_vector_type(2)));
typedef __bf16 bf16x2_t __attribute__((ext_vector_type(2)));
typedef unsigned u32x4 __attribute__((ext_vector_type(4)));
typedef unsigned u32x2 __attribute__((ext_vector_type(2)));
#define GLA_LAS __attribute__((address_space(3)))
#define GLA_GAS __attribute__((address_space(1)))
constexpr int RS256 = 272, RS128 = 144;
constexpr int OFF_QT = 0, OFF_KT = 64 * RS256, OFF_KH = 2 * 64 * RS256, OFF_V = OFF_KH + 128 * RS128, OFF_P = OFF_V + 32768, OFF_TOT = OFF_P + 64 * RS128, OFF_EL = OFF_TOT + 2048, OFF_ZG = OFF_EL + 512, OFF_W2 = OFF_ZG + 4096, GLA_LDS = OFF_W2 + 8192;
static_assert(GLA_LDS <= 131072 && OFF_V % 16 == 0 && OFF_P % 16 == 0 && OFF_TOT % 16 == 0, "gla lds map");
__device__ __forceinline__ int swz256(int row, int colB) { return row * RS256 + colB; }
__device__ __forceinline__ int swz128(int row, int colB) { return row * RS128 + colB; }
__device__ __forceinline__ int crow(int r, int hi) { return (r & 3) + 8 * (r >> 2) + 4 * hi; }
__device__ __forceinline__ unsigned pk2f(float lo, float hi) { const f32x2 v = {lo, hi}; return __builtin_bit_cast(unsigned, __builtin_convertvector(v, bf16x2_t)); }
__device__ __forceinline__ unsigned short bf1f(float x) { return (unsigned short)(pk2f(x, 0.f) & 0xffffu); }
__device__ __forceinline__ float bfu(unsigned short u) { return __uint_as_float(((unsigned)u) << 16); }
__device__ __forceinline__ int v_st(int k, int c) { const int kk = (k & ~0xC) | ((k & 4) << 1) | ((k & 8) >> 1); return ((kk >> 3) * 8 + (c >> 5)) * 512 + ((kk & 7) * 32 + (c & 31)) * 2; }
__device__ __forceinline__ int v_rd_base(int lane) { return ((lane & 3) << 3) | (((lane >> 2) & 3) << 6) | (((lane >> 4) & 1) << 5) | (((lane >> 5) & 1) << 8); }
template <int OFF> __device__ __forceinline__ s16x4 tr_read(int vb) { s16x4 r; asm volatile("ds_read_b64_tr_b16 %0, %1 offset:%2" : "=&v"(r) : "v"(vb), "i"(OFF) : "memory"); return r; }
#define GLA_MFMA(a, b, c) __builtin_amdgcn_mfma_f32_32x32x16_bf16((a), (b), (c), 0, 0, 0)
__device__ __forceinline__ bf16x8 pack_step(const f32x16& x, int s) {
    u32x4 p; p.x = pk2f(x[8 * s], x[8 * s + 1]); p.y = pk2f(x[8 * s + 2], x[8 * s + 3]); p.z = pk2f(x[8 * s + 4], x[8 * s + 5]); p.w = pk2f(x[8 * s + 6], x[8 * s + 7]); return __builtin_bit_cast(bf16x8, p);
}
__device__ __forceinline__ void gla_prep(const unsigned short* QK_, const unsigned short* ZG_, const float* w2_, const float* b2_, unsigned short* TQ_, unsigned short* TK_, unsigned short* TP_, float* EL_,
                                         int b, int h, int dir, int c_lo, int c_hi, int ML_, int SEQ_, int CTX_, GLA_LAS unsigned char* lds) {
    const GLA_GAS unsigned short* QK = (const GLA_GAS unsigned short*)QK_; const GLA_GAS unsigned short* ZG = (const GLA_GAS unsigned short*)ZG_;
    const GLA_GAS float* w2g = (const GLA_GAS float*)w2_; const GLA_GAS float* b2g = (const GLA_GAS float*)b2_;
    const int tid = threadIdx.x, wid = __builtin_amdgcn_readfirstlane(tid >> 6), lane = tid & 63, r32 = lane & 31, hi = lane >> 5;
    const int seg = tid >> 7, kk = tid & 127;
    GLA_LAS unsigned char* QT = lds + OFF_QT; GLA_LAS unsigned char* KT = lds + OFF_KT;
    GLA_LAS float* TOT = (GLA_LAS float*)(lds + OFF_TOT); GLA_LAS float* ZGS = (GLA_LAS float*)(lds + OFF_ZG); GLA_LAS float* W2S = (GLA_LAS float*)(lds + OFF_W2);
    __syncthreads();
#pragma unroll
    for (int i = 0; i < 4; ++i) { const int idx = tid + 512 * i; W2S[idx] = w2g[(size_t)(dir * 16 + (idx >> 7)) * 512 + h * 128 + (idx & 127)]; }
    const float b2 = b2g[dir * 512 + h * 128 + kk];
    const int nctx = CTX_ / 64;
    GLA_LAS unsigned* RAW = (GLA_LAS unsigned*)(lds + OFF_V);
    u32x4 sq0, sq1, sk0, sk1; unsigned zgw;
#define GLA_PLOAD(cs_) do { const long r0_ = ((cs_) < nctx) ? (long)ML_ + (long)b * CTX_ + 64 * (cs_) : (long)b * SEQ_ + 64 * ((cs_) - nctx); \
        zgw = *(const GLA_GAS unsigned*)(ZG + (r0_ + (tid >> 3)) * 2304 + dir * 16 + (tid & 7) * 2); \
        const GLA_GAS unsigned short* zr_ = QK + (r0_ + (tid >> 3)) * 1024 + h * 128 + 16 * (tid & 7); \
        sq0 = *(const GLA_GAS u32x4*)(zr_); sq1 = *(const GLA_GAS u32x4*)(zr_ + 8); sk0 = *(const GLA_GAS u32x4*)(zr_ + 512); sk1 = *(const GLA_GAS u32x4*)(zr_ + 520); } while (0)
    GLA_PLOAD(c_lo);
    for (int cs = c_lo; cs < c_hi; ++cs) {
        { u32x4 w0, w1, w2, w3;
#define GLA_IL(W, QW, KW, J) W[2 * (J)] = __builtin_amdgcn_perm(KW[J], QW[J], 0x05040100u); W[2 * (J) + 1] = __builtin_amdgcn_perm(KW[J], QW[J], 0x07060302u)
          { unsigned t_[8];
#define GLA_IL4(QW, KW) do { _Pragma("unroll") for (int j_ = 0; j_ < 4; ++j_) { t_[2 * j_] = __builtin_amdgcn_perm(KW[j_], QW[j_], 0x05040100u); t_[2 * j_ + 1] = __builtin_amdgcn_perm(KW[j_], QW[j_], 0x07060302u); } } while (0)
            GLA_IL4(sq0, sk0); w0 = u32x4{t_[0], t_[1], t_[2], t_[3]}; w1 = u32x4{t_[4], t_[5], t_[6], t_[7]};
            GLA_IL4(sq1, sk1); w2 = u32x4{t_[0], t_[1], t_[2], t_[3]}; w3 = u32x4{t_[4], t_[5], t_[6], t_[7]}; }
#undef GLA_IL4
#undef GLA_IL
          GLA_LAS u32x4* dst = (GLA_LAS u32x4*)(RAW + (tid >> 3) * 128 + 16 * (tid & 7)); dst[0] = w0; dst[1] = w1; dst[2] = w2; dst[3] = w3; }
        const size_t tile = (size_t)((b * 4 + h) * 2 + dir) * 36 + cs;
        GLA_GAS unsigned short* TQ = (GLA_GAS unsigned short*)TQ_ + tile * 8192; GLA_GAS unsigned short* TK = (GLA_GAS unsigned short*)TK_ + tile * 8192; GLA_GAS unsigned short* TP = (GLA_GAS unsigned short*)TP_ + tile * 4096;
        { const int l = tid >> 3, r2 = (tid & 7) * 2; ZGS[l * 16 + r2] = __uint_as_float(zgw << 16); ZGS[l * 16 + r2 + 1] = __uint_as_float(zgw & 0xffff0000u); }
        if (cs + 1 < c_hi) GLA_PLOAD(cs + 1);
        __syncthreads();
        unsigned raw[16];
#pragma unroll
        for (int i = 0; i < 16; ++i) raw[i] = RAW[(16 * seg + i) * 128 + kk];
        float cum[16];
#pragma unroll
        for (int i = 0; i < 16; ++i) cum[i] = b2;
#pragma unroll
        for (int q = 0; q < 4; ++q) { const float wa = W2S[(4 * q) * 128 + kk], wb = W2S[(4 * q + 1) * 128 + kk], wc_ = W2S[(4 * q + 2) * 128 + kk], wd = W2S[(4 * q + 3) * 128 + kk];
#pragma unroll
            for (int i = 0; i < 16; ++i) { const f32x4 z = *(const GLA_LAS f32x4*)(ZGS + (16 * seg + i) * 16 + 4 * q); cum[i] += z.x * wa + z.y * wb + z.z * wc_ + z.w * wd; } }
#pragma unroll
        for (int i = 0; i < 16; ++i) { const float x = cum[i]; cum[i] = (fminf(x, 0.f) - __logf(1.0f + __expf(-fabsf(x)))) * (1.0f / 16.0f); }
        if (dir == 0) {
#pragma unroll
            for (int i = 1; i < 16; ++i) cum[i] += cum[i - 1];
            TOT[seg * 128 + kk] = cum[15];
        } else {
#pragma unroll
            for (int i = 14; i >= 0; --i) cum[i] += cum[i + 1];
            TOT[seg * 128 + kk] = cum[0];
        }
        __syncthreads();
        { const float t0 = TOT[kk], t1 = TOT[128 + kk], t2 = TOT[256 + kk], t3 = TOT[384 + kk]; const float last = (t0 + t1) + (t2 + t3);
          float off;
          if (dir == 0) off = (seg > 0 ? t0 : 0.f) + (seg > 1 ? t1 : 0.f) + (seg > 2 ? t2 : 0.f);
          else off = (seg < 3 ? t3 : 0.f) + (seg < 2 ? t2 : 0.f) + (seg < 1 ? t1 : 0.f);
          if (seg == 0) ((GLA_GAS float*)EL_)[tile * 128 + kk] = __expf(last);
          unsigned ktp[8];
#pragma unroll
          for (int i = 0; i < 16; i += 2) {
              const float c0 = cum[i] + off, c1 = cum[i + 1] + off; const int l0 = 16 * seg + i, l1 = l0 + 1;
              const float q0 = __uint_as_float(raw[i] << 16), k0v = __uint_as_float(raw[i] & 0xffff0000u), q1 = __uint_as_float(raw[i + 1] << 16), k1v = __uint_as_float(raw[i + 1] & 0xffff0000u);
              const unsigned short qa = bf1f(q0 * __expf(c0)), qb = bf1f(q1 * __expf(c1)); const float ka = k0v * __expf(-c0), kb = k1v * __expf(-c1); const unsigned kp = pk2f(ka, kb);
              *(GLA_LAS unsigned short*)(QT + swz256(l0, 2 * kk)) = qa; *(GLA_LAS unsigned short*)(QT + swz256(l1, 2 * kk)) = qb;
              *(GLA_LAS unsigned short*)(KT + swz256(l0, 2 * kk)) = (unsigned short)(kp & 0xffffu); *(GLA_LAS unsigned short*)(KT + swz256(l1, 2 * kk)) = (unsigned short)(kp >> 16);
              TQ[l0 * 128 + kk] = qa; TQ[l1 * 128 + kk] = qb; ktp[i >> 1] = kp; }
          u32x4 k0 = {ktp[0], ktp[1], ktp[2], ktp[3]}, k1 = {ktp[4], ktp[5], ktp[6], ktp[7]};
          *(GLA_GAS u32x4*)(TK + kk * 64 + 16 * seg) = k0; *(GLA_GAS u32x4*)(TK + kk * 64 + 16 * seg + 8) = k1; }
        __syncthreads();
        if (wid < 4) { const int mi = wid >> 1, li = wid & 1; f32x16 x = f32x16{};
#pragma unroll
            for (int s2 = 0; s2 < 8; ++s2) { const int cb = (16 * s2 + 8 * hi) * 2;
                const bf16x8 a = *(const GLA_LAS bf16x8*)(KT + swz256(32 * mi + r32, cb)); const bf16x8 bq = *(const GLA_LAS bf16x8*)(QT + swz256(32 * li + r32, cb)); x = GLA_MFMA(a, bq, x); }
            const int l = 32 * li + r32;
#pragma unroll
            for (int g = 0; g < 4; ++g) { float v[4];
#pragma unroll
                for (int j = 0; j < 4; ++j) { const int m = 32 * mi + 8 * g + 4 * hi + j; const bool keep = (dir == 0) ? (m <= l) : (m >= l); v[j] = keep ? x[4 * g + j] : 0.f; }
                u32x2 w; w.x = pk2f(v[0], v[1]); w.y = pk2f(v[2], v[3]); *(GLA_GAS u32x2*)(TP + l * 64 + 32 * mi + 8 * g + 4 * hi) = w; } }
    }
#undef GLA_PLOAD
    __syncthreads();
}
__device__ __forceinline__ void gla_chain(const unsigned short* VR_, const unsigned short* TQ_, const unsigned short* TK_, const unsigned short* TP_, const float* EL_, unsigned short* O_, int b, int h, int dir,
                                          int ML_, int SEQ_, int CTX_, GLA_LAS unsigned char* lds) {
    const GLA_GAS unsigned short* VR = (const GLA_GAS unsigned short*)VR_; GLA_GAS unsigned short* O = (GLA_GAS unsigned short*)O_;
    const int tid = threadIdx.x, wid = __builtin_amdgcn_readfirstlane(tid >> 6), lane = tid & 63, r32 = lane & 31, hi = lane >> 5;
    GLA_LAS unsigned char* QT = lds + OFF_QT; GLA_LAS unsigned char* KH = lds + OFF_KH; GLA_LAS unsigned char* VI = lds + OFF_V; GLA_LAS unsigned char* PI = lds + OFF_P; GLA_LAS float* EL = (GLA_LAS float*)(lds + OFF_EL);
    f32x16 S[4];
#pragma unroll
    for (int t = 0; t < 4; ++t) S[t] = f32x16{};
    const int vb = (int)(unsigned)(uintptr_t)VI + v_rd_base(lane) + wid * 512;
    const int nchunk = (CTX_ + SEQ_) / 64, nctx = CTX_ / 64;
    const size_t tile0 = (size_t)((b * 4 + h) * 2 + dir) * 36;
    u32x4 pq[2], pk[2], pp, pv[4]; float pe = 0.f;
#define GLA_CS(sc_) ((dir == 0) ? (sc_) : (((sc_) < nctx) ? (nctx - 1 - (sc_)) : (nchunk - 1 - ((sc_) - nctx))))
#define GLA_FETCH(sc_) do { const int cs_ = GLA_CS(sc_); const size_t t_ = tile0 + cs_; const long r0_ = (cs_ < nctx) ? (long)ML_ + (long)b * CTX_ + 64 * cs_ : (long)b * SEQ_ + 64 * (cs_ - nctx); \
        const GLA_GAS u32x4* q_ = (const GLA_GAS u32x4*)((const GLA_GAS unsigned short*)TQ_ + t_ * 8192); const GLA_GAS u32x4* k_ = (const GLA_GAS u32x4*)((const GLA_GAS unsigned short*)TK_ + t_ * 8192); \
        pq[0] = q_[tid]; pq[1] = q_[tid + 512]; pk[0] = k_[tid]; pk[1] = k_[tid + 512]; pp = ((const GLA_GAS u32x4*)((const GLA_GAS unsigned short*)TP_ + t_ * 4096))[tid]; \
        if (tid < 128) pe = ((const GLA_GAS float*)EL_)[t_ * 128 + tid]; \
        _Pragma("unroll") for (int i_ = 0; i_ < 4; ++i_) { const int c_ = tid + 512 * i_; pv[i_] = *(const GLA_GAS u32x4*)(VR + (r0_ + (c_ >> 5)) * 2304 + h * 256 + (c_ & 31) * 8); } } while (0)
    GLA_FETCH(0);
    for (int sc = 0; sc < nchunk; ++sc) {
        const int cs = GLA_CS(sc); const bool is_lat = cs >= nctx; const long row0 = is_lat ? (long)b * SEQ_ + 64 * (cs - nctx) : (long)ML_ + (long)b * CTX_ + 64 * cs;
#pragma unroll
        for (int i = 0; i < 2; ++i) { const int c = tid + 512 * i; *(GLA_LAS u32x4*)(QT + (c >> 4) * RS256 + (c & 15) * 16) = pq[i]; *(GLA_LAS u32x4*)(KH + (c >> 3) * RS128 + (c & 7) * 16) = pk[i]; }
        *(GLA_LAS u32x4*)(PI + (tid >> 3) * RS128 + (tid & 7) * 16) = pp;
        if (tid < 128) EL[tid] = pe;
#pragma unroll
        for (int i = 0; i < 4; ++i) { const int c = tid + 512 * i; *(GLA_LAS u32x4*)(VI + v_st(c >> 5, (c & 31) * 8)) = pv[i]; }
        __syncthreads();
        if (sc + 1 < nchunk) GLA_FETCH(sc + 1);
        f32x16 o[2] = {f32x16{}, f32x16{}};
#pragma unroll
        for (int kt = 0; kt < 4; ++kt)
#pragma unroll
            for (int s2 = 0; s2 < 2; ++s2) { const bf16x8 bs = pack_step(S[kt], s2); const int cb0 = (32 * kt + 16 * s2 + 4 * hi) * 2;
#pragma unroll
                for (int rb = 0; rb < 2; ++rb) { const int l = 32 * rb + r32;
                    const s16x4 a0 = *(const GLA_LAS s16x4*)(QT + swz256(l, cb0)), a1 = *(const GLA_LAS s16x4*)(QT + swz256(l, cb0 + 16));
                    const bf16x8 a = {a0[0], a0[1], a0[2], a0[3], a1[0], a1[1], a1[2], a1[3]}; o[rb] = GLA_MFMA(a, bs, o[rb]); } }
        bf16x8 vf[4];
        { const s16x4 l0 = tr_read<0 * 8192>(vb), h0 = tr_read<0 * 8192 + 4096>(vb), l1 = tr_read<1 * 8192>(vb), h1 = tr_read<1 * 8192 + 4096>(vb);
          const s16x4 l2 = tr_read<2 * 8192>(vb), h2 = tr_read<2 * 8192 + 4096>(vb), l3 = tr_read<3 * 8192>(vb), h3 = tr_read<3 * 8192 + 4096>(vb);
          asm volatile("s_waitcnt lgkmcnt(0)" ::: "memory"); __builtin_amdgcn_sched_barrier(0);
          vf[0] = (bf16x8){l0[0], l0[1], l0[2], l0[3], h0[0], h0[1], h0[2], h0[3]}; vf[1] = (bf16x8){l1[0], l1[1], l1[2], l1[3], h1[0], h1[1], h1[2], h1[3]};
          vf[2] = (bf16x8){l2[0], l2[1], l2[2], l2[3], h2[0], h2[1], h2[2], h2[3]}; vf[3] = (bf16x8){l3[0], l3[1], l3[2], l3[3], h3[0], h3[1], h3[2], h3[3]}; }
#pragma unroll
        for (int rb = 0; rb < 2; ++rb)
#pragma unroll
            for (int ks = 0; ks < 4; ++ks) { const bf16x8 a = *(const GLA_LAS bf16x8*)(PI + swz128(32 * rb + r32, (16 * ks + 8 * hi) * 2)); o[rb] = GLA_MFMA(a, vf[ks], o[rb]); }
        if (is_lat) {
#pragma unroll
            for (int rb = 0; rb < 2; ++rb)
#pragma unroll
                for (int r = 0; r < 16; ++r) O[(row0 + 32 * rb + crow(r, hi)) * 1024 + h * 256 + 32 * wid + r32] = bf1f(o[rb][r]); }
#pragma unroll
        for (int kt = 0; kt < 4; ++kt) {
#pragma unroll
            for (int ks = 0; ks < 4; ++ks) { const bf16x8 a = *(const GLA_LAS bf16x8*)(KH + swz128(32 * kt + r32, (16 * ks + 8 * hi) * 2)); S[kt] = GLA_MFMA(a, vf[ks], S[kt]); }
#pragma unroll
            for (int r = 0; r < 16; ++r) S[kt][r] *= EL[32 * kt + crow(r, hi)]; }
        __syncthreads();
    }
#undef GLA_FETCH
#undef GLA_CS
}
__device__ __forceinline__ int v_st4(int k, int c) { const int kk = (k & ~0xC) | ((k & 4) << 1) | ((k & 8) >> 1); return ((kk >> 3) * 4 + (c >> 5)) * 512 + ((kk & 7) * 32 + (c & 31)) * 2; }
constexpr int OFF_XO_A = OFF_KT, OFF_XO_B = OFF_V + 16384;
static_assert(OFF_XO_A + 16384 <= OFF_KH && OFF_XO_B + 16384 <= OFF_P, "gla chain2 lds map");
__device__ __forceinline__ void gla_chain2(const unsigned short* VR_, const unsigned short* TQ_, const unsigned short* TK_, const unsigned short* TP_, const float* EL_, unsigned short* O_, int b, int h, int dir, int vh,
                                           int ML_, int SEQ_, int CTX_, GLA_LAS unsigned char* lds) {
    const GLA_GAS unsigned short* VR = (const GLA_GAS unsigned short*)VR_; GLA_GAS unsigned short* O = (GLA_GAS unsigned short*)O_;
    const int tid = threadIdx.x, wid = __builtin_amdgcn_readfirstlane(tid >> 6), lane = tid & 63, r32 = lane & 31, hi = lane >> 5;
    const int vt = wid & 3, kh = wid >> 2;
    GLA_LAS unsigned char* QT = lds + OFF_QT; GLA_LAS unsigned char* KH = lds + OFF_KH; GLA_LAS unsigned char* VI = lds + OFF_V; GLA_LAS unsigned char* PI = lds + OFF_P; GLA_LAS float* EL = (GLA_LAS float*)(lds + OFF_EL);
    GLA_LAS f32x4* XOs = (GLA_LAS f32x4*)(lds + (wid < 4 ? OFF_XO_A + wid * 4096 : OFF_XO_B + (wid - 4) * 4096));
    GLA_LAS f32x4* XOr = (GLA_LAS f32x4*)(lds + ((wid ^ 4) < 4 ? OFF_XO_A + (wid ^ 4) * 4096 : OFF_XO_B + ((wid ^ 4) - 4) * 4096));
    f32x16 S[2] = {f32x16{}, f32x16{}};
    const int vb = (int)(unsigned)(uintptr_t)VI + v_rd_base(lane) + vt * 512;
    const int nchunk = (CTX_ + SEQ_) / 64, nctx = CTX_ / 64;
    const size_t tile0 = (size_t)((b * 4 + h) * 2 + dir) * 36;
    u32x4 pq[2], pk[2], pp, pv[2]; float pe = 0.f;
#define GLA_CS(sc_) ((dir == 0) ? (sc_) : (((sc_) < nctx) ? (nctx - 1 - (sc_)) : (nchunk - 1 - ((sc_) - nctx))))
#define GLA_FETCH(sc_) do { const int cs_ = GLA_CS(sc_); const size_t t_ = tile0 + cs_; const long r0_ = (cs_ < nctx) ? (long)ML_ + (long)b * CTX_ + 64 * cs_ : (long)b * SEQ_ + 64 * (cs_ - nctx); \
        const GLA_GAS u32x4* q_ = (const GLA_GAS u32x4*)((const GLA_GAS unsigned short*)TQ_ + t_ * 8192); const GLA_GAS u32x4* k_ = (const GLA_GAS u32x4*)((const GLA_GAS unsigned short*)TK_ + t_ * 8192); \
        pq[0] = q_[tid]; pq[1] = q_[tid + 512]; pk[0] = k_[tid]; pk[1] = k_[tid + 512]; pp = ((const GLA_GAS u32x4*)((const GLA_GAS unsigned short*)TP_ + t_ * 4096))[tid]; \
        if (tid < 128) pe = ((const GLA_GAS float*)EL_)[t_ * 128 + tid]; \
        _Pragma("unroll") for (int i_ = 0; i_ < 2; ++i_) { const int c_ = tid + 512 * i_; pv[i_] = *(const GLA_GAS u32x4*)(VR + (r0_ + (c_ >> 4)) * 2304 + h * 256 + vh * 128 + (c_ & 15) * 8); } } while (0)
    GLA_FETCH(0);
    for (int sc = 0; sc < nchunk; ++sc) {
        const int cs = GLA_CS(sc); const bool is_lat = cs >= nctx; const long row0 = is_lat ? (long)b * SEQ_ + 64 * (cs - nctx) : (long)ML_ + (long)b * CTX_ + 64 * cs;
#pragma unroll
        for (int i = 0; i < 2; ++i) { const int c = tid + 512 * i; *(GLA_LAS u32x4*)(QT + (c >> 4) * RS256 + (c & 15) * 16) = pq[i]; *(GLA_LAS u32x4*)(KH + (c >> 3) * RS128 + (c & 7) * 16) = pk[i];
            *(GLA_LAS u32x4*)(VI + v_st4(c >> 4, (c & 15) * 8)) = pv[i]; }
        *(GLA_LAS u32x4*)(PI + (tid >> 3) * RS128 + (tid & 7) * 16) = pp;
        if (tid < 128) EL[tid] = pe;
        __syncthreads();
        if (sc + 1 < nchunk) GLA_FETCH(sc + 1);
        f32x16 op[2] = {f32x16{}, f32x16{}};
#pragma unroll
        for (int j = 0; j < 2; ++j)
#pragma unroll
            for (int s2 = 0; s2 < 2; ++s2) { const bf16x8 bs = pack_step(S[j], s2); const int cb0 = (32 * (2 * kh + j) + 16 * s2 + 4 * hi) * 2;
#pragma unroll
                for (int rb = 0; rb < 2; ++rb) { const int l = 32 * rb + r32;
                    const s16x4 a0 = *(const GLA_LAS s16x4*)(QT + swz256(l, cb0)), a1 = *(const GLA_LAS s16x4*)(QT + swz256(l, cb0 + 16));
                    const bf16x8 a = {a0[0], a0[1], a0[2], a0[3], a1[0], a1[1], a1[2], a1[3]}; op[rb] = GLA_MFMA(a, bs, op[rb]); } }
        { const f32x16& snd = kh ? op[0] : op[1];
#pragma unroll
          for (int g = 0; g < 4; ++g) XOs[g * 64 + lane] = (f32x4){snd[4 * g], snd[4 * g + 1], snd[4 * g + 2], snd[4 * g + 3]}; }
        __syncthreads();
        f32x16 o = kh ? op[1] : op[0];
#pragma unroll
        for (int g = 0; g < 4; ++g) { const f32x4 rv = XOr[g * 64 + lane]; o[4 * g] += rv.x; o[4 * g + 1] += rv.y; o[4 * g + 2] += rv.z; o[4 * g + 3] += rv.w; }
        bf16x8 vf[4];
        { const s16x4 l0 = tr_read<0 * 4096>(vb), h0 = tr_read<0 * 4096 + 2048>(vb), l1 = tr_read<1 * 4096>(vb), h1 = tr_read<1 * 4096 + 2048>(vb);
          const s16x4 l2 = tr_read<2 * 4096>(vb), h2 = tr_read<2 * 4096 + 2048>(vb), l3 = tr_read<3 * 4096>(vb), h3 = tr_read<3 * 4096 + 2048>(vb);
          asm volatile("s_waitcnt lgkmcnt(0)" ::: "memory"); __builtin_amdgcn_sched_barrier(0);
          vf[0] = (bf16x8){l0[0], l0[1], l0[2], l0[3], h0[0], h0[1], h0[2], h0[3]}; vf[1] = (bf16x8){l1[0], l1[1], l1[2], l1[3], h1[0], h1[1], h1[2], h1[3]};
          vf[2] = (bf16x8){l2[0], l2[1], l2[2], l2[3], h2[0], h2[1], h2[2], h2[3]}; vf[3] = (bf16x8){l3[0], l3[1], l3[2], l3[3], h3[0], h3[1], h3[2], h3[3]}; }
#pragma unroll
        for (int ks = 0; ks < 4; ++ks) { const bf16x8 a = *(const GLA_LAS bf16x8*)(PI + swz128(32 * kh + r32, (16 * ks + 8 * hi) * 2)); o = GLA_MFMA(a, vf[ks], o); }
        if (is_lat) {
#pragma unroll
            for (int r = 0; r < 16; ++r) O[(row0 + 32 * kh + crow(r, hi)) * 1024 + h * 256 + vh * 128 + 32 * vt + r32] = bf1f(o[r]); }
#pragma unroll
        for (int j = 0; j < 2; ++j) { const int kt = 2 * kh + j;
#pragma unroll
            for (int ks = 0; ks < 4; ++ks) { const bf16x8 a = *(const GLA_LAS bf16x8*)(KH + swz128(32 * kt + r32, (16 * ks + 8 * hi) * 2)); S[j] = GLA_MFMA(a, vf[ks], S[j]); }
#pragma unroll
            for (int r = 0; r < 16; ++r) S[j][r] *= EL[32 * kt + crow(r, hi)]; }
        __syncthreads();
    }
#undef GLA_FETCH
#undef GLA_CS
}
#undef GLA_MFMA
}

constexpr int NWAVES = 8;
constexpr int D = 1024, NB = 16, SEQ = 2048, CTXL = 256, TT = SEQ + CTXL;
constexpr int ML = NB * SEQ, MC = NB * CTXL, MA = ML + MC;
constexpr float EPS = 1e-6f;
constexpr int S5W = 512, S5G = 32, S5H = 16, S5P = 64;
constexpr int NH = 8, NOPE = 64, ROPE = 32, QK = 96, VD = 64, QRANK = 256, KVRANK = 128;
constexpr int EV_IN = 928, EV_INP = 1024, NQKV = 1792, KQKV = 384;
constexpr int GH = 4, GDK = 128, GDV = 256, GKEY = 512, GVAL = 1024, GRANK = 16;
constexpr int OD_IN = 3104, OD_INP = 3328;
constexpr int FFN = 2816, NE = 8, FE = 3584;
constexpr int MOE_MAXT = 264;

constexpr size_t MiB = 1u << 20;
constexpr size_t WS_CTL = 0, CTL_ZERO_BYTES = 1 * MiB;
constexpr size_t WS_MODV = 1 * MiB;
constexpr size_t WS_TOK = 2 * MiB;
constexpr size_t WS_INV = 3 * MiB;
constexpr size_t WS_W_IN1 = 4 * MiB, WS_W_OUT1 = 11 * MiB, WS_W_MGU = 13 * MiB  , WS_W_MDN = 69 * MiB  ;
constexpr size_t WS_W_IN0 = 97 * MiB, WS_W_QKV = 99 * MiB, WS_W_GLU = 100 * MiB + 512 * 1024, WS_W_OUT0 = 101 * MiB, WS_W_GU = 103 * MiB, WS_W_DN = 114 * MiB, WS_HC = 120 * MiB;
constexpr size_t PB = 136 * MiB;
constexpr size_t WS_XL = PB + 0 * MiB, WS_Q = PB + 0 * MiB, WS_A3 = PB + 72 * MiB, WS_YL = PB + 72 * MiB, WS_KV = PB + 144 * MiB, WS_Z0C = PB + 144 * MiB, WS_U = PB + 180 * MiB, WS_DS = PB + 216 * MiB, WS_AO = PB + 216 * MiB,
                 WS_QA = PB + 288 * MiB, WS_AG = PB + 288 * MiB, WS_KR = PB + 324 * MiB, WS_B1 = PB + 328 * MiB, WS_B3 = PB + 332 * MiB;
constexpr size_t WS_ACT = PB + 72 * MiB, WS_FL = PB + 270 * MiB;
constexpr size_t WS_TP = 97 * MiB, WS_EL = 133 * MiB, WS_OF = PB, WS_VR = 208 * MiB, WS_QK = 370 * MiB, WS_OB = 370 * MiB, WS_YL1 = 370 * MiB, WS_TQ = 442 * MiB, WS_TK = 514 * MiB;
constexpr int VRLD = 2304;
constexpr int GLA_TILES = NB * GH * 2 * 36;
constexpr int MOE_W_ITEMS = NE * (2 * (D / 64) * (FE / 32) + (FE / 64) * (D / 32));
constexpr int MW0 = 0, MW1 = (MOE_W_ITEMS * 20) / 100, MW2 = (MOE_W_ITEMS * 40) / 100, MW3 = (MOE_W_ITEMS * 54) / 100, MW4 = (MOE_W_ITEMS * 82) / 100, MW5 = MOE_W_ITEMS;
constexpr size_t WS_XLM = PB + 0 * MiB, WS_Y = PB + 0 * MiB, WS_XG = PB + 132 * MiB, WS_ACTM = PB + 198 * MiB;
constexpr size_t WS_END = 588 * MiB;
static_assert(WS_KR + (size_t)MA * 32 * 2 <= WS_B1 && WS_KV + (size_t)MA * 1024 * 2 <= WS_DS && WS_AG + (size_t)MA * 512 * 2 <= WS_KR && WS_AO + (size_t)MA * D * 2 <= WS_AG && WS_A3 + (size_t)MA * 1024 * 2 <= WS_KV &&
              WS_Z0C + (size_t)MA * 512 * 2 <= WS_U && WS_U + (size_t)MA * 512 * 2 <= WS_DS && WS_DS + (size_t)MA * 512 * 4 <= WS_QA && WS_QA + (size_t)MA * KQKV * 2 <= WS_KR && WS_B1 + (size_t)32 * 256 * 256 * 2 <= WS_B3 && WS_B3 + (size_t)32 * 256 * 512 * 2 <= WS_END, "ws map");
static_assert(WS_FL + (size_t)MA * D * 2 <= WS_END && WS_ACT + (size_t)MA * FFN * 2 <= WS_FL, "ws map 2");
static_assert(WS_TP + (size_t)GLA_TILES * 8192 <= WS_EL && WS_EL + (size_t)GLA_TILES * 512 <= PB && WS_XL + (size_t)MA * D * 2 <= WS_VR && WS_VR + (size_t)MA * VRLD * 2 <= WS_QK && WS_QK + (size_t)MA * 1024 * 2 <= WS_TQ &&
              WS_TQ + (size_t)GLA_TILES * 16384 <= WS_TK && WS_TK + (size_t)GLA_TILES * 16384 <= WS_END && WS_OF + (size_t)ML * D * 2 <= WS_VR && WS_OB + (size_t)ML * D * 2 <= WS_TQ, "ws map layer 1");
static_assert(WS_Y + (size_t)MOE_MAXT * 256 * D * 2 <= WS_XG && WS_XG + (size_t)MOE_MAXT * 256 * D <= WS_ACTM && WS_ACTM + (size_t)MOE_MAXT * 256 * FE <= WS_END && WS_XLM + (size_t)ML * D <= WS_XG, "ws map 3");
static_assert(WS_W_IN1 + (size_t)OD_INP * D * 2 <= WS_W_OUT1 && WS_W_OUT1 + (size_t)D * D * 2 <= WS_W_MGU && WS_W_MGU + (size_t)NE * 2 * FE * D <= WS_W_MDN && WS_W_MDN + (size_t)NE * D * FE <= WS_W_IN0 &&
              WS_W_GU + (size_t)2 * FFN * D * 2 <= WS_W_DN && WS_W_DN + (size_t)D * FFN * 2 <= WS_HC && WS_HC + (size_t)MC * D * 4 <= PB, "ws map 4");
#ifndef FFN0_FP8
#define FFN0_FP8 0
#endif
constexpr bool FFN0_IS_FP8 = FFN0_FP8;
#ifndef FFN0_DOWN_FP8
#define FFN0_DOWN_FP8 1
#endif
constexpr bool FFN0_DN_FP8 = FFN0_DOWN_FP8;
constexpr float FP8_SA = 8.0f, FP8_SW = 128.0f, FP8_SACT = 4.0f;

constexpr int CW_TMO = 0, CW_CODE = 1, CW_CNT = 64, CW_BAR = 4096;

constexpr int RING_OFF = 0, RING_BYTES = 131072;
constexpr int ATAB_OFF = RING_BYTES + 1024, ATAB_UNITS = 29;
constexpr int LDSCTL_OFF = RING_BYTES, MISC_OFF = LDSCTL_OFF + 320;
constexpr int LDS_BYTES = 147456;
static_assert(ATAB_OFF + ATAB_UNITS * 512 <= LDS_BYTES, "LDS map: row table");

struct Args { const float* in[35]; float* out; unsigned char* ws; int ph_lo, ph_hi; };
struct Frame { LAS unsigned char* lds; volatile LAS unsigned* MISC; gu32* ctl; int tid, lane, wave, G, gw, ngw; };

__device__ __forceinline__ float wave_sum(float v) {
#pragma unroll
    for (int o = 1; o < 64; o <<= 1) v += __shfl_xor(v, o);
    return v;
}
__device__ __forceinline__ float bf_lo(unsigned u) { return __uint_as_float(u << 16); }
__device__ __forceinline__ float bf_hi(unsigned u) { return __uint_as_float(u & 0xffff0000u); }
__device__ __forceinline__ float bf1(bf16 u) { return __uint_as_float(((unsigned)u) << 16); }
typedef unsigned v2u __attribute__((ext_vector_type(2)));
__device__ __forceinline__ unsigned pk4_fp8(float a, float b, float c, float d) { return pg8::pk4_fp8(a, b, c, d); }

__device__ __forceinline__ void ld_row_f32(const float* p, int lane, f32x4 (&v)[4]) {
    const GAS f32x4* q = (const GAS f32x4*)p + lane;
#pragma unroll
    for (int j = 0; j < 4; ++j) v[j] = q[64 * j];
}
__device__ __forceinline__ void st_row_f32(float* p, int lane, const f32x4 (&v)[4]) {
    GAS f32x4* q = (GAS f32x4*)p + lane;
#pragma unroll
    for (int j = 0; j < 4; ++j) q[64 * j] = v[j];
}
__device__ __forceinline__ void ld_row_bf16(const bf16* p, int lane, f32x4 (&v)[4]) {
    const GAS v2u* q = (const GAS v2u*)p + lane;
#pragma unroll
    for (int j = 0; j < 4; ++j) { const v2u w = q[64 * j]; v[j] = (f32x4){bf_lo(w.x), bf_hi(w.x), bf_lo(w.y), bf_hi(w.y)}; }
}
__device__ __forceinline__ void st_row_bf16(bf16* p, int lane, const f32x4 (&v)[4]) {
    GAS v2u* q = (GAS v2u*)p + lane;
#pragma unroll
    for (int j = 0; j < 4; ++j) { v2u w; w.x = pk2(v[j].x, v[j].y); w.y = pk2(v[j].z, v[j].w); q[64 * j] = w; }
}
__device__ __forceinline__ void st_row_fp8(unsigned char* p, int lane, const f32x4 (&v)[4], float sc) {
    GAS unsigned* q = (GAS unsigned*)p + lane;
#pragma unroll
    for (int j = 0; j < 4; ++j) q[64 * j] = pk4_fp8(v[j].x * sc, v[j].y * sc, v[j].z * sc, v[j].w * sc);
}
__device__ __forceinline__ float row_rs(const f32x4 (&v)[4]) {
    float s = 0.f;
#pragma unroll
    for (int j = 0; j < 4; ++j) s += (v[j].x * v[j].x + v[j].y * v[j].y) + (v[j].z * v[j].z + v[j].w * v[j].w);
    return rsqrtf(wave_sum(s) * (1.0f / D) + EPS);
}
__device__ __forceinline__ void norm_mod(f32x4 (&v)[4], const float* gam, const float* sh, const float* sc, int lane) {
    const float rs = row_rs(v); f32x4 g[4], a[4], b[4]; ld_row_f32(gam, lane, g); ld_row_f32(sh, lane, a); ld_row_f32(sc, lane, b);
#pragma unroll
    for (int j = 0; j < 4; ++j) v[j] = (v[j] * rs) * g[j] * (1.0f + b[j]) + a[j];
}
__device__ __forceinline__ void gated_add(f32x4 (&h)[4], const f32x4 (&y)[4], const float* gam, const float* gate, int lane) {
    const float rs = row_rs(y); f32x4 g[4], t[4]; ld_row_f32(gam, lane, g); ld_row_f32(gate, lane, t);
#pragma unroll
    for (int j = 0; j < 4; ++j) h[j] = h[j] + t[j] * ((y[j] * rs) * g[j]);
}

__device__ __forceinline__ void cvt_item(const float* W, int K, int N, bf16* WT, int ldk, int kcol0, int row_off, int mode, const float* gain, float scale, int nscale,
                                         LAS float* scr, int item, int lane, bool fp8 = false, bool tiled = false) {
    const int nblk = N / 32, kb = item / nblk, nb = item % nblk, k0 = 64 * kb, n0 = 32 * nb;
    { f32x4 t[8];
#pragma unroll
      for (int i = 0; i < 8; ++i) t[i] = *(const GAS f32x4*)(W + (size_t)(k0 + 8 * i + (lane >> 3)) * N + n0 + 4 * (lane & 7));
#pragma unroll
      for (int i = 0; i < 8; ++i) { LAS float* d = scr + (8 * i + (lane >> 3)) * 33 + 4 * (lane & 7); d[0] = t[i].x; d[1] = t[i].y; d[2] = t[i].z; d[3] = t[i].w; } }
    LDS_WAIT(); asm volatile("" ::: "memory");
    const int c = lane & 7;
    float gn[8];
#pragma unroll
    for (int q = 0; q < 8; ++q) gn[q] = (gain ? gain[k0 + 8 * c + q] : 1.0f) * ((n0 < nscale) ? scale : 1.0f);
    const int drow0 = (mode == 0) ? n0 : (mode == 3) ? ((n0 >> 7) * 64 + (n0 & 63) + ((n0 & 64) ? 512 : 0)) : ((n0 >> 7) * 256 + (n0 & 127) + (mode == 2 ? 128 : 0));
#pragma unroll
    for (int j = 0; j < 4; ++j) { const int n = (lane >> 3) + 8 * j; const LAS float* s = scr + (8 * c) * 33 + n;
        if (fp8) { v2u o; o.x = pk4_fp8(s[0 * 33] * gn[0], s[1 * 33] * gn[1], s[2 * 33] * gn[2], s[3 * 33] * gn[3]); o.y = pk4_fp8(s[4 * 33] * gn[4], s[5 * 33] * gn[5], s[6 * 33] * gn[6], s[7 * 33] * gn[7]);
            const int drow = row_off + drow0 + n, kc = kcol0 + k0 + 8 * c;
            unsigned char* dp = tiled ? (unsigned char*)WT + (size_t)(drow >> 8) * 256 * ldk + (size_t)(kc >> 7) * 32768 + (drow & 255) * 128 + (kc & 127) : (unsigned char*)WT + (size_t)drow * ldk + kc;
            *(GAS v2u*)dp = o; }
        else { v4u o; o.x = pk2(s[0 * 33] * gn[0], s[1 * 33] * gn[1]); o.y = pk2(s[2 * 33] * gn[2], s[3 * 33] * gn[3]); o.z = pk2(s[4 * 33] * gn[4], s[5 * 33] * gn[5]); o.w = pk2(s[6 * 33] * gn[6], s[7 * 33] * gn[7]);
            *(GAS v4u*)(WT + (size_t)(row_off + drow0 + n) * ldk + kcol0 + k0 + 8 * c) = o; } }
    LDS_WAIT(); asm volatile("" ::: "memory");
}
__device__ __forceinline__ void moe_weights(Frame& F, const Args& A, int it_lo, int it_hi, int widx, int nw) {
    LAS float* scr = (LAS float*)(F.lds + RING_OFF + F.wave * 16384);
    unsigned char* ws = A.ws;
    constexpr int I_MG1 = (D / 64) * (FE / 32), I_MD1 = (FE / 64) * (D / 32);
    for (int it = it_lo + widx; it < it_hi; it += nw) {
        int r = it;
        if (r < NE * I_MG1) { const int e = r / I_MG1; cvt_item(A.in[32] + (size_t)e * D * FE, D, FE, (bf16*)(ws + WS_W_MGU + (size_t)e * 2 * FE * D), D, 0, 0, 1, nullptr, FP8_SW, 1 << 30, scr, r % I_MG1, F.lane, true); continue; } r -= NE * I_MG1;
        if (r < NE * I_MG1) { const int e = r / I_MG1; cvt_item(A.in[33] + (size_t)e * D * FE, D, FE, (bf16*)(ws + WS_W_MGU + (size_t)e * 2 * FE * D), D, 0, 0, 2, nullptr, FP8_SW, 1 << 30, scr, r % I_MG1, F.lane, true); continue; } r -= NE * I_MG1;
        { const int e = r / I_MD1; cvt_item(A.in[34] + (size_t)e * FE * D, FE, D, (bf16*)(ws + WS_W_MDN + (size_t)e * D * FE), FE, 0, 0, 0, nullptr, FP8_SW, 1 << 30, scr, r % I_MD1, F.lane, true, true); }
    }
}
__device__ __forceinline__ void tail_convert(Frame& F, const Args& A, int nunit, int lo, int hi) {
    const int nlast = nunit % F.G, bid = (int)blockIdx.x;
    if (nlast != 0) { if (bid >= nlast) moe_weights(F, A, lo, hi, (bid - nlast) * NWAVES + F.wave, (F.G - nlast) * NWAVES); }
    else moe_weights(F, A, lo, hi, F.gw, F.ngw);
}
__device__ __forceinline__ void gen_s5(Frame& F, const Args& A, int g);
#ifndef PROBE_BLK
#define PROBE_BLK 0
#endif
#ifdef PROBE_SETA
#define PROBE_STAMP2(F, k) do { if (blockIdx.x == PROBE_BLK && F.tid == 0) { const unsigned long long t_ = __builtin_amdgcn_s_memrealtime(); const unsigned long long l_ = ((unsigned long long)F.MISC[17] << 32) | F.MISC[16]; const unsigned d_ = (unsigned)(t_ - l_); \
        if ((PROBE_SETA >> (k)) & 1ull) F.MISC[18] += d_; if ((PROBE_SETB >> (k)) & 1ull) F.MISC[20] += d_; F.MISC[16] = (unsigned)t_; F.MISC[17] = (unsigned)(t_ >> 32); } } while (0)
#else
#define PROBE_STAMP2(F, k) do { } while (0)
#endif
__device__ __forceinline__ void p0_prologue(Frame& F, const Args& A) {
    LAS float* scr = (LAS float*)(F.lds + RING_OFF + F.wave * 16384);
    unsigned char* ws = A.ws;
    constexpr int I_IN0 = (D / 64) * (EV_IN / 32), I_UQ = (QRANK / 64) * (768 / 32), I_UKV = (KVRANK / 64) * (1024 / 32), I_GLU = (512 / 64) * (512 / 32), I_OUT = (D / 64) * (D / 32);
    constexpr int I_FG = (D / 64) * (FFN / 32), I_FD = (FFN / 64) * (D / 32), I_IN1 = (D / 64) * (OD_IN / 32), I_MG1 = (D / 64) * (FE / 32), I_MD1 = (FE / 64) * (D / 32);
    constexpr int NITEMS = I_IN0 + I_UQ + I_UKV + I_GLU + I_OUT + 2 * I_FG + I_FD + I_IN1 + I_OUT;
    const bool s5_builder = (int)blockIdx.x >= F.G - S5G;
    for (int it = s5_builder ? NITEMS : F.gw; it < NITEMS; it += F.ngw - S5G * NWAVES) {
        int r = it;
        if (r < I_IN0) { cvt_item(A.in[7], D, EV_IN, (bf16*)(ws + WS_W_IN0), D, 0, 0, 0, nullptr, 1.f, 0, scr, r, F.lane); continue; } r -= I_IN0;
        if (r < I_UQ) { cvt_item(A.in[19], QRANK, 768, (bf16*)(ws + WS_W_QKV), KQKV, 0, 0, 0, A.in[18], 1.f, 0, scr, r, F.lane); continue; } r -= I_UQ;
        if (r < I_UKV) { cvt_item(A.in[21], KVRANK, 1024, (bf16*)(ws + WS_W_QKV), KQKV, QRANK, 768, 3, A.in[20], 1.f, 0, scr, r, F.lane); continue; } r -= I_UKV;
        if (r < I_GLU) { cvt_item(A.in[16], 512, 512, (bf16*)(ws + WS_W_GLU), 512, 0, 0, 0, nullptr, 1.f, 0, scr, r, F.lane); continue; } r -= I_GLU;
        if (r < I_OUT) { cvt_item(A.in[22], D, D, (bf16*)(ws + WS_W_OUT0), D, 0, 0, 0, nullptr, 1.f, 0, scr, r, F.lane); continue; } r -= I_OUT;
        if (r < I_FG) { cvt_item(A.in[23], D, FFN, (bf16*)(ws + WS_W_GU), D, 0, 0, 1, nullptr, FFN0_IS_FP8 ? FP8_SW : 1.f, 1 << 30, scr, r, F.lane, FFN0_IS_FP8); continue; } r -= I_FG;
        if (r < I_FG) { cvt_item(A.in[24], D, FFN, (bf16*)(ws + WS_W_GU), D, 0, 0, 2, nullptr, FFN0_IS_FP8 ? FP8_SW : 1.f, 1 << 30, scr, r, F.lane, FFN0_IS_FP8); continue; } r -= I_FG;
        if (r < I_FD) { cvt_item(A.in[25], FFN, D, (bf16*)(ws + WS_W_DN), FFN, 0, 0, 0, nullptr, (FFN0_IS_FP8 || FFN0_DN_FP8) ? FP8_SW : 1.f, 1 << 30, scr, r, F.lane, FFN0_IS_FP8 || FFN0_DN_FP8); continue; } r -= I_FD;
        if (r < I_IN1) { cvt_item(A.in[26], D, OD_IN, (bf16*)(ws + WS_W_IN1), D, 0, 0, 0, nullptr, 0.08838834764831845f, GKEY, scr, r, F.lane); continue; } r -= I_IN1;
        cvt_item(A.in[30], D, D, (bf16*)(ws + WS_W_OUT1), D, 0, 0, 0, nullptr, 1.f, 0, scr, r, F.lane);
    }
    { const v4u z = {0u, 0u, 0u, 0u}; const int gt = blockIdx.x * (NWAVES * 64) + F.tid, ngt = F.G * NWAVES * 64;
      GAS v4u* p0 = (GAS v4u*)((bf16*)(ws + WS_W_IN0) + (size_t)EV_IN * D); for (int i = gt; i < (EV_INP - EV_IN) * D / 8; i += ngt) p0[i] = z;
      for (int i = gt; i < 768 * (KVRANK / 8); i += ngt) { const int r = i / (KVRANK / 8), c = i % (KVRANK / 8); *(GAS v4u*)((bf16*)(ws + WS_W_QKV) + (size_t)r * KQKV + QRANK + 8 * c) = z; }
      for (int i = gt; i < 1024 * (QRANK / 8); i += ngt) { const int r = i / (QRANK / 8), c = i % (QRANK / 8); *(GAS v4u*)((bf16*)(ws + WS_W_QKV) + (size_t)(768 + r) * KQKV + 8 * c) = z; }
      GAS v4u* p1 = (GAS v4u*)((bf16*)(ws + WS_W_IN1) + (size_t)OD_IN * D); for (int i = gt; i < (OD_INP - OD_IN) * D / 8; i += ngt) p1[i] = z; }
    __syncthreads();
    PROBE_STAMP2(F, 22);
    LAS float* act = (LAS float*)(F.lds);
    LAS float* red = (LAS float*)(F.lds + 17 * 1024 * 4);
    float* modv = (float*)(ws + WS_MODV);
    bool have_act = false;
    for (int u = blockIdx.x; u < 2 * 96; u += F.G) {
        if (!have_act) {
            float xv[17 * 1024 / (NWAVES * 64)];
#pragma unroll
            for (int q = 0; q < 17 * 1024 / (NWAVES * 64); ++q) { const int i = F.tid + q * (NWAVES * 64); xv[q] = (i < 16 * 1024) ? A.in[1][i] : A.in[3][i - 16 * 1024]; }
#pragma unroll
            for (int q = 0; q < 17 * 1024 / (NWAVES * 64); ++q) { const float x = xv[q]; act[F.tid + q * (NWAVES * 64)] = x / (1.0f + __expf(-x)); }
            have_act = true;
        }
        __syncthreads();
        const int layer = u / 96, c0 = (u % 96) * 64;
        const float* mw = A.in[4] + (size_t)layer * D * 6144 + c0 + F.lane;
        float acc[17];
#pragma unroll
        for (int r = 0; r < 17; ++r) acc[r] = 0.f;
        for (int k0 = F.wave * 128; k0 < F.wave * 128 + 128; k0 += 32) { float w[32];
#pragma unroll
            for (int u2 = 0; u2 < 32; ++u2) w[u2] = mw[(size_t)(k0 + u2) * 6144];
#pragma unroll
            for (int u2 = 0; u2 < 32; ++u2)
#pragma unroll
                for (int r = 0; r < 17; ++r) acc[r] += act[r * 1024 + k0 + u2] * w[u2]; }
#pragma unroll
        for (int r = 0; r < 17; ++r) red[(F.wave * 17 + r) * 64 + F.lane] = acc[r];
        __syncthreads();
        for (int i = F.tid; i < 17 * 64; i += NWAVES * 64) { const int r = i >> 6, l = i & 63; float s = A.in[5][layer * 6144 + c0 + l];
#pragma unroll
            for (int w = 0; w < 8; ++w) s += red[(w * 17 + r) * 64 + l];
            modv[(size_t)(layer * 17 + r) * 6144 + c0 + l] = s; }
    }
    __syncthreads();
    PROBE_STAMP2(F, 23);
    for (int g = (int)blockIdx.x - (F.G - S5G); g >= 0 && g < S5G; g += F.G) gen_s5(F, A, g);
    PROBE_STAMP2(F, 24);
}

__device__ __forceinline__ void thin_t1(Frame& F, const Args& A) {
    const float* modv = (const float*)(A.ws + WS_MODV); bf16* XL = (bf16*)(A.ws + WS_XL); const float* gam = A.in[6];
    for (int r0 = F.gw; r0 < MA; r0 += 2 * F.ngw) {
        const int r1 = (r0 + F.ngw < MA) ? r0 + F.ngw : r0; const bool two = r1 != r0;
        const bool lat0 = r0 < ML, lat1 = r1 < ML; const float* src0 = lat0 ? A.in[0] + (size_t)r0 * D : A.in[2] + (size_t)(r0 - ML) * D; const float* src1 = lat1 ? A.in[0] + (size_t)r1 * D : A.in[2] + (size_t)(r1 - ML) * D;
        const float* mod0 = modv + (size_t)(lat0 ? r0 / SEQ : 16) * 6144; const float* mod1 = modv + (size_t)(lat1 ? r1 / SEQ : 16) * 6144;
        f32x4 v0[4], v1[4]; ld_row_f32(src0, F.lane, v0); ld_row_f32(src1, F.lane, v1);
        norm_mod(v0, gam, mod0, mod0 + D, F.lane); st_row_bf16(XL + (size_t)r0 * D, F.lane, v0);
        norm_mod(v1, gam, mod1, mod1 + D, F.lane); if (two) st_row_bf16(XL + (size_t)r1 * D, F.lane, v1);
    }
}
__device__ __forceinline__ void thin_t2(Frame& F, const Args& A) {
    const float* modv = (const float*)(A.ws + WS_MODV); bf16* XL = (bf16*)(A.ws + WS_XL); const bf16* YL = (const bf16*)(A.ws + WS_YL); float* HC = (float*)(A.ws + WS_HC); const float* gam = A.in[6];
    for (int r0 = F.gw; r0 < MA; r0 += 2 * F.ngw) {
        const int r1 = (r0 + F.ngw < MA) ? r0 + F.ngw : r0; const bool two = r1 != r0;
        const bool lat0 = r0 < ML, lat1 = r1 < ML;
        const float* src0 = lat0 ? A.in[0] + (size_t)r0 * D : A.in[2] + (size_t)(r0 - ML) * D; const float* src1 = lat1 ? A.in[0] + (size_t)r1 * D : A.in[2] + (size_t)(r1 - ML) * D;
        float* dst0 = lat0 ? A.out + (size_t)r0 * D : HC + (size_t)(r0 - ML) * D; float* dst1 = lat1 ? A.out + (size_t)r1 * D : HC + (size_t)(r1 - ML) * D;
        const float* mod0 = modv + (size_t)(lat0 ? r0 / SEQ : 16) * 6144; const float* mod1 = modv + (size_t)(lat1 ? r1 / SEQ : 16) * 6144;
        f32x4 h0[4], y0[4], h1[4], y1[4];
        ld_row_f32(src0, F.lane, h0); ld_row_bf16(YL + (size_t)r0 * D, F.lane, y0); ld_row_f32(src1, F.lane, h1); ld_row_bf16(YL + (size_t)r1 * D, F.lane, y1);
        gated_add(h0, y0, gam + 1 * D, mod0 + 2 * D, F.lane); gated_add(h1, y1, gam + 1 * D, mod1 + 2 * D, F.lane);
        st_row_f32(dst0, F.lane, h0); if (two) st_row_f32(dst1, F.lane, h1);
        norm_mod(h0, gam + 2 * D, mod0 + 3 * D, mod0 + 4 * D, F.lane); norm_mod(h1, gam + 2 * D, mod1 + 3 * D, mod1 + 4 * D, F.lane);
        if (FFN0_IS_FP8) { st_row_fp8((unsigned char*)XL + (size_t)r0 * D, F.lane, h0, FP8_SA); if (two) st_row_fp8((unsigned char*)XL + (size_t)r1 * D, F.lane, h1, FP8_SA); }
        else { st_row_bf16(XL + (size_t)r0 * D, F.lane, h0); if (two) st_row_bf16(XL + (size_t)r1 * D, F.lane, h1); }
    }
}
__device__ __forceinline__ void thin_t3(Frame& F, const Args& A) {
    const float* modv = (const float*)(A.ws + WS_MODV); bf16* XL = (bf16*)(A.ws + WS_XL); const bf16* FL = (const bf16*)(A.ws + WS_FL); const float* HC = (const float*)(A.ws + WS_HC); const float* gam = A.in[6];
    for (int r0 = F.gw; r0 < MA; r0 += 2 * F.ngw) {
        const int r1 = (r0 + F.ngw < MA) ? r0 + F.ngw : r0; const bool two = r1 != r0;
        const bool lat0 = r0 < ML, lat1 = r1 < ML;
        const float* src0 = lat0 ? A.out + (size_t)r0 * D : HC + (size_t)(r0 - ML) * D; const float* src1 = lat1 ? A.out + (size_t)r1 * D : HC + (size_t)(r1 - ML) * D;
        const int bs0 = lat0 ? r0 / SEQ : 16, bs1 = lat1 ? r1 / SEQ : 16;
        f32x4 h0[4], y0[4], h1[4], y1[4];
        ld_row_f32(src0, F.lane, h0); ld_row_bf16(FL + (size_t)r0 * D, F.lane, y0); ld_row_f32(src1, F.lane, h1); ld_row_bf16(FL + (size_t)r1 * D, F.lane, y1);
        gated_add(h0, y0, gam + 3 * D, modv + (size_t)bs0 * 6144 + 5 * D, F.lane); gated_add(h1, y1, gam + 3 * D, modv + (size_t)bs1 * 6144 + 5 * D, F.lane);
        if (lat0) st_row_f32(A.out + (size_t)r0 * D, F.lane, h0); if (two && lat1) st_row_f32(A.out + (size_t)r1 * D, F.lane, h1);
        { const float* m0 = modv + (size_t)(17 + bs0) * 6144; const float* m1 = modv + (size_t)(17 + bs1) * 6144;
          norm_mod(h0, gam + 4 * D, m0, m0 + D, F.lane); norm_mod(h1, gam + 4 * D, m1, m1 + D, F.lane); }
        st_row_bf16(XL + (size_t)r0 * D, F.lane, h0); if (two) st_row_bf16(XL + (size_t)r1 * D, F.lane, h1);
    }
}
__device__ __forceinline__ void thin_t4(Frame& F, const Args& A) {
    const float* modv = (const float*)(A.ws + WS_MODV); bf16* XL = (bf16*)(A.ws + WS_XLM); const bf16* YL = (const bf16*)(A.ws + WS_YL1); const float* gam = A.in[6] + 4 * D;
    const float* router = A.in[31]; unsigned* tok = (unsigned*)(A.ws + WS_TOK); unsigned short* inv = (unsigned short*)(A.ws + WS_INV);
    LAS float* rt = (LAS float*)(F.lds);
    LAS unsigned* wc = (LAS unsigned*)(F.lds + 32768);
    __syncthreads();
    for (int i = F.tid; i < 8 * 1024; i += NWAVES * 64) { const int e = i >> 10, c = i & 1023; rt[i] = router[(size_t)c * 8 + e]; }
    __syncthreads();
    for (int chunk = blockIdx.x; chunk < ML / 128; chunk += F.G) {
        const int row_base = chunk * 128 + F.wave * 16;
        int me0 = 0, me1 = 0; float mw0 = 0.f, mw1 = 0.f;
        for (int i = 0; i < 16; ++i) {
            const int r = row_base + i; const int bs = r / SEQ; const float* mod1 = modv + (size_t)(17 + bs) * 6144;
            f32x4 h[4], y[4]; ld_row_f32(A.out + (size_t)r * D, F.lane, h); ld_row_bf16(YL + (size_t)r * D, F.lane, y);
            gated_add(h, y, gam + 1 * D, mod1 + 2 * D, F.lane); st_row_f32(A.out + (size_t)r * D, F.lane, h);
            norm_mod(h, gam + 2 * D, mod1 + 3 * D, mod1 + 4 * D, F.lane); st_row_fp8((unsigned char*)XL + (size_t)r * D, F.lane, h, FP8_SA);
            float lg[8];
#pragma unroll
            for (int e = 0; e < 8; ++e) { float a = 0.f;
#pragma unroll
                for (int j = 0; j < 4; ++j) { const f32x4 w = *(const LAS f32x4*)(rt + e * 1024 + 256 * j + 4 * F.lane); a += (h[j].x * w.x + h[j].y * w.y) + (h[j].z * w.z + h[j].w * w.w); }
                lg[e] = a; }
            {
              const bool b5 = (F.lane & 32) != 0, b4 = (F.lane & 16) != 0, b3 = (F.lane & 8) != 0; float v4[4], v2[2];
#pragma unroll
              for (int i2 = 0; i2 < 4; ++i2) { const float keep = b5 ? lg[i2 + 4] : lg[i2], send = b5 ? lg[i2] : lg[i2 + 4]; v4[i2] = keep + __shfl_xor(send, 32); }
#pragma unroll
              for (int i2 = 0; i2 < 2; ++i2) { const float keep = b4 ? v4[i2 + 2] : v4[i2], send = b4 ? v4[i2] : v4[i2 + 2]; v2[i2] = keep + __shfl_xor(send, 16); }
              float v1 = (b3 ? v2[1] : v2[0]) + __shfl_xor(b3 ? v2[0] : v2[1], 8);
              v1 += __shfl_xor(v1, 1); v1 += __shfl_xor(v1, 2); v1 += __shfl_xor(v1, 4);
#pragma unroll
              for (int e = 0; e < 8; ++e) lg[e] = __builtin_bit_cast(float, __builtin_amdgcn_readlane(__builtin_bit_cast(int, v1), 8 * e)); }
            int e0 = 0; float v0 = lg[0];
#pragma unroll
            for (int e = 1; e < 8; ++e) if (lg[e] > v0) { v0 = lg[e]; e0 = e; }
            int e1 = (e0 + 1) & 7; float v1 = -3.0e38f;
#pragma unroll
            for (int e = 0; e < 8; ++e) if (e != e0 && lg[e] > v1) { v1 = lg[e]; e1 = e; }
            const float w1 = 1.0f / (1.0f + __expf(v0 - v1)), w0 = 1.0f - w1;
            if (F.lane == i) { me0 = e0; me1 = e1; mw0 = w0; mw1 = w1; }
        }
        unsigned long long m[8];
#pragma unroll
        for (int e = 0; e < 8; ++e) m[e] = __ballot(F.lane < 16 && (me0 == e || me1 == e));
        { unsigned c = 0;
#pragma unroll
          for (int e = 0; e < 8; ++e) c = (F.lane == e) ? (unsigned)__popcll(m[e]) : c;
          if (F.lane < 8) wc[F.wave * 8 + F.lane] = c; }
        __syncthreads();
        if (F.tid < 8) { unsigned tot = 0;
#pragma unroll
            for (int w = 0; w < 8; ++w) tot += wc[w * 8 + F.tid];
            unsigned run = __hip_atomic_fetch_add((unsigned*)(F.ctl + CW_CNT + F.tid), tot, __ATOMIC_RELAXED, __HIP_MEMORY_SCOPE_AGENT);
#pragma unroll
            for (int w = 0; w < 8; ++w) { const unsigned c = wc[w * 8 + F.tid]; wc[w * 8 + F.tid] = run; run += c; } }
        __syncthreads();
        if (F.lane < 16) { unsigned long long m0 = 0ull, m1 = 0ull;
#pragma unroll
            for (int e = 0; e < 8; ++e) { m0 = (me0 == e) ? m[e] : m0; m1 = (me1 == e) ? m[e] : m1; }
            const unsigned long long below = (1ull << F.lane) - 1ull;
            const unsigned i0 = wc[F.wave * 8 + me0] + (unsigned)__popcll(m0 & below), i1 = wc[F.wave * 8 + me1] + (unsigned)__popcll(m1 & below);
            unsigned* t = tok + (size_t)(row_base + F.lane) * 8; t[0] = (unsigned)me0; t[1] = (unsigned)me1; t[2] = i0; t[3] = i1; t[4] = __float_as_uint(mw0); t[5] = __float_as_uint(mw1);
            inv[(size_t)me0 * 32768 + i0] = (unsigned short)(row_base + F.lane); inv[(size_t)me1 * 32768 + i1] = (unsigned short)(row_base + F.lane); }
        __syncthreads();
    }
}
__device__ __forceinline__ void moe_tile_starts(Frame& F, int (&ts)[9]) {
    ts[0] = 0;
#pragma unroll
    for (int e = 0; e < 8; ++e) { const unsigned c = __hip_atomic_load((unsigned*)(F.ctl + CW_CNT + e), __ATOMIC_RELAXED, __HIP_MEMORY_SCOPE_AGENT); ts[e + 1] = ts[e] + (int)((c + 255u) >> 8); }
#pragma unroll
    for (int e = 0; e < 9; ++e) ts[e] = __builtin_amdgcn_readfirstlane(ts[e]);
}
template <class Sched> __device__ __forceinline__ void moe_row_table(Frame& F, const Args& A, const Sched& S, const int (&ts)[9]) {
    const unsigned short* inv = (const unsigned short*)(A.ws + WS_INV); LAS unsigned short* tab = (LAS unsigned short*)(F.lds + ATAB_OFF);
    __syncthreads();
    for (int i = 0; i < ATAB_UNITS; ++i) { pg8::Unit u; if (!S.next(i, u)) break;
        int e = 0;
#pragma unroll
        for (int q = 1; q < 8; ++q) e += (u.pm >= ts[q]) ? 1 : 0;
        int tse = 0;
#pragma unroll
        for (int q = 0; q < 8; ++q) tse = (e == q) ? ts[q] : tse;
        const unsigned cnt = __hip_atomic_load((unsigned*)(F.ctl + CW_CNT + e), __ATOMIC_RELAXED, __HIP_MEMORY_SCOPE_AGENT);
        if (F.tid < 256) { const unsigned r = (unsigned)(u.pm - tse) * 256u + (unsigned)F.tid; tab[i * 256 + F.tid] = (r < cnt) ? inv[(size_t)e * 32768 + r] : (unsigned short)0; } }
    __syncthreads();
}
__device__ __forceinline__ void thin_t5(Frame& F, const Args& A) {
    int ts[9]; moe_tile_starts(F, ts);
    const float* modv = (const float*)(A.ws + WS_MODV); const bf16* Y = (const bf16*)(A.ws + WS_Y); const float* gam = A.in[6] + 7 * D; const unsigned* tok = (const unsigned*)(A.ws + WS_TOK);
    for (int r = F.gw; r < ML; r += F.ngw) {
        const int bs = r / SEQ; const float* mod1 = modv + (size_t)(17 + bs) * 6144;
        const unsigned* t = tok + (size_t)r * 8; const float w0 = __uint_as_float(t[4]), w1 = __uint_as_float(t[5]); const int e0 = (int)t[0], e1 = (int)t[1]; int s0 = 0, s1 = 0;
#pragma unroll
        for (int e = 0; e < 8; ++e) { s0 = (e0 == e) ? ts[e] : s0; s1 = (e1 == e) ? ts[e] : s1; }
        const unsigned p0 = (unsigned)s0 * 256u + t[2], p1 = (unsigned)s1 * 256u + t[3];
        f32x4 h[4], y0[4], y1[4]; ld_row_f32(A.out + (size_t)r * D, F.lane, h); ld_row_bf16(Y + (size_t)p0 * D, F.lane, y0); ld_row_bf16(Y + (size_t)p1 * D, F.lane, y1);
#pragma unroll
        for (int j = 0; j < 4; ++j) y0[j] = y0[j] * w0 + y1[j] * w1;
        gated_add(h, y0, gam, mod1 + 5 * D, F.lane); st_row_f32(A.out + (size_t)r * D, F.lane, h);
    }
}

__device__ __forceinline__ float rope_inv(int f) { return exp2f(-(float)f * (13.287712379549449f / 8.0f)); }
__device__ __forceinline__ void prep_qa(Frame& F, const Args& A) {
    const bf16* Z0 = (const bf16*)(A.ws + WS_Z0C); bf16* QA = (bf16*)(A.ws + WS_QA); bf16* KR = (bf16*)(A.ws + WS_KR);
    for (int r = F.gw; r < MA; r += F.ngw) {
        const bf16* z = Z0 + (size_t)r * 512;
        const v2u cq = *((const GAS v2u*)(z) + F.lane); const unsigned ck = *((const GAS unsigned*)(z + 256) + F.lane);
        const float q0 = bf_lo(cq.x), q1 = bf_hi(cq.x), q2 = bf_lo(cq.y), q3 = bf_hi(cq.y), k0 = bf_lo(ck), k1 = bf_hi(ck);
        const float rq = rsqrtf(wave_sum((q0 * q0 + q1 * q1) + (q2 * q2 + q3 * q3)) * (1.0f / QRANK) + EPS);
        const float rk = rsqrtf(wave_sum(k0 * k0 + k1 * k1) * (1.0f / KVRANK) + EPS);
        v2u oq; oq.x = pk2(q0 * rq, q1 * rq); oq.y = pk2(q2 * rq, q3 * rq);
        *((GAS v2u*)(QA + (size_t)r * KQKV) + F.lane) = oq; *((GAS unsigned*)(QA + (size_t)r * KQKV + QRANK) + F.lane) = pk2(k0 * rk, k1 * rk);
        const int l = F.lane & 31; float v = bf1(z[384 + l]); const float pv = __shfl_xor(v, 8);
        if (r < ML) { const int t = r % SEQ; const float pos = (l < 16) ? (float)(t / 64) : (float)(t % 64); float sn, cs; sincosf(pos * rope_inv(l & 7), &sn, &cs);
            v = (l & 8) ? (v * cs + pv * sn) : (v * cs - pv * sn); }
        if (F.lane < 32) KR[(size_t)r * 32 + l] = (bf16)f2bf(v);
    }
}
__device__ __forceinline__ void rope_q(Frame& F, const Args& A) {
    bf16* Q = (bf16*)(A.ws + WS_Q);
    for (int r = F.gw; r < ML; r += F.ngw) {
        const int t = r % SEQ, hh = F.lane >> 3, sub = F.lane & 7; bf16* p = Q + (size_t)r * 768 + hh * QK + NOPE + sub;
        const float inv = rope_inv(sub); float sr, cr, sc, cc; sincosf((float)(t / 64) * inv, &sr, &cr); sincosf((float)(t % 64) * inv, &sc, &cc);
        const float x0 = bf1(p[0]), x1 = bf1(p[8]), x2 = bf1(p[16]), x3 = bf1(p[24]);
        p[0] = (bf16)f2bf(x0 * cr - x1 * sr); p[8] = (bf16)f2bf(x1 * cr + x0 * sr); p[16] = (bf16)f2bf(x2 * cc - x3 * sc); p[24] = (bf16)f2bf(x3 * cc + x2 * sc);
    }
}
__device__ __forceinline__ int scan_row(int b, int dir, int tau) {
    if (tau < CTXL) return ML + b * CTXL + (dir ? CTXL - 1 - tau : tau);
    const int t = tau - CTXL; return b * SEQ + (dir ? SEQ - 1 - t : t);
}
__device__ __forceinline__ float gelu_tanh(float x) { const float u = 0.7978845608028654f * (x + 0.044715f * x * x * x); const float e = __expf(2.0f * u); const float th = 1.0f - 2.0f / (e + 1.0f); return 0.5f * x * (1.0f + th); }
__device__ __forceinline__ void gen_s5(Frame& F, const Args& A, int g) {
    constexpr int CS = 65;
    LAS float* pw = (LAS float*)F.lds;
    LAS float* cc = pw + 2 * 64 * 17 * 2;
    LAS float* bb = cc + 2 * 16 * CS * 2;
    LAS float* KK = bb + 2 * 64 * 16 * 2;
    LAS float* LL = KK + 2 * 16 * 16 * 16;
    LAS float* DSK = LL + 128 * 4;
    bf16* B1g = (bf16*)(A.ws + WS_B1) + (size_t)g * 256 * 256; bf16* B3g = (bf16*)(A.ws + WS_B3) + (size_t)g * 256 * 512;
    __syncthreads();
    { float lr = 0.f, li = 0.f, dtr = 0.f, dk = 0.f, braw[4], biraw[4], craw[4], ciraw[4];
      if (F.tid < 128) { const int d = F.tid >> 6, p = F.tid & 63, ig = d * S5G + g, i = ig * S5P + p; lr = A.in[8][i]; li = A.in[9][i]; dtr = A.in[10][ig]; }
      if (F.tid < 16) dk = A.in[15][g * 16 + F.tid];
#pragma unroll
      for (int q = 0; q < 4; ++q) { const int idx = F.tid + q * (NWAVES * 64); { const int dp = idx >> 4, h = idx & 15, d = dp >> 6, p = dp & 63; const size_t i = (size_t)((d * S5G + g) * S5P + p); braw[q] = A.in[11][i * 16 + h]; biraw[q] = A.in[12][i * 16 + h]; }
        { const int d = idx >> 10, ho = (idx >> 6) & 15, p = idx & 63; const size_t ci = (size_t)((d * S5G + g) * 16 + ho) * S5P + p; craw[q] = A.in[13][ci]; ciraw[q] = A.in[14][ci]; } }
      if (F.tid < 128) { const float dt = expf(dtr); LL[F.tid * 4] = lr; LL[F.tid * 4 + 1] = li; LL[F.tid * 4 + 2] = lr * dt; LL[F.tid * 4 + 3] = li * dt; }
      if (F.tid < 16) DSK[F.tid] = dk;
#pragma unroll
      for (int q = 0; q < 4; ++q) { const int idx = F.tid + q * (NWAVES * 64); bb[idx * 2] = braw[q]; bb[idx * 2 + 1] = biraw[q];
        { const int d = idx >> 10, ho = (idx >> 6) & 15, p = idx & 63; cc[((d * 16 + ho) * CS + p) * 2] = craw[q]; cc[((d * 16 + ho) * CS + p) * 2 + 1] = ciraw[q]; } } }
    __syncthreads();
    for (int idx = F.tid; idx < 128 * 17; idx += NWAVES * 64) { const int dp = idx / 17, k = idx - dp * 17;
        const float mag = expf((float)k * LL[dp * 4 + 2]), ang = (float)k * LL[dp * 4 + 3]; pw[(dp * 17 + k) * 2] = mag * cosf(ang); pw[(dp * 17 + k) * 2 + 1] = mag * sinf(ang); }
    for (int idx = F.tid; idx < 128 * 16; idx += NWAVES * 64) { const int dp = idx >> 4;
        const float lr = LL[dp * 4], li = LL[dp * 4 + 1], lrdt = LL[dp * 4 + 2], lidt = LL[dp * 4 + 3];
        const float mag = expf(lrdt), ar = mag * cosf(lidt), ai = mag * sinf(lidt), den = lr * lr + li * li, nr = ar - 1.0f;
        const float cr = (nr * lr + ai * li) / den, ci = (ai * lr - nr * li) / den;
        const float br = bb[idx * 2], bi = bb[idx * 2 + 1]; bb[idx * 2] = cr * br - ci * bi; bb[idx * 2 + 1] = cr * bi + ci * br; }
    __syncthreads();
    { const int ho = F.tid & 15, k = (F.tid >> 4) & 15, d = F.tid >> 8;
      float acc[16];
#pragma unroll
      for (int hi = 0; hi < 16; ++hi) acc[hi] = 0.f;
      for (int p = 0; p < 64; ++p) { const float cr = cc[((d * 16 + ho) * CS + p) * 2], ci = cc[((d * 16 + ho) * CS + p) * 2 + 1], pr = pw[((d * 64 + p) * 17 + k) * 2], pi = pw[((d * 64 + p) * 17 + k) * 2 + 1];
          const float wr = cr * pr - ci * pi, wi = cr * pi + ci * pr; const LAS f32x4* bp = (const LAS f32x4*)(bb + (d * 64 + p) * 32);
#pragma unroll
          for (int q = 0; q < 8; ++q) { const f32x4 b4 = bp[q]; acc[2 * q] += wr * b4.x - wi * b4.y; acc[2 * q + 1] += wr * b4.z - wi * b4.w; } }
#pragma unroll
      for (int hi = 0; hi < 16; ++hi) KK[((d * 16 + k) * 16 + ho) * 16 + hi] = acc[hi]; }
    __syncthreads();
    for (int it = F.tid; it < 256 * 32; it += NWAVES * 64) { const int n = it >> 5, kk0 = (it & 31) * 8;
        float v3[8], v3b[8], v1[8];
        { const int j = n >> 4, ho = n & 15, i = kk0 >> 4, hi0 = kk0 & 15; const float dsk = DSK[ho];
#pragma unroll
          for (int e8 = 0; e8 < 8; ++e8) { const int hi = hi0 + e8; float val = 0.f;
            if (i <= j) val += KK[((0 * 16 + (j - i)) * 16 + ho) * 16 + hi];
            if (i >= j) val += KK[((1 * 16 + (i - j)) * 16 + ho) * 16 + hi];
            if (i == j && ho == hi) val += dsk;
            v3[e8] = val; }
          const int d = kk0 >> 7, reim = (kk0 >> 6) & 1, p0 = kk0 & 63, e = d ? (16 - j) : (j + 1);
#pragma unroll
          for (int e8 = 0; e8 < 8; ++e8) { const int p = p0 + e8;
            const float cr = cc[((d * 16 + ho) * CS + p) * 2], ci = cc[((d * 16 + ho) * CS + p) * 2 + 1], pr = pw[((d * 64 + p) * 17 + e) * 2], pi = pw[((d * 64 + p) * 17 + e) * 2 + 1];
            v3b[e8] = reim ? -(cr * pi + ci * pr) : (cr * pr - ci * pi); } }
        { const int d = n >> 7, reim = (n >> 6) & 1, p = n & 63, i = kk0 >> 4, hi0 = kk0 & 15, e = d ? i : (15 - i);
          const float pr = pw[((d * 64 + p) * 17 + e) * 2], pi = pw[((d * 64 + p) * 17 + e) * 2 + 1];
#pragma unroll
          for (int e8 = 0; e8 < 8; ++e8) { const int hi = hi0 + e8; const float br = bb[((d * 64 + p) * 16 + hi) * 2], bi = bb[((d * 64 + p) * 16 + hi) * 2 + 1];
            v1[e8] = reim ? (pr * bi + pi * br) : (pr * br - pi * bi); } }
        const v4u w3 = {pk2(v3[0], v3[1]), pk2(v3[2], v3[3]), pk2(v3[4], v3[5]), pk2(v3[6], v3[7])}, w3b = {pk2(v3b[0], v3b[1]), pk2(v3b[2], v3b[3]), pk2(v3b[4], v3b[5]), pk2(v3b[6], v3b[7])};
        const v4u w1 = {pk2(v1[0], v1[1]), pk2(v1[2], v1[3]), pk2(v1[4], v1[5]), pk2(v1[6], v1[7])};
        *(GAS v4u*)(B3g + (size_t)n * 512 + kk0) = w3; *(GAS v4u*)(B3g + (size_t)n * 512 + 256 + kk0) = w3b; *(GAS v4u*)(B1g + (size_t)n * 256 + kk0) = w1; }
    __syncthreads();
}
__device__ __forceinline__ void s5_scan(Frame& F, const Args& A) {
    if (F.wave < 4) {
        const float* DS = (const float*)(A.ws + WS_DS); bf16* A3 = (bf16*)(A.ws + WS_A3); const int p = F.lane;
        for (int task = blockIdx.x * 4 + F.wave; task < NB * S5G * 2; task += F.G * 4) {
            const int d = task & 1, g = (task >> 1) & 31, b = task >> 6, ig = d * S5G + g;
            const float lr = A.in[8][ig * S5P + p], li = A.in[9][ig * S5P + p], dt = expf(A.in[10][ig]);
            const float m16 = expf(16.0f * lr * dt), a16r = m16 * cosf(16.0f * li * dt), a16i = m16 * sinf(16.0f * li * dt);
            const float* ds = DS + (size_t)(g * 16 + b) * 144 * 256 + d * 128 + p; bf16* so = A3 + (size_t)(g * 16 + b) * 144 * 512 + 256 + d * 128 + p;
            float sr = 0.f, si = 0.f;
            for (int blk = 0; blk < 9; ++blk) {
                const int cbase = d ? (blk == 0 ? 15 : 143 - (blk - 1) * 16) : blk * 16, cstep = d ? -1 : 1;
                float xr[16], xi[16];
#pragma unroll
                for (int s = 0; s < 16; ++s) { const int c = cbase + cstep * s; xr[s] = ds[(size_t)c * 256]; xi[s] = ds[(size_t)c * 256 + 64]; }
#pragma unroll
                for (int s = 0; s < 16; ++s) { const int c = cbase + cstep * s; so[(size_t)c * 512] = (bf16)f2bf(sr); so[(size_t)c * 512 + 64] = (bf16)f2bf(si);
                    const float nsr = a16r * sr - a16i * si + xr[s], nsi = a16r * si + a16i * sr + xi[s]; sr = nsr; si = nsi; }
            }
        }
    }
}
__device__ __forceinline__ void attn_phase(Frame& F, const Args& A) {
    const bf16* Q = (const bf16*)(A.ws + WS_Q); const bf16* KV = (const bf16*)(A.ws + WS_KV); const bf16* KR = (const bf16*)(A.ws + WS_KR); bf16* AO = (bf16*)(A.ws + WS_AO);
    const int bid = (int)blockIdx.x; const int vcu = (F.G % 8 == 0) ? (bid % 8) * (F.G / 8) + bid / 8 : bid;
    for (int u = vcu; u < 1024 + 128; u += F.G) {
        int b, h, qrow0, NT;
        if (u < 1024) { const int bh = u >> 3; b = bh >> 3; h = bh & 7; qrow0 = b * SEQ + (u & 7) * 256; NT = TT / 64; }
        else { const int uu = u - 1024; b = uu >> 3; h = uu & 7; qrow0 = ML + b * CTXL; NT = CTXL / 64; }
        att::attn_unit(Q + (size_t)qrow0 * 768 + h * QK, KV + h * NOPE, KR, KV + 512 + h * VD, ML + b * CTXL, CTXL / 64, b * SEQ, NT, AO + (size_t)qrow0 * D + S5W + h * VD, F.lds, (u < 1024) ? (u & 7) * 256 : -1);
    }
}
__device__ __forceinline__ void gla_prep_phase(Frame& F, const Args& A) {
    for (int j = blockIdx.x; j < NB * GH * 2 * 2; j += F.G) { const int ch = j >> 1, b = ch >> 3, h = (ch >> 1) & 3, dir = ch & 1;
        gla::gla_prep((const bf16*)(A.ws + WS_QK), (const bf16*)(A.ws + WS_VR) + 2048, A.in[27], A.in[28], (bf16*)(A.ws + WS_TQ), (bf16*)(A.ws + WS_TK), (bf16*)(A.ws + WS_TP), (float*)(A.ws + WS_EL),
                      b, h, dir, 18 * (j & 1), 18 * (j & 1) + 18, ML, SEQ, CTXL, F.lds); }
}
__device__ __forceinline__ void gla_chain_phase(Frame& F, const Args& A) {
    const int bid = (int)blockIdx.x; const int vcu = (F.G % 8 == 0) ? (bid % 8) * (F.G / 8) + bid / 8 : bid;
    for (int u = vcu; u < NB * GH * 2 * 2; u += F.G) { const int ch = u >> 1, vh = u & 1, b = ch >> 3, h = (ch >> 1) & 3, dir = ch & 1;
        gla::gla_chain2((const bf16*)(A.ws + WS_VR), (const bf16*)(A.ws + WS_TQ), (const bf16*)(A.ws + WS_TK), (const bf16*)(A.ws + WS_TP), (const float*)(A.ws + WS_EL), (bf16*)(A.ws + (dir ? WS_OB : WS_OF)),
                        b, h, dir, vh, ML, SEQ, CTXL, F.lds); }
}
__device__ __forceinline__ void gla_finish(Frame& F, const Args& A) {
    bf16* OF = (bf16*)(A.ws + WS_OF); const bf16* OB = (const bf16*)(A.ws + WS_OB); const bf16* VR = (const bf16*)(A.ws + WS_VR); const float* hn = A.in[29];
    const f32x4 g = *(const GAS f32x4*)(hn + 4 * F.lane);
    for (int r0 = F.gw; r0 < ML; r0 += 2 * F.ngw) {
        const int r1 = (r0 + F.ngw < ML) ? r0 + F.ngw : r0; const bool two = r1 != r0;
        f32x4 a0[4], b0[4], x0[4], a1[4], b1[4], x1[4];
        ld_row_bf16(OF + (size_t)r0 * D, F.lane, a0); ld_row_bf16(OB + (size_t)r0 * D, F.lane, b0); ld_row_bf16(VR + (size_t)r0 * VRLD + GVAL, F.lane, x0);
        ld_row_bf16(OF + (size_t)r1 * D, F.lane, a1); ld_row_bf16(OB + (size_t)r1 * D, F.lane, b1); ld_row_bf16(VR + (size_t)r1 * VRLD + GVAL, F.lane, x1);
#pragma unroll
        for (int j = 0; j < 4; ++j) { const f32x4 o0 = a0[j] + b0[j], o1 = a1[j] + b1[j];
            const float s0 = wave_sum((o0.x * o0.x + o0.y * o0.y) + (o0.z * o0.z + o0.w * o0.w)), s1 = wave_sum((o1.x * o1.x + o1.y * o1.y) + (o1.z * o1.z + o1.w * o1.w));
            const float rs0 = rsqrtf(s0 * (1.0f / GDV) + EPS), rs1 = rsqrtf(s1 * (1.0f / GDV) + EPS);
#pragma unroll
            for (int i = 0; i < 4; ++i) { const float u0 = x0[j][i], u1 = x1[j][i];
                a0[j][i] = o0[i] * rs0 * g[i] * (u0 * __builtin_amdgcn_rcpf(1.0f + __expf(-u0))); a1[j][i] = o1[i] * rs1 * g[i] * (u1 * __builtin_amdgcn_rcpf(1.0f + __expf(-u1))); } }
        st_row_bf16(OF + (size_t)r0 * D, F.lane, a0); if (two) st_row_bf16(OF + (size_t)r1 * D, F.lane, a1);
    }
}

#ifndef MK_ONE_LAUNCH
#define MK_ONE_LAUNCH 1
#endif
constexpr int NPHASE = 21;
constexpr bool SP2 = true, ALIGN = true;

__global__ void __launch_bounds__(NWAVES * 64, 2) fwd_kernel(Args args) {
    extern __shared__ __attribute__((aligned(16))) unsigned char lds[];
    Frame F;
    F.lds = (LAS unsigned char*)lds;
    F.MISC = (volatile LAS unsigned*)(F.lds + MISC_OFF);
    F.tid = threadIdx.x; F.lane = F.tid & 63; F.wave = __builtin_amdgcn_readfirstlane(F.tid >> 6);
    F.G = gridDim.x; F.gw = blockIdx.x * NWAVES + F.wave; F.ngw = F.G * NWAVES;
    unsigned char* ws = args.ws;
    F.ctl = (gu32*)(ws + WS_CTL);
    for (int u = F.tid; u < (LDS_BYTES - LDSCTL_OFF) / 4; u += NWAVES * 64) ((LAS unsigned*)(F.lds + LDSCTL_OFF))[u] = 0u;
    __syncthreads();
    XcdBarrier bar; bar.bar = (unsigned*)(F.ctl + CW_BAR); bar.x = 0; bar.st = nullptr;
    if (MK_ONE_LAUNCH) bar = xcd_barrier_post((unsigned*)(F.ctl + CW_BAR), F.MISC + 8);
    const int lo = args.ph_lo, hi = args.ph_hi;
#define IN(k) (lo <= (k) && (k) < hi)
#ifdef PROBE_SETA
    if (blockIdx.x == PROBE_BLK && F.tid == 0) { const unsigned long long t_ = __builtin_amdgcn_s_memrealtime(); F.MISC[16] = (unsigned)t_; F.MISC[17] = (unsigned)(t_ >> 32); }
#define PROBE_STAMP(k) do { if (blockIdx.x == PROBE_BLK && F.tid == 0) { const unsigned long long t_ = __builtin_amdgcn_s_memrealtime(); const unsigned long long l_ = ((unsigned long long)F.MISC[17] << 32) | F.MISC[16]; const unsigned d_ = (unsigned)(t_ - l_); \
        if ((PROBE_SETA >> (k)) & 1ull) F.MISC[18] += d_; if ((PROBE_SETB >> (k)) & 1ull) F.MISC[20] += d_; F.MISC[16] = (unsigned)t_; F.MISC[17] = (unsigned)(t_ >> 32); } } while (0)
#else
#define PROBE_STAMP(k) do { } while (0)
#endif
#define SEAM(k) do { if (MK_ONE_LAUNCH && IN(k) && IN((k) + 1)) xcd_barrier(bar); PROBE_STAMP(k); } while (0)
    const int bid = (int)blockIdx.x;

    if (IN(0)) {
#ifndef NO_P0
 p0_prologue(F, args);
#endif
 } SEAM(0);
    if (IN(1)) { thin_t1(F, args); } SEAM(1);
    if (IN(2)) { pg8::Gemm g{(const bf16*)(ws + WS_XL), (const bf16*)(ws + WS_W_IN0), MA, EV_INP, D}; pg8::StaticOrder S; S.init(MA, EV_INP, F.G, bid);
        pg8::EpiIn0 E{(bf16*)(ws + WS_U), (bf16*)(ws + WS_A3), (bf16*)(ws + WS_Z0C)};
        pg8::gemm_phase<pg8::EpiIn0, pg8::StaticOrder, ALIGN, SP2>(F.lds + RING_OFF, g, S, E);
        tail_convert(F, args, (MA / 256) * (EV_INP / 256), MW0, MW1); } SEAM(2);
    if (IN(3)) { prep_qa(F, args);
        int k256 = 256; asm volatile("" : "+s"(k256));
        pg8::Gemm g{(const bf16*)(ws + WS_U), (const bf16*)(ws + WS_B1), 32 * 2304, 256, k256}; pg8::S5Order S{F.G, bid};
        pg8::EpiF32 E{(float*)(ws + WS_DS), 256};
        pg8::gemm_phase<pg8::EpiF32, pg8::S5Order, ALIGN, SP2>(F.lds + RING_OFF, g, S, E); } SEAM(3);
    if (IN(4)) { s5_scan(F, args);
        pg8::Gemm g{(const bf16*)(ws + WS_QA), (const bf16*)(ws + WS_W_QKV), MA, NQKV, KQKV}; pg8::StaticOrder S; S.init(MA, NQKV, F.G, bid);
        pg8::EpiSplit E{(bf16*)(ws + WS_Q), 768, (bf16*)(ws + WS_KV), 1024, 3, 0x7fffffff};
        pg8::gemm_phase<pg8::EpiSplit, pg8::StaticOrder, ALIGN, SP2>(F.lds + RING_OFF, g, S, E); } SEAM(4);
    if (IN(5)) {
        pg8::Gemm g{(const bf16*)(ws + WS_A3), (const bf16*)(ws + WS_B3), 32 * 2304, 256, 512}; pg8::S5Order S{F.G, bid};
        pg8::EpiS5Out E{(bf16*)(ws + WS_AG)};
        pg8::gemm_phase<pg8::EpiS5Out, pg8::S5Order, ALIGN, SP2>(F.lds + RING_OFF, g, S, E); } SEAM(5);
    if (IN(6)) {
#ifndef NO_ATT
 attn_phase(F, args);
#endif
        PROBE_STAMP(21);
        pg8::Gemm g{(const bf16*)(ws + WS_AG), (const bf16*)(ws + WS_W_GLU), MA, S5W, S5W}; pg8::StaticOrder S; S.init(MA, S5W, F.G, bid);
        pg8::EpiGlu E{(const bf16*)(ws + WS_AG), args.in[17], (bf16*)(ws + WS_AO), D};
        pg8::gemm_phase<pg8::EpiGlu, pg8::StaticOrder, ALIGN, SP2, false, false, true>(F.lds + RING_OFF, g, S, E); } SEAM(6);
    if (IN(7)) { pg8::Gemm g{(const bf16*)(ws + WS_AO), (const bf16*)(ws + WS_W_OUT0), MA, D, D}; pg8::StaticOrder S; S.init(MA, D, F.G, bid);
        pg8::EpiPlain E{(bf16*)(ws + WS_YL), D, 0, 0, 1.0f};
        pg8::gemm_phase<pg8::EpiPlain, pg8::StaticOrder, ALIGN, SP2>(F.lds + RING_OFF, g, S, E);
        tail_convert(F, args, (MA / 256) * (D / 256), MW1, MW2); } SEAM(7);
    if (IN(8)) { thin_t2(F, args); } SEAM(8);
    static_assert(!FFN0_IS_FP8, "the e4m3 dense-FFN variant does not carry the MoE weight conversion in its down phase");
    if constexpr (FFN0_IS_FP8) {
    if (IN(9)) { pg8::Gemm g{(const bf16*)(ws + WS_XL), (const bf16*)(ws + WS_W_GU), MA, 2 * FFN, D / 2}; pg8::StaticOrder S; S.init(MA, 2 * FFN, F.G, bid);
        pg8::EpiSwiGlu8 E{ws + WS_ACT, FFN, 0, 1.0f / (FP8_SA * FP8_SW), FP8_SACT, 0};
        pg8::gemm_phase<pg8::EpiSwiGlu8, pg8::StaticOrder, ALIGN, SP2, true>(F.lds + RING_OFF, g, S, E); } SEAM(9);
    if (IN(10)) { pg8::Gemm g{(const bf16*)(ws + WS_ACT), (const bf16*)(ws + WS_W_DN), MA, D, FFN / 2}; pg8::StaticOrder S; S.init(MA, D, F.G, bid);
        pg8::EpiPlain E{(bf16*)(ws + WS_FL), D, 0, 0, 1.0f / (FP8_SACT * FP8_SW)};
        pg8::gemm_phase<pg8::EpiPlain, pg8::StaticOrder, ALIGN, SP2, true>(F.lds + RING_OFF, g, S, E); } SEAM(10);
    } else {
    if (IN(9)) { pg8::Gemm g{(const bf16*)(ws + WS_XL), (const bf16*)(ws + WS_W_GU), MA, 2 * FFN, D}; pg8::StaticOrder S; S.init(MA, 2 * FFN, F.G, bid);
        if constexpr (FFN0_DN_FP8) { pg8::EpiSwiGlu8 E{ws + WS_ACT, FFN, 0, 1.0f, FP8_SACT, 0};
            pg8::gemm_phase<pg8::EpiSwiGlu8, pg8::StaticOrder, ALIGN, SP2>(F.lds + RING_OFF, g, S, E); }
        else { pg8::EpiSwiGlu E{(bf16*)(ws + WS_ACT), FFN, 0, 0};
            pg8::gemm_phase<pg8::EpiSwiGlu, pg8::StaticOrder, ALIGN, SP2>(F.lds + RING_OFF, g, S, E); }
        tail_convert(F, args, (MA / 256) * (2 * FFN / 256), MW2, MW3); } SEAM(9);
    if (IN(10)) { pg8::StaticOrder S; S.init(MA, D, F.G, bid);
        if constexpr (FFN0_DN_FP8) { pg8::Gemm g{(const bf16*)(ws + WS_ACT), (const bf16*)(ws + WS_W_DN), MA, D, FFN / 2};
            pg8::EpiPlain E{(bf16*)(ws + WS_FL), D, 0, 0, 1.0f / (FP8_SACT * FP8_SW)};
            pg8::gemm_phase<pg8::EpiPlain, pg8::StaticOrder, ALIGN, SP2, true>(F.lds + RING_OFF, g, S, E); }
        else { pg8::Gemm g{(const bf16*)(ws + WS_ACT), (const bf16*)(ws + WS_W_DN), MA, D, FFN};
            pg8::EpiPlain E{(bf16*)(ws + WS_FL), D, 0, 0, 1.0f};
            pg8::gemm_phase<pg8::EpiPlain, pg8::StaticOrder, ALIGN, SP2>(F.lds + RING_OFF, g, S, E); }
        tail_convert(F, args, (MA / 256) * (D / 256), MW3, MW4); } SEAM(10);
    }
    if (IN(11)) { thin_t3(F, args); } SEAM(11);
    if (IN(12)) { pg8::Gemm g{(const bf16*)(ws + WS_XL), (const bf16*)(ws + WS_W_IN1), MA, OD_INP, D}; pg8::StaticOrder S; S.init(MA, OD_INP, F.G, bid);
        pg8::EpiSplit E{(bf16*)(ws + WS_QK), 1024, (bf16*)(ws + WS_VR), VRLD, 4, 0x7fffffff};
        pg8::gemm_phase<pg8::EpiSplit, pg8::StaticOrder, ALIGN, SP2>(F.lds + RING_OFF, g, S, E);
        tail_convert(F, args, (MA / 256) * (OD_INP / 256), MW4, MW5); } SEAM(12);
    if (IN(13)) {
#ifndef NO_GLA
 gla_prep_phase(F, args);
#endif
    } SEAM(13);
    if (IN(14)) {
#ifndef NO_GLA
 gla_chain_phase(F, args);
#endif
    } SEAM(14);
    if (IN(15)) { gla_finish(F, args); } SEAM(15);
    if (IN(16)) { pg8::Gemm g{(const bf16*)(ws + WS_OF), (const bf16*)(ws + WS_W_OUT1), ML, D, D}; pg8::StaticOrder S; S.init(ML, D, F.G, bid);
        pg8::EpiPlain E{(bf16*)(ws + WS_YL1), D, 0, 0, 1.0f};
        pg8::gemm_phase<pg8::EpiPlain, pg8::StaticOrder, ALIGN, SP2>(F.lds + RING_OFF, g, S, E); } SEAM(16);
    if (IN(17)) { thin_t4(F, args); } SEAM(17);
    if (lo < 20 && hi > 18) {
        int ts[9]; moe_tile_starts(F, ts); const int NT = ts[8];
        if (IN(18)) { pg8::MoeOrder S{0, NT, 2 * FE / 256, F.G, bid, ts[1], ts[2], ts[3], ts[4], ts[5], ts[6], ts[7], 0};
            moe_row_table(F, args, S, ts);
            pg8::Gemm g{(const bf16*)(ws + WS_XLM), (const bf16*)(ws + WS_W_MGU), ML, 2 * FE, D / 2, (const LAS unsigned short*)(F.lds + ATAB_OFF)};
            pg8::EpiSwiGlu8 E{ws + WS_ACTM, FE, 2 * FE / 256, 1.0f / (FP8_SA * FP8_SW), FP8_SACT, 1};
            pg8::gemm_phase<pg8::EpiSwiGlu8, pg8::MoeOrder, ALIGN, SP2, true, false, false, true>(F.lds + RING_OFF, g, S, E); } SEAM(18);
        if (IN(19)) { pg8::Gemm g{(const bf16*)(ws + WS_ACTM), (const bf16*)(ws + WS_W_MDN), MOE_MAXT * 256, D, FE / 2};
            pg8::MoeOrder S{0, NT, D / 256, F.G, bid, ts[1], ts[2], ts[3], ts[4], ts[5], ts[6], ts[7], 1};
            pg8::EpiPlain E{(bf16*)(ws + WS_Y), D, 0, D / 256, 1.0f / (FP8_SACT * FP8_SW)};
            pg8::gemm_phase<pg8::EpiPlain, pg8::MoeOrder, ALIGN, SP2, true, true>(F.lds + RING_OFF, g, S, E); } SEAM(19);
    }
    if (IN(20)) { thin_t5(F, args); }
#ifdef PROBE_SETA
    PROBE_STAMP(20);
    if (blockIdx.x == PROBE_BLK && F.tid == 0) {
        unsigned long long qa = F.MISC[18] / 100u, qb = F.MISC[20] / 400u; qa = qa > 999 ? 999 : qa; qb = qb > 199 ? 199 : qb;
        const unsigned long long t0 = __builtin_amdgcn_s_memrealtime(), dl = qa * 1000ull + qb * 1000000ull;
        while (__builtin_amdgcn_s_memrealtime() - t0 < dl) __builtin_amdgcn_s_sleep(32);
    }
#endif
#undef IN
#undef SEAM
}

extern "C" void kernel_launch(void* const* d_in, const int* in_sizes, int n_in, void* d_out, int out_size, void* d_ws, size_t ws_size, hipStream_t stream) {
    static int grid = 0;
    if (grid == 0) {
        if (n_in != 35 || out_size != ML * D || ws_size < WS_END) { fprintf(stderr, "kernel_launch: unexpected shapes: n_in %d out %d ws %zu (need %zu)\n", n_in, out_size, ws_size, (size_t)WS_END); grid = -1; return; }
        int dev = 0, cus = 0, per_cu = 0;
        if (hipGetDevice(&dev) != hipSuccess || hipDeviceGetAttribute(&cus, hipDeviceAttributeMultiprocessorCount, dev) != hipSuccess) { grid = -1; return; }
        if (hipFuncSetAttribute((const void*)fwd_kernel, hipFuncAttributeMaxDynamicSharedMemorySize, LDS_BYTES) != hipSuccess) { fprintf(stderr, "kernel_launch: hipFuncSetAttribute failed\n"); grid = -1; return; }
        if (hipOccupancyMaxActiveBlocksPerMultiprocessor(&per_cu, (const void*)fwd_kernel, NWAVES * 64, LDS_BYTES) != hipSuccess || per_cu < 1) { fprintf(stderr, "kernel_launch: occupancy query reports %d blocks per CU\n", per_cu); }
        (void)hipGetLastError();
        grid = cus;
    }
    if (grid < 0) return;
    (void)hipMemsetAsync((char*)d_ws + WS_CTL, 0, CTL_ZERO_BYTES, stream);
    Args a{};
    for (int i = 0; i < 35; ++i) a.in[i] = (const float*)d_in[i];
    a.out = (float*)d_out; a.ws = (unsigned char*)d_ws;
#if MK_ONE_LAUNCH
    a.ph_lo = 0; a.ph_hi = NPHASE;
    hipLaunchKernelGGL(fwd_kernel, dim3(grid), dim3(NWAVES * 64), LDS_BYTES, stream, a);
#else
    for (int p = 0; p < NPHASE; ++p) { a.ph_lo = p; a.ph_hi = p + 1; hipLaunchKernelGGL(fwd_kernel, dim3(grid), dim3(NWAVES * 64), LDS_BYTES, stream, a); }
#endif
}
```

```cpp
#include <hip/hip_runtime.h>
#include <cstdio>
#include <cstdint>
#define MK_ONE_LAUNCH 1
namespace pg8 {
#define PG8_LAS __attribute__((address_space(3)))
typedef unsigned short bf16_t;
typedef short bf16x8 __attribute__((ext_vector_type(8)));
typedef float f32x4 __attribute__((ext_vector_type(4)));
typedef unsigned u32x4 __attribute__((ext_vector_type(4)));
constexpr int BM = 256, BK = 64, HALF = 128, HTB = HALF * BK * 2  , STAGE_BYTES = 8 * HTB, NXCD = 8, WGM = 8;

__host__ __device__ __forceinline__ int lds_byte(int r, int c) { const int st = (r >> 4) * 2 + (c >> 5), rr = r & 15, cc = c & 31, ob = rr * 64 + cc * 2; return st * 1024 + (ob ^ (((ob >> 9) & 1) << 5)); }
__host__ __device__ __forceinline__ void stage_rc(int b, int& R, int& C) { const int st = b / 1024, sb = b % 1024, swz = sb ^ (((sb >> 9) & 1) << 5); R = (st >> 1) * 16 + swz / 64; C = (st & 1) * 32 + (swz % 64) / 2; }
__host__ __device__ __forceinline__ int perm32(int rho) { const int n = rho >> 4, i = rho & 15; return 8 * (i >> 2) + 4 * n + (i & 3); }

struct Unit { int pm, pn; };
struct Gemm { const bf16_t* A; const bf16_t* Bt; int M, N, K; const PG8_LAS unsigned short* atab = nullptr; };
constexpr unsigned ACH_GS = 2304u * 256u * 2u;

struct StaticOrder {
    int nM, nN, nwg, G, c;
    __host__ __device__ void init(int M, int N, int G_, int c_) { nM = M / BM; nN = N / BM; nwg = nM * nN; G = G_; c = c_; }
    __host__ __device__ bool next(int i, Unit& u) const {
        const long L = (long)i * G + c; if (L >= nwg) return false;
        int wgid = (int)L; { const int q = nwg / NXCD, r = nwg % NXCD, xcd = wgid % NXCD, off = wgid / NXCD; wgid = (xcd < r ? xcd * (q + 1) : r * (q + 1) + (xcd - r) * q) + off; }
        const int nig = WGM * nN, gid = wgid / nig, fm = gid * WGM, gsz = (nM - fm) < WGM ? (nM - fm) : WGM;
        u.pm = fm + ((wgid % nig) % gsz); u.pn = (wgid % nig) / gsz; return true;
    }
    __device__ __forceinline__ void a_ready(const Unit&) const {}
    __device__ __forceinline__ void done(const Unit&) const {}
};

__device__ __forceinline__ unsigned cvt_pk_bf16(float lo, float hi) { unsigned r; asm volatile("v_cvt_pk_bf16_f32 %0, %1, %2" : "=v"(r) : "v"(lo), "v"(hi)); return r; }
typedef float f32x2 __attribute__((ext_vector_type(2)));
__device__ __forceinline__ u32x4 pack8(const f32x4 v0, const f32x4 v1) { u32x4 w; w.x = cvt_pk_bf16(v0[0], v0[1]); w.y = cvt_pk_bf16(v0[2], v0[3]); w.z = cvt_pk_bf16(v1[0], v1[1]); w.w = cvt_pk_bf16(v1[2], v1[3]); return w; }
__device__ __forceinline__ float bf_lo(unsigned u) { return __uint_as_float(u << 16); }
__device__ __forceinline__ float bf_hi(unsigned u) { return __uint_as_float(u & 0xffff0000u); }
__device__ __forceinline__ unsigned pk4_fp8(float a, float b, float c, float d) {
    a = __builtin_amdgcn_fmed3f(a, -448.f, 448.f); b = __builtin_amdgcn_fmed3f(b, -448.f, 448.f); c = __builtin_amdgcn_fmed3f(c, -448.f, 448.f); d = __builtin_amdgcn_fmed3f(d, -448.f, 448.f);
    int r = __builtin_amdgcn_cvt_pk_fp8_f32(a, b, 0, false); r = __builtin_amdgcn_cvt_pk_fp8_f32(c, d, r, true); return (unsigned)r; }
__device__ __forceinline__ float sigmoid_f(float x) { return __builtin_amdgcn_rcpf(1.0f + __builtin_amdgcn_exp2f(-1.4426950408889634f * x)); }

struct EpiPlain {
    static constexpr bool PERM = true, AFTER_DRAIN = false;
    bf16_t* O; int ldc; int pm_off; int nmod; float sc;
    __device__ __forceinline__ void operator()(const f32x4 (&acc)[2][2][4][2], const Unit& u, int wr, int wc, int fr, int fq) const {
        const int row0 = (u.pm - pm_off) * BM + wr * 64 + fr; const int ct = nmod ? (u.pn % nmod) : u.pn; const int col0 = ct * BM + wc * 32 + 8 * fq;
#pragma unroll
        for (int ai = 0; ai < 2; ++ai)
#pragma unroll
            for (int m = 0; m < 4; ++m) { bf16_t* rowp = O + (size_t)(row0 + ai * HALF + m * 16) * ldc + col0;
#pragma unroll
                for (int bj = 0; bj < 2; ++bj) *(u32x4*)(rowp + bj * HALF) = pack8(acc[ai][bj][m][0] * sc, acc[ai][bj][m][1] * sc); }
    }
};
struct EpiSplit {
    static constexpr bool PERM = true, AFTER_DRAIN = false;
    bf16_t* O0; int ld0; bf16_t* O1; int ld1; int nsplit; int ncols1;
    __device__ __forceinline__ void operator()(const f32x4 (&acc)[2][2][4][2], const Unit& u, int wr, int wc, int fr, int fq) const {
        const int row0 = u.pm * BM + wr * 64 + fr; const bool first = u.pn < nsplit;
        bf16_t* base = first ? O0 : O1; const int ld = first ? ld0 : ld1; const int col0 = (first ? u.pn : u.pn - nsplit) * BM + wc * 32 + 8 * fq; const int lim = first ? 0x7fffffff : ncols1;
#pragma unroll
        for (int ai = 0; ai < 2; ++ai)
#pragma unroll
            for (int m = 0; m < 4; ++m) { bf16_t* rowp = base + (size_t)(row0 + ai * HALF + m * 16) * ld + col0;
#pragma unroll
                for (int bj = 0; bj < 2; ++bj) if (col0 + bj * HALF < lim) *(u32x4*)(rowp + bj * HALF) = pack8(acc[ai][bj][m][0], acc[ai][bj][m][1]); }
    }
};
struct EpiGlu {
    static constexpr bool PERM = true, AFTER_DRAIN = false;
    const bf16_t* Aa; const float* bias; bf16_t* O; int ldc;
    __device__ __forceinline__ void operator()(const f32x4 (&acc)[2][2][4][2], const Unit& u, int wr, int wc, int fr, int fq) const {
        const int row0 = u.pm * BM + wr * 64 + fr; const int col0 = u.pn * BM + wc * 32 + 8 * fq;
        const int crow0 = (u.pm < 128 ? (u.pm >> 3) * 144 + 16 + (u.pm & 7) * 16 : (u.pm - 128) * 144) + wr * 4;
#pragma unroll
        for (int bj = 0; bj < 2; ++bj) { const f32x4 b0 = *(const f32x4*)(bias + col0 + bj * HALF), b1 = *(const f32x4*)(bias + col0 + bj * HALF + 4);
            const int cg = (col0 + bj * HALF) >> 4, ch = (col0 + bj * HALF) & 15;
#pragma unroll
            for (int ai = 0; ai < 2; ++ai)
#pragma unroll
                for (int m = 0; m < 4; ++m) { const size_t r = (size_t)(row0 + ai * HALF + m * 16);
                    const u32x4 a8 = *(const u32x4*)(Aa + (size_t)cg * (2304 * 256) + (size_t)(crow0 + ai * 8 + m) * 256 + fr * 16 + ch);
                    f32x4 v0 = acc[ai][bj][m][0] + b0, v1 = acc[ai][bj][m][1] + b1;
                    v0[0] = bf_lo(a8.x) * sigmoid_f(v0[0]); v0[1] = bf_hi(a8.x) * sigmoid_f(v0[1]); v0[2] = bf_lo(a8.y) * sigmoid_f(v0[2]); v0[3] = bf_hi(a8.y) * sigmoid_f(v0[3]);
                    v1[0] = bf_lo(a8.z) * sigmoid_f(v1[0]); v1[1] = bf_hi(a8.z) * sigmoid_f(v1[1]); v1[2] = bf_lo(a8.w) * sigmoid_f(v1[2]); v1[3] = bf_hi(a8.w) * sigmoid_f(v1[3]);
                    *(u32x4*)(O + r * ldc + col0 + bj * HALF) = pack8(v0, v1); } }
    }
};
struct EpiSwiGlu {
    static constexpr bool PERM = true, AFTER_DRAIN = false;
    bf16_t* O; int ldc; int pm_off; int nmod;
    __device__ __forceinline__ void operator()(const f32x4 (&acc)[2][2][4][2], const Unit& u, int wr, int wc, int fr, int fq) const {
        const int row0 = (u.pm - pm_off) * BM + wr * 64 + fr; const int ct = nmod ? (u.pn % nmod) : u.pn; const int col0 = ct * HALF + wc * 32 + 8 * fq;
#pragma unroll
        for (int ai = 0; ai < 2; ++ai)
#pragma unroll
            for (int m = 0; m < 4; ++m) { f32x4 o0, o1;
#pragma unroll
                for (int i = 0; i < 4; ++i) { const float g0 = acc[ai][0][m][0][i], g1 = acc[ai][0][m][1][i]; o0[i] = g0 * sigmoid_f(g0) * acc[ai][1][m][0][i]; o1[i] = g1 * sigmoid_f(g1) * acc[ai][1][m][1][i]; }
                *(u32x4*)(O + (size_t)(row0 + ai * HALF + m * 16) * ldc + col0) = pack8(o0, o1); }
    }
};
struct EpiIn0 {
    static constexpr bool PERM = true, AFTER_DRAIN = false;
    bf16_t* U; bf16_t* A3; bf16_t* Z0c;
    __device__ __forceinline__ void operator()(const f32x4 (&acc)[2][2][4][2], const Unit& u, int wr, int wc, int fr, int fq) const {
        if (u.pn >= 2) {
            const int row0 = u.pm * BM + wr * 64 + fr, col0 = (u.pn - 2) * BM + wc * 32 + 8 * fq;
#pragma unroll
            for (int ai = 0; ai < 2; ++ai)
#pragma unroll
                for (int m = 0; m < 4; ++m) { bf16_t* rowp = Z0c + (size_t)(row0 + ai * HALF + m * 16) * 512 + col0;
#pragma unroll
                    for (int bj = 0; bj < 2; ++bj) *(u32x4*)(rowp + bj * HALF) = pack8(acc[ai][bj][m][0], acc[ai][bj][m][1]); }
        } else {
            const int b = (u.pm < 128) ? (u.pm >> 3) : (u.pm - 128); const int c0 = (u.pm < 128) ? (16 + (u.pm & 7) * 16) : 0;
            const int g0 = u.pn * 16 + wc * 2 + (fq >> 1);
            const size_t r0 = (size_t)(g0 * 16 + b) * 144 + c0 + wr * 4;
            const int cc = fr * 16 + 8 * (fq & 1);
#pragma unroll
            for (int ai = 0; ai < 2; ++ai)
#pragma unroll
                for (int m = 0; m < 4; ++m)
#pragma unroll
                    for (int bj = 0; bj < 2; ++bj) { const size_t r = r0 + (size_t)bj * (8 * 16 * 144) + ai * 8 + m; const u32x4 w = pack8(acc[ai][bj][m][0], acc[ai][bj][m][1]);
                        *(u32x4*)(U + r * 256 + cc) = w; *(u32x4*)(A3 + r * 512 + cc) = w; }
        }
    }
};
struct EpiF32 {
    static constexpr bool PERM = false, AFTER_DRAIN = false;
    float* C; int ldc;
    __device__ __forceinline__ void operator()(const f32x4 (&acc)[2][2][4][2], const Unit& u, int wr, int wc, int fr, int fq) const {
        const int row0 = u.pm * BM + wr * 64 + fr, col0 = wc * 32 + 4 * fq;
#pragma unroll
        for (int ai = 0; ai < 2; ++ai)
#pragma unroll
            for (int m = 0; m < 4; ++m) { float* rowp = C + (size_t)(row0 + ai * HALF + m * 16) * ldc + col0;
#pragma unroll
                for (int bj = 0; bj < 2; ++bj)
#pragma unroll
                    for (int n = 0; n < 2; ++n) *(f32x4*)(rowp + bj * HALF + n * 16) = acc[ai][bj][m][n]; }
    }
};
__device__ __forceinline__ float gelu_tanh_f(float x) { const float t = 0.7978845608028654f * (x + 0.044715f * x * x * x); const float e = __builtin_amdgcn_exp2f(2.8853900817779268f * t); return x - x * __builtin_amdgcn_rcpf(e + 1.0f); }
struct EpiS5Out {
    static constexpr bool PERM = true, AFTER_DRAIN = false;
    bf16_t* AG;
    __device__ __forceinline__ void operator()(const f32x4 (&acc)[2][2][4][2], const Unit& u, int wr, int wc, int fr, int fq) const {
        const int row0 = u.pm * BM + wr * 64 + fr, col0 = wc * 32 + 8 * fq;
#pragma unroll
        for (int ai = 0; ai < 2; ++ai)
#pragma unroll
            for (int m = 0; m < 4; ++m) { bf16_t* rowp = AG + (size_t)(row0 + ai * HALF + m * 16) * 256 + col0;
#pragma unroll
                for (int bj = 0; bj < 2; ++bj) { f32x4 v0 = acc[ai][bj][m][0], v1 = acc[ai][bj][m][1];
#pragma unroll
                    for (int i = 0; i < 4; ++i) { v0[i] = gelu_tanh_f(v0[i]); v1[i] = gelu_tanh_f(v1[i]); }
                    *(u32x4*)(rowp + bj * HALF) = pack8(v0, v1); } }
    }
};
struct S5Order {
    int G, c;
    __device__ __forceinline__ bool next(int i, Unit& u) const { const int L = i * G + c; if (L >= 32 * 9) return false; u.pm = L; u.pn = L / 9; return true; }
    __device__ __forceinline__ void a_ready(const Unit&) const {}
    __device__ __forceinline__ void done(const Unit&) const {}
};
struct EpiSwiGlu8 {
    static constexpr bool PERM = true, AFTER_DRAIN = false;
    unsigned char* O; int ldc; int nmod; float us, os; int tiled;
    __device__ __forceinline__ void operator()(const f32x4 (&acc)[2][2][4][2], const Unit& u, int wr, int wc, int fr, int fq) const {
        const int row0 = u.pm * BM + wr * 64 + fr; const int ct = nmod ? (u.pn % nmod) : u.pn; const int col0 = ct * HALF + wc * 32 + 8 * fq;
        typedef unsigned u32x2_ __attribute__((ext_vector_type(2))); typedef float f32x2_ __attribute__((ext_vector_type(2)));
        const float kexp = -1.4426950408889634f * us, kout = us * us * os;
#pragma unroll
        for (int ai = 0; ai < 2; ++ai)
#pragma unroll
            for (int m = 0; m < 4; ++m) { f32x4 o0, o1;
#pragma unroll
                for (int i = 0; i < 4; i += 2) {
                    const f32x2_ ga = {acc[ai][0][m][0][i], acc[ai][0][m][0][i + 1]}, gb = {acc[ai][0][m][1][i], acc[ai][0][m][1][i + 1]}, ua = {acc[ai][1][m][0][i], acc[ai][1][m][0][i + 1]}, ub = {acc[ai][1][m][1][i], acc[ai][1][m][1][i + 1]};
                    f32x2_ ta = ga * kexp, tb = gb * kexp; ta.x = __builtin_amdgcn_exp2f(ta.x); ta.y = __builtin_amdgcn_exp2f(ta.y); tb.x = __builtin_amdgcn_exp2f(tb.x); tb.y = __builtin_amdgcn_exp2f(tb.y);
                    ta = ta + 1.0f; tb = tb + 1.0f; ta.x = __builtin_amdgcn_rcpf(ta.x); ta.y = __builtin_amdgcn_rcpf(ta.y); tb.x = __builtin_amdgcn_rcpf(tb.x); tb.y = __builtin_amdgcn_rcpf(tb.y);
                    const f32x2_ ra = (ga * ua) * (ta * kout), rb = (gb * ub) * (tb * kout); o0[i] = ra.x; o0[i + 1] = ra.y; o1[i] = rb.x; o1[i + 1] = rb.y; }
                u32x2_ w; w.x = pk4_fp8(o0[0], o0[1], o0[2], o0[3]); w.y = pk4_fp8(o1[0], o1[1], o1[2], o1[3]);
                const int rr = wr * 64 + fr + ai * HALF + m * 16;
                if (tiled) *(u32x2_*)(O + (size_t)u.pm * BM * ldc + (size_t)ct * (BM * 128) + rr * 128 + wc * 32 + 8 * fq) = w;
                else *(u32x2_*)(O + (size_t)(row0 + ai * HALF + m * 16) * ldc + col0) = w; }
    }
};
struct MoeOrder {
    int t0, nT, nN, G, c; int e1, e2, e3, e4, e5, e6, e7; int rev;
    __device__ __forceinline__ bool next(int i, Unit& u) const {
        const int nwg = nT * nN; const long L = (long)i * G + c; if (L >= nwg) return false;
        int wgid = (int)L; { const int q = nwg / NXCD, r = nwg % NXCD, xcd = wgid % NXCD, off = wgid / NXCD, sz = xcd < r ? q + 1 : q; wgid = (xcd < r ? xcd * (q + 1) : r * (q + 1) + (xcd - r) * q) + (rev ? sz - 1 - off : off); }
        const int nig = WGM * nN, gid = wgid / nig, fm = gid * WGM, gsz = (nT - fm) < WGM ? (nT - fm) : WGM;
        const int pm = t0 + fm + ((wgid % nig) % gsz), pn = (wgid % nig) / gsz;
        const int e = (pm >= e1) + (pm >= e2) + (pm >= e3) + (pm >= e4) + (pm >= e5) + (pm >= e6) + (pm >= e7);
        u.pm = pm; u.pn = e * nN + pn; return true;
    }
    __device__ __forceinline__ void a_ready(const Unit&) const {}
    __device__ __forceinline__ void done(const Unit&) const {}
};
template <class Epi, class Sched, bool ALIGN_EPI = false, bool SP2 = false, bool FP8 = false, bool TILED = false, bool ACHUNK = false, bool AGATHER = false>
__device__ __forceinline__ void gemm_phase(PG8_LAS unsigned char* lds, const Gemm g, const Sched& S, const Epi& E) {
    const int tid = threadIdx.x, wid = __builtin_amdgcn_readfirstlane(tid >> 6), lane = tid & 63, wr = wid >> 2, wc = wid & 3, fr = lane & 15, fq = lane >> 4;
    const int K = g.K, nt = K / BK;
    unsigned voffA[2], voffB[2];
#pragma unroll
    for (int i = 0; i < 2; ++i) { int R, C; stage_rc(tid * 16 + i * 8192, R, C); const int Rb = Epi::PERM ? ((R & ~31) + perm32(R & 31)) : R;
        voffA[i] = TILED ? (unsigned)(R * BK + C) * 2u : (unsigned)(R * K + C) * 2u; voffB[i] = TILED ? (unsigned)(Rb * BK + C) * 2u : (unsigned)(Rb * K + C) * 2u;
        if (ACHUNK) voffA[i] = (unsigned)((R >> 4) * 512 + (R & 15) * 32 + (C & 15) * 2) + (unsigned)(C >> 4) * ACH_GS; }
    const size_t kstep = TILED ? (size_t)(BM * BK * 2) : (size_t)(BK * 2);
    const size_t hstep = TILED ? (size_t)(HALF * BK * 2) : (size_t)HALF * K * 2;
    const size_t tstep = (size_t)BM * K * 2;
    const size_t kstepA = ACHUNK ? (size_t)4 * ACH_GS : kstep, hstepA = ACHUNK ? (size_t)4096 : hstep;
#define PG8_ABASE(pm_) (AGATHER ? (const char*)g.A : ACHUNK ? (const char*)g.A + (size_t)((pm_) < 128 ? ((pm_) >> 3) * 144 + 16 + ((pm_) & 7) * 16 : ((pm_) - 128) * 144) * 512 : (const char*)g.A + (size_t)(pm_) * tstep)
    const unsigned ldsw = (unsigned)wid * 1024u;
    const int aoff = lds_byte(wr * 64 + fr, fq * 8), boff = lds_byte(wc * 32 + fr, fq * 8);
#define PG8_SA(b, h) (((b) * 2 + (h)) * HTB)
#define PG8_SB(b, h) ((4 + (b) * 2 + (h)) * HTB)
#define PG8_STAGE(bufoff, gbase, voff) do { _Pragma("unroll") for (int _i = 0; _i < 2; ++_i) \
        __builtin_amdgcn_global_load_lds((const unsigned*)((const char*)(gbase) + (voff)[_i]), (PG8_LAS unsigned*)(lds + (bufoff) + ldsw + _i * 8192), 16, 0, 0); } while (0)
    static_assert(!AGATHER || SP2, "AGATHER is written for the SP2 loop");
    unsigned gvA0[2] = {0u, 0u}, gvA1[2] = {0u, 0u}, gnA0[2] = {0u, 0u}, gnA1[2] = {0u, 0u};
#define PG8_GLOAD(uidx, v0, v1) do { _Pragma("unroll") for (int i_ = 0; i_ < 2; ++i_) { int R_, C_; stage_rc(tid * 16 + i_ * 8192, R_, C_); \
        const unsigned t0_ = g.atab[(uidx) * 256 + R_], t1_ = g.atab[(uidx) * 256 + 128 + R_]; v0[i_] = t0_ * (unsigned)(2 * K) + (unsigned)C_ * 2u; v1[i_] = t1_ * (unsigned)(2 * K) + (unsigned)C_ * 2u; } } while (0)
#define PG8_STAGE_A(bufoff, gbase, half, nx) do { if constexpr (AGATHER) { unsigned vs_[2]; \
        vs_[0] = (nx) ? ((half) ? gnA1[0] : gnA0[0]) : ((half) ? gvA1[0] : gvA0[0]); vs_[1] = (nx) ? ((half) ? gnA1[1] : gnA0[1]) : ((half) ? gvA1[1] : gvA0[1]); PG8_STAGE(bufoff, gbase, vs_); } \
        else PG8_STAGE(bufoff, (gbase) + ((half) ? hstepA : (size_t)0), voffA); } while (0)
#define PG8_LDA(dst, b, h) do { _Pragma("unroll") for (int m = 0; m < 4; ++m) _Pragma("unroll") for (int k = 0; k < 2; ++k) dst[m][k] = *(const PG8_LAS bf16x8*)(lds + PG8_SA(b, h) + aoff + m * 2048 + k * 1024); } while (0)
#define PG8_LDB(dst, b, h) do { _Pragma("unroll") for (int n = 0; n < 2; ++n) _Pragma("unroll") for (int k = 0; k < 2; ++k) dst[n][k] = *(const PG8_LAS bf16x8*)(lds + PG8_SB(b, h) + boff + n * 2048 + k * 1024); } while (0)
#define PG8_MMA(ai, bj, At, Bt) do { __builtin_amdgcn_s_setprio(1); _Pragma("unroll") for (int m = 0; m < 4; ++m) _Pragma("unroll") for (int n = 0; n < 2; ++n) { \
        if constexpr (FP8) { typedef int i32x4_ __attribute__((ext_vector_type(4))); typedef int i32x8_ __attribute__((ext_vector_type(8))); \
            const i32x8_ bo_ = __builtin_shufflevector(__builtin_bit_cast(i32x4_, Bt[n][0]), __builtin_bit_cast(i32x4_, Bt[n][1]), 0, 1, 2, 3, 4, 5, 6, 7); \
            const i32x8_ ao_ = __builtin_shufflevector(__builtin_bit_cast(i32x4_, At[m][0]), __builtin_bit_cast(i32x4_, At[m][1]), 0, 1, 2, 3, 4, 5, 6, 7); \
            asm volatile("v_mfma_f32_16x16x128_f8f6f4 %0, %1, %2, %0" : "+v"(acc[ai][bj][m][n]) : "v"(bo_), "v"(ao_)); } \
        else { _Pragma("unroll") for (int k = 0; k < 2; ++k) acc[ai][bj][m][n] = __builtin_amdgcn_mfma_f32_16x16x32_bf16(Bt[n][k], At[m][k], acc[ai][bj][m][n], 0, 0, 0); } } \
        __builtin_amdgcn_s_setprio(0); } while (0)
#define PG8_WAIT_V(n) asm volatile("s_waitcnt vmcnt(" #n ")" ::: "memory")
#define PG8_WAIT_L(n) asm volatile("s_waitcnt lgkmcnt(" #n ")" ::: "memory")
#define PG8_BAR __builtin_amdgcn_s_barrier()
#define PG8_SCHED __builtin_amdgcn_sched_barrier(0)
    const int fp8_unit_scale_ = 0x7f7f7f7f; (void)fp8_unit_scale_;
    Unit cur, nxt; int ui = 0;
    if (!S.next(0, cur)) return;
    f32x4 acc[2][2][4][2];
#pragma unroll
    for (int a = 0; a < 2; ++a)
#pragma unroll
        for (int b = 0; b < 2; ++b)
#pragma unroll
            for (int m = 0; m < 4; ++m)
#pragma unroll
                for (int n = 0; n < 2; ++n) acc[a][b][m][n] = (f32x4){0.f, 0.f, 0.f, 0.f};
    bf16x8 At[4][2], B0[2][2], B1[2][2];
    const char* cA = PG8_ABASE(cur.pm); const char* cB = (const char*)g.Bt + (size_t)cur.pn * tstep;
    if constexpr (AGATHER) PG8_GLOAD(0, gvA0, gvA1);
    S.a_ready(cur);
    if constexpr (SP2) {
        PG8_STAGE(PG8_SB(0, 0), cB, voffB); PG8_STAGE(PG8_SB(0, 1), cB + hstep, voffB); PG8_STAGE_A(PG8_SA(0, 0), cA, 0, false); PG8_STAGE_A(PG8_SA(0, 1), cA, 1, false);
        if (wr == 1) PG8_BAR;
        PG8_WAIT_V(2); PG8_BAR;
        PG8_STAGE(PG8_SB(1, 0), cB + kstep, voffB); PG8_STAGE_A(PG8_SA(1, 0), cA + kstepA, 0, false); PG8_STAGE(PG8_SB(1, 1), cB + hstep + kstep, voffB);
        PG8_WAIT_V(6); PG8_BAR;
    } else {
        PG8_STAGE(PG8_SB(0, 0), cB, voffB); PG8_STAGE(PG8_SA(0, 0), cA, voffA); PG8_STAGE(PG8_SB(0, 1), cB + hstep, voffB); PG8_STAGE(PG8_SA(0, 1), cA + hstepA, voffA);
        if (wr == 1) PG8_BAR;
        PG8_WAIT_V(4); PG8_BAR;
        PG8_STAGE(PG8_SB(1, 0), cB + kstep, voffB); PG8_STAGE(PG8_SA(1, 0), cA + kstepA, voffA); PG8_STAGE(PG8_SB(1, 1), cB + hstep + kstep, voffB);
        PG8_WAIT_V(6); PG8_BAR;
    }
    for (;;) {
        const bool has_next = S.next(ui + 1, nxt);
        const char* nA = has_next ? PG8_ABASE(nxt.pm) : cA; const char* nB = has_next ? (const char*)g.Bt + (size_t)nxt.pn * tstep : cB;
        for (int t = 0; t < nt; t += 2) {
            const bool last = (t == nt - 2);
            const char* a1 = cA + (size_t)(t + 1) * kstepA;
            const char* a2 = last ? nA : cA + (size_t)(t + 2) * kstepA; const char* b2 = last ? nB : cB + (size_t)(t + 2) * kstep;
            const char* a3 = a2 + kstepA; const char* b3 = b2 + kstep;
            if (last && has_next) S.a_ready(nxt);
            const bool nx_ = last && has_next;
            if constexpr (AGATHER) { if (nx_) PG8_GLOAD(ui + 1, gnA0, gnA1); }
            if constexpr (SP2) {
            PG8_LDB(B0, 0, 0); PG8_LDB(B1, 0, 1); PG8_SCHED; PG8_LDA(At, 0, 0); PG8_STAGE_A(PG8_SA(1, 1), a1, 1, false);
            PG8_WAIT_V(8); PG8_WAIT_L(0); PG8_BAR; PG8_MMA(0, 0, At, B0); PG8_MMA(0, 1, At, B1); PG8_BAR; PG8_SCHED;
            PG8_LDA(At, 0, 1); PG8_STAGE(PG8_SB(0, 0), b2, voffB); PG8_STAGE(PG8_SB(0, 1), b2 + hstep, voffB); PG8_STAGE_A(PG8_SA(0, 0), a2, 0, nx_);
            PG8_WAIT_V(8); PG8_WAIT_L(0); PG8_BAR; PG8_MMA(1, 0, At, B0); PG8_MMA(1, 1, At, B1); PG8_BAR; PG8_SCHED;
            PG8_LDB(B0, 1, 0); PG8_LDB(B1, 1, 1); PG8_SCHED; PG8_LDA(At, 1, 0); PG8_STAGE_A(PG8_SA(0, 1), a2, 1, nx_);
            PG8_WAIT_V(8); PG8_WAIT_L(0); PG8_BAR; PG8_MMA(0, 0, At, B0); PG8_MMA(0, 1, At, B1); PG8_BAR; PG8_SCHED;
            PG8_LDA(At, 1, 1); PG8_STAGE(PG8_SB(1, 0), b3, voffB); PG8_STAGE(PG8_SB(1, 1), b3 + hstep, voffB); PG8_STAGE_A(PG8_SA(1, 0), a3, 0, nx_);
            PG8_WAIT_V(8); PG8_WAIT_L(0); PG8_BAR; PG8_MMA(1, 0, At, B0); PG8_MMA(1, 1, At, B1); PG8_BAR; PG8_SCHED;
            } else {
            PG8_LDB(B0, 0, 0); PG8_SCHED; PG8_LDA(At, 0, 0); PG8_STAGE(PG8_SA(1, 1), a1 + hstepA, voffA);
            PG8_WAIT_L(8); PG8_BAR; PG8_WAIT_L(0); PG8_MMA(0, 0, At, B0); PG8_BAR; PG8_SCHED;
            PG8_LDB(B1, 0, 1); PG8_STAGE(PG8_SB(0, 0), b2, voffB);
            PG8_BAR; PG8_WAIT_L(0); PG8_MMA(0, 1, At, B1); PG8_BAR;
            PG8_LDA(At, 0, 1); PG8_STAGE(PG8_SA(0, 0), a2, voffA);
            PG8_BAR; PG8_WAIT_L(0); PG8_MMA(1, 0, At, B0); PG8_BAR; PG8_SCHED;
            PG8_STAGE(PG8_SB(0, 1), b2 + hstep, voffB);
            PG8_WAIT_V(6); PG8_BAR; PG8_MMA(1, 1, At, B1); PG8_BAR;
            PG8_LDB(B0, 1, 0); PG8_SCHED; PG8_LDA(At, 1, 0); PG8_STAGE(PG8_SA(0, 1), a2 + hstepA, voffA);
            PG8_WAIT_L(8); PG8_BAR; PG8_WAIT_L(0); PG8_MMA(0, 0, At, B0); PG8_BAR; PG8_SCHED;
            PG8_LDB(B1, 1, 1); PG8_STAGE(PG8_SB(1, 0), b3, voffB);
            PG8_BAR; PG8_WAIT_L(0); PG8_MMA(0, 1, At, B1); PG8_BAR;
            PG8_LDA(At, 1, 1); PG8_STAGE(PG8_SA(1, 0), a3, voffA);
            PG8_BAR; PG8_WAIT_L(0); PG8_MMA(1, 0, At, B0); PG8_BAR; PG8_SCHED;
            PG8_STAGE(PG8_SB(1, 1), b3 + hstep, voffB);
            PG8_WAIT_V(6); PG8_BAR; PG8_MMA(1, 1, At, B1); PG8_BAR;
            }
        }
        if constexpr (ALIGN_EPI) { if (wr == 0) PG8_BAR; }
        if constexpr (FP8) asm volatile("s_nop 15\n\ts_nop 7" ::: "memory");
        if constexpr (!Epi::AFTER_DRAIN) { E(acc, cur, wr, wc, fr, fq); S.done(cur); }
        if (!has_next) break;
#pragma unroll
        for (int a = 0; a < 2; ++a)
#pragma unroll
            for (int b = 0; b < 2; ++b)
#pragma unroll
                for (int m = 0; m < 4; ++m)
#pragma unroll
                    for (int n = 0; n < 2; ++n) acc[a][b][m][n] = (f32x4){0.f, 0.f, 0.f, 0.f};
        cur = nxt; cA = nA; cB = nB; ++ui;
        if constexpr (AGATHER) { gvA0[0] = gnA0[0]; gvA0[1] = gnA0[1]; gvA1[0] = gnA1[0]; gvA1[1] = gnA1[1]; }
        if constexpr (ALIGN_EPI) { if (wr == 1) PG8_BAR; }
    }
    PG8_WAIT_V(0);
    if constexpr (!ALIGN_EPI) { if (wr == 0) PG8_BAR; }
    PG8_BAR;
    if constexpr (Epi::AFTER_DRAIN) { E.fused(acc, cur, wr, wc, fr, fq, lds, wid, lane); S.done(cur); }
#undef PG8_ABASE
#undef PG8_GLOAD
#undef PG8_STAGE_A
#undef PG8_SA
#undef PG8_SB
#undef PG8_STAGE
#undef PG8_LDA
#undef PG8_LDB
#undef PG8_MMA
#undef PG8_WAIT_V
#undef PG8_WAIT_L
#undef PG8_BAR
#undef PG8_SCHED
}
}
#define GAS __attribute__((address_space(1)))
#define LAS __attribute__((address_space(3)))
typedef unsigned short bf16;
typedef unsigned v4u __attribute__((ext_vector_type(4)));
typedef float f32x4 __attribute__((ext_vector_type(4)));
typedef short bf16x8 __attribute__((ext_vector_type(8)));
typedef GAS unsigned gu32;
typedef GAS unsigned long long gu64;
#define RLX_AGENT __ATOMIC_RELAXED, __HIP_MEMORY_SCOPE_AGENT
#define LDS_WAIT() asm volatile("s_waitcnt lgkmcnt(0)" ::: "memory")
#define VM_WAIT() asm volatile("s_waitcnt vmcnt(0)" ::: "memory")
__device__ __forceinline__ unsigned long long rt() { return __builtin_amdgcn_s_memrealtime(); }
__device__ __forceinline__ unsigned f2bf(float f) { unsigned u = __builtin_bit_cast(unsigned, f); return (u + 0x7fffu + ((u >> 16) & 1u)) >> 16; }
__device__ __forceinline__ unsigned pk2(float lo, float hi) { return f2bf(lo) | (f2bf(hi) << 16); }
#define XB_TMO      128
#define XB_XCNT(j)  (256  + 64 * (j))
#define XB_XSUB(j)  (1280 + 64 * (j))
#define XB_XGEN(j)  (2304 + 64 * (j))
#define XB_TOP      3328
#define XB_TOPGEN   3392
#define XCD_BAR_WORDS 3456
#define XB_SPIN_CAP (1u << 18)

__device__ __forceinline__ unsigned xb_ld(unsigned* p)              { return __hip_atomic_load(p, __ATOMIC_RELAXED, __HIP_MEMORY_SCOPE_AGENT); }
__device__ __forceinline__ unsigned xb_add(unsigned* p, unsigned v) { return __hip_atomic_fetch_add(p, v, __ATOMIC_RELAXED, __HIP_MEMORY_SCOPE_AGENT); }
__device__ __forceinline__ unsigned xb_xcc_id() { return (unsigned)__builtin_amdgcn_s_getreg((3 << 11) | 20) & 0xFu; }
#define XB_SPIN(cond, bar) do { unsigned _sp = 0; while (cond) { __builtin_amdgcn_s_sleep(1); \
    if ((++_sp & 255u) == 0u) { if (xb_ld(&(bar)[XB_TMO])) break; if (_sp > XB_SPIN_CAP) { atomicAdd(&(bar)[XB_TMO], 1u); break; } } } } while (0)

struct XcdBarrier {
    unsigned* bar; unsigned x;
    volatile LAS unsigned* st;
};

__device__ __forceinline__ XcdBarrier xcd_barrier_post(unsigned* bar, volatile LAS unsigned* st) {
    XcdBarrier b; b.bar = bar; b.x = xb_xcc_id(); b.st = st;
    if (threadIdx.x == 0) (void)xb_add(&bar[XB_XCNT(b.x)], 1u);
    return b;
}
__device__ __forceinline__ void xcd_barrier_complete(unsigned* bar, unsigned x, unsigned& nloc, unsigned& nx) {
    const unsigned G = gridDim.x * gridDim.y * gridDim.z;
    unsigned sum, cnt, mine, sp = 0u;
    for (;;) {
        sum = 0u; cnt = 0u; mine = 0u;
#pragma unroll
        for (unsigned j = 0; j < 16; ++j) { const unsigned c = xb_ld(&bar[XB_XCNT(j)]); sum += c; cnt += (c > 0u) ? 1u : 0u; mine = (j == x) ? c : mine; }
        if (sum == G) break;
        __builtin_amdgcn_s_sleep(1);
        if ((++sp & 255u) == 0u) { if (xb_ld(&bar[XB_TMO])) break; if (sp > XB_SPIN_CAP) { atomicAdd(&bar[XB_TMO], 1u); break; } }
    }
    nloc = mine > 0u ? mine : 1u; nx = cnt > 0u ? cnt : 1u;
}

__device__ __forceinline__ void xcd_barrier(const XcdBarrier& b) {
    asm volatile("s_waitcnt vmcnt(0)" ::: "memory");
    __syncthreads();
    if (threadIdx.x == 0) {
        unsigned* bar = b.bar;
        __builtin_amdgcn_s_waitcnt(0);
        unsigned nloc = b.st[0], nx = b.st[1];
        if (nloc == 0u) { xcd_barrier_complete(bar, b.x, nloc, nx); b.st[0] = nloc; b.st[1] = nx; }
        const unsigned old = xb_add(&bar[XB_XSUB(b.x)], 1u);
        const unsigned gen = old / nloc;
        if (old + 1u == (gen + 1u) * nloc) {
            __builtin_amdgcn_fence(__ATOMIC_RELEASE, "agent");
            asm volatile("s_waitcnt vmcnt(0)" ::: "memory");
            const unsigned og = xb_add(&bar[XB_TOP], 1u);
            const unsigned tg = og / nx;
            if (og + 1u == (tg + 1u) * nx) xb_add(&bar[XB_TOPGEN], 1u);
            else XB_SPIN(xb_ld(&bar[XB_TOPGEN]) == tg, bar);
            __builtin_amdgcn_fence(__ATOMIC_ACQUIRE, "agent");
            xb_add(&bar[XB_XGEN(b.x)], 1u);
            asm volatile("s_waitcnt vmcnt(0)" ::: "memory");
        } else {
            XB_SPIN(xb_ld(&bar[XB_XGEN(b.x)]) == gen, bar);
            __builtin_amdgcn_fence(__ATOMIC_ACQUIRE, "agent");
            asm volatile("s_waitcnt vmcnt(0)" ::: "memory");
        }
    }
    __syncthreads();
}

namespace att {
typedef short bf16x8 __attribute__((ext_vector_type(8)));
typedef short s16x4 __attribute__((ext_vector_type(4)));
typedef float f32x16 __attribute__((ext_vector_type(16)));
typedef unsigned u32x4 __attribute__((ext_vector_type(4)));
#define ATT_LAS __attribute__((address_space(3)))
constexpr int QBLK = 32, KVBLK = 64, DQ = 96, DV = 64, LDQ = 768, LDKN = 1024, LDKR = 32, LDV = 1024, LDO = 1024;
typedef const __attribute__((address_space(1))) unsigned short* gcp; typedef __attribute__((address_space(1))) unsigned short* gp;
constexpr float SCALE = 0.10206207261596577f, QSC = SCALE * 1.4426950408889634f, THR2 = 8.f * 1.4426950408889634f;
constexpr int SHM_V = KVBLK * DV * 2, SHM_K = KVBLK * 256, NRING = 4, OFF_K = 0, OFF_V = NRING * SHM_K, OFF_WS = NRING * (SHM_V + SHM_K), ATT_LDS = OFF_WS + 8 * 256;
#define KSWZ(row, colB) ((row) * 256 + ((colB) ^ (((row) & 7) << 4)))
#define SBAR() __builtin_amdgcn_sched_barrier(0)
__device__ __forceinline__ int crow(int r, int hi) { return (r & 3) + 8 * (r >> 2) + 4 * hi; }
__device__ __forceinline__ unsigned cvtpk(float lo, float hi) { unsigned r; asm volatile("v_cvt_pk_bf16_f32 %0, %1, %2" : "=v"(r) : "v"(lo), "v"(hi)); return r; }
template <bool FIRST> __device__ __forceinline__ void partialSM(f32x16& p0, f32x16& p1, f32x16& mC, float& alpha) {
  float pmax = p0[0];
#pragma unroll
  for (int r = 1; r < 16; ++r) pmax = fmaxf(pmax, p0[r]);
#pragma unroll
  for (int r = 0; r < 16; ++r) pmax = fmaxf(pmax, p1[r]);
  { auto rr = __builtin_amdgcn_permlane32_swap(__float_as_uint(pmax), __float_as_uint(pmax), false, false);
    pmax = fmaxf(__uint_as_float(rr[0]), __uint_as_float(rr[1])); }
  if (!FIRST && __builtin_expect(__all(pmax <= THR2), 1)) alpha = 1.f;
  else { const float d = FIRST ? pmax : fmaxf(pmax, 0.f); alpha = __builtin_amdgcn_exp2f(-d);
#pragma unroll
    for (int r = 0; r < 16; ++r) { p0[r] -= d; p1[r] -= d; mC[r] -= d; } }
#pragma unroll
  for (int r = 0; r < 16; ++r) p0[r] = __builtin_amdgcn_exp2f(p0[r]);
}
__device__ __forceinline__ void finishSM(f32x16& p0, f32x16& p1, bf16x8& pa0, bf16x8& pa1, bf16x8& pa2, bf16x8& pa3) {
#pragma unroll
  for (int r = 0; r < 16; ++r) p1[r] = __builtin_amdgcn_exp2f(p1[r]);
#define PK4(P, BASE, OUT) do { u32x4 w = {cvtpk(P[BASE + 0], P[BASE + 1]), cvtpk(P[BASE + 2], P[BASE + 3]), cvtpk(P[BASE + 4], P[BASE + 5]), cvtpk(P[BASE + 6], P[BASE + 7])}; OUT = __builtin_bit_cast(bf16x8, w); } while (0)
  PK4(p0, 0, pa0); PK4(p0, 8, pa1); PK4(p1, 0, pa2); PK4(p1, 8, pa3);
#undef PK4
}
__device__ __forceinline__ void qkt(f32x16& p0, f32x16& p1, const f32x16& mC, const ATT_LAS unsigned char* Ks, const bf16x8* qr, int r32, int hi) {
#pragma unroll
  for (int d0 = 0; d0 < DQ / 16; ++d0) { const int cb = (d0 * 16 + hi * 8) * 2;
    const bf16x8 b0 = *(const ATT_LAS bf16x8*)(Ks + KSWZ(r32, cb));
    const bf16x8 b1 = *(const ATT_LAS bf16x8*)(Ks + KSWZ(32 + r32, cb));
    p0 = __builtin_amdgcn_mfma_f32_32x32x16_bf16(b0, qr[d0], d0 ? p0 : mC, 0, 0, 0);
    p1 = __builtin_amdgcn_mfma_f32_32x32x16_bf16(b1, qr[d0], d0 ? p1 : mC, 0, 0, 0); }
}
__device__ __forceinline__ int v_st(int k, int c) { const int kk = k; return ((kk >> 3) * 2 + (c >> 5)) * 512 + ((kk & 7) * 32 + (c & 31)) * 2; }
__device__ __forceinline__ int v_rd_base(int lane) { return ((lane & 3) << 3) | (((lane >> 2) & 3) << 6) | (((lane >> 4) & 1) << 5) | (((lane >> 5) & 1) << 8); }
constexpr int v_rd_off(int d0, int ks, int half) { return d0 * 512 + ks * 2048 + half * 1024; }
struct KPre { bf16x8 a0, b0, a1, b1; };
#define KLDX(KS, D0, A, B) do { A = *(const ATT_LAS bf16x8*)((KS) + KSWZ(r32, ((D0) * 16 + hi * 8) * 2)); B = *(const ATT_LAS bf16x8*)((KS) + KSWZ(32 + r32, ((D0) * 16 + hi * 8) * 2)); } while (0)
#define VLD(D0, KS_, H) __builtin_amdgcn_ds_read_tr16_b64_v4i16((ATT_LAS s16x4*)(vbp + VO + v_rd_off(D0, KS_, H)))
#define PK(L, H) (bf16x8){L[0], L[1], L[2], L[3], H[0], H[1], H[2], H[3]}
#define MFMA(A, B, C) __builtin_amdgcn_mfma_f32_32x32x16_bf16(A, B, C, 0, 0, 0)
template <int VO> __device__ __forceinline__ void region1(f32x16& n0, f32x16& n1, const f32x16& mC, const ATT_LAS unsigned char* Ks, const bf16x8* qr, int r32, int hi, const KPre& kp,
                                                          f32x16& p0, f32x16& p1, bf16x8& pa0, bf16x8& pa1, bf16x8& pa2, bf16x8& pa3, const ATT_LAS unsigned char* vbp, s16x4* vf) {
  bf16x8 kA[DQ / 16], kB[DQ / 16]; unsigned w[16]; kA[0] = kp.a0; kB[0] = kp.b0; kA[1] = kp.a1; kB[1] = kp.b1;
#define KLD(D0) KLDX(Ks, D0, kA[D0], kB[D0])
#define KMM(D0) do { n0 = MFMA(kA[D0], qr[D0], (D0) ? n0 : mC); n1 = MFMA(kB[D0], qr[D0], (D0) ? n1 : mC); } while (0)
#define EXP1(R) p1[R] = __builtin_amdgcn_exp2f(p1[R])
  KLD(2); KMM(0); EXP1(0); EXP1(1); EXP1(2); EXP1(3); EXP1(4); EXP1(5); w[0] = cvtpk(p0[0], p0[1]); w[1] = cvtpk(p0[2], p0[3]); SBAR();
  KLD(3); KMM(1); EXP1(6); EXP1(7); EXP1(8); EXP1(9); EXP1(10); EXP1(11); w[2] = cvtpk(p0[4], p0[5]); w[3] = cvtpk(p0[6], p0[7]); SBAR();
  KLD(4); KMM(2); EXP1(12); EXP1(13); EXP1(14); EXP1(15); w[4] = cvtpk(p0[8], p0[9]); w[5] = cvtpk(p0[10], p0[11]); w[6] = cvtpk(p0[12], p0[13]); w[7] = cvtpk(p0[14], p0[15]); SBAR();
  KLD(5); KMM(3); w[8] = cvtpk(p1[0], p1[1]); w[9] = cvtpk(p1[2], p1[3]); w[10] = cvtpk(p1[4], p1[5]); w[11] = cvtpk(p1[6], p1[7]); SBAR();
#pragma unroll
  for (int ks = 0; ks < 4; ++ks) { vf[2 * ks] = VLD(0, ks, 0); vf[2 * ks + 1] = VLD(0, ks, 1); }
  KMM(4); w[12] = cvtpk(p1[8], p1[9]); w[13] = cvtpk(p1[10], p1[11]); w[14] = cvtpk(p1[12], p1[13]); w[15] = cvtpk(p1[14], p1[15]); SBAR();
  KMM(5);
#undef KLD
#undef KMM
#undef EXP1
  { const u32x4 a = {w[0], w[1], w[2], w[3]}, b = {w[4], w[5], w[6], w[7]}, c = {w[8], w[9], w[10], w[11]}, d = {w[12], w[13], w[14], w[15]};
    pa0 = __builtin_bit_cast(bf16x8, a); pa1 = __builtin_bit_cast(bf16x8, b); pa2 = __builtin_bit_cast(bf16x8, c); pa3 = __builtin_bit_cast(bf16x8, d); }
}
template <int VO> __device__ __forceinline__ void region2(f32x16* o, const s16x4* vf, const ATT_LAS unsigned char* vbp, bf16x8 pa0, bf16x8 pa1, bf16x8 pa2, bf16x8 pa3, bf16x8 ones,
                                                          f32x16& n0, f32x16& n1, f32x16& mC, float& alpha) {
  s16x4 vg[8];
#pragma unroll
  for (int ks = 0; ks < 4; ++ks) { vg[2 * ks] = VLD(1, ks, 0); vg[2 * ks + 1] = VLD(1, ks, 1); }
#define MX3(A, P, R) A = fmaxf(fmaxf(A, P[R]), P[R + 1])
  o[0] = MFMA(pa0, PK(vf[0], vf[1]), o[0]); o[2] = MFMA(pa0, ones, o[2]); SBAR();
  float ma = fmaxf(n0[0], n0[1]), mb = fmaxf(n1[0], n1[1]);
  o[0] = MFMA(pa1, PK(vf[2], vf[3]), o[0]); o[2] = MFMA(pa1, ones, o[2]); MX3(ma, n0, 2); MX3(mb, n1, 2); MX3(ma, n0, 4); MX3(mb, n1, 4); SBAR();
  o[0] = MFMA(pa2, PK(vf[4], vf[5]), o[0]); o[2] = MFMA(pa2, ones, o[2]); MX3(ma, n0, 6); MX3(mb, n1, 6); MX3(ma, n0, 8); MX3(mb, n1, 8); MX3(ma, n0, 10); MX3(mb, n1, 10); SBAR();
  o[0] = MFMA(pa3, PK(vf[6], vf[7]), o[0]); o[2] = MFMA(pa3, ones, o[2]); MX3(ma, n0, 12); MX3(mb, n1, 12); MX3(ma, n0, 14); MX3(mb, n1, 14);
  float pmax = fmaxf(ma, mb);
  { auto rr = __builtin_amdgcn_permlane32_swap(__float_as_uint(pmax), __float_as_uint(pmax), false, false);
    pmax = fmaxf(__uint_as_float(rr[0]), __uint_as_float(rr[1])); }
  if (__builtin_expect(__all(pmax <= THR2), 1)) alpha = 1.f;
  else { const float d = fmaxf(pmax, 0.f); alpha = __builtin_amdgcn_exp2f(-d);
#pragma unroll
    for (int r = 0; r < 16; ++r) { n0[r] -= d; n1[r] -= d; mC[r] -= d; } }
#define EXP4(R) do { float e0 = __builtin_amdgcn_exp2f(n0[R]), e1 = __builtin_amdgcn_exp2f(n0[R + 1]), e2 = __builtin_amdgcn_exp2f(n0[R + 2]), e3 = __builtin_amdgcn_exp2f(n0[R + 3]); \
    asm volatile("" : "+v"(e0), "+v"(e1), "+v"(e2), "+v"(e3)); n0[R] = e0; n0[R + 1] = e1; n0[R + 2] = e2; n0[R + 3] = e3; } while (0)
  SBAR(); o[1] = MFMA(pa0, PK(vg[0], vg[1]), o[1]); EXP4(0); SBAR();
  o[1] = MFMA(pa1, PK(vg[2], vg[3]), o[1]); EXP4(4); SBAR();
  o[1] = MFMA(pa2, PK(vg[4], vg[5]), o[1]); EXP4(8); SBAR();
  o[1] = MFMA(pa3, PK(vg[6], vg[7]), o[1]); EXP4(12);
#undef EXP4
#undef MX3
}
template <int VO> __device__ __forceinline__ void pv_last(f32x16* o, const ATT_LAS unsigned char* vbp, bf16x8 pa0, bf16x8 pa1, bf16x8 pa2, bf16x8 pa3, bf16x8 ones) {
  s16x4 vf[8], vg[8];
#pragma unroll
  for (int ks = 0; ks < 4; ++ks) { vf[2 * ks] = VLD(0, ks, 0); vf[2 * ks + 1] = VLD(0, ks, 1); vg[2 * ks] = VLD(1, ks, 0); vg[2 * ks + 1] = VLD(1, ks, 1); }
  o[0] = MFMA(pa0, PK(vf[0], vf[1]), o[0]); o[1] = MFMA(pa0, PK(vg[0], vg[1]), o[1]); o[2] = MFMA(pa0, ones, o[2]);
  o[0] = MFMA(pa1, PK(vf[2], vf[3]), o[0]); o[1] = MFMA(pa1, PK(vg[2], vg[3]), o[1]); o[2] = MFMA(pa1, ones, o[2]);
  o[0] = MFMA(pa2, PK(vf[4], vf[5]), o[0]); o[1] = MFMA(pa2, PK(vg[4], vg[5]), o[1]); o[2] = MFMA(pa2, ones, o[2]);
  o[0] = MFMA(pa3, PK(vf[6], vf[7]), o[0]); o[1] = MFMA(pa3, PK(vg[6], vg[7]), o[1]); o[2] = MFMA(pa3, ones, o[2]);
}
#undef VLD
#undef PK
#undef MFMA

__device__ __forceinline__ void attn_unit(const unsigned short* Qb_, const unsigned short* Kn_, const unsigned short* Kr_, const unsigned short* Vc_, int ra, int nt_a, int rb, int NT,
                                          unsigned short* Ob_, ATT_LAS unsigned char* lds, int rope_t0) {
  gcp Qb = (gcp)Qb_, Kn = (gcp)Kn_, Kr = (gcp)Kr_, Vc = (gcp)Vc_; gp Ob = (gp)Ob_;
  const int tid = threadIdx.x, wid = tid >> 6, lane = tid & 63, r32 = lane & 31, hi = lane >> 5;
  ATT_LAS unsigned char* V_lds = lds + OFF_V; ATT_LAS unsigned char* K_lds = lds + OFF_K;
  ATT_LAS float* wsp = (ATT_LAS float*)(lds + OFF_WS) + wid * 64; ATT_LAS float* al_l = wsp + 32;
  f32x16 o[3] = {}, mC = {}; bf16x8 qr[DQ / 16]; const u32x4 ones_w = {0x3f803f80u, 0x3f803f80u, 0x3f803f80u, 0x3f803f80u}; const bf16x8 ones = __builtin_bit_cast(bf16x8, ones_w);
  const int sk = tid >> 3, sc = (tid & 7) * 8, rk = (tid & 255) >> 2, rc = (tid & 3) * 8; const bool rw = tid < 256;
  const int vst = v_st(sk, sc), kst0 = KSWZ(sk, sc * 2), kst1 = KSWZ(rk, (64 + rc) * 2);
  struct SR { bf16x8 vs, k0, k1; };
#define TROW(t) ((t) < nt_a ? ra + (t) * KVBLK : rb + ((t) - nt_a) * KVBLK)
#define SLOADX(S, t) do { const long r0_ = TROW(t); S.vs = *(const __attribute__((address_space(1))) bf16x8*)(Vc + (r0_ + sk) * LDV + sc); S.k0 = *(const __attribute__((address_space(1))) bf16x8*)(Kn + (r0_ + sk) * LDKN + sc); \
    S.k1 = *(const __attribute__((address_space(1))) bf16x8*)(Kr + (r0_ + rk) * LDKR + rc); } while (0)
#define SWRITEX(b, S) do { *(ATT_LAS bf16x8*)(V_lds + (b) * SHM_V + vst) = S.vs; *(ATT_LAS bf16x8*)(K_lds + (b) * SHM_K + kst0) = S.k0; \
    if (rw) *(ATT_LAS bf16x8*)(K_lds + (b) * SHM_K + kst1) = S.k1; } while (0)
  SR s0_, s1_, sr_; SLOADX(s0_, 0); SLOADX(s1_, 1); SLOADX(sr_, 2);
  gcp Qw = Qb + (long)(wid * QBLK + r32) * LDQ + hi * 8;
#pragma unroll
  for (int d0 = 0; d0 < DQ / 16; ++d0) qr[d0] = *(const __attribute__((address_space(1))) bf16x8*)(Qw + d0 * 16);
  if (rope_t0 >= 0) {
    int t = rope_t0 + wid * QBLK + r32; asm volatile("" : "+v"(t));
    const float prow = (float)(t >> 6), pcol = (float)(t & 63);
#pragma unroll
    for (int f = 0; f < 2; ++f) { const u32x4 own = __builtin_bit_cast(u32x4, qr[4 + f]); u32x4 oth;
      oth.x = (unsigned)__shfl_xor((int)own.x, 32); oth.y = (unsigned)__shfl_xor((int)own.y, 32); oth.z = (unsigned)__shfl_xor((int)own.z, 32); oth.w = (unsigned)__shfl_xor((int)own.w, 32);
      const float pos = f ? pcol : prow; float o8[8];
#pragma unroll
      for (int j = 0; j < 8; ++j) { const unsigned wo = (j < 2) ? own.x : (j < 4) ? own.y : (j < 6) ? own.z : own.w, wp = (j < 2) ? oth.x : (j < 4) ? oth.y : (j < 6) ? oth.z : oth.w;
        const float a = (j & 1) ? __uint_as_float(wo & 0xffff0000u) : __uint_as_float(wo << 16), bq = (j & 1) ? __uint_as_float(wp & 0xffff0000u) : __uint_as_float(wp << 16);
        const float ang = pos * __builtin_amdgcn_exp2f(-(float)j * (13.287712379549449f / 8.0f)); float sn, cs; __sincosf(ang, &sn, &cs);
        o8[j] = hi ? (a * cs + bq * sn) : (a * cs - bq * sn); }
      u32x4 w = {cvtpk(o8[0], o8[1]), cvtpk(o8[2], o8[3]), cvtpk(o8[4], o8[5]), cvtpk(o8[6], o8[7])}; qr[4 + f] = __builtin_bit_cast(bf16x8, w); } }
#pragma unroll
  for (int d0 = 0; d0 < DQ / 16; ++d0) { const u32x4 w = __builtin_bit_cast(u32x4, qr[d0]); u32x4 q;
#pragma unroll
    for (int i = 0; i < 4; ++i) q[i] = cvtpk(__uint_as_float(w[i] << 16) * QSC, __uint_as_float(w[i] & 0xffff0000u) * QSC);
    qr[d0] = __builtin_bit_cast(bf16x8, q); }
#define SLOAD(t) SLOADX(sr_, t)
#define SWRITE(b) SWRITEX(b, sr_)
#define SWAIT() asm volatile("s_waitcnt vmcnt(0)" ::: "memory")
#define BAR() asm volatile("s_barrier" ::: "memory")
#define RESC(a) do { if (__any((a) < 1.f)) { if (hi == 0) al_l[r32] = (a); asm volatile("s_waitcnt lgkmcnt(0)" ::: "memory"); \
    _Pragma("unroll") for (int d = 0; d < 3; ++d) _Pragma("unroll") for (int r = 0; r < 16; ++r) o[d][r] *= al_l[crow(r, hi)]; } } while (0)
#define KPRE(KB) do { KLDX(K_lds + (KB) * SHM_K, 0, kp.a0, kp.b0); KLDX(K_lds + (KB) * SHM_K, 1, kp.a1, kp.b1); } while (0)
  f32x16 pA0, pA1, pB0, pB1; float alA, alB; bf16x8 pa0, pa1, pa2, pa3; KPre kp; s16x4 vf[8];
  const ATT_LAS unsigned char* vbp = V_lds + v_rd_base(lane);
  SWAIT(); SWRITEX(0, s0_); SWRITEX(1, s1_); SWRITE(2); SLOAD(3); __syncthreads();
  qkt(pA0, pA1, mC, K_lds, qr, r32, hi); partialSM<true>(pA0, pA1, mC, alA);
  KPRE(1); BAR();
#define STEP(PN0, PN1, ALN, PO0, PO1, KB, VB, T, WR, LD, NX) do { \
    SBAR(); if (WR) { SWAIT(); SWRITE(((KB) + 2) & 3); } if (LD) SLOAD((T) + 3); SBAR(); \
    region1<(VB) * SHM_V>(PN0, PN1, mC, K_lds + (KB) * SHM_K, qr, r32, hi, kp, PO0, PO1, pa0, pa1, pa2, pa3, vbp, vf); SBAR(); \
    region2<(VB) * SHM_V>(o, vf, vbp, pa0, pa1, pa2, pa3, ones, PN0, PN1, mC, ALN); SBAR(); \
    if (NX) KPRE(((KB) + 1) & 3); RESC(ALN); BAR(); } while (0)
  int j = 1;
  for (; j + 3 < NT; j += 4) {
    STEP(pB0, pB1, alB, pA0, pA1, 1, 0, j, true, true, true);
    STEP(pA0, pA1, alA, pB0, pB1, 2, 1, j + 1, true, true, true);
    STEP(pB0, pB1, alB, pA0, pA1, 3, 2, j + 2, true, true, true);
    STEP(pA0, pA1, alA, pB0, pB1, 0, 3, j + 3, true, true, true);
  }
  STEP(pB0, pB1, alB, pA0, pA1, 1, 0, j, true, false, true);
  STEP(pA0, pA1, alA, pB0, pB1, 2, 1, j + 1, false, false, true);
  STEP(pB0, pB1, alB, pA0, pA1, 3, 2, j + 2, false, false, false);
  finishSM(pB0, pB1, pa0, pa1, pa2, pa3); SBAR();
  pv_last<3 * SHM_V>(o, vbp, pa0, pa1, pa2, pa3, ones);
  float rli[16];
#pragma unroll
  for (int r = 0; r < 16; ++r) rli[r] = __builtin_amdgcn_rcpf(o[2][r]);
  gp Ow = Ob + (long)(wid * QBLK) * LDO;
#pragma unroll
  for (int r = 0; r < 16; ++r) { const int orow = crow(r, hi);
#pragma unroll
    for (int d0 = 0; d0 < 2; ++d0) Ow[(long)orow * LDO + d0 * 32 + r32] = (unsigned short)(cvtpk(o[d0][r] * rli[r], 0.f) & 0xffffu); }
  asm volatile("s_waitcnt vmcnt(0)" ::: "memory");
  __syncthreads();
#undef TROW
#undef SLOAD
#undef SWRITE
#undef SLOADX
#undef SWRITEX
#undef STEP
#undef BAR
#undef KPRE
#undef SWAIT
#undef RESC
}
#undef KLDX
#undef KSWZ
#undef SBAR
}

namespace gla {
typedef short bf16x8 __attribute__((ext_vector_type(8)));
typedef short s16x4 __attribute__((ext_vector_type(4)));
typedef float f32x16 __attribute__((ext_vector_type(16)));
typedef float f32x4 __attribute__((ext_vector_type(4)));
typedef float f32x2 __attribute__((ext_vector_type(2)));
typedef __bf16 bf16x2_t __attribute__((ext_vector_type(2)));
typedef unsigned u32x4 __attribute__((ext_vector_type(4)));
typedef unsigned u32x2 __attribute__((ext_vector_type(2)));
#define GLA_LAS __attribute__((address_space(3)))
#define GLA_GAS __attribute__((address_space(1)))
constexpr int RS256 = 272, RS128 = 144;
constexpr int OFF_QT = 0, OFF_KT = 64 * RS256, OFF_KH = 2 * 64 * RS256, OFF_V = OFF_KH + 128 * RS128, OFF_P = OFF_V + 32768, OFF_TOT = OFF_P + 64 * RS128, OFF_EL = OFF_TOT + 2048, OFF_ZG = OFF_EL + 512, OFF_W2 = OFF_ZG + 4096, GLA_LDS = OFF_W2 + 8192;
static_assert(GLA_LDS <= 131072 && OFF_V % 16 == 0 && OFF_P % 16 == 0 && OFF_TOT % 16 == 0, "gla lds map");
__device__ __forceinline__ int swz256(int row, int colB) { return row * RS256 + colB; }
__device__ __forceinline__ int swz128(int row, int colB) { return row * RS128 + colB; }
__device__ __forceinline__ int crow(int r, int hi) { return (r & 3) + 8 * (r >> 2) + 4 * hi; }
__device__ __forceinline__ unsigned pk2f(float lo, float hi) { const f32x2 v = {lo, hi}; return __builtin_bit_cast(unsigned, __builtin_convertvector(v, bf16x2_t)); }
__device__ __forceinline__ unsigned short bf1f(float x) { return (unsigned short)(pk2f(x, 0.f) & 0xffffu); }
__device__ __forceinline__ float bfu(unsigned short u) { return __uint_as_float(((unsigned)u) << 16); }
__device__ __forceinline__ int v_st(int k, int c) { const int kk = (k & ~0xC) | ((k & 4) << 1) | ((k & 8) >> 1); return ((kk >> 3) * 8 + (c >> 5)) * 512 + ((kk & 7) * 32 + (c & 31)) * 2; }
__device__ __forceinline__ int v_rd_base(int lane) { return ((lane & 3) << 3) | (((lane >> 2) & 3) << 6) | (((lane >> 4) & 1) << 5) | (((lane >> 5) & 1) << 8); }
template <int OFF> __device__ __forceinline__ s16x4 tr_read(int vb) { s16x4 r; asm volatile("ds_read_b64_tr_b16 %0, %1 offset:%2" : "=&v"(r) : "v"(vb), "i"(OFF) : "memory"); return r; }
#define GLA_MFMA(a, b, c) __builtin_amdgcn_mfma_f32_32x32x16_bf16((a), (b), (c), 0, 0, 0)
__device__ __forceinline__ bf16x8 pack_step(const f32x16& x, int s) {
    u32x4 p; p.x = pk2f(x[8 * s], x[8 * s + 1]); p.y = pk2f(x[8 * s + 2], x[8 * s + 3]); p.z = pk2f(x[8 * s + 4], x[8 * s + 5]); p.w = pk2f(x[8 * s + 6], x[8 * s + 7]); return __builtin_bit_cast(bf16x8, p);
}
__device__ __forceinline__ void gla_prep(const unsigned short* QK_, const unsigned short* ZG_, const float* w2_, const float* b2_, unsigned short* TQ_, unsigned short* TK_, unsigned short* TP_, float* EL_,
                                         int b, int h, int dir, int c_lo, int c_hi, int ML_, int SEQ_, int CTX_, GLA_LAS unsigned char* lds) {
    const GLA_GAS unsigned short* QK = (const GLA_GAS unsigned short*)QK_; const GLA_GAS unsigned short* ZG = (const GLA_GAS unsigned short*)ZG_;
    const GLA_GAS float* w2g = (const GLA_GAS float*)w2_; const GLA_GAS float* b2g = (const GLA_GAS float*)b2_;
    const int tid = threadIdx.x, wid = __builtin_amdgcn_readfirstlane(tid >> 6), lane = tid & 63, r32 = lane & 31, hi = lane >> 5;
    const int seg = tid >> 7, kk = tid & 127;
    GLA_LAS unsigned char* QT = lds + OFF_QT; GLA_LAS unsigned char* KT = lds + OFF_KT;
    GLA_LAS float* TOT = (GLA_LAS float*)(lds + OFF_TOT); GLA_LAS float* ZGS = (GLA_LAS float*)(lds + OFF_ZG); GLA_LAS float* W2S = (GLA_LAS float*)(lds + OFF_W2);
    __syncthreads();
#pragma unroll
    for (int i = 0; i < 4; ++i) { const int idx = tid + 512 * i; W2S[idx] = w2g[(size_t)(dir * 16 + (idx >> 7)) * 512 + h * 128 + (idx & 127)]; }
    const float b2 = b2g[dir * 512 + h * 128 + kk];
    const int nctx = CTX_ / 64;
    GLA_LAS unsigned* RAW = (GLA_LAS unsigned*)(lds + OFF_V);
    u32x4 sq0, sq1, sk0, sk1; unsigned zgw;
#define GLA_PLOAD(cs_) do { const long r0_ = ((cs_) < nctx) ? (long)ML_ + (long)b * CTX_ + 64 * (cs_) : (long)b * SEQ_ + 64 * ((cs_) - nctx); \
        zgw = *(const GLA_GAS unsigned*)(ZG + (r0_ + (tid >> 3)) * 2304 + dir * 16 + (tid & 7) * 2); \
        const GLA_GAS unsigned short* zr_ = QK + (r0_ + (tid >> 3)) * 1024 + h * 128 + 16 * (tid & 7); \
        sq0 = *(const GLA_GAS u32x4*)(zr_); sq1 = *(const GLA_GAS u32x4*)(zr_ + 8); sk0 = *(const GLA_GAS u32x4*)(zr_ + 512); sk1 = *(const GLA_GAS u32x4*)(zr_ + 520); } while (0)
    GLA_PLOAD(c_lo);
    for (int cs = c_lo; cs < c_hi; ++cs) {
        { u32x4 w0, w1, w2, w3;
#define GLA_IL(W, QW, KW, J) W[2 * (J)] = __builtin_amdgcn_perm(KW[J], QW[J], 0x05040100u); W[2 * (J) + 1] = __builtin_amdgcn_perm(KW[J], QW[J], 0x07060302u)
          { unsigned t_[8];
#define GLA_IL4(QW, KW) do { _Pragma("unroll") for (int j_ = 0; j_ < 4; ++j_) { t_[2 * j_] = __builtin_amdgcn_perm(KW[j_], QW[j_], 0x05040100u); t_[2 * j_ + 1] = __builtin_amdgcn_perm(KW[j_], QW[j_], 0x07060302u); } } while (0)
            GLA_IL4(sq0, sk0); w0 = u32x4{t_[0], t_[1], t_[2], t_[3]}; w1 = u32x4{t_[4], t_[5], t_[6], t_[7]};
            GLA_IL4(sq1, sk1); w2 = u32x4{t_[0], t_[1], t_[2], t_[3]}; w3 = u32x4{t_[4], t_[5], t_[6], t_[7]}; }
#undef GLA_IL4
#undef GLA_IL
          GLA_LAS u32x4* dst = (GLA_LAS u32x4*)(RAW + (tid >> 3) * 128 + 16 * (tid & 7)); dst[0] = w0; dst[1] = w1; dst[2] = w2; dst[3] = w3; }
        const size_t tile = (size_t)((b * 4 + h) * 2 + dir) * 36 + cs;
        GLA_GAS unsigned short* TQ = (GLA_GAS unsigned short*)TQ_ + tile * 8192; GLA_GAS unsigned short* TK = (GLA_GAS unsigned short*)TK_ + tile * 8192; GLA_GAS unsigned short* TP = (GLA_GAS unsigned short*)TP_ + tile * 4096;
        { const int l = tid >> 3, r2 = (tid & 7) * 2; ZGS[l * 16 + r2] = __uint_as_float(zgw << 16); ZGS[l * 16 + r2 + 1] = __uint_as_float(zgw & 0xffff0000u); }
        if (cs + 1 < c_hi) GLA_PLOAD(cs + 1);
        __syncthreads();
        unsigned raw[16];
#pragma unroll
        for (int i = 0; i < 16; ++i) raw[i] = RAW[(16 * seg + i) * 128 + kk];
        float cum[16];
#pragma unroll
        for (int i = 0; i < 16; ++i) cum[i] = b2;
#pragma unroll
        for (int q = 0; q < 4; ++q) { const float wa = W2S[(4 * q) * 128 + kk], wb = W2S[(4 * q + 1) * 128 + kk], wc_ = W2S[(4 * q + 2) * 128 + kk], wd = W2S[(4 * q + 3) * 128 + kk];
#pragma unroll
            for (int i = 0; i < 16; ++i) { const f32x4 z = *(const GLA_LAS f32x4*)(ZGS + (16 * seg + i) * 16 + 4 * q); cum[i] += z.x * wa + z.y * wb + z.z * wc_ + z.w * wd; } }
#pragma unroll
        for (int i = 0; i < 16; ++i) { const float x = cum[i]; cum[i] = (fminf(x, 0.f) - __logf(1.0f + __expf(-fabsf(x)))) * (1.0f / 16.0f); }
        if (dir == 0) {
#pragma unroll
            for (int i = 1; i < 16; ++i) cum[i] += cum[i - 1];
            TOT[seg * 128 + kk] = cum[15];
        } else {
#pragma unroll
            for (int i = 14; i >= 0; --i) cum[i] += cum[i + 1];
            TOT[seg * 128 + kk] = cum[0];
        }
        __syncthreads();
        { const float t0 = TOT[kk], t1 = TOT[128 + kk], t2 = TOT[256 + kk], t3 = TOT[384 + kk]; const float last = (t0 + t1) + (t2 + t3);
          float off;
          if (dir == 0) off = (seg > 0 ? t0 : 0.f) + (seg > 1 ? t1 : 0.f) + (seg > 2 ? t2 : 0.f);
          else off = (seg < 3 ? t3 : 0.f) + (seg < 2 ? t2 : 0.f) + (seg < 1 ? t1 : 0.f);
          if (seg == 0) ((GLA_GAS float*)EL_)[tile * 128 + kk] = __expf(last);
          unsigned ktp[8];
#pragma unroll
          for (int i = 0; i < 16; i += 2) {
              const float c0 = cum[i] + off, c1 = cum[i + 1] + off; const int l0 = 16 * seg + i, l1 = l0 + 1;
              const float q0 = __uint_as_float(raw[i] << 16), k0v = __uint_as_float(raw[i] & 0xffff0000u), q1 = __uint_as_float(raw[i + 1] << 16), k1v = __uint_as_float(raw[i + 1] & 0xffff0000u);
              const unsigned short qa = bf1f(q0 * __expf(c0)), qb = bf1f(q1 * __expf(c1)); const float ka = k0v * __expf(-c0), kb = k1v * __expf(-c1); const unsigned kp = pk2f(ka, kb);
              *(GLA_LAS unsigned short*)(QT + swz256(l0, 2 * kk)) = qa; *(GLA_LAS unsigned short*)(QT + swz256(l1, 2 * kk)) = qb;
              *(GLA_LAS unsigned short*)(KT + swz256(l0, 2 * kk)) = (unsigned short)(kp & 0xffffu); *(GLA_LAS unsigned short*)(KT + swz256(l1, 2 * kk)) = (unsigned short)(kp >> 16);
              TQ[l0 * 128 + kk] = qa; TQ[l1 * 128 + kk] = qb; ktp[i >> 1] = kp; }
          u32x4 k0 = {ktp[0], ktp[1], ktp[2], ktp[3]}, k1 = {ktp[4], ktp[5], ktp[6], ktp[7]};
          *(GLA_GAS u32x4*)(TK + kk * 64 + 16 * seg) = k0; *(GLA_GAS u32x4*)(TK + kk * 64 + 16 * seg + 8) = k1; }
        __syncthreads();
        if (wid < 4) { const int mi = wid >> 1, li = wid & 1; f32x16 x = f32x16{};
#pragma unroll
            for (int s2 = 0; s2 < 8; ++s2) { const int cb = (16 * s2 + 8 * hi) * 2;
                const bf16x8 a = *(const GLA_LAS bf16x8*)(KT + swz256(32 * mi + r32, cb)); const bf16x8 bq = *(const GLA_LAS bf16x8*)(QT + swz256(32 * li + r32, cb)); x = GLA_MFMA(a, bq, x); }
            const int l = 32 * li + r32;
#pragma unroll
            for (int g = 0; g < 4; ++g) { float v[4];
#pragma unroll
                for (int j = 0; j < 4; ++j) { const int m = 32 * mi + 8 * g + 4 * hi + j; const bool keep = (dir == 0) ? (m <= l) : (m >= l); v[j] = keep ? x[4 * g + j] : 0.f; }
                u32x2 w; w.x = pk2f(v[0], v[1]); w.y = pk2f(v[2], v[3]); *(GLA_GAS u32x2*)(TP + l * 64 + 32 * mi + 8 * g + 4 * hi) = w; } }
    }
#undef GLA_PLOAD
    __syncthreads();
}
__device__ __forceinline__ void gla_chain(const unsigned short* VR_, const unsigned short* TQ_, const unsigned short* TK_, const unsigned short* TP_, const float* EL_, unsigned short* O_, int b, int h, int dir,
                                          int ML_, int SEQ_, int CTX_, GLA_LAS unsigned char* lds) {
    const GLA_GAS unsigned short* VR = (const GLA_GAS unsigned short*)VR_; GLA_GAS unsigned short* O = (GLA_GAS unsigned short*)O_;
    const int tid = threadIdx.x, wid = __builtin_amdgcn_readfirstlane(tid >> 6), lane = tid & 63, r32 = lane & 31, hi = lane >> 5;
    GLA_LAS unsigned char* QT = lds + OFF_QT; GLA_LAS unsigned char* KH = lds + OFF_KH; GLA_LAS unsigned char* VI = lds + OFF_V; GLA_LAS unsigned char* PI = lds + OFF_P; GLA_LAS float* EL = (GLA_LAS float*)(lds + OFF_EL);
    f32x16 S[4];
#pragma unroll
    for (int t = 0; t < 4; ++t) S[t] = f32x16{};
    const int vb = (int)(unsigned)(uintptr_t)VI + v_rd_base(lane) + wid * 512;
    const int nchunk = (CTX_ + SEQ_) / 64, nctx = CTX_ / 64;
    const size_t tile0 = (size_t)((b * 4 + h) * 2 + dir) * 36;
    u32x4 pq[2], pk[2], pp, pv[4]; float pe = 0.f;
#define GLA_CS(sc_) ((dir == 0) ? (sc_) : (((sc_) < nctx) ? (nctx - 1 - (sc_)) : (nchunk - 1 - ((sc_) - nctx))))
#define GLA_FETCH(sc_) do { const int cs_ = GLA_CS(sc_); const size_t t_ = tile0 + cs_; const long r0_ = (cs_ < nctx) ? (long)ML_ + (long)b * CTX_ + 64 * cs_ : (long)b * SEQ_ + 64 * (cs_ - nctx); \
        const GLA_GAS u32x4* q_ = (const GLA_GAS u32x4*)((const GLA_GAS unsigned short*)TQ_ + t_ * 8192); const GLA_GAS u32x4* k_ = (const GLA_GAS u32x4*)((const GLA_GAS unsigned short*)TK_ + t_ * 8192); \
        pq[0] = q_[tid]; pq[1] = q_[tid + 512]; pk[0] = k_[tid]; pk[1] = k_[tid + 512]; pp = ((const GLA_GAS u32x4*)((const GLA_GAS unsigned short*)TP_ + t_ * 4096))[tid]; \
        if (tid < 128) pe = ((const GLA_GAS float*)EL_)[t_ * 128 + tid]; \
        _Pragma("unroll") for (int i_ = 0; i_ < 4; ++i_) { const int c_ = tid + 512 * i_; pv[i_] = *(const GLA_GAS u32x4*)(VR + (r0_ + (c_ >> 5)) * 2304 + h * 256 + (c_ & 31) * 8); } } while (0)
    GLA_FETCH(0);
    for (int sc = 0; sc < nchunk; ++sc) {
        const int cs = GLA_CS(sc); const bool is_lat = cs >= nctx; const long row0 = is_lat ? (long)b * SEQ_ + 64 * (cs - nctx) : (long)ML_ + (long)b * CTX_ + 64 * cs;
#pragma unroll
        for (int i = 0; i < 2; ++i) { const int c = tid + 512 * i; *(GLA_LAS u32x4*)(QT + (c >> 4) * RS256 + (c & 15) * 16) = pq[i]; *(GLA_LAS u32x4*)(KH + (c >> 3) * RS128 + (c & 7) * 16) = pk[i]; }
        *(GLA_LAS u32x4*)(PI + (tid >> 3) * RS128 + (tid & 7) * 16) = pp;
        if (tid < 128) EL[tid] = pe;
#pragma unroll
        for (int i = 0; i < 4; ++i) { const int c = tid + 512 * i; *(GLA_LAS u32x4*)(VI + v_st(c >> 5, (c & 31) * 8)) = pv[i]; }
        __syncthreads();
        if (sc + 1 < nchunk) GLA_FETCH(sc + 1);
        f32x16 o[2] = {f32x16{}, f32x16{}};
#pragma unroll
        for (int kt = 0; kt < 4; ++kt)
#pragma unroll
            for (int s2 = 0; s2 < 2; ++s2) { const bf16x8 bs = pack_step(S[kt], s2); const int cb0 = (32 * kt + 16 * s2 + 4 * hi) * 2;
#pragma unroll
                for (int rb = 0; rb < 2; ++rb) { const int l = 32 * rb + r32;
                    const s16x4 a0 = *(const GLA_LAS s16x4*)(QT + swz256(l, cb0)), a1 = *(const GLA_LAS s16x4*)(QT + swz256(l, cb0 + 16));
                    const bf16x8 a = {a0[0], a0[1], a0[2], a0[3], a1[0], a1[1], a1[2], a1[3]}; o[rb] = GLA_MFMA(a, bs, o[rb]); } }
        bf16x8 vf[4];
        { const s16x4 l0 = tr_read<0 * 8192>(vb), h0 = tr_read<0 * 8192 + 4096>(vb), l1 = tr_read<1 * 8192>(vb), h1 = tr_read<1 * 8192 + 4096>(vb);
          const s16x4 l2 = tr_read<2 * 8192>(vb), h2 = tr_read<2 * 8192 + 4096>(vb), l3 = tr_read<3 * 8192>(vb), h3 = tr_read<3 * 8192 + 4096>(vb);
          asm volatile("s_waitcnt lgkmcnt(0)" ::: "memory"); __builtin_amdgcn_sched_barrier(0);
          vf[0] = (bf16x8){l0[0], l0[1], l0[2], l0[3], h0[0], h0[1], h0[2], h0[3]}; vf[1] = (bf16x8){l1[0], l1[1], l1[2], l1[3], h1[0], h1[1], h1[2], h1[3]};
          vf[2] = (bf16x8){l2[0], l2[1], l2[2], l2[3], h2[0], h2[1], h2[2], h2[3]}; vf[3] = (bf16x8){l3[0], l3[1], l3[2], l3[3], h3[0], h3[1], h3[2], h3[3]}; }
#pragma unroll
        for (int rb = 0; rb < 2; ++rb)
#pragma unroll
            for (int ks = 0; ks < 4; ++ks) { const bf16x8 a = *(const GLA_LAS bf16x8*)(PI + swz128(32 * rb + r32, (16 * ks + 8 * hi) * 2)); o[rb] = GLA_MFMA(a, vf[ks], o[rb]); }
        if (is_lat) {
#pragma unroll
            for (int rb = 0; rb < 2; ++rb)
#pragma unroll
                for (int r = 0; r < 16; ++r) O[(row0 + 32 * rb + crow(r, hi)) * 1024 + h * 256 + 32 * wid + r32] = bf1f(o[rb][r]); }
#pragma unroll
        for (int kt = 0; kt < 4; ++kt) {
#pragma unroll
            for (int ks = 0; ks < 4; ++ks) { const bf16x8 a = *(const GLA_LAS bf16x8*)(KH + swz128(32 * kt + r32, (16 * ks + 8 * hi) * 2)); S[kt] = GLA_MFMA(a, vf[ks], S[kt]); }
#pragma unroll
            for (int r = 0; r < 16; ++r) S[kt][r] *= EL[32 * kt + crow(r, hi)]; }
        __syncthreads();
    }
#undef GLA_FETCH
#undef GLA_CS
}
__device__ __forceinline__ int v_st4(int k, int c) { const int kk = (k & ~0xC) | ((k & 4) << 1) | ((k & 8) >> 1); return ((kk >> 3) * 4 + (c >> 5)) * 512 + ((kk & 7) * 32 + (c & 31)) * 2; }
constexpr int OFF_XO_A = OFF_KT, OFF_XO_B = OFF_V + 16384;
static_assert(OFF_XO_A + 16384 <= OFF_KH && OFF_XO_B + 16384 <= OFF_P, "gla chain2 lds map");
__device__ __forceinline__ void gla_chain2(const unsigned short* VR_, const unsigned short* TQ_, const unsigned short* TK_, const unsigned short* TP_, const float* EL_, unsigned short* O_, int b, int h, int dir, int vh,
                                           int ML_, int SEQ_, int CTX_, GLA_LAS unsigned char* lds) {
    const GLA_GAS unsigned short* VR = (const GLA_GAS unsigned short*)VR_; GLA_GAS unsigned short* O = (GLA_GAS unsigned short*)O_;
    const int tid = threadIdx.x, wid = __builtin_amdgcn_readfirstlane(tid >> 6), lane = tid & 63, r32 = lane & 31, hi = lane >> 5;
    const int vt = wid & 3, kh = wid >> 2;
    GLA_LAS unsigned char* QT = lds + OFF_QT; GLA_LAS unsigned char* KH = lds + OFF_KH; GLA_LAS unsigned char* VI = lds + OFF_V; GLA_LAS unsigned char* PI = lds + OFF_P; GLA_LAS float* EL = (GLA_LAS float*)(lds + OFF_EL);
    GLA_LAS f32x4* XOs = (GLA_LAS f32x4*)(lds + (wid < 4 ? OFF_XO_A + wid * 4096 : OFF_XO_B + (wid - 4) * 4096));
    GLA_LAS f32x4* XOr = (GLA_LAS f32x4*)(lds + ((wid ^ 4) < 4 ? OFF_XO_A + (wid ^ 4) * 4096 : OFF_XO_B + ((wid ^ 4) - 4) * 4096));
    f32x16 S[2] = {f32x16{}, f32x16{}};
    const int vb = (int)(unsigned)(uintptr_t)VI + v_rd_base(lane) + vt * 512;
    const int nchunk = (CTX_ + SEQ_) / 64, nctx = CTX_ / 64;
    const size_t tile0 = (size_t)((b * 4 + h) * 2 + dir) * 36;
    u32x4 pq[2], pk[2], pp, pv[2]; float pe = 0.f;
#define GLA_CS(sc_) ((dir == 0) ? (sc_) : (((sc_) < nctx) ? (nctx - 1 - (sc_)) : (nchunk - 1 - ((sc_) - nctx))))
#define GLA_FETCH(sc_) do { const int cs_ = GLA_CS(sc_); const size_t t_ = tile0 + cs_; const long r0_ = (cs_ < nctx) ? (long)ML_ + (long)b * CTX_ + 64 * cs_ : (long)b * SEQ_ + 64 * (cs_ - nctx); \
        const GLA_GAS u32x4* q_ = (const GLA_GAS u32x4*)((const GLA_GAS unsigned short*)TQ_ + t_ * 8192); const GLA_GAS u32x4* k_ = (const GLA_GAS u32x4*)((const GLA_GAS unsigned short*)TK_ + t_ * 8192); \
        pq[0] = q_[tid]; pq[1] = q_[tid + 512]; pk[0] = k_[tid]; pk[1] = k_[tid + 512]; pp = ((const GLA_GAS u32x4*)((const GLA_GAS unsigned short*)TP_ + t_ * 4096))[tid]; \
        if (tid < 128) pe = ((const GLA_GAS float*)EL_)[t_ * 128 + tid]; \
        _Pragma("unroll") for (int i_ = 0; i_ < 2; ++i_) { const int c_ = tid + 512 * i_; pv[i_] = *(const GLA_GAS u32x4*)(VR + (r0_ + (c_ >> 4)) * 2304 + h * 256 + vh * 128 + (c_ & 15) * 8); } } while (0)
    GLA_FETCH(0);
    for (int sc = 0; sc < nchunk; ++sc) {
        const int cs = GLA_CS(sc); const bool is_lat = cs >= nctx; const long row0 = is_lat ? (long)b * SEQ_ + 64 * (cs - nctx) : (long)ML_ + (long)b * CTX_ + 64 * cs;
#pragma unroll
        for (int i = 0; i < 2; ++i) { const int c = tid + 512 * i; *(GLA_LAS u32x4*)(QT + (c >> 4) * RS256 + (c & 15) * 16) = pq[i]; *(GLA_LAS u32x4*)(KH + (c >> 3) * RS128 + (c & 7) * 16) = pk[i];
            *(GLA_LAS u32x4*)(VI + v_st4(c >> 4, (c & 15) * 8)) = pv[i]; }
        *(GLA_LAS u32x4*)(PI + (tid >> 3) * RS128 + (tid & 7) * 16) = pp;
        if (tid < 128) EL[tid] = pe;
        __syncthreads();
        if (sc + 1 < nchunk) GLA_FETCH(sc + 1);
        f32x16 op[2] = {f32x16{}, f32x16{}};
#pragma unroll
        for (int j = 0; j < 2; ++j)
#pragma unroll
            for (int s2 = 0; s2 < 2; ++s2) { const bf16x8 bs = pack_step(S[j], s2); const int cb0 = (32 * (2 * kh + j) + 16 * s2 + 4 * hi) * 2;
#pragma unroll
                for (int rb = 0; rb < 2; ++rb) { const int l = 32 * rb + r32;
                    const s16x4 a0 = *(const GLA_LAS s16x4*)(QT + swz256(l, cb0)), a1 = *(const GLA_LAS s16x4*)(QT + swz256(l, cb0 + 16));
                    const bf16x8 a = {a0[0], a0[1], a0[2], a0[3], a1[0], a1[1], a1[2], a1[3]}; op[rb] = GLA_MFMA(a, bs, op[rb]); } }
        { const f32x16& snd = kh ? op[0] : op[1];
#pragma unroll
          for (int g = 0; g < 4; ++g) XOs[g * 64 + lane] = (f32x4){snd[4 * g], snd[4 * g + 1], snd[4 * g + 2], snd[4 * g + 3]}; }
        __syncthreads();
        f32x16 o = kh ? op[1] : op[0];
#pragma unroll
        for (int g = 0; g < 4; ++g) { const f32x4 rv = XOr[g * 64 + lane]; o[4 * g] += rv.x; o[4 * g + 1] += rv.y; o[4 * g + 2] += rv.z; o[4 * g + 3] += rv.w; }
        bf16x8 vf[4];
        { const s16x4 l0 = tr_read<0 * 4096>(vb), h0 = tr_read<0 * 4096 + 2048>(vb), l1 = tr_read<1 * 4096>(vb), h1 = tr_read<1 * 4096 + 2048>(vb);
          const s16x4 l2 = tr_read<2 * 4096>(vb), h2 = tr_read<2 * 4096 + 2048>(vb), l3 = tr_read<3 * 4096>(vb), h3 = tr_read<3 * 4096 + 2048>(vb);
          asm volatile("s_waitcnt lgkmcnt(0)" ::: "memory"); __builtin_amdgcn_sched_barrier(0);
          vf[0] = (bf16x8){l0[0], l0[1], l0[2], l0[3], h0[0], h0[1], h0[2], h0[3]}; vf[1] = (bf16x8){l1[0], l1[1], l1[2], l1[3], h1[0], h1[1], h1[2], h1[3]};
          vf[2] = (bf16x8){l2[0], l2[1], l2[2], l2[3], h2[0], h2[1], h2[2], h2[3]}; vf[3] = (bf16x8){l3[0], l3[1], l3[2], l3[3], h3[0], h3[1], h3[2], h3[3]}; }
#pragma unroll
        for (int ks = 0; ks < 4; ++ks) { const bf16x8 a = *(const GLA_LAS bf16x8*)(PI + swz128(32 * kh + r32, (16 * ks + 8 * hi) * 2)); o = GLA_MFMA(a, vf[ks], o); }
        if (is_lat) {
#pragma unroll
            for (int r = 0; r < 16; ++r) O[(row0 + 32 * kh + crow(r, hi)) * 1024 + h * 256 + vh * 128 + 32 * vt + r32] = bf1f(o[r]); }
#pragma unroll
        for (int j = 0; j < 2; ++j) { const int kt = 2 * kh + j;
#pragma unroll
            for (int ks = 0; ks < 4; ++ks) { const bf16x8 a = *(const GLA_LAS bf16x8*)(KH + swz128(32 * kt + r32, (16 * ks + 8 * hi) * 2)); S[j] = GLA_MFMA(a, vf[ks], S[j]); }
#pragma unroll
            for (int r = 0; r < 16; ++r) S[j][r] *= EL[32 * kt + crow(r, hi)]; }
        __syncthreads();
    }
#undef GLA_FETCH
#undef GLA_CS
}
#undef GLA_MFMA
}

constexpr int NWAVES = 8;
constexpr int D = 1024, NB = 16, SEQ = 2048, CTXL = 256, TT = SEQ + CTXL;
constexpr int ML = NB * SEQ, MC = NB * CTXL, MA = ML + MC;
constexpr float EPS = 1e-6f;
constexpr int S5W = 512, S5G = 32, S5H = 16, S5P = 64;
constexpr int NH = 8, NOPE = 64, ROPE = 32, QK = 96, VD = 64, QRANK = 256, KVRANK = 128;
constexpr int EV_IN = 928, EV_INP = 1024, NQKV = 1792, KQKV = 384;
constexpr int GH = 4, GDK = 128, GDV = 256, GKEY = 512, GVAL = 1024, GRANK = 16;
constexpr int OD_IN = 3104, OD_INP = 3328;
constexpr int FFN = 2816, NE = 8, FE = 3584;
constexpr int MOE_MAXT = 264;

constexpr size_t MiB = 1u << 20;
constexpr size_t WS_CTL = 0, CTL_ZERO_BYTES = 1 * MiB;
constexpr size_t WS_MODV = 1 * MiB;
constexpr size_t WS_TOK = 2 * MiB;
constexpr size_t WS_INV = 3 * MiB;
constexpr size_t WS_W_IN1 = 4 * MiB, WS_W_OUT1 = 11 * MiB, WS_W_MGU = 13 * MiB  , WS_W_MDN = 69 * MiB  ;
constexpr size_t WS_W_IN0 = 97 * MiB, WS_W_QKV = 99 * MiB, WS_W_GLU = 100 * MiB + 512 * 1024, WS_W_OUT0 = 101 * MiB, WS_W_GU = 103 * MiB, WS_W_DN = 114 * MiB, WS_HC = 120 * MiB;
constexpr size_t PB = 136 * MiB;
constexpr size_t WS_XL = PB + 0 * MiB, WS_Q = PB + 0 * MiB, WS_A3 = PB + 72 * MiB, WS_YL = PB + 72 * MiB, WS_KV = PB + 144 * MiB, WS_Z0C = PB + 144 * MiB, WS_U = PB + 180 * MiB, WS_DS = PB + 216 * MiB, WS_AO = PB + 216 * MiB,
                 WS_QA = PB + 288 * MiB, WS_AG = PB + 288 * MiB, WS_KR = PB + 324 * MiB, WS_B1 = PB + 328 * MiB, WS_B3 = PB + 332 * MiB;
constexpr size_t WS_ACT = PB + 72 * MiB, WS_FL = PB + 270 * MiB;
constexpr size_t WS_TP = 97 * MiB, WS_EL = 133 * MiB, WS_OF = PB, WS_VR = 208 * MiB, WS_QK = 370 * MiB, WS_OB = 370 * MiB, WS_YL1 = 370 * MiB, WS_TQ = 442 * MiB, WS_TK = 514 * MiB;
constexpr int VRLD = 2304;
constexpr int GLA_TILES = NB * GH * 2 * 36;
constexpr int MOE_W_ITEMS = NE * (2 * (D / 64) * (FE / 32) + (FE / 64) * (D / 32));
constexpr int MW0 = 0, MW1 = (MOE_W_ITEMS * 20) / 100, MW2 = (MOE_W_ITEMS * 40) / 100, MW3 = (MOE_W_ITEMS * 54) / 100, MW4 = (MOE_W_ITEMS * 82) / 100, MW5 = MOE_W_ITEMS;
constexpr size_t WS_XLM = PB + 0 * MiB, WS_Y = PB + 0 * MiB, WS_XG = PB + 132 * MiB, WS_ACTM = PB + 198 * MiB;
constexpr size_t WS_END = 588 * MiB;
static_assert(WS_KR + (size_t)MA * 32 * 2 <= WS_B1 && WS_KV + (size_t)MA * 1024 * 2 <= WS_DS && WS_AG + (size_t)MA * 512 * 2 <= WS_KR && WS_AO + (size_t)MA * D * 2 <= WS_AG && WS_A3 + (size_t)MA * 1024 * 2 <= WS_KV &&
              WS_Z0C + (size_t)MA * 512 * 2 <= WS_U && WS_U + (size_t)MA * 512 * 2 <= WS_DS && WS_DS + (size_t)MA * 512 * 4 <= WS_QA && WS_QA + (size_t)MA * KQKV * 2 <= WS_KR && WS_B1 + (size_t)32 * 256 * 256 * 2 <= WS_B3 && WS_B3 + (size_t)32 * 256 * 512 * 2 <= WS_END, "ws map");
static_assert(WS_FL + (size_t)MA * D * 2 <= WS_END && WS_ACT + (size_t)MA * FFN * 2 <= WS_FL, "ws map 2");
static_assert(WS_TP + (size_t)GLA_TILES * 8192 <= WS_EL && WS_EL + (size_t)GLA_TILES * 512 <= PB && WS_XL + (size_t)MA * D * 2 <= WS_VR && WS_VR + (size_t)MA * VRLD * 2 <= WS_QK && WS_QK + (size_t)MA * 1024 * 2 <= WS_TQ &&
              WS_TQ + (size_t)GLA_TILES * 16384 <= WS_TK && WS_TK + (size_t)GLA_TILES * 16384 <= WS_END && WS_OF + (size_t)ML * D * 2 <= WS_VR && WS_OB + (size_t)ML * D * 2 <= WS_TQ, "ws map layer 1");
static_assert(WS_Y + (size_t)MOE_MAXT * 256 * D * 2 <= WS_XG && WS_XG + (size_t)MOE_MAXT * 256 * D <= WS_ACTM && WS_ACTM + (size_t)MOE_MAXT * 256 * FE <= WS_END && WS_XLM + (size_t)ML * D <= WS_XG, "ws map 3");
static_assert(WS_W_IN1 + (size_t)OD_INP * D * 2 <= WS_W_OUT1 && WS_W_OUT1 + (size_t)D * D * 2 <= WS_W_MGU && WS_W_MGU + (size_t)NE * 2 * FE * D <= WS_W_MDN && WS_W_MDN + (size_t)NE * D * FE <= WS_W_IN0 &&
              WS_W_GU + (size_t)2 * FFN * D * 2 <= WS_W_DN && WS_W_DN + (size_t)D * FFN * 2 <= WS_HC && WS_HC + (size_t)MC * D * 4 <= PB, "ws map 4");
#ifndef FFN0_FP8
#define FFN0_FP8 0
#endif
constexpr bool FFN0_IS_FP8 = FFN0_FP8;
#ifndef FFN0_DOWN_FP8
#define FFN0_DOWN_FP8 1
#endif
constexpr bool FFN0_DN_FP8 = FFN0_DOWN_FP8;
constexpr float FP8_SA = 8.0f, FP8_SW = 128.0f, FP8_SACT = 4.0f;

constexpr int CW_TMO = 0, CW_CODE = 1, CW_CNT = 64, CW_BAR = 4096;

constexpr int RING_OFF = 0, RING_BYTES = 131072;
constexpr int ATAB_OFF = RING_BYTES + 1024, ATAB_UNITS = 29;
constexpr int LDSCTL_OFF = RING_BYTES, MISC_OFF = LDSCTL_OFF + 320;
constexpr int LDS_BYTES = 147456;
static_assert(ATAB_OFF + ATAB_UNITS * 512 <= LDS_BYTES, "LDS map: row table");
#ifndef PROBE_BLK
#define PROBE_BLK 0
#endif
#ifdef PROBE_SETA
#define PROBE_STAMP2(F, k) do { if (blockIdx.x == PROBE_BLK && F.tid == 0) { const unsigned long long t_ = __builtin_amdgcn_s_memrealtime(); const unsigned long long l_ = ((unsigned long long)F.MISC[17] << 32) | F.MISC[16]; const unsigned d_ = (unsigned)(t_ - l_); \
        if ((PROBE_SETA >> (k)) & 1ull) F.MISC[18] += d_; if ((PROBE_SETB >> (k)) & 1ull) F.MISC[20] += d_; F.MISC[16] = (unsigned)t_; F.MISC[17] = (unsigned)(t_ >> 32); } } while (0)
#else
#define PROBE_STAMP2(F, k) do { } while (0)
#endif

struct Args { const float* in[35]; float* out; unsigned char* ws; int ph_lo, ph_hi; };
struct Frame { LAS unsigned char* lds; volatile LAS unsigned* MISC; gu32* ctl; int tid, lane, wave, G, gw, ngw; };

__device__ __forceinline__ float wave_sum(float v) {
#pragma unroll
    for (int o = 1; o < 64; o <<= 1) v += __shfl_xor(v, o);
    return v;
}
__device__ __forceinline__ float bf_lo(unsigned u) { return __uint_as_float(u << 16); }
__device__ __forceinline__ float bf_hi(unsigned u) { return __uint_as_float(u & 0xffff0000u); }
__device__ __forceinline__ float bf1(bf16 u) { return __uint_as_float(((unsigned)u) << 16); }
typedef unsigned v2u __attribute__((ext_vector_type(2)));
__device__ __forceinline__ unsigned pk4_fp8(float a, float b, float c, float d) { return pg8::pk4_fp8(a, b, c, d); }

__device__ __forceinline__ void ld_row_f32(const float* p, int lane, f32x4 (&v)[4]) {
    const GAS f32x4* q = (const GAS f32x4*)p + lane;
#pragma unroll
    for (int j = 0; j < 4; ++j) v[j] = q[64 * j];
}
__device__ __forceinline__ void st_row_f32(float* p, int lane, const f32x4 (&v)[4]) {
    GAS f32x4* q = (GAS f32x4*)p + lane;
#pragma unroll
    for (int j = 0; j < 4; ++j) q[64 * j] = v[j];
}
__device__ __forceinline__ void ld_row_bf16(const bf16* p, int lane, f32x4 (&v)[4]) {
    const GAS v2u* q = (const GAS v2u*)p + lane;
#pragma unroll
    for (int j = 0; j < 4; ++j) { const v2u w = q[64 * j]; v[j] = (f32x4){bf_lo(w.x), bf_hi(w.x), bf_lo(w.y), bf_hi(w.y)}; }
}
__device__ __forceinline__ void st_row_bf16(bf16* p, int lane, const f32x4 (&v)[4]) {
    GAS v2u* q = (GAS v2u*)p + lane;
#pragma unroll
    for (int j = 0; j < 4; ++j) { v2u w; w.x = pk2(v[j].x, v[j].y); w.y = pk2(v[j].z, v[j].w); q[64 * j] = w; }
}
__device__ __forceinline__ void st_row_fp8(unsigned char* p, int lane, const f32x4 (&v)[4], float sc) {
    GAS unsigned* q = (GAS unsigned*)p + lane;
#pragma unroll
    for (int j = 0; j < 4; ++j) q[64 * j] = pk4_fp8(v[j].x * sc, v[j].y * sc, v[j].z * sc, v[j].w * sc);
}
__device__ __forceinline__ float row_rs(const f32x4 (&v)[4]) {
    float s = 0.f;
#pragma unroll
    for (int j = 0; j < 4; ++j) s += (v[j].x * v[j].x + v[j].y * v[j].y) + (v[j].z * v[j].z + v[j].w * v[j].w);
    return rsqrtf(wave_sum(s) * (1.0f / D) + EPS);
}
__device__ __forceinline__ void norm_mod(f32x4 (&v)[4], const float* gam, const float* sh, const float* sc, int lane) {
    const float rs = row_rs(v); f32x4 g[4], a[4], b[4]; ld_row_f32(gam, lane, g); ld_row_f32(sh, lane, a); ld_row_f32(sc, lane, b);
#pragma unroll
    for (int j = 0; j < 4; ++j) v[j] = (v[j] * rs) * g[j] * (1.0f + b[j]) + a[j];
}
__device__ __forceinline__ void gated_add(f32x4 (&h)[4], const f32x4 (&y)[4], const float* gam, const float* gate, int lane) {
    const float rs = row_rs(y); f32x4 g[4], t[4]; ld_row_f32(gam, lane, g); ld_row_f32(gate, lane, t);
#pragma unroll
    for (int j = 0; j < 4; ++j) h[j] = h[j] + t[j] * ((y[j] * rs) * g[j]);
}

__device__ __forceinline__ void cvt_item(const float* W, int K, int N, bf16* WT, int ldk, int kcol0, int row_off, int mode, const float* gain, float scale, int nscale,
                                         LAS float* scr, int item, int lane, bool fp8 = false, bool tiled = false) {
    const int nblk = N / 32, kb = item / nblk, nb = item % nblk, k0 = 64 * kb, n0 = 32 * nb;
    { f32x4 t[8];
#pragma unroll
      for (int i = 0; i < 8; ++i) t[i] = *(const GAS f32x4*)(W + (size_t)(k0 + 8 * i + (lane >> 3)) * N + n0 + 4 * (lane & 7));
#pragma unroll
      for (int i = 0; i < 8; ++i) { LAS float* d = scr + (8 * i + (lane >> 3)) * 33 + 4 * (lane & 7); d[0] = t[i].x; d[1] = t[i].y; d[2] = t[i].z; d[3] = t[i].w; } }
    LDS_WAIT(); asm volatile("" ::: "memory");
    const int c = lane & 7;
    float gn[8];
#pragma unroll
    for (int q = 0; q < 8; ++q) gn[q] = (gain ? gain[k0 + 8 * c + q] : 1.0f) * ((n0 < nscale) ? scale : 1.0f);
    const int drow0 = (mode == 0) ? n0 : (mode == 3) ? ((n0 >> 7) * 64 + (n0 & 63) + ((n0 & 64) ? 512 : 0)) : ((n0 >> 7) * 256 + (n0 & 127) + (mode == 2 ? 128 : 0));
#pragma unroll
    for (int j = 0; j < 4; ++j) { const int n = (lane >> 3) + 8 * j; const LAS float* s = scr + (8 * c) * 33 + n;
        if (fp8) { v2u o; o.x = pk4_fp8(s[0 * 33] * gn[0], s[1 * 33] * gn[1], s[2 * 33] * gn[2], s[3 * 33] * gn[3]); o.y = pk4_fp8(s[4 * 33] * gn[4], s[5 * 33] * gn[5], s[6 * 33] * gn[6], s[7 * 33] * gn[7]);
            const int drow = row_off + drow0 + n, kc = kcol0 + k0 + 8 * c;
            unsigned char* dp = tiled ? (unsigned char*)WT + (size_t)(drow >> 8) * 256 * ldk + (size_t)(kc >> 7) * 32768 + (drow & 255) * 128 + (kc & 127) : (unsigned char*)WT + (size_t)drow * ldk + kc;
            *(GAS v2u*)dp = o; }
        else { v4u o; o.x = pk2(s[0 * 33] * gn[0], s[1 * 33] * gn[1]); o.y = pk2(s[2 * 33] * gn[2], s[3 * 33] * gn[3]); o.z = pk2(s[4 * 33] * gn[4], s[5 * 33] * gn[5]); o.w = pk2(s[6 * 33] * gn[6], s[7 * 33] * gn[7]);
            *(GAS v4u*)(WT + (size_t)(row_off + drow0 + n) * ldk + kcol0 + k0 + 8 * c) = o; } }
    LDS_WAIT(); asm volatile("" ::: "memory");
}
__device__ __forceinline__ void moe_weights(Frame& F, const Args& A, int it_lo, int it_hi, int widx, int nw) {
    LAS float* scr = (LAS float*)(F.lds + RING_OFF + F.wave * 16384);
    unsigned char* ws = A.ws;
    constexpr int I_MG1 = (D / 64) * (FE / 32), I_MD1 = (FE / 64) * (D / 32);
    for (int it = it_lo + widx; it < it_hi; it += nw) {
        int r = it;
        if (r < NE * I_MG1) { const int e = r / I_MG1; cvt_item(A.in[32] + (size_t)e * D * FE, D, FE, (bf16*)(ws + WS_W_MGU + (size_t)e * 2 * FE * D), D, 0, 0, 1, nullptr, FP8_SW, 1 << 30, scr, r % I_MG1, F.lane, true); continue; } r -= NE * I_MG1;
        if (r < NE * I_MG1) { const int e = r / I_MG1; cvt_item(A.in[33] + (size_t)e * D * FE, D, FE, (bf16*)(ws + WS_W_MGU + (size_t)e * 2 * FE * D), D, 0, 0, 2, nullptr, FP8_SW, 1 << 30, scr, r % I_MG1, F.lane, true); continue; } r -= NE * I_MG1;
        { const int e = r / I_MD1; cvt_item(A.in[34] + (size_t)e * FE * D, FE, D, (bf16*)(ws + WS_W_MDN + (size_t)e * D * FE), FE, 0, 0, 0, nullptr, FP8_SW, 1 << 30, scr, r % I_MD1, F.lane, true, true); }
    }
}
__device__ __forceinline__ void tail_convert(Frame& F, const Args& A, int nunit, int lo, int hi) {
    const int nlast = nunit % F.G, bid = (int)blockIdx.x;
    if (nlast != 0) { if (bid >= nlast) moe_weights(F, A, lo, hi, (bid - nlast) * NWAVES + F.wave, (F.G - nlast) * NWAVES); }
    else moe_weights(F, A, lo, hi, F.gw, F.ngw);
}
__device__ __forceinline__ void gen_s5(Frame& F, const Args& A, int g);
__device__ __forceinline__ void p0_prologue(Frame& F, const Args& A) {
    LAS float* scr = (LAS float*)(F.lds + RING_OFF + F.wave * 16384);
    unsigned char* ws = A.ws;
    constexpr int I_IN0 = (D / 64) * (EV_IN / 32), I_UQ = (QRANK / 64) * (768 / 32), I_UKV = (KVRANK / 64) * (1024 / 32), I_GLU = (512 / 64) * (512 / 32), I_OUT = (D / 64) * (D / 32);
    constexpr int I_FG = (D / 64) * (FFN / 32), I_FD = (FFN / 64) * (D / 32), I_IN1 = (D / 64) * (OD_IN / 32), I_MG1 = (D / 64) * (FE / 32), I_MD1 = (FE / 64) * (D / 32);
    constexpr int NITEMS = I_IN0 + I_UQ + I_UKV + I_GLU + I_OUT + 2 * I_FG + I_FD + I_IN1 + I_OUT;
    const bool s5_builder = (int)blockIdx.x >= F.G - S5G;
    for (int it = s5_builder ? NITEMS : F.gw; it < NITEMS; it += F.ngw - S5G * NWAVES) {
        int r = it;
        if (r < I_IN0) { cvt_item(A.in[7], D, EV_IN, (bf16*)(ws + WS_W_IN0), D, 0, 0, 0, nullptr, 1.f, 0, scr, r, F.lane); continue; } r -= I_IN0;
        if (r < I_UQ) { cvt_item(A.in[19], QRANK, 768, (bf16*)(ws + WS_W_QKV), KQKV, 0, 0, 0, A.in[18], 1.f, 0, scr, r, F.lane); continue; } r -= I_UQ;
        if (r < I_UKV) { cvt_item(A.in[21], KVRANK, 1024, (bf16*)(ws + WS_W_QKV), KQKV, QRANK, 768, 3, A.in[20], 1.f, 0, scr, r, F.lane); continue; } r -= I_UKV;
        if (r < I_GLU) { cvt_item(A.in[16], 512, 512, (bf16*)(ws + WS_W_GLU), 512, 0, 0, 0, nullptr, 1.f, 0, scr, r, F.lane); continue; } r -= I_GLU;
        if (r < I_OUT) { cvt_item(A.in[22], D, D, (bf16*)(ws + WS_W_OUT0), D, 0, 0, 0, nullptr, 1.f, 0, scr, r, F.lane); continue; } r -= I_OUT;
        if (r < I_FG) { cvt_item(A.in[23], D, FFN, (bf16*)(ws + WS_W_GU), D, 0, 0, 1, nullptr, FFN0_IS_FP8 ? FP8_SW : 1.f, 1 << 30, scr, r, F.lane, FFN0_IS_FP8); continue; } r -= I_FG;
        if (r < I_FG) { cvt_item(A.in[24], D, FFN, (bf16*)(ws + WS_W_GU), D, 0, 0, 2, nullptr, FFN0_IS_FP8 ? FP8_SW : 1.f, 1 << 30, scr, r, F.lane, FFN0_IS_FP8); continue; } r -= I_FG;
        if (r < I_FD) { cvt_item(A.in[25], FFN, D, (bf16*)(ws + WS_W_DN), FFN, 0, 0, 0, nullptr, (FFN0_IS_FP8 || FFN0_DN_FP8) ? FP8_SW : 1.f, 1 << 30, scr, r, F.lane, FFN0_IS_FP8 || FFN0_DN_FP8); continue; } r -= I_FD;
        if (r < I_IN1) { cvt_item(A.in[26], D, OD_IN, (bf16*)(ws + WS_W_IN1), D, 0, 0, 0, nullptr, 0.08838834764831845f, GKEY, scr, r, F.lane); continue; } r -= I_IN1;
        cvt_item(A.in[30], D, D, (bf16*)(ws + WS_W_OUT1), D, 0, 0, 0, nullptr, 1.f, 0, scr, r, F.lane);
    }
    { const v4u z = {0u, 0u, 0u, 0u}; const int gt = blockIdx.x * (NWAVES * 64) + F.tid, ngt = F.G * NWAVES * 64;
      GAS v4u* p0 = (GAS v4u*)((bf16*)(ws + WS_W_IN0) + (size_t)EV_IN * D); for (int i = gt; i < (EV_INP - EV_IN) * D / 8; i += ngt) p0[i] = z;
      for (int i = gt; i < 768 * (KVRANK / 8); i += ngt) { const int r = i / (KVRANK / 8), c = i % (KVRANK / 8); *(GAS v4u*)((bf16*)(ws + WS_W_QKV) + (size_t)r * KQKV + QRANK + 8 * c) = z; }
      for (int i = gt; i < 1024 * (QRANK / 8); i += ngt) { const int r = i / (QRANK / 8), c = i % (QRANK / 8); *(GAS v4u*)((bf16*)(ws + WS_W_QKV) + (size_t)(768 + r) * KQKV + 8 * c) = z; }
      GAS v4u* p1 = (GAS v4u*)((bf16*)(ws + WS_W_IN1) + (size_t)OD_IN * D); for (int i = gt; i < (OD_INP - OD_IN) * D / 8; i += ngt) p1[i] = z; }
    __syncthreads();
    PROBE_STAMP2(F, 22);
    LAS float* act = (LAS float*)(F.lds);
    LAS float* red = (LAS float*)(F.lds + 17 * 1024 * 4);
    float* modv = (float*)(ws + WS_MODV);
    bool have_act = false;
    for (int u = blockIdx.x; u < 2 * 96; u += F.G) {
        if (!have_act) {
            float xv[17 * 1024 / (NWAVES * 64)];
#pragma unroll
            for (int q = 0; q < 17 * 1024 / (NWAVES * 64); ++q) { const int i = F.tid + q * (NWAVES * 64); xv[q] = (i < 16 * 1024) ? A.in[1][i] : A.in[3][i - 16 * 1024]; }
#pragma unroll
            for (int q = 0; q < 17 * 1024 / (NWAVES * 64); ++q) { const float x = xv[q]; act[F.tid + q * (NWAVES * 64)] = x / (1.0f + __expf(-x)); }
            have_act = true;
        }
        __syncthreads();
        const int layer = u / 96, c0 = (u % 96) * 64;
        const float* mw = A.in[4] + (size_t)layer * D * 6144 + c0 + F.lane;
        float acc[17];
#pragma unroll
        for (int r = 0; r < 17; ++r) acc[r] = 0.f;
        for (int k0 = F.wave * 128; k0 < F.wave * 128 + 128; k0 += 32) { float w[32];
#pragma unroll
            for (int u2 = 0; u2 < 32; ++u2) w[u2] = mw[(size_t)(k0 + u2) * 6144];
#pragma unroll
            for (int u2 = 0; u2 < 32; ++u2)
#pragma unroll
                for (int r = 0; r < 17; ++r) acc[r] += act[r * 1024 + k0 + u2] * w[u2]; }
#pragma unroll
        for (int r = 0; r < 17; ++r) red[(F.wave * 17 + r) * 64 + F.lane] = acc[r];
        __syncthreads();
        for (int i = F.tid; i < 17 * 64; i += NWAVES * 64) { const int r = i >> 6, l = i & 63; float s = A.in[5][layer * 6144 + c0 + l];
#pragma unroll
            for (int w = 0; w < 8; ++w) s += red[(w * 17 + r) * 64 + l];
            modv[(size_t)(layer * 17 + r) * 6144 + c0 + l] = s; }
    }
    __syncthreads();
    PROBE_STAMP2(F, 23);
    for (int g = (int)blockIdx.x - (F.G - S5G); g >= 0 && g < S5G; g += F.G) gen_s5(F, A, g);
    PROBE_STAMP2(F, 24);
}

__device__ __forceinline__ void thin_t1(Frame& F, const Args& A) {
    const float* modv = (const float*)(A.ws + WS_MODV); bf16* XL = (bf16*)(A.ws + WS_XL); const float* gam = A.in[6];
    for (int r0 = F.gw; r0 < MA; r0 += 2 * F.ngw) {
        const int r1 = (r0 + F.ngw < MA) ? r0 + F.ngw : r0; const bool two = r1 != r0;
        const bool lat0 = r0 < ML, lat1 = r1 < ML; const float* src0 = lat0 ? A.in[0] + (size_t)r0 * D : A.in[2] + (size_t)(r0 - ML) * D; const float* src1 = lat1 ? A.in[0] + (size_t)r1 * D : A.in[2] + (size_t)(r1 - ML) * D;
        const float* mod0 = modv + (size_t)(lat0 ? r0 / SEQ : 16) * 6144; const float* mod1 = modv + (size_t)(lat1 ? r1 / SEQ : 16) * 6144;
        f32x4 v0[4], v1[4]; ld_row_f32(src0, F.lane, v0); ld_row_f32(src1, F.lane, v1);
        norm_mod(v0, gam, mod0, mod0 + D, F.lane); st_row_bf16(XL + (size_t)r0 * D, F.lane, v0);
        norm_mod(v1, gam, mod1, mod1 + D, F.lane); if (two) st_row_bf16(XL + (size_t)r1 * D, F.lane, v1);
    }
}
__device__ __forceinline__ void thin_t2(Frame& F, const Args& A) {
    const float* modv = (const float*)(A.ws + WS_MODV); bf16* XL = (bf16*)(A.ws + WS_XL); const bf16* YL = (const bf16*)(A.ws + WS_YL); float* HC = (float*)(A.ws + WS_HC); const float* gam = A.in[6];
    for (int r0 = F.gw; r0 < MA; r0 += 2 * F.ngw) {
        const int r1 = (r0 + F.ngw < MA) ? r0 + F.ngw : r0; const bool two = r1 != r0;
        const bool lat0 = r0 < ML, lat1 = r1 < ML;
        const float* src0 = lat0 ? A.in[0] + (size_t)r0 * D : A.in[2] + (size_t)(r0 - ML) * D; const float* src1 = lat1 ? A.in[0] + (size_t)r1 * D : A.in[2] + (size_t)(r1 - ML) * D;
        float* dst0 = lat0 ? A.out + (size_t)r0 * D : HC + (size_t)(r0 - ML) * D; float* dst1 = lat1 ? A.out + (size_t)r1 * D : HC + (size_t)(r1 - ML) * D;
        const float* mod0 = modv + (size_t)(lat0 ? r0 / SEQ : 16) * 6144; const float* mod1 = modv + (size_t)(lat1 ? r1 / SEQ : 16) * 6144;
        f32x4 h0[4], y0[4], h1[4], y1[4];
        ld_row_f32(src0, F.lane, h0); ld_row_bf16(YL + (size_t)r0 * D, F.lane, y0); ld_row_f32(src1, F.lane, h1); ld_row_bf16(YL + (size_t)r1 * D, F.lane, y1);
        gated_add(h0, y0, gam + 1 * D, mod0 + 2 * D, F.lane); gated_add(h1, y1, gam + 1 * D, mod1 + 2 * D, F.lane);
        st_row_f32(dst0, F.lane, h0); if (two) st_row_f32(dst1, F.lane, h1);
        norm_mod(h0, gam + 2 * D, mod0 + 3 * D, mod0 + 4 * D, F.lane); norm_mod(h1, gam + 2 * D, mod1 + 3 * D, mod1 + 4 * D, F.lane);
        if (FFN0_IS_FP8) { st_row_fp8((unsigned char*)XL + (size_t)r0 * D, F.lane, h0, FP8_SA); if (two) st_row_fp8((unsigned char*)XL + (size_t)r1 * D, F.lane, h1, FP8_SA); }
        else { st_row_bf16(XL + (size_t)r0 * D, F.lane, h0); if (two) st_row_bf16(XL + (size_t)r1 * D, F.lane, h1); }
    }
}
__device__ __forceinline__ void thin_t3(Frame& F, const Args& A) {
    const float* modv = (const float*)(A.ws + WS_MODV); bf16* XL = (bf16*)(A.ws + WS_XL); const bf16* FL = (const bf16*)(A.ws + WS_FL); const float* HC = (const float*)(A.ws + WS_HC); const float* gam = A.in[6];
    for (int r0 = F.gw; r0 < MA; r0 += 2 * F.ngw) {
        const int r1 = (r0 + F.ngw < MA) ? r0 + F.ngw : r0; const bool two = r1 != r0;
        const bool lat0 = r0 < ML, lat1 = r1 < ML;
        const float* src0 = lat0 ? A.out + (size_t)r0 * D : HC + (size_t)(r0 - ML) * D; const float* src1 = lat1 ? A.out + (size_t)r1 * D : HC + (size_t)(r1 - ML) * D;
        const int bs0 = lat0 ? r0 / SEQ : 16, bs1 = lat1 ? r1 / SEQ : 16;
        f32x4 h0[4], y0[4], h1[4], y1[4];
        ld_row_f32(src0, F.lane, h0); ld_row_bf16(FL + (size_t)r0 * D, F.lane, y0); ld_row_f32(src1, F.lane, h1); ld_row_bf16(FL + (size_t)r1 * D, F.lane, y1);
        gated_add(h0, y0, gam + 3 * D, modv + (size_t)bs0 * 6144 + 5 * D, F.lane); gated_add(h1, y1, gam + 3 * D, modv + (size_t)bs1 * 6144 + 5 * D, F.lane);
        if (lat0) st_row_f32(A.out + (size_t)r0 * D, F.lane, h0); if (two && lat1) st_row_f32(A.out + (size_t)r1 * D, F.lane, h1);
        { const float* m0 = modv + (size_t)(17 + bs0) * 6144; const float* m1 = modv + (size_t)(17 + bs1) * 6144;
          norm_mod(h0, gam + 4 * D, m0, m0 + D, F.lane); norm_mod(h1, gam + 4 * D, m1, m1 + D, F.lane); }
        st_row_bf16(XL + (size_t)r0 * D, F.lane, h0); if (two) st_row_bf16(XL + (size_t)r1 * D, F.lane, h1);
    }
}
__device__ __forceinline__ void thin_t4(Frame& F, const Args& A) {
    const float* modv = (const float*)(A.ws + WS_MODV); bf16* XL = (bf16*)(A.ws + WS_XLM); const bf16* YL = (const bf16*)(A.ws + WS_YL1); const float* gam = A.in[6] + 4 * D;
    const float* router = A.in[31]; unsigned* tok = (unsigned*)(A.ws + WS_TOK); unsigned short* inv = (unsigned short*)(A.ws + WS_INV);
    LAS float* rt = (LAS float*)(F.lds);
    LAS unsigned* wc = (LAS unsigned*)(F.lds + 32768);
    __syncthreads();
    for (int i = F.tid; i < 8 * 1024; i += NWAVES * 64) { const int e = i >> 10, c = i & 1023; rt[i] = router[(size_t)c * 8 + e]; }
    __syncthreads();
    for (int chunk = blockIdx.x; chunk < ML / 128; chunk += F.G) {
        const int row_base = chunk * 128 + F.wave * 16;
        int me0 = 0, me1 = 0; float mw0 = 0.f, mw1 = 0.f;
        for (int i = 0; i < 16; ++i) {
            const int r = row_base + i; const int bs = r / SEQ; const float* mod1 = modv + (size_t)(17 + bs) * 6144;
            f32x4 h[4], y[4]; ld_row_f32(A.out + (size_t)r * D, F.lane, h); ld_row_bf16(YL + (size_t)r * D, F.lane, y);
            gated_add(h, y, gam + 1 * D, mod1 + 2 * D, F.lane); st_row_f32(A.out + (size_t)r * D, F.lane, h);
            norm_mod(h, gam + 2 * D, mod1 + 3 * D, mod1 + 4 * D, F.lane); st_row_fp8((unsigned char*)XL + (size_t)r * D, F.lane, h, FP8_SA);
            float lg[8];
#pragma unroll
            for (int e = 0; e < 8; ++e) { float a = 0.f;
#pragma unroll
                for (int j = 0; j < 4; ++j) { const f32x4 w = *(const LAS f32x4*)(rt + e * 1024 + 256 * j + 4 * F.lane); a += (h[j].x * w.x + h[j].y * w.y) + (h[j].z * w.z + h[j].w * w.w); }
                lg[e] = a; }
            {
              const bool b5 = (F.lane & 32) != 0, b4 = (F.lane & 16) != 0, b3 = (F.lane & 8) != 0; float v4[4], v2[2];
#pragma unroll
              for (int i2 = 0; i2 < 4; ++i2) { const float keep = b5 ? lg[i2 + 4] : lg[i2], send = b5 ? lg[i2] : lg[i2 + 4]; v4[i2] = keep + __shfl_xor(send, 32); }
#pragma unroll
              for (int i2 = 0; i2 < 2; ++i2) { const float keep = b4 ? v4[i2 + 2] : v4[i2], send = b4 ? v4[i2] : v4[i2 + 2]; v2[i2] = keep + __shfl_xor(send, 16); }
              float v1 = (b3 ? v2[1] : v2[0]) + __shfl_xor(b3 ? v2[0] : v2[1], 8);
              v1 += __shfl_xor(v1, 1); v1 += __shfl_xor(v1, 2); v1 += __shfl_xor(v1, 4);
#pragma unroll
              for (int e = 0; e < 8; ++e) lg[e] = __builtin_bit_cast(float, __builtin_amdgcn_readlane(__builtin_bit_cast(int, v1), 8 * e)); }
            int e0 = 0; float v0 = lg[0];
#pragma unroll
            for (int e = 1; e < 8; ++e) if (lg[e] > v0) { v0 = lg[e]; e0 = e; }
            int e1 = (e0 + 1) & 7; float v1 = -3.0e38f;
#pragma unroll
            for (int e = 0; e < 8; ++e) if (e != e0 && lg[e] > v1) { v1 = lg[e]; e1 = e; }
            const float w1 = 1.0f / (1.0f + __expf(v0 - v1)), w0 = 1.0f - w1;
            if (F.lane == i) { me0 = e0; me1 = e1; mw0 = w0; mw1 = w1; }
        }
        unsigned long long m[8];
#pragma unroll
        for (int e = 0; e < 8; ++e) m[e] = __ballot(F.lane < 16 && (me0 == e || me1 == e));
        { unsigned c = 0;
#pragma unroll
          for (int e = 0; e < 8; ++e) c = (F.lane == e) ? (unsigned)__popcll(m[e]) : c;
          if (F.lane < 8) wc[F.wave * 8 + F.lane] = c; }
        __syncthreads();
        if (F.tid < 8) { unsigned tot = 0;
#pragma unroll
            for (int w = 0; w < 8; ++w) tot += wc[w * 8 + F.tid];
            unsigned run = __hip_atomic_fetch_add((unsigned*)(F.ctl + CW_CNT + F.tid), tot, __ATOMIC_RELAXED, __HIP_MEMORY_SCOPE_AGENT);
#pragma unroll
            for (int w = 0; w < 8; ++w) { const unsigned c = wc[w * 8 + F.tid]; wc[w * 8 + F.tid] = run; run += c; } }
        __syncthreads();
        if (F.lane < 16) { unsigned long long m0 = 0ull, m1 = 0ull;
#pragma unroll
            for (int e = 0; e < 8; ++e) { m0 = (me0 == e) ? m[e] : m0; m1 = (me1 == e) ? m[e] : m1; }
            const unsigned long long below = (1ull << F.lane) - 1ull;
            const unsigned i0 = wc[F.wave * 8 + me0] + (unsigned)__popcll(m0 & below), i1 = wc[F.wave * 8 + me1] + (unsigned)__popcll(m1 & below);
            unsigned* t = tok + (size_t)(row_base + F.lane) * 8; t[0] = (unsigned)me0; t[1] = (unsigned)me1; t[2] = i0; t[3] = i1; t[4] = __float_as_uint(mw0); t[5] = __float_as_uint(mw1);
            inv[(size_t)me0 * 32768 + i0] = (unsigned short)(row_base + F.lane); inv[(size_t)me1 * 32768 + i1] = (unsigned short)(row_base + F.lane); }
        __syncthreads();
    }
}
__device__ __forceinline__ void moe_tile_starts(Frame& F, int (&ts)[9]) {
    ts[0] = 0;
#pragma unroll
    for (int e = 0; e < 8; ++e) { const unsigned c = __hip_atomic_load((unsigned*)(F.ctl + CW_CNT + e), __ATOMIC_RELAXED, __HIP_MEMORY_SCOPE_AGENT); ts[e + 1] = ts[e] + (int)((c + 255u) >> 8); }
#pragma unroll
    for (int e = 0; e < 9; ++e) ts[e] = __builtin_amdgcn_readfirstlane(ts[e]);
}
template <class Sched> __device__ __forceinline__ void moe_row_table(Frame& F, const Args& A, const Sched& S, const int (&ts)[9]) {
    const unsigned short* inv = (const unsigned short*)(A.ws + WS_INV); LAS unsigned short* tab = (LAS unsigned short*)(F.lds + ATAB_OFF);
    __syncthreads();
    for (int i = 0; i < ATAB_UNITS; ++i) { pg8::Unit u; if (!S.next(i, u)) break;
        int e = 0;
#pragma unroll
        for (int q = 1; q < 8; ++q) e += (u.pm >= ts[q]) ? 1 : 0;
        int tse = 0;
#pragma unroll
        for (int q = 0; q < 8; ++q) tse = (e == q) ? ts[q] : tse;
        const unsigned cnt = __hip_atomic_load((unsigned*)(F.ctl + CW_CNT + e), __ATOMIC_RELAXED, __HIP_MEMORY_SCOPE_AGENT);
        if (F.tid < 256) { const unsigned r = (unsigned)(u.pm - tse) * 256u + (unsigned)F.tid; tab[i * 256 + F.tid] = (r < cnt) ? inv[(size_t)e * 32768 + r] : (unsigned short)0; } }
    __syncthreads();
}
__device__ __forceinline__ void thin_t5(Frame& F, const Args& A) {
    int ts[9]; moe_tile_starts(F, ts);
    const float* modv = (const float*)(A.ws + WS_MODV); const bf16* Y = (const bf16*)(A.ws + WS_Y); const float* gam = A.in[6] + 7 * D; const unsigned* tok = (const unsigned*)(A.ws + WS_TOK);
    for (int r = F.gw; r < ML; r += F.ngw) {
        const int bs = r / SEQ; const float* mod1 = modv + (size_t)(17 + bs) * 6144;
        const unsigned* t = tok + (size_t)r * 8; const float w0 = __uint_as_float(t[4]), w1 = __uint_as_float(t[5]); const int e0 = (int)t[0], e1 = (int)t[1]; int s0 = 0, s1 = 0;
#pragma unroll
        for (int e = 0; e < 8; ++e) { s0 = (e0 == e) ? ts[e] : s0; s1 = (e1 == e) ? ts[e] : s1; }
        const unsigned p0 = (unsigned)s0 * 256u + t[2], p1 = (unsigned)s1 * 256u + t[3];
        f32x4 h[4], y0[4], y1[4]; ld_row_f32(A.out + (size_t)r * D, F.lane, h); ld_row_bf16(Y + (size_t)p0 * D, F.lane, y0); ld_row_bf16(Y + (size_t)p1 * D, F.lane, y1);
#pragma unroll
        for (int j = 0; j < 4; ++j) y0[j] = y0[j] * w0 + y1[j] * w1;
        gated_add(h, y0, gam, mod1 + 5 * D, F.lane); st_row_f32(A.out + (size_t)r * D, F.lane, h);
    }
}

__device__ __forceinline__ float rope_inv(int f) { return exp2f(-(float)f * (13.287712379549449f / 8.0f)); }
__device__ __forceinline__ void prep_qa(Frame& F, const Args& A) {
    const bf16* Z0 = (const bf16*)(A.ws + WS_Z0C); bf16* QA = (bf16*)(A.ws + WS_QA); bf16* KR = (bf16*)(A.ws + WS_KR);
    for (int r = F.gw; r < MA; r += F.ngw) {
        const bf16* z = Z0 + (size_t)r * 512;
        const v2u cq = *((const GAS v2u*)(z) + F.lane); const unsigned ck = *((const GAS unsigned*)(z + 256) + F.lane);
        const float q0 = bf_lo(cq.x), q1 = bf_hi(cq.x), q2 = bf_lo(cq.y), q3 = bf_hi(cq.y), k0 = bf_lo(ck), k1 = bf_hi(ck);
        const float rq = rsqrtf(wave_sum((q0 * q0 + q1 * q1) + (q2 * q2 + q3 * q3)) * (1.0f / QRANK) + EPS);
        const float rk = rsqrtf(wave_sum(k0 * k0 + k1 * k1) * (1.0f / KVRANK) + EPS);
        v2u oq; oq.x = pk2(q0 * rq, q1 * rq); oq.y = pk2(q2 * rq, q3 * rq);
        *((GAS v2u*)(QA + (size_t)r * KQKV) + F.lane) = oq; *((GAS unsigned*)(QA + (size_t)r * KQKV + QRANK) + F.lane) = pk2(k0 * rk, k1 * rk);
        const int l = F.lane & 31; float v = bf1(z[384 + l]); const float pv = __shfl_xor(v, 8);
        if (r < ML) { const int t = r % SEQ; const float pos = (l < 16) ? (float)(t / 64) : (float)(t % 64); float sn, cs; sincosf(pos * rope_inv(l & 7), &sn, &cs);
            v = (l & 8) ? (v * cs + pv * sn) : (v * cs - pv * sn); }
        if (F.lane < 32) KR[(size_t)r * 32 + l] = (bf16)f2bf(v);
    }
}
__device__ __forceinline__ void rope_q(Frame& F, const Args& A) {
    bf16* Q = (bf16*)(A.ws + WS_Q);
    for (int r = F.gw; r < ML; r += F.ngw) {
        const int t = r % SEQ, hh = F.lane >> 3, sub = F.lane & 7; bf16* p = Q + (size_t)r * 768 + hh * QK + NOPE + sub;
        const float inv = rope_inv(sub); float sr, cr, sc, cc; sincosf((float)(t / 64) * inv, &sr, &cr); sincosf((float)(t % 64) * inv, &sc, &cc);
        const float x0 = bf1(p[0]), x1 = bf1(p[8]), x2 = bf1(p[16]), x3 = bf1(p[24]);
        p[0] = (bf16)f2bf(x0 * cr - x1 * sr); p[8] = (bf16)f2bf(x1 * cr + x0 * sr); p[16] = (bf16)f2bf(x2 * cc - x3 * sc); p[24] = (bf16)f2bf(x3 * cc + x2 * sc);
    }
}
__device__ __forceinline__ int scan_row(int b, int dir, int tau) {
    if (tau < CTXL) return ML + b * CTXL + (dir ? CTXL - 1 - tau : tau);
    const int t = tau - CTXL; return b * SEQ + (dir ? SEQ - 1 - t : t);
}
__device__ __forceinline__ float gelu_tanh(float x) { const float u = 0.7978845608028654f * (x + 0.044715f * x * x * x); const float e = __expf(2.0f * u); const float th = 1.0f - 2.0f / (e + 1.0f); return 0.5f * x * (1.0f + th); }
__device__ __forceinline__ void gen_s5(Frame& F, const Args& A, int g) {
    constexpr int CS = 65, PS = 34, KS = 260;
    LAS float* pw = (LAS float*)F.lds;
    LAS float* cc = pw + 2 * 64 * PS;
    LAS float* bb = cc + 2 * 16 * CS * 2;
    LAS float* KK = bb + 2 * 64 * 16 * 2;
    LAS float* LL = KK + 2 * 16 * KS;
    LAS float* DSK = LL + 128 * 4;
    bf16* B1g = (bf16*)(A.ws + WS_B1) + (size_t)g * 256 * 256; bf16* B3g = (bf16*)(A.ws + WS_B3) + (size_t)g * 256 * 512;
    __syncthreads();
    { float lr = 0.f, li = 0.f, dtr = 0.f, dk = 0.f, braw[4], biraw[4], craw[4], ciraw[4];
      if (F.tid < 128) { const int d = F.tid >> 6, p = F.tid & 63, ig = d * S5G + g, i = ig * S5P + p; lr = A.in[8][i]; li = A.in[9][i]; dtr = A.in[10][ig]; }
      if (F.tid < 16) dk = A.in[15][g * 16 + F.tid];
#pragma unroll
      for (int q = 0; q < 4; ++q) { const int idx = F.tid + q * (NWAVES * 64); { const int dp = idx >> 4, h = idx & 15, d = dp >> 6, p = dp & 63; const size_t i = (size_t)((d * S5G + g) * S5P + p); braw[q] = A.in[11][i * 16 + h]; biraw[q] = A.in[12][i * 16 + h]; }
        { const int d = idx >> 10, ho = (idx >> 6) & 15, p = idx & 63; const size_t ci = (size_t)((d * S5G + g) * 16 + ho) * S5P + p; craw[q] = A.in[13][ci]; ciraw[q] = A.in[14][ci]; } }
      if (F.tid < 128) { const float dt = expf(dtr); LL[F.tid * 4] = lr; LL[F.tid * 4 + 1] = li; LL[F.tid * 4 + 2] = lr * dt; LL[F.tid * 4 + 3] = li * dt; }
      if (F.tid < 16) DSK[F.tid] = dk;
#pragma unroll
      for (int q = 0; q < 4; ++q) { const int idx = F.tid + q * (NWAVES * 64); bb[idx * 2] = braw[q]; bb[idx * 2 + 1] = biraw[q];
        { const int d = idx >> 10, ho = (idx >> 6) & 15, p = idx & 63; cc[((d * 16 + ho) * CS + p) * 2] = craw[q]; cc[((d * 16 + ho) * CS + p) * 2 + 1] = ciraw[q]; } } }
    __syncthreads();
    PROBE_STAMP2(F, 25);
    for (int idx = F.tid; idx < 128 * 17; idx += NWAVES * 64) { const int dp = idx / 17, k = idx - dp * 17;
        const float mag = expf((float)k * LL[dp * 4 + 2]), ang = (float)k * LL[dp * 4 + 3]; pw[dp * PS + k * 2] = mag * cosf(ang); pw[dp * PS + k * 2 + 1] = mag * sinf(ang); }
    for (int idx = F.tid; idx < 128 * 16; idx += NWAVES * 64) { const int dp = idx >> 4;
        const float lr = LL[dp * 4], li = LL[dp * 4 + 1], lrdt = LL[dp * 4 + 2], lidt = LL[dp * 4 + 3];
        const float mag = expf(lrdt), ar = mag * cosf(lidt), ai = mag * sinf(lidt), den = lr * lr + li * li, nr = ar - 1.0f;
        const float cr = (nr * lr + ai * li) / den, ci = (ai * lr - nr * li) / den;
        const float br = bb[idx * 2], bi = bb[idx * 2 + 1]; bb[idx * 2] = cr * br - ci * bi; bb[idx * 2 + 1] = cr * bi + ci * br; }
    __syncthreads();
    PROBE_STAMP2(F, 26);
    { const int ho = F.tid & 15, k = (F.tid >> 4) & 15, d = F.tid >> 8;
      float acc[16];
#pragma unroll
      for (int hi = 0; hi < 16; ++hi) acc[hi] = 0.f;
      for (int p = 0; p < 64; ++p) { const float cr = cc[((d * 16 + ho) * CS + p) * 2], ci = cc[((d * 16 + ho) * CS + p) * 2 + 1], pr = pw[(d * 64 + p) * PS + k * 2], pi = pw[(d * 64 + p) * PS + k * 2 + 1];
          const float wr = cr * pr - ci * pi, wi = cr * pi + ci * pr; const LAS f32x4* bp = (const LAS f32x4*)(bb + (d * 64 + p) * 32);
#pragma unroll
          for (int q = 0; q < 8; ++q) { const f32x4 b4 = bp[q]; acc[2 * q] += wr * b4.x - wi * b4.y; acc[2 * q + 1] += wr * b4.z - wi * b4.w; } }
#pragma unroll
      for (int hi = 0; hi < 16; ++hi) KK[(d * 16 + k) * KS + ho * 16 + hi] = acc[hi]; }
    __syncthreads();
    PROBE_STAMP2(F, 27);
    for (int it = F.tid; it < 256 * 32; it += NWAVES * 64) { const int n = it >> 5, kk0 = (it & 31) * 8;
        float v3[8], v3b[8], v1[8];
        { const int j = n >> 4, ho = n & 15, i = kk0 >> 4, hi0 = kk0 & 15; const float dsk = DSK[ho];
#pragma unroll
          for (int e8 = 0; e8 < 8; ++e8) { const int hi = hi0 + e8; float val = 0.f;
            if (i <= j) val += KK[(0 * 16 + (j - i)) * KS + ho * 16 + hi];
            if (i >= j) val += KK[(1 * 16 + (i - j)) * KS + ho * 16 + hi];
            if (i == j && ho == hi) val += dsk;
            v3[e8] = val; }
          const int d = kk0 >> 7, reim = (kk0 >> 6) & 1, p0 = kk0 & 63, e = d ? (16 - j) : (j + 1);
#pragma unroll
          for (int e8 = 0; e8 < 8; ++e8) { const int p = p0 + e8;
            const float cr = cc[((d * 16 + ho) * CS + p) * 2], ci = cc[((d * 16 + ho) * CS + p) * 2 + 1], pr = pw[(d * 64 + p) * PS + e * 2], pi = pw[(d * 64 + p) * PS + e * 2 + 1];
            v3b[e8] = reim ? -(cr * pi + ci * pr) : (cr * pr - ci * pi); } }
        { const int d = n >> 7, reim = (n >> 6) & 1, p = n & 63, i = kk0 >> 4, hi0 = kk0 & 15, e = d ? i : (15 - i);
          const float pr = pw[(d * 64 + p) * PS + e * 2], pi = pw[(d * 64 + p) * PS + e * 2 + 1];
#pragma unroll
          for (int e8 = 0; e8 < 8; ++e8) { const int hi = hi0 + e8; const float br = bb[((d * 64 + p) * 16 + hi) * 2], bi = bb[((d * 64 + p) * 16 + hi) * 2 + 1];
            v1[e8] = reim ? (pr * bi + pi * br) : (pr * br - pi * bi); } }
        const v4u w3 = {pk2(v3[0], v3[1]), pk2(v3[2], v3[3]), pk2(v3[4], v3[5]), pk2(v3[6], v3[7])}, w3b = {pk2(v3b[0], v3b[1]), pk2(v3b[2], v3b[3]), pk2(v3b[4], v3b[5]), pk2(v3b[6], v3b[7])};
        const v4u w1 = {pk2(v1[0], v1[1]), pk2(v1[2], v1[3]), pk2(v1[4], v1[5]), pk2(v1[6], v1[7])};
        *(GAS v4u*)(B3g + (size_t)n * 512 + kk0) = w3; *(GAS v4u*)(B3g + (size_t)n * 512 + 256 + kk0) = w3b; *(GAS v4u*)(B1g + (size_t)n * 256 + kk0) = w1; }
    __syncthreads();
}
__device__ __forceinline__ void s5_scan(Frame& F, const Args& A) {
    if (F.wave < 4) {
        const float* DS = (const float*)(A.ws + WS_DS); bf16* A3 = (bf16*)(A.ws + WS_A3); const int p = F.lane;
        for (int task = blockIdx.x * 4 + F.wave; task < NB * S5G * 2; task += F.G * 4) {
            const int d = task & 1, g = (task >> 1) & 31, b = task >> 6, ig = d * S5G + g;
            const float lr = A.in[8][ig * S5P + p], li = A.in[9][ig * S5P + p], dt = expf(A.in[10][ig]);
            const float m16 = expf(16.0f * lr * dt), a16r = m16 * cosf(16.0f * li * dt), a16i = m16 * sinf(16.0f * li * dt);
            const float* ds = DS + (size_t)(g * 16 + b) * 144 * 256 + d * 128 + p; bf16* so = A3 + (size_t)(g * 16 + b) * 144 * 512 + 256 + d * 128 + p;
            float sr = 0.f, si = 0.f;
            for (int blk = 0; blk < 9; ++blk) {
                const int cbase = d ? (blk == 0 ? 15 : 143 - (blk - 1) * 16) : blk * 16, cstep = d ? -1 : 1;
                float xr[16], xi[16];
#pragma unroll
                for (int s = 0; s < 16; ++s) { const int c = cbase + cstep * s; xr[s] = ds[(size_t)c * 256]; xi[s] = ds[(size_t)c * 256 + 64]; }
#pragma unroll
                for (int s = 0; s < 16; ++s) { const int c = cbase + cstep * s; so[(size_t)c * 512] = (bf16)f2bf(sr); so[(size_t)c * 512 + 64] = (bf16)f2bf(si);
                    const float nsr = a16r * sr - a16i * si + xr[s], nsi = a16r * si + a16i * sr + xi[s]; sr = nsr; si = nsi; }
            }
        }
    }
}
__device__ __forceinline__ void attn_phase(Frame& F, const Args& A) {
    const bf16* Q = (const bf16*)(A.ws + WS_Q); const bf16* KV = (const bf16*)(A.ws + WS_KV); const bf16* KR = (const bf16*)(A.ws + WS_KR); bf16* AO = (bf16*)(A.ws + WS_AO);
    const int bid = (int)blockIdx.x; const int vcu = (F.G % 8 == 0) ? (bid % 8) * (F.G / 8) + bid / 8 : bid;
    for (int u = vcu; u < 1024 + 128; u += F.G) {
        int b, h, qrow0, NT;
        if (u < 1024) { const int bh = u >> 3; b = bh >> 3; h = bh & 7; qrow0 = b * SEQ + (u & 7) * 256; NT = TT / 64; }
        else { const int uu = u - 1024; b = uu >> 3; h = uu & 7; qrow0 = ML + b * CTXL; NT = CTXL / 64; }
        att::attn_unit(Q + (size_t)qrow0 * 768 + h * QK, KV + h * NOPE, KR, KV + 512 + h * VD, ML + b * CTXL, CTXL / 64, b * SEQ, NT, AO + (size_t)qrow0 * D + S5W + h * VD, F.lds, (u < 1024) ? (u & 7) * 256 : -1);
    }
}
__device__ __forceinline__ void gla_prep_phase(Frame& F, const Args& A) {
    for (int j = blockIdx.x; j < NB * GH * 2 * 2; j += F.G) { const int ch = j >> 1, b = ch >> 3, h = (ch >> 1) & 3, dir = ch & 1;
        gla::gla_prep((const bf16*)(A.ws + WS_QK), (const bf16*)(A.ws + WS_VR) + 2048, A.in[27], A.in[28], (bf16*)(A.ws + WS_TQ), (bf16*)(A.ws + WS_TK), (bf16*)(A.ws + WS_TP), (float*)(A.ws + WS_EL),
                      b, h, dir, 18 * (j & 1), 18 * (j & 1) + 18, ML, SEQ, CTXL, F.lds); }
}
__device__ __forceinline__ void gla_chain_phase(Frame& F, const Args& A) {
    const int bid = (int)blockIdx.x; const int vcu = (F.G % 8 == 0) ? (bid % 8) * (F.G / 8) + bid / 8 : bid;
    for (int u = vcu; u < NB * GH * 2 * 2; u += F.G) { const int ch = u >> 1, vh = u & 1, b = ch >> 3, h = (ch >> 1) & 3, dir = ch & 1;
        gla::gla_chain2((const bf16*)(A.ws + WS_VR), (const bf16*)(A.ws + WS_TQ), (const bf16*)(A.ws + WS_TK), (const bf16*)(A.ws + WS_TP), (const float*)(A.ws + WS_EL), (bf16*)(A.ws + (dir ? WS_OB : WS_OF)),
                        b, h, dir, vh, ML, SEQ, CTXL, F.lds); }
}
__device__ __forceinline__ void gla_finish(Frame& F, const Args& A) {
    bf16* OF = (bf16*)(A.ws + WS_OF); const bf16* OB = (const bf16*)(A.ws + WS_OB); const bf16* VR = (const bf16*)(A.ws + WS_VR); const float* hn = A.in[29];
    const f32x4 g = *(const GAS f32x4*)(hn + 4 * F.lane);
    for (int r0 = F.gw; r0 < ML; r0 += 2 * F.ngw) {
        const int r1 = (r0 + F.ngw < ML) ? r0 + F.ngw : r0; const bool two = r1 != r0;
        f32x4 a0[4], b0[4], x0[4], a1[4], b1[4], x1[4];
        ld_row_bf16(OF + (size_t)r0 * D, F.lane, a0); ld_row_bf16(OB + (size_t)r0 * D, F.lane, b0); ld_row_bf16(VR + (size_t)r0 * VRLD + GVAL, F.lane, x0);
        ld_row_bf16(OF + (size_t)r1 * D, F.lane, a1); ld_row_bf16(OB + (size_t)r1 * D, F.lane, b1); ld_row_bf16(VR + (size_t)r1 * VRLD + GVAL, F.lane, x1);
#pragma unroll
        for (int j = 0; j < 4; ++j) { const f32x4 o0 = a0[j] + b0[j], o1 = a1[j] + b1[j];
            const float s0 = wave_sum((o0.x * o0.x + o0.y * o0.y) + (o0.z * o0.z + o0.w * o0.w)), s1 = wave_sum((o1.x * o1.x + o1.y * o1.y) + (o1.z * o1.z + o1.w * o1.w));
            const float rs0 = rsqrtf(s0 * (1.0f / GDV) + EPS), rs1 = rsqrtf(s1 * (1.0f / GDV) + EPS);
#pragma unroll
            for (int i = 0; i < 4; ++i) { const float u0 = x0[j][i], u1 = x1[j][i];
                a0[j][i] = o0[i] * rs0 * g[i] * (u0 * __builtin_amdgcn_rcpf(1.0f + __expf(-u0))); a1[j][i] = o1[i] * rs1 * g[i] * (u1 * __builtin_amdgcn_rcpf(1.0f + __expf(-u1))); } }
        st_row_bf16(OF + (size_t)r0 * D, F.lane, a0); if (two) st_row_bf16(OF + (size_t)r1 * D, F.lane, a1);
    }
}

#ifndef MK_ONE_LAUNCH
#define MK_ONE_LAUNCH 1
#endif
constexpr int NPHASE = 21;
constexpr bool SP2 = true, ALIGN = true;

__global__ void __launch_bounds__(NWAVES * 64, 2) fwd_kernel(Args args) {
    extern __shared__ __attribute__((aligned(16))) unsigned char lds[];
    Frame F;
    F.lds = (LAS unsigned char*)lds;
    F.MISC = (volatile LAS unsigned*)(F.lds + MISC_OFF);
    F.tid = threadIdx.x; F.lane = F.tid & 63; F.wave = __builtin_amdgcn_readfirstlane(F.tid >> 6);
    F.G = gridDim.x; F.gw = blockIdx.x * NWAVES + F.wave; F.ngw = F.G * NWAVES;
    unsigned char* ws = args.ws;
    F.ctl = (gu32*)(ws + WS_CTL);
    for (int u = F.tid; u < (LDS_BYTES - LDSCTL_OFF) / 4; u += NWAVES * 64) ((LAS unsigned*)(F.lds + LDSCTL_OFF))[u] = 0u;
    __syncthreads();
    XcdBarrier bar; bar.bar = (unsigned*)(F.ctl + CW_BAR); bar.x = 0; bar.st = nullptr;
    if (MK_ONE_LAUNCH) bar = xcd_barrier_post((unsigned*)(F.ctl + CW_BAR), F.MISC + 8);
    const int lo = args.ph_lo, hi = args.ph_hi;
#define IN(k) (lo <= (k) && (k) < hi)
#ifdef PROBE_SETA
    if (blockIdx.x == PROBE_BLK && F.tid == 0) { const unsigned long long t_ = __builtin_amdgcn_s_memrealtime(); F.MISC[16] = (unsigned)t_; F.MISC[17] = (unsigned)(t_ >> 32); }
#define PROBE_STAMP(k) do { if (blockIdx.x == PROBE_BLK && F.tid == 0) { const unsigned long long t_ = __builtin_amdgcn_s_memrealtime(); const unsigned long long l_ = ((unsigned long long)F.MISC[17] << 32) | F.MISC[16]; const unsigned d_ = (unsigned)(t_ - l_); \
        if ((PROBE_SETA >> (k)) & 1ull) F.MISC[18] += d_; if ((PROBE_SETB >> (k)) & 1ull) F.MISC[20] += d_; F.MISC[16] = (unsigned)t_; F.MISC[17] = (unsigned)(t_ >> 32); } } while (0)
#else
#define PROBE_STAMP(k) do { } while (0)
#endif
#define SEAM(k) do { if (MK_ONE_LAUNCH && IN(k) && IN((k) + 1)) xcd_barrier(bar); PROBE_STAMP(k); } while (0)
    const int bid = (int)blockIdx.x;

    if (IN(0)) {
#ifndef NO_P0
 p0_prologue(F, args);
#endif
 } SEAM(0);
    if (IN(1)) { thin_t1(F, args); } SEAM(1);
    if (IN(2)) { pg8::Gemm g{(const bf16*)(ws + WS_XL), (const bf16*)(ws + WS_W_IN0), MA, EV_INP, D}; pg8::StaticOrder S; S.init(MA, EV_INP, F.G, bid);
        pg8::EpiIn0 E{(bf16*)(ws + WS_U), (bf16*)(ws + WS_A3), (bf16*)(ws + WS_Z0C)};
        pg8::gemm_phase<pg8::EpiIn0, pg8::StaticOrder, ALIGN, SP2>(F.lds + RING_OFF, g, S, E);
        tail_convert(F, args, (MA / 256) * (EV_INP / 256), MW0, MW1); } SEAM(2);
    if (IN(3)) { prep_qa(F, args);
        int k256 = 256; asm volatile("" : "+s"(k256));
        pg8::Gemm g{(const bf16*)(ws + WS_U), (const bf16*)(ws + WS_B1), 32 * 2304, 256, k256}; pg8::S5Order S{F.G, bid};
        pg8::EpiF32 E{(float*)(ws + WS_DS), 256};
        pg8::gemm_phase<pg8::EpiF32, pg8::S5Order, ALIGN, SP2>(F.lds + RING_OFF, g, S, E); } SEAM(3);
    if (IN(4)) { s5_scan(F, args);
        pg8::Gemm g{(const bf16*)(ws + WS_QA), (const bf16*)(ws + WS_W_QKV), MA, NQKV, KQKV}; pg8::StaticOrder S; S.init(MA, NQKV, F.G, bid);
        pg8::EpiSplit E{(bf16*)(ws + WS_Q), 768, (bf16*)(ws + WS_KV), 1024, 3, 0x7fffffff};
        pg8::gemm_phase<pg8::EpiSplit, pg8::StaticOrder, ALIGN, SP2>(F.lds + RING_OFF, g, S, E); } SEAM(4);
    if (IN(5)) {
        pg8::Gemm g{(const bf16*)(ws + WS_A3), (const bf16*)(ws + WS_B3), 32 * 2304, 256, 512}; pg8::S5Order S{F.G, bid};
        pg8::EpiS5Out E{(bf16*)(ws + WS_AG)};
        pg8::gemm_phase<pg8::EpiS5Out, pg8::S5Order, ALIGN, SP2>(F.lds + RING_OFF, g, S, E); } SEAM(5);
    if (IN(6)) {
#ifndef NO_ATT
 attn_phase(F, args);
#endif
        PROBE_STAMP(21);
        pg8::Gemm g{(const bf16*)(ws + WS_AG), (const bf16*)(ws + WS_W_GLU), MA, S5W, S5W}; pg8::StaticOrder S; S.init(MA, S5W, F.G, bid);
        pg8::EpiGlu E{(const bf16*)(ws + WS_AG), args.in[17], (bf16*)(ws + WS_AO), D};
        pg8::gemm_phase<pg8::EpiGlu, pg8::StaticOrder, ALIGN, SP2, false, false, true>(F.lds + RING_OFF, g, S, E); } SEAM(6);
    if (IN(7)) { pg8::Gemm g{(const bf16*)(ws + WS_AO), (const bf16*)(ws + WS_W_OUT0), MA, D, D}; pg8::StaticOrder S; S.init(MA, D, F.G, bid);
        pg8::EpiPlain E{(bf16*)(ws + WS_YL), D, 0, 0, 1.0f};
        pg8::gemm_phase<pg8::EpiPlain, pg8::StaticOrder, ALIGN, SP2>(F.lds + RING_OFF, g, S, E);
        tail_convert(F, args, (MA / 256) * (D / 256), MW1, MW2); } SEAM(7);
    if (IN(8)) { thin_t2(F, args); } SEAM(8);
    static_assert(!FFN0_IS_FP8, "the e4m3 dense-FFN variant does not carry the MoE weight conversion in its down phase");
    if constexpr (FFN0_IS_FP8) {
    if (IN(9)) { pg8::Gemm g{(const bf16*)(ws + WS_XL), (const bf16*)(ws + WS_W_GU), MA, 2 * FFN, D / 2}; pg8::StaticOrder S; S.init(MA, 2 * FFN, F.G, bid);
        pg8::EpiSwiGlu8 E{ws + WS_ACT, FFN, 0, 1.0f / (FP8_SA * FP8_SW), FP8_SACT, 0};
        pg8::gemm_phase<pg8::EpiSwiGlu8, pg8::StaticOrder, ALIGN, SP2, true>(F.lds + RING_OFF, g, S, E); } SEAM(9);
    if (IN(10)) { pg8::Gemm g{(const bf16*)(ws + WS_ACT), (const bf16*)(ws + WS_W_DN), MA, D, FFN / 2}; pg8::StaticOrder S; S.init(MA, D, F.G, bid);
        pg8::EpiPlain E{(bf16*)(ws + WS_FL), D, 0, 0, 1.0f / (FP8_SACT * FP8_SW)};
        pg8::gemm_phase<pg8::EpiPlain, pg8::StaticOrder, ALIGN, SP2, true>(F.lds + RING_OFF, g, S, E); } SEAM(10);
    } else {
    if (IN(9)) { pg8::Gemm g{(const bf16*)(ws + WS_XL), (const bf16*)(ws + WS_W_GU), MA, 2 * FFN, D}; pg8::StaticOrder S; S.init(MA, 2 * FFN, F.G, bid);
        if constexpr (FFN0_DN_FP8) { pg8::EpiSwiGlu8 E{ws + WS_ACT, FFN, 0, 1.0f, FP8_SACT, 0};
            pg8::gemm_phase<pg8::EpiSwiGlu8, pg8::StaticOrder, ALIGN, SP2>(F.lds + RING_OFF, g, S, E); }
        else { pg8::EpiSwiGlu E{(bf16*)(ws + WS_ACT), FFN, 0, 0};
            pg8::gemm_phase<pg8::EpiSwiGlu, pg8::StaticOrder, ALIGN, SP2>(F.lds + RING_OFF, g, S, E); }
        tail_convert(F, args, (MA / 256) * (2 * FFN / 256), MW2, MW3); } SEAM(9);
    if (IN(10)) { pg8::StaticOrder S; S.init(MA, D, F.G, bid);
        if constexpr (FFN0_DN_FP8) { pg8::Gemm g{(const bf16*)(ws + WS_ACT), (const bf16*)(ws + WS_W_DN), MA, D, FFN / 2};
            pg8::EpiPlain E{(bf16*)(ws + WS_FL), D, 0, 0, 1.0f / (FP8_SACT * FP8_SW)};
            pg8::gemm_phase<pg8::EpiPlain, pg8::StaticOrder, ALIGN, SP2, true>(F.lds + RING_OFF, g, S, E); }
        else { pg8::Gemm g{(const bf16*)(ws + WS_ACT), (const bf16*)(ws + WS_W_DN), MA, D, FFN};
            pg8::EpiPlain E{(bf16*)(ws + WS_FL), D, 0, 0, 1.0f};
            pg8::gemm_phase<pg8::EpiPlain, pg8::StaticOrder, ALIGN, SP2>(F.lds + RING_OFF, g, S, E); }
        tail_convert(F, args, (MA / 256) * (D / 256), MW3, MW4); } SEAM(10);
    }
    if (IN(11)) { thin_t3(F, args); } SEAM(11);
    if (IN(12)) { pg8::Gemm g{(const bf16*)(ws + WS_XL), (const bf16*)(ws + WS_W_IN1), MA, OD_INP, D}; pg8::StaticOrder S; S.init(MA, OD_INP, F.G, bid);
        pg8::EpiSplit E{(bf16*)(ws + WS_QK), 1024, (bf16*)(ws + WS_VR), VRLD, 4, 0x7fffffff};
        pg8::gemm_phase<pg8::EpiSplit, pg8::StaticOrder, ALIGN, SP2>(F.lds + RING_OFF, g, S, E);
        tail_convert(F, args, (MA / 256) * (OD_INP / 256), MW4, MW5); } SEAM(12);
    if (IN(13)) {
#ifndef NO_GLA
 gla_prep_phase(F, args);
#endif
    } SEAM(13);
    if (IN(14)) {
#ifndef NO_GLA
 gla_chain_phase(F, args);
#endif
    } SEAM(14);
    if (IN(15)) { gla_finish(F, args); } SEAM(15);
    if (IN(16)) { pg8::Gemm g{(const bf16*)(ws + WS_OF), (const bf16*)(ws + WS_W_OUT1), ML, D, D}; pg8::StaticOrder S; S.init(ML, D, F.G, bid);
        pg8::EpiPlain E{(bf16*)(ws + WS_YL1), D, 0, 0, 1.0f};
        pg8::gemm_phase<pg8::EpiPlain, pg8::StaticOrder, ALIGN, SP2>(F.lds + RING_OFF, g, S, E); } SEAM(16);
    if (IN(17)) { thin_t4(F, args); } SEAM(17);
    if (lo < 20 && hi > 18) {
        int ts[9]; moe_tile_starts(F, ts); const int NT = ts[8];
        if (IN(18)) { pg8::MoeOrder S{0, NT, 2 * FE / 256, F.G, bid, ts[1], ts[2], ts[3], ts[4], ts[5], ts[6], ts[7], 0};
            moe_row_table(F, args, S, ts);
            pg8::Gemm g{(const bf16*)(ws + WS_XLM), (const bf16*)(ws + WS_W_MGU), ML, 2 * FE, D / 2, (const LAS unsigned short*)(F.lds + ATAB_OFF)};
            pg8::EpiSwiGlu8 E{ws + WS_ACTM, FE, 2 * FE / 256, 1.0f / (FP8_SA * FP8_SW), FP8_SACT, 1};
            pg8::gemm_phase<pg8::EpiSwiGlu8, pg8::MoeOrder, ALIGN, SP2, true, false, false, true>(F.lds + RING_OFF, g, S, E); } SEAM(18);
        if (IN(19)) { pg8::Gemm g{(const bf16*)(ws + WS_ACTM), (const bf16*)(ws + WS_W_MDN), MOE_MAXT * 256, D, FE / 2};
            pg8::MoeOrder S{0, NT, D / 256, F.G, bid, ts[1], ts[2], ts[3], ts[4], ts[5], ts[6], ts[7], 1};
            pg8::EpiPlain E{(bf16*)(ws + WS_Y), D, 0, D / 256, 1.0f / (FP8_SACT * FP8_SW)};
            pg8::gemm_phase<pg8::EpiPlain, pg8::MoeOrder, ALIGN, SP2, true, true>(F.lds + RING_OFF, g, S, E); } SEAM(19);
    }
    if (IN(20)) { thin_t5(F, args); }
#ifdef PROBE_SETA
    PROBE_STAMP(20);
    if (blockIdx.x == PROBE_BLK && F.tid == 0) {
        unsigned long long qa = F.MISC[18] / 100u, qb = F.MISC[20] / 400u; qa = qa > 999 ? 999 : qa; qb = qb > 199 ? 199 : qb;
        const unsigned long long t0 = __builtin_amdgcn_s_memrealtime(), dl = qa * 1000ull + qb * 1000000ull;
        while (__builtin_amdgcn_s_memrealtime() - t0 < dl) __builtin_amdgcn_s_sleep(32);
    }
#endif
#undef IN
#undef SEAM
}

extern "C" void kernel_launch(void* const* d_in, const int* in_sizes, int n_in, void* d_out, int out_size, void* d_ws, size_t ws_size, hipStream_t stream) {
    static int grid = 0;
    if (grid == 0) {
        if (n_in != 35 || out_size != ML * D || ws_size < WS_END) { fprintf(stderr, "kernel_launch: unexpected shapes: n_in %d out %d ws %zu (need %zu)\n", n_in, out_size, ws_size, (size_t)WS_END); grid = -1; return; }
        int dev = 0, cus = 0, per_cu = 0;
        if (hipGetDevice(&dev) != hipSuccess || hipDeviceGetAttribute(&cus, hipDeviceAttributeMultiprocessorCount, dev) != hipSuccess) { grid = -1; return; }
        if (hipFuncSetAttribute((const void*)fwd_kernel, hipFuncAttributeMaxDynamicSharedMemorySize, LDS_BYTES) != hipSuccess) { fprintf(stderr, "kernel_launch: hipFuncSetAttribute failed\n"); grid = -1; return; }
        if (hipOccupancyMaxActiveBlocksPerMultiprocessor(&per_cu, (const void*)fwd_kernel, NWAVES * 64, LDS_BYTES) != hipSuccess || per_cu < 1) { fprintf(stderr, "kernel_launch: occupancy query reports %d blocks per CU\n", per_cu); }
        (void)hipGetLastError();
        grid = cus;
    }
    if (grid < 0) return;
    (void)hipMemsetAsync((char*)d_ws + WS_CTL, 0, CTL_ZERO_BYTES, stream);
    Args a{};
    for (int i = 0; i < 35; ++i) a.in[i] = (const float*)d_in[i];
    a.out = (float*)d_out; a.ws = (unsigned char*)d_ws;
#if MK_ONE_LAUNCH
    a.ph_lo = 0; a.ph_hi = NPHASE;
    hipLaunchKernelGGL(fwd_kernel, dim3(grid), dim3(NWAVES * 64), LDS_BYTES, stream, a);
#else
    for (int p = 0; p < NPHASE; ++p) { a.ph_lo = p; a.ph_hi = p + 1; hipLaunchKernelGGL(fwd_kernel, dim3(grid), dim3(NWAVES * 64), LDS_BYTES, stream, a); }
#endif
}
```

```cpp
#include <hip/hip_runtime.h>
#include <cstdio>
#include <cstdint>
#define MK_ONE_LAUNCH 1
namespace pg8 {
#define PG8_LAS __attribute__((address_space(3)))
typedef unsigned short bf16_t;
typedef short bf16x8 __attribute__((ext_vector_type(8)));
typedef float f32x4 __attribute__((ext_vector_type(4)));
typedef unsigned u32x4 __attribute__((ext_vector_type(4)));
constexpr int BM = 256, BK = 64, HALF = 128, HTB = HALF * BK * 2  , STAGE_BYTES = 8 * HTB, NXCD = 8, WGM = 8;

__host__ __device__ __forceinline__ int lds_byte(int r, int c) { const int st = (r >> 4) * 2 + (c >> 5), rr = r & 15, cc = c & 31, ob = rr * 64 + cc * 2; return st * 1024 + (ob ^ (((ob >> 9) & 1) << 5)); }
__host__ __device__ __forceinline__ void stage_rc(int b, int& R, int& C) { const int st = b / 1024, sb = b % 1024, swz = sb ^ (((sb >> 9) & 1) << 5); R = (st >> 1) * 16 + swz / 64; C = (st & 1) * 32 + (swz % 64) / 2; }
__host__ __device__ __forceinline__ int perm32(int rho) { const int n = rho >> 4, i = rho & 15; return 8 * (i >> 2) + 4 * n + (i & 3); }

struct Unit { int pm, pn; };
struct Gemm { const bf16_t* A; const bf16_t* Bt; int M, N, K; const PG8_LAS unsigned short* atab = nullptr; };
constexpr unsigned ACH_GS = 2304u * 256u * 2u;

struct StaticOrder {
    int nM, nN, nwg, G, c;
    __host__ __device__ void init(int M, int N, int G_, int c_) { nM = M / BM; nN = N / BM; nwg = nM * nN; G = G_; c = c_; }
    __host__ __device__ bool next(int i, Unit& u) const {
        const long L = (long)i * G + c; if (L >= nwg) return false;
        int wgid = (int)L; { const int q = nwg / NXCD, r = nwg % NXCD, xcd = wgid % NXCD, off = wgid / NXCD; wgid = (xcd < r ? xcd * (q + 1) : r * (q + 1) + (xcd - r) * q) + off; }
        const int nig = WGM * nN, gid = wgid / nig, fm = gid * WGM, gsz = (nM - fm) < WGM ? (nM - fm) : WGM;
        u.pm = fm + ((wgid % nig) % gsz); u.pn = (wgid % nig) / gsz; return true;
    }
    __device__ __forceinline__ void a_ready(const Unit&) const {}
    __device__ __forceinline__ void done(const Unit&) const {}
};

__device__ __forceinline__ unsigned cvt_pk_bf16(float lo, float hi) { unsigned r; asm volatile("v_cvt_pk_bf16_f32 %0, %1, %2" : "=v"(r) : "v"(lo), "v"(hi)); return r; }
typedef float f32x2 __attribute__((ext_vector_type(2)));
__device__ __forceinline__ u32x4 pack8(const f32x4 v0, const f32x4 v1) { u32x4 w; w.x = cvt_pk_bf16(v0[0], v0[1]); w.y = cvt_pk_bf16(v0[2], v0[3]); w.z = cvt_pk_bf16(v1[0], v1[1]); w.w = cvt_pk_bf16(v1[2], v1[3]); return w; }
__device__ __forceinline__ float bf_lo(unsigned u) { return __uint_as_float(u << 16); }
__device__ __forceinline__ float bf_hi(unsigned u) { return __uint_as_float(u & 0xffff0000u); }
__device__ __forceinline__ unsigned pk4_fp8(float a, float b, float c, float d) {
    a = __builtin_amdgcn_fmed3f(a, -448.f, 448.f); b = __builtin_amdgcn_fmed3f(b, -448.f, 448.f); c = __builtin_amdgcn_fmed3f(c, -448.f, 448.f); d = __builtin_amdgcn_fmed3f(d, -448.f, 448.f);
    int r = __builtin_amdgcn_cvt_pk_fp8_f32(a, b, 0, false); r = __builtin_amdgcn_cvt_pk_fp8_f32(c, d, r, true); return (unsigned)r; }
__device__ __forceinline__ float sigmoid_f(float x) { return __builtin_amdgcn_rcpf(1.0f + __builtin_amdgcn_exp2f(-1.4426950408889634f * x)); }

struct EpiPlain {
    static constexpr bool PERM = true, AFTER_DRAIN = false;
    bf16_t* O; int ldc; int pm_off; int nmod; float sc;
    __device__ __forceinline__ void operator()(const f32x4 (&acc)[2][2][4][2], const Unit& u, int wr, int wc, int fr, int fq) const {
        const int row0 = (u.pm - pm_off) * BM + wr * 64 + fr; const int ct = nmod ? (u.pn % nmod) : u.pn; const int col0 = ct * BM + wc * 32 + 8 * fq;
#pragma unroll
        for (int ai = 0; ai < 2; ++ai)
#pragma unroll
            for (int m = 0; m < 4; ++m) { bf16_t* rowp = O + (size_t)(row0 + ai * HALF + m * 16) * ldc + col0;
#pragma unroll
                for (int bj = 0; bj < 2; ++bj) *(u32x4*)(rowp + bj * HALF) = pack8(acc[ai][bj][m][0] * sc, acc[ai][bj][m][1] * sc); }
    }
};
struct EpiSplit {
    static constexpr bool PERM = true, AFTER_DRAIN = false;
    bf16_t* O0; int ld0; bf16_t* O1; int ld1; int nsplit; int ncols1;
    __device__ __forceinline__ void operator()(const f32x4 (&acc)[2][2][4][2], const Unit& u, int wr, int wc, int fr, int fq) const {
        const int row0 = u.pm * BM + wr * 64 + fr; const bool first = u.pn < nsplit;
        bf16_t* base = first ? O0 : O1; const int ld = first ? ld0 : ld1; const int col0 = (first ? u.pn : u.pn - nsplit) * BM + wc * 32 + 8 * fq; const int lim = first ? 0x7fffffff : ncols1;
#pragma unroll
        for (int ai = 0; ai < 2; ++ai)
#pragma unroll
            for (int m = 0; m < 4; ++m) { bf16_t* rowp = base + (size_t)(row0 + ai * HALF + m * 16) * ld + col0;
#pragma unroll
                for (int bj = 0; bj < 2; ++bj) if (col0 + bj * HALF < lim) *(u32x4*)(rowp + bj * HALF) = pack8(acc[ai][bj][m][0], acc[ai][bj][m][1]); }
    }
};
struct EpiGlu {
    static constexpr bool PERM = true, AFTER_DRAIN = false;
    const bf16_t* Aa; const float* bias; bf16_t* O; int ldc;
    __device__ __forceinline__ void operator()(const f32x4 (&acc)[2][2][4][2], const Unit& u, int wr, int wc, int fr, int fq) const {
        const int row0 = u.pm * BM + wr * 64 + fr; const int col0 = u.pn * BM + wc * 32 + 8 * fq;
        const int crow0 = (u.pm < 128 ? (u.pm >> 3) * 144 + 16 + (u.pm & 7) * 16 : (u.pm - 128) * 144) + wr * 4;
#pragma unroll
        for (int bj = 0; bj < 2; ++bj) { const f32x4 b0 = *(const f32x4*)(bias + col0 + bj * HALF), b1 = *(const f32x4*)(bias + col0 + bj * HALF + 4);
            const int cg = (col0 + bj * HALF) >> 4, ch = (col0 + bj * HALF) & 15;
#pragma unroll
            for (int ai = 0; ai < 2; ++ai)
#pragma unroll
                for (int m = 0; m < 4; ++m) { const size_t r = (size_t)(row0 + ai * HALF + m * 16);
                    const u32x4 a8 = *(const u32x4*)(Aa + (size_t)cg * (2304 * 256) + (size_t)(crow0 + ai * 8 + m) * 256 + fr * 16 + ch);
                    f32x4 v0 = acc[ai][bj][m][0] + b0, v1 = acc[ai][bj][m][1] + b1;
                    v0[0] = bf_lo(a8.x) * sigmoid_f(v0[0]); v0[1] = bf_hi(a8.x) * sigmoid_f(v0[1]); v0[2] = bf_lo(a8.y) * sigmoid_f(v0[2]); v0[3] = bf_hi(a8.y) * sigmoid_f(v0[3]);
                    v1[0] = bf_lo(a8.z) * sigmoid_f(v1[0]); v1[1] = bf_hi(a8.z) * sigmoid_f(v1[1]); v1[2] = bf_lo(a8.w) * sigmoid_f(v1[2]); v1[3] = bf_hi(a8.w) * sigmoid_f(v1[3]);
                    *(u32x4*)(O + r * ldc + col0 + bj * HALF) = pack8(v0, v1); } }
    }
};
struct EpiSwiGlu {
    static constexpr bool PERM = true, AFTER_DRAIN = false;
    bf16_t* O; int ldc; int pm_off; int nmod;
    __device__ __forceinline__ void operator()(const f32x4 (&acc)[2][2][4][2], const Unit& u, int wr, int wc, int fr, int fq) const {
        const int row0 = (u.pm - pm_off) * BM + wr * 64 + fr; const int ct = nmod ? (u.pn % nmod) : u.pn; const int col0 = ct * HALF + wc * 32 + 8 * fq;
#pragma unroll
        for (int ai = 0; ai < 2; ++ai)
#pragma unroll
            for (int m = 0; m < 4; ++m) { f32x4 o0, o1;
#pragma unroll
                for (int i = 0; i < 4; ++i) { const float g0 = acc[ai][0][m][0][i], g1 = acc[ai][0][m][1][i]; o0[i] = g0 * sigmoid_f(g0) * acc[ai][1][m][0][i]; o1[i] = g1 * sigmoid_f(g1) * acc[ai][1][m][1][i]; }
                *(u32x4*)(O + (size_t)(row0 + ai * HALF + m * 16) * ldc + col0) = pack8(o0, o1); }
    }
};
struct EpiIn0 {
    static constexpr bool PERM = true, AFTER_DRAIN = false;
    bf16_t* U; bf16_t* A3; bf16_t* Z0c;
    __device__ __forceinline__ void operator()(const f32x4 (&acc)[2][2][4][2], const Unit& u, int wr, int wc, int fr, int fq) const {
        if (u.pn >= 2) {
            const int row0 = u.pm * BM + wr * 64 + fr, col0 = (u.pn - 2) * BM + wc * 32 + 8 * fq;
#pragma unroll
            for (int ai = 0; ai < 2; ++ai)
#pragma unroll
                for (int m = 0; m < 4; ++m) { bf16_t* rowp = Z0c + (size_t)(row0 + ai * HALF + m * 16) * 512 + col0;
#pragma unroll
                    for (int bj = 0; bj < 2; ++bj) *(u32x4*)(rowp + bj * HALF) = pack8(acc[ai][bj][m][0], acc[ai][bj][m][1]); }
        } else {
            const int b = (u.pm < 128) ? (u.pm >> 3) : (u.pm - 128); const int c0 = (u.pm < 128) ? (16 + (u.pm & 7) * 16) : 0;
            const int g0 = u.pn * 16 + wc * 2 + (fq >> 1);
            const size_t r0 = (size_t)(g0 * 16 + b) * 144 + c0 + wr * 4;
            const int cc = fr * 16 + 8 * (fq & 1);
#pragma unroll
            for (int ai = 0; ai < 2; ++ai)
#pragma unroll
                for (int m = 0; m < 4; ++m)
#pragma unroll
                    for (int bj = 0; bj < 2; ++bj) { const size_t r = r0 + (size_t)bj * (8 * 16 * 144) + ai * 8 + m; const u32x4 w = pack8(acc[ai][bj][m][0], acc[ai][bj][m][1]);
                        *(u32x4*)(U + r * 256 + cc) = w; *(u32x4*)(A3 + r * 512 + cc) = w; }
        }
    }
};
struct EpiF32 {
    static constexpr bool PERM = false, AFTER_DRAIN = false;
    float* C; int ldc;
    __device__ __forceinline__ void operator()(const f32x4 (&acc)[2][2][4][2], const Unit& u, int wr, int wc, int fr, int fq) const {
        const int row0 = u.pm * BM + wr * 64 + fr, col0 = wc * 32 + 4 * fq;
#pragma unroll
        for (int ai = 0; ai < 2; ++ai)
#pragma unroll
            for (int m = 0; m < 4; ++m) { float* rowp = C + (size_t)(row0 + ai * HALF + m * 16) * ldc + col0;
#pragma unroll
                for (int bj = 0; bj < 2; ++bj)
#pragma unroll
                    for (int n = 0; n < 2; ++n) *(f32x4*)(rowp + bj * HALF + n * 16) = acc[ai][bj][m][n]; }
    }
};
__device__ __forceinline__ float gelu_tanh_f(float x) { const float t = 0.7978845608028654f * (x + 0.044715f * x * x * x); const float e = __builtin_amdgcn_exp2f(2.8853900817779268f * t); return x - x * __builtin_amdgcn_rcpf(e + 1.0f); }
struct EpiS5Out {
    static constexpr bool PERM = true, AFTER_DRAIN = false;
    bf16_t* AG;
    __device__ __forceinline__ void operator()(const f32x4 (&acc)[2][2][4][2], const Unit& u, int wr, int wc, int fr, int fq) const {
        const int row0 = u.pm * BM + wr * 64 + fr, col0 = wc * 32 + 8 * fq;
#pragma unroll
        for (int ai = 0; ai < 2; ++ai)
#pragma unroll
            for (int m = 0; m < 4; ++m) { bf16_t* rowp = AG + (size_t)(row0 + ai * HALF + m * 16) * 256 + col0;
#pragma unroll
                for (int bj = 0; bj < 2; ++bj) { f32x4 v0 = acc[ai][bj][m][0], v1 = acc[ai][bj][m][1];
#pragma unroll
                    for (int i = 0; i < 4; ++i) { v0[i] = gelu_tanh_f(v0[i]); v1[i] = gelu_tanh_f(v1[i]); }
                    *(u32x4*)(rowp + bj * HALF) = pack8(v0, v1); } }
    }
};
struct S5Order {
    int G, c;
    __device__ __forceinline__ bool next(int i, Unit& u) const { const int L = i * G + c; if (L >= 32 * 9) return false; u.pm = L; u.pn = L / 9; return true; }
    __device__ __forceinline__ void a_ready(const Unit&) const {}
    __device__ __forceinline__ void done(const Unit&) const {}
};
struct EpiSwiGlu8 {
    static constexpr bool PERM = true, AFTER_DRAIN = false;
    unsigned char* O; int ldc; int nmod; float us, os; int tiled;
    __device__ __forceinline__ void operator()(const f32x4 (&acc)[2][2][4][2], const Unit& u, int wr, int wc, int fr, int fq) const {
        const int row0 = u.pm * BM + wr * 64 + fr; const int ct = nmod ? (u.pn % nmod) : u.pn; const int col0 = ct * HALF + wc * 32 + 8 * fq;
        typedef unsigned u32x2_ __attribute__((ext_vector_type(2))); typedef float f32x2_ __attribute__((ext_vector_type(2)));
        const float kexp = -1.4426950408889634f * us, kout = us * us * os;
#pragma unroll
        for (int ai = 0; ai < 2; ++ai)
#pragma unroll
            for (int m = 0; m < 4; ++m) { f32x4 o0, o1;
#pragma unroll
                for (int i = 0; i < 4; i += 2) {
                    const f32x2_ ga = {acc[ai][0][m][0][i], acc[ai][0][m][0][i + 1]}, gb = {acc[ai][0][m][1][i], acc[ai][0][m][1][i + 1]}, ua = {acc[ai][1][m][0][i], acc[ai][1][m][0][i + 1]}, ub = {acc[ai][1][m][1][i], acc[ai][1][m][1][i + 1]};
                    f32x2_ ta = ga * kexp, tb = gb * kexp; ta.x = __builtin_amdgcn_exp2f(ta.x); ta.y = __builtin_amdgcn_exp2f(ta.y); tb.x = __builtin_amdgcn_exp2f(tb.x); tb.y = __builtin_amdgcn_exp2f(tb.y);
                    ta = ta + 1.0f; tb = tb + 1.0f; ta.x = __builtin_amdgcn_rcpf(ta.x); ta.y = __builtin_amdgcn_rcpf(ta.y); tb.x = __builtin_amdgcn_rcpf(tb.x); tb.y = __builtin_amdgcn_rcpf(tb.y);
                    const f32x2_ ra = (ga * ua) * (ta * kout), rb = (gb * ub) * (tb * kout); o0[i] = ra.x; o0[i + 1] = ra.y; o1[i] = rb.x; o1[i + 1] = rb.y; }
                u32x2_ w; w.x = pk4_fp8(o0[0], o0[1], o0[2], o0[3]); w.y = pk4_fp8(o1[0], o1[1], o1[2], o1[3]);
                const int rr = wr * 64 + fr + ai * HALF + m * 16;
                if (tiled) *(u32x2_*)(O + (size_t)u.pm * BM * ldc + (size_t)ct * (BM * 128) + rr * 128 + wc * 32 + 8 * fq) = w;
                else *(u32x2_*)(O + (size_t)(row0 + ai * HALF + m * 16) * ldc + col0) = w; }
    }
};
struct MoeOrder {
    int t0, nT, nN, G, c; int e1, e2, e3, e4, e5, e6, e7; int rev;
    __device__ __forceinline__ bool next(int i, Unit& u) const {
        const int nwg = nT * nN; const long L = (long)i * G + c; if (L >= nwg) return false;
        int wgid = (int)L; { const int q = nwg / NXCD, r = nwg % NXCD, xcd = wgid % NXCD, off = wgid / NXCD, sz = xcd < r ? q + 1 : q; wgid = (xcd < r ? xcd * (q + 1) : r * (q + 1) + (xcd - r) * q) + (rev ? sz - 1 - off : off); }
        const int nig = WGM * nN, gid = wgid / nig, fm = gid * WGM, gsz = (nT - fm) < WGM ? (nT - fm) : WGM;
        const int pm = t0 + fm + ((wgid % nig) % gsz), pn = (wgid % nig) / gsz;
        const int e = (pm >= e1) + (pm >= e2) + (pm >= e3) + (pm >= e4) + (pm >= e5) + (pm >= e6) + (pm >= e7);
        u.pm = pm; u.pn = e * nN + pn; return true;
    }
    __device__ __forceinline__ void a_ready(const Unit&) const {}
    __device__ __forceinline__ void done(const Unit&) const {}
};
template <class Epi, class Sched, bool ALIGN_EPI = false, bool SP2 = false, bool FP8 = false, bool TILED = false, bool ACHUNK = false, bool AGATHER = false>
__device__ __forceinline__ void gemm_phase(PG8_LAS unsigned char* lds, const Gemm g, const Sched& S, const Epi& E) {
    const int tid = threadIdx.x, wid = __builtin_amdgcn_readfirstlane(tid >> 6), lane = tid & 63, wr = wid >> 2, wc = wid & 3, fr = lane & 15, fq = lane >> 4;
    const int K = g.K, nt = K / BK;
    unsigned voffA[2], voffB[2];
#pragma unroll
    for (int i = 0; i < 2; ++i) { int R, C; stage_rc(tid * 16 + i * 8192, R, C); const int Rb = Epi::PERM ? ((R & ~31) + perm32(R & 31)) : R;
        voffA[i] = TILED ? (unsigned)(R * BK + C) * 2u : (unsigned)(R * K + C) * 2u; voffB[i] = TILED ? (unsigned)(Rb * BK + C) * 2u : (unsigned)(Rb * K + C) * 2u;
        if (ACHUNK) voffA[i] = (unsigned)((R >> 4) * 512 + (R & 15) * 32 + (C & 15) * 2) + (unsigned)(C >> 4) * ACH_GS; }
    const size_t kstep = TILED ? (size_t)(BM * BK * 2) : (size_t)(BK * 2);
    const size_t hstep = TILED ? (size_t)(HALF * BK * 2) : (size_t)HALF * K * 2;
    const size_t tstep = (size_t)BM * K * 2;
    const size_t kstepA = ACHUNK ? (size_t)4 * ACH_GS : kstep, hstepA = ACHUNK ? (size_t)4096 : hstep;
#define PG8_ABASE(pm_) (AGATHER ? (const char*)g.A : ACHUNK ? (const char*)g.A + (size_t)((pm_) < 128 ? ((pm_) >> 3) * 144 + 16 + ((pm_) & 7) * 16 : ((pm_) - 128) * 144) * 512 : (const char*)g.A + (size_t)(pm_) * tstep)
    const unsigned ldsw = (unsigned)wid * 1024u;
    const int aoff = lds_byte(wr * 64 + fr, fq * 8), boff = lds_byte(wc * 32 + fr, fq * 8);
#define PG8_SA(b, h) (((b) * 2 + (h)) * HTB)
#define PG8_SB(b, h) ((4 + (b) * 2 + (h)) * HTB)
#define PG8_STAGE(bufoff, gbase, voff) do { _Pragma("unroll") for (int _i = 0; _i < 2; ++_i) \
        __builtin_amdgcn_global_load_lds((const unsigned*)((const char*)(gbase) + (voff)[_i]), (PG8_LAS unsigned*)(lds + (bufoff) + ldsw + _i * 8192), 16, 0, 0); } while (0)
    static_assert(!AGATHER || SP2, "AGATHER is written for the SP2 loop");
    unsigned gvA0[2] = {0u, 0u}, gvA1[2] = {0u, 0u}, gnA0[2] = {0u, 0u}, gnA1[2] = {0u, 0u};
#define PG8_GLOAD(uidx, v0, v1) do { _Pragma("unroll") for (int i_ = 0; i_ < 2; ++i_) { int R_, C_; stage_rc(tid * 16 + i_ * 8192, R_, C_); \
        const unsigned t0_ = g.atab[(uidx) * 256 + R_], t1_ = g.atab[(uidx) * 256 + 128 + R_]; v0[i_] = t0_ * (unsigned)(2 * K) + (unsigned)C_ * 2u; v1[i_] = t1_ * (unsigned)(2 * K) + (unsigned)C_ * 2u; } } while (0)
#define PG8_STAGE_A(bufoff, gbase, half, nx) do { if constexpr (AGATHER) { unsigned vs_[2]; \
        vs_[0] = (nx) ? ((half) ? gnA1[0] : gnA0[0]) : ((half) ? gvA1[0] : gvA0[0]); vs_[1] = (nx) ? ((half) ? gnA1[1] : gnA0[1]) : ((half) ? gvA1[1] : gvA0[1]); PG8_STAGE(bufoff, gbase, vs_); } \
        else PG8_STAGE(bufoff, (gbase) + ((half) ? hstepA : (size_t)0), voffA); } while (0)
#define PG8_LDA(dst, b, h) do { _Pragma("unroll") for (int m = 0; m < 4; ++m) _Pragma("unroll") for (int k = 0; k < 2; ++k) dst[m][k] = *(const PG8_LAS bf16x8*)(lds + PG8_SA(b, h) + aoff + m * 2048 + k * 1024); } while (0)
#define PG8_LDB(dst, b, h) do { _Pragma("unroll") for (int n = 0; n < 2; ++n) _Pragma("unroll") for (int k = 0; k < 2; ++k) dst[n][k] = *(const PG8_LAS bf16x8*)(lds + PG8_SB(b, h) + boff + n * 2048 + k * 1024); } while (0)
#define PG8_MMA(ai, bj, At, Bt) do { __builtin_amdgcn_s_setprio(1); _Pragma("unroll") for (int m = 0; m < 4; ++m) _Pragma("unroll") for (int n = 0; n < 2; ++n) { \
        if constexpr (FP8) { typedef int i32x4_ __attribute__((ext_vector_type(4))); typedef int i32x8_ __attribute__((ext_vector_type(8))); \
            const i32x8_ bo_ = __builtin_shufflevector(__builtin_bit_cast(i32x4_, Bt[n][0]), __builtin_bit_cast(i32x4_, Bt[n][1]), 0, 1, 2, 3, 4, 5, 6, 7); \
            const i32x8_ ao_ = __builtin_shufflevector(__builtin_bit_cast(i32x4_, At[m][0]), __builtin_bit_cast(i32x4_, At[m][1]), 0, 1, 2, 3, 4, 5, 6, 7); \
            asm volatile("v_mfma_f32_16x16x128_f8f6f4 %0, %1, %2, %0" : "+v"(acc[ai][bj][m][n]) : "v"(bo_), "v"(ao_)); } \
        else { _Pragma("unroll") for (int k = 0; k < 2; ++k) acc[ai][bj][m][n] = __builtin_amdgcn_mfma_f32_16x16x32_bf16(Bt[n][k], At[m][k], acc[ai][bj][m][n], 0, 0, 0); } } \
        __builtin_amdgcn_s_setprio(0); } while (0)
#define PG8_WAIT_V(n) asm volatile("s_waitcnt vmcnt(" #n ")" ::: "memory")
#define PG8_WAIT_L(n) asm volatile("s_waitcnt lgkmcnt(" #n ")" ::: "memory")
#define PG8_BAR __builtin_amdgcn_s_barrier()
#define PG8_SCHED __builtin_amdgcn_sched_barrier(0)
    const int fp8_unit_scale_ = 0x7f7f7f7f; (void)fp8_unit_scale_;
    Unit cur, nxt; int ui = 0;
    if (!S.next(0, cur)) return;
    f32x4 acc[2][2][4][2];
#pragma unroll
    for (int a = 0; a < 2; ++a)
#pragma unroll
        for (int b = 0; b < 2; ++b)
#pragma unroll
            for (int m = 0; m < 4; ++m)
#pragma unroll
                for (int n = 0; n < 2; ++n) acc[a][b][m][n] = (f32x4){0.f, 0.f, 0.f, 0.f};
    bf16x8 At[4][2], B0[2][2], B1[2][2];
    const char* cA = PG8_ABASE(cur.pm); const char* cB = (const char*)g.Bt + (size_t)cur.pn * tstep;
    if constexpr (AGATHER) PG8_GLOAD(0, gvA0, gvA1);
    S.a_ready(cur);
    if constexpr (SP2) {
        PG8_STAGE(PG8_SB(0, 0), cB, voffB); PG8_STAGE(PG8_SB(0, 1), cB + hstep, voffB); PG8_STAGE_A(PG8_SA(0, 0), cA, 0, false); PG8_STAGE_A(PG8_SA(0, 1), cA, 1, false);
        if (wr == 1) PG8_BAR;
        PG8_WAIT_V(2); PG8_BAR;
        PG8_STAGE(PG8_SB(1, 0), cB + kstep, voffB); PG8_STAGE_A(PG8_SA(1, 0), cA + kstepA, 0, false); PG8_STAGE(PG8_SB(1, 1), cB + hstep + kstep, voffB);
        PG8_WAIT_V(6); PG8_BAR;
    } else {
        PG8_STAGE(PG8_SB(0, 0), cB, voffB); PG8_STAGE(PG8_SA(0, 0), cA, voffA); PG8_STAGE(PG8_SB(0, 1), cB + hstep, voffB); PG8_STAGE(PG8_SA(0, 1), cA + hstepA, voffA);
        if (wr == 1) PG8_BAR;
        PG8_WAIT_V(4); PG8_BAR;
        PG8_STAGE(PG8_SB(1, 0), cB + kstep, voffB); PG8_STAGE(PG8_SA(1, 0), cA + kstepA, voffA); PG8_STAGE(PG8_SB(1, 1), cB + hstep + kstep, voffB);
        PG8_WAIT_V(6); PG8_BAR;
    }
    for (;;) {
        const bool has_next = S.next(ui + 1, nxt);
        const char* nA = has_next ? PG8_ABASE(nxt.pm) : cA; const char* nB = has_next ? (const char*)g.Bt + (size_t)nxt.pn * tstep : cB;
        for (int t = 0; t < nt; t += 2) {
            const bool last = (t == nt - 2);
            const char* a1 = cA + (size_t)(t + 1) * kstepA;
            const char* a2 = last ? nA : cA + (size_t)(t + 2) * kstepA; const char* b2 = last ? nB : cB + (size_t)(t + 2) * kstep;
            const char* a3 = a2 + kstepA; const char* b3 = b2 + kstep;
            if (last && has_next) S.a_ready(nxt);
            const bool nx_ = last && has_next;
            if constexpr (AGATHER) { if (nx_) PG8_GLOAD(ui + 1, gnA0, gnA1); }
            if constexpr (SP2) {
            PG8_LDB(B0, 0, 0); PG8_LDB(B1, 0, 1); PG8_SCHED; PG8_LDA(At, 0, 0); PG8_STAGE_A(PG8_SA(1, 1), a1, 1, false);
            PG8_WAIT_V(8); PG8_WAIT_L(0); PG8_BAR; PG8_MMA(0, 0, At, B0); PG8_MMA(0, 1, At, B1); PG8_BAR; PG8_SCHED;
            PG8_LDA(At, 0, 1); PG8_STAGE(PG8_SB(0, 0), b2, voffB); PG8_STAGE(PG8_SB(0, 1), b2 + hstep, voffB); PG8_STAGE_A(PG8_SA(0, 0), a2, 0, nx_);
            PG8_WAIT_V(8); PG8_WAIT_L(0); PG8_BAR; PG8_MMA(1, 0, At, B0); PG8_MMA(1, 1, At, B1); PG8_BAR; PG8_SCHED;
            PG8_LDB(B0, 1, 0); PG8_LDB(B1, 1, 1); PG8_SCHED; PG8_LDA(At, 1, 0); PG8_STAGE_A(PG8_SA(0, 1), a2, 1, nx_);
            PG8_WAIT_V(8); PG8_WAIT_L(0); PG8_BAR; PG8_MMA(0, 0, At, B0); PG8_MMA(0, 1, At, B1); PG8_BAR; PG8_SCHED;
            PG8_LDA(At, 1, 1); PG8_STAGE(PG8_SB(1, 0), b3, voffB); PG8_STAGE(PG8_SB(1, 1), b3 + hstep, voffB); PG8_STAGE_A(PG8_SA(1, 0), a3, 0, nx_);
            PG8_WAIT_V(8); PG8_WAIT_L(0); PG8_BAR; PG8_MMA(1, 0, At, B0); PG8_MMA(1, 1, At, B1); PG8_BAR; PG8_SCHED;
            } else {
            PG8_LDB(B0, 0, 0); PG8_SCHED; PG8_LDA(At, 0, 0); PG8_STAGE(PG8_SA(1, 1), a1 + hstepA, voffA);
            PG8_WAIT_L(8); PG8_BAR; PG8_WAIT_L(0); PG8_MMA(0, 0, At, B0); PG8_BAR; PG8_SCHED;
            PG8_LDB(B1, 0, 1); PG8_STAGE(PG8_SB(0, 0), b2, voffB);
            PG8_BAR; PG8_WAIT_L(0); PG8_MMA(0, 1, At, B1); PG8_BAR;
            PG8_LDA(At, 0, 1); PG8_STAGE(PG8_SA(0, 0), a2, voffA);
            PG8_BAR; PG8_WAIT_L(0); PG8_MMA(1, 0, At, B0); PG8_BAR; PG8_SCHED;
            PG8_STAGE(PG8_SB(0, 1), b2 + hstep, voffB);
            PG8_WAIT_V(6); PG8_BAR; PG8_MMA(1, 1, At, B1); PG8_BAR;
            PG8_LDB(B0, 1, 0); PG8_SCHED; PG8_LDA(At, 1, 0); PG8_STAGE(PG8_SA(0, 1), a2 + hstepA, voffA);
            PG8_WAIT_L(8); PG8_BAR; PG8_WAIT_L(0); PG8_MMA(0, 0, At, B0); PG8_BAR; PG8_SCHED;
            PG8_LDB(B1, 1, 1); PG8_STAGE(PG8_SB(1, 0), b3, voffB);
            PG8_BAR; PG8_WAIT_L(0); PG8_MMA(0, 1, At, B1); PG8_BAR;
            PG8_LDA(At, 1, 1); PG8_STAGE(PG8_SA(1, 0), a3, voffA);
            PG8_BAR; PG8_WAIT_L(0); PG8_MMA(1, 0, At, B0); PG8_BAR; PG8_SCHED;
            PG8_STAGE(PG8_SB(1, 1), b3 + hstep, voffB);
            PG8_WAIT_V(6); PG8_BAR; PG8_MMA(1, 1, At, B1); PG8_BAR;
            }
        }
        if constexpr (ALIGN_EPI) { if (wr == 0) PG8_BAR; }
        if constexpr (FP8) asm volatile("s_nop 15\n\ts_nop 7" ::: "memory");
        if constexpr (!Epi::AFTER_DRAIN) { E(acc, cur, wr, wc, fr, fq); S.done(cur); }
        if (!has_next) break;
#pragma unroll
        for (int a = 0; a < 2; ++a)
#pragma unroll
            for (int b = 0; b < 2; ++b)
#pragma unroll
                for (int m = 0; m < 4; ++m)
#pragma unroll
                    for (int n = 0; n < 2; ++n) acc[a][b][m][n] = (f32x4){0.f, 0.f, 0.f, 0.f};
        cur = nxt; cA = nA; cB = nB; ++ui;
        if constexpr (AGATHER) { gvA0[0] = gnA0[0]; gvA0[1] = gnA0[1]; gvA1[0] = gnA1[0]; gvA1[1] = gnA1[1]; }
        if constexpr (ALIGN_EPI) { if (wr == 1) PG8_BAR; }
    }
    PG8_WAIT_V(0);
    if constexpr (!ALIGN_EPI) { if (wr == 0) PG8_BAR; }
    PG8_BAR;
    if constexpr (Epi::AFTER_DRAIN) { E.fused(acc, cur, wr, wc, fr, fq, lds, wid, lane); S.done(cur); }
#undef PG8_ABASE
#undef PG8_GLOAD
#undef PG8_STAGE_A
#undef PG8_SA
#undef PG8_SB
#undef PG8_STAGE
#undef PG8_LDA
#undef PG8_LDB
#undef PG8_MMA
#undef PG8_WAIT_V
#undef PG8_WAIT_L
#undef PG8_BAR
#undef PG8_SCHED
}
}
#define GAS __attribute__((address_space(1)))
#define LAS __attribute__((address_space(3)))
typedef unsigned short bf16;
typedef unsigned v4u __attribute__((ext_vector_type(4)));
typedef float f32x4 __attribute__((ext_vector_type(4)));
typedef short bf16x8 __attribute__((ext_vector_type(8)));
typedef GAS unsigned gu32;
typedef GAS unsigned long long gu64;
#define RLX_AGENT __ATOMIC_RELAXED, __HIP_MEMORY_SCOPE_AGENT
#define LDS_WAIT() asm volatile("s_waitcnt lgkmcnt(0)" ::: "memory")
#define VM_WAIT() asm volatile("s_waitcnt vmcnt(0)" ::: "memory")
__device__ __forceinline__ unsigned long long rt() { return __builtin_amdgcn_s_memrealtime(); }
__device__ __forceinline__ unsigned f2bf(float f) { unsigned u = __builtin_bit_cast(unsigned, f); return (u + 0x7fffu + ((u >> 16) & 1u)) >> 16; }
__device__ __forceinline__ unsigned pk2(float lo, float hi) { return f2bf(lo) | (f2bf(hi) << 16); }
#define XB_TMO      128
#define XB_XCNT(j)  (256  + 64 * (j))
#define XB_XSUB(j)  (1280 + 64 * (j))
#define XB_XGEN(j)  (2304 + 64 * (j))
#define XB_TOP      3328
#define XB_TOPGEN   3392
#define XCD_BAR_WORDS 3456
#define XB_SPIN_CAP (1u << 18)

__device__ __forceinline__ unsigned xb_ld(unsigned* p)              { return __hip_atomic_load(p, __ATOMIC_RELAXED, __HIP_MEMORY_SCOPE_AGENT); }
__device__ __forceinline__ unsigned xb_add(unsigned* p, unsigned v) { return __hip_atomic_fetch_add(p, v, __ATOMIC_RELAXED, __HIP_MEMORY_SCOPE_AGENT); }
__device__ __forceinline__ unsigned xb_xcc_id() { return (unsigned)__builtin_amdgcn_s_getreg((3 << 11) | 20) & 0xFu; }
#define XB_SPIN(cond, bar) do { unsigned _sp = 0; while (cond) { __builtin_amdgcn_s_sleep(1); \
    if ((++_sp & 255u) == 0u) { if (xb_ld(&(bar)[XB_TMO])) break; if (_sp > XB_SPIN_CAP) { atomicAdd(&(bar)[XB_TMO], 1u); break; } } } } while (0)

struct XcdBarrier {
    unsigned* bar; unsigned x;
    volatile LAS unsigned* st;
};

__device__ __forceinline__ XcdBarrier xcd_barrier_post(unsigned* bar, volatile LAS unsigned* st) {
    XcdBarrier b; b.bar = bar; b.x = xb_xcc_id(); b.st = st;
    if (threadIdx.x == 0) (void)xb_add(&bar[XB_XCNT(b.x)], 1u);
    return b;
}
__device__ __forceinline__ void xcd_barrier_complete(unsigned* bar, unsigned x, unsigned& nloc, unsigned& nx) {
    const unsigned G = gridDim.x * gridDim.y * gridDim.z;
    unsigned sum, cnt, mine, sp = 0u;
    for (;;) {
        sum = 0u; cnt = 0u; mine = 0u;
#pragma unroll
        for (unsigned j = 0; j < 16; ++j) { const unsigned c = xb_ld(&bar[XB_XCNT(j)]); sum += c; cnt += (c > 0u) ? 1u : 0u; mine = (j == x) ? c : mine; }
        if (sum == G) break;
        __builtin_amdgcn_s_sleep(1);
        if ((++sp & 255u) == 0u) { if (xb_ld(&bar[XB_TMO])) break; if (sp > XB_SPIN_CAP) { atomicAdd(&bar[XB_TMO], 1u); break; } }
    }
    nloc = mine > 0u ? mine : 1u; nx = cnt > 0u ? cnt : 1u;
}

__device__ __forceinline__ void xcd_barrier(const XcdBarrier& b) {
    asm volatile("s_waitcnt vmcnt(0)" ::: "memory");
    __syncthreads();
    if (threadIdx.x == 0) {
        unsigned* bar = b.bar;
        __builtin_amdgcn_s_waitcnt(0);
        unsigned nloc = b.st[0], nx = b.st[1];
        if (nloc == 0u) { xcd_barrier_complete(bar, b.x, nloc, nx); b.st[0] = nloc; b.st[1] = nx; }
        const unsigned old = xb_add(&bar[XB_XSUB(b.x)], 1u);
        const unsigned gen = old / nloc;
        if (old + 1u == (gen + 1u) * nloc) {
            __builtin_amdgcn_fence(__ATOMIC_RELEASE, "agent");
            asm volatile("s_waitcnt vmcnt(0)" ::: "memory");
            const unsigned og = xb_add(&bar[XB_TOP], 1u);
            const unsigned tg = og / nx;
            if (og + 1u == (tg + 1u) * nx) xb_add(&bar[XB_TOPGEN], 1u);
            else XB_SPIN(xb_ld(&bar[XB_TOPGEN]) == tg, bar);
            __builtin_amdgcn_fence(__ATOMIC_ACQUIRE, "agent");
            xb_add(&bar[XB_XGEN(b.x)], 1u);
            asm volatile("s_waitcnt vmcnt(0)" ::: "memory");
        } else {
            XB_SPIN(xb_ld(&bar[XB_XGEN(b.x)]) == gen, bar);
            __builtin_amdgcn_fence(__ATOMIC_ACQUIRE, "agent");
            asm volatile("s_waitcnt vmcnt(0)" ::: "memory");
        }
    }
    __syncthreads();
}

namespace att {
typedef short bf16x8 __attribute__((ext_vector_type(8)));
typedef short s16x4 __attribute__((ext_vector_type(4)));
typedef float f32x16 __attribute__((ext_vector_type(16)));
typedef unsigned u32x4 __attribute__((ext_vector_type(4)));
#define ATT_LAS __attribute__((address_space(3)))
constexpr int QBLK = 32, KVBLK = 64, DQ = 96, DV = 64, LDQ = 768, LDKN = 1024, LDKR = 32, LDV = 1024, LDO = 1024;
typedef const __attribute__((address_space(1))) unsigned short* gcp; typedef __attribute__((address_space(1))) unsigned short* gp;
constexpr float SCALE = 0.10206207261596577f, QSC = SCALE * 1.4426950408889634f, THR2 = 8.f * 1.4426950408889634f;
constexpr int SHM_V = KVBLK * DV * 2, SHM_K = KVBLK * 256, NRING = 4, OFF_K = 0, OFF_V = NRING * SHM_K, OFF_WS = NRING * (SHM_V + SHM_K), ATT_LDS = OFF_WS + 8 * 256;
#define KSWZ(row, colB) ((row) * 256 + ((colB) ^ (((row) & 7) << 4)))
#define SBAR() __builtin_amdgcn_sched_barrier(0)
__device__ __forceinline__ int crow(int r, int hi) { return (r & 3) + 8 * (r >> 2) + 4 * hi; }
__device__ __forceinline__ unsigned cvtpk(float lo, float hi) { unsigned r; asm volatile("v_cvt_pk_bf16_f32 %0, %1, %2" : "=v"(r) : "v"(lo), "v"(hi)); return r; }
template <bool FIRST> __device__ __forceinline__ void partialSM(f32x16& p0, f32x16& p1, f32x16& mC, float& alpha) {
  float pmax = p0[0];
#pragma unroll
  for (int r = 1; r < 16; ++r) pmax = fmaxf(pmax, p0[r]);
#pragma unroll
  for (int r = 0; r < 16; ++r) pmax = fmaxf(pmax, p1[r]);
  { auto rr = __builtin_amdgcn_permlane32_swap(__float_as_uint(pmax), __float_as_uint(pmax), false, false);
    pmax = fmaxf(__uint_as_float(rr[0]), __uint_as_float(rr[1])); }
  if (!FIRST && __builtin_expect(__all(pmax <= THR2), 1)) alpha = 1.f;
  else { const float d = FIRST ? pmax : fmaxf(pmax, 0.f); alpha = __builtin_amdgcn_exp2f(-d);
#pragma unroll
    for (int r = 0; r < 16; ++r) { p0[r] -= d; p1[r] -= d; mC[r] -= d; } }
#pragma unroll
  for (int r = 0; r < 16; ++r) p0[r] = __builtin_amdgcn_exp2f(p0[r]);
}
__device__ __forceinline__ void finishSM(f32x16& p0, f32x16& p1, bf16x8& pa0, bf16x8& pa1, bf16x8& pa2, bf16x8& pa3) {
#pragma unroll
  for (int r = 0; r < 16; ++r) p1[r] = __builtin_amdgcn_exp2f(p1[r]);
#define PK4(P, BASE, OUT) do { u32x4 w = {cvtpk(P[BASE + 0], P[BASE + 1]), cvtpk(P[BASE + 2], P[BASE + 3]), cvtpk(P[BASE + 4], P[BASE + 5]), cvtpk(P[BASE + 6], P[BASE + 7])}; OUT = __builtin_bit_cast(bf16x8, w); } while (0)
  PK4(p0, 0, pa0); PK4(p0, 8, pa1); PK4(p1, 0, pa2); PK4(p1, 8, pa3);
#undef PK4
}
__device__ __forceinline__ void qkt(f32x16& p0, f32x16& p1, const f32x16& mC, const ATT_LAS unsigned char* Ks, const bf16x8* qr, int r32, int hi) {
#pragma unroll
  for (int d0 = 0; d0 < DQ / 16; ++d0) { const int cb = (d0 * 16 + hi * 8) * 2;
    const bf16x8 b0 = *(const ATT_LAS bf16x8*)(Ks + KSWZ(r32, cb));
    const bf16x8 b1 = *(const ATT_LAS bf16x8*)(Ks + KSWZ(32 + r32, cb));
    p0 = __builtin_amdgcn_mfma_f32_32x32x16_bf16(b0, qr[d0], d0 ? p0 : mC, 0, 0, 0);
    p1 = __builtin_amdgcn_mfma_f32_32x32x16_bf16(b1, qr[d0], d0 ? p1 : mC, 0, 0, 0); }
}
__device__ __forceinline__ int v_st(int k, int c) { const int kk = k; return ((kk >> 3) * 2 + (c >> 5)) * 512 + ((kk & 7) * 32 + (c & 31)) * 2; }
__device__ __forceinline__ int v_rd_base(int lane) { return ((lane & 3) << 3) | (((lane >> 2) & 3) << 6) | (((lane >> 4) & 1) << 5) | (((lane >> 5) & 1) << 8); }
constexpr int v_rd_off(int d0, int ks, int half) { return d0 * 512 + ks * 2048 + half * 1024; }
struct KPre { bf16x8 a0, b0, a1, b1; };
#define KLDX(KS, D0, A, B) do { A = *(const ATT_LAS bf16x8*)((KS) + KSWZ(r32, ((D0) * 16 + hi * 8) * 2)); B = *(const ATT_LAS bf16x8*)((KS) + KSWZ(32 + r32, ((D0) * 16 + hi * 8) * 2)); } while (0)
#define VLD(D0, KS_, H) __builtin_amdgcn_ds_read_tr16_b64_v4i16((ATT_LAS s16x4*)(vbp + VO + v_rd_off(D0, KS_, H)))
#define PK(L, H) (bf16x8){L[0], L[1], L[2], L[3], H[0], H[1], H[2], H[3]}
#define MFMA(A, B, C) __builtin_amdgcn_mfma_f32_32x32x16_bf16(A, B, C, 0, 0, 0)
template <int VO> __device__ __forceinline__ void region1(f32x16& n0, f32x16& n1, const f32x16& mC, const ATT_LAS unsigned char* Ks, const bf16x8* qr, int r32, int hi, const KPre& kp,
                                                          f32x16& p0, f32x16& p1, bf16x8& pa0, bf16x8& pa1, bf16x8& pa2, bf16x8& pa3, const ATT_LAS unsigned char* vbp, s16x4* vf) {
  bf16x8 kA[DQ / 16], kB[DQ / 16]; unsigned w[16]; kA[0] = kp.a0; kB[0] = kp.b0; kA[1] = kp.a1; kB[1] = kp.b1;
#define KLD(D0) KLDX(Ks, D0, kA[D0], kB[D0])
#define KMM(D0) do { n0 = MFMA(kA[D0], qr[D0], (D0) ? n0 : mC); n1 = MFMA(kB[D0], qr[D0], (D0) ? n1 : mC); } while (0)
#define EXP1(R) p1[R] = __builtin_amdgcn_exp2f(p1[R])
  KLD(2); KMM(0); EXP1(0); EXP1(1); EXP1(2); EXP1(3); EXP1(4); EXP1(5); w[0] = cvtpk(p0[0], p0[1]); w[1] = cvtpk(p0[2], p0[3]); SBAR();
  KLD(3); KMM(1); EXP1(6); EXP1(7); EXP1(8); EXP1(9); EXP1(10); EXP1(11); w[2] = cvtpk(p0[4], p0[5]); w[3] = cvtpk(p0[6], p0[7]); SBAR();
  KLD(4); KMM(2); EXP1(12); EXP1(13); EXP1(14); EXP1(15); w[4] = cvtpk(p0[8], p0[9]); w[5] = cvtpk(p0[10], p0[11]); w[6] = cvtpk(p0[12], p0[13]); w[7] = cvtpk(p0[14], p0[15]); SBAR();
  KLD(5); KMM(3); w[8] = cvtpk(p1[0], p1[1]); w[9] = cvtpk(p1[2], p1[3]); w[10] = cvtpk(p1[4], p1[5]); w[11] = cvtpk(p1[6], p1[7]); SBAR();
#pragma unroll
  for (int ks = 0; ks < 4; ++ks) { vf[2 * ks] = VLD(0, ks, 0); vf[2 * ks + 1] = VLD(0, ks, 1); }
  KMM(4); w[12] = cvtpk(p1[8], p1[9]); w[13] = cvtpk(p1[10], p1[11]); w[14] = cvtpk(p1[12], p1[13]); w[15] = cvtpk(p1[14], p1[15]); SBAR();
  KMM(5);
#undef KLD
#undef KMM
#undef EXP1
  { const u32x4 a = {w[0], w[1], w[2], w[3]}, b = {w[4], w[5], w[6], w[7]}, c = {w[8], w[9], w[10], w[11]}, d = {w[12], w[13], w[14], w[15]};
    pa0 = __builtin_bit_cast(bf16x8, a); pa1 = __builtin_bit_cast(bf16x8, b); pa2 = __builtin_bit_cast(bf16x8, c); pa3 = __builtin_bit_cast(bf16x8, d); }
}
template <int VO> __device__ __forceinline__ void region2(f32x16* o, const s16x4* vf, const ATT_LAS unsigned char* vbp, bf16x8 pa0, bf16x8 pa1, bf16x8 pa2, bf16x8 pa3, bf16x8 ones,
                                                          f32x16& n0, f32x16& n1, f32x16& mC, float& alpha) {
  s16x4 vg[8];
#pragma unroll
  for (int ks = 0; ks < 4; ++ks) { vg[2 * ks] = VLD(1, ks, 0); vg[2 * ks + 1] = VLD(1, ks, 1); }
#define MX3(A, P, R) A = fmaxf(fmaxf(A, P[R]), P[R + 1])
  o[0] = MFMA(pa0, PK(vf[0], vf[1]), o[0]); o[2] = MFMA(pa0, ones, o[2]); SBAR();
  float ma = fmaxf(n0[0], n0[1]), mb = fmaxf(n1[0], n1[1]);
  o[0] = MFMA(pa1, PK(vf[2], vf[3]), o[0]); o[2] = MFMA(pa1, ones, o[2]); MX3(ma, n0, 2); MX3(mb, n1, 2); MX3(ma, n0, 4); MX3(mb, n1, 4); SBAR();
  o[0] = MFMA(pa2, PK(vf[4], vf[5]), o[0]); o[2] = MFMA(pa2, ones, o[2]); MX3(ma, n0, 6); MX3(mb, n1, 6); MX3(ma, n0, 8); MX3(mb, n1, 8); MX3(ma, n0, 10); MX3(mb, n1, 10); SBAR();
  o[0] = MFMA(pa3, PK(vf[6], vf[7]), o[0]); o[2] = MFMA(pa3, ones, o[2]); MX3(ma, n0, 12); MX3(mb, n1, 12); MX3(ma, n0, 14); MX3(mb, n1, 14);
  float pmax = fmaxf(ma, mb);
  { auto rr = __builtin_amdgcn_permlane32_swap(__float_as_uint(pmax), __float_as_uint(pmax), false, false);
    pmax = fmaxf(__uint_as_float(rr[0]), __uint_as_float(rr[1])); }
  if (__builtin_expect(__all(pmax <= THR2), 1)) alpha = 1.f;
  else { const float d = fmaxf(pmax, 0.f); alpha = __builtin_amdgcn_exp2f(-d);
#pragma unroll
    for (int r = 0; r < 16; ++r) { n0[r] -= d; n1[r] -= d; mC[r] -= d; } }
#define EXP4(R) do { float e0 = __builtin_amdgcn_exp2f(n0[R]), e1 = __builtin_amdgcn_exp2f(n0[R + 1]), e2 = __builtin_amdgcn_exp2f(n0[R + 2]), e3 = __builtin_amdgcn_exp2f(n0[R + 3]); \
    asm volatile("" : "+v"(e0), "+v"(e1), "+v"(e2), "+v"(e3)); n0[R] = e0; n0[R + 1] = e1; n0[R + 2] = e2; n0[R + 3] = e3; } while (0)
  SBAR(); o[1] = MFMA(pa0, PK(vg[0], vg[1]), o[1]); EXP4(0); SBAR();
  o[1] = MFMA(pa1, PK(vg[2], vg[3]), o[1]); EXP4(4); SBAR();
  o[1] = MFMA(pa2, PK(vg[4], vg[5]), o[1]); EXP4(8); SBAR();
  o[1] = MFMA(pa3, PK(vg[6], vg[7]), o[1]); EXP4(12);
#undef EXP4
#undef MX3
}
template <int VO> __device__ __forceinline__ void pv_last(f32x16* o, const ATT_LAS unsigned char* vbp, bf16x8 pa0, bf16x8 pa1, bf16x8 pa2, bf16x8 pa3, bf16x8 ones) {
  s16x4 vf[8], vg[8];
#pragma unroll
  for (int ks = 0; ks < 4; ++ks) { vf[2 * ks] = VLD(0, ks, 0); vf[2 * ks + 1] = VLD(0, ks, 1); vg[2 * ks] = VLD(1, ks, 0); vg[2 * ks + 1] = VLD(1, ks, 1); }
  o[0] = MFMA(pa0, PK(vf[0], vf[1]), o[0]); o[1] = MFMA(pa0, PK(vg[0], vg[1]), o[1]); o[2] = MFMA(pa0, ones, o[2]);
  o[0] = MFMA(pa1, PK(vf[2], vf[3]), o[0]); o[1] = MFMA(pa1, PK(vg[2], vg[3]), o[1]); o[2] = MFMA(pa1, ones, o[2]);
  o[0] = MFMA(pa2, PK(vf[4], vf[5]), o[0]); o[1] = MFMA(pa2, PK(vg[4], vg[5]), o[1]); o[2] = MFMA(pa2, ones, o[2]);
  o[0] = MFMA(pa3, PK(vf[6], vf[7]), o[0]); o[1] = MFMA(pa3, PK(vg[6], vg[7]), o[1]); o[2] = MFMA(pa3, ones, o[2]);
}
#undef VLD
#undef PK
#undef MFMA

__device__ __forceinline__ void attn_unit(const unsigned short* Qb_, const unsigned short* Kn_, const unsigned short* Kr_, const unsigned short* Vc_, int ra, int nt_a, int rb, int NT,
                                          unsigned short* Ob_, ATT_LAS unsigned char* lds, int rope_t0) {
  gcp Qb = (gcp)Qb_, Kn = (gcp)Kn_, Kr = (gcp)Kr_, Vc = (gcp)Vc_; gp Ob = (gp)Ob_;
  const int tid = threadIdx.x, wid = tid >> 6, lane = tid & 63, r32 = lane & 31, hi = lane >> 5;
  ATT_LAS unsigned char* V_lds = lds + OFF_V; ATT_LAS unsigned char* K_lds = lds + OFF_K;
  ATT_LAS float* wsp = (ATT_LAS float*)(lds + OFF_WS) + wid * 64; ATT_LAS float* al_l = wsp + 32;
  f32x16 o[3] = {}, mC = {}; bf16x8 qr[DQ / 16]; const u32x4 ones_w = {0x3f803f80u, 0x3f803f80u, 0x3f803f80u, 0x3f803f80u}; const bf16x8 ones = __builtin_bit_cast(bf16x8, ones_w);
  const int sk = tid >> 3, sc = (tid & 7) * 8, rk = (tid & 255) >> 2, rc = (tid & 3) * 8; const bool rw = tid < 256;
  const int vst = v_st(sk, sc), kst0 = KSWZ(sk, sc * 2), kst1 = KSWZ(rk, (64 + rc) * 2);
  struct SR { bf16x8 vs, k0, k1; };
#define TROW(t) ((t) < nt_a ? ra + (t) * KVBLK : rb + ((t) - nt_a) * KVBLK)
#define SLOADX(S, t) do { const long r0_ = TROW(t); S.vs = *(const __attribute__((address_space(1))) bf16x8*)(Vc + (r0_ + sk) * LDV + sc); S.k0 = *(const __attribute__((address_space(1))) bf16x8*)(Kn + (r0_ + sk) * LDKN + sc); \
    S.k1 = *(const __attribute__((address_space(1))) bf16x8*)(Kr + (r0_ + rk) * LDKR + rc); } while (0)
#define SWRITEX(b, S) do { *(ATT_LAS bf16x8*)(V_lds + (b) * SHM_V + vst) = S.vs; *(ATT_LAS bf16x8*)(K_lds + (b) * SHM_K + kst0) = S.k0; \
    if (rw) *(ATT_LAS bf16x8*)(K_lds + (b) * SHM_K + kst1) = S.k1; } while (0)
  SR s0_, s1_, sr_; SLOADX(s0_, 0); SLOADX(s1_, 1); SLOADX(sr_, 2);
  gcp Qw = Qb + (long)(wid * QBLK + r32) * LDQ + hi * 8;
#pragma unroll
  for (int d0 = 0; d0 < DQ / 16; ++d0) qr[d0] = *(const __attribute__((address_space(1))) bf16x8*)(Qw + d0 * 16);
  if (rope_t0 >= 0) {
    int t = rope_t0 + wid * QBLK + r32; asm volatile("" : "+v"(t));
    const float prow = (float)(t >> 6), pcol = (float)(t & 63);
#pragma unroll
    for (int f = 0; f < 2; ++f) { const u32x4 own = __builtin_bit_cast(u32x4, qr[4 + f]); u32x4 oth;
      oth.x = (unsigned)__shfl_xor((int)own.x, 32); oth.y = (unsigned)__shfl_xor((int)own.y, 32); oth.z = (unsigned)__shfl_xor((int)own.z, 32); oth.w = (unsigned)__shfl_xor((int)own.w, 32);
      const float pos = f ? pcol : prow; float o8[8];
#pragma unroll
      for (int j = 0; j < 8; ++j) { const unsigned wo = (j < 2) ? own.x : (j < 4) ? own.y : (j < 6) ? own.z : own.w, wp = (j < 2) ? oth.x : (j < 4) ? oth.y : (j < 6) ? oth.z : oth.w;
        const float a = (j & 1) ? __uint_as_float(wo & 0xffff0000u) : __uint_as_float(wo << 16), bq = (j & 1) ? __uint_as_float(wp & 0xffff0000u) : __uint_as_float(wp << 16);
        const float ang = pos * __builtin_amdgcn_exp2f(-(float)j * (13.287712379549449f / 8.0f)); float sn, cs; __sincosf(ang, &sn, &cs);
        o8[j] = hi ? (a * cs + bq * sn) : (a * cs - bq * sn); }
      u32x4 w = {cvtpk(o8[0], o8[1]), cvtpk(o8[2], o8[3]), cvtpk(o8[4], o8[5]), cvtpk(o8[6], o8[7])}; qr[4 + f] = __builtin_bit_cast(bf16x8, w); } }
#pragma unroll
  for (int d0 = 0; d0 < DQ / 16; ++d0) { const u32x4 w = __builtin_bit_cast(u32x4, qr[d0]); u32x4 q;
#pragma unroll
    for (int i = 0; i < 4; ++i) q[i] = cvtpk(__uint_as_float(w[i] << 16) * QSC, __uint_as_float(w[i] & 0xffff0000u) * QSC);
    qr[d0] = __builtin_bit_cast(bf16x8, q); }
#define SLOAD(t) SLOADX(sr_, t)
#define SWRITE(b) SWRITEX(b, sr_)
#define SWAIT() asm volatile("s_waitcnt vmcnt(0)" ::: "memory")
#define BAR() asm volatile("s_barrier" ::: "memory")
#define RESC(a) do { if (__any((a) < 1.f)) { if (hi == 0) al_l[r32] = (a); asm volatile("s_waitcnt lgkmcnt(0)" ::: "memory"); \
    _Pragma("unroll") for (int d = 0; d < 3; ++d) _Pragma("unroll") for (int r = 0; r < 16; ++r) o[d][r] *= al_l[crow(r, hi)]; } } while (0)
#define KPRE(KB) do { KLDX(K_lds + (KB) * SHM_K, 0, kp.a0, kp.b0); KLDX(K_lds + (KB) * SHM_K, 1, kp.a1, kp.b1); } while (0)
  f32x16 pA0, pA1, pB0, pB1; float alA, alB; bf16x8 pa0, pa1, pa2, pa3; KPre kp; s16x4 vf[8];
  const ATT_LAS unsigned char* vbp = V_lds + v_rd_base(lane);
  SWAIT(); SWRITEX(0, s0_); SWRITEX(1, s1_); SWRITE(2); SLOAD(3); __syncthreads();
  qkt(pA0, pA1, mC, K_lds, qr, r32, hi); partialSM<true>(pA0, pA1, mC, alA);
  KPRE(1); BAR();
#define STEP(PN0, PN1, ALN, PO0, PO1, KB, VB, T, WR, LD, NX) do { \
    SBAR(); if (WR) { SWAIT(); SWRITE(((KB) + 2) & 3); } if (LD) SLOAD((T) + 3); SBAR(); \
    region1<(VB) * SHM_V>(PN0, PN1, mC, K_lds + (KB) * SHM_K, qr, r32, hi, kp, PO0, PO1, pa0, pa1, pa2, pa3, vbp, vf); SBAR(); \
    region2<(VB) * SHM_V>(o, vf, vbp, pa0, pa1, pa2, pa3, ones, PN0, PN1, mC, ALN); SBAR(); \
    if (NX) KPRE(((KB) + 1) & 3); RESC(ALN); BAR(); } while (0)
  int j = 1;
  for (; j + 3 < NT; j += 4) {
    STEP(pB0, pB1, alB, pA0, pA1, 1, 0, j, true, true, true);
    STEP(pA0, pA1, alA, pB0, pB1, 2, 1, j + 1, true, true, true);
    STEP(pB0, pB1, alB, pA0, pA1, 3, 2, j + 2, true, true, true);
    STEP(pA0, pA1, alA, pB0, pB1, 0, 3, j + 3, true, true, true);
  }
  STEP(pB0, pB1, alB, pA0, pA1, 1, 0, j, true, false, true);
  STEP(pA0, pA1, alA, pB0, pB1, 2, 1, j + 1, false, false, true);
  STEP(pB0, pB1, alB, pA0, pA1, 3, 2, j + 2, false, false, false);
  finishSM(pB0, pB1, pa0, pa1, pa2, pa3); SBAR();
  pv_last<3 * SHM_V>(o, vbp, pa0, pa1, pa2, pa3, ones);
  float rli[16];
#pragma unroll
  for (int r = 0; r < 16; ++r) rli[r] = __builtin_amdgcn_rcpf(o[2][r]);
  gp Ow = Ob + (long)(wid * QBLK) * LDO;
#pragma unroll
  for (int r = 0; r < 16; ++r) { const int orow = crow(r, hi);
#pragma unroll
    for (int d0 = 0; d0 < 2; ++d0) Ow[(long)orow * LDO + d0 * 32 + r32] = (unsigned short)(cvtpk(o[d0][r] * rli[r], 0.f) & 0xffffu); }
  asm volatile("s_waitcnt vmcnt(0)" ::: "memory");
  __syncthreads();
#undef TROW
#undef SLOAD
#undef SWRITE
#undef SLOADX
#undef SWRITEX
#undef STEP
#undef BAR
#undef KPRE
#undef SWAIT
#undef RESC
}
#undef KLDX
#undef KSWZ
#undef SBAR
}

namespace gla {
typedef short bf16x8 __attribute__((ext_vector_type(8)));
typedef short s16x4 __attribute__((ext_vector_type(4)));
typedef float f32x16 __attribute__((ext_vector_type(16)));
typedef float f32x4 __attribute__((ext_vector_type(4)));
typedef float f32x2 __attribute__((ext_vector_type(2)));
typedef __bf16 bf16x2_t __attribute__((ext_vector_type(2)));
typedef unsigned u32x4 __attribute__((ext_vector_type(4)));
typedef unsigned u32x2 __attribute__((ext_vector_type(2)));
#define GLA_LAS __attribute__((address_space(3)))
#define GLA_GAS __attribute__((address_space(1)))
constexpr int RS256 = 272, RS128 = 144;
constexpr int OFF_QT = 0, OFF_KT = 64 * RS256, OFF_KH = 2 * 64 * RS256, OFF_V = OFF_KH + 128 * RS128, OFF_P = OFF_V + 32768, OFF_TOT = OFF_P + 64 * RS128, OFF_EL = OFF_TOT + 2048, OFF_ZG = OFF_EL + 512, OFF_W2 = OFF_ZG + 4096, GLA_LDS = OFF_W2 + 8192;
static_assert(GLA_LDS <= 131072 && OFF_V % 16 == 0 && OFF_P % 16 == 0 && OFF_TOT % 16 == 0, "gla lds map");
__device__ __forceinline__ int swz256(int row, int colB) { return row * RS256 + colB; }
__device__ __forceinline__ int swz128(int row, int colB) { return row * RS128 + colB; }
__device__ __forceinline__ int crow(int r, int hi) { return (r & 3) + 8 * (r >> 2) + 4 * hi; }
__device__ __forceinline__ unsigned pk2f(float lo, float hi) { const f32x2 v = {lo, hi}; return __builtin_bit_cast(unsigned, __builtin_convertvector(v, bf16x2_t)); }
__device__ __forceinline__ unsigned short bf1f(float x) { return (unsigned short)(pk2f(x, 0.f) & 0xffffu); }
__device__ __forceinline__ float bfu(unsigned short u) { return __uint_as_float(((unsigned)u) << 16); }
__device__ __forceinline__ int v_st(int k, int c) { const int kk = (k & ~0xC) | ((k & 4) << 1) | ((k & 8) >> 1); return ((kk >> 3) * 8 + (c >> 5)) * 512 + ((kk & 7) * 32 + (c & 31)) * 2; }
__device__ __forceinline__ int v_rd_base(int lane) { return ((lane & 3) << 3) | (((lane >> 2) & 3) << 6) | (((lane >> 4) & 1) << 5) | (((lane >> 5) & 1) << 8); }
template <int OFF> __device__ __forceinline__ s16x4 tr_read(int vb) { s16x4 r; asm volatile("ds_read_b64_tr_b16 %0, %1 offset:%2" : "=&v"(r) : "v"(vb), "i"(OFF) : "memory"); return r; }
#define GLA_MFMA(a, b, c) __builtin_amdgcn_mfma_f32_32x32x16_bf16((a), (b), (c), 0, 0, 0)
__device__ __forceinline__ bf16x8 pack_step(const f32x16& x, int s) {
    u32x4 p; p.x = pk2f(x[8 * s], x[8 * s + 1]); p.y = pk2f(x[8 * s + 2], x[8 * s + 3]); p.z = pk2f(x[8 * s + 4], x[8 * s + 5]); p.w = pk2f(x[8 * s + 6], x[8 * s + 7]); return __builtin_bit_cast(bf16x8, p);
}
__device__ __forceinline__ void gla_prep(const unsigned short* QK_, const unsigned short* ZG_, const float* w2_, const float* b2_, unsigned short* TQ_, unsigned short* TK_, unsigned short* TP_, float* EL_,
                                         int b, int h, int dir, int c_lo, int c_hi, int ML_, int SEQ_, int CTX_, GLA_LAS unsigned char* lds) {
    const GLA_GAS unsigned short* QK = (const GLA_GAS unsigned short*)QK_; const GLA_GAS unsigned short* ZG = (const GLA_GAS unsigned short*)ZG_;
    const GLA_GAS float* w2g = (const GLA_GAS float*)w2_; const GLA_GAS float* b2g = (const GLA_GAS float*)b2_;
    const int tid = threadIdx.x, wid = __builtin_amdgcn_readfirstlane(tid >> 6), lane = tid & 63, r32 = lane & 31, hi = lane >> 5;
    const int seg = tid >> 7, kk = tid & 127;
    GLA_LAS unsigned char* QT = lds + OFF_QT; GLA_LAS unsigned char* KT = lds + OFF_KT;
    GLA_LAS float* TOT = (GLA_LAS float*)(lds + OFF_TOT); GLA_LAS float* ZGS = (GLA_LAS float*)(lds + OFF_ZG); GLA_LAS float* W2S = (GLA_LAS float*)(lds + OFF_W2);
    __syncthreads();
#pragma unroll
    for (int i = 0; i < 4; ++i) { const int idx = tid + 512 * i; W2S[idx] = w2g[(size_t)(dir * 16 + (idx >> 7)) * 512 + h * 128 + (idx & 127)]; }
    const float b2 = b2g[dir * 512 + h * 128 + kk];
    const int nctx = CTX_ / 64;
    GLA_LAS unsigned* RAW = (GLA_LAS unsigned*)(lds + OFF_V);
    u32x4 sq0, sq1, sk0, sk1; unsigned zgw;
#define GLA_PLOAD(cs_) do { const long r0_ = ((cs_) < nctx) ? (long)ML_ + (long)b * CTX_ + 64 * (cs_) : (long)b * SEQ_ + 64 * ((cs_) - nctx); \
        zgw = *(const GLA_GAS unsigned*)(ZG + (r0_ + (tid >> 3)) * 2304 + dir * 16 + (tid & 7) * 2); \
        const GLA_GAS unsigned short* zr_ = QK + (r0_ + (tid >> 3)) * 1024 + h * 128 + 16 * (tid & 7); \
        sq0 = *(const GLA_GAS u32x4*)(zr_); sq1 = *(const GLA_GAS u32x4*)(zr_ + 8); sk0 = *(const GLA_GAS u32x4*)(zr_ + 512); sk1 = *(const GLA_GAS u32x4*)(zr_ + 520); } while (0)
    GLA_PLOAD(c_lo);
    for (int cs = c_lo; cs < c_hi; ++cs) {
        { u32x4 w0, w1, w2, w3;
#define GLA_IL(W, QW, KW, J) W[2 * (J)] = __builtin_amdgcn_perm(KW[J], QW[J], 0x05040100u); W[2 * (J) + 1] = __builtin_amdgcn_perm(KW[J], QW[J], 0x07060302u)
          { unsigned t_[8];
#define GLA_IL4(QW, KW) do { _Pragma("unroll") for (int j_ = 0; j_ < 4; ++j_) { t_[2 * j_] = __builtin_amdgcn_perm(KW[j_], QW[j_], 0x05040100u); t_[2 * j_ + 1] = __builtin_amdgcn_perm(KW[j_], QW[j_], 0x07060302u); } } while (0)
            GLA_IL4(sq0, sk0); w0 = u32x4{t_[0], t_[1], t_[2], t_[3]}; w1 = u32x4{t_[4], t_[5], t_[6], t_[7]};
            GLA_IL4(sq1, sk1); w2 = u32x4{t_[0], t_[1], t_[2], t_[3]}; w3 = u32x4{t_[4], t_[5], t_[6], t_[7]}; }
#undef GLA_IL4
#undef GLA_IL
          GLA_LAS u32x4* dst = (GLA_LAS u32x4*)(RAW + (tid >> 3) * 128 + 16 * (tid & 7)); dst[0] = w0; dst[1] = w1; dst[2] = w2; dst[3] = w3; }
        const size_t tile = (size_t)((b * 4 + h) * 2 + dir) * 36 + cs;
        GLA_GAS unsigned short* TQ = (GLA_GAS unsigned short*)TQ_ + tile * 8192; GLA_GAS unsigned short* TK = (GLA_GAS unsigned short*)TK_ + tile * 8192; GLA_GAS unsigned short* TP = (GLA_GAS unsigned short*)TP_ + tile * 4096;
        { const int l = tid >> 3, r2 = (tid & 7) * 2; ZGS[l * 16 + r2] = __uint_as_float(zgw << 16); ZGS[l * 16 + r2 + 1] = __uint_as_float(zgw & 0xffff0000u); }
        if (cs + 1 < c_hi) GLA_PLOAD(cs + 1);
        __syncthreads();
        unsigned raw[16];
#pragma unroll
        for (int i = 0; i < 16; ++i) raw[i] = RAW[(16 * seg + i) * 128 + kk];
        float cum[16];
#pragma unroll
        for (int i = 0; i < 16; ++i) cum[i] = b2;
#pragma unroll
        for (int q = 0; q < 4; ++q) { const float wa = W2S[(4 * q) * 128 + kk], wb = W2S[(4 * q + 1) * 128 + kk], wc_ = W2S[(4 * q + 2) * 128 + kk], wd = W2S[(4 * q + 3) * 128 + kk];
#pragma unroll
            for (int i = 0; i < 16; ++i) { const f32x4 z = *(const GLA_LAS f32x4*)(ZGS + (16 * seg + i) * 16 + 4 * q); cum[i] += z.x * wa + z.y * wb + z.z * wc_ + z.w * wd; } }
#pragma unroll
        for (int i = 0; i < 16; ++i) { const float x = cum[i]; cum[i] = (fminf(x, 0.f) - __logf(1.0f + __expf(-fabsf(x)))) * (1.0f / 16.0f); }
        if (dir == 0) {
#pragma unroll
            for (int i = 1; i < 16; ++i) cum[i] += cum[i - 1];
            TOT[seg * 128 + kk] = cum[15];
        } else {
#pragma unroll
            for (int i = 14; i >= 0; --i) cum[i] += cum[i + 1];
            TOT[seg * 128 + kk] = cum[0];
        }
        __syncthreads();
        { const float t0 = TOT[kk], t1 = TOT[128 + kk], t2 = TOT[256 + kk], t3 = TOT[384 + kk]; const float last = (t0 + t1) + (t2 + t3);
          float off;
          if (dir == 0) off = (seg > 0 ? t0 : 0.f) + (seg > 1 ? t1 : 0.f) + (seg > 2 ? t2 : 0.f);
          else off = (seg < 3 ? t3 : 0.f) + (seg < 2 ? t2 : 0.f) + (seg < 1 ? t1 : 0.f);
          if (seg == 0) ((GLA_GAS float*)EL_)[tile * 128 + kk] = __expf(last);
          unsigned ktp[8];
#pragma unroll
          for (int i = 0; i < 16; i += 2) {
              const float c0 = cum[i] + off, c1 = cum[i + 1] + off; const int l0 = 16 * seg + i, l1 = l0 + 1;
              const float q0 = __uint_as_float(raw[i] << 16), k0v = __uint_as_float(raw[i] & 0xffff0000u), q1 = __uint_as_float(raw[i + 1] << 16), k1v = __uint_as_float(raw[i + 1] & 0xffff0000u);
              const unsigned short qa = bf1f(q0 * __expf(c0)), qb = bf1f(q1 * __expf(c1)); const float ka = k0v * __expf(-c0), kb = k1v * __expf(-c1); const unsigned kp = pk2f(ka, kb);
              *(GLA_LAS unsigned short*)(QT + swz256(l0, 2 * kk)) = qa; *(GLA_LAS unsigned short*)(QT + swz256(l1, 2 * kk)) = qb;
              *(GLA_LAS unsigned short*)(KT + swz256(l0, 2 * kk)) = (unsigned short)(kp & 0xffffu); *(GLA_LAS unsigned short*)(KT + swz256(l1, 2 * kk)) = (unsigned short)(kp >> 16);
              TQ[l0 * 128 + kk] = qa; TQ[l1 * 128 + kk] = qb; ktp[i >> 1] = kp; }
          u32x4 k0 = {ktp[0], ktp[1], ktp[2], ktp[3]}, k1 = {ktp[4], ktp[5], ktp[6], ktp[7]};
          *(GLA_GAS u32x4*)(TK + kk * 64 + 16 * seg) = k0; *(GLA_GAS u32x4*)(TK + kk * 64 + 16 * seg + 8) = k1; }
        __syncthreads();
        if (wid < 4) { const int mi = wid >> 1, li = wid & 1; f32x16 x = f32x16{};
#pragma unroll
            for (int s2 = 0; s2 < 8; ++s2) { const int cb = (16 * s2 + 8 * hi) * 2;
                const bf16x8 a = *(const GLA_LAS bf16x8*)(KT + swz256(32 * mi + r32, cb)); const bf16x8 bq = *(const GLA_LAS bf16x8*)(QT + swz256(32 * li + r32, cb)); x = GLA_MFMA(a, bq, x); }
            const int l = 32 * li + r32;
#pragma unroll
            for (int g = 0; g < 4; ++g) { float v[4];
#pragma unroll
                for (int j = 0; j < 4; ++j) { const int m = 32 * mi + 8 * g + 4 * hi + j; const bool keep = (dir == 0) ? (m <= l) : (m >= l); v[j] = keep ? x[4 * g + j] : 0.f; }
                u32x2 w; w.x = pk2f(v[0], v[1]); w.y = pk2f(v[2], v[3]); *(GLA_GAS u32x2*)(TP + l * 64 + 32 * mi + 8 * g + 4 * hi) = w; } }
    }
#undef GLA_PLOAD
    __syncthreads();
}
__device__ __forceinline__ void gla_chain(const unsigned short* VR_, const unsigned short* TQ_, const unsigned short* TK_, const unsigned short* TP_, const float* EL_, unsigned short* O_, int b, int h, int dir,
                                          int ML_, int SEQ_, int CTX_, GLA_LAS unsigned char* lds) {
    const GLA_GAS unsigned short* VR = (const GLA_GAS unsigned short*)VR_; GLA_GAS unsigned short* O = (GLA_GAS unsigned short*)O_;
    const int tid = threadIdx.x, wid = __builtin_amdgcn_readfirstlane(tid >> 6), lane = tid & 63, r32 = lane & 31, hi = lane >> 5;
    GLA_LAS unsigned char* QT = lds + OFF_QT; GLA_LAS unsigned char* KH = lds + OFF_KH; GLA_LAS unsigned char* VI = lds + OFF_V; GLA_LAS unsigned char* PI = lds + OFF_P; GLA_LAS float* EL = (GLA_LAS float*)(lds + OFF_EL);
    f32x16 S[4];
#pragma unroll
    for (int t = 0; t < 4; ++t) S[t] = f32x16{};
    const int vb = (int)(unsigned)(uintptr_t)VI + v_rd_base(lane) + wid * 512;
    const int nchunk = (CTX_ + SEQ_) / 64, nctx = CTX_ / 64;
    const size_t tile0 = (size_t)((b * 4 + h) * 2 + dir) * 36;
    u32x4 pq[2], pk[2], pp, pv[4]; float pe = 0.f;
#define GLA_CS(sc_) ((dir == 0) ? (sc_) : (((sc_) < nctx) ? (nctx - 1 - (sc_)) : (nchunk - 1 - ((sc_) - nctx))))
#define GLA_FETCH(sc_) do { const int cs_ = GLA_CS(sc_); const size_t t_ = tile0 + cs_; const long r0_ = (cs_ < nctx) ? (long)ML_ + (long)b * CTX_ + 64 * cs_ : (long)b * SEQ_ + 64 * (cs_ - nctx); \
        const GLA_GAS u32x4* q_ = (const GLA_GAS u32x4*)((const GLA_GAS unsigned short*)TQ_ + t_ * 8192); const GLA_GAS u32x4* k_ = (const GLA_GAS u32x4*)((const GLA_GAS unsigned short*)TK_ + t_ * 8192); \
        pq[0] = q_[tid]; pq[1] = q_[tid + 512]; pk[0] = k_[tid]; pk[1] = k_[tid + 512]; pp = ((const GLA_GAS u32x4*)((const GLA_GAS unsigned short*)TP_ + t_ * 4096))[tid]; \
        if (tid < 128) pe = ((const GLA_GAS float*)EL_)[t_ * 128 + tid]; \
        _Pragma("unroll") for (int i_ = 0; i_ < 4; ++i_) { const int c_ = tid + 512 * i_; pv[i_] = *(const GLA_GAS u32x4*)(VR + (r0_ + (c_ >> 5)) * 2304 + h * 256 + (c_ & 31) * 8); } } while (0)
    GLA_FETCH(0);
    for (int sc = 0; sc < nchunk; ++sc) {
        const int cs = GLA_CS(sc); const bool is_lat = cs >= nctx; const long row0 = is_lat ? (long)b * SEQ_ + 64 * (cs - nctx) : (long)ML_ + (long)b * CTX_ + 64 * cs;
#pragma unroll
        for (int i = 0; i < 2; ++i) { const int c = tid + 512 * i; *(GLA_LAS u32x4*)(QT + (c >> 4) * RS256 + (c & 15) * 16) = pq[i]; *(GLA_LAS u32x4*)(KH + (c >> 3) * RS128 + (c & 7) * 16) = pk[i]; }
        *(GLA_LAS u32x4*)(PI + (tid >> 3) * RS128 + (tid & 7) * 16) = pp;
        if (tid < 128) EL[tid] = pe;
#pragma unroll
        for (int i = 0; i < 4; ++i) { const int c = tid + 512 * i; *(GLA_LAS u32x4*)(VI + v_st(c >> 5, (c & 31) * 8)) = pv[i]; }
        __syncthreads();
        if (sc + 1 < nchunk) GLA_FETCH(sc + 1);
        f32x16 o[2] = {f32x16{}, f32x16{}};
#pragma unroll
        for (int kt = 0; kt < 4; ++kt)
#pragma unroll
            for (int s2 = 0; s2 < 2; ++s2) { const bf16x8 bs = pack_step(S[kt], s2); const int cb0 = (32 * kt + 16 * s2 + 4 * hi) * 2;
#pragma unroll
                for (int rb = 0; rb < 2; ++rb) { const int l = 32 * rb + r32;
                    const s16x4 a0 = *(const GLA_LAS s16x4*)(QT + swz256(l, cb0)), a1 = *(const GLA_LAS s16x4*)(QT + swz256(l, cb0 + 16));
                    const bf16x8 a = {a0[0], a0[1], a0[2], a0[3], a1[0], a1[1], a1[2], a1[3]}; o[rb] = GLA_MFMA(a, bs, o[rb]); } }
        bf16x8 vf[4];
        { const s16x4 l0 = tr_read<0 * 8192>(vb), h0 = tr_read<0 * 8192 + 4096>(vb), l1 = tr_read<1 * 8192>(vb), h1 = tr_read<1 * 8192 + 4096>(vb);
          const s16x4 l2 = tr_read<2 * 8192>(vb), h2 = tr_read<2 * 8192 + 4096>(vb), l3 = tr_read<3 * 8192>(vb), h3 = tr_read<3 * 8192 + 4096>(vb);
          asm volatile("s_waitcnt lgkmcnt(0)" ::: "memory"); __builtin_amdgcn_sched_barrier(0);
          vf[0] = (bf16x8){l0[0], l0[1], l0[2], l0[3], h0[0], h0[1], h0[2], h0[3]}; vf[1] = (bf16x8){l1[0], l1[1], l1[2], l1[3], h1[0], h1[1], h1[2], h1[3]};
          vf[2] = (bf16x8){l2[0], l2[1], l2[2], l2[3], h2[0], h2[1], h2[2], h2[3]}; vf[3] = (bf16x8){l3[0], l3[1], l3[2], l3[3], h3[0], h3[1], h3[2], h3[3]}; }
#pragma unroll
        for (int rb = 0; rb < 2; ++rb)
#pragma unroll
            for (int ks = 0; ks < 4; ++ks) { const bf16x8 a = *(const GLA_LAS bf16x8*)(PI + swz128(32 * rb + r32, (16 * ks + 8 * hi) * 2)); o[rb] = GLA_MFMA(a, vf[ks], o[rb]); }
        if (is_lat) {
#pragma unroll
            for (int rb = 0; rb < 2; ++rb)
#pragma unroll
                for (int r = 0; r < 16; ++r) O[(row0 + 32 * rb + crow(r, hi)) * 1024 + h * 256 + 32 * wid + r32] = bf1f(o[rb][r]); }
#pragma unroll
        for (int kt = 0; kt < 4; ++kt) {
#pragma unroll
            for (int ks = 0; ks < 4; ++ks) { const bf16x8 a = *(const GLA_LAS bf16x8*)(KH + swz128(32 * kt + r32, (16 * ks + 8 * hi) * 2)); S[kt] = GLA_MFMA(a, vf[ks], S[kt]); }
#pragma unroll
            for (int r = 0; r < 16; ++r) S[kt][r] *= EL[32 * kt + crow(r, hi)]; }
        __syncthreads();
    }
#undef GLA_FETCH
#undef GLA_CS
}
__device__ __forceinline__ int v_st4(int k, int c) { const int kk = (k & ~0xC) | ((k & 4) << 1) | ((k & 8) >> 1); return ((kk >> 3) * 4 + (c >> 5)) * 512 + ((kk & 7) * 32 + (c & 31)) * 2; }
constexpr int OFF_XO_A = OFF_KT, OFF_XO_B = OFF_V + 16384;
static_assert(OFF_XO_A + 16384 <= OFF_KH && OFF_XO_B + 16384 <= OFF_P, "gla chain2 lds map");
__device__ __forceinline__ void gla_chain2(const unsigned short* VR_, const unsigned short* TQ_, const unsigned short* TK_, const unsigned short* TP_, const float* EL_, unsigned short* O_, int b, int h, int dir, int vh,
                                           int ML_, int SEQ_, int CTX_, GLA_LAS unsigned char* lds) {
    const GLA_GAS unsigned short* VR = (const GLA_GAS unsigned short*)VR_; GLA_GAS unsigned short* O = (GLA_GAS unsigned short*)O_;
    const int tid = threadIdx.x, wid = __builtin_amdgcn_readfirstlane(tid >> 6), lane = tid & 63, r32 = lane & 31, hi = lane >> 5;
    const int vt = wid & 3, kh = wid >> 2;
    GLA_LAS unsigned char* QT = lds + OFF_QT; GLA_LAS unsigned char* KH = lds + OFF_KH; GLA_LAS unsigned char* VI = lds + OFF_V; GLA_LAS unsigned char* PI = lds + OFF_P; GLA_LAS float* EL = (GLA_LAS float*)(lds + OFF_EL);
    GLA_LAS f32x4* XOs = (GLA_LAS f32x4*)(lds + (wid < 4 ? OFF_XO_A + wid * 4096 : OFF_XO_B + (wid - 4) * 4096));
    GLA_LAS f32x4* XOr = (GLA_LAS f32x4*)(lds + ((wid ^ 4) < 4 ? OFF_XO_A + (wid ^ 4) * 4096 : OFF_XO_B + ((wid ^ 4) - 4) * 4096));
    f32x16 S[2] = {f32x16{}, f32x16{}};
    const int vb = (int)(unsigned)(uintptr_t)VI + v_rd_base(lane) + vt * 512;
    const int nchunk = (CTX_ + SEQ_) / 64, nctx = CTX_ / 64;
    const size_t tile0 = (size_t)((b * 4 + h) * 2 + dir) * 36;
    u32x4 pq[2], pk[2], pp, pv[2]; float pe = 0.f;
#define GLA_CS(sc_) ((dir == 0) ? (sc_) : (((sc_) < nctx) ? (nctx - 1 - (sc_)) : (nchunk - 1 - ((sc_) - nctx))))
#define GLA_FETCH(sc_) do { const int cs_ = GLA_CS(sc_); const size_t t_ = tile0 + cs_; const long r0_ = (cs_ < nctx) ? (long)ML_ + (long)b * CTX_ + 64 * cs_ : (long)b * SEQ_ + 64 * (cs_ - nctx); \
        const GLA_GAS u32x4* q_ = (const GLA_GAS u32x4*)((const GLA_GAS unsigned short*)TQ_ + t_ * 8192); const GLA_GAS u32x4* k_ = (const GLA_GAS u32x4*)((const GLA_GAS unsigned short*)TK_ + t_ * 8192); \
        pq[0] = q_[tid]; pq[1] = q_[tid + 512]; pk[0] = k_[tid]; pk[1] = k_[tid + 512]; pp = ((const GLA_GAS u32x4*)((const GLA_GAS unsigned short*)TP_ + t_ * 4096))[tid]; \
        if (tid < 128) pe = ((const GLA_GAS float*)EL_)[t_ * 128 + tid]; \
        _Pragma("unroll") for (int i_ = 0; i_ < 2; ++i_) { const int c_ = tid + 512 * i_; pv[i_] = *(const GLA_GAS u32x4*)(VR + (r0_ + (c_ >> 4)) * 2304 + h * 256 + vh * 128 + (c_ & 15) * 8); } } while (0)
    GLA_FETCH(0);
    for (int sc = 0; sc < nchunk; ++sc) {
        const int cs = GLA_CS(sc); const bool is_lat = cs >= nctx; const long row0 = is_lat ? (long)b * SEQ_ + 64 * (cs - nctx) : (long)ML_ + (long)b * CTX_ + 64 * cs;
#pragma unroll
        for (int i = 0; i < 2; ++i) { const int c = tid + 512 * i; *(GLA_LAS u32x4*)(QT + (c >> 4) * RS256 + (c & 15) * 16) = pq[i]; *(GLA_LAS u32x4*)(KH + (c >> 3) * RS128 + (c & 7) * 16) = pk[i];
            *(GLA_LAS u32x4*)(VI + v_st4(c >> 4, (c & 15) * 8)) = pv[i]; }
        *(GLA_LAS u32x4*)(PI + (tid >> 3) * RS128 + (tid & 7) * 16) = pp;
        if (tid < 128) EL[tid] = pe;
        __syncthreads();
        if (sc + 1 < nchunk) GLA_FETCH(sc + 1);
        f32x16 op[2] = {f32x16{}, f32x16{}};
#pragma unroll
        for (int j = 0; j < 2; ++j)
#pragma unroll
            for (int s2 = 0; s2 < 2; ++s2) { const bf16x8 bs = pack_step(S[j], s2); const int cb0 = (32 * (2 * kh + j) + 16 * s2 + 4 * hi) * 2;
#pragma unroll
                for (int rb = 0; rb < 2; ++rb) { const int l = 32 * rb + r32;
                    const s16x4 a0 = *(const GLA_LAS s16x4*)(QT + swz256(l, cb0)), a1 = *(const GLA_LAS s16x4*)(QT + swz256(l, cb0 + 16));
                    const bf16x8 a = {a0[0], a0[1], a0[2], a0[3], a1[0], a1[1], a1[2], a1[3]}; op[rb] = GLA_MFMA(a, bs, op[rb]); } }
        { const f32x16& snd = kh ? op[0] : op[1];
#pragma unroll
          for (int g = 0; g < 4; ++g) XOs[g * 64 + lane] = (f32x4){snd[4 * g], snd[4 * g + 1], snd[4 * g + 2], snd[4 * g + 3]}; }
        __syncthreads();
        f32x16 o = kh ? op[1] : op[0];
#pragma unroll
        for (int g = 0; g < 4; ++g) { const f32x4 rv = XOr[g * 64 + lane]; o[4 * g] += rv.x; o[4 * g + 1] += rv.y; o[4 * g + 2] += rv.z; o[4 * g + 3] += rv.w; }
        bf16x8 vf[4];
        { const s16x4 l0 = tr_read<0 * 4096>(vb), h0 = tr_read<0 * 4096 + 2048>(vb), l1 = tr_read<1 * 4096>(vb), h1 = tr_read<1 * 4096 + 2048>(vb);
          const s16x4 l2 = tr_read<2 * 4096>(vb), h2 = tr_read<2 * 4096 + 2048>(vb), l3 = tr_read<3 * 4096>(vb), h3 = tr_read<3 * 4096 + 2048>(vb);
          asm volatile("s_waitcnt lgkmcnt(0)" ::: "memory"); __builtin_amdgcn_sched_barrier(0);
          vf[0] = (bf16x8){l0[0], l0[1], l0[2], l0[3], h0[0], h0[1], h0[2], h0[3]}; vf[1] = (bf16x8){l1[0], l1[1], l1[2], l1[3], h1[0], h1[1], h1[2], h1[3]};
          vf[2] = (bf16x8){l2[0], l2[1], l2[2], l2[3], h2[0], h2[1], h2[2], h2[3]}; vf[3] = (bf16x8){l3[0], l3[1], l3[2], l3[3], h3[0], h3[1], h3[2], h3[3]}; }
#pragma unroll
        for (int ks = 0; ks < 4; ++ks) { const bf16x8 a = *(const GLA_LAS bf16x8*)(PI + swz128(32 * kh + r32, (16 * ks + 8 * hi) * 2)); o = GLA_MFMA(a, vf[ks], o); }
        if (is_lat) {
#pragma unroll
            for (int r = 0; r < 16; ++r) O[(row0 + 32 * kh + crow(r, hi)) * 1024 + h * 256 + vh * 128 + 32 * vt + r32] = bf1f(o[r]); }
#pragma unroll
        for (int j = 0; j < 2; ++j) { const int kt = 2 * kh + j;
#pragma unroll
            for (int ks = 0; ks < 4; ++ks) { const bf16x8 a = *(const GLA_LAS bf16x8*)(KH + swz128(32 * kt + r32, (16 * ks + 8 * hi) * 2)); S[j] = GLA_MFMA(a, vf[ks], S[j]); }
#pragma unroll
            for (int r = 0; r < 16; ++r) S[j][r] *= EL[32 * kt + crow(r, hi)]; }
        __syncthreads();
    }
#undef GLA_FETCH
#undef GLA_CS
}
#undef GLA_MFMA
}

constexpr int NWAVES = 8;
constexpr int D = 1024, NB = 16, SEQ = 2048, CTXL = 256, TT = SEQ + CTXL;
constexpr int ML = NB * SEQ, MC = NB * CTXL, MA = ML + MC;
constexpr float EPS = 1e-6f;
constexpr int S5W = 512, S5G = 32, S5H = 16, S5P = 64;
constexpr int NH = 8, NOPE = 64, ROPE = 32, QK = 96, VD = 64, QRANK = 256, KVRANK = 128;
constexpr int EV_IN = 928, EV_INP = 1024, NQKV = 1792, KQKV = 384;
constexpr int GH = 4, GDK = 128, GDV = 256, GKEY = 512, GVAL = 1024, GRANK = 16;
constexpr int OD_IN = 3104, OD_INP = 3328;
constexpr int FFN = 2816, NE = 8, FE = 3584;
constexpr int MOE_MAXT = 264;

constexpr size_t MiB = 1u << 20;
constexpr size_t WS_CTL = 0, CTL_ZERO_BYTES = 1 * MiB;
constexpr size_t WS_MODV = 1 * MiB;
constexpr size_t WS_TOK = 2 * MiB;
constexpr size_t WS_INV = 3 * MiB;
constexpr size_t WS_W_IN1 = 4 * MiB, WS_W_OUT1 = 11 * MiB, WS_W_MGU = 13 * MiB  , WS_W_MDN = 69 * MiB  ;
constexpr size_t WS_W_IN0 = 97 * MiB, WS_W_QKV = 99 * MiB, WS_W_GLU = 100 * MiB + 512 * 1024, WS_W_OUT0 = 101 * MiB, WS_W_GU = 103 * MiB, WS_W_DN = 114 * MiB, WS_HC = 120 * MiB;
constexpr size_t PB = 136 * MiB;
constexpr size_t WS_XL = PB + 0 * MiB, WS_Q = PB + 0 * MiB, WS_A3 = PB + 72 * MiB, WS_YL = PB + 72 * MiB, WS_KV = PB + 144 * MiB, WS_Z0C = PB + 144 * MiB, WS_U = PB + 180 * MiB, WS_DS = PB + 216 * MiB, WS_AO = PB + 216 * MiB,
                 WS_QA = PB + 288 * MiB, WS_AG = PB + 288 * MiB, WS_KR = PB + 324 * MiB, WS_B1 = PB + 328 * MiB, WS_B3 = PB + 332 * MiB;
constexpr size_t WS_ACT = PB + 72 * MiB, WS_FL = PB + 270 * MiB;
constexpr size_t WS_TP = 97 * MiB, WS_EL = 133 * MiB, WS_OF = PB, WS_VR = 208 * MiB, WS_QK = 370 * MiB, WS_OB = 370 * MiB, WS_YL1 = 370 * MiB, WS_TQ = 442 * MiB, WS_TK = 514 * MiB;
constexpr int VRLD = 2304;
constexpr int GLA_TILES = NB * GH * 2 * 36;
constexpr int MOE_W_ITEMS = NE * (2 * (D / 64) * (FE / 32) + (FE / 64) * (D / 32));
constexpr int MW0 = 0, MW1 = (MOE_W_ITEMS * 20) / 100, MW2 = (MOE_W_ITEMS * 40) / 100, MW3 = (MOE_W_ITEMS * 54) / 100, MW4 = (MOE_W_ITEMS * 82) / 100, MW5 = MOE_W_ITEMS;
constexpr size_t WS_XLM = PB + 0 * MiB, WS_Y = PB + 0 * MiB, WS_XG = PB + 132 * MiB, WS_ACTM = PB + 198 * MiB;
constexpr size_t WS_END = 588 * MiB;
static_assert(WS_KR + (size_t)MA * 32 * 2 <= WS_B1 && WS_KV + (size_t)MA * 1024 * 2 <= WS_DS && WS_AG + (size_t)MA * 512 * 2 <= WS_KR && WS_AO + (size_t)MA * D * 2 <= WS_AG && WS_A3 + (size_t)MA * 1024 * 2 <= WS_KV &&
              WS_Z0C + (size_t)MA * 512 * 2 <= WS_U && WS_U + (size_t)MA * 512 * 2 <= WS_DS && WS_DS + (size_t)MA * 512 * 4 <= WS_QA && WS_QA + (size_t)MA * KQKV * 2 <= WS_KR && WS_B1 + (size_t)32 * 256 * 256 * 2 <= WS_B3 && WS_B3 + (size_t)32 * 256 * 512 * 2 <= WS_END, "ws map");
static_assert(WS_FL + (size_t)MA * D * 2 <= WS_END && WS_ACT + (size_t)MA * FFN * 2 <= WS_FL, "ws map 2");
static_assert(WS_TP + (size_t)GLA_TILES * 8192 <= WS_EL && WS_EL + (size_t)GLA_TILES * 512 <= PB && WS_XL + (size_t)MA * D * 2 <= WS_VR && WS_VR + (size_t)MA * VRLD * 2 <= WS_QK && WS_QK + (size_t)MA * 1024 * 2 <= WS_TQ &&
              WS_TQ + (size_t)GLA_TILES * 16384 <= WS_TK && WS_TK + (size_t)GLA_TILES * 16384 <= WS_END && WS_OF + (size_t)ML * D * 2 <= WS_VR && WS_OB + (size_t)ML * D * 2 <= WS_TQ, "ws map layer 1");
static_assert(WS_Y + (size_t)MOE_MAXT * 256 * D * 2 <= WS_XG && WS_XG + (size_t)MOE_MAXT * 256 * D <= WS_ACTM && WS_ACTM + (size_t)MOE_MAXT * 256 * FE <= WS_END && WS_XLM + (size_t)ML * D <= WS_XG, "ws map 3");
static_assert(WS_W_IN1 + (size_t)OD_INP * D * 2 <= WS_W_OUT1 && WS_W_OUT1 + (size_t)D * D * 2 <= WS_W_MGU && WS_W_MGU + (size_t)NE * 2 * FE * D <= WS_W_MDN && WS_W_MDN + (size_t)NE * D * FE <= WS_W_IN0 &&
              WS_W_GU + (size_t)2 * FFN * D * 2 <= WS_W_DN && WS_W_DN + (size_t)D * FFN * 2 <= WS_HC && WS_HC + (size_t)MC * D * 4 <= PB, "ws map 4");
#ifndef FFN0_FP8
#define FFN0_FP8 0
#endif
constexpr bool FFN0_IS_FP8 = FFN0_FP8;
#ifndef FFN0_DOWN_FP8
#define FFN0_DOWN_FP8 1
#endif
constexpr bool FFN0_DN_FP8 = FFN0_DOWN_FP8;
constexpr float FP8_SA = 8.0f, FP8_SW = 128.0f, FP8_SACT = 4.0f;

constexpr int CW_TMO = 0, CW_CODE = 1, CW_CNT = 64, CW_BAR = 4096;

constexpr int RING_OFF = 0, RING_BYTES = 131072;
constexpr int ATAB_OFF = RING_BYTES + 1024, ATAB_UNITS = 29;
constexpr int LDSCTL_OFF = RING_BYTES, MISC_OFF = LDSCTL_OFF + 320;
constexpr int LDS_BYTES = 147456;
static_assert(ATAB_OFF + ATAB_UNITS * 512 <= LDS_BYTES, "LDS map: row table");
#ifndef PROBE_BLK
#define PROBE_BLK 0
#endif
#ifdef PROBE_SETA
#define PROBE_STAMP2(F, k) do { if (blockIdx.x == PROBE_BLK && F.tid == 0) { const unsigned long long t_ = __builtin_amdgcn_s_memrealtime(); const unsigned long long l_ = ((unsigned long long)F.MISC[17] << 32) | F.MISC[16]; const unsigned d_ = (unsigned)(t_ - l_); \
        if ((PROBE_SETA >> (k)) & 1ull) F.MISC[18] += d_; if ((PROBE_SETB >> (k)) & 1ull) F.MISC[20] += d_; F.MISC[16] = (unsigned)t_; F.MISC[17] = (unsigned)(t_ >> 32); } } while (0)
#else
#define PROBE_STAMP2(F, k) do { } while (0)
#endif

struct Args { const float* in[35]; float* out; unsigned char* ws; int ph_lo, ph_hi; };
struct Frame { LAS unsigned char* lds; volatile LAS unsigned* MISC; gu32* ctl; int tid, lane, wave, G, gw, ngw; };

__device__ __forceinline__ float wave_sum(float v) {
#pragma unroll
    for (int o = 1; o < 64; o <<= 1) v += __shfl_xor(v, o);
    return v;
}
__device__ __forceinline__ float bf_lo(unsigned u) { return __uint_as_float(u << 16); }
__device__ __forceinline__ float bf_hi(unsigned u) { return __uint_as_float(u & 0xffff0000u); }
__device__ __forceinline__ float bf1(bf16 u) { return __uint_as_float(((unsigned)u) << 16); }
typedef unsigned v2u __attribute__((ext_vector_type(2)));
__device__ __forceinline__ unsigned pk4_fp8(float a, float b, float c, float d) { return pg8::pk4_fp8(a, b, c, d); }

__device__ __forceinline__ void ld_row_f32(const float* p, int lane, f32x4 (&v)[4]) {
    const GAS f32x4* q = (const GAS f32x4*)p + lane;
#pragma unroll
    for (int j = 0; j < 4; ++j) v[j] = q[64 * j];
}
__device__ __forceinline__ void st_row_f32(float* p, int lane, const f32x4 (&v)[4]) {
    GAS f32x4* q = (GAS f32x4*)p + lane;
#pragma unroll
    for (int j = 0; j < 4; ++j) q[64 * j] = v[j];
}
__device__ __forceinline__ void ld_row_bf16(const bf16* p, int lane, f32x4 (&v)[4]) {
    const GAS v2u* q = (const GAS v2u*)p + lane;
#pragma unroll
    for (int j = 0; j < 4; ++j) { const v2u w = q[64 * j]; v[j] = (f32x4){bf_lo(w.x), bf_hi(w.x), bf_lo(w.y), bf_hi(w.y)}; }
}
__device__ __forceinline__ void st_row_bf16(bf16* p, int lane, const f32x4 (&v)[4]) {
    GAS v2u* q = (GAS v2u*)p + lane;
#pragma unroll
    for (int j = 0; j < 4; ++j) { v2u w; w.x = pk2(v[j].x, v[j].y); w.y = pk2(v[j].z, v[j].w); q[64 * j] = w; }
}
__device__ __forceinline__ void st_row_fp8(unsigned char* p, int lane, const f32x4 (&v)[4], float sc) {
    GAS unsigned* q = (GAS unsigned*)p + lane;
#pragma unroll
    for (int j = 0; j < 4; ++j) q[64 * j] = pk4_fp8(v[j].x * sc, v[j].y * sc, v[j].z * sc, v[j].w * sc);
}
__device__ __forceinline__ float row_rs(const f32x4 (&v)[4]) {
    float s = 0.f;
#pragma unroll
    for (int j = 0; j < 4; ++j) s += (v[j].x * v[j].x + v[j].y * v[j].y) + (v[j].z * v[j].z + v[j].w * v[j].w);
    return rsqrtf(wave_sum(s) * (1.0f / D) + EPS);
}
__device__ __forceinline__ void norm_mod(f32x4 (&v)[4], const float* gam, const float* sh, const float* sc, int lane) {
    const float rs = row_rs(v); f32x4 g[4], a[4], b[4]; ld_row_f32(gam, lane, g); ld_row_f32(sh, lane, a); ld_row_f32(sc, lane, b);
#pragma unroll
    for (int j = 0; j < 4; ++j) v[j] = (v[j] * rs) * g[j] * (1.0f + b[j]) + a[j];
}
__device__ __forceinline__ void gated_add(f32x4 (&h)[4], const f32x4 (&y)[4], const float* gam, const float* gate, int lane) {
    const float rs = row_rs(y); f32x4 g[4], t[4]; ld_row_f32(gam, lane, g); ld_row_f32(gate, lane, t);
#pragma unroll
    for (int j = 0; j < 4; ++j) h[j] = h[j] + t[j] * ((y[j] * rs) * g[j]);
}

__device__ __forceinline__ void cvt_item(const float* W, int K, int N, bf16* WT, int ldk, int kcol0, int row_off, int mode, const float* gain, float scale, int nscale,
                                         LAS float* scr, int item, int lane, bool fp8 = false, bool tiled = false) {
    const int nblk = N / 32, kb = item / nblk, nb = item % nblk, k0 = 64 * kb, n0 = 32 * nb;
    { f32x4 t[8];
#pragma unroll
      for (int i = 0; i < 8; ++i) t[i] = *(const GAS f32x4*)(W + (size_t)(k0 + 8 * i + (lane >> 3)) * N + n0 + 4 * (lane & 7));
#pragma unroll
      for (int i = 0; i < 8; ++i) { LAS float* d = scr + (8 * i + (lane >> 3)) * 33 + 4 * (lane & 7); d[0] = t[i].x; d[1] = t[i].y; d[2] = t[i].z; d[3] = t[i].w; } }
    LDS_WAIT(); asm volatile("" ::: "memory");
    const int c = lane & 7;
    float gn[8];
#pragma unroll
    for (int q = 0; q < 8; ++q) gn[q] = (gain ? gain[k0 + 8 * c + q] : 1.0f) * ((n0 < nscale) ? scale : 1.0f);
    const int drow0 = (mode == 0) ? n0 : (mode == 3) ? ((n0 >> 7) * 64 + (n0 & 63) + ((n0 & 64) ? 512 : 0)) : ((n0 >> 7) * 256 + (n0 & 127) + (mode == 2 ? 128 : 0));
#pragma unroll
    for (int j = 0; j < 4; ++j) { const int n = (lane >> 3) + 8 * j; const LAS float* s = scr + (8 * c) * 33 + n;
        if (fp8) { v2u o; o.x = pk4_fp8(s[0 * 33] * gn[0], s[1 * 33] * gn[1], s[2 * 33] * gn[2], s[3 * 33] * gn[3]); o.y = pk4_fp8(s[4 * 33] * gn[4], s[5 * 33] * gn[5], s[6 * 33] * gn[6], s[7 * 33] * gn[7]);
            const int drow = row_off + drow0 + n, kc = kcol0 + k0 + 8 * c;
            unsigned char* dp = tiled ? (unsigned char*)WT + (size_t)(drow >> 8) * 256 * ldk + (size_t)(kc >> 7) * 32768 + (drow & 255) * 128 + (kc & 127) : (unsigned char*)WT + (size_t)drow * ldk + kc;
            *(GAS v2u*)dp = o; }
        else { v4u o; o.x = pk2(s[0 * 33] * gn[0], s[1 * 33] * gn[1]); o.y = pk2(s[2 * 33] * gn[2], s[3 * 33] * gn[3]); o.z = pk2(s[4 * 33] * gn[4], s[5 * 33] * gn[5]); o.w = pk2(s[6 * 33] * gn[6], s[7 * 33] * gn[7]);
            *(GAS v4u*)(WT + (size_t)(row_off + drow0 + n) * ldk + kcol0 + k0 + 8 * c) = o; } }
    LDS_WAIT(); asm volatile("" ::: "memory");
}
__device__ __forceinline__ void moe_weights(Frame& F, const Args& A, int it_lo, int it_hi, int widx, int nw) {
    LAS float* scr = (LAS float*)(F.lds + RING_OFF + F.wave * 16384);
    unsigned char* ws = A.ws;
    constexpr int I_MG1 = (D / 64) * (FE / 32), I_MD1 = (FE / 64) * (D / 32);
    for (int it = it_lo + widx; it < it_hi; it += nw) {
        int r = it;
        if (r < NE * I_MG1) { const int e = r / I_MG1; cvt_item(A.in[32] + (size_t)e * D * FE, D, FE, (bf16*)(ws + WS_W_MGU + (size_t)e * 2 * FE * D), D, 0, 0, 1, nullptr, FP8_SW, 1 << 30, scr, r % I_MG1, F.lane, true); continue; } r -= NE * I_MG1;
        if (r < NE * I_MG1) { const int e = r / I_MG1; cvt_item(A.in[33] + (size_t)e * D * FE, D, FE, (bf16*)(ws + WS_W_MGU + (size_t)e * 2 * FE * D), D, 0, 0, 2, nullptr, FP8_SW, 1 << 30, scr, r % I_MG1, F.lane, true); continue; } r -= NE * I_MG1;
        { const int e = r / I_MD1; cvt_item(A.in[34] + (size_t)e * FE * D, FE, D, (bf16*)(ws + WS_W_MDN + (size_t)e * D * FE), FE, 0, 0, 0, nullptr, FP8_SW, 1 << 30, scr, r % I_MD1, F.lane, true, true); }
    }
}
__device__ __forceinline__ void tail_convert(Frame& F, const Args& A, int nunit, int lo, int hi) {
    const int nlast = nunit % F.G, bid = (int)blockIdx.x;
    if (nlast != 0) { if (bid >= nlast) moe_weights(F, A, lo, hi, (bid - nlast) * NWAVES + F.wave, (F.G - nlast) * NWAVES); }
    else moe_weights(F, A, lo, hi, F.gw, F.ngw);
}
__device__ __forceinline__ void gen_s5(Frame& F, const Args& A, int g);
__device__ __forceinline__ void p0_prologue(Frame& F, const Args& A) {
    LAS float* scr = (LAS float*)(F.lds + RING_OFF + F.wave * 16384);
    unsigned char* ws = A.ws;
    constexpr int I_IN0 = (D / 64) * (EV_IN / 32), I_UQ = (QRANK / 64) * (768 / 32), I_UKV = (KVRANK / 64) * (1024 / 32), I_GLU = (512 / 64) * (512 / 32), I_OUT = (D / 64) * (D / 32);
    constexpr int I_FG = (D / 64) * (FFN / 32), I_FD = (FFN / 64) * (D / 32), I_IN1 = (D / 64) * (OD_IN / 32), I_MG1 = (D / 64) * (FE / 32), I_MD1 = (FE / 64) * (D / 32);
    constexpr int NITEMS = I_IN0 + I_UQ + I_UKV + I_GLU + I_OUT + 2 * I_FG + I_FD + I_IN1 + I_OUT;
    const bool s5_builder = (int)blockIdx.x >= F.G - S5G;
    for (int it = s5_builder ? NITEMS : F.gw; it < NITEMS; it += F.ngw - S5G * NWAVES) {
        int r = it;
        if (r < I_IN0) { cvt_item(A.in[7], D, EV_IN, (bf16*)(ws + WS_W_IN0), D, 0, 0, 0, nullptr, 1.f, 0, scr, r, F.lane); continue; } r -= I_IN0;
        if (r < I_UQ) { cvt_item(A.in[19], QRANK, 768, (bf16*)(ws + WS_W_QKV), KQKV, 0, 0, 0, A.in[18], 1.f, 0, scr, r, F.lane); continue; } r -= I_UQ;
        if (r < I_UKV) { cvt_item(A.in[21], KVRANK, 1024, (bf16*)(ws + WS_W_QKV), KQKV, QRANK, 768, 3, A.in[20], 1.f, 0, scr, r, F.lane); continue; } r -= I_UKV;
        if (r < I_GLU) { cvt_item(A.in[16], 512, 512, (bf16*)(ws + WS_W_GLU), 512, 0, 0, 0, nullptr, 1.f, 0, scr, r, F.lane); continue; } r -= I_GLU;
        if (r < I_OUT) { cvt_item(A.in[22], D, D, (bf16*)(ws + WS_W_OUT0), D, 0, 0, 0, nullptr, 1.f, 0, scr, r, F.lane); continue; } r -= I_OUT;
        if (r < I_FG) { cvt_item(A.in[23], D, FFN, (bf16*)(ws + WS_W_GU), D, 0, 0, 1, nullptr, FFN0_IS_FP8 ? FP8_SW : 1.f, 1 << 30, scr, r, F.lane, FFN0_IS_FP8); continue; } r -= I_FG;
        if (r < I_FG) { cvt_item(A.in[24], D, FFN, (bf16*)(ws + WS_W_GU), D, 0, 0, 2, nullptr, FFN0_IS_FP8 ? FP8_SW : 1.f, 1 << 30, scr, r, F.lane, FFN0_IS_FP8); continue; } r -= I_FG;
        if (r < I_FD) { cvt_item(A.in[25], FFN, D, (bf16*)(ws + WS_W_DN), FFN, 0, 0, 0, nullptr, (FFN0_IS_FP8 || FFN0_DN_FP8) ? FP8_SW : 1.f, 1 << 30, scr, r, F.lane, FFN0_IS_FP8 || FFN0_DN_FP8); continue; } r -= I_FD;
        if (r < I_IN1) { cvt_item(A.in[26], D, OD_IN, (bf16*)(ws + WS_W_IN1), D, 0, 0, 0, nullptr, 0.08838834764831845f, GKEY, scr, r, F.lane); continue; } r -= I_IN1;
        cvt_item(A.in[30], D, D, (bf16*)(ws + WS_W_OUT1), D, 0, 0, 0, nullptr, 1.f, 0, scr, r, F.lane);
    }
    { const v4u z = {0u, 0u, 0u, 0u}; const int gt = blockIdx.x * (NWAVES * 64) + F.tid, ngt = F.G * NWAVES * 64;
      GAS v4u* p0 = (GAS v4u*)((bf16*)(ws + WS_W_IN0) + (size_t)EV_IN * D); for (int i = gt; i < (EV_INP - EV_IN) * D / 8; i += ngt) p0[i] = z;
      for (int i = gt; i < 768 * (KVRANK / 8); i += ngt) { const int r = i / (KVRANK / 8), c = i % (KVRANK / 8); *(GAS v4u*)((bf16*)(ws + WS_W_QKV) + (size_t)r * KQKV + QRANK + 8 * c) = z; }
      for (int i = gt; i < 1024 * (QRANK / 8); i += ngt) { const int r = i / (QRANK / 8), c = i % (QRANK / 8); *(GAS v4u*)((bf16*)(ws + WS_W_QKV) + (size_t)(768 + r) * KQKV + 8 * c) = z; }
      GAS v4u* p1 = (GAS v4u*)((bf16*)(ws + WS_W_IN1) + (size_t)OD_IN * D); for (int i = gt; i < (OD_INP - OD_IN) * D / 8; i += ngt) p1[i] = z; }
    __syncthreads();
    PROBE_STAMP2(F, 22);
    LAS float* act = (LAS float*)(F.lds);
    LAS float* red = (LAS float*)(F.lds + 17 * 1024 * 4);
    float* modv = (float*)(ws + WS_MODV);
    bool have_act = false;
    for (int u = blockIdx.x; u < 2 * 96; u += F.G) {
        if (!have_act) {
            float xv[17 * 1024 / (NWAVES * 64)];
#pragma unroll
            for (int q = 0; q < 17 * 1024 / (NWAVES * 64); ++q) { const int i = F.tid + q * (NWAVES * 64); xv[q] = (i < 16 * 1024) ? A.in[1][i] : A.in[3][i - 16 * 1024]; }
#pragma unroll
            for (int q = 0; q < 17 * 1024 / (NWAVES * 64); ++q) { const float x = xv[q]; act[F.tid + q * (NWAVES * 64)] = x / (1.0f + __expf(-x)); }
            have_act = true;
        }
        __syncthreads();
        const int layer = u / 96, c0 = (u % 96) * 64;
        const float* mw = A.in[4] + (size_t)layer * D * 6144 + c0 + F.lane;
        float acc[17];
#pragma unroll
        for (int r = 0; r < 17; ++r) acc[r] = 0.f;
        for (int k0 = F.wave * 128; k0 < F.wave * 128 + 128; k0 += 32) { float w[32];
#pragma unroll
            for (int u2 = 0; u2 < 32; ++u2) w[u2] = mw[(size_t)(k0 + u2) * 6144];
#pragma unroll
            for (int u2 = 0; u2 < 32; ++u2)
#pragma unroll
                for (int r = 0; r < 17; ++r) acc[r] += act[r * 1024 + k0 + u2] * w[u2]; }
#pragma unroll
        for (int r = 0; r < 17; ++r) red[(F.wave * 17 + r) * 64 + F.lane] = acc[r];
        __syncthreads();
        for (int i = F.tid; i < 17 * 64; i += NWAVES * 64) { const int r = i >> 6, l = i & 63; float s = A.in[5][layer * 6144 + c0 + l];
#pragma unroll
            for (int w = 0; w < 8; ++w) s += red[(w * 17 + r) * 64 + l];
            modv[(size_t)(layer * 17 + r) * 6144 + c0 + l] = s; }
    }
    __syncthreads();
    PROBE_STAMP2(F, 23);
    for (int g = (int)blockIdx.x - (F.G - S5G); g >= 0 && g < S5G; g += F.G) gen_s5(F, A, g);
    PROBE_STAMP2(F, 24);
}

__device__ __forceinline__ void thin_t1(Frame& F, const Args& A) {
    const float* modv = (const float*)(A.ws + WS_MODV); bf16* XL = (bf16*)(A.ws + WS_XL); const float* gam = A.in[6];
    for (int r0 = F.gw; r0 < MA; r0 += 2 * F.ngw) {
        const int r1 = (r0 + F.ngw < MA) ? r0 + F.ngw : r0; const bool two = r1 != r0;
        const bool lat0 = r0 < ML, lat1 = r1 < ML; const float* src0 = lat0 ? A.in[0] + (size_t)r0 * D : A.in[2] + (size_t)(r0 - ML) * D; const float* src1 = lat1 ? A.in[0] + (size_t)r1 * D : A.in[2] + (size_t)(r1 - ML) * D;
        const float* mod0 = modv + (size_t)(lat0 ? r0 / SEQ : 16) * 6144; const float* mod1 = modv + (size_t)(lat1 ? r1 / SEQ : 16) * 6144;
        f32x4 v0[4], v1[4]; ld_row_f32(src0, F.lane, v0); ld_row_f32(src1, F.lane, v1);
        norm_mod(v0, gam, mod0, mod0 + D, F.lane); st_row_bf16(XL + (size_t)r0 * D, F.lane, v0);
        norm_mod(v1, gam, mod1, mod1 + D, F.lane); if (two) st_row_bf16(XL + (size_t)r1 * D, F.lane, v1);
    }
}
__device__ __forceinline__ void thin_t2(Frame& F, const Args& A) {
    const float* modv = (const float*)(A.ws + WS_MODV); bf16* XL = (bf16*)(A.ws + WS_XL); const bf16* YL = (const bf16*)(A.ws + WS_YL); float* HC = (float*)(A.ws + WS_HC); const float* gam = A.in[6];
    for (int r0 = F.gw; r0 < MA; r0 += 2 * F.ngw) {
        const int r1 = (r0 + F.ngw < MA) ? r0 + F.ngw : r0; const bool two = r1 != r0;
        const bool lat0 = r0 < ML, lat1 = r1 < ML;
        const float* src0 = lat0 ? A.in[0] + (size_t)r0 * D : A.in[2] + (size_t)(r0 - ML) * D; const float* src1 = lat1 ? A.in[0] + (size_t)r1 * D : A.in[2] + (size_t)(r1 - ML) * D;
        float* dst0 = lat0 ? A.out + (size_t)r0 * D : HC + (size_t)(r0 - ML) * D; float* dst1 = lat1 ? A.out + (size_t)r1 * D : HC + (size_t)(r1 - ML) * D;
        const float* mod0 = modv + (size_t)(lat0 ? r0 / SEQ : 16) * 6144; const float* mod1 = modv + (size_t)(lat1 ? r1 / SEQ : 16) * 6144;
        f32x4 h0[4], y0[4], h1[4], y1[4];
        ld_row_f32(src0, F.lane, h0); ld_row_bf16(YL + (size_t)r0 * D, F.lane, y0); ld_row_f32(src1, F.lane, h1); ld_row_bf16(YL + (size_t)r1 * D, F.lane, y1);
        gated_add(h0, y0, gam + 1 * D, mod0 + 2 * D, F.lane); gated_add(h1, y1, gam + 1 * D, mod1 + 2 * D, F.lane);
        st_row_f32(dst0, F.lane, h0); if (two) st_row_f32(dst1, F.lane, h1);
        norm_mod(h0, gam + 2 * D, mod0 + 3 * D, mod0 + 4 * D, F.lane); norm_mod(h1, gam + 2 * D, mod1 + 3 * D, mod1 + 4 * D, F.lane);
        if (FFN0_IS_FP8) { st_row_fp8((unsigned char*)XL + (size_t)r0 * D, F.lane, h0, FP8_SA); if (two) st_row_fp8((unsigned char*)XL + (size_t)r1 * D, F.lane, h1, FP8_SA); }
        else { st_row_bf16(XL + (size_t)r0 * D, F.lane, h0); if (two) st_row_bf16(XL + (size_t)r1 * D, F.lane, h1); }
    }
}
__device__ __forceinline__ void thin_t3(Frame& F, const Args& A) {
    const float* modv = (const float*)(A.ws + WS_MODV); bf16* XL = (bf16*)(A.ws + WS_XL); const bf16* FL = (const bf16*)(A.ws + WS_FL); const float* HC = (const float*)(A.ws + WS_HC); const float* gam = A.in[6];
    for (int r0 = F.gw; r0 < MA; r0 += 2 * F.ngw) {
        const int r1 = (r0 + F.ngw < MA) ? r0 + F.ngw : r0; const bool two = r1 != r0;
        const bool lat0 = r0 < ML, lat1 = r1 < ML;
        const float* src0 = lat0 ? A.out + (size_t)r0 * D : HC + (size_t)(r0 - ML) * D; const float* src1 = lat1 ? A.out + (size_t)r1 * D : HC + (size_t)(r1 - ML) * D;
        const int bs0 = lat0 ? r0 / SEQ : 16, bs1 = lat1 ? r1 / SEQ : 16;
        f32x4 h0[4], y0[4], h1[4], y1[4];
        ld_row_f32(src0, F.lane, h0); ld_row_bf16(FL + (size_t)r0 * D, F.lane, y0); ld_row_f32(src1, F.lane, h1); ld_row_bf16(FL + (size_t)r1 * D, F.lane, y1);
        gated_add(h0, y0, gam + 3 * D, modv + (size_t)bs0 * 6144 + 5 * D, F.lane); gated_add(h1, y1, gam + 3 * D, modv + (size_t)bs1 * 6144 + 5 * D, F.lane);
        if (lat0) st_row_f32(A.out + (size_t)r0 * D, F.lane, h0); if (two && lat1) st_row_f32(A.out + (size_t)r1 * D, F.lane, h1);
        { const float* m0 = modv + (size_t)(17 + bs0) * 6144; const float* m1 = modv + (size_t)(17 + bs1) * 6144;
          norm_mod(h0, gam + 4 * D, m0, m0 + D, F.lane); norm_mod(h1, gam + 4 * D, m1, m1 + D, F.lane); }
        st_row_bf16(XL + (size_t)r0 * D, F.lane, h0); if (two) st_row_bf16(XL + (size_t)r1 * D, F.lane, h1);
    }
}
__device__ __forceinline__ void thin_t4(Frame& F, const Args& A) {
    const float* modv = (const float*)(A.ws + WS_MODV); bf16* XL = (bf16*)(A.ws + WS_XLM); const bf16* YL = (const bf16*)(A.ws + WS_YL1); const float* gam = A.in[6] + 4 * D;
    const float* router = A.in[31]; unsigned* tok = (unsigned*)(A.ws + WS_TOK); unsigned short* inv = (unsigned short*)(A.ws + WS_INV);
    LAS float* rt = (LAS float*)(F.lds);
    LAS unsigned* wc = (LAS unsigned*)(F.lds + 32768);
    __syncthreads();
    for (int i = F.tid; i < 8 * 1024; i += NWAVES * 64) { const int e = i >> 10, c = i & 1023; rt[i] = router[(size_t)c * 8 + e]; }
    __syncthreads();
    for (int chunk = blockIdx.x; chunk < ML / 128; chunk += F.G) {
        const int row_base = chunk * 128 + F.wave * 16;
        int me0 = 0, me1 = 0; float mw0 = 0.f, mw1 = 0.f;
        for (int i = 0; i < 16; ++i) {
            const int r = row_base + i; const int bs = r / SEQ; const float* mod1 = modv + (size_t)(17 + bs) * 6144;
            f32x4 h[4], y[4]; ld_row_f32(A.out + (size_t)r * D, F.lane, h); ld_row_bf16(YL + (size_t)r * D, F.lane, y);
            gated_add(h, y, gam + 1 * D, mod1 + 2 * D, F.lane); st_row_f32(A.out + (size_t)r * D, F.lane, h);
            norm_mod(h, gam + 2 * D, mod1 + 3 * D, mod1 + 4 * D, F.lane); st_row_fp8((unsigned char*)XL + (size_t)r * D, F.lane, h, FP8_SA);
            float lg[8];
#pragma unroll
            for (int e = 0; e < 8; ++e) { float a = 0.f;
#pragma unroll
                for (int j = 0; j < 4; ++j) { const f32x4 w = *(const LAS f32x4*)(rt + e * 1024 + 256 * j + 4 * F.lane); a += (h[j].x * w.x + h[j].y * w.y) + (h[j].z * w.z + h[j].w * w.w); }
                lg[e] = a; }
            {
              const bool b5 = (F.lane & 32) != 0, b4 = (F.lane & 16) != 0, b3 = (F.lane & 8) != 0; float v4[4], v2[2];
#pragma unroll
              for (int i2 = 0; i2 < 4; ++i2) { const float keep = b5 ? lg[i2 + 4] : lg[i2], send = b5 ? lg[i2] : lg[i2 + 4]; v4[i2] = keep + __shfl_xor(send, 32); }
#pragma unroll
              for (int i2 = 0; i2 < 2; ++i2) { const float keep = b4 ? v4[i2 + 2] : v4[i2], send = b4 ? v4[i2] : v4[i2 + 2]; v2[i2] = keep + __shfl_xor(send, 16); }
              float v1 = (b3 ? v2[1] : v2[0]) + __shfl_xor(b3 ? v2[0] : v2[1], 8);
              v1 += __shfl_xor(v1, 1); v1 += __shfl_xor(v1, 2); v1 += __shfl_xor(v1, 4);
#pragma unroll
              for (int e = 0; e < 8; ++e) lg[e] = __builtin_bit_cast(float, __builtin_amdgcn_readlane(__builtin_bit_cast(int, v1), 8 * e)); }
            int e0 = 0; float v0 = lg[0];
#pragma unroll
            for (int e = 1; e < 8; ++e) if (lg[e] > v0) { v0 = lg[e]; e0 = e; }
            int e1 = (e0 + 1) & 7; float v1 = -3.0e38f;
#pragma unroll
            for (int e = 0; e < 8; ++e) if (e != e0 && lg[e] > v1) { v1 = lg[e]; e1 = e; }
            const float w1 = 1.0f / (1.0f + __expf(v0 - v1)), w0 = 1.0f - w1;
            if (F.lane == i) { me0 = e0; me1 = e1; mw0 = w0; mw1 = w1; }
        }
        unsigned long long m[8];
#pragma unroll
        for (int e = 0; e < 8; ++e) m[e] = __ballot(F.lane < 16 && (me0 == e || me1 == e));
        { unsigned c = 0;
#pragma unroll
          for (int e = 0; e < 8; ++e) c = (F.lane == e) ? (unsigned)__popcll(m[e]) : c;
          if (F.lane < 8) wc[F.wave * 8 + F.lane] = c; }
        __syncthreads();
        if (F.tid < 8) { unsigned tot = 0;
#pragma unroll
            for (int w = 0; w < 8; ++w) tot += wc[w * 8 + F.tid];
            unsigned run = __hip_atomic_fetch_add((unsigned*)(F.ctl + CW_CNT + F.tid), tot, __ATOMIC_RELAXED, __HIP_MEMORY_SCOPE_AGENT);
#pragma unroll
            for (int w = 0; w < 8; ++w) { const unsigned c = wc[w * 8 + F.tid]; wc[w * 8 + F.tid] = run; run += c; } }
        __syncthreads();
        if (F.lane < 16) { unsigned long long m0 = 0ull, m1 = 0ull;
#pragma unroll
            for (int e = 0; e < 8; ++e) { m0 = (me0 == e) ? m[e] : m0; m1 = (me1 == e) ? m[e] : m1; }
            const unsigned long long below = (1ull << F.lane) - 1ull;
            const unsigned i0 = wc[F.wave * 8 + me0] + (unsigned)__popcll(m0 & below), i1 = wc[F.wave * 8 + me1] + (unsigned)__popcll(m1 & below);
            unsigned* t = tok + (size_t)(row_base + F.lane) * 8; t[0] = (unsigned)me0; t[1] = (unsigned)me1; t[2] = i0; t[3] = i1; t[4] = __float_as_uint(mw0); t[5] = __float_as_uint(mw1);
            inv[(size_t)me0 * 32768 + i0] = (unsigned short)(row_base + F.lane); inv[(size_t)me1 * 32768 + i1] = (unsigned short)(row_base + F.lane); }
        __syncthreads();
    }
}
__device__ __forceinline__ void moe_tile_starts(Frame& F, int (&ts)[9]) {
    ts[0] = 0;
#pragma unroll
    for (int e = 0; e < 8; ++e) { const unsigned c = __hip_atomic_load((unsigned*)(F.ctl + CW_CNT + e), __ATOMIC_RELAXED, __HIP_MEMORY_SCOPE_AGENT); ts[e + 1] = ts[e] + (int)((c + 255u) >> 8); }
#pragma unroll
    for (int e = 0; e < 9; ++e) ts[e] = __builtin_amdgcn_readfirstlane(ts[e]);
}
template <class Sched> __device__ __forceinline__ void moe_row_table(Frame& F, const Args& A, const Sched& S, const int (&ts)[9]) {
    const unsigned short* inv = (const unsigned short*)(A.ws + WS_INV); LAS unsigned short* tab = (LAS unsigned short*)(F.lds + ATAB_OFF);
    __syncthreads();
    for (int i = 0; i < ATAB_UNITS; ++i) { pg8::Unit u; if (!S.next(i, u)) break;
        int e = 0;
#pragma unroll
        for (int q = 1; q < 8; ++q) e += (u.pm >= ts[q]) ? 1 : 0;
        int tse = 0;
#pragma unroll
        for (int q = 0; q < 8; ++q) tse = (e == q) ? ts[q] : tse;
        const unsigned cnt = __hip_atomic_load((unsigned*)(F.ctl + CW_CNT + e), __ATOMIC_RELAXED, __HIP_MEMORY_SCOPE_AGENT);
        if (F.tid < 256) { const unsigned r = (unsigned)(u.pm - tse) * 256u + (unsigned)F.tid; tab[i * 256 + F.tid] = (r < cnt) ? inv[(size_t)e * 32768 + r] : (unsigned short)0; } }
    __syncthreads();
}
__device__ __forceinline__ void thin_t5(Frame& F, const Args& A) {
    int ts[9]; moe_tile_starts(F, ts);
    const float* modv = (const float*)(A.ws + WS_MODV); const bf16* Y = (const bf16*)(A.ws + WS_Y); const float* gam = A.in[6] + 7 * D; const unsigned* tok = (const unsigned*)(A.ws + WS_TOK);
    for (int r = F.gw; r < ML; r += F.ngw) {
        const int bs = r / SEQ; const float* mod1 = modv + (size_t)(17 + bs) * 6144;
        const unsigned* t = tok + (size_t)r * 8; const float w0 = __uint_as_float(t[4]), w1 = __uint_as_float(t[5]); const int e0 = (int)t[0], e1 = (int)t[1]; int s0 = 0, s1 = 0;
#pragma unroll
        for (int e = 0; e < 8; ++e) { s0 = (e0 == e) ? ts[e] : s0; s1 = (e1 == e) ? ts[e] : s1; }
        const unsigned p0 = (unsigned)s0 * 256u + t[2], p1 = (unsigned)s1 * 256u + t[3];
        f32x4 h[4], y0[4], y1[4]; ld_row_f32(A.out + (size_t)r * D, F.lane, h); ld_row_bf16(Y + (size_t)p0 * D, F.lane, y0); ld_row_bf16(Y + (size_t)p1 * D, F.lane, y1);
#pragma unroll
        for (int j = 0; j < 4; ++j) y0[j] = y0[j] * w0 + y1[j] * w1;
        gated_add(h, y0, gam, mod1 + 5 * D, F.lane); st_row_f32(A.out + (size_t)r * D, F.lane, h);
    }
}

__device__ __forceinline__ float rope_inv(int f) { return exp2f(-(float)f * (13.287712379549449f / 8.0f)); }
__device__ __forceinline__ void prep_qa(Frame& F, const Args& A) {
    const bf16* Z0 = (const bf16*)(A.ws + WS_Z0C); bf16* QA = (bf16*)(A.ws + WS_QA); bf16* KR = (bf16*)(A.ws + WS_KR);
    const int n2 = (32 * 9 > F.G && 32 * 9 < 2 * F.G) ? 32 * 9 - F.G : 0;
    if ((int)blockIdx.x < n2) return;
    for (int r = F.gw - n2 * NWAVES; r < MA; r += F.ngw - n2 * NWAVES) {
        const bf16* z = Z0 + (size_t)r * 512;
        const v2u cq = *((const GAS v2u*)(z) + F.lane); const unsigned ck = *((const GAS unsigned*)(z + 256) + F.lane);
        const float q0 = bf_lo(cq.x), q1 = bf_hi(cq.x), q2 = bf_lo(cq.y), q3 = bf_hi(cq.y), k0 = bf_lo(ck), k1 = bf_hi(ck);
        const float rq = rsqrtf(wave_sum((q0 * q0 + q1 * q1) + (q2 * q2 + q3 * q3)) * (1.0f / QRANK) + EPS);
        const float rk = rsqrtf(wave_sum(k0 * k0 + k1 * k1) * (1.0f / KVRANK) + EPS);
        v2u oq; oq.x = pk2(q0 * rq, q1 * rq); oq.y = pk2(q2 * rq, q3 * rq);
        *((GAS v2u*)(QA + (size_t)r * KQKV) + F.lane) = oq; *((GAS unsigned*)(QA + (size_t)r * KQKV + QRANK) + F.lane) = pk2(k0 * rk, k1 * rk);
        const int l = F.lane & 31; float v = bf1(z[384 + l]); const float pv = __shfl_xor(v, 8);
        if (r < ML) { const int t = r % SEQ; const float pos = (l < 16) ? (float)(t / 64) : (float)(t % 64); float sn, cs; sincosf(pos * rope_inv(l & 7), &sn, &cs);
            v = (l & 8) ? (v * cs + pv * sn) : (v * cs - pv * sn); }
        if (F.lane < 32) KR[(size_t)r * 32 + l] = (bf16)f2bf(v);
    }
}
__device__ __forceinline__ void rope_q(Frame& F, const Args& A) {
    bf16* Q = (bf16*)(A.ws + WS_Q);
    for (int r = F.gw; r < ML; r += F.ngw) {
        const int t = r % SEQ, hh = F.lane >> 3, sub = F.lane & 7; bf16* p = Q + (size_t)r * 768 + hh * QK + NOPE + sub;
        const float inv = rope_inv(sub); float sr, cr, sc, cc; sincosf((float)(t / 64) * inv, &sr, &cr); sincosf((float)(t % 64) * inv, &sc, &cc);
        const float x0 = bf1(p[0]), x1 = bf1(p[8]), x2 = bf1(p[16]), x3 = bf1(p[24]);
        p[0] = (bf16)f2bf(x0 * cr - x1 * sr); p[8] = (bf16)f2bf(x1 * cr + x0 * sr); p[16] = (bf16)f2bf(x2 * cc - x3 * sc); p[24] = (bf16)f2bf(x3 * cc + x2 * sc);
    }
}
__device__ __forceinline__ int scan_row(int b, int dir, int tau) {
    if (tau < CTXL) return ML + b * CTXL + (dir ? CTXL - 1 - tau : tau);
    const int t = tau - CTXL; return b * SEQ + (dir ? SEQ - 1 - t : t);
}
__device__ __forceinline__ float gelu_tanh(float x) { const float u = 0.7978845608028654f * (x + 0.044715f * x * x * x); const float e = __expf(2.0f * u); const float th = 1.0f - 2.0f / (e + 1.0f); return 0.5f * x * (1.0f + th); }
__device__ __forceinline__ void gen_s5(Frame& F, const Args& A, int g) {
    constexpr int CS = 65, PS = 34, KS = 260;
    LAS float* pw = (LAS float*)F.lds;
    LAS float* cc = pw + 2 * 64 * PS;
    LAS float* bb = cc + 2 * 16 * CS * 2;
    LAS float* KK = bb + 2 * 64 * 16 * 2;
    LAS float* LL = KK + 2 * 16 * KS;
    LAS float* DSK = LL + 128 * 4;
    bf16* B1g = (bf16*)(A.ws + WS_B1) + (size_t)g * 256 * 256; bf16* B3g = (bf16*)(A.ws + WS_B3) + (size_t)g * 256 * 512;
    __syncthreads();
    { float lr = 0.f, li = 0.f, dtr = 0.f, dk = 0.f, braw[4], biraw[4], craw[4], ciraw[4];
      if (F.tid < 128) { const int d = F.tid >> 6, p = F.tid & 63, ig = d * S5G + g, i = ig * S5P + p; lr = A.in[8][i]; li = A.in[9][i]; dtr = A.in[10][ig]; }
      if (F.tid < 16) dk = A.in[15][g * 16 + F.tid];
#pragma unroll
      for (int q = 0; q < 4; ++q) { const int idx = F.tid + q * (NWAVES * 64); { const int dp = idx >> 4, h = idx & 15, d = dp >> 6, p = dp & 63; const size_t i = (size_t)((d * S5G + g) * S5P + p); braw[q] = A.in[11][i * 16 + h]; biraw[q] = A.in[12][i * 16 + h]; }
        { const int d = idx >> 10, ho = (idx >> 6) & 15, p = idx & 63; const size_t ci = (size_t)((d * S5G + g) * 16 + ho) * S5P + p; craw[q] = A.in[13][ci]; ciraw[q] = A.in[14][ci]; } }
      if (F.tid < 128) { const float dt = expf(dtr); LL[F.tid * 4] = lr; LL[F.tid * 4 + 1] = li; LL[F.tid * 4 + 2] = lr * dt; LL[F.tid * 4 + 3] = li * dt; }
      if (F.tid < 16) DSK[F.tid] = dk;
#pragma unroll
      for (int q = 0; q < 4; ++q) { const int idx = F.tid + q * (NWAVES * 64); bb[idx * 2] = braw[q]; bb[idx * 2 + 1] = biraw[q];
        { const int d = idx >> 10, ho = (idx >> 6) & 15, p = idx & 63; cc[((d * 16 + ho) * CS + p) * 2] = craw[q]; cc[((d * 16 + ho) * CS + p) * 2 + 1] = ciraw[q]; } } }
    __syncthreads();
    PROBE_STAMP2(F, 25);
    for (int idx = F.tid; idx < 128 * 17; idx += NWAVES * 64) { const int dp = idx / 17, k = idx - dp * 17;
        const float mag = expf((float)k * LL[dp * 4 + 2]), ang = (float)k * LL[dp * 4 + 3]; pw[dp * PS + k * 2] = mag * cosf(ang); pw[dp * PS + k * 2 + 1] = mag * sinf(ang); }
    for (int idx = F.tid; idx < 128 * 16; idx += NWAVES * 64) { const int dp = idx >> 4;
        const float lr = LL[dp * 4], li = LL[dp * 4 + 1], lrdt = LL[dp * 4 + 2], lidt = LL[dp * 4 + 3];
        const float mag = expf(lrdt), ar = mag * cosf(lidt), ai = mag * sinf(lidt), den = lr * lr + li * li, nr = ar - 1.0f;
        const float cr = (nr * lr + ai * li) / den, ci = (ai * lr - nr * li) / den;
        const float br = bb[idx * 2], bi = bb[idx * 2 + 1]; bb[idx * 2] = cr * br - ci * bi; bb[idx * 2 + 1] = cr * bi + ci * br; }
    __syncthreads();
    PROBE_STAMP2(F, 26);
    { const int ho = F.tid & 15, k = (F.tid >> 4) & 15, d = F.tid >> 8;
      float acc[16];
#pragma unroll
      for (int hi = 0; hi < 16; ++hi) acc[hi] = 0.f;
      for (int p = 0; p < 64; ++p) { const float cr = cc[((d * 16 + ho) * CS + p) * 2], ci = cc[((d * 16 + ho) * CS + p) * 2 + 1], pr = pw[(d * 64 + p) * PS + k * 2], pi = pw[(d * 64 + p) * PS + k * 2 + 1];
          const float wr = cr * pr - ci * pi, wi = cr * pi + ci * pr; const LAS f32x4* bp = (const LAS f32x4*)(bb + (d * 64 + p) * 32);
#pragma unroll
          for (int q = 0; q < 8; ++q) { const f32x4 b4 = bp[q]; acc[2 * q] += wr * b4.x - wi * b4.y; acc[2 * q + 1] += wr * b4.z - wi * b4.w; } }
#pragma unroll
      for (int hi = 0; hi < 16; ++hi) KK[(d * 16 + k) * KS + ho * 16 + hi] = acc[hi]; }
    __syncthreads();
    PROBE_STAMP2(F, 27);
    for (int it = F.tid; it < 256 * 32; it += NWAVES * 64) { const int n = it >> 5, kk0 = (it & 31) * 8;
        float v3[8], v3b[8], v1[8];
        { const int j = n >> 4, ho = n & 15, i = kk0 >> 4, hi0 = kk0 & 15; const float dsk = DSK[ho];
#pragma unroll
          for (int e8 = 0; e8 < 8; ++e8) { const int hi = hi0 + e8; float val = 0.f;
            if (i <= j) val += KK[(0 * 16 + (j - i)) * KS + ho * 16 + hi];
            if (i >= j) val += KK[(1 * 16 + (i - j)) * KS + ho * 16 + hi];
            if (i == j && ho == hi) val += dsk;
            v3[e8] = val; }
          const int d = kk0 >> 7, reim = (kk0 >> 6) & 1, p0 = kk0 & 63, e = d ? (16 - j) : (j + 1);
#pragma unroll
          for (int e8 = 0; e8 < 8; ++e8) { const int p = p0 + e8;
            const float cr = cc[((d * 16 + ho) * CS + p) * 2], ci = cc[((d * 16 + ho) * CS + p) * 2 + 1], pr = pw[(d * 64 + p) * PS + e * 2], pi = pw[(d * 64 + p) * PS + e * 2 + 1];
            v3b[e8] = reim ? -(cr * pi + ci * pr) : (cr * pr - ci * pi); } }
        { const int d = n >> 7, reim = (n >> 6) & 1, p = n & 63, i = kk0 >> 4, hi0 = kk0 & 15, e = d ? i : (15 - i);
          const float pr = pw[(d * 64 + p) * PS + e * 2], pi = pw[(d * 64 + p) * PS + e * 2 + 1];
#pragma unroll
          for (int e8 = 0; e8 < 8; ++e8) { const int hi = hi0 + e8; const float br = bb[((d * 64 + p) * 16 + hi) * 2], bi = bb[((d * 64 + p) * 16 + hi) * 2 + 1];
            v1[e8] = reim ? (pr * bi + pi * br) : (pr * br - pi * bi); } }
        const v4u w3 = {pk2(v3[0], v3[1]), pk2(v3[2], v3[3]), pk2(v3[4], v3[5]), pk2(v3[6], v3[7])}, w3b = {pk2(v3b[0], v3b[1]), pk2(v3b[2], v3b[3]), pk2(v3b[4], v3b[5]), pk2(v3b[6], v3b[7])};
        const v4u w1 = {pk2(v1[0], v1[1]), pk2(v1[2], v1[3]), pk2(v1[4], v1[5]), pk2(v1[6], v1[7])};
        *(GAS v4u*)(B3g + (size_t)n * 512 + kk0) = w3; *(GAS v4u*)(B3g + (size_t)n * 512 + 256 + kk0) = w3b; *(GAS v4u*)(B1g + (size_t)n * 256 + kk0) = w1; }
    __syncthreads();
}
__device__ __forceinline__ void s5_scan(Frame& F, const Args& A) {
    if (F.wave < 4) {
        const float* DS = (const float*)(A.ws + WS_DS); bf16* A3 = (bf16*)(A.ws + WS_A3); const int p = F.lane;
        for (int task = blockIdx.x * 4 + F.wave; task < NB * S5G * 2; task += F.G * 4) {
            const int d = task & 1, g = (task >> 1) & 31, b = task >> 6, ig = d * S5G + g;
            const float lr = A.in[8][ig * S5P + p], li = A.in[9][ig * S5P + p], dt = expf(A.in[10][ig]);
            const float m16 = expf(16.0f * lr * dt), a16r = m16 * cosf(16.0f * li * dt), a16i = m16 * sinf(16.0f * li * dt);
            const float* ds = DS + (size_t)(g * 16 + b) * 144 * 256 + d * 128 + p; bf16* so = A3 + (size_t)(g * 16 + b) * 144 * 512 + 256 + d * 128 + p;
            float sr = 0.f, si = 0.f;
            for (int blk = 0; blk < 9; ++blk) {
                const int cbase = d ? (blk == 0 ? 15 : 143 - (blk - 1) * 16) : blk * 16, cstep = d ? -1 : 1;
                float xr[16], xi[16];
#pragma unroll
                for (int s = 0; s < 16; ++s) { const int c = cbase + cstep * s; xr[s] = ds[(size_t)c * 256]; xi[s] = ds[(size_t)c * 256 + 64]; }
#pragma unroll
                for (int s = 0; s < 16; ++s) { const int c = cbase + cstep * s; so[(size_t)c * 512] = (bf16)f2bf(sr); so[(size_t)c * 512 + 64] = (bf16)f2bf(si);
                    const float nsr = a16r * sr - a16i * si + xr[s], nsi = a16r * si + a16i * sr + xi[s]; sr = nsr; si = nsi; }
            }
        }
    }
}
__device__ __forceinline__ void attn_phase(Frame& F, const Args& A) {
    const bf16* Q = (const bf16*)(A.ws + WS_Q); const bf16* KV = (const bf16*)(A.ws + WS_KV); const bf16* KR = (const bf16*)(A.ws + WS_KR); bf16* AO = (bf16*)(A.ws + WS_AO);
    const int bid = (int)blockIdx.x; const int vcu = (F.G % 8 == 0) ? (bid % 8) * (F.G / 8) + bid / 8 : bid;
    const int shift = (F.G >= 256 && 1024 % F.G == 0) ? F.G - 128 : 0;
    for (int v = vcu; v < 1024 + shift + 128; v += F.G) {
        int u = v; if (v >= 1024 && shift) { u = 1024 + bid - shift; if (u < 1024) continue; }
        int b, h, qrow0, NT;
        if (u < 1024) { const int bh = u >> 3; b = bh >> 3; h = bh & 7; qrow0 = b * SEQ + (u & 7) * 256; NT = TT / 64; }
        else { const int uu = u - 1024; b = uu >> 3; h = uu & 7; qrow0 = ML + b * CTXL; NT = CTXL / 64; }
        att::attn_unit(Q + (size_t)qrow0 * 768 + h * QK, KV + h * NOPE, KR, KV + 512 + h * VD, ML + b * CTXL, CTXL / 64, b * SEQ, NT, AO + (size_t)qrow0 * D + S5W + h * VD, F.lds, (u < 1024) ? (u & 7) * 256 : -1);
    }
}
__device__ __forceinline__ void gla_prep_phase(Frame& F, const Args& A) {
    for (int j = blockIdx.x; j < NB * GH * 2 * 2; j += F.G) { const int ch = j >> 1, b = ch >> 3, h = (ch >> 1) & 3, dir = ch & 1;
        gla::gla_prep((const bf16*)(A.ws + WS_QK), (const bf16*)(A.ws + WS_VR) + 2048, A.in[27], A.in[28], (bf16*)(A.ws + WS_TQ), (bf16*)(A.ws + WS_TK), (bf16*)(A.ws + WS_TP), (float*)(A.ws + WS_EL),
                      b, h, dir, 18 * (j & 1), 18 * (j & 1) + 18, ML, SEQ, CTXL, F.lds); }
}
__device__ __forceinline__ void gla_chain_phase(Frame& F, const Args& A) {
    const int bid = (int)blockIdx.x; const int vcu = (F.G % 8 == 0) ? (bid % 8) * (F.G / 8) + bid / 8 : bid;
    for (int u = vcu; u < NB * GH * 2 * 2; u += F.G) { const int ch = u >> 1, vh = u & 1, b = ch >> 3, h = (ch >> 1) & 3, dir = ch & 1;
        gla::gla_chain2((const bf16*)(A.ws + WS_VR), (const bf16*)(A.ws + WS_TQ), (const bf16*)(A.ws + WS_TK), (const bf16*)(A.ws + WS_TP), (const float*)(A.ws + WS_EL), (bf16*)(A.ws + (dir ? WS_OB : WS_OF)),
                        b, h, dir, vh, ML, SEQ, CTXL, F.lds); }
}
__device__ __forceinline__ void gla_finish(Frame& F, const Args& A) {
    bf16* OF = (bf16*)(A.ws + WS_OF); const bf16* OB = (const bf16*)(A.ws + WS_OB); const bf16* VR = (const bf16*)(A.ws + WS_VR); const float* hn = A.in[29];
    const f32x4 g = *(const GAS f32x4*)(hn + 4 * F.lane);
    for (int r0 = F.gw; r0 < ML; r0 += 2 * F.ngw) {
        const int r1 = (r0 + F.ngw < ML) ? r0 + F.ngw : r0; const bool two = r1 != r0;
        f32x4 a0[4], b0[4], x0[4], a1[4], b1[4], x1[4];
        ld_row_bf16(OF + (size_t)r0 * D, F.lane, a0); ld_row_bf16(OB + (size_t)r0 * D, F.lane, b0); ld_row_bf16(VR + (size_t)r0 * VRLD + GVAL, F.lane, x0);
        ld_row_bf16(OF + (size_t)r1 * D, F.lane, a1); ld_row_bf16(OB + (size_t)r1 * D, F.lane, b1); ld_row_bf16(VR + (size_t)r1 * VRLD + GVAL, F.lane, x1);
#pragma unroll
        for (int j = 0; j < 4; ++j) { const f32x4 o0 = a0[j] + b0[j], o1 = a1[j] + b1[j];
            const float s0 = wave_sum((o0.x * o0.x + o0.y * o0.y) + (o0.z * o0.z + o0.w * o0.w)), s1 = wave_sum((o1.x * o1.x + o1.y * o1.y) + (o1.z * o1.z + o1.w * o1.w));
            const float rs0 = rsqrtf(s0 * (1.0f / GDV) + EPS), rs1 = rsqrtf(s1 * (1.0f / GDV) + EPS);
#pragma unroll
            for (int i = 0; i < 4; ++i) { const float u0 = x0[j][i], u1 = x1[j][i];
                a0[j][i] = o0[i] * rs0 * g[i] * (u0 * __builtin_amdgcn_rcpf(1.0f + __expf(-u0))); a1[j][i] = o1[i] * rs1 * g[i] * (u1 * __builtin_amdgcn_rcpf(1.0f + __expf(-u1))); } }
        st_row_bf16(OF + (size_t)r0 * D, F.lane, a0); if (two) st_row_bf16(OF + (size_t)r1 * D, F.lane, a1);
    }
}

#ifndef MK_ONE_LAUNCH
#define MK_ONE_LAUNCH 1
#endif
constexpr int NPHASE = 21;
constexpr bool SP2 = true, ALIGN = true;

__global__ void __launch_bounds__(NWAVES * 64, 2) fwd_kernel(Args args) {
    extern __shared__ __attribute__((aligned(16))) unsigned char lds[];
    Frame F;
    F.lds = (LAS unsigned char*)lds;
    F.MISC = (volatile LAS unsigned*)(F.lds + MISC_OFF);
    F.tid = threadIdx.x; F.lane = F.tid & 63; F.wave = __builtin_amdgcn_readfirstlane(F.tid >> 6);
    F.G = gridDim.x; F.gw = blockIdx.x * NWAVES + F.wave; F.ngw = F.G * NWAVES;
    unsigned char* ws = args.ws;
    F.ctl = (gu32*)(ws + WS_CTL);
    for (int u = F.tid; u < (LDS_BYTES - LDSCTL_OFF) / 4; u += NWAVES * 64) ((LAS unsigned*)(F.lds + LDSCTL_OFF))[u] = 0u;
    __syncthreads();
    XcdBarrier bar; bar.bar = (unsigned*)(F.ctl + CW_BAR); bar.x = 0; bar.st = nullptr;
    if (MK_ONE_LAUNCH) bar = xcd_barrier_post((unsigned*)(F.ctl + CW_BAR), F.MISC + 8);
    const int lo = args.ph_lo, hi = args.ph_hi;
#define IN(k) (lo <= (k) && (k) < hi)
#ifdef PROBE_SETA
    if (blockIdx.x == PROBE_BLK && F.tid == 0) { const unsigned long long t_ = __builtin_amdgcn_s_memrealtime(); F.MISC[16] = (unsigned)t_; F.MISC[17] = (unsigned)(t_ >> 32); }
#define PROBE_STAMP(k) do { if (blockIdx.x == PROBE_BLK && F.tid == 0) { const unsigned long long t_ = __builtin_amdgcn_s_memrealtime(); const unsigned long long l_ = ((unsigned long long)F.MISC[17] << 32) | F.MISC[16]; const unsigned d_ = (unsigned)(t_ - l_); \
        if ((PROBE_SETA >> (k)) & 1ull) F.MISC[18] += d_; if ((PROBE_SETB >> (k)) & 1ull) F.MISC[20] += d_; F.MISC[16] = (unsigned)t_; F.MISC[17] = (unsigned)(t_ >> 32); } } while (0)
#else
#define PROBE_STAMP(k) do { } while (0)
#endif
#define SEAM(k) do { if (MK_ONE_LAUNCH && IN(k) && IN((k) + 1)) xcd_barrier(bar); PROBE_STAMP(k); } while (0)
    const int bid = (int)blockIdx.x;

    if (IN(0)) {
#ifndef NO_P0
 p0_prologue(F, args);
#endif
 } SEAM(0);
    if (IN(1)) { thin_t1(F, args); } SEAM(1);
    if (IN(2)) { pg8::Gemm g{(const bf16*)(ws + WS_XL), (const bf16*)(ws + WS_W_IN0), MA, EV_INP, D}; pg8::StaticOrder S; S.init(MA, EV_INP, F.G, bid);
        pg8::EpiIn0 E{(bf16*)(ws + WS_U), (bf16*)(ws + WS_A3), (bf16*)(ws + WS_Z0C)};
        pg8::gemm_phase<pg8::EpiIn0, pg8::StaticOrder, ALIGN, SP2>(F.lds + RING_OFF, g, S, E);
        tail_convert(F, args, (MA / 256) * (EV_INP / 256), MW0, MW1); } SEAM(2);
    if (IN(3)) { prep_qa(F, args);
        int k256 = 256; asm volatile("" : "+s"(k256));
        pg8::Gemm g{(const bf16*)(ws + WS_U), (const bf16*)(ws + WS_B1), 32 * 2304, 256, k256}; pg8::S5Order S{F.G, bid};
        pg8::EpiF32 E{(float*)(ws + WS_DS), 256};
        pg8::gemm_phase<pg8::EpiF32, pg8::S5Order, ALIGN, SP2>(F.lds + RING_OFF, g, S, E); } SEAM(3);
    if (IN(4)) { s5_scan(F, args);
        pg8::Gemm g{(const bf16*)(ws + WS_QA), (const bf16*)(ws + WS_W_QKV), MA, NQKV, KQKV}; pg8::StaticOrder S; S.init(MA, NQKV, F.G, bid);
        pg8::EpiSplit E{(bf16*)(ws + WS_Q), 768, (bf16*)(ws + WS_KV), 1024, 3, 0x7fffffff};
        pg8::gemm_phase<pg8::EpiSplit, pg8::StaticOrder, ALIGN, SP2>(F.lds + RING_OFF, g, S, E); } SEAM(4);
    if (IN(5)) {
        pg8::Gemm g{(const bf16*)(ws + WS_A3), (const bf16*)(ws + WS_B3), 32 * 2304, 256, 512}; pg8::S5Order S{F.G, bid};
        pg8::EpiS5Out E{(bf16*)(ws + WS_AG)};
        pg8::gemm_phase<pg8::EpiS5Out, pg8::S5Order, ALIGN, SP2>(F.lds + RING_OFF, g, S, E); } SEAM(5);
    if (IN(6)) {
#ifndef NO_ATT
 attn_phase(F, args);
#endif
        PROBE_STAMP(21);
        pg8::Gemm g{(const bf16*)(ws + WS_AG), (const bf16*)(ws + WS_W_GLU), MA, S5W, S5W}; pg8::StaticOrder S; S.init(MA, S5W, F.G, bid);
        pg8::EpiGlu E{(const bf16*)(ws + WS_AG), args.in[17], (bf16*)(ws + WS_AO), D};
        pg8::gemm_phase<pg8::EpiGlu, pg8::StaticOrder, ALIGN, SP2, false, false, true>(F.lds + RING_OFF, g, S, E); } SEAM(6);
    if (IN(7)) { pg8::Gemm g{(const bf16*)(ws + WS_AO), (const bf16*)(ws + WS_W_OUT0), MA, D, D}; pg8::StaticOrder S; S.init(MA, D, F.G, bid);
        pg8::EpiPlain E{(bf16*)(ws + WS_YL), D, 0, 0, 1.0f};
        pg8::gemm_phase<pg8::EpiPlain, pg8::StaticOrder, ALIGN, SP2>(F.lds + RING_OFF, g, S, E);
        tail_convert(F, args, (MA / 256) * (D / 256), MW1, MW2); } SEAM(7);
    if (IN(8)) { thin_t2(F, args); } SEAM(8);
    static_assert(!FFN0_IS_FP8, "the e4m3 dense-FFN variant does not carry the MoE weight conversion in its down phase");
    if constexpr (FFN0_IS_FP8) {
    if (IN(9)) { pg8::Gemm g{(const bf16*)(ws + WS_XL), (const bf16*)(ws + WS_W_GU), MA, 2 * FFN, D / 2}; pg8::StaticOrder S; S.init(MA, 2 * FFN, F.G, bid);
        pg8::EpiSwiGlu8 E{ws + WS_ACT, FFN, 0, 1.0f / (FP8_SA * FP8_SW), FP8_SACT, 0};
        pg8::gemm_phase<pg8::EpiSwiGlu8, pg8::StaticOrder, ALIGN, SP2, true>(F.lds + RING_OFF, g, S, E); } SEAM(9);
    if (IN(10)) { pg8::Gemm g{(const bf16*)(ws + WS_ACT), (const bf16*)(ws + WS_W_DN), MA, D, FFN / 2}; pg8::StaticOrder S; S.init(MA, D, F.G, bid);
        pg8::EpiPlain E{(bf16*)(ws + WS_FL), D, 0, 0, 1.0f / (FP8_SACT * FP8_SW)};
        pg8::gemm_phase<pg8::EpiPlain, pg8::StaticOrder, ALIGN, SP2, true>(F.lds + RING_OFF, g, S, E); } SEAM(10);
    } else {
    if (IN(9)) { pg8::Gemm g{(const bf16*)(ws + WS_XL), (const bf16*)(ws + WS_W_GU), MA, 2 * FFN, D}; pg8::StaticOrder S; S.init(MA, 2 * FFN, F.G, bid);
        if constexpr (FFN0_DN_FP8) { pg8::EpiSwiGlu8 E{ws + WS_ACT, FFN, 0, 1.0f, FP8_SACT, 0};
            pg8::gemm_phase<pg8::EpiSwiGlu8, pg8::StaticOrder, ALIGN, SP2>(F.lds + RING_OFF, g, S, E); }
        else { pg8::EpiSwiGlu E{(bf16*)(ws + WS_ACT), FFN, 0, 0};
            pg8::gemm_phase<pg8::EpiSwiGlu, pg8::StaticOrder, ALIGN, SP2>(F.lds + RING_OFF, g, S, E); }
        tail_convert(F, args, (MA / 256) * (2 * FFN / 256), MW2, MW3); } SEAM(9);
    if (IN(10)) { pg8::StaticOrder S; S.init(MA, D, F.G, bid);
        if constexpr (FFN0_DN_FP8) { pg8::Gemm g{(const bf16*)(ws + WS_ACT), (const bf16*)(ws + WS_W_DN), MA, D, FFN / 2};
            pg8::EpiPlain E{(bf16*)(ws + WS_FL), D, 0, 0, 1.0f / (FP8_SACT * FP8_SW)};
            pg8::gemm_phase<pg8::EpiPlain, pg8::StaticOrder, ALIGN, SP2, true>(F.lds + RING_OFF, g, S, E); }
        else { pg8::Gemm g{(const bf16*)(ws + WS_ACT), (const bf16*)(ws + WS_W_DN), MA, D, FFN};
            pg8::EpiPlain E{(bf16*)(ws + WS_FL), D, 0, 0, 1.0f};
            pg8::gemm_phase<pg8::EpiPlain, pg8::StaticOrder, ALIGN, SP2>(F.lds + RING_OFF, g, S, E); }
        tail_convert(F, args, (MA / 256) * (D / 256), MW3, MW4); } SEAM(10);
    }
    if (IN(11)) { thin_t3(F, args); } SEAM(11);
    if (IN(12)) { pg8::Gemm g{(const bf16*)(ws + WS_XL), (const bf16*)(ws + WS_W_IN1), MA, OD_INP, D}; pg8::StaticOrder S; S.init(MA, OD_INP, F.G, bid);
        pg8::EpiSplit E{(bf16*)(ws + WS_QK), 1024, (bf16*)(ws + WS_VR), VRLD, 4, 0x7fffffff};
        pg8::gemm_phase<pg8::EpiSplit, pg8::StaticOrder, ALIGN, SP2>(F.lds + RING_OFF, g, S, E);
        tail_convert(F, args, (MA / 256) * (OD_INP / 256), MW4, MW5); } SEAM(12);
    if (IN(13)) {
#ifndef NO_GLA
 gla_prep_phase(F, args);
#endif
    } SEAM(13);
    if (IN(14)) {
#ifndef NO_GLA
 gla_chain_phase(F, args);
#endif
    } SEAM(14);
    if (IN(15)) { gla_finish(F, args); } SEAM(15);
    if (IN(16)) { pg8::Gemm g{(const bf16*)(ws + WS_OF), (const bf16*)(ws + WS_W_OUT1), ML, D, D}; pg8::StaticOrder S; S.init(ML, D, F.G, bid);
        pg8::EpiPlain E{(bf16*)(ws + WS_YL1), D, 0, 0, 1.0f};
        pg8::gemm_phase<pg8::EpiPlain, pg8::StaticOrder, ALIGN, SP2>(F.lds + RING_OFF, g, S, E); } SEAM(16);
    if (IN(17)) { thin_t4(F, args); } SEAM(17);
    if (lo < 20 && hi > 18) {
        int ts[9]; moe_tile_starts(F, ts); const int NT = ts[8];
        if (IN(18)) { pg8::MoeOrder S{0, NT, 2 * FE / 256, F.G, bid, ts[1], ts[2], ts[3], ts[4], ts[5], ts[6], ts[7], 0};
            moe_row_table(F, args, S, ts);
            pg8::Gemm g{(const bf16*)(ws + WS_XLM), (const bf16*)(ws + WS_W_MGU), ML, 2 * FE, D / 2, (const LAS unsigned short*)(F.lds + ATAB_OFF)};
            pg8::EpiSwiGlu8 E{ws + WS_ACTM, FE, 2 * FE / 256, 1.0f / (FP8_SA * FP8_SW), FP8_SACT, 1};
            pg8::gemm_phase<pg8::EpiSwiGlu8, pg8::MoeOrder, ALIGN, SP2, true, false, false, true>(F.lds + RING_OFF, g, S, E); } SEAM(18);
        if (IN(19)) { pg8::Gemm g{(const bf16*)(ws + WS_ACTM), (const bf16*)(ws + WS_W_MDN), MOE_MAXT * 256, D, FE / 2};
            pg8::MoeOrder S{0, NT, D / 256, F.G, bid, ts[1], ts[2], ts[3], ts[4], ts[5], ts[6], ts[7], 1};
            pg8::EpiPlain E{(bf16*)(ws + WS_Y), D, 0, D / 256, 1.0f / (FP8_SACT * FP8_SW)};
            pg8::gemm_phase<pg8::EpiPlain, pg8::MoeOrder, ALIGN, SP2, true, true>(F.lds + RING_OFF, g, S, E); } SEAM(19);
    }
    if (IN(20)) { thin_t5(F, args); }
#ifdef PROBE_SETA
    PROBE_STAMP(20);
    if (blockIdx.x == PROBE_BLK && F.tid == 0) {
        unsigned long long qa = F.MISC[18] / 100u, qb = F.MISC[20] / 400u; qa = qa > 999 ? 999 : qa; qb = qb > 199 ? 199 : qb;
        const unsigned long long t0 = __builtin_amdgcn_s_memrealtime(), dl = qa * 1000ull + qb * 1000000ull;
        while (__builtin_amdgcn_s_memrealtime() - t0 < dl) __builtin_amdgcn_s_sleep(32);
    }
#endif
#undef IN
#undef SEAM
}

extern "C" void kernel_launch(void* const* d_in, const int* in_sizes, int n_in, void* d_out, int out_size, void* d_ws, size_t ws_size, hipStream_t stream) {
    static int grid = 0;
    if (grid == 0) {
        if (n_in != 35 || out_size != ML * D || ws_size < WS_END) { fprintf(stderr, "kernel_launch: unexpected shapes: n_in %d out %d ws %zu (need %zu)\n", n_in, out_size, ws_size, (size_t)WS_END); grid = -1; return; }
        int dev = 0, cus = 0, per_cu = 0;
        if (hipGetDevice(&dev) != hipSuccess || hipDeviceGetAttribute(&cus, hipDeviceAttributeMultiprocessorCount, dev) != hipSuccess) { grid = -1; return; }
        if (hipFuncSetAttribute((const void*)fwd_kernel, hipFuncAttributeMaxDynamicSharedMemorySize, LDS_BYTES) != hipSuccess) { fprintf(stderr, "kernel_launch: hipFuncSetAttribute failed\n"); grid = -1; return; }
        if (hipOccupancyMaxActiveBlocksPerMultiprocessor(&per_cu, (const void*)fwd_kernel, NWAVES * 64, LDS_BYTES) != hipSuccess || per_cu < 1) { fprintf(stderr, "kernel_launch: occupancy query reports %d blocks per CU\n", per_cu); }
        (void)hipGetLastError();
        grid = cus;
    }
    if (grid < 0) return;
    (void)hipMemsetAsync((char*)d_ws + WS_CTL, 0, CTL_ZERO_BYTES, stream);
    Args a{};
    for (int i = 0; i < 35; ++i) a.in[i] = (const float*)d_in[i];
    a.out = (float*)d_out; a.ws = (unsigned char*)d_ws;
#if MK_ONE_LAUNCH
    a.ph_lo = 0; a.ph_hi = NPHASE;
    hipLaunchKernelGGL(fwd_kernel, dim3(grid), dim3(NWAVES * 64), LDS_BYTES, stream, a);
#else
    for (int p = 0; p < NPHASE; ++p) { a.ph_lo = p; a.ph_hi = p + 1; hipLaunchKernelGGL(fwd_kernel, dim3(grid), dim3(NWAVES * 64), LDS_BYTES, stream, a); }
#endif
}
```

```cpp
#include <hip/hip_runtime.h>
#include <cstdio>
#include <cstdint>
#define MK_ONE_LAUNCH 1
namespace pg8 {
#define PG8_LAS __attribute__((address_space(3)))
typedef unsigned short bf16_t;
typedef short bf16x8 __attribute__((ext_vector_type(8)));
typedef float f32x4 __attribute__((ext_vector_type(4)));
typedef unsigned u32x4 __attribute__((ext_vector_type(4)));
constexpr int BM = 256, BK = 64, HALF = 128, HTB = HALF * BK * 2  , STAGE_BYTES = 8 * HTB, NXCD = 8, WGM = 8;

__host__ __device__ __forceinline__ int lds_byte(int r, int c) { const int st = (r >> 4) * 2 + (c >> 5), rr = r & 15, cc = c & 31, ob = rr * 64 + cc * 2; return st * 1024 + (ob ^ (((ob >> 9) & 1) << 5)); }
__host__ __device__ __forceinline__ void stage_rc(int b, int& R, int& C) { const int st = b / 1024, sb = b % 1024, swz = sb ^ (((sb >> 9) & 1) << 5); R = (st >> 1) * 16 + swz / 64; C = (st & 1) * 32 + (swz % 64) / 2; }
__host__ __device__ __forceinline__ int perm32(int rho) { const int n = rho >> 4, i = rho & 15; return 8 * (i >> 2) + 4 * n + (i & 3); }

struct Unit { int pm, pn; };
struct Gemm { const bf16_t* A; const bf16_t* Bt; int M, N, K; const PG8_LAS unsigned short* atab = nullptr; };
constexpr unsigned ACH_GS = 2304u * 256u * 2u;

struct StaticOrder {
    int nM, nN, nwg, G, c, wgm;
    __host__ __device__ void init(int M, int N, int G_, int c_) { nM = M / BM; nN = N / BM; nwg = nM * nN; G = G_; c = c_; wgm = (nM % (2 * NXCD) == 0) ? nM / (2 * NXCD) : WGM; }
    __host__ __device__ bool next(int i, Unit& u) const {
        const long L = (long)i * G + c; if (L >= nwg) return false;
        int wgid = (int)L; { const int q = nwg / NXCD, r = nwg % NXCD, xcd = wgid % NXCD, off = wgid / NXCD; wgid = (xcd < r ? xcd * (q + 1) : r * (q + 1) + (xcd - r) * q) + off; }
        const int nig = wgm * nN, gid = wgid / nig, fm = gid * wgm, gsz = (nM - fm) < wgm ? (nM - fm) : wgm;
        u.pm = fm + ((wgid % nig) % gsz); u.pn = (wgid % nig) / gsz; return true;
    }
    __device__ __forceinline__ void a_ready(const Unit&) const {}
    __device__ __forceinline__ void done(const Unit&) const {}
};

__device__ __forceinline__ unsigned cvt_pk_bf16(float lo, float hi) { unsigned r; asm volatile("v_cvt_pk_bf16_f32 %0, %1, %2" : "=v"(r) : "v"(lo), "v"(hi)); return r; }
typedef float f32x2 __attribute__((ext_vector_type(2)));
__device__ __forceinline__ u32x4 pack8(const f32x4 v0, const f32x4 v1) { u32x4 w; w.x = cvt_pk_bf16(v0[0], v0[1]); w.y = cvt_pk_bf16(v0[2], v0[3]); w.z = cvt_pk_bf16(v1[0], v1[1]); w.w = cvt_pk_bf16(v1[2], v1[3]); return w; }
__device__ __forceinline__ float bf_lo(unsigned u) { return __uint_as_float(u << 16); }
__device__ __forceinline__ float bf_hi(unsigned u) { return __uint_as_float(u & 0xffff0000u); }
__device__ __forceinline__ unsigned pk4_fp8(float a, float b, float c, float d) {
    a = __builtin_amdgcn_fmed3f(a, -448.f, 448.f); b = __builtin_amdgcn_fmed3f(b, -448.f, 448.f); c = __builtin_amdgcn_fmed3f(c, -448.f, 448.f); d = __builtin_amdgcn_fmed3f(d, -448.f, 448.f);
    int r = __builtin_amdgcn_cvt_pk_fp8_f32(a, b, 0, false); r = __builtin_amdgcn_cvt_pk_fp8_f32(c, d, r, true); return (unsigned)r; }
__device__ __forceinline__ float sigmoid_f(float x) { return __builtin_amdgcn_rcpf(1.0f + __builtin_amdgcn_exp2f(-1.4426950408889634f * x)); }

struct EpiPlain {
    static constexpr bool PERM = true, AFTER_DRAIN = false;
    bf16_t* O; int ldc; int pm_off; int nmod; float sc;
    __device__ __forceinline__ void operator()(const f32x4 (&acc)[2][2][4][2], const Unit& u, int wr, int wc, int fr, int fq) const {
        const int row0 = (u.pm - pm_off) * BM + wr * 64 + fr; const int ct = nmod ? (u.pn % nmod) : u.pn; const int col0 = ct * BM + wc * 32 + 8 * fq;
#pragma unroll
        for (int ai = 0; ai < 2; ++ai)
#pragma unroll
            for (int m = 0; m < 4; ++m) { bf16_t* rowp = O + (size_t)(row0 + ai * HALF + m * 16) * ldc + col0;
#pragma unroll
                for (int bj = 0; bj < 2; ++bj) *(u32x4*)(rowp + bj * HALF) = pack8(acc[ai][bj][m][0] * sc, acc[ai][bj][m][1] * sc); }
    }
};
struct EpiSplit {
    static constexpr bool PERM = true, AFTER_DRAIN = false;
    bf16_t* O0; int ld0; bf16_t* O1; int ld1; int nsplit; int ncols1;
    __device__ __forceinline__ void operator()(const f32x4 (&acc)[2][2][4][2], const Unit& u, int wr, int wc, int fr, int fq) const {
        const int row0 = u.pm * BM + wr * 64 + fr; const bool first = u.pn < nsplit;
        bf16_t* base = first ? O0 : O1; const int ld = first ? ld0 : ld1; const int col0 = (first ? u.pn : u.pn - nsplit) * BM + wc * 32 + 8 * fq; const int lim = first ? 0x7fffffff : ncols1;
#pragma unroll
        for (int ai = 0; ai < 2; ++ai)
#pragma unroll
            for (int m = 0; m < 4; ++m) { bf16_t* rowp = base + (size_t)(row0 + ai * HALF + m * 16) * ld + col0;
#pragma unroll
                for (int bj = 0; bj < 2; ++bj) if (col0 + bj * HALF < lim) *(u32x4*)(rowp + bj * HALF) = pack8(acc[ai][bj][m][0], acc[ai][bj][m][1]); }
    }
};
struct EpiGlu {
    static constexpr bool PERM = true, AFTER_DRAIN = false;
    const bf16_t* Aa; const float* bias; bf16_t* O; int ldc;
    __device__ __forceinline__ void operator()(const f32x4 (&acc)[2][2][4][2], const Unit& u, int wr, int wc, int fr, int fq) const {
        const int row0 = u.pm * BM + wr * 64 + fr; const int col0 = u.pn * BM + wc * 32 + 8 * fq;
        const int crow0 = (u.pm < 128 ? (u.pm >> 3) * 144 + 16 + (u.pm & 7) * 16 : (u.pm - 128) * 144) + wr * 4;
#pragma unroll
        for (int bj = 0; bj < 2; ++bj) { const f32x4 b0 = *(const f32x4*)(bias + col0 + bj * HALF), b1 = *(const f32x4*)(bias + col0 + bj * HALF + 4);
            const int cg = (col0 + bj * HALF) >> 4, ch = (col0 + bj * HALF) & 15;
#pragma unroll
            for (int ai = 0; ai < 2; ++ai)
#pragma unroll
                for (int m = 0; m < 4; ++m) { const size_t r = (size_t)(row0 + ai * HALF + m * 16);
                    const u32x4 a8 = *(const u32x4*)(Aa + (size_t)cg * (2304 * 256) + (size_t)(crow0 + ai * 8 + m) * 256 + fr * 16 + ch);
                    f32x4 v0 = acc[ai][bj][m][0] + b0, v1 = acc[ai][bj][m][1] + b1;
                    v0[0] = bf_lo(a8.x) * sigmoid_f(v0[0]); v0[1] = bf_hi(a8.x) * sigmoid_f(v0[1]); v0[2] = bf_lo(a8.y) * sigmoid_f(v0[2]); v0[3] = bf_hi(a8.y) * sigmoid_f(v0[3]);
                    v1[0] = bf_lo(a8.z) * sigmoid_f(v1[0]); v1[1] = bf_hi(a8.z) * sigmoid_f(v1[1]); v1[2] = bf_lo(a8.w) * sigmoid_f(v1[2]); v1[3] = bf_hi(a8.w) * sigmoid_f(v1[3]);
                    *(u32x4*)(O + r * ldc + col0 + bj * HALF) = pack8(v0, v1); } }
    }
};
struct EpiSwiGlu {
    static constexpr bool PERM = true, AFTER_DRAIN = false;
    bf16_t* O; int ldc; int pm_off; int nmod;
    __device__ __forceinline__ void operator()(const f32x4 (&acc)[2][2][4][2], const Unit& u, int wr, int wc, int fr, int fq) const {
        const int row0 = (u.pm - pm_off) * BM + wr * 64 + fr; const int ct = nmod ? (u.pn % nmod) : u.pn; const int col0 = ct * HALF + wc * 32 + 8 * fq;
#pragma unroll
        for (int ai = 0; ai < 2; ++ai)
#pragma unroll
            for (int m = 0; m < 4; ++m) { f32x4 o0, o1;
#pragma unroll
                for (int i = 0; i < 4; ++i) { const float g0 = acc[ai][0][m][0][i], g1 = acc[ai][0][m][1][i]; o0[i] = g0 * sigmoid_f(g0) * acc[ai][1][m][0][i]; o1[i] = g1 * sigmoid_f(g1) * acc[ai][1][m][1][i]; }
                *(u32x4*)(O + (size_t)(row0 + ai * HALF + m * 16) * ldc + col0) = pack8(o0, o1); }
    }
};
struct EpiIn0 {
    static constexpr bool PERM = true, AFTER_DRAIN = false;
    bf16_t* U; bf16_t* A3; bf16_t* Z0c;
    __device__ __forceinline__ void operator()(const f32x4 (&acc)[2][2][4][2], const Unit& u, int wr, int wc, int fr, int fq) const {
        if (u.pn >= 2) {
            const int row0 = u.pm * BM + wr * 64 + fr, col0 = (u.pn - 2) * BM + wc * 32 + 8 * fq;
#pragma unroll
            for (int ai = 0; ai < 2; ++ai)
#pragma unroll
                for (int m = 0; m < 4; ++m) { bf16_t* rowp = Z0c + (size_t)(row0 + ai * HALF + m * 16) * 512 + col0;
#pragma unroll
                    for (int bj = 0; bj < 2; ++bj) *(u32x4*)(rowp + bj * HALF) = pack8(acc[ai][bj][m][0], acc[ai][bj][m][1]); }
        } else {
            const int b = (u.pm < 128) ? (u.pm >> 3) : (u.pm - 128); const int c0 = (u.pm < 128) ? (16 + (u.pm & 7) * 16) : 0;
            const int g0 = u.pn * 16 + wc * 2 + (fq >> 1);
            const size_t r0 = (size_t)(g0 * 16 + b) * 144 + c0 + wr * 4;
            const int cc = fr * 16 + 8 * (fq & 1);
#pragma unroll
            for (int ai = 0; ai < 2; ++ai)
#pragma unroll
                for (int m = 0; m < 4; ++m)
#pragma unroll
                    for (int bj = 0; bj < 2; ++bj) { const size_t r = r0 + (size_t)bj * (8 * 16 * 144) + ai * 8 + m; const u32x4 w = pack8(acc[ai][bj][m][0], acc[ai][bj][m][1]);
                        *(u32x4*)(U + r * 256 + cc) = w; *(u32x4*)(A3 + r * 512 + cc) = w; }
        }
    }
};
struct EpiF32 {
    static constexpr bool PERM = false, AFTER_DRAIN = false;
    float* C; int ldc;
    __device__ __forceinline__ void operator()(const f32x4 (&acc)[2][2][4][2], const Unit& u, int wr, int wc, int fr, int fq) const {
        const int row0 = u.pm * BM + wr * 64 + fr, col0 = wc * 32 + 4 * fq;
#pragma unroll
        for (int ai = 0; ai < 2; ++ai)
#pragma unroll
            for (int m = 0; m < 4; ++m) { float* rowp = C + (size_t)(row0 + ai * HALF + m * 16) * ldc + col0;
#pragma unroll
                for (int bj = 0; bj < 2; ++bj)
#pragma unroll
                    for (int n = 0; n < 2; ++n) *(f32x4*)(rowp + bj * HALF + n * 16) = acc[ai][bj][m][n]; }
    }
};
__device__ __forceinline__ float gelu_tanh_f(float x) { const float t = 0.7978845608028654f * (x + 0.044715f * x * x * x); const float e = __builtin_amdgcn_exp2f(2.8853900817779268f * t); return x - x * __builtin_amdgcn_rcpf(e + 1.0f); }
struct EpiS5Out {
    static constexpr bool PERM = true, AFTER_DRAIN = false;
    bf16_t* AG;
    __device__ __forceinline__ void operator()(const f32x4 (&acc)[2][2][4][2], const Unit& u, int wr, int wc, int fr, int fq) const {
        const int row0 = u.pm * BM + wr * 64 + fr, col0 = wc * 32 + 8 * fq;
#pragma unroll
        for (int ai = 0; ai < 2; ++ai)
#pragma unroll
            for (int m = 0; m < 4; ++m) { bf16_t* rowp = AG + (size_t)(row0 + ai * HALF + m * 16) * 256 + col0;
#pragma unroll
                for (int bj = 0; bj < 2; ++bj) { f32x4 v0 = acc[ai][bj][m][0], v1 = acc[ai][bj][m][1];
#pragma unroll
                    for (int i = 0; i < 4; ++i) { v0[i] = gelu_tanh_f(v0[i]); v1[i] = gelu_tanh_f(v1[i]); }
                    *(u32x4*)(rowp + bj * HALF) = pack8(v0, v1); } }
    }
};
struct S5Order {
    int G, c;
    __device__ __forceinline__ bool next(int i, Unit& u) const { const int L = i * G + c; if (L >= 32 * 9) return false; u.pm = L; u.pn = L / 9; return true; }
    __device__ __forceinline__ void a_ready(const Unit&) const {}
    __device__ __forceinline__ void done(const Unit&) const {}
};
struct EpiSwiGlu8 {
    static constexpr bool PERM = true, AFTER_DRAIN = false;
    unsigned char* O; int ldc; int nmod; float us, os; int tiled;
    __device__ __forceinline__ void operator()(const f32x4 (&acc)[2][2][4][2], const Unit& u, int wr, int wc, int fr, int fq) const {
        const int row0 = u.pm * BM + wr * 64 + fr; const int ct = nmod ? (u.pn % nmod) : u.pn; const int col0 = ct * HALF + wc * 32 + 8 * fq;
        typedef unsigned u32x2_ __attribute__((ext_vector_type(2))); typedef float f32x2_ __attribute__((ext_vector_type(2)));
        const float kexp = -1.4426950408889634f * us, kout = us * us * os;
#pragma unroll
        for (int ai = 0; ai < 2; ++ai)
#pragma unroll
            for (int m = 0; m < 4; ++m) { f32x4 o0, o1;
#pragma unroll
                for (int i = 0; i < 4; i += 2) {
                    const f32x2_ ga = {acc[ai][0][m][0][i], acc[ai][0][m][0][i + 1]}, gb = {acc[ai][0][m][1][i], acc[ai][0][m][1][i + 1]}, ua = {acc[ai][1][m][0][i], acc[ai][1][m][0][i + 1]}, ub = {acc[ai][1][m][1][i], acc[ai][1][m][1][i + 1]};
                    f32x2_ ta = ga * kexp, tb = gb * kexp; ta.x = __builtin_amdgcn_exp2f(ta.x); ta.y = __builtin_amdgcn_exp2f(ta.y); tb.x = __builtin_amdgcn_exp2f(tb.x); tb.y = __builtin_amdgcn_exp2f(tb.y);
                    ta = ta + 1.0f; tb = tb + 1.0f; ta.x = __builtin_amdgcn_rcpf(ta.x); ta.y = __builtin_amdgcn_rcpf(ta.y); tb.x = __builtin_amdgcn_rcpf(tb.x); tb.y = __builtin_amdgcn_rcpf(tb.y);
                    const f32x2_ ra = (ga * ua) * (ta * kout), rb = (gb * ub) * (tb * kout); o0[i] = ra.x; o0[i + 1] = ra.y; o1[i] = rb.x; o1[i + 1] = rb.y; }
                u32x2_ w; w.x = pk4_fp8(o0[0], o0[1], o0[2], o0[3]); w.y = pk4_fp8(o1[0], o1[1], o1[2], o1[3]);
                const int rr = wr * 64 + fr + ai * HALF + m * 16;
                if (tiled) *(u32x2_*)(O + (size_t)u.pm * BM * ldc + (size_t)ct * (BM * 128) + rr * 128 + wc * 32 + 8 * fq) = w;
                else *(u32x2_*)(O + (size_t)(row0 + ai * HALF + m * 16) * ldc + col0) = w; }
    }
};
struct MoeOrder {
    int t0, nT, nN, G, c; int e1, e2, e3, e4, e5, e6, e7; int rev;
    __device__ __forceinline__ bool next(int i, Unit& u) const {
        const int nwg = nT * nN; const long L = (long)i * G + c; if (L >= nwg) return false;
        int wgid = (int)L; { const int q = nwg / NXCD, r = nwg % NXCD, xcd = wgid % NXCD, off = wgid / NXCD, sz = xcd < r ? q + 1 : q; wgid = (xcd < r ? xcd * (q + 1) : r * (q + 1) + (xcd - r) * q) + (rev ? sz - 1 - off : off); }
        const int nig = WGM * nN, gid = wgid / nig, fm = gid * WGM, gsz = (nT - fm) < WGM ? (nT - fm) : WGM;
        const int pm = t0 + fm + ((wgid % nig) % gsz), pn = (wgid % nig) / gsz;
        const int e = (pm >= e1) + (pm >= e2) + (pm >= e3) + (pm >= e4) + (pm >= e5) + (pm >= e6) + (pm >= e7);
        u.pm = pm; u.pn = e * nN + pn; return true;
    }
    __device__ __forceinline__ void a_ready(const Unit&) const {}
    __device__ __forceinline__ void done(const Unit&) const {}
};

template <class Inner> struct CachedOrder {
    Inner in; const PG8_LAS unsigned* tab;
    __device__ __forceinline__ bool next(int i, Unit& u) const { if (i >= 32) return in.next(i, u);
        const unsigned v = (unsigned)__builtin_amdgcn_readfirstlane((int)tab[i]); if (v == 0xffffffffu) return false; u.pm = (int)(v & 0xffffu); u.pn = (int)(v >> 16); return true; }
    __device__ __forceinline__ void a_ready(const Unit& u) const { in.a_ready(u); }
    __device__ __forceinline__ void done(const Unit& u) const { in.done(u); }
};
template <class Inner> __device__ __forceinline__ CachedOrder<Inner> cache_order(const Inner& in, PG8_LAS unsigned* tab, int tid) {
    asm volatile("" : "+v"(tid));
    if (tid < 32) { Unit u; tab[tid] = in.next(tid, u) ? ((unsigned)u.pm | ((unsigned)u.pn << 16)) : 0xffffffffu; }
    __syncthreads();
    return CachedOrder<Inner>{in, tab};
}
#if defined(PROBE_SETA) && defined(PROBE_GP)
#define PG8_PSTAMP(k) do { if (blockIdx.x == PROBE_BLK && threadIdx.x == 0) { PG8_LAS unsigned* M_ = (PG8_LAS unsigned*)(lds + 131072 + 320); if (M_[22] == (unsigned)PROBE_GP) { const unsigned long long t_ = __builtin_amdgcn_s_memrealtime(); \
        const unsigned long long l_ = ((unsigned long long)M_[17] << 32) | M_[16]; const unsigned d_ = (unsigned)(t_ - l_); if ((PROBE_SETA >> (k)) & 1ull) M_[18] += d_; if ((PROBE_SETB >> (k)) & 1ull) M_[20] += d_; M_[16] = (unsigned)t_; M_[17] = (unsigned)(t_ >> 32); } } } while (0)
#else
#define PG8_PSTAMP(k) do { } while (0)
#endif
template <class Epi, class Sched, bool ALIGN_EPI = false, bool SP2 = false, bool FP8 = false, bool TILED = false, bool ACHUNK = false, bool AGATHER = false, bool KSEL = false>
__device__ __forceinline__ void gemm_phase(PG8_LAS unsigned char* lds, const Gemm g, const Sched& S, const Epi& E) {
    const int tid = threadIdx.x, wid = __builtin_amdgcn_readfirstlane(tid >> 6), lane = tid & 63, wr = wid >> 2, wc = wid & 3, fr = lane & 15, fq = lane >> 4;
    const int K = g.K, nt = K / BK;
    unsigned voffA[2], voffB[2];
#pragma unroll
    for (int i = 0; i < 2; ++i) { int R, C; stage_rc(tid * 16 + i * 8192, R, C); const int Rb = Epi::PERM ? ((R & ~31) + perm32(R & 31)) : R;
        voffA[i] = TILED ? (unsigned)(R * BK + C) * 2u : (unsigned)(R * K + C) * 2u; voffB[i] = TILED ? (unsigned)(Rb * BK + C) * 2u : (unsigned)(Rb * K + C) * 2u;
        if (ACHUNK) voffA[i] = (unsigned)((R >> 4) * 512 + (R & 15) * 32 + (C & 15) * 2) + (unsigned)(C >> 4) * ACH_GS; }
    const size_t kstep = TILED ? (size_t)(BM * BK * 2) : (size_t)(BK * 2);
    const size_t hstep = TILED ? (size_t)(HALF * BK * 2) : (size_t)HALF * K * 2;
    const size_t tstep = (size_t)BM * K * 2;
    const size_t kstepA = ACHUNK ? (size_t)4 * ACH_GS : kstep, hstepA = ACHUNK ? (size_t)4096 : hstep;
#define PG8_ABASE(pm_) (AGATHER ? (const char*)g.A : ACHUNK ? (const char*)g.A + (size_t)((pm_) < 128 ? ((pm_) >> 3) * 144 + 16 + ((pm_) & 7) * 16 : ((pm_) - 128) * 144) * 512 : (const char*)g.A + (size_t)(pm_) * tstep)
    const unsigned ldsw = (unsigned)wid * 1024u;
    const int aoff = lds_byte(wr * 64 + fr, fq * 8), boff = lds_byte(wc * 32 + fr, fq * 8);
#define PG8_SA(b, h) (((b) * 2 + (h)) * HTB)
#define PG8_SB(b, h) ((4 + (b) * 2 + (h)) * HTB)
#define PG8_STAGE(bufoff, gbase, voff) do { _Pragma("unroll") for (int _i = 0; _i < 2; ++_i) \
        __builtin_amdgcn_global_load_lds((const unsigned*)((const char*)(gbase) + (voff)[_i]), (PG8_LAS unsigned*)(lds + (bufoff) + ldsw + _i * 8192), 16, 0, 0); } while (0)
    static_assert(!AGATHER || SP2, "AGATHER is written for the SP2 loop");
    unsigned gvA0[2] = {0u, 0u}, gvA1[2] = {0u, 0u}, gnA0[2] = {0u, 0u}, gnA1[2] = {0u, 0u};
#define PG8_GLOAD(uidx, v0, v1) do { _Pragma("unroll") for (int i_ = 0; i_ < 2; ++i_) { int R_, C_; stage_rc(tid * 16 + i_ * 8192, R_, C_); \
        const unsigned t0_ = g.atab[(uidx) * 256 + R_], t1_ = g.atab[(uidx) * 256 + 128 + R_]; v0[i_] = t0_ * (unsigned)(2 * K) + (unsigned)C_ * 2u; v1[i_] = t1_ * (unsigned)(2 * K) + (unsigned)C_ * 2u; } } while (0)
#define PG8_STAGE_A(bufoff, gbase, half, nx) do { if constexpr (AGATHER) { unsigned vs_[2]; \
        vs_[0] = (nx) ? ((half) ? gnA1[0] : gnA0[0]) : ((half) ? gvA1[0] : gvA0[0]); vs_[1] = (nx) ? ((half) ? gnA1[1] : gnA0[1]) : ((half) ? gvA1[1] : gvA0[1]); PG8_STAGE(bufoff, gbase, vs_); } \
        else PG8_STAGE(bufoff, (gbase) + ((half) ? hstepA : (size_t)0), voffA); } while (0)
#define PG8_LDA(dst, b, h) do { _Pragma("unroll") for (int m = 0; m < 4; ++m) _Pragma("unroll") for (int k = 0; k < 2; ++k) dst[m][k] = *(const PG8_LAS bf16x8*)(lds + PG8_SA(b, h) + aoff + m * 2048 + k * 1024); } while (0)
#define PG8_LDB(dst, b, h) do { _Pragma("unroll") for (int n = 0; n < 2; ++n) _Pragma("unroll") for (int k = 0; k < 2; ++k) dst[n][k] = *(const PG8_LAS bf16x8*)(lds + PG8_SB(b, h) + boff + n * 2048 + k * 1024); } while (0)
#define PG8_MMA(ai, bj, At, Bt) do { __builtin_amdgcn_s_setprio(1); _Pragma("unroll") for (int m = 0; m < 4; ++m) _Pragma("unroll") for (int n = 0; n < 2; ++n) { \
        if constexpr (FP8) { typedef int i32x4_ __attribute__((ext_vector_type(4))); typedef int i32x8_ __attribute__((ext_vector_type(8))); \
            const i32x8_ bo_ = __builtin_shufflevector(__builtin_bit_cast(i32x4_, Bt[n][0]), __builtin_bit_cast(i32x4_, Bt[n][1]), 0, 1, 2, 3, 4, 5, 6, 7); \
            const i32x8_ ao_ = __builtin_shufflevector(__builtin_bit_cast(i32x4_, At[m][0]), __builtin_bit_cast(i32x4_, At[m][1]), 0, 1, 2, 3, 4, 5, 6, 7); \
            asm volatile("v_mfma_f32_16x16x128_f8f6f4 %0, %1, %2, %0" : "+v"(acc[ai][bj][m][n]) : "v"(bo_), "v"(ao_)); } \
        else { _Pragma("unroll") for (int k = 0; k < 2; ++k) acc[ai][bj][m][n] = __builtin_amdgcn_mfma_f32_16x16x32_bf16(Bt[n][k], At[m][k], acc[ai][bj][m][n], 0, 0, 0); } } \
        __builtin_amdgcn_s_setprio(0); } while (0)
#define PG8_WAIT_V(n) asm volatile("s_waitcnt vmcnt(" #n ")" ::: "memory")
#define PG8_WAIT_L(n) asm volatile("s_waitcnt lgkmcnt(" #n ")" ::: "memory")
#define PG8_BAR __builtin_amdgcn_s_barrier()
#define PG8_SCHED __builtin_amdgcn_sched_barrier(0)
    const int fp8_unit_scale_ = 0x7f7f7f7f; (void)fp8_unit_scale_;
    Unit cur, nxt; int ui = 0;
    if (!S.next(0, cur)) return;
    f32x4 acc[2][2][4][2];
#pragma unroll
    for (int a = 0; a < 2; ++a)
#pragma unroll
        for (int b = 0; b < 2; ++b)
#pragma unroll
            for (int m = 0; m < 4; ++m)
#pragma unroll
                for (int n = 0; n < 2; ++n) acc[a][b][m][n] = (f32x4){0.f, 0.f, 0.f, 0.f};
    bf16x8 At[4][2], B0[2][2], B1[2][2];
    int ntc = nt, kt0c = 0; if constexpr (KSEL) { kt0c = (cur.pn < 3) ? 0 : 4; ntc = (cur.pn < 3) ? 4 : 2; }
    const char* cA = PG8_ABASE(cur.pm) + (size_t)kt0c * kstepA; const char* cB = (const char*)g.Bt + (size_t)cur.pn * tstep + (size_t)kt0c * kstep;
    if constexpr (AGATHER) PG8_GLOAD(0, gvA0, gvA1);
    S.a_ready(cur);
    if constexpr (SP2) {
        PG8_STAGE(PG8_SB(0, 0), cB, voffB); PG8_STAGE(PG8_SB(0, 1), cB + hstep, voffB); PG8_STAGE_A(PG8_SA(0, 0), cA, 0, false); PG8_STAGE_A(PG8_SA(0, 1), cA, 1, false);
        if (wr == 1) PG8_BAR;
        PG8_WAIT_V(2); PG8_BAR;
        PG8_STAGE(PG8_SB(1, 0), cB + kstep, voffB); PG8_STAGE_A(PG8_SA(1, 0), cA + kstepA, 0, false); PG8_STAGE(PG8_SB(1, 1), cB + hstep + kstep, voffB);
        PG8_WAIT_V(6); PG8_BAR;
    } else {
        PG8_STAGE(PG8_SB(0, 0), cB, voffB); PG8_STAGE(PG8_SA(0, 0), cA, voffA); PG8_STAGE(PG8_SB(0, 1), cB + hstep, voffB); PG8_STAGE(PG8_SA(0, 1), cA + hstepA, voffA);
        if (wr == 1) PG8_BAR;
        PG8_WAIT_V(4); PG8_BAR;
        PG8_STAGE(PG8_SB(1, 0), cB + kstep, voffB); PG8_STAGE(PG8_SA(1, 0), cA + kstepA, voffA); PG8_STAGE(PG8_SB(1, 1), cB + hstep + kstep, voffB);
        PG8_WAIT_V(6); PG8_BAR;
    }
    for (;;) {
        const bool has_next = S.next(ui + 1, nxt);
        int ntn = nt, kt0n = 0; if constexpr (KSEL) { if (has_next) { kt0n = (nxt.pn < 3) ? 0 : 4; ntn = (nxt.pn < 3) ? 4 : 2; } else ntn = ntc; }
        const char* nA = has_next ? PG8_ABASE(nxt.pm) + (size_t)kt0n * kstepA : cA; const char* nB = has_next ? (const char*)g.Bt + (size_t)nxt.pn * tstep + (size_t)kt0n * kstep : cB;
        for (int t = 0; t < ntc; t += 2) {
            const bool last = (t == ntc - 2);
            const char* a1 = cA + (size_t)(t + 1) * kstepA;
            const char* a2 = last ? nA : cA + (size_t)(t + 2) * kstepA; const char* b2 = last ? nB : cB + (size_t)(t + 2) * kstep;
            const char* a3 = a2 + kstepA; const char* b3 = b2 + kstep;
            if (last && has_next) S.a_ready(nxt);
            const bool nx_ = last && has_next;
            if constexpr (AGATHER) { if (nx_) PG8_GLOAD(ui + 1, gnA0, gnA1); }
            if constexpr (SP2) {
            PG8_LDB(B0, 0, 0); PG8_LDB(B1, 0, 1); PG8_SCHED; PG8_LDA(At, 0, 0); PG8_STAGE_A(PG8_SA(1, 1), a1, 1, false);
            PG8_WAIT_V(8); PG8_WAIT_L(0); PG8_BAR; PG8_MMA(0, 0, At, B0); PG8_MMA(0, 1, At, B1); PG8_BAR; PG8_SCHED;
            PG8_LDA(At, 0, 1); PG8_STAGE(PG8_SB(0, 0), b2, voffB); PG8_STAGE(PG8_SB(0, 1), b2 + hstep, voffB); PG8_STAGE_A(PG8_SA(0, 0), a2, 0, nx_);
            PG8_WAIT_V(8); PG8_WAIT_L(0); PG8_BAR; PG8_MMA(1, 0, At, B0); PG8_MMA(1, 1, At, B1); PG8_BAR; PG8_SCHED;
            PG8_LDB(B0, 1, 0); PG8_LDB(B1, 1, 1); PG8_SCHED; PG8_LDA(At, 1, 0); PG8_STAGE_A(PG8_SA(0, 1), a2, 1, nx_);
            PG8_WAIT_V(8); PG8_WAIT_L(0); PG8_BAR; PG8_MMA(0, 0, At, B0); PG8_MMA(0, 1, At, B1); PG8_BAR; PG8_SCHED;
            PG8_LDA(At, 1, 1); PG8_STAGE(PG8_SB(1, 0), b3, voffB); PG8_STAGE(PG8_SB(1, 1), b3 + hstep, voffB); PG8_STAGE_A(PG8_SA(1, 0), a3, 0, nx_);
            PG8_WAIT_V(8); PG8_WAIT_L(0); PG8_BAR; PG8_MMA(1, 0, At, B0); PG8_MMA(1, 1, At, B1); PG8_BAR; PG8_SCHED;
            } else {
            PG8_LDB(B0, 0, 0); PG8_SCHED; PG8_LDA(At, 0, 0); PG8_STAGE(PG8_SA(1, 1), a1 + hstepA, voffA);
            PG8_WAIT_L(8); PG8_BAR; PG8_WAIT_L(0); PG8_MMA(0, 0, At, B0); PG8_BAR; PG8_SCHED;
            PG8_LDB(B1, 0, 1); PG8_STAGE(PG8_SB(0, 0), b2, voffB);
            PG8_BAR; PG8_WAIT_L(0); PG8_MMA(0, 1, At, B1); PG8_BAR;
            PG8_LDA(At, 0, 1); PG8_STAGE(PG8_SA(0, 0), a2, voffA);
            PG8_BAR; PG8_WAIT_L(0); PG8_MMA(1, 0, At, B0); PG8_BAR; PG8_SCHED;
            PG8_STAGE(PG8_SB(0, 1), b2 + hstep, voffB);
            PG8_WAIT_V(6); PG8_BAR; PG8_MMA(1, 1, At, B1); PG8_BAR;
            PG8_LDB(B0, 1, 0); PG8_SCHED; PG8_LDA(At, 1, 0); PG8_STAGE(PG8_SA(0, 1), a2 + hstepA, voffA);
            PG8_WAIT_L(8); PG8_BAR; PG8_WAIT_L(0); PG8_MMA(0, 0, At, B0); PG8_BAR; PG8_SCHED;
            PG8_LDB(B1, 1, 1); PG8_STAGE(PG8_SB(1, 0), b3, voffB);
            PG8_BAR; PG8_WAIT_L(0); PG8_MMA(0, 1, At, B1); PG8_BAR;
            PG8_LDA(At, 1, 1); PG8_STAGE(PG8_SA(1, 0), a3, voffA);
            PG8_BAR; PG8_WAIT_L(0); PG8_MMA(1, 0, At, B0); PG8_BAR; PG8_SCHED;
            PG8_STAGE(PG8_SB(1, 1), b3 + hstep, voffB);
            PG8_WAIT_V(6); PG8_BAR; PG8_MMA(1, 1, At, B1); PG8_BAR;
            }
        }
        if constexpr (ALIGN_EPI) { if (wr == 0) PG8_BAR; }
        if constexpr (FP8) asm volatile("s_nop 15\n\ts_nop 7" ::: "memory");
        PG8_PSTAMP(28);
        if constexpr (!Epi::AFTER_DRAIN) { E(acc, cur, wr, wc, fr, fq); S.done(cur); }
        PG8_PSTAMP(29);
        if (!has_next) break;
#pragma unroll
        for (int a = 0; a < 2; ++a)
#pragma unroll
            for (int b = 0; b < 2; ++b)
#pragma unroll
                for (int m = 0; m < 4; ++m)
#pragma unroll
                    for (int n = 0; n < 2; ++n) acc[a][b][m][n] = (f32x4){0.f, 0.f, 0.f, 0.f};
        cur = nxt; cA = nA; cB = nB; ntc = ntn; ++ui;
        if constexpr (AGATHER) { gvA0[0] = gnA0[0]; gvA0[1] = gnA0[1]; gvA1[0] = gnA1[0]; gvA1[1] = gnA1[1]; }
        if constexpr (ALIGN_EPI) { if (wr == 1) PG8_BAR; }
    }
    PG8_WAIT_V(0);
    if constexpr (!ALIGN_EPI) { if (wr == 0) PG8_BAR; }
    PG8_BAR;
    if constexpr (Epi::AFTER_DRAIN) { E.fused(acc, cur, wr, wc, fr, fq, lds, wid, lane); S.done(cur); }
#undef PG8_ABASE
#undef PG8_GLOAD
#undef PG8_STAGE_A
#undef PG8_SA
#undef PG8_SB
#undef PG8_STAGE
#undef PG8_LDA
#undef PG8_LDB
#undef PG8_MMA
#undef PG8_WAIT_V
#undef PG8_WAIT_L
#undef PG8_BAR
#undef PG8_SCHED
}
}
#define GAS __attribute__((address_space(1)))
#define LAS __attribute__((address_space(3)))
typedef unsigned short bf16;
typedef unsigned v4u __attribute__((ext_vector_type(4)));
typedef float f32x4 __attribute__((ext_vector_type(4)));
typedef short bf16x8 __attribute__((ext_vector_type(8)));
typedef GAS unsigned gu32;
typedef GAS unsigned long long gu64;
#define RLX_AGENT __ATOMIC_RELAXED, __HIP_MEMORY_SCOPE_AGENT
#define LDS_WAIT() asm volatile("s_waitcnt lgkmcnt(0)" ::: "memory")
#define VM_WAIT() asm volatile("s_waitcnt vmcnt(0)" ::: "memory")
__device__ __forceinline__ unsigned long long rt() { return __builtin_amdgcn_s_memrealtime(); }
__device__ __forceinline__ unsigned f2bf(float f) { unsigned u = __builtin_bit_cast(unsigned, f); return (u + 0x7fffu + ((u >> 16) & 1u)) >> 16; }
__device__ __forceinline__ unsigned pk2(float lo, float hi) { return f2bf(lo) | (f2bf(hi) << 16); }
#define XB_TMO      128
#define XB_XCNT(j)  (256  + 64 * (j))
#define XB_XSUB(j)  (1280 + 64 * (j))
#define XB_XGEN(j)  (2304 + 64 * (j))
#define XB_TOP      3328
#define XB_TOPGEN   3392
#define XCD_BAR_WORDS 3456
#define XB_SPIN_CAP (1u << 18)

__device__ __forceinline__ unsigned xb_ld(unsigned* p)              { return __hip_atomic_load(p, __ATOMIC_RELAXED, __HIP_MEMORY_SCOPE_AGENT); }
__device__ __forceinline__ unsigned xb_add(unsigned* p, unsigned v) { return __hip_atomic_fetch_add(p, v, __ATOMIC_RELAXED, __HIP_MEMORY_SCOPE_AGENT); }
__device__ __forceinline__ unsigned xb_xcc_id() { return (unsigned)__builtin_amdgcn_s_getreg((3 << 11) | 20) & 0xFu; }
#define XB_SPIN(cond, bar) do { unsigned _sp = 0; while (cond) { __builtin_amdgcn_s_sleep(1); \
    if ((++_sp & 255u) == 0u) { if (xb_ld(&(bar)[XB_TMO])) break; if (_sp > XB_SPIN_CAP) { atomicAdd(&(bar)[XB_TMO], 1u); break; } } } } while (0)

struct XcdBarrier {
    unsigned* bar; unsigned x;
    volatile LAS unsigned* st;
};

__device__ __forceinline__ XcdBarrier xcd_barrier_post(unsigned* bar, volatile LAS unsigned* st) {
    XcdBarrier b; b.bar = bar; b.x = xb_xcc_id(); b.st = st;
    if (threadIdx.x == 0) (void)xb_add(&bar[XB_XCNT(b.x)], 1u);
    return b;
}
__device__ __forceinline__ void xcd_barrier_complete(unsigned* bar, unsigned x, unsigned& nloc, unsigned& nx) {
    const unsigned G = gridDim.x * gridDim.y * gridDim.z;
    unsigned sum, cnt, mine, sp = 0u;
    for (;;) {
        sum = 0u; cnt = 0u; mine = 0u;
#pragma unroll
        for (unsigned j = 0; j < 16; ++j) { const unsigned c = xb_ld(&bar[XB_XCNT(j)]); sum += c; cnt += (c > 0u) ? 1u : 0u; mine = (j == x) ? c : mine; }
        if (sum == G) break;
        __builtin_amdgcn_s_sleep(1);
        if ((++sp & 255u) == 0u) { if (xb_ld(&bar[XB_TMO])) break; if (sp > XB_SPIN_CAP) { atomicAdd(&bar[XB_TMO], 1u); break; } }
    }
    nloc = mine > 0u ? mine : 1u; nx = cnt > 0u ? cnt : 1u;
}

__device__ __forceinline__ void xcd_barrier(const XcdBarrier& b) {
    asm volatile("s_waitcnt vmcnt(0)" ::: "memory");
    __syncthreads();
    if (threadIdx.x == 0) {
        unsigned* bar = b.bar;
        __builtin_amdgcn_s_waitcnt(0);
        unsigned nloc = b.st[0], nx = b.st[1];
        if (nloc == 0u) { xcd_barrier_complete(bar, b.x, nloc, nx); b.st[0] = nloc; b.st[1] = nx; }
        const unsigned old = xb_add(&bar[XB_XSUB(b.x)], 1u);
        const unsigned gen = old / nloc;
        if (old + 1u == (gen + 1u) * nloc) {
            __builtin_amdgcn_fence(__ATOMIC_RELEASE, "agent");
            asm volatile("s_waitcnt vmcnt(0)" ::: "memory");
            const unsigned og = xb_add(&bar[XB_TOP], 1u);
            const unsigned tg = og / nx;
            if (og + 1u == (tg + 1u) * nx) xb_add(&bar[XB_TOPGEN], 1u);
            else XB_SPIN(xb_ld(&bar[XB_TOPGEN]) == tg, bar);
            __builtin_amdgcn_fence(__ATOMIC_ACQUIRE, "agent");
            xb_add(&bar[XB_XGEN(b.x)], 1u);
            asm volatile("s_waitcnt vmcnt(0)" ::: "memory");
        } else {
            XB_SPIN(xb_ld(&bar[XB_XGEN(b.x)]) == gen, bar);
            __builtin_amdgcn_fence(__ATOMIC_ACQUIRE, "agent");
            asm volatile("s_waitcnt vmcnt(0)" ::: "memory");
        }
    }
    __syncthreads();
}

namespace att {
typedef short bf16x8 __attribute__((ext_vector_type(8)));
typedef short s16x4 __attribute__((ext_vector_type(4)));
typedef float f32x16 __attribute__((ext_vector_type(16)));
typedef unsigned u32x4 __attribute__((ext_vector_type(4)));
#define ATT_LAS __attribute__((address_space(3)))
constexpr int QBLK = 32, KVBLK = 64, DQ = 96, DV = 64, LDQ = 768, LDKN = 1024, LDKR = 32, LDV = 1024, LDO = 1024;
typedef const __attribute__((address_space(1))) unsigned short* gcp; typedef __attribute__((address_space(1))) unsigned short* gp;
constexpr float SCALE = 0.10206207261596577f, QSC = SCALE * 1.4426950408889634f, THR2 = 8.f * 1.4426950408889634f;
constexpr int SHM_V = KVBLK * DV * 2, SHM_K = KVBLK * 256, NRING = 4, OFF_K = 0, OFF_V = NRING * SHM_K, OFF_WS = NRING * (SHM_V + SHM_K), ATT_LDS = OFF_WS + 8 * 256;
#define KSWZ(row, colB) ((row) * 256 + ((colB) ^ (((row) & 7) << 4)))
#define SBAR() __builtin_amdgcn_sched_barrier(0)
__device__ __forceinline__ int crow(int r, int hi) { return (r & 3) + 8 * (r >> 2) + 4 * hi; }
__device__ __forceinline__ unsigned cvtpk(float lo, float hi) { unsigned r; asm volatile("v_cvt_pk_bf16_f32 %0, %1, %2" : "=v"(r) : "v"(lo), "v"(hi)); return r; }
template <bool FIRST> __device__ __forceinline__ void partialSM(f32x16& p0, f32x16& p1, f32x16& mC, float& alpha) {
  float pmax = p0[0];
#pragma unroll
  for (int r = 1; r < 16; ++r) pmax = fmaxf(pmax, p0[r]);
#pragma unroll
  for (int r = 0; r < 16; ++r) pmax = fmaxf(pmax, p1[r]);
  { auto rr = __builtin_amdgcn_permlane32_swap(__float_as_uint(pmax), __float_as_uint(pmax), false, false);
    pmax = fmaxf(__uint_as_float(rr[0]), __uint_as_float(rr[1])); }
  if (!FIRST && __builtin_expect(__all(pmax <= THR2), 1)) alpha = 1.f;
  else { const float d = FIRST ? pmax : fmaxf(pmax, 0.f); alpha = __builtin_amdgcn_exp2f(-d);
#pragma unroll
    for (int r = 0; r < 16; ++r) { p0[r] -= d; p1[r] -= d; mC[r] -= d; } }
#pragma unroll
  for (int r = 0; r < 16; ++r) p0[r] = __builtin_amdgcn_exp2f(p0[r]);
}
__device__ __forceinline__ void finishSM(f32x16& p0, f32x16& p1, bf16x8& pa0, bf16x8& pa1, bf16x8& pa2, bf16x8& pa3) {
#pragma unroll
  for (int r = 0; r < 16; ++r) p1[r] = __builtin_amdgcn_exp2f(p1[r]);
#define PK4(P, BASE, OUT) do { u32x4 w = {cvtpk(P[BASE + 0], P[BASE + 1]), cvtpk(P[BASE + 2], P[BASE + 3]), cvtpk(P[BASE + 4], P[BASE + 5]), cvtpk(P[BASE + 6], P[BASE + 7])}; OUT = __builtin_bit_cast(bf16x8, w); } while (0)
  PK4(p0, 0, pa0); PK4(p0, 8, pa1); PK4(p1, 0, pa2); PK4(p1, 8, pa3);
#undef PK4
}
__device__ __forceinline__ void qkt(f32x16& p0, f32x16& p1, const f32x16& mC, const ATT_LAS unsigned char* Ks, const bf16x8* qr, int r32, int hi) {
#pragma unroll
  for (int d0 = 0; d0 < DQ / 16; ++d0) { const int cb = (d0 * 16 + hi * 8) * 2;
    const bf16x8 b0 = *(const ATT_LAS bf16x8*)(Ks + KSWZ(r32, cb));
    const bf16x8 b1 = *(const ATT_LAS bf16x8*)(Ks + KSWZ(32 + r32, cb));
    p0 = __builtin_amdgcn_mfma_f32_32x32x16_bf16(b0, qr[d0], d0 ? p0 : mC, 0, 0, 0);
    p1 = __builtin_amdgcn_mfma_f32_32x32x16_bf16(b1, qr[d0], d0 ? p1 : mC, 0, 0, 0); }
}
__device__ __forceinline__ int v_st(int k, int c) { const int kk = k; return ((kk >> 3) * 2 + (c >> 5)) * 512 + ((kk & 7) * 32 + (c & 31)) * 2; }
__device__ __forceinline__ int v_rd_base(int lane) { return ((lane & 3) << 3) | (((lane >> 2) & 3) << 6) | (((lane >> 4) & 1) << 5) | (((lane >> 5) & 1) << 8); }
constexpr int v_rd_off(int d0, int ks, int half) { return d0 * 512 + ks * 2048 + half * 1024; }
struct KPre { bf16x8 a0, b0, a1, b1; };
#define KLDX(KS, D0, A, B) do { A = *(const ATT_LAS bf16x8*)((KS) + KSWZ(r32, ((D0) * 16 + hi * 8) * 2)); B = *(const ATT_LAS bf16x8*)((KS) + KSWZ(32 + r32, ((D0) * 16 + hi * 8) * 2)); } while (0)
#define VLD(D0, KS_, H) __builtin_amdgcn_ds_read_tr16_b64_v4i16((ATT_LAS s16x4*)(vbp + VO + v_rd_off(D0, KS_, H)))
#define PK(L, H) (bf16x8){L[0], L[1], L[2], L[3], H[0], H[1], H[2], H[3]}
#define MFMA(A, B, C) __builtin_amdgcn_mfma_f32_32x32x16_bf16(A, B, C, 0, 0, 0)
template <int VO> __device__ __forceinline__ void region1(f32x16& n0, f32x16& n1, const f32x16& mC, const ATT_LAS unsigned char* Ks, const bf16x8* qr, int r32, int hi, const KPre& kp,
                                                          f32x16& p0, f32x16& p1, bf16x8& pa0, bf16x8& pa1, bf16x8& pa2, bf16x8& pa3, const ATT_LAS unsigned char* vbp, s16x4* vf) {
  bf16x8 kA[DQ / 16], kB[DQ / 16]; unsigned w[16]; kA[0] = kp.a0; kB[0] = kp.b0; kA[1] = kp.a1; kB[1] = kp.b1;
#define KLD(D0) KLDX(Ks, D0, kA[D0], kB[D0])
#define KMM(D0) do { n0 = MFMA(kA[D0], qr[D0], (D0) ? n0 : mC); n1 = MFMA(kB[D0], qr[D0], (D0) ? n1 : mC); } while (0)
#define EXP1(R) p1[R] = __builtin_amdgcn_exp2f(p1[R])
  KLD(2); KMM(0); EXP1(0); EXP1(1); EXP1(2); EXP1(3); EXP1(4); EXP1(5); w[0] = cvtpk(p0[0], p0[1]); w[1] = cvtpk(p0[2], p0[3]); SBAR();
  KLD(3); KMM(1); EXP1(6); EXP1(7); EXP1(8); EXP1(9); EXP1(10); EXP1(11); w[2] = cvtpk(p0[4], p0[5]); w[3] = cvtpk(p0[6], p0[7]); SBAR();
  KLD(4); KMM(2); EXP1(12); EXP1(13); EXP1(14); EXP1(15); w[4] = cvtpk(p0[8], p0[9]); w[5] = cvtpk(p0[10], p0[11]); w[6] = cvtpk(p0[12], p0[13]); w[7] = cvtpk(p0[14], p0[15]); SBAR();
  KLD(5); KMM(3); w[8] = cvtpk(p1[0], p1[1]); w[9] = cvtpk(p1[2], p1[3]); w[10] = cvtpk(p1[4], p1[5]); w[11] = cvtpk(p1[6], p1[7]); SBAR();
#pragma unroll
  for (int ks = 0; ks < 4; ++ks) { vf[2 * ks] = VLD(0, ks, 0); vf[2 * ks + 1] = VLD(0, ks, 1); }
  KMM(4); w[12] = cvtpk(p1[8], p1[9]); w[13] = cvtpk(p1[10], p1[11]); w[14] = cvtpk(p1[12], p1[13]); w[15] = cvtpk(p1[14], p1[15]); SBAR();
  KMM(5);
#undef KLD
#undef KMM
#undef EXP1
  { const u32x4 a = {w[0], w[1], w[2], w[3]}, b = {w[4], w[5], w[6], w[7]}, c = {w[8], w[9], w[10], w[11]}, d = {w[12], w[13], w[14], w[15]};
    pa0 = __builtin_bit_cast(bf16x8, a); pa1 = __builtin_bit_cast(bf16x8, b); pa2 = __builtin_bit_cast(bf16x8, c); pa3 = __builtin_bit_cast(bf16x8, d); }
}
template <int VO> __device__ __forceinline__ void region2(f32x16* o, const s16x4* vf, const ATT_LAS unsigned char* vbp, bf16x8 pa0, bf16x8 pa1, bf16x8 pa2, bf16x8 pa3, bf16x8 ones,
                                                          f32x16& n0, f32x16& n1, f32x16& mC, float& alpha) {
  s16x4 vg[8];
#pragma unroll
  for (int ks = 0; ks < 4; ++ks) { vg[2 * ks] = VLD(1, ks, 0); vg[2 * ks + 1] = VLD(1, ks, 1); }
#define MX3(A, P, R) A = fmaxf(fmaxf(A, P[R]), P[R + 1])
  o[0] = MFMA(pa0, PK(vf[0], vf[1]), o[0]); o[2] = MFMA(pa0, ones, o[2]); SBAR();
  float ma = fmaxf(n0[0], n0[1]), mb = fmaxf(n1[0], n1[1]);
  o[0] = MFMA(pa1, PK(vf[2], vf[3]), o[0]); o[2] = MFMA(pa1, ones, o[2]); MX3(ma, n0, 2); MX3(mb, n1, 2); MX3(ma, n0, 4); MX3(mb, n1, 4); SBAR();
  o[0] = MFMA(pa2, PK(vf[4], vf[5]), o[0]); o[2] = MFMA(pa2, ones, o[2]); MX3(ma, n0, 6); MX3(mb, n1, 6); MX3(ma, n0, 8); MX3(mb, n1, 8); MX3(ma, n0, 10); MX3(mb, n1, 10); SBAR();
  o[0] = MFMA(pa3, PK(vf[6], vf[7]), o[0]); o[2] = MFMA(pa3, ones, o[2]); MX3(ma, n0, 12); MX3(mb, n1, 12); MX3(ma, n0, 14); MX3(mb, n1, 14);
  float pmax = fmaxf(ma, mb);
  { auto rr = __builtin_amdgcn_permlane32_swap(__float_as_uint(pmax), __float_as_uint(pmax), false, false);
    pmax = fmaxf(__uint_as_float(rr[0]), __uint_as_float(rr[1])); }
  if (__builtin_expect(__all(pmax <= THR2), 1)) alpha = 1.f;
  else { const float d = fmaxf(pmax, 0.f); alpha = __builtin_amdgcn_exp2f(-d);
#pragma unroll
    for (int r = 0; r < 16; ++r) { n0[r] -= d; n1[r] -= d; mC[r] -= d; } }
#define EXP4(R) do { float e0 = __builtin_amdgcn_exp2f(n0[R]), e1 = __builtin_amdgcn_exp2f(n0[R + 1]), e2 = __builtin_amdgcn_exp2f(n0[R + 2]), e3 = __builtin_amdgcn_exp2f(n0[R + 3]); \
    asm volatile("" : "+v"(e0), "+v"(e1), "+v"(e2), "+v"(e3)); n0[R] = e0; n0[R + 1] = e1; n0[R + 2] = e2; n0[R + 3] = e3; } while (0)
  SBAR(); o[1] = MFMA(pa0, PK(vg[0], vg[1]), o[1]); EXP4(0); SBAR();
  o[1] = MFMA(pa1, PK(vg[2], vg[3]), o[1]); EXP4(4); SBAR();
  o[1] = MFMA(pa2, PK(vg[4], vg[5]), o[1]); EXP4(8); SBAR();
  o[1] = MFMA(pa3, PK(vg[6], vg[7]), o[1]); EXP4(12);
#undef EXP4
#undef MX3
}
template <int VO> __device__ __forceinline__ void pv_last(f32x16* o, const ATT_LAS unsigned char* vbp, bf16x8 pa0, bf16x8 pa1, bf16x8 pa2, bf16x8 pa3, bf16x8 ones) {
  s16x4 vf[8], vg[8];
#pragma unroll
  for (int ks = 0; ks < 4; ++ks) { vf[2 * ks] = VLD(0, ks, 0); vf[2 * ks + 1] = VLD(0, ks, 1); vg[2 * ks] = VLD(1, ks, 0); vg[2 * ks + 1] = VLD(1, ks, 1); }
  o[0] = MFMA(pa0, PK(vf[0], vf[1]), o[0]); o[1] = MFMA(pa0, PK(vg[0], vg[1]), o[1]); o[2] = MFMA(pa0, ones, o[2]);
  o[0] = MFMA(pa1, PK(vf[2], vf[3]), o[0]); o[1] = MFMA(pa1, PK(vg[2], vg[3]), o[1]); o[2] = MFMA(pa1, ones, o[2]);
  o[0] = MFMA(pa2, PK(vf[4], vf[5]), o[0]); o[1] = MFMA(pa2, PK(vg[4], vg[5]), o[1]); o[2] = MFMA(pa2, ones, o[2]);
  o[0] = MFMA(pa3, PK(vf[6], vf[7]), o[0]); o[1] = MFMA(pa3, PK(vg[6], vg[7]), o[1]); o[2] = MFMA(pa3, ones, o[2]);
}
#undef VLD
#undef PK
#undef MFMA

__device__ __forceinline__ void attn_unit(const unsigned short* Qb_, const unsigned short* Kn_, const unsigned short* Kr_, const unsigned short* Vc_, int ra, int nt_a, int rb, int NT,
                                          unsigned short* Ob_, ATT_LAS unsigned char* lds, int rope_t0) {
  gcp Qb = (gcp)Qb_, Kn = (gcp)Kn_, Kr = (gcp)Kr_, Vc = (gcp)Vc_; gp Ob = (gp)Ob_;
  const int tid = threadIdx.x, wid = tid >> 6, lane = tid & 63, r32 = lane & 31, hi = lane >> 5;
  ATT_LAS unsigned char* V_lds = lds + OFF_V; ATT_LAS unsigned char* K_lds = lds + OFF_K;
  ATT_LAS float* wsp = (ATT_LAS float*)(lds + OFF_WS) + wid * 64; ATT_LAS float* al_l = wsp + 32;
  f32x16 o[3] = {}, mC = {}; bf16x8 qr[DQ / 16]; const u32x4 ones_w = {0x3f803f80u, 0x3f803f80u, 0x3f803f80u, 0x3f803f80u}; const bf16x8 ones = __builtin_bit_cast(bf16x8, ones_w);
  const int sk = tid >> 3, sc = (tid & 7) * 8, rk = (tid & 255) >> 2, rc = (tid & 3) * 8; const bool rw = tid < 256;
  const int vst = v_st(sk, sc), kst0 = KSWZ(sk, sc * 2), kst1 = KSWZ(rk, (64 + rc) * 2);
  struct SR { bf16x8 vs, k0, k1; };
#define TROW(t) ((t) < nt_a ? ra + (t) * KVBLK : rb + ((t) - nt_a) * KVBLK)
#define SLOADX(S, t) do { const long r0_ = TROW(t); S.vs = *(const __attribute__((address_space(1))) bf16x8*)(Vc + (r0_ + sk) * LDV + sc); S.k0 = *(const __attribute__((address_space(1))) bf16x8*)(Kn + (r0_ + sk) * LDKN + sc); \
    S.k1 = *(const __attribute__((address_space(1))) bf16x8*)(Kr + (r0_ + rk) * LDKR + rc); } while (0)
#define SWRITEX(b, S) do { *(ATT_LAS bf16x8*)(V_lds + (b) * SHM_V + vst) = S.vs; *(ATT_LAS bf16x8*)(K_lds + (b) * SHM_K + kst0) = S.k0; \
    if (rw) *(ATT_LAS bf16x8*)(K_lds + (b) * SHM_K + kst1) = S.k1; } while (0)
  SR s0_, s1_, sr_; SLOADX(s0_, 0); SLOADX(s1_, 1); SLOADX(sr_, 2);
  gcp Qw = Qb + (long)(wid * QBLK + r32) * LDQ + hi * 8;
#pragma unroll
  for (int d0 = 0; d0 < DQ / 16; ++d0) qr[d0] = *(const __attribute__((address_space(1))) bf16x8*)(Qw + d0 * 16);
  if (rope_t0 >= 0) {
    int t = rope_t0 + wid * QBLK + r32; asm volatile("" : "+v"(t));
    const float prow = (float)(t >> 6), pcol = (float)(t & 63);
#pragma unroll
    for (int f = 0; f < 2; ++f) { const u32x4 own = __builtin_bit_cast(u32x4, qr[4 + f]); u32x4 oth;
      oth.x = (unsigned)__shfl_xor((int)own.x, 32); oth.y = (unsigned)__shfl_xor((int)own.y, 32); oth.z = (unsigned)__shfl_xor((int)own.z, 32); oth.w = (unsigned)__shfl_xor((int)own.w, 32);
      const float pos = f ? pcol : prow; float o8[8];
#pragma unroll
      for (int j = 0; j < 8; ++j) { const unsigned wo = (j < 2) ? own.x : (j < 4) ? own.y : (j < 6) ? own.z : own.w, wp = (j < 2) ? oth.x : (j < 4) ? oth.y : (j < 6) ? oth.z : oth.w;
        const float a = (j & 1) ? __uint_as_float(wo & 0xffff0000u) : __uint_as_float(wo << 16), bq = (j & 1) ? __uint_as_float(wp & 0xffff0000u) : __uint_as_float(wp << 16);
        const float ang = pos * __builtin_amdgcn_exp2f(-(float)j * (13.287712379549449f / 8.0f)); float sn, cs; __sincosf(ang, &sn, &cs);
        o8[j] = hi ? (a * cs + bq * sn) : (a * cs - bq * sn); }
      u32x4 w = {cvtpk(o8[0], o8[1]), cvtpk(o8[2], o8[3]), cvtpk(o8[4], o8[5]), cvtpk(o8[6], o8[7])}; qr[4 + f] = __builtin_bit_cast(bf16x8, w); } }
#pragma unroll
  for (int d0 = 0; d0 < DQ / 16; ++d0) { const u32x4 w = __builtin_bit_cast(u32x4, qr[d0]); u32x4 q;
#pragma unroll
    for (int i = 0; i < 4; ++i) q[i] = cvtpk(__uint_as_float(w[i] << 16) * QSC, __uint_as_float(w[i] & 0xffff0000u) * QSC);
    qr[d0] = __builtin_bit_cast(bf16x8, q); }
#define SLOAD(t) SLOADX(sr_, t)
#define SWRITE(b) SWRITEX(b, sr_)
#define SWAIT() asm volatile("s_waitcnt vmcnt(0)" ::: "memory")
#define BAR() asm volatile("s_barrier" ::: "memory")
#define RESC(a) do { if (__any((a) < 1.f)) { if (hi == 0) al_l[r32] = (a); asm volatile("s_waitcnt lgkmcnt(0)" ::: "memory"); \
    _Pragma("unroll") for (int d = 0; d < 3; ++d) _Pragma("unroll") for (int r = 0; r < 16; ++r) o[d][r] *= al_l[crow(r, hi)]; } } while (0)
#define KPRE(KB) do { KLDX(K_lds + (KB) * SHM_K, 0, kp.a0, kp.b0); KLDX(K_lds + (KB) * SHM_K, 1, kp.a1, kp.b1); } while (0)
  f32x16 pA0, pA1, pB0, pB1; float alA, alB; bf16x8 pa0, pa1, pa2, pa3; KPre kp; s16x4 vf[8];
  const ATT_LAS unsigned char* vbp = V_lds + v_rd_base(lane);
  SWAIT(); SWRITEX(0, s0_); SWRITEX(1, s1_); SWRITE(2); SLOAD(3); __syncthreads();
  qkt(pA0, pA1, mC, K_lds, qr, r32, hi); partialSM<true>(pA0, pA1, mC, alA);
  KPRE(1); BAR();
#define STEP(PN0, PN1, ALN, PO0, PO1, KB, VB, T, WR, LD, NX) do { \
    SBAR(); if (WR) { SWAIT(); SWRITE(((KB) + 2) & 3); } if (LD) SLOAD((T) + 3); SBAR(); \
    region1<(VB) * SHM_V>(PN0, PN1, mC, K_lds + (KB) * SHM_K, qr, r32, hi, kp, PO0, PO1, pa0, pa1, pa2, pa3, vbp, vf); SBAR(); \
    region2<(VB) * SHM_V>(o, vf, vbp, pa0, pa1, pa2, pa3, ones, PN0, PN1, mC, ALN); SBAR(); \
    if (NX) KPRE(((KB) + 1) & 3); RESC(ALN); BAR(); } while (0)
  if (wid >= 4) __builtin_amdgcn_s_setprio(1);
  int j = 1;
  for (; j + 3 < NT; j += 4) {
    STEP(pB0, pB1, alB, pA0, pA1, 1, 0, j, true, true, true);
    STEP(pA0, pA1, alA, pB0, pB1, 2, 1, j + 1, true, true, true);
    STEP(pB0, pB1, alB, pA0, pA1, 3, 2, j + 2, true, true, true);
    STEP(pA0, pA1, alA, pB0, pB1, 0, 3, j + 3, true, true, true);
  }
  STEP(pB0, pB1, alB, pA0, pA1, 1, 0, j, true, false, true);
  STEP(pA0, pA1, alA, pB0, pB1, 2, 1, j + 1, false, false, true);
  STEP(pB0, pB1, alB, pA0, pA1, 3, 2, j + 2, false, false, false);
  __builtin_amdgcn_s_setprio(0);
  finishSM(pB0, pB1, pa0, pa1, pa2, pa3); SBAR();
  pv_last<3 * SHM_V>(o, vbp, pa0, pa1, pa2, pa3, ones);
  float rli[16];
#pragma unroll
  for (int r = 0; r < 16; ++r) rli[r] = __builtin_amdgcn_rcpf(o[2][r]);
  gp Ow = Ob + (long)(wid * QBLK) * LDO;
#pragma unroll
  for (int r = 0; r < 16; ++r) { const int orow = crow(r, hi);
#pragma unroll
    for (int d0 = 0; d0 < 2; ++d0) Ow[(long)orow * LDO + d0 * 32 + r32] = (unsigned short)(cvtpk(o[d0][r] * rli[r], 0.f) & 0xffffu); }
  __syncthreads();
#undef TROW
#undef SLOAD
#undef SWRITE
#undef SLOADX
#undef SWRITEX
#undef STEP
#undef BAR
#undef KPRE
#undef SWAIT
#undef RESC
}
#undef KLDX
#undef KSWZ
#undef SBAR
}

namespace gla {
typedef short bf16x8 __attribute__((ext_vector_type(8)));
typedef short s16x4 __attribute__((ext_vector_type(4)));
typedef float f32x16 __attribute__((ext_vector_type(16)));
typedef float f32x4 __attribute__((ext_vector_type(4)));
typedef float f32x2 __attribute__((ext_vector_type(2)));
typedef __bf16 bf16x2_t __attribute__((ext_vector_type(2)));
typedef unsigned u32x4 __attribute__((ext_vector_type(4)));
typedef unsigned u32x2 __attribute__((ext_vector_type(2)));
#define GLA_LAS __attribute__((address_space(3)))
#define GLA_GAS __attribute__((address_space(1)))
constexpr int RS256 = 272, RS128 = 144;
constexpr int OFF_QT = 0, OFF_KT = 64 * RS256, OFF_KH = 2 * 64 * RS256, OFF_V = OFF_KH + 128 * RS128, OFF_P = OFF_V + 32768, OFF_TOT = OFF_P + 64 * RS128, OFF_EL = OFF_TOT + 2048, OFF_ZG = OFF_EL + 512, OFF_W2 = OFF_ZG + 4096, GLA_LDS = OFF_W2 + 8192;
static_assert(GLA_LDS <= 131072 && OFF_V % 16 == 0 && OFF_P % 16 == 0 && OFF_TOT % 16 == 0, "gla lds map");
__device__ __forceinline__ int swz256(int row, int colB) { return row * RS256 + colB; }
__device__ __forceinline__ int swz128(int row, int colB) { return row * RS128 + colB; }
__device__ __forceinline__ int crow(int r, int hi) { return (r & 3) + 8 * (r >> 2) + 4 * hi; }
__device__ __forceinline__ unsigned pk2f(float lo, float hi) { const f32x2 v = {lo, hi}; return __builtin_bit_cast(unsigned, __builtin_convertvector(v, bf16x2_t)); }
__device__ __forceinline__ unsigned short bf1f(float x) { return (unsigned short)(pk2f(x, 0.f) & 0xffffu); }
__device__ __forceinline__ float bfu(unsigned short u) { return __uint_as_float(((unsigned)u) << 16); }
__device__ __forceinline__ int v_st(int k, int c) { const int kk = (k & ~0xC) | ((k & 4) << 1) | ((k & 8) >> 1); return ((kk >> 3) * 8 + (c >> 5)) * 512 + ((kk & 7) * 32 + (c & 31)) * 2; }
__device__ __forceinline__ int v_rd_base(int lane) { return ((lane & 3) << 3) | (((lane >> 2) & 3) << 6) | (((lane >> 4) & 1) << 5) | (((lane >> 5) & 1) << 8); }
template <int OFF> __device__ __forceinline__ s16x4 tr_read(int vb) { s16x4 r; asm volatile("ds_read_b64_tr_b16 %0, %1 offset:%2" : "=&v"(r) : "v"(vb), "i"(OFF) : "memory"); return r; }
#define GLA_MFMA(a, b, c) __builtin_amdgcn_mfma_f32_32x32x16_bf16((a), (b), (c), 0, 0, 0)
__device__ __forceinline__ bf16x8 pack_step(const f32x16& x, int s) {
    u32x4 p; p.x = pk2f(x[8 * s], x[8 * s + 1]); p.y = pk2f(x[8 * s + 2], x[8 * s + 3]); p.z = pk2f(x[8 * s + 4], x[8 * s + 5]); p.w = pk2f(x[8 * s + 6], x[8 * s + 7]); return __builtin_bit_cast(bf16x8, p);
}
#if defined(PROBE_SETA)
#define GLA_PSTAMP(k) do { if (blockIdx.x == PROBE_BLK && threadIdx.x == 0) { GLA_LAS unsigned* M_ = (GLA_LAS unsigned*)(lds + 131072 + 320); const unsigned long long t_ = __builtin_amdgcn_s_memrealtime(); \
        const unsigned long long l_ = ((unsigned long long)M_[17] << 32) | M_[16]; const unsigned d_ = (unsigned)(t_ - l_); if ((PROBE_SETA >> (k)) & 1ull) M_[18] += d_; if ((PROBE_SETB >> (k)) & 1ull) M_[20] += d_; M_[16] = (unsigned)t_; M_[17] = (unsigned)(t_ >> 32); } } while (0)
#else
#define GLA_PSTAMP(k) do { } while (0)
#endif
__device__ __forceinline__ void gla_prep(const unsigned short* QK_, const unsigned short* ZG_, const float* w2_, const float* b2_, unsigned short* TQ_, unsigned short* TK_, unsigned short* TP_, float* EL_,
                                         int b, int h, int dir, int c_lo, int c_hi, int ML_, int SEQ_, int CTX_, GLA_LAS unsigned char* lds) {
    const GLA_GAS unsigned short* QK = (const GLA_GAS unsigned short*)QK_; const GLA_GAS unsigned short* ZG = (const GLA_GAS unsigned short*)ZG_;
    const GLA_GAS float* w2g = (const GLA_GAS float*)w2_; const GLA_GAS float* b2g = (const GLA_GAS float*)b2_;
    const int tid = threadIdx.x, wid = __builtin_amdgcn_readfirstlane(tid >> 6), lane = tid & 63, r32 = lane & 31, hi = lane >> 5;
    const int seg = tid >> 7, kk = tid & 127;
    GLA_LAS unsigned char* QT = lds + OFF_QT; GLA_LAS unsigned char* KT = lds + OFF_KT;
    GLA_LAS float* TOT = (GLA_LAS float*)(lds + OFF_TOT); GLA_LAS float* ZGS = (GLA_LAS float*)(lds + OFF_ZG); GLA_LAS float* W2S = (GLA_LAS float*)(lds + OFF_W2);
    __syncthreads();
#pragma unroll
    for (int i = 0; i < 4; ++i) { const int idx = tid + 512 * i; ((GLA_LAS unsigned short*)W2S)[(idx & 127) * 16 + (idx >> 7)] = bf1f(w2g[(size_t)(dir * 16 + (idx >> 7)) * 512 + h * 128 + (idx & 127)]); }
    __syncthreads();
    GLA_LAS float* XG = (GLA_LAS float*)(lds + OFF_QT);
    const float b2 = b2g[dir * 512 + h * 128 + kk];
    const int nctx = CTX_ / 64;
    GLA_LAS unsigned* RAW = (GLA_LAS unsigned*)(lds + OFF_V);
    u32x4 sq0, sq1, sk0, sk1; unsigned zgw;
#define GLA_PLOAD(cs_) do { const long r0_ = ((cs_) < nctx) ? (long)ML_ + (long)b * CTX_ + 64 * (cs_) : (long)b * SEQ_ + 64 * ((cs_) - nctx); \
        zgw = *(const GLA_GAS unsigned*)(ZG + (r0_ + (tid >> 3)) * 2304 + dir * 16 + (tid & 7) * 2); \
        const GLA_GAS unsigned short* zr_ = QK + (r0_ + (tid >> 3)) * 1024 + h * 128 + 16 * (tid & 7); \
        sq0 = *(const GLA_GAS u32x4*)(zr_); sq1 = *(const GLA_GAS u32x4*)(zr_ + 8); sk0 = *(const GLA_GAS u32x4*)(zr_ + 512); sk1 = *(const GLA_GAS u32x4*)(zr_ + 520); } while (0)
    GLA_PLOAD(c_lo);
    for (int cs = c_lo; cs < c_hi; ++cs) {
        { u32x4 w0, w1, w2, w3;
#define GLA_IL(W, QW, KW, J) W[2 * (J)] = __builtin_amdgcn_perm(KW[J], QW[J], 0x05040100u); W[2 * (J) + 1] = __builtin_amdgcn_perm(KW[J], QW[J], 0x07060302u)
          { unsigned t_[8];
#define GLA_IL4(QW, KW) do { _Pragma("unroll") for (int j_ = 0; j_ < 4; ++j_) { t_[2 * j_] = __builtin_amdgcn_perm(KW[j_], QW[j_], 0x05040100u); t_[2 * j_ + 1] = __builtin_amdgcn_perm(KW[j_], QW[j_], 0x07060302u); } } while (0)
            GLA_IL4(sq0, sk0); w0 = u32x4{t_[0], t_[1], t_[2], t_[3]}; w1 = u32x4{t_[4], t_[5], t_[6], t_[7]};
            GLA_IL4(sq1, sk1); w2 = u32x4{t_[0], t_[1], t_[2], t_[3]}; w3 = u32x4{t_[4], t_[5], t_[6], t_[7]}; }
#undef GLA_IL4
#undef GLA_IL
          GLA_LAS u32x4* dst = (GLA_LAS u32x4*)(RAW + (tid >> 3) * 128 + 16 * (tid & 7)); dst[0] = w0; dst[1] = w1; dst[2] = w2; dst[3] = w3; }
        const size_t tile = (size_t)((b * 4 + h) * 2 + dir) * 36 + cs;
        GLA_GAS unsigned short* TQ = (GLA_GAS unsigned short*)TQ_ + tile * 8192; GLA_GAS unsigned short* TK = (GLA_GAS unsigned short*)TK_ + tile * 8192; GLA_GAS unsigned short* TP = (GLA_GAS unsigned short*)TP_ + tile * 4096;
        ((GLA_LAS unsigned*)ZGS)[(tid >> 3) * 8 + (tid & 7)] = zgw;
        if (cs + 1 < c_hi) GLA_PLOAD(cs + 1);
        __syncthreads();
        GLA_PSTAMP(30);
        { const bf16x8 zf = *(const GLA_LAS bf16x8*)((GLA_LAS unsigned short*)ZGS + (32 * (wid >> 2) + r32) * 16 + 8 * hi);
          const bf16x8 w2frag = *(const GLA_LAS bf16x8*)((GLA_LAS unsigned short*)W2S + (32 * (wid & 3) + r32) * 16 + 8 * hi);
          const f32x16 xg = GLA_MFMA(zf, w2frag, f32x16{});
#pragma unroll
          for (int r = 0; r < 16; ++r) XG[(32 * (wid >> 2) + crow(r, hi)) * 128 + 32 * (wid & 3) + r32] = xg[r]; }
        __syncthreads();
        float cum[16];
#pragma unroll
        for (int i = 0; i < 16; ++i) cum[i] = b2 + XG[(16 * seg + i) * 128 + kk];
#pragma unroll
        for (int i = 0; i < 16; ++i) { const float x = cum[i]; cum[i] = (fminf(x, 0.f) - __logf(1.0f + __expf(-fabsf(x)))) * (1.0f / 16.0f); }
        if (dir == 0) {
#pragma unroll
            for (int i = 1; i < 16; ++i) cum[i] += cum[i - 1];
            TOT[seg * 128 + kk] = cum[15];
        } else {
#pragma unroll
            for (int i = 14; i >= 0; --i) cum[i] += cum[i + 1];
            TOT[seg * 128 + kk] = cum[0];
        }
        __syncthreads();
        GLA_PSTAMP(31);
        unsigned raw[16];
#pragma unroll
        for (int i = 0; i < 16; ++i) raw[i] = RAW[(16 * seg + i) * 128 + kk];
        { const float t0 = TOT[kk], t1 = TOT[128 + kk], t2 = TOT[256 + kk], t3 = TOT[384 + kk]; const float last = (t0 + t1) + (t2 + t3);
          float off;
          if (dir == 0) off = (seg > 0 ? t0 : 0.f) + (seg > 1 ? t1 : 0.f) + (seg > 2 ? t2 : 0.f);
          else off = (seg < 3 ? t3 : 0.f) + (seg < 2 ? t2 : 0.f) + (seg < 1 ? t1 : 0.f);
          if (seg == 0) ((GLA_GAS float*)EL_)[tile * 128 + kk] = __expf(last);
          unsigned ktp[8];
#pragma unroll
          for (int i = 0; i < 16; i += 2) {
              const float c0 = cum[i] + off, c1 = cum[i + 1] + off; const int l0 = 16 * seg + i, l1 = l0 + 1;
              const float q0 = __uint_as_float(raw[i] << 16), k0v = __uint_as_float(raw[i] & 0xffff0000u), q1 = __uint_as_float(raw[i + 1] << 16), k1v = __uint_as_float(raw[i + 1] & 0xffff0000u);
              const unsigned short qa = bf1f(q0 * __expf(c0)), qb = bf1f(q1 * __expf(c1)); const float ka = k0v * __expf(-c0), kb = k1v * __expf(-c1); const unsigned kp = pk2f(ka, kb);
              *(GLA_LAS unsigned short*)(QT + swz256(l0, 2 * kk)) = qa; *(GLA_LAS unsigned short*)(QT + swz256(l1, 2 * kk)) = qb;
              *(GLA_LAS unsigned short*)(KT + swz256(l0, 2 * kk)) = (unsigned short)(kp & 0xffffu); *(GLA_LAS unsigned short*)(KT + swz256(l1, 2 * kk)) = (unsigned short)(kp >> 16);
              ktp[i >> 1] = kp; }
          u32x4 k0 = {ktp[0], ktp[1], ktp[2], ktp[3]}, k1 = {ktp[4], ktp[5], ktp[6], ktp[7]};
          *(GLA_GAS u32x4*)(TK + kk * 64 + 16 * seg) = k0; *(GLA_GAS u32x4*)(TK + kk * 64 + 16 * seg + 8) = k1; }
        __syncthreads();
        GLA_PSTAMP(32);
        if (wid >= 4) {
            const int t2 = tid - 256;
#pragma unroll
            for (int i = 0; i < 4; ++i) { const int c = t2 + 256 * i, l = c >> 4, cB = (c & 15) * 16; *(GLA_GAS u32x4*)(TQ + l * 128 + (c & 15) * 8) = *(const GLA_LAS u32x4*)(QT + swz256(l, cB)); } }
        if (wid < 4) { const int mi = wid >> 1, li = wid & 1; f32x16 x = f32x16{};
#pragma unroll
            for (int s2 = 0; s2 < 8; ++s2) { const int cb = (16 * s2 + 8 * hi) * 2;
                const bf16x8 a = *(const GLA_LAS bf16x8*)(KT + swz256(32 * mi + r32, cb)); const bf16x8 bq = *(const GLA_LAS bf16x8*)(QT + swz256(32 * li + r32, cb)); x = GLA_MFMA(a, bq, x); }
            const int l = 32 * li + r32;
#pragma unroll
            for (int g = 0; g < 4; ++g) { float v[4];
#pragma unroll
                for (int j = 0; j < 4; ++j) { const int m = 32 * mi + 8 * g + 4 * hi + j; const bool keep = (dir == 0) ? (m <= l) : (m >= l); v[j] = keep ? x[4 * g + j] : 0.f; }
                u32x2 w; w.x = pk2f(v[0], v[1]); w.y = pk2f(v[2], v[3]); *(GLA_GAS u32x2*)(TP + l * 64 + 32 * mi + 8 * g + 4 * hi) = w; } }
        GLA_PSTAMP(33);
    }
#undef GLA_PLOAD
    __syncthreads();
}
__device__ __forceinline__ void gla_chain(const unsigned short* VR_, const unsigned short* TQ_, const unsigned short* TK_, const unsigned short* TP_, const float* EL_, unsigned short* O_, int b, int h, int dir,
                                          int ML_, int SEQ_, int CTX_, GLA_LAS unsigned char* lds) {
    const GLA_GAS unsigned short* VR = (const GLA_GAS unsigned short*)VR_; GLA_GAS unsigned short* O = (GLA_GAS unsigned short*)O_;
    const int tid = threadIdx.x, wid = __builtin_amdgcn_readfirstlane(tid >> 6), lane = tid & 63, r32 = lane & 31, hi = lane >> 5;
    GLA_LAS unsigned char* QT = lds + OFF_QT; GLA_LAS unsigned char* KH = lds + OFF_KH; GLA_LAS unsigned char* VI = lds + OFF_V; GLA_LAS unsigned char* PI = lds + OFF_P; GLA_LAS float* EL = (GLA_LAS float*)(lds + OFF_EL);
    f32x16 S[4];
#pragma unroll
    for (int t = 0; t < 4; ++t) S[t] = f32x16{};
    const int vb = (int)(unsigned)(uintptr_t)VI + v_rd_base(lane) + wid * 512;
    const int nchunk = (CTX_ + SEQ_) / 64, nctx = CTX_ / 64;
    const size_t tile0 = (size_t)((b * 4 + h) * 2 + dir) * 36;
    u32x4 pq[2], pk[2], pp, pv[4]; float pe = 0.f;
#define GLA_CS(sc_) ((dir == 0) ? (sc_) : (((sc_) < nctx) ? (nctx - 1 - (sc_)) : (nchunk - 1 - ((sc_) - nctx))))
#define GLA_FETCH(sc_) do { const int cs_ = GLA_CS(sc_); const size_t t_ = tile0 + cs_; const long r0_ = (cs_ < nctx) ? (long)ML_ + (long)b * CTX_ + 64 * cs_ : (long)b * SEQ_ + 64 * (cs_ - nctx); \
        const GLA_GAS u32x4* q_ = (const GLA_GAS u32x4*)((const GLA_GAS unsigned short*)TQ_ + t_ * 8192); const GLA_GAS u32x4* k_ = (const GLA_GAS u32x4*)((const GLA_GAS unsigned short*)TK_ + t_ * 8192); \
        pq[0] = q_[tid]; pq[1] = q_[tid + 512]; pk[0] = k_[tid]; pk[1] = k_[tid + 512]; pp = ((const GLA_GAS u32x4*)((const GLA_GAS unsigned short*)TP_ + t_ * 4096))[tid]; \
        if (tid < 128) pe = ((const GLA_GAS float*)EL_)[t_ * 128 + tid]; \
        _Pragma("unroll") for (int i_ = 0; i_ < 4; ++i_) { const int c_ = tid + 512 * i_; pv[i_] = *(const GLA_GAS u32x4*)(VR + (r0_ + (c_ >> 5)) * 2304 + h * 256 + (c_ & 31) * 8); } } while (0)
    GLA_FETCH(0);
    for (int sc = 0; sc < nchunk; ++sc) {
        const int cs = GLA_CS(sc); const bool is_lat = cs >= nctx; const long row0 = is_lat ? (long)b * SEQ_ + 64 * (cs - nctx) : (long)ML_ + (long)b * CTX_ + 64 * cs;
#pragma unroll
        for (int i = 0; i < 2; ++i) { const int c = tid + 512 * i; *(GLA_LAS u32x4*)(QT + (c >> 4) * RS256 + (c & 15) * 16) = pq[i]; *(GLA_LAS u32x4*)(KH + (c >> 3) * RS128 + (c & 7) * 16) = pk[i]; }
        *(GLA_LAS u32x4*)(PI + (tid >> 3) * RS128 + (tid & 7) * 16) = pp;
        if (tid < 128) EL[tid] = pe;
#pragma unroll
        for (int i = 0; i < 4; ++i) { const int c = tid + 512 * i; *(GLA_LAS u32x4*)(VI + v_st(c >> 5, (c & 31) * 8)) = pv[i]; }
        __syncthreads();
        if (sc + 1 < nchunk) GLA_FETCH(sc + 1);
        f32x16 o[2] = {f32x16{}, f32x16{}};
#pragma unroll
        for (int kt = 0; kt < 4; ++kt)
#pragma unroll
            for (int s2 = 0; s2 < 2; ++s2) { const bf16x8 bs = pack_step(S[kt], s2); const int cb0 = (32 * kt + 16 * s2 + 4 * hi) * 2;
#pragma unroll
                for (int rb = 0; rb < 2; ++rb) { const int l = 32 * rb + r32;
                    const s16x4 a0 = *(const GLA_LAS s16x4*)(QT + swz256(l, cb0)), a1 = *(const GLA_LAS s16x4*)(QT + swz256(l, cb0 + 16));
                    const bf16x8 a = {a0[0], a0[1], a0[2], a0[3], a1[0], a1[1], a1[2], a1[3]}; o[rb] = GLA_MFMA(a, bs, o[rb]); } }
        bf16x8 vf[4];
        { const s16x4 l0 = tr_read<0 * 8192>(vb), h0 = tr_read<0 * 8192 + 4096>(vb), l1 = tr_read<1 * 8192>(vb), h1 = tr_read<1 * 8192 + 4096>(vb);
          const s16x4 l2 = tr_read<2 * 8192>(vb), h2 = tr_read<2 * 8192 + 4096>(vb), l3 = tr_read<3 * 8192>(vb), h3 = tr_read<3 * 8192 + 4096>(vb);
          asm volatile("s_waitcnt lgkmcnt(0)" ::: "memory"); __builtin_amdgcn_sched_barrier(0);
          vf[0] = (bf16x8){l0[0], l0[1], l0[2], l0[3], h0[0], h0[1], h0[2], h0[3]}; vf[1] = (bf16x8){l1[0], l1[1], l1[2], l1[3], h1[0], h1[1], h1[2], h1[3]};
          vf[2] = (bf16x8){l2[0], l2[1], l2[2], l2[3], h2[0], h2[1], h2[2], h2[3]}; vf[3] = (bf16x8){l3[0], l3[1], l3[2], l3[3], h3[0], h3[1], h3[2], h3[3]}; }
#pragma unroll
        for (int rb = 0; rb < 2; ++rb)
#pragma unroll
            for (int ks = 0; ks < 4; ++ks) { const bf16x8 a = *(const GLA_LAS bf16x8*)(PI + swz128(32 * rb + r32, (16 * ks + 8 * hi) * 2)); o[rb] = GLA_MFMA(a, vf[ks], o[rb]); }
        if (is_lat) {
#pragma unroll
            for (int rb = 0; rb < 2; ++rb)
#pragma unroll
                for (int r = 0; r < 16; ++r) O[(row0 + 32 * rb + crow(r, hi)) * 1024 + h * 256 + 32 * wid + r32] = bf1f(o[rb][r]); }
#pragma unroll
        for (int kt = 0; kt < 4; ++kt) {
#pragma unroll
            for (int ks = 0; ks < 4; ++ks) { const bf16x8 a = *(const GLA_LAS bf16x8*)(KH + swz128(32 * kt + r32, (16 * ks + 8 * hi) * 2)); S[kt] = GLA_MFMA(a, vf[ks], S[kt]); }
#pragma unroll
            for (int r = 0; r < 16; ++r) S[kt][r] *= EL[32 * kt + crow(r, hi)]; }
        __syncthreads();
    }
#undef GLA_FETCH
#undef GLA_CS
}
__device__ __forceinline__ int v_st4(int k, int c) { const int kk = (k & ~0xC) | ((k & 4) << 1) | ((k & 8) >> 1); return ((kk >> 3) * 4 + (c >> 5)) * 512 + ((kk & 7) * 32 + (c & 31)) * 2; }
constexpr int OFF_XO_A = OFF_KT, OFF_XO_B = OFF_V + 16384;
static_assert(OFF_XO_A + 16384 <= OFF_KH && OFF_XO_B + 16384 <= OFF_P, "gla chain2 lds map");
__device__ __forceinline__ void gla_chain2(const unsigned short* VR_, const unsigned short* TQ_, const unsigned short* TK_, const unsigned short* TP_, const float* EL_, unsigned short* O_, int b, int h, int dir, int vh,
                                           int ML_, int SEQ_, int CTX_, GLA_LAS unsigned char* lds) {
    const GLA_GAS unsigned short* VR = (const GLA_GAS unsigned short*)VR_; GLA_GAS unsigned short* O = (GLA_GAS unsigned short*)O_;
    const int tid = threadIdx.x, wid = __builtin_amdgcn_readfirstlane(tid >> 6), lane = tid & 63, r32 = lane & 31, hi = lane >> 5;
    const int vt = wid & 3, kh = wid >> 2;
    GLA_LAS unsigned char* QT = lds + OFF_QT; GLA_LAS unsigned char* KH = lds + OFF_KH; GLA_LAS unsigned char* VI = lds + OFF_V; GLA_LAS unsigned char* PI = lds + OFF_P; GLA_LAS float* EL = (GLA_LAS float*)(lds + OFF_EL);
    GLA_LAS f32x4* XOs = (GLA_LAS f32x4*)(lds + (wid < 4 ? OFF_XO_A + wid * 4096 : OFF_XO_B + (wid - 4) * 4096));
    GLA_LAS f32x4* XOr = (GLA_LAS f32x4*)(lds + ((wid ^ 4) < 4 ? OFF_XO_A + (wid ^ 4) * 4096 : OFF_XO_B + ((wid ^ 4) - 4) * 4096));
    f32x16 S[2] = {f32x16{}, f32x16{}};
    const int vb = (int)(unsigned)(uintptr_t)VI + v_rd_base(lane) + vt * 512;
    const int nchunk = (CTX_ + SEQ_) / 64, nctx = CTX_ / 64;
    const size_t tile0 = (size_t)((b * 4 + h) * 2 + dir) * 36;
    u32x4 pq[2], pk[2], pp, pv[2]; float pe = 0.f;
#define GLA_CS(sc_) ((dir == 0) ? (sc_) : (((sc_) < nctx) ? (nctx - 1 - (sc_)) : (nchunk - 1 - ((sc_) - nctx))))
#define GLA_FETCH(sc_) do { const int cs_ = GLA_CS(sc_); const size_t t_ = tile0 + cs_; const long r0_ = (cs_ < nctx) ? (long)ML_ + (long)b * CTX_ + 64 * cs_ : (long)b * SEQ_ + 64 * (cs_ - nctx); \
        const GLA_GAS u32x4* q_ = (const GLA_GAS u32x4*)((const GLA_GAS unsigned short*)TQ_ + t_ * 8192); const GLA_GAS u32x4* k_ = (const GLA_GAS u32x4*)((const GLA_GAS unsigned short*)TK_ + t_ * 8192); \
        pq[0] = q_[tid]; pq[1] = q_[tid + 512]; pk[0] = k_[tid]; pk[1] = k_[tid + 512]; pp = ((const GLA_GAS u32x4*)((const GLA_GAS unsigned short*)TP_ + t_ * 4096))[tid]; \
        if (tid < 128) pe = ((const GLA_GAS float*)EL_)[t_ * 128 + tid]; \
        _Pragma("unroll") for (int i_ = 0; i_ < 2; ++i_) { const int c_ = tid + 512 * i_; pv[i_] = *(const GLA_GAS u32x4*)(VR + (r0_ + (c_ >> 4)) * 2304 + h * 256 + vh * 128 + (c_ & 15) * 8); } } while (0)
    GLA_FETCH(0);
    for (int sc = 0; sc < nchunk; ++sc) {
        const int cs = GLA_CS(sc); const bool is_lat = cs >= nctx; const long row0 = is_lat ? (long)b * SEQ_ + 64 * (cs - nctx) : (long)ML_ + (long)b * CTX_ + 64 * cs;
#pragma unroll
        for (int i = 0; i < 2; ++i) { const int c = tid + 512 * i; *(GLA_LAS u32x4*)(QT + (c >> 4) * RS256 + (c & 15) * 16) = pq[i]; *(GLA_LAS u32x4*)(KH + (c >> 3) * RS128 + (c & 7) * 16) = pk[i];
            *(GLA_LAS u32x4*)(VI + v_st4(c >> 4, (c & 15) * 8)) = pv[i]; }
        *(GLA_LAS u32x4*)(PI + (tid >> 3) * RS128 + (tid & 7) * 16) = pp;
        if (tid < 128) EL[tid] = pe;
        __syncthreads();
        GLA_PSTAMP(34);
        if (sc + 1 < nchunk) GLA_FETCH(sc + 1);
        f32x16 op[2] = {f32x16{}, f32x16{}};
#pragma unroll
        for (int j = 0; j < 2; ++j)
#pragma unroll
            for (int s2 = 0; s2 < 2; ++s2) { const bf16x8 bs = pack_step(S[j], s2); const int cb0 = (32 * (2 * kh + j) + 16 * s2 + 4 * hi) * 2;
#pragma unroll
                for (int rb = 0; rb < 2; ++rb) { const int l = 32 * rb + r32;
                    const s16x4 a0 = *(const GLA_LAS s16x4*)(QT + swz256(l, cb0)), a1 = *(const GLA_LAS s16x4*)(QT + swz256(l, cb0 + 16));
                    const bf16x8 a = {a0[0], a0[1], a0[2], a0[3], a1[0], a1[1], a1[2], a1[3]}; op[rb] = GLA_MFMA(a, bs, op[rb]); } }
        { const f32x16& snd = kh ? op[0] : op[1];
#pragma unroll
          for (int g = 0; g < 4; ++g) XOs[g * 64 + lane] = (f32x4){snd[4 * g], snd[4 * g + 1], snd[4 * g + 2], snd[4 * g + 3]}; }
        __syncthreads();
        GLA_PSTAMP(35);
        f32x16 o = kh ? op[1] : op[0];
#pragma unroll
        for (int g = 0; g < 4; ++g) { const f32x4 rv = XOr[g * 64 + lane]; o[4 * g] += rv.x; o[4 * g + 1] += rv.y; o[4 * g + 2] += rv.z; o[4 * g + 3] += rv.w; }
        bf16x8 vf[4];
        { const s16x4 l0 = tr_read<0 * 4096>(vb), h0 = tr_read<0 * 4096 + 2048>(vb), l1 = tr_read<1 * 4096>(vb), h1 = tr_read<1 * 4096 + 2048>(vb);
          const s16x4 l2 = tr_read<2 * 4096>(vb), h2 = tr_read<2 * 4096 + 2048>(vb), l3 = tr_read<3 * 4096>(vb), h3 = tr_read<3 * 4096 + 2048>(vb);
          asm volatile("s_waitcnt lgkmcnt(0)" ::: "memory"); __builtin_amdgcn_sched_barrier(0);
          vf[0] = (bf16x8){l0[0], l0[1], l0[2], l0[3], h0[0], h0[1], h0[2], h0[3]}; vf[1] = (bf16x8){l1[0], l1[1], l1[2], l1[3], h1[0], h1[1], h1[2], h1[3]};
          vf[2] = (bf16x8){l2[0], l2[1], l2[2], l2[3], h2[0], h2[1], h2[2], h2[3]}; vf[3] = (bf16x8){l3[0], l3[1], l3[2], l3[3], h3[0], h3[1], h3[2], h3[3]}; }
#pragma unroll
        for (int ks = 0; ks < 4; ++ks) { const bf16x8 a = *(const GLA_LAS bf16x8*)(PI + swz128(32 * kh + r32, (16 * ks + 8 * hi) * 2)); o = GLA_MFMA(a, vf[ks], o); }
        if (is_lat) {
#pragma unroll
            for (int r = 0; r < 16; ++r) O[(row0 + 32 * kh + crow(r, hi)) * 1024 + h * 256 + vh * 128 + 32 * vt + r32] = bf1f(o[r]); }
#pragma unroll
        for (int j = 0; j < 2; ++j) { const int kt = 2 * kh + j;
#pragma unroll
            for (int ks = 0; ks < 4; ++ks) { const bf16x8 a = *(const GLA_LAS bf16x8*)(KH + swz128(32 * kt + r32, (16 * ks + 8 * hi) * 2)); S[j] = GLA_MFMA(a, vf[ks], S[j]); }
#pragma unroll
            for (int r = 0; r < 16; ++r) S[j][r] *= EL[32 * kt + crow(r, hi)]; }
        __syncthreads();
        GLA_PSTAMP(36);
    }
#undef GLA_FETCH
#undef GLA_CS
}
#undef GLA_MFMA
}

constexpr int NWAVES = 8;
constexpr int D = 1024, NB = 16, SEQ = 2048, CTXL = 256, TT = SEQ + CTXL;
constexpr int ML = NB * SEQ, MC = NB * CTXL, MA = ML + MC;
constexpr float EPS = 1e-6f;
constexpr int S5W = 512, S5G = 32, S5H = 16, S5P = 64;
constexpr int NH = 8, NOPE = 64, ROPE = 32, QK = 96, VD = 64, QRANK = 256, KVRANK = 128;
constexpr int EV_IN = 928, EV_INP = 1024, NQKV = 1792, KQKV = 384;
constexpr int GH = 4, GDK = 128, GDV = 256, GKEY = 512, GVAL = 1024, GRANK = 16;
constexpr int OD_IN = 3104, OD_INP = 3328;
constexpr int FFN = 2816, NE = 8, FE = 3584;
constexpr int MOE_MAXT = 264;

constexpr size_t MiB = 1u << 20;
constexpr size_t WS_CTL = 0, CTL_ZERO_BYTES = 1 * MiB;
constexpr size_t WS_MODV = 1 * MiB;
constexpr size_t WS_TOK = 2 * MiB;
constexpr size_t WS_INV = 3 * MiB;
constexpr size_t WS_W_IN1 = 4 * MiB, WS_W_OUT1 = 11 * MiB, WS_W_MGU = 13 * MiB  , WS_W_MDN = 69 * MiB  ;
constexpr size_t WS_W_IN0 = 97 * MiB, WS_W_QKV = 99 * MiB, WS_W_GLU = 100 * MiB + 512 * 1024, WS_W_OUT0 = 101 * MiB, WS_W_GU = 103 * MiB, WS_W_DN = 114 * MiB, WS_HC = 120 * MiB;
constexpr size_t PB = 136 * MiB;
constexpr size_t WS_XL = PB + 0 * MiB, WS_Q = PB + 0 * MiB, WS_A3 = PB + 72 * MiB, WS_YL = PB + 72 * MiB, WS_KV = PB + 144 * MiB, WS_Z0C = PB + 144 * MiB, WS_U = PB + 180 * MiB, WS_DS = PB + 216 * MiB, WS_AO = PB + 216 * MiB,
                 WS_QA = PB + 288 * MiB, WS_AG = PB + 288 * MiB, WS_KR = PB + 324 * MiB, WS_B1 = PB + 328 * MiB, WS_B3 = PB + 332 * MiB;
constexpr size_t WS_ACT = PB + 72 * MiB, WS_FL = PB + 270 * MiB, WS_HB = PB + 171 * MiB;
constexpr size_t WS_TP = 97 * MiB, WS_EL = 133 * MiB, WS_OF = PB, WS_VR = 208 * MiB, WS_QK = 370 * MiB, WS_OB = 370 * MiB, WS_YL1 = 370 * MiB, WS_TQ = 442 * MiB, WS_TK = 514 * MiB;
constexpr int VRLD = 2304;
constexpr int GLA_TILES = NB * GH * 2 * 36;
constexpr int MOE_W_ITEMS = NE * (2 * (D / 64) * (FE / 32) + (FE / 64) * (D / 32));
constexpr int MW0 = 0, MW1 = (MOE_W_ITEMS * 23) / 100, MW2 = (MOE_W_ITEMS * 46) / 100, MW3 = (MOE_W_ITEMS * 63) / 100, MW4 = (MOE_W_ITEMS * 94) / 100, MW5 = MOE_W_ITEMS;
constexpr size_t WS_XLM = PB + 0 * MiB, WS_Y = PB + 0 * MiB, WS_XG = PB + 132 * MiB, WS_ACTM = PB + 198 * MiB, WS_HB2 = PB + 132 * MiB;
constexpr size_t WS_END = 588 * MiB;
static_assert(WS_KR + (size_t)MA * 32 * 2 <= WS_B1 && WS_KV + (size_t)MA * 1024 * 2 <= WS_DS && WS_AG + (size_t)MA * 512 * 2 <= WS_KR && WS_AO + (size_t)MA * D * 2 <= WS_AG && WS_A3 + (size_t)MA * 1024 * 2 <= WS_KV &&
              WS_Z0C + (size_t)MA * 512 * 2 <= WS_U && WS_U + (size_t)MA * 512 * 2 <= WS_DS && WS_DS + (size_t)MA * 512 * 4 <= WS_QA && WS_QA + (size_t)MA * KQKV * 2 <= WS_KR && WS_B1 + (size_t)32 * 256 * 256 * 2 <= WS_B3 && WS_B3 + (size_t)32 * 256 * 512 * 2 <= WS_END, "ws map");
static_assert(WS_FL + (size_t)MA * D * 2 <= WS_END && WS_ACT + (size_t)MA * FFN * 2 <= WS_FL, "ws map 2");
static_assert(WS_ACT + (size_t)MA * FFN <= WS_HB && WS_HB + (size_t)MA * D * 2 <= WS_FL, "ws map 2b: HB behind the e4m3 ACT");
static_assert(WS_TP + (size_t)GLA_TILES * 8192 <= WS_EL && WS_EL + (size_t)GLA_TILES * 512 <= PB && WS_XL + (size_t)MA * D * 2 <= WS_VR && WS_VR + (size_t)MA * VRLD * 2 <= WS_QK && WS_QK + (size_t)MA * 1024 * 2 <= WS_TQ &&
              WS_TQ + (size_t)GLA_TILES * 16384 <= WS_TK && WS_TK + (size_t)GLA_TILES * 16384 <= WS_END && WS_OF + (size_t)ML * D * 2 <= WS_VR && WS_OB + (size_t)ML * D * 2 <= WS_TQ, "ws map layer 1");
static_assert(WS_HB2 + (size_t)ML * D * 2 <= WS_ACTM && WS_Y + (size_t)MOE_MAXT * 256 * D * 2 <= WS_HB2, "ws map 3b: HB2");
static_assert(WS_Y + (size_t)MOE_MAXT * 256 * D * 2 <= WS_XG && WS_XG + (size_t)MOE_MAXT * 256 * D <= WS_ACTM && WS_ACTM + (size_t)MOE_MAXT * 256 * FE <= WS_END && WS_XLM + (size_t)ML * D <= WS_XG, "ws map 3");
static_assert(WS_W_IN1 + (size_t)OD_INP * D * 2 <= WS_W_OUT1 && WS_W_OUT1 + (size_t)D * D * 2 <= WS_W_MGU && WS_W_MGU + (size_t)NE * 2 * FE * D <= WS_W_MDN && WS_W_MDN + (size_t)NE * D * FE <= WS_W_IN0 &&
              WS_W_GU + (size_t)2 * FFN * D * 2 <= WS_W_DN && WS_W_DN + (size_t)D * FFN * 2 <= WS_HC && WS_HC + (size_t)MC * D * 4 <= PB, "ws map 4");
#ifndef FFN0_FP8
#define FFN0_FP8 0
#endif
constexpr bool FFN0_IS_FP8 = FFN0_FP8;
#ifndef FFN0_DOWN_FP8
#define FFN0_DOWN_FP8 1
#endif
constexpr bool FFN0_DN_FP8 = FFN0_DOWN_FP8;
constexpr float FP8_SA = 8.0f, FP8_SW = 128.0f, FP8_SACT = 4.0f;

constexpr int CW_TMO = 0, CW_CODE = 1, CW_CNT = 64, CW_BAR = 4096;

constexpr int RING_OFF = 0, RING_BYTES = 131072;
constexpr int ATAB_OFF = RING_BYTES + 1024, ATAB_UNITS = 29;
constexpr int LDSCTL_OFF = RING_BYTES, MISC_OFF = LDSCTL_OFF + 320;
constexpr int LDS_BYTES = 147456;
static_assert(ATAB_OFF + ATAB_UNITS * 512 + ATAB_UNITS * 16 <= LDS_BYTES, "LDS map: row table + unit parameters");
#ifndef PROBE_BLK
#define PROBE_BLK 0
#endif
#ifdef PROBE_SETA
#define PROBE_STAMP2(F, k) do { if (blockIdx.x == PROBE_BLK && F.tid == 0) { const unsigned long long t_ = __builtin_amdgcn_s_memrealtime(); const unsigned long long l_ = ((unsigned long long)F.MISC[17] << 32) | F.MISC[16]; const unsigned d_ = (unsigned)(t_ - l_); \
        if ((PROBE_SETA >> (k)) & 1ull) F.MISC[18] += d_; if ((PROBE_SETB >> (k)) & 1ull) F.MISC[20] += d_; F.MISC[16] = (unsigned)t_; F.MISC[17] = (unsigned)(t_ >> 32); } } while (0)
#else
#define PROBE_STAMP2(F, k) do { } while (0)
#endif

struct Args { const float* in[35]; float* out; unsigned char* ws; int ph_lo, ph_hi; };
struct Frame { LAS unsigned char* lds; volatile LAS unsigned* MISC; gu32* ctl; int tid, lane, wave, G, gw, ngw; };

__device__ __forceinline__ float wave_sum(float v) {
#pragma unroll
    for (int o = 1; o < 64; o <<= 1) v += __shfl_xor(v, o);
    return v;
}
__device__ __forceinline__ float bf_lo(unsigned u) { return __uint_as_float(u << 16); }
__device__ __forceinline__ float bf_hi(unsigned u) { return __uint_as_float(u & 0xffff0000u); }
__device__ __forceinline__ float bf1(bf16 u) { return __uint_as_float(((unsigned)u) << 16); }
typedef unsigned v2u __attribute__((ext_vector_type(2)));
__device__ __forceinline__ unsigned pk4_fp8(float a, float b, float c, float d) { return pg8::pk4_fp8(a, b, c, d); }

__device__ __forceinline__ void ld_row_f32(const float* p, int lane, f32x4 (&v)[4]) {
    const GAS f32x4* q = (const GAS f32x4*)p + lane;
#pragma unroll
    for (int j = 0; j < 4; ++j) v[j] = q[64 * j];
}
__device__ __forceinline__ void st_row_f32(float* p, int lane, const f32x4 (&v)[4]) {
    GAS f32x4* q = (GAS f32x4*)p + lane;
#pragma unroll
    for (int j = 0; j < 4; ++j) q[64 * j] = v[j];
}
__device__ __forceinline__ void ld_row_bf16(const bf16* p, int lane, f32x4 (&v)[4]) {
    const GAS v2u* q = (const GAS v2u*)p + lane;
#pragma unroll
    for (int j = 0; j < 4; ++j) { const v2u w = q[64 * j]; v[j] = (f32x4){bf_lo(w.x), bf_hi(w.x), bf_lo(w.y), bf_hi(w.y)}; }
}
__device__ __forceinline__ void st_row_bf16(bf16* p, int lane, const f32x4 (&v)[4]) {
    GAS v2u* q = (GAS v2u*)p + lane;
#pragma unroll
    for (int j = 0; j < 4; ++j) { v2u w; w.x = pk2(v[j].x, v[j].y); w.y = pk2(v[j].z, v[j].w); q[64 * j] = w; }
}
__device__ __forceinline__ void st_row_fp8(unsigned char* p, int lane, const f32x4 (&v)[4], float sc) {
    GAS unsigned* q = (GAS unsigned*)p + lane;
#pragma unroll
    for (int j = 0; j < 4; ++j) q[64 * j] = pk4_fp8(v[j].x * sc, v[j].y * sc, v[j].z * sc, v[j].w * sc);
}
__device__ __forceinline__ float row_rs(const f32x4 (&v)[4]) {
    float s = 0.f;
#pragma unroll
    for (int j = 0; j < 4; ++j) s += (v[j].x * v[j].x + v[j].y * v[j].y) + (v[j].z * v[j].z + v[j].w * v[j].w);
    return rsqrtf(wave_sum(s) * (1.0f / D) + EPS);
}
__device__ __forceinline__ void norm_mod(f32x4 (&v)[4], const float* gam, const float* sh, const float* sc, int lane) {
    const float rs = row_rs(v); f32x4 g[4], a[4], b[4]; ld_row_f32(gam, lane, g); ld_row_f32(sh, lane, a); ld_row_f32(sc, lane, b);
#pragma unroll
    for (int j = 0; j < 4; ++j) v[j] = (v[j] * rs) * g[j] * (1.0f + b[j]) + a[j];
}
__device__ __forceinline__ void gated_add(f32x4 (&h)[4], const f32x4 (&y)[4], const float* gam, const float* gate, int lane) {
    const float rs = row_rs(y); f32x4 g[4], t[4]; ld_row_f32(gam, lane, g); ld_row_f32(gate, lane, t);
#pragma unroll
    for (int j = 0; j < 4; ++j) h[j] = h[j] + t[j] * ((y[j] * rs) * g[j]);
}

__device__ __forceinline__ void cvt_item(const float* W, int K, int N, bf16* WT, int ldk, int kcol0, int row_off, int mode, const float* gain, float scale, int nscale,
                                         LAS float* scr, int item, int lane, bool fp8 = false, bool tiled = false) {
    const int nblk = N / 32, kb = item / nblk, nb = item % nblk, k0 = 64 * kb, n0 = 32 * nb;
    { f32x4 t[8];
#pragma unroll
      for (int i = 0; i < 8; ++i) t[i] = *(const GAS f32x4*)(W + (size_t)(k0 + 8 * i + (lane >> 3)) * N + n0 + 4 * (lane & 7));
#pragma unroll
      for (int i = 0; i < 8; ++i) { LAS float* d = scr + (8 * i + (lane >> 3)) * 33 + 4 * (lane & 7); d[0] = t[i].x; d[1] = t[i].y; d[2] = t[i].z; d[3] = t[i].w; } }
    LDS_WAIT(); asm volatile("" ::: "memory");
    const int c = lane & 7;
    float gn[8];
#pragma unroll
    for (int q = 0; q < 8; ++q) gn[q] = (gain ? gain[k0 + 8 * c + q] : 1.0f) * ((n0 < nscale) ? scale : 1.0f);
    const int drow0 = (mode == 0) ? n0 : (mode == 3) ? ((n0 >> 7) * 64 + (n0 & 63) + ((n0 & 64) ? 512 : 0)) : ((n0 >> 7) * 256 + (n0 & 127) + (mode == 2 ? 128 : 0));
#pragma unroll
    for (int j = 0; j < 4; ++j) { const int n = (lane >> 3) + 8 * j; const LAS float* s = scr + (8 * c) * 33 + n;
        if (fp8) { v2u o; o.x = pk4_fp8(s[0 * 33] * gn[0], s[1 * 33] * gn[1], s[2 * 33] * gn[2], s[3 * 33] * gn[3]); o.y = pk4_fp8(s[4 * 33] * gn[4], s[5 * 33] * gn[5], s[6 * 33] * gn[6], s[7 * 33] * gn[7]);
            const int drow = row_off + drow0 + n, kc = kcol0 + k0 + 8 * c;
            unsigned char* dp = tiled ? (unsigned char*)WT + (size_t)(drow >> 8) * 256 * ldk + (size_t)(kc >> 7) * 32768 + (drow & 255) * 128 + (kc & 127) : (unsigned char*)WT + (size_t)drow * ldk + kc;
            *(GAS v2u*)dp = o; }
        else { v4u o; o.x = pk2(s[0 * 33] * gn[0], s[1 * 33] * gn[1]); o.y = pk2(s[2 * 33] * gn[2], s[3 * 33] * gn[3]); o.z = pk2(s[4 * 33] * gn[4], s[5 * 33] * gn[5]); o.w = pk2(s[6 * 33] * gn[6], s[7 * 33] * gn[7]);
            *(GAS v4u*)(WT + (size_t)(row_off + drow0 + n) * ldk + kcol0 + k0 + 8 * c) = o; } }
    LDS_WAIT(); asm volatile("" ::: "memory");
}
__device__ __forceinline__ void moe_weights(Frame& F, const Args& A, int it_lo, int it_hi, int widx, int nw) {
    LAS float* scr = (LAS float*)(F.lds + RING_OFF + F.wave * 16384);
    unsigned char* ws = A.ws;
    constexpr int I_MG1 = (D / 64) * (FE / 32), I_MD1 = (FE / 64) * (D / 32);
    for (int it = it_lo + widx; it < it_hi; it += nw) {
        int r = it;
        if (r < NE * I_MG1) { const int e = r / I_MG1; cvt_item(A.in[32] + (size_t)e * D * FE, D, FE, (bf16*)(ws + WS_W_MGU + (size_t)e * 2 * FE * D), D, 0, 0, 1, nullptr, FP8_SW, 1 << 30, scr, r % I_MG1, F.lane, true); continue; } r -= NE * I_MG1;
        if (r < NE * I_MG1) { const int e = r / I_MG1; cvt_item(A.in[33] + (size_t)e * D * FE, D, FE, (bf16*)(ws + WS_W_MGU + (size_t)e * 2 * FE * D), D, 0, 0, 2, nullptr, FP8_SW, 1 << 30, scr, r % I_MG1, F.lane, true); continue; } r -= NE * I_MG1;
        { const int e = r / I_MD1; cvt_item(A.in[34] + (size_t)e * FE * D, FE, D, (bf16*)(ws + WS_W_MDN + (size_t)e * D * FE), FE, 0, 0, 0, nullptr, FP8_SW, 1 << 30, scr, r % I_MD1, F.lane, true, true); }
    }
}
__device__ __forceinline__ void tail_convert(Frame& F, const Args& A, int nunit, int lo, int hi) {
    const int nlast = nunit % F.G, bid = (int)blockIdx.x;
    if (nlast != 0) { if (bid >= nlast) moe_weights(F, A, lo, hi, (bid - nlast) * NWAVES + F.wave, (F.G - nlast) * NWAVES); }
    else moe_weights(F, A, lo, hi, F.gw, F.ngw);
}
__device__ __forceinline__ void gen_s5(Frame& F, const Args& A, int g);
__device__ __forceinline__ void p0_prologue(Frame& F, const Args& A) {
    LAS float* scr = (LAS float*)(F.lds + RING_OFF + F.wave * 16384);
    unsigned char* ws = A.ws;
    constexpr int I_IN0 = (D / 64) * (EV_IN / 32), I_UQ = (QRANK / 64) * (768 / 32), I_UKV = (KVRANK / 64) * (1024 / 32), I_GLU = (512 / 64) * (512 / 32), I_OUT = (D / 64) * (D / 32);
    constexpr int I_FG = (D / 64) * (FFN / 32), I_FD = (FFN / 64) * (D / 32), I_IN1 = (D / 64) * (OD_IN / 32), I_MG1 = (D / 64) * (FE / 32), I_MD1 = (FE / 64) * (D / 32);
    constexpr int NITEMS = I_IN0 + I_UQ + I_UKV + I_GLU + I_OUT + 2 * I_FG + I_FD + I_IN1 + I_OUT;
    const bool s5_builder = (int)blockIdx.x >= F.G - S5G;
    for (int it = s5_builder ? NITEMS : F.gw; it < NITEMS; it += F.ngw - S5G * NWAVES) {
        int r = it;
        if (r < I_IN0) { cvt_item(A.in[7], D, EV_IN, (bf16*)(ws + WS_W_IN0), D, 0, 0, 0, nullptr, 1.f, 0, scr, r, F.lane); continue; } r -= I_IN0;
        if (r < I_UQ) { cvt_item(A.in[19], QRANK, 768, (bf16*)(ws + WS_W_QKV), KQKV, 0, 0, 0, A.in[18], 1.f, 0, scr, r, F.lane); continue; } r -= I_UQ;
        if (r < I_UKV) { cvt_item(A.in[21], KVRANK, 1024, (bf16*)(ws + WS_W_QKV), KQKV, QRANK, 768, 3, A.in[20], 1.f, 0, scr, r, F.lane); continue; } r -= I_UKV;
        if (r < I_GLU) { cvt_item(A.in[16], 512, 512, (bf16*)(ws + WS_W_GLU), 512, 0, 0, 0, nullptr, 1.f, 0, scr, r, F.lane); continue; } r -= I_GLU;
        if (r < I_OUT) { cvt_item(A.in[22], D, D, (bf16*)(ws + WS_W_OUT0), D, 0, 0, 0, nullptr, 1.f, 0, scr, r, F.lane); continue; } r -= I_OUT;
        if (r < I_FG) { cvt_item(A.in[23], D, FFN, (bf16*)(ws + WS_W_GU), D, 0, 0, 1, nullptr, FFN0_IS_FP8 ? FP8_SW : 1.f, 1 << 30, scr, r, F.lane, FFN0_IS_FP8); continue; } r -= I_FG;
        if (r < I_FG) { cvt_item(A.in[24], D, FFN, (bf16*)(ws + WS_W_GU), D, 0, 0, 2, nullptr, FFN0_IS_FP8 ? FP8_SW : 1.f, 1 << 30, scr, r, F.lane, FFN0_IS_FP8); continue; } r -= I_FG;
        if (r < I_FD) { cvt_item(A.in[25], FFN, D, (bf16*)(ws + WS_W_DN), FFN, 0, 0, 0, nullptr, (FFN0_IS_FP8 || FFN0_DN_FP8) ? FP8_SW : 1.f, 1 << 30, scr, r, F.lane, FFN0_IS_FP8 || FFN0_DN_FP8); continue; } r -= I_FD;
        if (r < I_IN1) { cvt_item(A.in[26], D, OD_IN, (bf16*)(ws + WS_W_IN1), D, 0, 0, 0, nullptr, 0.08838834764831845f, GKEY, scr, r, F.lane); continue; } r -= I_IN1;
        cvt_item(A.in[30], D, D, (bf16*)(ws + WS_W_OUT1), D, 0, 0, 0, nullptr, 1.f, 0, scr, r, F.lane);
    }
    { const v4u z = {0u, 0u, 0u, 0u}; const int gt = blockIdx.x * (NWAVES * 64) + F.tid, ngt = F.G * NWAVES * 64;
      GAS v4u* p0 = (GAS v4u*)((bf16*)(ws + WS_W_IN0) + (size_t)EV_IN * D); for (int i = gt; i < (EV_INP - EV_IN) * D / 8; i += ngt) p0[i] = z;
      for (int i = gt; i < 768 * (KVRANK / 8); i += ngt) { const int r = i / (KVRANK / 8), c = i % (KVRANK / 8); *(GAS v4u*)((bf16*)(ws + WS_W_QKV) + (size_t)r * KQKV + QRANK + 8 * c) = z; }
      for (int i = gt; i < 1024 * (QRANK / 8); i += ngt) { const int r = i / (QRANK / 8), c = i % (QRANK / 8); *(GAS v4u*)((bf16*)(ws + WS_W_QKV) + (size_t)(768 + r) * KQKV + 8 * c) = z; }
      GAS v4u* p1 = (GAS v4u*)((bf16*)(ws + WS_W_IN1) + (size_t)OD_IN * D); for (int i = gt; i < (OD_INP - OD_IN) * D / 8; i += ngt) p1[i] = z; }
    __syncthreads();
    PROBE_STAMP2(F, 22);
    LAS float* act = (LAS float*)(F.lds);
    LAS float* red = (LAS float*)(F.lds + 17 * 1024 * 4);
    float* modv = (float*)(ws + WS_MODV);
    bool have_act = false;
    for (int u = blockIdx.x; u < 2 * 96; u += F.G) {
        if (!have_act) {
            float xv[17 * 1024 / (NWAVES * 64)];
#pragma unroll
            for (int q = 0; q < 17 * 1024 / (NWAVES * 64); ++q) { const int i = F.tid + q * (NWAVES * 64); xv[q] = (i < 16 * 1024) ? A.in[1][i] : A.in[3][i - 16 * 1024]; }
#pragma unroll
            for (int q = 0; q < 17 * 1024 / (NWAVES * 64); ++q) { const float x = xv[q]; act[F.tid + q * (NWAVES * 64)] = x / (1.0f + __expf(-x)); }
            have_act = true;
        }
        __syncthreads();
        const int layer = u / 96, c0 = (u % 96) * 64;
        const float* mw = A.in[4] + (size_t)layer * D * 6144 + c0 + F.lane;
        float acc[17];
#pragma unroll
        for (int r = 0; r < 17; ++r) acc[r] = 0.f;
        for (int k0 = F.wave * 128; k0 < F.wave * 128 + 128; k0 += 32) { float w[32];
#pragma unroll
            for (int u2 = 0; u2 < 32; ++u2) w[u2] = mw[(size_t)(k0 + u2) * 6144];
#pragma unroll
            for (int u2 = 0; u2 < 32; ++u2)
#pragma unroll
                for (int r = 0; r < 17; ++r) acc[r] += act[r * 1024 + k0 + u2] * w[u2]; }
#pragma unroll
        for (int r = 0; r < 17; ++r) red[(F.wave * 17 + r) * 64 + F.lane] = acc[r];
        __syncthreads();
        for (int i = F.tid; i < 17 * 64; i += NWAVES * 64) { const int r = i >> 6, l = i & 63; float s = A.in[5][layer * 6144 + c0 + l];
#pragma unroll
            for (int w = 0; w < 8; ++w) s += red[(w * 17 + r) * 64 + l];
            modv[(size_t)(layer * 17 + r) * 6144 + c0 + l] = s; }
    }
    __syncthreads();
    PROBE_STAMP2(F, 23);
    for (int g = (int)blockIdx.x - (F.G - S5G); g >= 0 && g < S5G; g += F.G) gen_s5(F, A, g);
    PROBE_STAMP2(F, 24);
}

__device__ __forceinline__ void thin_t1(Frame& F, const Args& A) {
    const float* modv = (const float*)(A.ws + WS_MODV); bf16* XL = (bf16*)(A.ws + WS_XL); const float* gam = A.in[6];
    const int per = (MA + F.ngw - 1) / F.ngw, rb = F.gw * per, re = (rb + per < MA) ? rb + per : MA;
    int cur_bs = -1; f32x4 gm[4], sh[4];
    for (int r0 = rb; r0 < re; r0 += 2) {
        const int r1 = (r0 + 1 < re) ? r0 + 1 : r0; const bool two = r1 != r0;
        const bool lat0 = r0 < ML, lat1 = r1 < ML; const float* src0 = lat0 ? A.in[0] + (size_t)r0 * D : A.in[2] + (size_t)(r0 - ML) * D; const float* src1 = lat1 ? A.in[0] + (size_t)r1 * D : A.in[2] + (size_t)(r1 - ML) * D;
        const int bs0 = lat0 ? r0 / SEQ : 16, bs1 = lat1 ? r1 / SEQ : 16;
        f32x4 v0[4], v1[4]; ld_row_f32(src0, F.lane, v0); ld_row_f32(src1, F.lane, v1);
        if (bs0 != cur_bs) { const float* mod = modv + (size_t)bs0 * 6144; f32x4 g[4]; ld_row_f32(gam, F.lane, g); ld_row_f32(mod + D, F.lane, gm); ld_row_f32(mod, F.lane, sh); cur_bs = bs0;
#pragma unroll
            for (int j = 0; j < 4; ++j) gm[j] = g[j] * (1.0f + gm[j]); }
        { const float rs = row_rs(v0);
#pragma unroll
          for (int j = 0; j < 4; ++j) v0[j] = (v0[j] * rs) * gm[j] + sh[j]; }
        st_row_bf16(XL + (size_t)r0 * D, F.lane, v0);
        if (bs1 != cur_bs) { const float* mod = modv + (size_t)bs1 * 6144; f32x4 g[4]; ld_row_f32(gam, F.lane, g); ld_row_f32(mod + D, F.lane, gm); ld_row_f32(mod, F.lane, sh); cur_bs = bs1;
#pragma unroll
            for (int j = 0; j < 4; ++j) gm[j] = g[j] * (1.0f + gm[j]); }
        { const float rs = row_rs(v1);
#pragma unroll
          for (int j = 0; j < 4; ++j) v1[j] = (v1[j] * rs) * gm[j] + sh[j]; }
        if (two) st_row_bf16(XL + (size_t)r1 * D, F.lane, v1);
    }
}
template <bool HIN16, bool HOUT16, class SrcH, class DstH, class Keep, class Vecs>
__device__ __forceinline__ void thin_gn(Frame& F, const bf16* Y, bf16* XL, SrcH srcH, DstH dstH, Keep keep, Vecs vecs) {
    const int per = (MA + F.ngw - 1) / F.ngw, rb = F.gw * per, re = (rb + per < MA) ? rb + per : MA;
    int cur_bs = -1; f32x4 tg[4], gm[4], sh[4];
    for (int r0 = rb; r0 < re; r0 += 2) {
        const int r1 = (r0 + 1 < re) ? r0 + 1 : r0; const bool two = r1 != r0;
        f32x4 h0[4], y0[4], h1[4], y1[4];
        if constexpr (HIN16) { ld_row_bf16((const bf16*)srcH(r0), F.lane, h0); ld_row_bf16((const bf16*)srcH(r1), F.lane, h1); } else { ld_row_f32((const float*)srcH(r0), F.lane, h0); ld_row_f32((const float*)srcH(r1), F.lane, h1); }
        ld_row_bf16(Y + (size_t)r0 * D, F.lane, y0); ld_row_bf16(Y + (size_t)r1 * D, F.lane, y1);
#pragma unroll
        for (int q = 0; q < 2; ++q) { const int r = q ? r1 : r0; f32x4 (&h)[4] = q ? h1 : h0; f32x4 (&y)[4] = q ? y1 : y0;
            const int bs = (r < ML) ? r / SEQ : 16;
            if (bs != cur_bs) { cur_bs = bs; const float *ga, *gt, *gb, *sc, *sf; vecs(bs, ga, gt, gb, sc, sf); f32x4 g1[4], g2[4];
                ld_row_f32(ga, F.lane, g1); ld_row_f32(gt, F.lane, tg); ld_row_f32(gb, F.lane, g2); ld_row_f32(sc, F.lane, gm); ld_row_f32(sf, F.lane, sh);
#pragma unroll
                for (int j = 0; j < 4; ++j) { tg[j] = tg[j] * g1[j]; gm[j] = g2[j] * (1.0f + gm[j]); } }
            { const float rs = row_rs(y);
#pragma unroll
              for (int j = 0; j < 4; ++j) h[j] = h[j] + (y[j] * rs) * tg[j]; }
            if ((q == 0 || two) && keep(r)) { if constexpr (HOUT16) st_row_bf16((bf16*)dstH(r), F.lane, h); else st_row_f32((float*)dstH(r), F.lane, h); }
            { const float rs = row_rs(h);
#pragma unroll
              for (int j = 0; j < 4; ++j) h[j] = (h[j] * rs) * gm[j] + sh[j]; }
            if (q == 0 || two) st_row_bf16(XL + (size_t)r * D, F.lane, h); }
    }
}
__device__ __forceinline__ void thin_t2(Frame& F, const Args& A) {
    static_assert(!FFN0_IS_FP8 && FFN0_DN_FP8, "T2 writes a bf16 XL; HB sits behind the e4m3 ACT");
    const float* modv = (const float*)(A.ws + WS_MODV); bf16* HB = (bf16*)(A.ws + WS_HB); const float* gam = A.in[6]; const float* in0 = A.in[0]; const float* in2 = A.in[2];
    thin_gn<false, true>(F, (const bf16*)(A.ws + WS_YL), (bf16*)(A.ws + WS_XL),
            [=](int r) { return (const void*)((r < ML) ? in0 + (size_t)r * D : in2 + (size_t)(r - ML) * D); }, [=](int r) { return (void*)(HB + (size_t)r * D); }, [](int) { return true; },
            [=](int bs, const float*& ga, const float*& gt, const float*& gb, const float*& sc, const float*& sf) { const float* m = modv + (size_t)bs * 6144; ga = gam + 1 * D; gt = m + 2 * D; gb = gam + 2 * D; sc = m + 4 * D; sf = m + 3 * D; });
}
__device__ __forceinline__ void thin_t3(Frame& F, const Args& A) {
    const float* modv = (const float*)(A.ws + WS_MODV); const bf16* HB = (const bf16*)(A.ws + WS_HB); const float* gam = A.in[6]; bf16* h2 = (bf16*)A.out;
    thin_gn<true, true>(F, (const bf16*)(A.ws + WS_FL), (bf16*)(A.ws + WS_XL),
            [=](int r) { return (const void*)(HB + (size_t)r * D); }, [=](int r) { return (void*)(h2 + (size_t)r * D); }, [](int r) { return r < ML; },
            [=](int bs, const float*& ga, const float*& gt, const float*& gb, const float*& sc, const float*& sf) { const float* m = modv + (size_t)bs * 6144; const float* m1 = modv + (size_t)(17 + bs) * 6144; ga = gam + 3 * D; gt = m + 5 * D; gb = gam + 4 * D; sc = m1 + D; sf = m1; });
}
__device__ __forceinline__ void thin_t4(Frame& F, const Args& A) {
    const float* modv = (const float*)(A.ws + WS_MODV); bf16* XL = (bf16*)(A.ws + WS_XLM); const bf16* YL = (const bf16*)(A.ws + WS_YL1); const float* gam = A.in[6] + 4 * D;
    const float* router = A.in[31]; unsigned* tok = (unsigned*)(A.ws + WS_TOK); unsigned short* inv = (unsigned short*)(A.ws + WS_INV);
    LAS float* rt = (LAS float*)(F.lds);
    LAS unsigned* wc = (LAS unsigned*)(F.lds + 32768);
    __syncthreads();
    for (int i = F.tid; i < 8 * 1024; i += NWAVES * 64) { const int e = i >> 10, c = i & 1023; rt[i] = router[(size_t)c * 8 + e]; }
    __syncthreads();
    for (int chunk = blockIdx.x; chunk < ML / 128; chunk += F.G) {
        const int row_base = chunk * 128 + F.wave * 16;
        int me0 = 0, me1 = 0; float mw0 = 0.f, mw1 = 0.f;
        const float* mod1 = modv + (size_t)(17 + row_base / SEQ) * 6144;
        f32x4 tg[4], gm[4], sh[4];
        { f32x4 g1[4], g2[4]; ld_row_f32(gam + 1 * D, F.lane, g1); ld_row_f32(mod1 + 2 * D, F.lane, tg); ld_row_f32(gam + 2 * D, F.lane, g2); ld_row_f32(mod1 + 4 * D, F.lane, gm); ld_row_f32(mod1 + 3 * D, F.lane, sh);
#pragma unroll
          for (int j = 0; j < 4; ++j) { tg[j] = tg[j] * g1[j]; gm[j] = g2[j] * (1.0f + gm[j]); } }
        const bf16* h2 = (const bf16*)A.out;
        v2u hn[4], yn[4];
#pragma unroll
        for (int j = 0; j < 4; ++j) hn[j] = ((const GAS v2u*)(h2 + (size_t)row_base * D) + F.lane)[64 * j];
#pragma unroll
        for (int j = 0; j < 4; ++j) yn[j] = ((const GAS v2u*)(YL + (size_t)row_base * D) + F.lane)[64 * j];
        for (int i = 0; i < 16; ++i) {
            const int r = row_base + i;
            f32x4 h[4], y[4];
#pragma unroll
            for (int j = 0; j < 4; ++j) { h[j] = (f32x4){bf_lo(hn[j].x), bf_hi(hn[j].x), bf_lo(hn[j].y), bf_hi(hn[j].y)}; y[j] = (f32x4){bf_lo(yn[j].x), bf_hi(yn[j].x), bf_lo(yn[j].y), bf_hi(yn[j].y)}; }
            if (i + 1 < 16) {
#pragma unroll
                for (int j = 0; j < 4; ++j) { hn[j] = ((const GAS v2u*)(h2 + (size_t)(r + 1) * D) + F.lane)[64 * j]; yn[j] = ((const GAS v2u*)(YL + (size_t)(r + 1) * D) + F.lane)[64 * j]; } }
            { const float rs = row_rs(y);
#pragma unroll
              for (int j = 0; j < 4; ++j) h[j] = h[j] + (y[j] * rs) * tg[j]; }
            st_row_bf16((bf16*)(A.ws + WS_HB2) + (size_t)r * D, F.lane, h);
            { const float rs = row_rs(h);
#pragma unroll
              for (int j = 0; j < 4; ++j) h[j] = (h[j] * rs) * gm[j] + sh[j]; }
            st_row_fp8((unsigned char*)XL + (size_t)r * D, F.lane, h, FP8_SA);
            float lg[8];
#pragma unroll
            for (int e = 0; e < 8; ++e) lg[e] = 0.f;
#pragma unroll
            for (int j = 0; j < 4; ++j) {
#pragma unroll
                for (int e = 0; e < 8; ++e) { const f32x4 w = *(const LAS f32x4*)(rt + e * 1024 + 256 * j + 4 * F.lane); lg[e] += (h[j].x * w.x + h[j].y * w.y) + (h[j].z * w.z + h[j].w * w.w); }
                __builtin_amdgcn_sched_barrier(0); }
            {
              const bool b5 = (F.lane & 32) != 0, b4 = (F.lane & 16) != 0, b3 = (F.lane & 8) != 0; float v4[4], v2[2];
#pragma unroll
              for (int i2 = 0; i2 < 4; ++i2) { const float keep = b5 ? lg[i2 + 4] : lg[i2], send = b5 ? lg[i2] : lg[i2 + 4]; v4[i2] = keep + __shfl_xor(send, 32); }
#pragma unroll
              for (int i2 = 0; i2 < 2; ++i2) { const float keep = b4 ? v4[i2 + 2] : v4[i2], send = b4 ? v4[i2] : v4[i2 + 2]; v2[i2] = keep + __shfl_xor(send, 16); }
              float v1 = (b3 ? v2[1] : v2[0]) + __shfl_xor(b3 ? v2[0] : v2[1], 8);
              v1 += __shfl_xor(v1, 1); v1 += __shfl_xor(v1, 2); v1 += __shfl_xor(v1, 4);
#pragma unroll
              for (int e = 0; e < 8; ++e) lg[e] = __builtin_bit_cast(float, __builtin_amdgcn_readlane(__builtin_bit_cast(int, v1), 8 * e)); }
            int e0 = 0; float v0 = lg[0];
#pragma unroll
            for (int e = 1; e < 8; ++e) if (lg[e] > v0) { v0 = lg[e]; e0 = e; }
            int e1 = (e0 + 1) & 7; float v1 = -3.0e38f;
#pragma unroll
            for (int e = 0; e < 8; ++e) if (e != e0 && lg[e] > v1) { v1 = lg[e]; e1 = e; }
            const float w1 = 1.0f / (1.0f + __expf(v0 - v1)), w0 = 1.0f - w1;
            if (F.lane == i) { me0 = e0; me1 = e1; mw0 = w0; mw1 = w1; }
        }
        unsigned long long m[8];
#pragma unroll
        for (int e = 0; e < 8; ++e) m[e] = __ballot(F.lane < 16 && (me0 == e || me1 == e));
        { unsigned c = 0;
#pragma unroll
          for (int e = 0; e < 8; ++e) c = (F.lane == e) ? (unsigned)__popcll(m[e]) : c;
          if (F.lane < 8) wc[F.wave * 8 + F.lane] = c; }
        __syncthreads();
        if (F.tid < 8) { unsigned tot = 0;
#pragma unroll
            for (int w = 0; w < 8; ++w) tot += wc[w * 8 + F.tid];
            unsigned run = __hip_atomic_fetch_add((unsigned*)(F.ctl + CW_CNT + F.tid), tot, __ATOMIC_RELAXED, __HIP_MEMORY_SCOPE_AGENT);
#pragma unroll
            for (int w = 0; w < 8; ++w) { const unsigned c = wc[w * 8 + F.tid]; wc[w * 8 + F.tid] = run; run += c; } }
        __syncthreads();
        if (F.lane < 16) { unsigned long long m0 = 0ull, m1 = 0ull;
#pragma unroll
            for (int e = 0; e < 8; ++e) { m0 = (me0 == e) ? m[e] : m0; m1 = (me1 == e) ? m[e] : m1; }
            const unsigned long long below = (1ull << F.lane) - 1ull;
            const unsigned i0 = wc[F.wave * 8 + me0] + (unsigned)__popcll(m0 & below), i1 = wc[F.wave * 8 + me1] + (unsigned)__popcll(m1 & below);
            unsigned* t = tok + (size_t)(row_base + F.lane) * 8; t[0] = (unsigned)me0; t[1] = (unsigned)me1; t[2] = i0; t[3] = i1; t[4] = __float_as_uint(mw0); t[5] = __float_as_uint(mw1);
            inv[(size_t)me0 * 32768 + i0] = (unsigned short)(row_base + F.lane); inv[(size_t)me1 * 32768 + i1] = (unsigned short)(row_base + F.lane); }
        __syncthreads();
    }
}
__device__ __forceinline__ void moe_tile_starts(Frame& F, int (&ts)[9]) {
    ts[0] = 0;
#pragma unroll
    for (int e = 0; e < 8; ++e) { const unsigned c = __hip_atomic_load((unsigned*)(F.ctl + CW_CNT + e), __ATOMIC_RELAXED, __HIP_MEMORY_SCOPE_AGENT); ts[e + 1] = ts[e] + (int)((c + 255u) >> 8); }
#pragma unroll
    for (int e = 0; e < 9; ++e) ts[e] = __builtin_amdgcn_readfirstlane(ts[e]);
}
template <class Sched> __device__ __forceinline__ void moe_row_table(Frame& F, const Args& A, const Sched& S, const int (&ts)[9]) {
    const unsigned short* inv = (const unsigned short*)(A.ws + WS_INV); LAS unsigned short* tab = (LAS unsigned short*)(F.lds + ATAB_OFF);
    __syncthreads();
    LAS unsigned* up = (LAS unsigned*)(F.lds + ATAB_OFF + ATAB_UNITS * 512);
    if (F.tid < ATAB_UNITS) { pg8::Unit u; unsigned r0 = 0, left = 0, e = 0;
        if (S.next(F.tid, u)) { int ee = 0;
#pragma unroll
            for (int q = 1; q < 8; ++q) ee += (u.pm >= ts[q]) ? 1 : 0;
            int tse = 0;
#pragma unroll
            for (int q = 0; q < 8; ++q) tse = (ee == q) ? ts[q] : tse;
            const unsigned cnt = __hip_atomic_load((unsigned*)(F.ctl + CW_CNT + ee), __ATOMIC_RELAXED, __HIP_MEMORY_SCOPE_AGENT);
            r0 = (unsigned)(u.pm - tse) * 256u; left = cnt > r0 ? cnt - r0 : 0u; e = (unsigned)ee; }
        up[F.tid * 4] = r0; up[F.tid * 4 + 1] = left; up[F.tid * 4 + 2] = e; }
    __syncthreads();
    if (F.tid < 256) {
        for (int i0 = 0; i0 < ATAB_UNITS; i0 += 8) {
            unsigned short v[8];
#pragma unroll
            for (int k = 0; k < 8; ++k) { v[k] = 0; if (i0 + k < ATAB_UNITS) { const unsigned r0 = up[(i0 + k) * 4], left = up[(i0 + k) * 4 + 1], e = up[(i0 + k) * 4 + 2];
                if ((unsigned)F.tid < left) v[k] = inv[(size_t)e * 32768 + r0 + F.tid]; } }
#pragma unroll
            for (int k = 0; k < 8; ++k) if (i0 + k < ATAB_UNITS) tab[(i0 + k) * 256 + F.tid] = v[k];
        } }
    __syncthreads();
}
__device__ __forceinline__ void thin_t5(Frame& F, const Args& A) {
    int ts[9]; moe_tile_starts(F, ts);
    const float* modv = (const float*)(A.ws + WS_MODV); const bf16* Y = (const bf16*)(A.ws + WS_Y); const float* gam = A.in[6] + 7 * D; const unsigned* tok = (const unsigned*)(A.ws + WS_TOK);
    for (int r = F.gw; r < ML; r += F.ngw) {
        const int bs = r / SEQ; const float* mod1 = modv + (size_t)(17 + bs) * 6144;
        const unsigned* t = tok + (size_t)r * 8; const float w0 = __uint_as_float(t[4]), w1 = __uint_as_float(t[5]); const int e0 = (int)t[0], e1 = (int)t[1]; int s0 = 0, s1 = 0;
#pragma unroll
        for (int e = 0; e < 8; ++e) { s0 = (e0 == e) ? ts[e] : s0; s1 = (e1 == e) ? ts[e] : s1; }
        const unsigned p0 = (unsigned)s0 * 256u + t[2], p1 = (unsigned)s1 * 256u + t[3];
        f32x4 h[4], y0[4], y1[4]; ld_row_bf16((const bf16*)(A.ws + WS_HB2) + (size_t)r * D, F.lane, h); ld_row_bf16(Y + (size_t)p0 * D, F.lane, y0); ld_row_bf16(Y + (size_t)p1 * D, F.lane, y1);
#pragma unroll
        for (int j = 0; j < 4; ++j) y0[j] = y0[j] * w0 + y1[j] * w1;
        gated_add(h, y0, gam, mod1 + 5 * D, F.lane); st_row_f32(A.out + (size_t)r * D, F.lane, h);
    }
}

__device__ __forceinline__ float rope_inv(int f) { return exp2f(-(float)f * (13.287712379549449f / 8.0f)); }
__device__ __forceinline__ unsigned pk2hw(float lo, float hi) { unsigned r; asm("v_cvt_pk_bf16_f32 %0, %1, %2" : "=v"(r) : "v"(lo), "v"(hi)); return r; }
__device__ __forceinline__ void prep_qa(Frame& F, const Args& A) {
    const bf16* Z0 = (const bf16*)(A.ws + WS_Z0C); bf16* QA = (bf16*)(A.ws + WS_QA); bf16* KR = (bf16*)(A.ws + WS_KR);
    const int n2 = (32 * 9 > F.G && 32 * 9 < 2 * F.G) ? 32 * 9 - F.G : 0;
    if ((int)blockIdx.x < n2) return;
    const int step = F.ngw - n2 * NWAVES, l = F.lane & 31;
    for (int rb = F.gw - n2 * NWAVES; rb < MA; rb += 4 * step) {
        v2u cq4[4]; unsigned ck4[4]; unsigned short v4[4];
#pragma unroll
        for (int q = 0; q < 4; ++q) { const int r = (rb + q * step < MA) ? rb + q * step : rb; const bf16* z = Z0 + (size_t)r * 512;
            cq4[q] = *((const GAS v2u*)(z) + F.lane); ck4[q] = *((const GAS unsigned*)(z + 256) + F.lane); v4[q] = *((const GAS unsigned short*)(z + 384) + l); }
#pragma unroll
        for (int q = 0; q < 4; ++q) { const int r = rb + q * step; if (r >= MA) break;
            const v2u cq = cq4[q]; const unsigned ck = ck4[q];
            const float q0 = bf_lo(cq.x), q1 = bf_hi(cq.x), q2 = bf_lo(cq.y), q3 = bf_hi(cq.y), k0 = bf_lo(ck), k1 = bf_hi(ck);
            const float rq = rsqrtf(wave_sum((q0 * q0 + q1 * q1) + (q2 * q2 + q3 * q3)) * (1.0f / QRANK) + EPS);
            const float rk = rsqrtf(wave_sum(k0 * k0 + k1 * k1) * (1.0f / KVRANK) + EPS);
            v2u oq; oq.x = pk2hw(q0 * rq, q1 * rq); oq.y = pk2hw(q2 * rq, q3 * rq);
            *((GAS v2u*)(QA + (size_t)r * KQKV) + F.lane) = oq; *((GAS unsigned*)(QA + (size_t)r * KQKV + QRANK) + F.lane) = pk2hw(k0 * rk, k1 * rk);
            float v = __uint_as_float((unsigned)v4[q] << 16); const float pv = __shfl_xor(v, 8);
            if (r < ML) { const int t = r % SEQ; const float pos = (l < 16) ? (float)(t / 64) : (float)(t % 64); float sn, cs; __sincosf(pos * rope_inv(l & 7), &sn, &cs);
                v = (l & 8) ? (v * cs + pv * sn) : (v * cs - pv * sn); }
            if (F.lane < 32) KR[(size_t)r * 32 + l] = (bf16)(pk2hw(v, 0.f) & 0xffffu); }
    }
}
__device__ __forceinline__ void rope_q(Frame& F, const Args& A) {
    bf16* Q = (bf16*)(A.ws + WS_Q);
    for (int r = F.gw; r < ML; r += F.ngw) {
        const int t = r % SEQ, hh = F.lane >> 3, sub = F.lane & 7; bf16* p = Q + (size_t)r * 768 + hh * QK + NOPE + sub;
        const float inv = rope_inv(sub); float sr, cr, sc, cc; sincosf((float)(t / 64) * inv, &sr, &cr); sincosf((float)(t % 64) * inv, &sc, &cc);
        const float x0 = bf1(p[0]), x1 = bf1(p[8]), x2 = bf1(p[16]), x3 = bf1(p[24]);
        p[0] = (bf16)f2bf(x0 * cr - x1 * sr); p[8] = (bf16)f2bf(x1 * cr + x0 * sr); p[16] = (bf16)f2bf(x2 * cc - x3 * sc); p[24] = (bf16)f2bf(x3 * cc + x2 * sc);
    }
}
__device__ __forceinline__ int scan_row(int b, int dir, int tau) {
    if (tau < CTXL) return ML + b * CTXL + (dir ? CTXL - 1 - tau : tau);
    const int t = tau - CTXL; return b * SEQ + (dir ? SEQ - 1 - t : t);
}
__device__ __forceinline__ float gelu_tanh(float x) { const float u = 0.7978845608028654f * (x + 0.044715f * x * x * x); const float e = __expf(2.0f * u); const float th = 1.0f - 2.0f / (e + 1.0f); return 0.5f * x * (1.0f + th); }
__device__ __forceinline__ void gen_s5(Frame& F, const Args& A, int g) {
    constexpr int CS = 65, PS = 34, KS = 260;
    LAS float* pw = (LAS float*)F.lds;
    LAS float* cc = pw + 2 * 64 * PS;
    LAS float* bb = cc + 2 * 16 * CS * 2;
    LAS float* KK = bb + 2 * 64 * 16 * 2;
    LAS float* LL = KK + 2 * 16 * KS;
    LAS float* DSK = LL + 128 * 4;
    bf16* B1g = (bf16*)(A.ws + WS_B1) + (size_t)g * 256 * 256; bf16* B3g = (bf16*)(A.ws + WS_B3) + (size_t)g * 256 * 512;
    __syncthreads();
    { float lr = 0.f, li = 0.f, dtr = 0.f, dk = 0.f, braw[4], biraw[4], craw[4], ciraw[4];
      if (F.tid < 128) { const int d = F.tid >> 6, p = F.tid & 63, ig = d * S5G + g, i = ig * S5P + p; lr = A.in[8][i]; li = A.in[9][i]; dtr = A.in[10][ig]; }
      if (F.tid < 16) dk = A.in[15][g * 16 + F.tid];
#pragma unroll
      for (int q = 0; q < 4; ++q) { const int idx = F.tid + q * (NWAVES * 64); { const int dp = idx >> 4, h = idx & 15, d = dp >> 6, p = dp & 63; const size_t i = (size_t)((d * S5G + g) * S5P + p); braw[q] = A.in[11][i * 16 + h]; biraw[q] = A.in[12][i * 16 + h]; }
        { const int d = idx >> 10, ho = (idx >> 6) & 15, p = idx & 63; const size_t ci = (size_t)((d * S5G + g) * 16 + ho) * S5P + p; craw[q] = A.in[13][ci]; ciraw[q] = A.in[14][ci]; } }
      if (F.tid < 128) { const float dt = expf(dtr); LL[F.tid * 4] = lr; LL[F.tid * 4 + 1] = li; LL[F.tid * 4 + 2] = lr * dt; LL[F.tid * 4 + 3] = li * dt; }
      if (F.tid < 16) DSK[F.tid] = dk;
#pragma unroll
      for (int q = 0; q < 4; ++q) { const int idx = F.tid + q * (NWAVES * 64); bb[idx * 2] = braw[q]; bb[idx * 2 + 1] = biraw[q];
        { const int d = idx >> 10, ho = (idx >> 6) & 15, p = idx & 63; cc[((d * 16 + ho) * CS + p) * 2] = craw[q]; cc[((d * 16 + ho) * CS + p) * 2 + 1] = ciraw[q]; } } }
    __syncthreads();
    PROBE_STAMP2(F, 25);
    for (int idx = F.tid; idx < 128 * 17; idx += NWAVES * 64) { const int dp = idx / 17, k = idx - dp * 17;
        const float mag = expf((float)k * LL[dp * 4 + 2]), ang = (float)k * LL[dp * 4 + 3]; pw[dp * PS + k * 2] = mag * cosf(ang); pw[dp * PS + k * 2 + 1] = mag * sinf(ang); }
    for (int idx = F.tid; idx < 128 * 16; idx += NWAVES * 64) { const int dp = idx >> 4;
        const float lr = LL[dp * 4], li = LL[dp * 4 + 1], lrdt = LL[dp * 4 + 2], lidt = LL[dp * 4 + 3];
        const float mag = expf(lrdt), ar = mag * cosf(lidt), ai = mag * sinf(lidt), den = lr * lr + li * li, nr = ar - 1.0f;
        const float cr = (nr * lr + ai * li) / den, ci = (ai * lr - nr * li) / den;
        const float br = bb[idx * 2], bi = bb[idx * 2 + 1]; bb[idx * 2] = cr * br - ci * bi; bb[idx * 2 + 1] = cr * bi + ci * br; }
    __syncthreads();
    PROBE_STAMP2(F, 26);
    { const int ho = F.tid & 15, k = (F.tid >> 4) & 15, d = F.tid >> 8;
      float acc[16];
#pragma unroll
      for (int hi = 0; hi < 16; ++hi) acc[hi] = 0.f;
      for (int p = 0; p < 64; ++p) { const float cr = cc[((d * 16 + ho) * CS + p) * 2], ci = cc[((d * 16 + ho) * CS + p) * 2 + 1], pr = pw[(d * 64 + p) * PS + k * 2], pi = pw[(d * 64 + p) * PS + k * 2 + 1];
          const float wr = cr * pr - ci * pi, wi = cr * pi + ci * pr; const LAS f32x4* bp = (const LAS f32x4*)(bb + (d * 64 + p) * 32);
#pragma unroll
          for (int q = 0; q < 8; ++q) { const f32x4 b4 = bp[q]; acc[2 * q] += wr * b4.x - wi * b4.y; acc[2 * q + 1] += wr * b4.z - wi * b4.w; } }
#pragma unroll
      for (int hi = 0; hi < 16; ++hi) KK[(d * 16 + k) * KS + ho * 16 + hi] = acc[hi]; }
    __syncthreads();
    PROBE_STAMP2(F, 27);
    for (int it = F.tid; it < 256 * 32; it += NWAVES * 64) { const int n = it >> 5, kk0 = (it & 31) * 8;
        float v3[8], v3b[8], v1[8];
        { const int j = n >> 4, ho = n & 15, i = kk0 >> 4, hi0 = kk0 & 15; const float dsk = DSK[ho];
#pragma unroll
          for (int e8 = 0; e8 < 8; ++e8) { const int hi = hi0 + e8; float val = 0.f;
            if (i <= j) val += KK[(0 * 16 + (j - i)) * KS + ho * 16 + hi];
            if (i >= j) val += KK[(1 * 16 + (i - j)) * KS + ho * 16 + hi];
            if (i == j && ho == hi) val += dsk;
            v3[e8] = val; }
          const int d = kk0 >> 7, p0 = (kk0 & 127) >> 1, e = d ? (16 - j) : (j + 1);
#pragma unroll
          for (int e8 = 0; e8 < 8; ++e8) { const int p = p0 + (e8 >> 1), reim = e8 & 1;
            const float cr = cc[((d * 16 + ho) * CS + p) * 2], ci = cc[((d * 16 + ho) * CS + p) * 2 + 1], pr = pw[(d * 64 + p) * PS + e * 2], pi = pw[(d * 64 + p) * PS + e * 2 + 1];
            v3b[e8] = reim ? -(cr * pi + ci * pr) : (cr * pr - ci * pi); } }
        { const int d = n >> 7, reim = n & 1, p = (n & 127) >> 1, i = kk0 >> 4, hi0 = kk0 & 15, e = d ? i : (15 - i);
          const float pr = pw[(d * 64 + p) * PS + e * 2], pi = pw[(d * 64 + p) * PS + e * 2 + 1];
#pragma unroll
          for (int e8 = 0; e8 < 8; ++e8) { const int hi = hi0 + e8; const float br = bb[((d * 64 + p) * 16 + hi) * 2], bi = bb[((d * 64 + p) * 16 + hi) * 2 + 1];
            v1[e8] = reim ? (pr * bi + pi * br) : (pr * br - pi * bi); } }
        const v4u w3 = {pk2(v3[0], v3[1]), pk2(v3[2], v3[3]), pk2(v3[4], v3[5]), pk2(v3[6], v3[7])}, w3b = {pk2(v3b[0], v3b[1]), pk2(v3b[2], v3b[3]), pk2(v3b[4], v3b[5]), pk2(v3b[6], v3b[7])};
        const v4u w1 = {pk2(v1[0], v1[1]), pk2(v1[2], v1[3]), pk2(v1[4], v1[5]), pk2(v1[6], v1[7])};
        *(GAS v4u*)(B3g + (size_t)n * 512 + kk0) = w3; *(GAS v4u*)(B3g + (size_t)n * 512 + 256 + kk0) = w3b; *(GAS v4u*)(B1g + (size_t)n * 256 + kk0) = w1; }
    __syncthreads();
}
typedef float f32x2s __attribute__((ext_vector_type(2)));
__device__ __forceinline__ void s5_scan(Frame& F, const Args& A) {
    if (F.wave < 4) {
        const float* DS = (const float*)(A.ws + WS_DS); bf16* A3 = (bf16*)(A.ws + WS_A3); const int p = F.lane;
        for (int task = blockIdx.x * 4 + F.wave; task < NB * S5G * 2; task += F.G * 4) {
            const int d = task & 1, g = (task >> 1) & 31, b = task >> 6, ig = d * S5G + g;
            const float lr = A.in[8][ig * S5P + p], li = A.in[9][ig * S5P + p], dt = expf(A.in[10][ig]);
            const float m16 = expf(16.0f * lr * dt), a16r = m16 * cosf(16.0f * li * dt), a16i = m16 * sinf(16.0f * li * dt);
            const float* ds = DS + (size_t)(g * 16 + b) * 144 * 256 + d * 128 + 2 * p; bf16* so = A3 + (size_t)(g * 16 + b) * 144 * 512 + 256 + d * 128 + 2 * p;
            float sr = 0.f, si = 0.f;
            float xr[2][16], xi[2][16];
#define S5_CBASE(blk) (d ? ((blk) == 0 ? 15 : 143 - ((blk) - 1) * 16) : (blk) * 16)
#define S5_LOAD(buf, blk) do { const int cb_ = S5_CBASE(blk), cs_ = d ? -1 : 1; _Pragma("unroll") for (int s = 0; s < 16; ++s) { const int c = cb_ + cs_ * s; const f32x2s t_ = *(const GAS f32x2s*)(ds + (size_t)c * 256); xr[buf][s] = t_.x; xi[buf][s] = t_.y; } } while (0)
            S5_LOAD(0, 0);
#pragma unroll
            for (int blk = 0; blk < 9; ++blk) {
                const int cbase = S5_CBASE(blk), cstep = d ? -1 : 1;
                if (blk + 1 < 9) S5_LOAD((blk + 1) & 1, blk + 1);
#pragma unroll
                for (int s = 0; s < 16; ++s) { const int c = cbase + cstep * s; unsigned pkd; asm("v_cvt_pk_bf16_f32 %0, %1, %2" : "=v"(pkd) : "v"(sr), "v"(si)); *(GAS unsigned*)(so + (size_t)c * 512) = pkd;
                    const float nsr = a16r * sr - a16i * si + xr[blk & 1][s], nsi = a16r * si + a16i * sr + xi[blk & 1][s]; sr = nsr; si = nsi; }
            }
#undef S5_LOAD
#undef S5_CBASE
        }
    }
}
__device__ __forceinline__ void attn_phase(Frame& F, const Args& A) {
    const bf16* Q = (const bf16*)(A.ws + WS_Q); const bf16* KV = (const bf16*)(A.ws + WS_KV); const bf16* KR = (const bf16*)(A.ws + WS_KR); bf16* AO = (bf16*)(A.ws + WS_AO);
    const int bid = (int)blockIdx.x; const int vcu = (F.G % 8 == 0) ? (bid % 8) * (F.G / 8) + bid / 8 : bid;
    const int shift = (F.G >= 256 && 1024 % F.G == 0) ? F.G - 128 : 0;
    for (int v = vcu; v < 1024 + shift + 128; v += F.G) {
        int u = v; if (v >= 1024 && shift) { u = 1024 + bid - shift; if (u < 1024) continue; }
        int b, h, qrow0, NT;
        if (u < 1024) { const int bh = u >> 3; b = bh >> 3; h = bh & 7; qrow0 = b * SEQ + (u & 7) * 256; NT = TT / 64; }
        else { const int uu = u - 1024; b = uu >> 3; h = uu & 7; qrow0 = ML + b * CTXL; NT = CTXL / 64; }
        att::attn_unit(Q + (size_t)qrow0 * 768 + h * QK, KV + h * NOPE, KR, KV + 512 + h * VD, ML + b * CTXL, CTXL / 64, b * SEQ, NT, AO + (size_t)qrow0 * D + S5W + h * VD, F.lds, (u < 1024) ? (u & 7) * 256 : -1);
    }
}
__device__ __forceinline__ void gate_ranks(Frame& F, const Args& A) {
    typedef short bf16x8_ __attribute__((ext_vector_type(8))); typedef float f32x16_ __attribute__((ext_vector_type(16)));
    const bf16* XL = (const bf16*)(A.ws + WS_XL); const bf16* W = (const bf16*)(A.ws + WS_W_IN1) + (size_t)3072 * D; bf16* VR = (bf16*)(A.ws + WS_VR);
    const int r32 = F.lane & 31, hi = F.lane >> 5;
    for (int rbk = F.wave * F.G + (int)blockIdx.x; rbk < MA / 32; rbk += NWAVES * F.G) {
        const GAS bf16x8_* xa = (const GAS bf16x8_*)(XL + (size_t)(rbk * 32 + r32) * D + hi * 8); const GAS bf16x8_* wb = (const GAS bf16x8_*)(W + (size_t)r32 * D + hi * 8);
        f32x16_ acc = {};
#pragma clang loop unroll(disable)
        for (int s0 = 0; s0 < 64; s0 += 8) { bf16x8_ a[8], b[8];
#pragma unroll
            for (int q = 0; q < 8; ++q) { a[q] = xa[(s0 + q) * 2]; b[q] = wb[(s0 + q) * 2]; }
#pragma unroll
            for (int q = 0; q < 8; ++q) acc = __builtin_amdgcn_mfma_f32_32x32x16_bf16(a[q], b[q], acc, 0, 0, 0); }
#pragma unroll
        for (int r = 0; r < 16; ++r) { const int row = rbk * 32 + (r & 3) + 8 * (r >> 2) + 4 * hi; VR[(size_t)row * VRLD + 2048 + r32] = (bf16)f2bf(acc[r]); }
    }
}
__device__ __forceinline__ void gla_prep_phase(Frame& F, const Args& A) {
    for (int j = blockIdx.x; j < NB * GH * 2 * 2; j += F.G) { const int ch = j >> 1, b = ch >> 3, h = (ch >> 1) & 3, dir = ch & 1;
        gla::gla_prep((const bf16*)(A.ws + WS_QK), (const bf16*)(A.ws + WS_VR) + 2048, A.in[27], A.in[28], (bf16*)(A.ws + WS_TQ), (bf16*)(A.ws + WS_TK), (bf16*)(A.ws + WS_TP), (float*)(A.ws + WS_EL),
                      b, h, dir, 18 * (j & 1), 18 * (j & 1) + 18, ML, SEQ, CTXL, F.lds); }
}
__device__ __forceinline__ void gla_chain_phase(Frame& F, const Args& A) {
    const int bid = (int)blockIdx.x; const int vcu = (F.G % 8 == 0) ? (bid % 8) * (F.G / 8) + bid / 8 : bid;
    for (int u = vcu; u < NB * GH * 2 * 2; u += F.G) { const int ch = u >> 1, vh = u & 1, b = ch >> 3, h = (ch >> 1) & 3, dir = ch & 1;
        gla::gla_chain2((const bf16*)(A.ws + WS_VR), (const bf16*)(A.ws + WS_TQ), (const bf16*)(A.ws + WS_TK), (const bf16*)(A.ws + WS_TP), (const float*)(A.ws + WS_EL), (bf16*)(A.ws + (dir ? WS_OB : WS_OF)),
                        b, h, dir, vh, ML, SEQ, CTXL, F.lds); }
}
__device__ __forceinline__ void gla_finish(Frame& F, const Args& A) {
    bf16* OF = (bf16*)(A.ws + WS_OF); const bf16* OB = (const bf16*)(A.ws + WS_OB); const bf16* VR = (const bf16*)(A.ws + WS_VR); const float* hn = A.in[29];
    const f32x4 g = *(const GAS f32x4*)(hn + 4 * F.lane);
    for (int r0 = F.gw; r0 < ML; r0 += 2 * F.ngw) {
        const int r1 = (r0 + F.ngw < ML) ? r0 + F.ngw : r0; const bool two = r1 != r0;
        f32x4 a0[4], b0[4], x0[4], a1[4], b1[4], x1[4];
        ld_row_bf16(OF + (size_t)r0 * D, F.lane, a0); ld_row_bf16(OB + (size_t)r0 * D, F.lane, b0); ld_row_bf16(VR + (size_t)r0 * VRLD + GVAL, F.lane, x0);
        ld_row_bf16(OF + (size_t)r1 * D, F.lane, a1); ld_row_bf16(OB + (size_t)r1 * D, F.lane, b1); ld_row_bf16(VR + (size_t)r1 * VRLD + GVAL, F.lane, x1);
#pragma unroll
        for (int j = 0; j < 4; ++j) { const f32x4 o0 = a0[j] + b0[j], o1 = a1[j] + b1[j];
            const float s0 = wave_sum((o0.x * o0.x + o0.y * o0.y) + (o0.z * o0.z + o0.w * o0.w)), s1 = wave_sum((o1.x * o1.x + o1.y * o1.y) + (o1.z * o1.z + o1.w * o1.w));
            const float rs0 = rsqrtf(s0 * (1.0f / GDV) + EPS), rs1 = rsqrtf(s1 * (1.0f / GDV) + EPS);
#pragma unroll
            for (int i = 0; i < 4; ++i) { const float u0 = x0[j][i], u1 = x1[j][i];
                a0[j][i] = o0[i] * rs0 * g[i] * (u0 * __builtin_amdgcn_rcpf(1.0f + __expf(-u0))); a1[j][i] = o1[i] * rs1 * g[i] * (u1 * __builtin_amdgcn_rcpf(1.0f + __expf(-u1))); } }
        st_row_bf16(OF + (size_t)r0 * D, F.lane, a0); if (two) st_row_bf16(OF + (size_t)r1 * D, F.lane, a1);
    }
}

#ifndef MK_ONE_LAUNCH
#define MK_ONE_LAUNCH 1
#endif
constexpr int NPHASE = 21;
constexpr bool SP2 = true, ALIGN = true;

__global__ void __launch_bounds__(NWAVES * 64, 2) fwd_kernel(Args args) {
    extern __shared__ __attribute__((aligned(16))) unsigned char lds[];
    Frame F;
    F.lds = (LAS unsigned char*)lds;
    F.MISC = (volatile LAS unsigned*)(F.lds + MISC_OFF);
    F.tid = threadIdx.x; F.lane = F.tid & 63; F.wave = __builtin_amdgcn_readfirstlane(F.tid >> 6);
    F.G = gridDim.x; F.gw = blockIdx.x * NWAVES + F.wave; F.ngw = F.G * NWAVES;
    unsigned char* ws = args.ws;
    F.ctl = (gu32*)(ws + WS_CTL);
    for (int u = F.tid; u < (LDS_BYTES - LDSCTL_OFF) / 4; u += NWAVES * 64) ((LAS unsigned*)(F.lds + LDSCTL_OFF))[u] = 0u;
    __syncthreads();
    XcdBarrier bar; bar.bar = (unsigned*)(F.ctl + CW_BAR); bar.x = 0; bar.st = nullptr;
    if (MK_ONE_LAUNCH) bar = xcd_barrier_post((unsigned*)(F.ctl + CW_BAR), F.MISC + 8);
    const int lo = args.ph_lo, hi = args.ph_hi;
#define IN(k) (lo <= (k) && (k) < hi)
#ifdef PROBE_SETA
    if (blockIdx.x == PROBE_BLK && F.tid == 0) { const unsigned long long t_ = __builtin_amdgcn_s_memrealtime(); F.MISC[16] = (unsigned)t_; F.MISC[17] = (unsigned)(t_ >> 32); }
#define PROBE_STAMP(k) do { if (blockIdx.x == PROBE_BLK && F.tid == 0) { const unsigned long long t_ = __builtin_amdgcn_s_memrealtime(); const unsigned long long l_ = ((unsigned long long)F.MISC[17] << 32) | F.MISC[16]; const unsigned d_ = (unsigned)(t_ - l_); \
        if ((PROBE_SETA >> (k)) & 1ull) F.MISC[18] += d_; if ((PROBE_SETB >> (k)) & 1ull) F.MISC[20] += d_; F.MISC[16] = (unsigned)t_; F.MISC[17] = (unsigned)(t_ >> 32); } } while (0)
#else
#define PROBE_STAMP(k) do { } while (0)
#endif
#ifdef PROBE_SETA
#define SEAM(k) do { if (MK_ONE_LAUNCH && IN(k) && IN((k) + 1)) xcd_barrier(bar); PROBE_STAMP(k); if (blockIdx.x == PROBE_BLK && F.tid == 0) F.MISC[22] = (unsigned)((k) + 1); } while (0)
#else
#define SEAM(k) do { if (MK_ONE_LAUNCH && IN(k) && IN((k) + 1)) xcd_barrier(bar); PROBE_STAMP(k); } while (0)
#endif
    const int bid = (int)blockIdx.x;
    LAS unsigned* UTAB = (LAS unsigned*)(F.lds + ATAB_OFF + ATAB_UNITS * 512);

    if (IN(0)) {
#ifndef NO_P0
 p0_prologue(F, args);
#endif
 } SEAM(0);
    if (IN(1)) { thin_t1(F, args); } SEAM(1);
    if (IN(2)) { pg8::Gemm g{(const bf16*)(ws + WS_XL), (const bf16*)(ws + WS_W_IN0), MA, EV_INP, D}; pg8::StaticOrder S; S.init(MA, EV_INP, F.G, bid);
        pg8::EpiIn0 E{(bf16*)(ws + WS_U), (bf16*)(ws + WS_A3), (bf16*)(ws + WS_Z0C)};
        { auto CS = pg8::cache_order(S, UTAB, F.tid); pg8::gemm_phase<pg8::EpiIn0, pg8::CachedOrder<pg8::StaticOrder>, ALIGN, SP2>(F.lds + RING_OFF, g, CS, E); }
        tail_convert(F, args, (MA / 256) * (EV_INP / 256), MW0, MW1); } SEAM(2);
    if (IN(3)) { prep_qa(F, args); PROBE_STAMP(26);
        int k256 = 256; asm volatile("" : "+s"(k256));
        pg8::Gemm g{(const bf16*)(ws + WS_U), (const bf16*)(ws + WS_B1), 32 * 2304, 256, k256}; pg8::S5Order S{F.G, bid};
        pg8::EpiF32 E{(float*)(ws + WS_DS), 256};
        { auto CS = pg8::cache_order(S, UTAB, F.tid); pg8::gemm_phase<pg8::EpiF32, pg8::CachedOrder<pg8::S5Order>, ALIGN, SP2>(F.lds + RING_OFF, g, CS, E); } } SEAM(3);
    if (IN(4)) { s5_scan(F, args); PROBE_STAMP(25);
        pg8::Gemm g{(const bf16*)(ws + WS_QA), (const bf16*)(ws + WS_W_QKV), MA, NQKV, KQKV}; pg8::StaticOrder S; S.init(MA, NQKV, F.G, bid);
        pg8::EpiSplit E{(bf16*)(ws + WS_Q), 768, (bf16*)(ws + WS_KV), 1024, 3, 0x7fffffff};
        { auto CS = pg8::cache_order(S, UTAB, F.tid); pg8::gemm_phase<pg8::EpiSplit, pg8::CachedOrder<pg8::StaticOrder>, ALIGN, SP2, false, false, false, false, true>(F.lds + RING_OFF, g, CS, E); } } SEAM(4);
    if (IN(5)) {
        pg8::Gemm g{(const bf16*)(ws + WS_A3), (const bf16*)(ws + WS_B3), 32 * 2304, 256, 512}; pg8::S5Order S{F.G, bid};
        pg8::EpiS5Out E{(bf16*)(ws + WS_AG)};
        { auto CS = pg8::cache_order(S, UTAB, F.tid); pg8::gemm_phase<pg8::EpiS5Out, pg8::CachedOrder<pg8::S5Order>, ALIGN, SP2>(F.lds + RING_OFF, g, CS, E); } } SEAM(5);
    if (IN(6)) {
#ifndef NO_ATT
 attn_phase(F, args);
#endif
        PROBE_STAMP(21);
        pg8::Gemm g{(const bf16*)(ws + WS_AG), (const bf16*)(ws + WS_W_GLU), MA, S5W, S5W}; pg8::StaticOrder S; S.init(MA, S5W, F.G, bid);
        pg8::EpiGlu E{(const bf16*)(ws + WS_AG), args.in[17], (bf16*)(ws + WS_AO), D};
        { auto CS = pg8::cache_order(S, UTAB, F.tid); pg8::gemm_phase<pg8::EpiGlu, pg8::CachedOrder<pg8::StaticOrder>, ALIGN, SP2, false, false, true>(F.lds + RING_OFF, g, CS, E); } } SEAM(6);
    if (IN(7)) { pg8::Gemm g{(const bf16*)(ws + WS_AO), (const bf16*)(ws + WS_W_OUT0), MA, D, D}; pg8::StaticOrder S; S.init(MA, D, F.G, bid);
        pg8::EpiPlain E{(bf16*)(ws + WS_YL), D, 0, 0, 1.0f};
        { auto CS = pg8::cache_order(S, UTAB, F.tid); pg8::gemm_phase<pg8::EpiPlain, pg8::CachedOrder<pg8::StaticOrder>, ALIGN, SP2>(F.lds + RING_OFF, g, CS, E); }
        tail_convert(F, args, (MA / 256) * (D / 256), MW1, MW2); } SEAM(7);
    if (IN(8)) { thin_t2(F, args); } SEAM(8);
    static_assert(!FFN0_IS_FP8, "the e4m3 dense-FFN variant does not carry the MoE weight conversion in its down phase");
    if constexpr (FFN0_IS_FP8) {
    if (IN(9)) { pg8::Gemm g{(const bf16*)(ws + WS_XL), (const bf16*)(ws + WS_W_GU), MA, 2 * FFN, D / 2}; pg8::StaticOrder S; S.init(MA, 2 * FFN, F.G, bid);
        pg8::EpiSwiGlu8 E{ws + WS_ACT, FFN, 0, 1.0f / (FP8_SA * FP8_SW), FP8_SACT, 0};
        { auto CS = pg8::cache_order(S, UTAB, F.tid); pg8::gemm_phase<pg8::EpiSwiGlu8, pg8::CachedOrder<pg8::StaticOrder>, ALIGN, SP2, true>(F.lds + RING_OFF, g, CS, E); } } SEAM(9);
    if (IN(10)) { pg8::Gemm g{(const bf16*)(ws + WS_ACT), (const bf16*)(ws + WS_W_DN), MA, D, FFN / 2}; pg8::StaticOrder S; S.init(MA, D, F.G, bid);
        pg8::EpiPlain E{(bf16*)(ws + WS_FL), D, 0, 0, 1.0f / (FP8_SACT * FP8_SW)};
        { auto CS = pg8::cache_order(S, UTAB, F.tid); pg8::gemm_phase<pg8::EpiPlain, pg8::CachedOrder<pg8::StaticOrder>, ALIGN, SP2, true>(F.lds + RING_OFF, g, CS, E); } } SEAM(10);
    } else {
    if (IN(9)) { pg8::Gemm g{(const bf16*)(ws + WS_XL), (const bf16*)(ws + WS_W_GU), MA, 2 * FFN, D}; pg8::StaticOrder S; S.init(MA, 2 * FFN, F.G, bid);
        if constexpr (FFN0_DN_FP8) { pg8::EpiSwiGlu8 E{ws + WS_ACT, FFN, 0, 1.0f, FP8_SACT, 0};
            { auto CS = pg8::cache_order(S, UTAB, F.tid); pg8::gemm_phase<pg8::EpiSwiGlu8, pg8::CachedOrder<pg8::StaticOrder>, ALIGN, SP2>(F.lds + RING_OFF, g, CS, E); } }
        else { pg8::EpiSwiGlu E{(bf16*)(ws + WS_ACT), FFN, 0, 0};
            { auto CS = pg8::cache_order(S, UTAB, F.tid); pg8::gemm_phase<pg8::EpiSwiGlu, pg8::CachedOrder<pg8::StaticOrder>, ALIGN, SP2>(F.lds + RING_OFF, g, CS, E); } }
        tail_convert(F, args, (MA / 256) * (2 * FFN / 256), MW2, MW3); } SEAM(9);
    if (IN(10)) { pg8::StaticOrder S; S.init(MA, D, F.G, bid);
        if constexpr (FFN0_DN_FP8) { pg8::Gemm g{(const bf16*)(ws + WS_ACT), (const bf16*)(ws + WS_W_DN), MA, D, FFN / 2};
            pg8::EpiPlain E{(bf16*)(ws + WS_FL), D, 0, 0, 1.0f / (FP8_SACT * FP8_SW)};
            { auto CS = pg8::cache_order(S, UTAB, F.tid); pg8::gemm_phase<pg8::EpiPlain, pg8::CachedOrder<pg8::StaticOrder>, ALIGN, SP2, true>(F.lds + RING_OFF, g, CS, E); } }
        else { pg8::Gemm g{(const bf16*)(ws + WS_ACT), (const bf16*)(ws + WS_W_DN), MA, D, FFN};
            pg8::EpiPlain E{(bf16*)(ws + WS_FL), D, 0, 0, 1.0f};
            { auto CS = pg8::cache_order(S, UTAB, F.tid); pg8::gemm_phase<pg8::EpiPlain, pg8::CachedOrder<pg8::StaticOrder>, ALIGN, SP2>(F.lds + RING_OFF, g, CS, E); } }
        tail_convert(F, args, (MA / 256) * (D / 256), MW3, MW4); } SEAM(10);
    }
    if (IN(11)) { thin_t3(F, args); } SEAM(11);
    if (IN(12)) { gate_ranks(F, args);
        pg8::Gemm g{(const bf16*)(ws + WS_XL), (const bf16*)(ws + WS_W_IN1), MA, 3072, D}; pg8::StaticOrder S; S.init(MA, 3072, F.G, bid);
        pg8::EpiSplit E{(bf16*)(ws + WS_QK), 1024, (bf16*)(ws + WS_VR), VRLD, 4, 0x7fffffff};
        { auto CS = pg8::cache_order(S, UTAB, F.tid); pg8::gemm_phase<pg8::EpiSplit, pg8::CachedOrder<pg8::StaticOrder>, ALIGN, SP2>(F.lds + RING_OFF, g, CS, E); }
        tail_convert(F, args, (MA / 256) * (3072 / 256), MW4, MW5); } SEAM(12);
    if (IN(13)) {
#ifndef NO_GLA
 gla_prep_phase(F, args);
#endif
    } SEAM(13);
    if (IN(14)) {
#ifndef NO_GLA
 gla_chain_phase(F, args);
#endif
    } SEAM(14);
    if (IN(15)) { gla_finish(F, args); } SEAM(15);
    if (IN(16)) { pg8::Gemm g{(const bf16*)(ws + WS_OF), (const bf16*)(ws + WS_W_OUT1), ML, D, D}; pg8::StaticOrder S; S.init(ML, D, F.G, bid);
        pg8::EpiPlain E{(bf16*)(ws + WS_YL1), D, 0, 0, 1.0f};
        { auto CS = pg8::cache_order(S, UTAB, F.tid); pg8::gemm_phase<pg8::EpiPlain, pg8::CachedOrder<pg8::StaticOrder>, ALIGN, SP2>(F.lds + RING_OFF, g, CS, E); } } SEAM(16);
    if (IN(17)) { thin_t4(F, args); } SEAM(17);
    if (lo < 20 && hi > 18) {
        int ts[9]; moe_tile_starts(F, ts); const int NT = ts[8];
        if (IN(18)) { pg8::MoeOrder S{0, NT, 2 * FE / 256, F.G, bid, ts[1], ts[2], ts[3], ts[4], ts[5], ts[6], ts[7], 0};
            moe_row_table(F, args, S, ts); PROBE_STAMP(27);
            pg8::Gemm g{(const bf16*)(ws + WS_XLM), (const bf16*)(ws + WS_W_MGU), ML, 2 * FE, D / 2, (const LAS unsigned short*)(F.lds + ATAB_OFF)};
            pg8::EpiSwiGlu8 E{ws + WS_ACTM, FE, 2 * FE / 256, 1.0f / (FP8_SA * FP8_SW), FP8_SACT, 1};
            { auto CS = pg8::cache_order(S, UTAB, F.tid); pg8::gemm_phase<pg8::EpiSwiGlu8, pg8::CachedOrder<pg8::MoeOrder>, ALIGN, SP2, true, false, false, true>(F.lds + RING_OFF, g, CS, E); } } SEAM(18);
        if (IN(19)) { pg8::Gemm g{(const bf16*)(ws + WS_ACTM), (const bf16*)(ws + WS_W_MDN), MOE_MAXT * 256, D, FE / 2};
            pg8::MoeOrder S{0, NT, D / 256, F.G, bid, ts[1], ts[2], ts[3], ts[4], ts[5], ts[6], ts[7], 1};
            pg8::EpiPlain E{(bf16*)(ws + WS_Y), D, 0, D / 256, 1.0f / (FP8_SACT * FP8_SW)};
            { auto CS = pg8::cache_order(S, UTAB, F.tid); pg8::gemm_phase<pg8::EpiPlain, pg8::CachedOrder<pg8::MoeOrder>, ALIGN, SP2, true, true>(F.lds + RING_OFF, g, CS, E); } } SEAM(19);
    }
    if (IN(20)) { thin_t5(F, args); }
#ifdef PROBE_SETA
    PROBE_STAMP(20);
    if (blockIdx.x == PROBE_BLK && F.tid == 0) {
        unsigned long long qa = F.MISC[18] / 100u, qb = F.MISC[20] / 400u; qa = qa > 999 ? 999 : qa; qb = qb > 199 ? 199 : qb;
        const unsigned long long t0 = __builtin_amdgcn_s_memrealtime(), dl = qa * 1000ull + qb * 1000000ull;
        while (__builtin_amdgcn_s_memrealtime() - t0 < dl) __builtin_amdgcn_s_sleep(32);
    }
#endif
#undef IN
#undef SEAM
}

extern "C" void kernel_launch(void* const* d_in, const int* in_sizes, int n_in, void* d_out, int out_size, void* d_ws, size_t ws_size, hipStream_t stream) {
    static int grid = 0;
    if (grid == 0) {
        if (n_in != 35 || out_size != ML * D || ws_size < WS_END) { fprintf(stderr, "kernel_launch: unexpected shapes: n_in %d out %d ws %zu (need %zu)\n", n_in, out_size, ws_size, (size_t)WS_END); grid = -1; return; }
        int dev = 0, cus = 0, per_cu = 0;
        if (hipGetDevice(&dev) != hipSuccess || hipDeviceGetAttribute(&cus, hipDeviceAttributeMultiprocessorCount, dev) != hipSuccess) { grid = -1; return; }
        if (hipFuncSetAttribute((const void*)fwd_kernel, hipFuncAttributeMaxDynamicSharedMemorySize, LDS_BYTES) != hipSuccess) { fprintf(stderr, "kernel_launch: hipFuncSetAttribute failed\n"); grid = -1; return; }
        if (hipOccupancyMaxActiveBlocksPerMultiprocessor(&per_cu, (const void*)fwd_kernel, NWAVES * 64, LDS_BYTES) != hipSuccess || per_cu < 1) { fprintf(stderr, "kernel_launch: occupancy query reports %d blocks per CU\n", per_cu); }
        (void)hipGetLastError();
        grid = cus;
    }
    if (grid < 0) return;
    (void)hipMemsetAsync((char*)d_ws + WS_CTL, 0, CTL_ZERO_BYTES, stream);
    Args a{};
    for (int i = 0; i < 35; ++i) a.in[i] = (const float*)d_in[i];
    a.out = (float*)d_out; a.ws = (unsigned char*)d_ws;
#if MK_ONE_LAUNCH
    a.ph_lo = 0; a.ph_hi = NPHASE;
    hipLaunchKernelGGL(fwd_kernel, dim3(grid), dim3(NWAVES * 64), LDS_BYTES, stream, a);
#else
    for (int p = 0; p < NPHASE; ++p) { a.ph_lo = p; a.ph_hi = p + 1; hipLaunchKernelGGL(fwd_kernel, dim3(grid), dim3(NWAVES * 64), LDS_BYTES, stream, a); }
#endif
}
```
